# Optimizing an MI355X kernel written in HIP

```python
import jax, jax.numpy as jnp
from jax import lax
import numpy as np

D_MODEL = 2048
BATCH = 2
SEQ = 4096
DEPTH = 1

GLA_HEADS = 4
GLA_DK = D_MODEL // 4 // GLA_HEADS
GLA_DV = D_MODEL // 2 // GLA_HEADS
GLA_RANK = 16
GLA_TAU = 16.0
GLA_CHUNK = 64
MOBA_HEADS = 8
MOBA_HD = D_MODEL // 2 // MOBA_HEADS
MOBA_BLOCK = 256
MOBA_TOPK = 3
MOBA_QCHUNK = 16
ROPE_THETA = 10000.0
N_EXPERTS = 32
TOP_K = 4
D_EXPERT = D_MODEL
SWIGLU_LIMIT = 7.0
SWIGLU_ALPHA = 1.702
MOE_BLOCK = 128
EPS = 1e-6

QA = GLA_HEADS * GLA_DK
VA = GLA_HEADS * GLA_DV
QB = MOBA_HEADS * MOBA_HD
IN_SIZES = [QA, QA, VA, VA, GLA_RANK, QB, QB, QB]
D_IN = sum(IN_SIZES)
IN_SPLITS = [int(s) for s in np.cumsum(IN_SIZES)[:-1]]

kernel_name = "hymba_gla_moba_gptoss_moe_adaln"


def rmsnorm(x, w):
    x32 = x.astype(jnp.float32)
    y = x32 * lax.rsqrt(jnp.mean(x32 * x32, axis=-1, keepdims=True) + EPS)
    return (y * w.astype(jnp.float32)).astype(x.dtype)


def modulate(h, shift, scale):
    return h * (1.0 + scale[:, None, :]) + shift[:, None, :]


def rope(x):
    T, D = x.shape[1], x.shape[3]
    half = D // 2
    inv = ROPE_THETA ** (-jnp.arange(half, dtype=jnp.float32) * 2.0 / D)
    ang = jnp.arange(T, dtype=jnp.float32)[:, None] * inv[None, :]
    cos = jnp.cos(ang)[None, :, None, :].astype(x.dtype)
    sin = jnp.sin(ang)[None, :, None, :].astype(x.dtype)
    x1, x2 = x[..., :half], x[..., half:]
    return jnp.concatenate([x1 * cos - x2 * sin, x1 * sin + x2 * cos], axis=-1)


def gla_mixer(q, k, v, gk):
    B, T, H, DK = q.shape
    DV = v.shape[-1]
    nc = T // GLA_CHUNK

    def to_chunks(a):
        a = a.astype(jnp.float32).reshape(B, nc, GLA_CHUNK, H, a.shape[-1])
        return a.transpose(1, 0, 3, 2, 4)

    qc, kc, vc, gc = (to_chunks(a) for a in (q * (GLA_DK ** -0.5), k, v, gk))
    causal = jnp.tril(jnp.ones((GLA_CHUNK, GLA_CHUNK), dtype=bool))

    def step(S, inp):
        qi, ki, vi, gi = inp
        b = jnp.cumsum(gi, axis=2)
        b_last = b[:, :, -1:, :]
        o_inter = jnp.einsum('bhcd,bhde->bhce', qi * jnp.exp(b), S)
        diff = b[:, :, :, None, :] - b[:, :, None, :, :]
        decay = jnp.exp(jnp.where(causal[:, :, None], diff, -jnp.inf))
        A = jnp.einsum('bhid,bhjd,bhijd->bhij', qi, ki, decay)
        o = o_inter + jnp.einsum('bhij,bhje->bhie', A, vi)
        S = jnp.exp(b_last[:, :, 0, :])[..., None] * S + jnp.einsum(
            'bhcd,bhce->bhde', ki * jnp.exp(b_last - b), vi)
        return S, o

    S0 = jnp.zeros((B, H, DK, DV), jnp.float32)
    _, o = lax.scan(step, S0, (qc, kc, vc, gc))
    o = o.transpose(1, 0, 3, 2, 4).reshape(B, T, H, DV)
    return o.astype(v.dtype)


def moba_mixer(q, k, v):
    B, T, H, D = q.shape
    nb = -(-T // MOBA_BLOCK)
    Tp = nb * MOBA_BLOCK
    pad = ((0, 0), (0, 0), (0, Tp - T), (0, 0))
    qh = jnp.pad(q.transpose(0, 2, 1, 3), pad)
    kh = jnp.pad(k.transpose(0, 2, 1, 3), pad)
    vh = jnp.pad(v.transpose(0, 2, 1, 3), pad)
    kb = kh.reshape(B, H, nb, MOBA_BLOCK, D)
    vb = vh.reshape(B, H, nb, MOBA_BLOCK, D)
    pos = jnp.arange(Tp)
    qblk = pos // MOBA_BLOCK
    n_sel = min(MOBA_TOPK, nb - 1)
    own = jnp.broadcast_to(qblk[None, None, :, None], (B, H, Tp, 1))
    if n_sel > 0:
        kmean = jnp.mean(kb.astype(jnp.float32), axis=3)
        gate = jnp.einsum('bhtd,bhnd->bhtn', qh.astype(jnp.float32), kmean)
        past = jnp.arange(nb)[None, :] < qblk[:, None]
        gate = jnp.where(past[None, None], gate, -jnp.inf)
        _, sel = lax.top_k(gate, n_sel)
        idx = jnp.concatenate([sel.astype(jnp.int32), own.astype(jnp.int32)], axis=-1)
        sel_valid = jnp.arange(n_sel)[None, :] < qblk[:, None]
        slot_valid = jnp.concatenate([sel_valid, jnp.ones((Tp, 1), bool)], axis=-1)
    else:
        idx = own.astype(jnp.int32)
        slot_valid = jnp.ones((Tp, 1), bool)
    S = idx.shape[-1]
    nq = Tp // MOBA_QCHUNK
    qc = jnp.moveaxis(qh.reshape(B, H, nq, MOBA_QCHUNK, D), 2, 0)
    ic = jnp.moveaxis(idx.reshape(B, H, nq, MOBA_QCHUNK, S), 2, 0)
    svc = slot_valid.reshape(nq, MOBA_QCHUNK, S)
    qpc = pos.reshape(nq, MOBA_QCHUNK)
    bidx = jnp.arange(B)[:, None, None, None]
    hidx = jnp.arange(H)[None, :, None, None]
    scale = MOBA_HD ** -0.5

    def attend(inp):
        qi, ii, sv, qp = inp
        ks = kb[bidx, hidx, ii]
        vs = vb[bidx, hidx, ii]
        kpos = ii[..., None] * MOBA_BLOCK + jnp.arange(MOBA_BLOCK)
        mask = sv[None, None, :, :, None] & (kpos <= qp[None, None, :, None, None])
        s = jnp.einsum('bhqd,bhqskd->bhqsk', qi, ks).astype(jnp.float32) * scale
        s = jnp.where(mask, s, -jnp.inf)
        Bq, Hq, Q = s.shape[:3]
        p = jax.nn.softmax(s.reshape(Bq, Hq, Q, -1), axis=-1).reshape(s.shape)
        return jnp.einsum('bhqsk,bhqskd->bhqd', p.astype(vs.dtype), vs)

    o = lax.map(attend, (qc, ic, svc, qpc))
    o = jnp.moveaxis(o, 0, 2).reshape(B, H, Tp, D)[:, :, :T]
    return o.transpose(0, 2, 1, 3)


def moe_ffn(h, w_router, b_router, w_gate_up, b_gate_up, w_down, b_down):
    B, T, D = h.shape
    xf = h.reshape(-1, D)
    N = xf.shape[0]
    logits = (xf @ w_router + b_router).astype(jnp.float32)
    top_v, top_i = lax.top_k(logits, TOP_K)
    top_w = jax.nn.softmax(top_v, axis=-1)
    NK = N * TOP_K
    flat_e = top_i.reshape(-1).astype(jnp.int32)
    flat_t = jnp.repeat(jnp.arange(N, dtype=jnp.int32), TOP_K)
    flat_w = top_w.reshape(-1)
    order = jnp.argsort(flat_e)
    se, st, sw = flat_e[order], flat_t[order], flat_w[order]
    counts = jnp.bincount(flat_e, length=N_EXPERTS)
    start = jnp.cumsum(counts) - counts
    pcounts = (counts + MOE_BLOCK - 1) // MOE_BLOCK * MOE_BLOCK
    pend = jnp.cumsum(pcounts)
    pstart = pend - pcounts
    dest = pstart[se] + jnp.arange(NK) - start[se]
    P = (-(-NK // MOE_BLOCK)) * MOE_BLOCK + N_EXPERTS * MOE_BLOCK
    nblk = P // MOE_BLOCK
    tok_buf = jnp.full((P,), N, jnp.int32).at[dest].set(st)
    w_buf = jnp.zeros((P,), jnp.float32).at[dest].set(sw)
    blk_e = jnp.minimum(jnp.searchsorted(pend, jnp.arange(nblk) * MOE_BLOCK, side='right'),
                        N_EXPERTS - 1).astype(jnp.int32)
    x_pad = jnp.concatenate([xf, jnp.zeros((1, D), xf.dtype)], axis=0)

    def expert_block(inp):
        tok, e = inp
        xb = x_pad[tok]
        gu = xb @ w_gate_up[e] + b_gate_up[e]
        g, u = gu[:, :D_EXPERT], gu[:, D_EXPERT:]
        g = jnp.minimum(g, SWIGLU_LIMIT)
        u = jnp.clip(u, -SWIGLU_LIMIT, SWIGLU_LIMIT)
        glu = g * jax.nn.sigmoid(g * SWIGLU_ALPHA)
        return ((u + 1.0) * glu) @ w_down[e] + b_down[e]

    y = lax.map(expert_block, (tok_buf.reshape(nblk, MOE_BLOCK), blk_e)).reshape(P, D)
    y = (y * w_buf[:, None]).astype(h.dtype)
    out = jnp.zeros((N + 1, D), h.dtype).at[tok_buf].add(y)[:N]
    return out.reshape(B, T, D)


def setup_inputs(seed: int = 0) -> dict:
    key = jax.random.key(seed)
    ks = jax.random.split(key, 20)
    L, D, E, F = DEPTH, D_MODEL, N_EXPERTS, D_EXPERT
    nrm = lambda k, shape, fan: jax.random.normal(k, shape, jnp.float32) * (fan ** -0.5)
    return {
        "x": jax.random.normal(ks[0], (BATCH, SEQ, D), jnp.float32),
        "c": jax.random.normal(ks[1], (BATCH, D), jnp.float32),
        "w_ada": nrm(ks[2], (L, D, 6 * D), D) * 0.5,
        "b_ada": 0.01 * jax.random.normal(ks[3], (L, 6 * D), jnp.float32),
        "norm1_w": 1.0 + 0.02 * jax.random.normal(ks[4], (L, D), jnp.float32),
        "w_in": nrm(ks[5], (L, D, D_IN), D),
        "w_alpha2": nrm(ks[6], (L, GLA_RANK, QA), GLA_RANK),
        "b_alpha": 0.1 * jax.random.normal(ks[7], (L, QA), jnp.float32),
        "gla_norm_w": 1.0 + 0.02 * jax.random.normal(ks[8], (L, GLA_DV), jnp.float32),
        "w_out": nrm(ks[9], (L, VA + QB, D), VA + QB),
        "norm2_w": 1.0 + 0.02 * jax.random.normal(ks[10], (L, D), jnp.float32),
        "w_router": nrm(ks[11], (L, D, E), D),
        "b_router": 0.01 * jax.random.normal(ks[12], (L, E), jnp.float32),
        "w_gate_up": nrm(ks[13], (L, E, D, 2 * F), D),
        "b_gate_up": 0.01 * jax.random.normal(ks[14], (L, E, 2 * F), jnp.float32),
        "w_down": nrm(ks[15], (L, E, F, D), F),
        "b_down": 0.01 * jax.random.normal(ks[16], (L, E, D), jnp.float32),
        "final_norm_w": 1.0 + 0.02 * jax.random.normal(ks[17], (D,), jnp.float32),
    }


def reference(x, c, w_ada, b_ada, norm1_w, w_in, w_alpha2, b_alpha, gla_norm_w, w_out,
              norm2_w, w_router, b_router, w_gate_up, b_gate_up, w_down, b_down, final_norm_w):
    B, T, D = x.shape
    c_act = jax.nn.silu(c)
    for l in range(DEPTH):
        mod = c_act @ w_ada[l] + b_ada[l]
        sh1, sc1, g1, sh2, sc2, g2 = jnp.split(mod, 6, axis=-1)
        h = modulate(rmsnorm(x, norm1_w[l]), sh1, sc1)
        proj = h @ w_in[l]
        qa, ka, va, ga, la, qb, kb, vb = jnp.split(proj, IN_SPLITS, axis=-1)
        gk = jax.nn.log_sigmoid((la @ w_alpha2[l] + b_alpha[l]).astype(jnp.float32)) / GLA_TAU
        heads_a = lambda a, d: a.reshape(B, T, GLA_HEADS, d)
        oa = gla_mixer(heads_a(qa, GLA_DK), heads_a(ka, GLA_DK), heads_a(va, GLA_DV),
                       heads_a(gk, GLA_DK))
        oa = rmsnorm(oa, gla_norm_w[l]) * jax.nn.silu(heads_a(ga, GLA_DV))
        heads_b = lambda a: a.reshape(B, T, MOBA_HEADS, MOBA_HD)
        ob = moba_mixer(rope(heads_b(qb)), rope(heads_b(kb)), heads_b(vb))
        o = jnp.concatenate([oa.reshape(B, T, VA), ob.reshape(B, T, QB)], axis=-1) @ w_out[l]
        x = x + g1[:, None, :] * o
        h2 = modulate(rmsnorm(x, norm2_w[l]), sh2, sc2)
        x = x + g2[:, None, :] * moe_ffn(h2, w_router[l], b_router[l], w_gate_up[l],
                                         b_gate_up[l], w_down[l], b_down[l])
    return rmsnorm(x, final_norm_w)
```

```cpp
#include <hip/hip_runtime.h>
#include <stdint.h>
#include <stdio.h>

#define LAS __attribute__((address_space(3)))
typedef unsigned short bf16_t;
typedef short bf16x8 __attribute__((ext_vector_type(8)));
typedef float f32x4 __attribute__((ext_vector_type(4)));
typedef float f32x2 __attribute__((ext_vector_type(2)));
typedef unsigned u32x4 __attribute__((ext_vector_type(4)));
typedef unsigned u32x2 __attribute__((ext_vector_type(2)));

constexpr int DM = 2048, NBATCH = 2, SEQ = 4096, NTOK = 8192;
constexpr int DIN = 6160, NPROJ = 6144;
constexpr int NE = 32, TOPK = 4;
constexpr int C_QA = 0, C_KA = 512, C_VA = 1024, C_GA = 2048, C_QB = 3072, C_KB = 4096, C_VB = 5120;
constexpr int MAXROWS = 40960;
constexpr float EPS = 1e-6f;

constexpr size_t MB = 1024ull * 1024ull;
constexpr size_t WS_BAR = 0;
constexpr size_t WS_CNT = 16384;
constexpr size_t WS_ZERO_BYTES = 20480;
constexpr size_t WS_MOD = 32768;
constexpr size_t WS_ROPE = 1 * MB;
constexpr size_t WS_H1 = 3 * MB;
constexpr size_t WS_GK = WS_H1 + 32 * MB;
constexpr size_t WS_PROJ = WS_GK + 16 * MB;
constexpr size_t WS_WIN_T = WS_PROJ + 96 * MB;
constexpr size_t WS_WOUT_T = WS_WIN_T + 24 * MB;
constexpr size_t WS_WGU_T = WS_WOUT_T + 8 * MB;
constexpr size_t WS_WD_T = WS_WGU_T + 512 * MB;
constexpr size_t WS_BCUM = WS_WD_T + 256 * MB;
constexpr size_t WS_DST = WS_BCUM + 16 * MB;
constexpr size_t WS_DEC = WS_DST + 64 * MB;
constexpr size_t WS_ST = WS_DEC + 1 * MB;
constexpr size_t WS_QBR = WS_ST + 32 * MB;
constexpr size_t WS_KBR = WS_QBR + 16 * MB;
constexpr size_t WS_VBT = WS_KBR + 16 * MB;
constexpr size_t WS_KMEAN = WS_VBT + 16 * MB;
constexpr size_t WS_SEL = WS_KMEAN + 1 * MB;
constexpr size_t WS_OCAT = WS_SEL + 1 * MB;
constexpr size_t WS_X1 = WS_OCAT + 32 * MB;
constexpr size_t WS_PAIR_E = WS_X1 + 64 * MB;
constexpr size_t WS_PAIR_POS = WS_PAIR_E + 1 * MB;
constexpr size_t WS_PAIR_W = WS_PAIR_POS + 1 * MB;
constexpr size_t WS_SLOTROW = WS_PAIR_W + 1 * MB;
constexpr size_t WS_WBUF = WS_SLOTROW + 1 * MB;
constexpr size_t WS_XG = WS_WBUF + 1 * MB;
constexpr size_t WS_ACT = WS_XG + 160 * MB;
constexpr size_t WS_Y = WS_ACT + 160 * MB;
constexpr size_t WS_END = WS_Y + 160 * MB;

constexpr int LDS_BYTES = 147456;
constexpr int LDS_XB = 131072;
constexpr int LDS_TAB = 131072 + 64;
constexpr int LDS_EXTRA = 131072 + 1024;

struct Args {
    const float* x; const float* c; const float* w_ada; const float* b_ada; const float* norm1_w; const float* w_in; const float* w_alpha2; const float* b_alpha;
    const float* gla_norm_w; const float* w_out; const float* norm2_w; const float* w_router; const float* b_router; const float* w_gate_up; const float* b_gate_up;
    const float* w_down; const float* b_down; const float* final_norm_w;
    float* out; unsigned char* ws;
    int ph_lo, ph_hi;
};

__device__ __forceinline__ unsigned cvt_pk_bf16(float lo, float hi) { unsigned r; asm("v_cvt_pk_bf16_f32 %0, %1, %2" : "=v"(r) : "v"(lo), "v"(hi)); return r; }
__device__ __forceinline__ bf16_t f2bf(float f) { return (bf16_t)(cvt_pk_bf16(f, 0.f) & 0xffffu); }
__device__ __forceinline__ float bf2f(bf16_t b) { return __uint_as_float(((unsigned)b) << 16); }
__device__ __forceinline__ float bflo(unsigned w) { return __uint_as_float(w << 16); }
__device__ __forceinline__ float bfhi(unsigned w) { return __uint_as_float(w & 0xffff0000u); }
__device__ __forceinline__ float wave_sum(float v) {
#pragma unroll
    for (int o = 1; o < 64; o <<= 1) v += __shfl_xor(v, o);
    return v;
}
__device__ __forceinline__ float silu_f(float v) { return v / (1.f + expf(-v)); }
__device__ __forceinline__ f32x4 mfma16(bf16x8 a, bf16x8 b, f32x4 c) { return __builtin_amdgcn_mfma_f32_16x16x32_bf16(a, b, c, 0, 0, 0); }
__device__ __forceinline__ bf16x8 lds_frag(const LAS bf16_t* img, int ld, int r0, int k0, int lane) {
    return *(const LAS bf16x8*)(img + (r0 + (lane & 15)) * ld + k0 + 8 * (lane >> 4));
}

#define XB_TMO      128
#define XB_XCNT(j)  (256  + 64 * (j))
#define XB_XSUB(j)  (1280 + 64 * (j))
#define XB_XGEN(j)  (2304 + 64 * (j))
#define XB_TOP      3328
#define XB_TOPGEN   3392
#define XCD_BAR_WORDS 3456
#define XB_SPIN_CAP (1u << 18)
__device__ __forceinline__ unsigned xb_ld(unsigned* p)              { return __hip_atomic_load(p, __ATOMIC_RELAXED, __HIP_MEMORY_SCOPE_AGENT); }
__device__ __forceinline__ unsigned xb_add(unsigned* p, unsigned v) { return __hip_atomic_fetch_add(p, v, __ATOMIC_RELAXED, __HIP_MEMORY_SCOPE_AGENT); }
__device__ __forceinline__ unsigned xb_xcc_id() { return (unsigned)__builtin_amdgcn_s_getreg((3 << 11) | 20) & 0xFu; }
#define XB_SPIN(cond, bar) do { unsigned _sp = 0; while (cond) { __builtin_amdgcn_s_sleep(1); \
    if ((++_sp & 255u) == 0u) { if (xb_ld(&(bar)[XB_TMO])) break; if (_sp > XB_SPIN_CAP) { atomicAdd(&(bar)[XB_TMO], 1u); break; } } } } while (0)
struct XcdBarrier { unsigned* bar; unsigned x; volatile LAS unsigned* st; };
__device__ __forceinline__ XcdBarrier xcd_barrier_post(unsigned* bar, volatile LAS unsigned* st) {
    XcdBarrier b; b.bar = bar; b.x = xb_xcc_id(); b.st = st;
    if (threadIdx.x == 0) (void)xb_add(&bar[XB_XCNT(b.x)], 1u);
    return b;
}
__device__ __forceinline__ void xcd_barrier_complete(unsigned* bar, unsigned x, unsigned& nloc, unsigned& nx) {
    const unsigned G = gridDim.x * gridDim.y * gridDim.z;
    unsigned sum, cnt, mine, sp = 0u;
    for (;;) {
        sum = 0u; cnt = 0u; mine = 0u;
#pragma unroll
        for (unsigned j = 0; j < 16; ++j) { const unsigned c = xb_ld(&bar[XB_XCNT(j)]); sum += c; cnt += (c > 0u) ? 1u : 0u; mine = (j == x) ? c : mine; }
        if (sum == G) break;
        __builtin_amdgcn_s_sleep(1);
        if ((++sp & 255u) == 0u) { if (xb_ld(&bar[XB_TMO])) break; if (sp > XB_SPIN_CAP) { atomicAdd(&bar[XB_TMO], 1u); break; } }
    }
    nloc = mine > 0u ? mine : 1u; nx = cnt > 0u ? cnt : 1u;
}
__device__ __forceinline__ void xcd_barrier(const XcdBarrier& b) {
    asm volatile("s_waitcnt vmcnt(0)" ::: "memory");
    __syncthreads();
    if (threadIdx.x == 0) {
        unsigned* bar = b.bar;
        __builtin_amdgcn_s_waitcnt(0);
        unsigned nloc = b.st[0], nx = b.st[1];
        if (nloc == 0u) { xcd_barrier_complete(bar, b.x, nloc, nx); b.st[0] = nloc; b.st[1] = nx; }
        const unsigned old = xb_add(&bar[XB_XSUB(b.x)], 1u);
        const unsigned gen = old / nloc;
        if (old + 1u == (gen + 1u) * nloc) {
            __builtin_amdgcn_fence(__ATOMIC_RELEASE, "agent");
            asm volatile("s_waitcnt vmcnt(0)" ::: "memory");
            const unsigned og = xb_add(&bar[XB_TOP], 1u);
            const unsigned tg = og / nx;
            if (og + 1u == (tg + 1u) * nx) xb_add(&bar[XB_TOPGEN], 1u);
            else XB_SPIN(xb_ld(&bar[XB_TOPGEN]) == tg, bar);
            __builtin_amdgcn_fence(__ATOMIC_ACQUIRE, "agent");
            xb_add(&bar[XB_XGEN(b.x)], 1u);
            asm volatile("s_waitcnt vmcnt(0)" ::: "memory");
        } else {
            XB_SPIN(xb_ld(&bar[XB_XGEN(b.x)]) == gen, bar);
            __builtin_amdgcn_fence(__ATOMIC_ACQUIRE, "agent");
            asm volatile("s_waitcnt vmcnt(0)" ::: "memory");
        }
    }
    __syncthreads();
}

namespace pg8 {
constexpr int BM = 256, BK = 64, HALF = 128, HTB = HALF * BK * 2, STAGE_BYTES = 8 * HTB, NXCD = 8, WGM = 8;
__host__ __device__ __forceinline__ int lds_byte(int r, int c) { const int st = (r >> 4) * 2 + (c >> 5), rr = r & 15, cc = c & 31, ob = rr * 64 + cc * 2; return st * 1024 + (ob ^ (((ob >> 9) & 1) << 5)); }
__host__ __device__ __forceinline__ void stage_rc(int b, int& R, int& C) { const int st = b / 1024, sb = b % 1024, swz = sb ^ (((sb >> 9) & 1) << 5); R = (st >> 1) * 16 + swz / 64; C = (st & 1) * 32 + (swz % 64) / 2; }
__host__ __device__ __forceinline__ int perm32(int rho) { const int n = rho >> 4, i = rho & 15; return 8 * (i >> 2) + 4 * n + (i & 3); }

struct Unit { int pm, pn, e; };
struct Gemm { const bf16_t* A; const bf16_t* Bt; int K; size_t b_estride; };

struct StaticOrder {
    int nM, nN, nwg, G, c;
    __device__ void init(int M, int N, int G_, int c_) { nM = M / BM; nN = N / BM; nwg = nM * nN; G = G_; c = c_; }
    __device__ bool next(int i, Unit& u) const {
        const long L = (long)i * G + c; if (L >= nwg) return false;
        int wgid = (int)L; { const int q = nwg / NXCD, r = nwg % NXCD, xcd = wgid % NXCD, off = wgid / NXCD; wgid = (xcd < r ? xcd * (q + 1) : r * (q + 1) + (xcd - r) * q) + off; }
        const int nig = WGM * nN, gid = wgid / nig, fm = gid * WGM, gsz = (nM - fm) < WGM ? (nM - fm) : WGM;
        u.pm = fm + ((wgid % nig) % gsz); u.pn = (wgid % nig) / gsz; u.e = 0; return true;
    }
};
struct MoeOrder {
    const LAS int* tab; int G, c;
    __device__ bool next(int i, Unit& u) const {
        const int L = i * G + c; if (L >= tab[32]) return false;
        int e = 0;
#pragma unroll 1
        while (tab[e + 1] <= L) ++e;
        const int local = L - tab[e], rt0 = tab[33 + e], mte = tab[34 + e] - rt0;
        u.e = e; u.pn = local / mte; u.pm = rt0 + (local - u.pn * mte); return true;
    }
};

struct EpiProj {
    static constexpr bool PERM = true;
    bf16_t* O; int ldc;
    __device__ __forceinline__ void operator()(const f32x4 (&acc)[2][2][4][2], const Unit& u, int wr, int wc, int fr, int fq) const {
        const int row0 = u.pm * BM + wr * 64 + fr, col0 = u.pn * BM + wc * 32 + 8 * fq;
#pragma unroll
        for (int ai = 0; ai < 2; ++ai)
#pragma unroll
            for (int m = 0; m < 4; ++m) { bf16_t* rowp = O + (size_t)(row0 + ai * HALF + m * 16) * ldc + col0;
#pragma unroll
                for (int bj = 0; bj < 2; ++bj) { const f32x4 v0 = acc[ai][bj][m][0], v1 = acc[ai][bj][m][1];
                    u32x4 w; w.x = cvt_pk_bf16(v0[0], v0[1]); w.y = cvt_pk_bf16(v0[2], v0[3]); w.z = cvt_pk_bf16(v1[0], v1[1]); w.w = cvt_pk_bf16(v1[2], v1[3]);
                    *(u32x4*)(rowp + bj * HALF) = w; } }
    }
};
struct EpiOut {
    static constexpr bool PERM = false;
    const float* X; const float* g1;   float* O;
    __device__ __forceinline__ void operator()(const f32x4 (&acc)[2][2][4][2], const Unit& u, int wr, int wc, int fr, int fq) const {
        const int row0 = u.pm * BM + wr * 64 + fr, col0 = u.pn * BM + wc * 32 + 4 * fq;
        const float* gp = g1 + (size_t)((u.pm * BM) >> 12) * 12288 + col0;
        f32x4 gv[2][2];
#pragma unroll
        for (int bj = 0; bj < 2; ++bj)
#pragma unroll
            for (int n = 0; n < 2; ++n) gv[bj][n] = *(const f32x4*)(gp + bj * HALF + n * 16);
#pragma unroll
        for (int ai = 0; ai < 2; ++ai)
#pragma unroll
            for (int m = 0; m < 4; ++m) { const size_t off = (size_t)(row0 + ai * HALF + m * 16) * DM + col0;
#pragma unroll
                for (int bj = 0; bj < 2; ++bj)
#pragma unroll
                    for (int n = 0; n < 2; ++n) { const f32x4 xv = *(const f32x4*)(X + off + bj * HALF + n * 16);
                        *(f32x4*)(O + off + bj * HALF + n * 16) = xv + gv[bj][n] * acc[ai][bj][m][n]; }
                asm volatile("" ::: "memory"); }
    }
};
struct EpiGU {
    static constexpr bool PERM = true;
    const float* bias;   bf16_t* O;
    __device__ __forceinline__ void operator()(const f32x4 (&acc)[2][2][4][2], const Unit& u, int wr, int wc, int fr, int fq) const {
        const int row0 = u.pm * BM + wr * 64 + fr, cc = u.pn * HALF + wc * 32 + 8 * fq;
        const float* bp = bias + (size_t)u.e * 4096 + cc;
        f32x4 bg[2], bu[2];
#pragma unroll
        for (int n = 0; n < 2; ++n) { bg[n] = *(const f32x4*)(bp + 4 * n); bu[n] = *(const f32x4*)(bp + 2048 + 4 * n); }
#pragma unroll
        for (int ai = 0; ai < 2; ++ai)
#pragma unroll
            for (int m = 0; m < 4; ++m) { float r[8];
#pragma unroll
                for (int n = 0; n < 2; ++n)
#pragma unroll
                    for (int j = 0; j < 4; ++j) {
                        float g = acc[ai][0][m][n][j] + bg[n][j], uu = acc[ai][1][m][n][j] + bu[n][j];
                        g = fminf(g, 7.0f); uu = fminf(fmaxf(uu, -7.0f), 7.0f);
                        const float glu = g * __builtin_amdgcn_rcpf(1.0f + __expf(-1.702f * g));
                        r[n * 4 + j] = (uu + 1.0f) * glu; }
                u32x4 w; w.x = cvt_pk_bf16(r[0], r[1]); w.y = cvt_pk_bf16(r[2], r[3]); w.z = cvt_pk_bf16(r[4], r[5]); w.w = cvt_pk_bf16(r[6], r[7]);
                *(u32x4*)(O + (size_t)(row0 + ai * HALF + m * 16) * DM + cc) = w; }
    }
};
struct EpiDown {
    static constexpr bool PERM = true;
    const float* bias;   const float* wbuf; bf16_t* O;
    __device__ __forceinline__ void operator()(const f32x4 (&acc)[2][2][4][2], const Unit& u, int wr, int wc, int fr, int fq) const {
        const int row0 = u.pm * BM + wr * 64 + fr, col0 = u.pn * BM + wc * 32 + 8 * fq;
        const float* bp = bias + (size_t)u.e * 2048 + col0;
        f32x4 bv[2][2];
#pragma unroll
        for (int bj = 0; bj < 2; ++bj)
#pragma unroll
            for (int n = 0; n < 2; ++n) bv[bj][n] = *(const f32x4*)(bp + bj * HALF + 4 * n);
#pragma unroll
        for (int ai = 0; ai < 2; ++ai)
#pragma unroll
            for (int m = 0; m < 4; ++m) { const int row = row0 + ai * HALF + m * 16; const float rw = wbuf[row]; bf16_t* rowp = O + (size_t)row * DM + col0;
#pragma unroll
                for (int bj = 0; bj < 2; ++bj) { const f32x4 v0 = (acc[ai][bj][m][0] + bv[bj][0]) * rw, v1 = (acc[ai][bj][m][1] + bv[bj][1]) * rw;
                    u32x4 w; w.x = cvt_pk_bf16(v0[0], v0[1]); w.y = cvt_pk_bf16(v0[2], v0[3]); w.z = cvt_pk_bf16(v1[0], v1[1]); w.w = cvt_pk_bf16(v1[2], v1[3]);
                    *(u32x4*)(rowp + bj * HALF) = w; } }
    }
};

template <class Epi, class Sched>
__device__ __forceinline__ void gemm_phase(LAS unsigned char* lds, const Gemm g, const Sched& S, const Epi& E) {
    const int tid = threadIdx.x, wid = __builtin_amdgcn_readfirstlane(tid >> 6), lane = tid & 63, wr = wid >> 2, wc = wid & 3, fr = lane & 15, fq = lane >> 4;
    const int K = g.K, nt = K / BK;
    unsigned voffA[2], voffB[2];
#pragma unroll
    for (int i = 0; i < 2; ++i) { int R, C; stage_rc(tid * 16 + i * 8192, R, C); const int Rb = Epi::PERM ? ((R & ~31) + perm32(R & 31)) : R;
        voffA[i] = (unsigned)(R * K + C) * 2u; voffB[i] = (unsigned)(Rb * K + C) * 2u; }
    const size_t kstep = (size_t)(BK * 2);
    const size_t hstep = (size_t)HALF * K * 2;
    const size_t tstep = 2 * hstep;
    const size_t estep = g.b_estride * 2;
    const unsigned ldsw = (unsigned)wid * 1024u;
    const int aoff = lds_byte(wr * 64 + fr, fq * 8), boff = lds_byte(wc * 32 + fr, fq * 8);
#define PG8_SA(b, h) (((b) * 2 + (h)) * HTB)
#define PG8_SB(b, h) ((4 + (b) * 2 + (h)) * HTB)
#define PG8_STAGE(bufoff, gbase, voff) do { _Pragma("unroll") for (int _i = 0; _i < 2; ++_i) \
        __builtin_amdgcn_global_load_lds((const unsigned*)((const char*)(gbase) + (voff)[_i]), (LAS unsigned*)(lds + (bufoff) + ldsw + _i * 8192), 16, 0, 0); } while (0)
#define PG8_LDA(dst, b, h) do { _Pragma("unroll") for (int m = 0; m < 4; ++m) _Pragma("unroll") for (int k = 0; k < 2; ++k) dst[m][k] = *(const LAS bf16x8*)(lds + PG8_SA(b, h) + aoff + m * 2048 + k * 1024); } while (0)
#define PG8_LDB(dst, b, h) do { _Pragma("unroll") for (int n = 0; n < 2; ++n) _Pragma("unroll") for (int k = 0; k < 2; ++k) dst[n][k] = *(const LAS bf16x8*)(lds + PG8_SB(b, h) + boff + n * 2048 + k * 1024); } while (0)
#define PG8_MMA(ai, bj, At, Bt) do { __builtin_amdgcn_s_setprio(1); _Pragma("unroll") for (int m = 0; m < 4; ++m) _Pragma("unroll") for (int n = 0; n < 2; ++n) _Pragma("unroll") for (int k = 0; k < 2; ++k) \
        acc[ai][bj][m][n] = __builtin_amdgcn_mfma_f32_16x16x32_bf16(Bt[n][k], At[m][k], acc[ai][bj][m][n], 0, 0, 0); __builtin_amdgcn_s_setprio(0); } while (0)
#define PG8_WAIT_V(n) asm volatile("s_waitcnt vmcnt(" #n ")" ::: "memory")
#define PG8_WAIT_L(n) asm volatile("s_waitcnt lgkmcnt(" #n ")" ::: "memory")
#define PG8_BAR __builtin_amdgcn_s_barrier()
#define PG8_SCHED __builtin_amdgcn_sched_barrier(0)
    Unit cur, nxt; int ui = 0;
    if (!S.next(0, cur)) return;
    f32x4 acc[2][2][4][2];
#pragma unroll
    for (int a = 0; a < 2; ++a)
#pragma unroll
        for (int b = 0; b < 2; ++b)
#pragma unroll
            for (int m = 0; m < 4; ++m)
#pragma unroll
                for (int n = 0; n < 2; ++n) acc[a][b][m][n] = (f32x4){0.f, 0.f, 0.f, 0.f};
    bf16x8 At[4][2], B0[2][2], B1[2][2];
    const char* cA = (const char*)g.A + (size_t)cur.pm * tstep; const char* cB = (const char*)g.Bt + (size_t)cur.e * estep + (size_t)cur.pn * tstep;
    PG8_STAGE(PG8_SB(0, 0), cB, voffB); PG8_STAGE(PG8_SA(0, 0), cA, voffA); PG8_STAGE(PG8_SB(0, 1), cB + hstep, voffB); PG8_STAGE(PG8_SA(0, 1), cA + hstep, voffA);
    if (wr == 1) PG8_BAR;
    PG8_WAIT_V(4); PG8_BAR;
    PG8_STAGE(PG8_SB(1, 0), cB + kstep, voffB); PG8_STAGE(PG8_SA(1, 0), cA + kstep, voffA); PG8_STAGE(PG8_SB(1, 1), cB + hstep + kstep, voffB);
    PG8_WAIT_V(6); PG8_BAR;
    for (;;) {
        const bool has_next = S.next(ui + 1, nxt);
        const char* nA = has_next ? (const char*)g.A + (size_t)nxt.pm * tstep : cA;
        const char* nB = has_next ? (const char*)g.Bt + (size_t)nxt.e * estep + (size_t)nxt.pn * tstep : cB;
        for (int t = 0; t < nt; t += 2) {
            const bool last = (t == nt - 2);
            const char* a1 = cA + (size_t)(t + 1) * kstep;
            const char* a2 = last ? nA : cA + (size_t)(t + 2) * kstep; const char* b2 = last ? nB : cB + (size_t)(t + 2) * kstep;
            const char* a3 = a2 + kstep; const char* b3 = b2 + kstep;
            PG8_LDB(B0, 0, 0); PG8_SCHED; PG8_LDA(At, 0, 0); PG8_STAGE(PG8_SA(1, 1), a1 + hstep, voffA);
            PG8_WAIT_L(8); PG8_BAR; PG8_WAIT_L(0); PG8_MMA(0, 0, At, B0); PG8_BAR; PG8_SCHED;
            PG8_LDB(B1, 0, 1); PG8_STAGE(PG8_SB(0, 0), b2, voffB);
            PG8_BAR; PG8_WAIT_L(0); PG8_MMA(0, 1, At, B1); PG8_BAR;
            PG8_LDA(At, 0, 1); PG8_STAGE(PG8_SA(0, 0), a2, voffA);
            PG8_BAR; PG8_WAIT_L(0); PG8_MMA(1, 0, At, B0); PG8_BAR; PG8_SCHED;
            PG8_STAGE(PG8_SB(0, 1), b2 + hstep, voffB);
            PG8_WAIT_V(6); PG8_BAR; PG8_MMA(1, 1, At, B1); PG8_BAR;
            PG8_LDB(B0, 1, 0); PG8_SCHED; PG8_LDA(At, 1, 0); PG8_STAGE(PG8_SA(0, 1), a2 + hstep, voffA);
            PG8_WAIT_L(8); PG8_BAR; PG8_WAIT_L(0); PG8_MMA(0, 0, At, B0); PG8_BAR; PG8_SCHED;
            PG8_LDB(B1, 1, 1); PG8_STAGE(PG8_SB(1, 0), b3, voffB);
            PG8_BAR; PG8_WAIT_L(0); PG8_MMA(0, 1, At, B1); PG8_BAR;
            PG8_LDA(At, 1, 1); PG8_STAGE(PG8_SA(1, 0), a3, voffA);
            PG8_BAR; PG8_WAIT_L(0); PG8_MMA(1, 0, At, B0); PG8_BAR; PG8_SCHED;
            PG8_STAGE(PG8_SB(1, 1), b3 + hstep, voffB);
            PG8_WAIT_V(6); PG8_BAR; PG8_MMA(1, 1, At, B1); PG8_BAR;
        }
        E(acc, cur, wr, wc, fr, fq);
        if (!has_next) break;
#pragma unroll
        for (int a = 0; a < 2; ++a)
#pragma unroll
            for (int b = 0; b < 2; ++b)
#pragma unroll
                for (int m = 0; m < 4; ++m)
#pragma unroll
                    for (int n = 0; n < 2; ++n) acc[a][b][m][n] = (f32x4){0.f, 0.f, 0.f, 0.f};
        cur = nxt; cA = nA; cB = nB; ++ui;
    }
    PG8_WAIT_V(0);
    if (wr == 0) PG8_BAR;
    PG8_BAR;
#undef PG8_SA
#undef PG8_SB
#undef PG8_STAGE
#undef PG8_LDA
#undef PG8_LDB
#undef PG8_MMA
#undef PG8_WAIT_V
#undef PG8_WAIT_L
#undef PG8_BAR
#undef PG8_SCHED
}
}

__device__ __forceinline__ void conv_job(const float* src, int ld, bf16_t* dst, int kt) {
    const int w = threadIdx.x >> 6, lane = threadIdx.x & 63, kseg = lane & 7, nq = lane >> 3;
    const int k0 = kt * 128 + (w >> 2) * 64 + kseg * 8, nl = (w & 3) * 32 + nq * 4;
    f32x4 v[8];
#pragma unroll
    for (int r = 0; r < 8; ++r) v[r] = *(const f32x4*)(src + (size_t)(k0 + r) * ld + nl);
#pragma unroll
    for (int j = 0; j < 4; ++j) { u32x4 o; o.x = cvt_pk_bf16(v[0][j], v[1][j]); o.y = cvt_pk_bf16(v[2][j], v[3][j]); o.z = cvt_pk_bf16(v[4][j], v[5][j]); o.w = cvt_pk_bf16(v[6][j], v[7][j]);
        *(u32x4*)(dst + (size_t)(nl + j) * 2048 + k0) = o; }
}
__device__ __forceinline__ void phase_prologue(const Args& a, LAS unsigned char* lds) {
    const int tid = threadIdx.x, blk = blockIdx.x, G = gridDim.x;
    if (blk < 192) {
        LAS float* cact = (LAS float*)lds; LAS float* red = (LAS float*)(lds + 16384);
        for (int i = tid; i < 4096; i += 512) cact[i] = silu_f(a.c[i]);
        __syncthreads();
        float* mod = (float*)(a.ws + WS_MOD);
        for (int cb = blk; cb < 192; cb += G) {
            const int rg = tid >> 4, cl = tid & 15;
            const float* wp = a.w_ada + (size_t)cb * 64 + cl * 4;
            f32x4 a0 = {0.f, 0.f, 0.f, 0.f}, a1 = {0.f, 0.f, 0.f, 0.f};
#pragma unroll 8
            for (int i = 0; i < 64; ++i) { const int k = rg + 32 * i; const f32x4 w = *(const f32x4*)(wp + (size_t)k * 12288); a0 += w * cact[k]; a1 += w * cact[2048 + k]; }
#pragma unroll
            for (int j = 0; j < 4; ++j) { red[(rg * 2 + 0) * 64 + cl * 4 + j] = a0[j]; red[(rg * 2 + 1) * 64 + cl * 4 + j] = a1[j]; }
            __syncthreads();
            if (tid < 128) { const int b = tid >> 6, col = tid & 63; float s = 0.f; for (int r = 0; r < 32; ++r) s += red[(r * 2 + b) * 64 + col]; mod[b * 12288 + cb * 64 + col] = s + a.b_ada[cb * 64 + col]; }
            __syncthreads();
        }
    }
    {
        float* ct = (float*)(a.ws + WS_ROPE); float* st = ct + 4096 * 64;
        for (int idx = blk * 512 + tid; idx < 4096 * 64; idx += G * 512) {
            const int t = idx >> 6, i = idx & 63;
            const float inv = (float)exp2(-(double)i * (13.287712379549449 / 64.0));
            const float ang = (float)t * inv;
            const double ad = (double)ang, n = rint(ad * 0.15915494309189535), r = fma(-n, 6.283185307179586, ad) - n * 2.4492935982947064e-16;
            const float rf = (float)r;
            ct[idx] = cosf(rf); st[idx] = sinf(rf);
        }
    }
    {
        bf16_t* win_t = (bf16_t*)(a.ws + WS_WIN_T); bf16_t* wout_t = (bf16_t*)(a.ws + WS_WOUT_T); bf16_t* wgu_t = (bf16_t*)(a.ws + WS_WGU_T); bf16_t* wd_t = (bf16_t*)(a.ws + WS_WD_T);
        for (int job = blk; job < 1600 * 16; job += G) {
            const int rt = job >> 4, kt = job & 15;
            const float* src; int ld; bf16_t* dst;
            if (rt < 48) { const int n0 = rt * 128, col0 = n0 < 3072 ? n0 : n0 + 16; src = a.w_in + col0; ld = DIN; dst = win_t + (size_t)n0 * 2048; }
            else if (rt < 64) { const int n0 = (rt - 48) * 128; src = a.w_out + n0; ld = 2048; dst = wout_t + (size_t)n0 * 2048; }
            else if (rt < 1088) { const int idx = rt - 64, e = idx >> 5, r = idx & 31, pn = r >> 1, bj = r & 1; src = a.w_gate_up + (size_t)e * 2048 * 4096 + bj * 2048 + pn * 128; ld = 4096; dst = wgu_t + ((size_t)e * 4096 + r * 128) * 2048; }
            else { const int idx = rt - 1088, e = idx >> 4, n0 = (idx & 15) * 128; src = a.w_down + (size_t)e * 2048 * 2048 + n0; ld = 2048; dst = wd_t + ((size_t)e * 2048 + n0) * 2048; }
            conv_job(src, ld, dst, kt);
        }
    }
}

__device__ __forceinline__ void phase_norm1(const Args& a, LAS unsigned char* lds) {
    const int tid = threadIdx.x, blk = blockIdx.x, G = gridDim.x, w = tid >> 6, lane = tid & 63;
    LAS float* wlaT = (LAS float*)lds;
    for (int idx = tid; idx < 2048 * 16; idx += 512) { const int k = idx >> 4, j = idx & 15; wlaT[j * 2048 + k] = a.w_in[(size_t)k * DIN + 3072 + j]; }
    __syncthreads();
    const float* mod = (const float*)(a.ws + WS_MOD);
    bf16_t* h1 = (bf16_t*)(a.ws + WS_H1); float* gk = (float*)(a.ws + WS_GK);
    for (int r = blk * 8 + w; r < NTOK; r += G * 8) {
        const f32x4* xr = (const f32x4*)(a.x + (size_t)r * DM) + lane;
        f32x4 v[8]; float ss = 0.f;
#pragma unroll
        for (int q = 0; q < 8; ++q) { v[q] = xr[64 * q]; ss += (v[q][0] * v[q][0] + v[q][1] * v[q][1]) + (v[q][2] * v[q][2] + v[q][3] * v[q][3]); }
        ss = wave_sum(ss);
        const float rstd = 1.0f / sqrtf(ss * (1.0f / DM) + EPS);
        const float* sh = mod + (size_t)(r >> 12) * 12288; const float* sc = sh + 2048;
#pragma unroll
        for (int q = 0; q < 8; ++q) { const int k = 4 * (lane + 64 * q);
            const f32x4 nw = *(const f32x4*)(a.norm1_w + k), scv = *(const f32x4*)(sc + k), shv = *(const f32x4*)(sh + k);
            v[q] = (v[q] * rstd * nw) * (scv + 1.0f) + shv;
            u32x2 o; o.x = cvt_pk_bf16(v[q][0], v[q][1]); o.y = cvt_pk_bf16(v[q][2], v[q][3]);
            *(u32x2*)(h1 + (size_t)r * DM + k) = o; }
        LAS float* las = (LAS float*)(lds + LDS_EXTRA) + w * 16;
#pragma unroll 1
        for (int j = 0; j < 16; ++j) { float s = 0.f;
#pragma unroll
            for (int q = 0; q < 8; ++q) { const f32x4 wl = *(const LAS f32x4*)(wlaT + j * 2048 + 4 * (lane + 64 * q)); s += (v[q][0] * wl[0] + v[q][1] * wl[1]) + (v[q][2] * wl[2] + v[q][3] * wl[3]); }
            s = wave_sum(s); if (lane == 0) las[j] = s; }
        asm volatile("s_waitcnt lgkmcnt(0)" ::: "memory");
#pragma unroll 1
        for (int m = 0; m < 8; ++m) { const int d = lane + 64 * m; float z = a.b_alpha[d];
#pragma unroll
            for (int j = 0; j < 16; ++j) z += las[j] * a.w_alpha2[j * 512 + d];
            const float ls = fminf(z, 0.f) - log1pf(expf(-fabsf(z)));
            gk[(size_t)r * 512 + d] = ls * (1.0f / 16.0f); }
        asm volatile("s_waitcnt lgkmcnt(0)" ::: "memory");
    }
}

__device__ __forceinline__ void gla_stage_vt(const bf16_t* proj, int row0, int h, LAS bf16_t* VT, int tid) {
    const int i = tid >> 3, seg = tid & 7;
    const u32x4* vp = (const u32x4*)(proj + (size_t)(row0 + i) * NPROJ + C_VA + h * 256 + seg * 32);
#pragma unroll
    for (int c4 = 0; c4 < 4; ++c4) { const u32x4 vv = vp[c4];
#pragma unroll
        for (int p = 0; p < 4; ++p) { const unsigned wd = vv[p]; const int e = seg * 32 + c4 * 8 + p * 2;
            VT[e * 72 + i] = (bf16_t)(wd & 0xffffu); VT[(e + 1) * 72 + i] = (bf16_t)(wd >> 16); } }
}
__device__ __forceinline__ void gla1_unit(const Args& a, LAS unsigned char* lds, int u) {
    const int tid = threadIdx.x, w = tid >> 6, lane = tid & 63;
    const int bh = u >> 6, c = u & 63, b = bh >> 2, h = bh & 3, row0 = b * SEQ + c * 64;
    LAS float* Bm = (LAS float*)lds; LAS bf16_t* KT = (LAS bf16_t*)(lds + 32768); LAS bf16_t* VT = (LAS bf16_t*)(lds + 51200);
    const float* gk = (const float*)(a.ws + WS_GK); const bf16_t* proj = (const bf16_t*)(a.ws + WS_PROJ);
    float* bcum = (float*)(a.ws + WS_BCUM); float* dst = (float*)(a.ws + WS_DST); float* dec = (float*)(a.ws + WS_DEC);
    const int i = tid >> 3, seg = tid & 7;
    {
        const f32x4* gp = (const f32x4*)(gk + (size_t)(row0 + i) * 512 + h * 128 + seg * 16);
#pragma unroll
        for (int q = 0; q < 4; ++q) *(LAS f32x4*)(Bm + i * 128 + seg * 16 + q * 4) = gp[q];
    }
    __syncthreads();
    if (tid < 128) { float run = 0.f; for (int ii = 0; ii < 64; ++ii) { run += Bm[ii * 128 + tid]; Bm[ii * 128 + tid] = run; } }
    __syncthreads();
    {
        const u32x4* kp = (const u32x4*)(proj + (size_t)(row0 + i) * NPROJ + C_KA + h * 128 + seg * 16);
        float* bo = bcum + ((size_t)u * 64 + i) * 128 + seg * 16;
#pragma unroll
        for (int q = 0; q < 2; ++q) { const u32x4 kv = kp[q];
#pragma unroll
            for (int p = 0; p < 4; ++p) { const int d = seg * 16 + q * 8 + p * 2;
                const float b0 = Bm[i * 128 + d], b1 = Bm[i * 128 + d + 1], l0 = Bm[63 * 128 + d], l1 = Bm[63 * 128 + d + 1];
                bo[q * 8 + p * 2] = b0; bo[q * 8 + p * 2 + 1] = b1;
                KT[d * 72 + i] = f2bf(bflo(kv[p]) * expf(l0 - b0)); KT[(d + 1) * 72 + i] = f2bf(bfhi(kv[p]) * expf(l1 - b1));
                if (i == 63) { dec[(size_t)u * 128 + d] = expf(l0); dec[(size_t)u * 128 + d + 1] = expf(l1); } } }
        gla_stage_vt(proj, row0, h, VT, tid);
    }
    __syncthreads();
    {
        f32x4 acc[2][8];
#pragma unroll
        for (int x = 0; x < 2; ++x)
#pragma unroll
            for (int y = 0; y < 8; ++y) acc[x][y] = (f32x4){0.f, 0.f, 0.f, 0.f};
#pragma unroll
        for (int ks = 0; ks < 2; ++ks) {
            const bf16x8 a0 = lds_frag(VT, 72, (2 * w) * 16, ks * 32, lane), a1 = lds_frag(VT, 72, (2 * w + 1) * 16, ks * 32, lane);
#pragma unroll
            for (int dt = 0; dt < 8; ++dt) { const bf16x8 bf = lds_frag(KT, 72, dt * 16, ks * 32, lane); acc[0][dt] = mfma16(a0, bf, acc[0][dt]); acc[1][dt] = mfma16(a1, bf, acc[1][dt]); }
        }
        float* dp = dst + (size_t)u * 32768;
#pragma unroll
        for (int x = 0; x < 2; ++x)
#pragma unroll
            for (int dt = 0; dt < 8; ++dt)
#pragma unroll
                for (int r = 0; r < 4; ++r) dp[((2 * w + x) * 16 + 4 * (lane >> 4) + r) * 128 + dt * 16 + (lane & 15)] = acc[x][dt][r];
    }
    __syncthreads();
}
__device__ __forceinline__ void moba_prep_unit(const Args& a, LAS unsigned char* lds, int u2) {
    const int tid = threadIdx.x;
    const int bh = u2 >> 4, kb = u2 & 15, b = bh >> 3, h = bh & 7, row0 = b * SEQ + kb * 256, t0 = kb * 256;
    const bf16_t* proj = (const bf16_t*)(a.ws + WS_PROJ);
    const float* ct = (const float*)(a.ws + WS_ROPE); const float* st = ct + 4096 * 64;
    bf16_t* qbr = (bf16_t*)(a.ws + WS_QBR); bf16_t* kbr = (bf16_t*)(a.ws + WS_KBR); bf16_t* vbt = (bf16_t*)(a.ws + WS_VBT); float* kmean = (float*)(a.ws + WS_KMEAN);
    LAS float* Kf = (LAS float*)lds; LAS float* part = (LAS float*)(lds + LDS_EXTRA);
    const int row = tid >> 1, half = tid & 1;
    const float* cp = ct + (size_t)(t0 + row) * 64 + half * 32; const float* sp = st + (size_t)(t0 + row) * 64 + half * 32;
#pragma unroll 1
    for (int which = 0; which < 2; ++which) {
        const bf16_t* src = proj + (size_t)(row0 + row) * NPROJ + (which == 0 ? C_KB : C_QB) + h * 128 + half * 32;
        bf16_t* dsto = (which == 0 ? kbr : qbr) + ((size_t)bh * SEQ + t0 + row) * 128 + half * 32;
#pragma unroll
        for (int c4 = 0; c4 < 4; ++c4) {
            const u32x4 x1 = *(const u32x4*)(src + c4 * 8), x2 = *(const u32x4*)(src + 64 + c4 * 8);
            u32x4 o1, o2;
#pragma unroll
            for (int p = 0; p < 4; ++p) { const int ii = c4 * 8 + p * 2;
                const float c0 = cp[ii], c1 = cp[ii + 1], s0 = sp[ii], s1 = sp[ii + 1];
                const float a0 = bflo(x1[p]), a1 = bfhi(x1[p]), b0 = bflo(x2[p]), b1 = bfhi(x2[p]);
                const float r10 = a0 * c0 - b0 * s0, r11 = a1 * c1 - b1 * s1, r20 = a0 * s0 + b0 * c0, r21 = a1 * s1 + b1 * c1;
                o1[p] = cvt_pk_bf16(r10, r11); o2[p] = cvt_pk_bf16(r20, r21);
                if (which == 0) { Kf[row * 128 + half * 32 + ii] = r10; Kf[row * 128 + half * 32 + ii + 1] = r11; Kf[row * 128 + 64 + half * 32 + ii] = r20; Kf[row * 128 + 64 + half * 32 + ii + 1] = r21; } }
            *(u32x4*)(dsto + c4 * 8) = o1; *(u32x4*)(dsto + 64 + c4 * 8) = o2;
        }
        if (which == 0) {
            __syncthreads();
            { const int d = tid & 127, rq = tid >> 7; float s = 0.f; for (int rr = 0; rr < 64; ++rr) s += Kf[(rq * 64 + rr) * 128 + d]; part[rq * 128 + d] = s; }
            __syncthreads();
            if (tid < 128) kmean[((size_t)bh * 16 + kb) * 128 + tid] = (part[tid] + part[128 + tid] + part[256 + tid] + part[384 + tid]) * (1.0f / 256.0f);
        }
    }
    __syncthreads();
    LAS bf16_t* Vl = (LAS bf16_t*)lds;
    {
        const u32x4* vp = (const u32x4*)(proj + (size_t)(row0 + row) * NPROJ + C_VB + h * 128 + half * 64);
#pragma unroll
        for (int c8 = 0; c8 < 8; ++c8) { const u32x4 vv = vp[c8]; LAS unsigned* dp = (LAS unsigned*)(Vl + row * 130 + half * 64 + c8 * 8); dp[0] = vv[0]; dp[1] = vv[1]; dp[2] = vv[2]; dp[3] = vv[3]; }
    }
    __syncthreads();
    {
        const int d = tid >> 2, ts = tid & 3;
        bf16_t* op = vbt + ((size_t)bh * 128 + d) * SEQ + t0 + ts * 64;
#pragma unroll
        for (int c8 = 0; c8 < 8; ++c8) { u32x4 o;
#pragma unroll
            for (int p = 0; p < 4; ++p) { const int tt = ts * 64 + c8 * 8 + p * 2; o[p] = (unsigned)Vl[tt * 130 + d] | ((unsigned)Vl[(tt + 1) * 130 + d] << 16); }
            *(u32x4*)(op + c8 * 8) = o; }
    }
    __syncthreads();
}
__device__ __forceinline__ void phase_mix_prep(const Args& a, LAS unsigned char* lds) {
    const int blk = blockIdx.x, G = gridDim.x;
    for (int u = blk; u < 512; u += G) gla1_unit(a, lds, u);
    for (int u2 = blk; u2 < 256; u2 += G) moba_prep_unit(a, lds, u2);
}

__device__ __forceinline__ void phase_scan_select(const Args& a, LAS unsigned char* lds) {
    const int tid = threadIdx.x, blk = blockIdx.x, G = gridDim.x;
    {
        const float* dst = (const float*)(a.ws + WS_DST); const float* dec = (const float*)(a.ws + WS_DEC); bf16_t* ST = (bf16_t*)(a.ws + WS_ST);
        for (int el = blk * 512 + tid; el < 8 * 32768; el += G * 512) {
            const int bh = el >> 15, ed = el & 32767, d = ed & 127; float cur = 0.f;
#pragma unroll 8
            for (int c = 0; c < 64; ++c) { const size_t u = (size_t)bh * 64 + c; ST[u * 32768 + ed] = f2bf(cur); cur = dec[u * 128 + d] * cur + dst[u * 32768 + ed]; }
        }
    }
    {
        const float* kmean = (const float*)(a.ws + WS_KMEAN); const bf16_t* qbr = (const bf16_t*)(a.ws + WS_QBR); unsigned* sel = (unsigned*)(a.ws + WS_SEL);
        LAS float* km = (LAS float*)lds;
        for (int u2 = blk; u2 < 256; u2 += G) {
            const int bh = u2 >> 4, qb = u2 & 15;
            __syncthreads();
            for (int i = tid; i < 2048; i += 512) km[i] = kmean[(size_t)bh * 2048 + i];
            __syncthreads();
            const int q = tid >> 1, half = tid & 1;
            float gv[8];
#pragma unroll
            for (int n = 0; n < 8; ++n) gv[n] = 0.f;
            const u32x4* qp = (const u32x4*)(qbr + ((size_t)bh * SEQ + qb * 256 + q) * 128);
#pragma unroll 4
            for (int c = 0; c < 16; ++c) { const u32x4 qq = qp[c]; float qf[8];
#pragma unroll
                for (int p = 0; p < 4; ++p) { qf[2 * p] = bflo(qq[p]); qf[2 * p + 1] = bfhi(qq[p]); }
#pragma unroll
                for (int n = 0; n < 8; ++n) { const LAS float* kr = km + (half * 8 + n) * 128 + c * 8; const f32x4 k0 = *(const LAS f32x4*)kr, k1 = *(const LAS f32x4*)(kr + 4);
                    gv[n] += (qf[0] * k0[0] + qf[1] * k0[1]) + (qf[2] * k0[2] + qf[3] * k0[3]) + (qf[4] * k1[0] + qf[5] * k1[1]) + (qf[6] * k1[2] + qf[7] * k1[3]); } }
            float ga[16];
#pragma unroll
            for (int n = 0; n < 8; ++n) { const float o = __shfl_xor(gv[n], 1); ga[n] = half ? o : gv[n]; ga[8 + n] = half ? gv[n] : o; }
            unsigned mask = 0u; const int nsel = qb < 3 ? qb : 3;
            for (int s = 0; s < nsel; ++s) { int best = -1; float bv = -INFINITY;
#pragma unroll
                for (int n = 0; n < 16; ++n) { const bool ok = (n < qb) && !((mask >> n) & 1u) && (best < 0 || ga[n] > bv); if (ok) { bv = ga[n]; best = n; } }
                mask |= 1u << best; }
            if (half == 0) sel[(size_t)bh * SEQ + qb * 256 + q] = mask;
        }
        __syncthreads();
    }
}

__device__ __forceinline__ void gla3_unit(const Args& a, LAS unsigned char* lds, int u) {
    const int tid = threadIdx.x, w = tid >> 6, lane = tid & 63, g = lane >> 4, fr = lane & 15;
    const int bh = u >> 6, c = u & 63, b = bh >> 2, h = bh & 3, row0 = b * SEQ + c * 64;
    LAS bf16_t* QP = (LAS bf16_t*)lds; LAS bf16_t* KP = (LAS bf16_t*)(lds + 17408); LAS bf16_t* VT = (LAS bf16_t*)(lds + 34816);
    LAS bf16_t* AM = (LAS bf16_t*)(lds + 71680); LAS float* RED = (LAS float*)(lds + 80896);
    const bf16_t* proj = (const bf16_t*)(a.ws + WS_PROJ); const float* bcum = (const float*)(a.ws + WS_BCUM); const bf16_t* ST = (const bf16_t*)(a.ws + WS_ST);
    bf16_t* ocat = (bf16_t*)(a.ws + WS_OCAT);
    {
        const int i = tid >> 3, seg = tid & 7;
        const f32x4* bp = (const f32x4*)(bcum + ((size_t)u * 64 + i) * 128 + seg * 16);
        const u32x4* qp = (const u32x4*)(proj + (size_t)(row0 + i) * NPROJ + C_QA + h * 128 + seg * 16);
        const u32x4* kp = (const u32x4*)(proj + (size_t)(row0 + i) * NPROJ + C_KA + h * 128 + seg * 16);
#pragma unroll
        for (int q = 0; q < 2; ++q) { const u32x4 qv = qp[q], kv = kp[q]; const f32x4 b0 = bp[2 * q], b1 = bp[2 * q + 1]; u32x4 qo, ko;
#pragma unroll
            for (int p = 0; p < 4; ++p) { const float bl = (p < 2) ? b0[2 * p] : b1[2 * p - 4], bhv = (p < 2) ? b0[2 * p + 1] : b1[2 * p - 3];
                const float el = expf(bl), eh = expf(bhv);
                qo[p] = cvt_pk_bf16(bflo(qv[p]) * el * 0.08838834764831845f, bfhi(qv[p]) * eh * 0.08838834764831845f);
                ko[p] = cvt_pk_bf16(bflo(kv[p]) / el, bfhi(kv[p]) / eh); }
            *(LAS u32x4*)(QP + i * 136 + seg * 16 + q * 8) = qo; *(LAS u32x4*)(KP + i * 136 + seg * 16 + q * 8) = ko; }
        gla_stage_vt(proj, row0, h, VT, tid);
    }
    __syncthreads();
    {
        const int it = w >> 1;
#pragma unroll
        for (int jj = 0; jj < 2; ++jj) { const int jt = (w & 1) * 2 + jj; f32x4 acc = {0.f, 0.f, 0.f, 0.f};
            if (jt <= it) {
#pragma unroll
                for (int ks = 0; ks < 4; ++ks) acc = mfma16(lds_frag(QP, 136, it * 16, ks * 32, lane), lds_frag(KP, 136, jt * 16, ks * 32, lane), acc);
            }
#pragma unroll
            for (int r = 0; r < 4; ++r) { const int i = it * 16 + 4 * g + r, j = jt * 16 + fr; AM[i * 72 + j] = f2bf((j <= i) ? acc[r] : 0.f); } }
    }
    __syncthreads();
    f32x4 acc[4][2];
    {
#pragma unroll
        for (int x = 0; x < 4; ++x)
#pragma unroll
            for (int y = 0; y < 2; ++y) acc[x][y] = (f32x4){0.f, 0.f, 0.f, 0.f};
        bf16x8 bS[2][4];
        const bf16_t* stp = ST + (size_t)u * 32768;
#pragma unroll
        for (int e2 = 0; e2 < 2; ++e2)
#pragma unroll
            for (int ks = 0; ks < 4; ++ks) bS[e2][ks] = *(const bf16x8*)(stp + ((2 * w + e2) * 16 + fr) * 128 + ks * 32 + 8 * g);
#pragma unroll
        for (int it = 0; it < 4; ++it) {
#pragma unroll
            for (int ks = 0; ks < 4; ++ks) { const bf16x8 aq = lds_frag(QP, 136, it * 16, ks * 32, lane); acc[it][0] = mfma16(aq, bS[0][ks], acc[it][0]); acc[it][1] = mfma16(aq, bS[1][ks], acc[it][1]); }
#pragma unroll
            for (int k2 = 0; k2 < 2; ++k2) { const bf16x8 aa = lds_frag(AM, 72, it * 16, k2 * 32, lane);
                acc[it][0] = mfma16(aa, lds_frag(VT, 72, (2 * w) * 16, k2 * 32, lane), acc[it][0]); acc[it][1] = mfma16(aa, lds_frag(VT, 72, (2 * w + 1) * 16, k2 * 32, lane), acc[it][1]); }
        }
#pragma unroll
        for (int it = 0; it < 4; ++it)
#pragma unroll
            for (int r = 0; r < 4; ++r) { float s = acc[it][0][r] * acc[it][0][r] + acc[it][1][r] * acc[it][1][r];
                s += __shfl_xor(s, 1); s += __shfl_xor(s, 2); s += __shfl_xor(s, 4); s += __shfl_xor(s, 8);
                if (fr == 0) RED[w * 64 + it * 16 + 4 * g + r] = s; }
    }
    __syncthreads();
    {
#pragma unroll
        for (int it = 0; it < 4; ++it)
#pragma unroll
            for (int r = 0; r < 4; ++r) { const int i = it * 16 + 4 * g + r; float tot = 0.f;
#pragma unroll
                for (int ww = 0; ww < 8; ++ww) tot += RED[ww * 64 + i];
                const float rstd = 1.0f / sqrtf(tot * (1.0f / 256.0f) + EPS);
#pragma unroll
                for (int e2 = 0; e2 < 2; ++e2) { const int e = (2 * w + e2) * 16 + fr;
                    const float ga = bf2f(proj[(size_t)(row0 + i) * NPROJ + C_GA + h * 256 + e]);
                    ocat[(size_t)(row0 + i) * DM + h * 256 + e] = f2bf(acc[it][e2][r] * rstd * a.gla_norm_w[e] * silu_f(ga)); } }
    }
    __syncthreads();
}

__device__ __forceinline__ void moba_attn_unit(const Args& a, LAS unsigned char* lds, int bh, int qb) {
    const int tid = threadIdx.x, w = tid >> 6, lane = tid & 63, g = lane >> 4, fr = lane & 15;
    const int b = bh >> 3, h = bh & 7, q0 = 32 * w;
    LAS bf16_t* Ks = (LAS bf16_t*)lds; LAS bf16_t* Vs = (LAS bf16_t*)(lds + 17408);
    const bf16_t* qbr = (const bf16_t*)(a.ws + WS_QBR); const bf16_t* kbr = (const bf16_t*)(a.ws + WS_KBR); const bf16_t* vbt = (const bf16_t*)(a.ws + WS_VBT);
    const unsigned* sel = (const unsigned*)(a.ws + WS_SEL); bf16_t* ocat = (bf16_t*)(a.ws + WS_OCAT);
    bf16x8 qf[2][4]; unsigned sm[2]; float m[2], l[2]; f32x4 O[8][2];
#pragma unroll
    for (int b2 = 0; b2 < 2; ++b2) { const size_t qrow = (size_t)bh * SEQ + qb * 256 + q0 + 16 * b2 + fr;
#pragma unroll
        for (int ks = 0; ks < 4; ++ks) qf[b2][ks] = *(const bf16x8*)(qbr + qrow * 128 + ks * 32 + 8 * g);
        sm[b2] = sel[qrow]; m[b2] = -INFINITY; l[b2] = 0.f;
#pragma unroll
        for (int dt = 0; dt < 8; ++dt) O[dt][b2] = (f32x4){0.f, 0.f, 0.f, 0.f}; }
    const float cs = 0.08838834764831845f * 1.4426950408889634f;
#pragma unroll 1
    for (int jj = 0; jj <= qb; ++jj) {
        const int j = (jj == 0) ? qb : jj - 1; const bool own = (jj == 0);
#pragma unroll 1
        for (int kt = 0; kt < 4; ++kt) {
            __syncthreads();
#pragma unroll
            for (int p = 0; p < 2; ++p) { const int cidx = tid + 512 * p;
                { const int row = cidx >> 4, cc = cidx & 15; *(LAS u32x4*)(Ks + row * 136 + cc * 8) = *(const u32x4*)(kbr + ((size_t)bh * SEQ + j * 256 + kt * 64 + row) * 128 + cc * 8); }
                { const int d = cidx >> 3, cc = cidx & 7; *(LAS u32x4*)(Vs + d * 72 + cc * 8) = *(const u32x4*)(vbt + ((size_t)bh * 128 + d) * SEQ + j * 256 + kt * 64 + cc * 8); } }
            __syncthreads();
            if (own && kt * 64 > q0 + 31) continue;
            f32x4 s[4][2];
#pragma unroll
            for (int t4 = 0; t4 < 4; ++t4) { s[t4][0] = (f32x4){0.f, 0.f, 0.f, 0.f}; s[t4][1] = (f32x4){0.f, 0.f, 0.f, 0.f};
#pragma unroll
                for (int ks = 0; ks < 4; ++ks) { const bf16x8 kf = lds_frag(Ks, 136, t4 * 16, ks * 32, lane); s[t4][0] = mfma16(kf, qf[0][ks], s[t4][0]); s[t4][1] = mfma16(kf, qf[1][ks], s[t4][1]); } }
            bf16x8 pf[2][2];
#pragma unroll
            for (int b2 = 0; b2 < 2; ++b2) {
                const int qi = q0 + 16 * b2 + fr; const bool allow_past = ((sm[b2] >> j) & 1u) != 0u;
                float tm = -INFINITY;
#pragma unroll
                for (int t4 = 0; t4 < 4; ++t4)
#pragma unroll
                    for (int r = 0; r < 4; ++r) { const int kk = kt * 64 + t4 * 16 + 4 * g + r; const bool ok = own ? (kk <= qi) : allow_past;
                        const float v = ok ? s[t4][b2][r] : -INFINITY; s[t4][b2][r] = v; tm = fmaxf(tm, v); }
                tm = fmaxf(tm, __shfl_xor(tm, 16)); tm = fmaxf(tm, __shfl_xor(tm, 32));
                const float mnew = fmaxf(m[b2], tm), msafe = (mnew == -INFINITY) ? 0.f : mnew;
                const float alpha = exp2f((m[b2] - msafe) * cs);
                float ps = 0.f;
#pragma unroll
                for (int t4 = 0; t4 < 4; ++t4)
#pragma unroll
                    for (int r = 0; r < 4; ++r) { const float p = exp2f((s[t4][b2][r] - msafe) * cs); s[t4][b2][r] = p; ps += p; }
                ps += __shfl_xor(ps, 16); ps += __shfl_xor(ps, 32);
                l[b2] = l[b2] * alpha + ps; m[b2] = mnew;
#pragma unroll
                for (int dt = 0; dt < 8; ++dt) O[dt][b2] *= alpha;
#pragma unroll
                for (int k2 = 0; k2 < 2; ++k2) { u32x4 pk; pk.x = cvt_pk_bf16(s[2 * k2][b2][0], s[2 * k2][b2][1]); pk.y = cvt_pk_bf16(s[2 * k2][b2][2], s[2 * k2][b2][3]);
                    pk.z = cvt_pk_bf16(s[2 * k2 + 1][b2][0], s[2 * k2 + 1][b2][1]); pk.w = cvt_pk_bf16(s[2 * k2 + 1][b2][2], s[2 * k2 + 1][b2][3]);
                    pf[k2][b2] = __builtin_bit_cast(bf16x8, pk); }
            }
#pragma unroll
            for (int dt = 0; dt < 8; ++dt)
#pragma unroll
                for (int k2 = 0; k2 < 2; ++k2) { const LAS bf16_t* vp = Vs + (dt * 16 + fr) * 72 + 32 * k2 + 4 * g;
                    const u32x2 lo = *(const LAS u32x2*)vp, hi = *(const LAS u32x2*)(vp + 16);
                    u32x4 vv; vv.x = lo.x; vv.y = lo.y; vv.z = hi.x; vv.w = hi.y; const bf16x8 vf = __builtin_bit_cast(bf16x8, vv);
                    O[dt][0] = mfma16(vf, pf[k2][0], O[dt][0]); O[dt][1] = mfma16(vf, pf[k2][1], O[dt][1]); }
        }
    }
#pragma unroll
    for (int b2 = 0; b2 < 2; ++b2) { const float inv = 1.0f / l[b2]; const size_t orow = (size_t)(b * SEQ + qb * 256 + q0 + 16 * b2 + fr) * DM + 1024 + h * 128;
#pragma unroll
        for (int dt = 0; dt < 8; ++dt) { u32x2 o; o.x = cvt_pk_bf16(O[dt][b2][0] * inv, O[dt][b2][1] * inv); o.y = cvt_pk_bf16(O[dt][b2][2] * inv, O[dt][b2][3] * inv);
            *(u32x2*)(ocat + orow + dt * 16 + 4 * g) = o; } }
    __syncthreads();
}
__device__ __forceinline__ void phase_mix_out(const Args& a, LAS unsigned char* lds) {
    const int blk = blockIdx.x, G = gridDim.x;
    for (int ua = blk; ua < 256; ua += G) moba_attn_unit(a, lds, ua & 15, 15 - (ua >> 4));
    for (int u = blk; u < 512; u += G) gla3_unit(a, lds, u);
}

__device__ __forceinline__ void phase_router(const Args& a, LAS unsigned char* lds) {
    const int tid = threadIdx.x, blk = blockIdx.x, G = gridDim.x, w = tid >> 6, lane = tid & 63;
    LAS float* h2s = (LAS float*)lds;
    LAS float* logit = (LAS float*)(lds + LDS_EXTRA);
    LAS int* pe = (LAS int*)(lds + LDS_EXTRA + 2048); LAS float* pw = (LAS float*)(lds + LDS_EXTRA + 2304); LAS int* lpos = (LAS int*)(lds + LDS_EXTRA + 2560);
    LAS int* hist = (LAS int*)(lds + LDS_EXTRA + 2816); LAS int* base = (LAS int*)(lds + LDS_EXTRA + 2944);
    const float* mod = (const float*)(a.ws + WS_MOD); const float* x1 = (const float*)(a.ws + WS_X1); bf16_t* h2 = (bf16_t*)(a.ws + WS_H1);
    unsigned* cnt = (unsigned*)(a.ws + WS_CNT); int* pair_e = (int*)(a.ws + WS_PAIR_E); int* pair_pos = (int*)(a.ws + WS_PAIR_POS); float* pair_w = (float*)(a.ws + WS_PAIR_W);
    for (int grp = blk; grp < 512; grp += G) {
#pragma unroll 1
        for (int tt = 0; tt < 2; ++tt) { const int tl = 2 * w + tt, t = grp * 16 + tl;
            const f32x4* xr = (const f32x4*)(x1 + (size_t)t * DM) + lane;
            f32x4 v[8]; float ss = 0.f;
#pragma unroll
            for (int q = 0; q < 8; ++q) { v[q] = xr[64 * q]; ss += (v[q][0] * v[q][0] + v[q][1] * v[q][1]) + (v[q][2] * v[q][2] + v[q][3] * v[q][3]); }
            ss = wave_sum(ss);
            const float rstd = 1.0f / sqrtf(ss * (1.0f / DM) + EPS);
            const float* sh = mod + (size_t)(t >> 12) * 12288 + 6144; const float* sc = sh + 2048;
#pragma unroll
            for (int q = 0; q < 8; ++q) { const int k = 4 * (lane + 64 * q);
                const f32x4 nw = *(const f32x4*)(a.norm2_w + k), scv = *(const f32x4*)(sc + k), shv = *(const f32x4*)(sh + k);
                const f32x4 hv = (v[q] * rstd * nw) * (scv + 1.0f) + shv;
                *(LAS f32x4*)(h2s + tl * 2048 + k) = hv;
                u32x2 o; o.x = cvt_pk_bf16(hv[0], hv[1]); o.y = cvt_pk_bf16(hv[2], hv[3]);
                *(u32x2*)(h2 + (size_t)t * DM + k) = o; } }
        if (tid < 32) hist[tid] = 0;
        __syncthreads();
        { const int tl = tid >> 5, e = tid & 31; float acc = a.b_router[e]; const float* wp = a.w_router + e;
#pragma unroll 4
            for (int k = 0; k < 2048; k += 4) { const f32x4 hv = *(const LAS f32x4*)(h2s + tl * 2048 + k);
                acc += hv[0] * wp[(size_t)k * 32]; acc += hv[1] * wp[(size_t)(k + 1) * 32]; acc += hv[2] * wp[(size_t)(k + 2) * 32]; acc += hv[3] * wp[(size_t)(k + 3) * 32]; }
            logit[tl * 32 + e] = acc; }
        __syncthreads();
        if (tid < 16) { unsigned chosen = 0u; float tv[4]; int te[4];
#pragma unroll
            for (int s = 0; s < 4; ++s) { int best = -1; float bv = -INFINITY;
                for (int e = 0; e < 32; ++e) { const float v = logit[tid * 32 + e]; if (!((chosen >> e) & 1u) && (best < 0 || v > bv)) { bv = v; best = e; } }
                chosen |= 1u << best; tv[s] = bv; te[s] = best; }
            float ex[4], den = 0.f;
#pragma unroll
            for (int s = 0; s < 4; ++s) { ex[s] = expf(tv[s] - tv[0]); den += ex[s]; }
#pragma unroll
            for (int s = 0; s < 4; ++s) { pe[tid * 4 + s] = te[s]; pw[tid * 4 + s] = ex[s] / den; } }
        __syncthreads();
        if (tid < 64) lpos[tid] = atomicAdd((int*)&hist[pe[tid]], 1);
        __syncthreads();
        if (tid < 32) { const int n = hist[tid]; base[tid] = n ? (int)atomicAdd(&cnt[tid], (unsigned)n) : 0; }
        __syncthreads();
        if (tid < 64) { const int p = grp * 64 + tid, e = pe[tid]; pair_e[p] = e; pair_pos[p] = base[e] + lpos[tid]; pair_w[p] = pw[tid]; }
        __syncthreads();
    }
}
__device__ __forceinline__ void phase_gather(const Args& a, LAS unsigned char* lds) {
    const int tid = threadIdx.x, blk = blockIdx.x, G = gridDim.x, w = tid >> 6, lane = tid & 63;
    LAS int* pstart = (LAS int*)(lds + LDS_EXTRA);
    const unsigned* cnt = (const unsigned*)(a.ws + WS_CNT);
    if (tid == 0) { int run = 0; for (int e = 0; e < 32; ++e) { pstart[e] = run; run += (int)((cnt[e] + 255u) & ~255u); } }
    __syncthreads();
    const int* pair_e = (const int*)(a.ws + WS_PAIR_E); const int* pair_pos = (const int*)(a.ws + WS_PAIR_POS); const float* pair_w = (const float*)(a.ws + WS_PAIR_W);
    int* slotrow = (int*)(a.ws + WS_SLOTROW); float* wbuf = (float*)(a.ws + WS_WBUF); const bf16_t* h2 = (const bf16_t*)(a.ws + WS_H1); bf16_t* xg = (bf16_t*)(a.ws + WS_XG);
    for (int p = blk * 8 + w; p < NTOK * TOPK; p += G * 8) {
        const int row = pstart[pair_e[p]] + pair_pos[p];
        const u32x4* sp = (const u32x4*)(h2 + (size_t)(p >> 2) * DM) + lane; u32x4* dp = (u32x4*)(xg + (size_t)row * DM) + lane;
#pragma unroll
        for (int q = 0; q < 4; ++q) dp[64 * q] = sp[64 * q];
        if (lane == 0) { wbuf[row] = pair_w[p]; slotrow[p] = row; }
    }
    __syncthreads();
}
__device__ __forceinline__ void moe_build_tab(const Args& a, LAS unsigned char* lds, int ntn) {
    LAS int* tab = (LAS int*)(lds + LDS_TAB);
    const unsigned* cnt = (const unsigned*)(a.ws + WS_CNT);
    __syncthreads();
    if (threadIdx.x == 0) { int us = 0, rs = 0; for (int e = 0; e < 32; ++e) { const int mt = (int)((cnt[e] + 255u) >> 8); tab[e] = us; tab[33 + e] = rs; us += mt * ntn; rs += mt; } tab[32] = us; tab[65] = rs; }
    __syncthreads();
}
__device__ __forceinline__ void phase_final(const Args& a, LAS unsigned char* lds) {
    const int tid = threadIdx.x, blk = blockIdx.x, G = gridDim.x, w = tid >> 6, lane = tid & 63;
    const float* mod = (const float*)(a.ws + WS_MOD); const float* x1 = (const float*)(a.ws + WS_X1); const int* slotrow = (const int*)(a.ws + WS_SLOTROW); const bf16_t* y = (const bf16_t*)(a.ws + WS_Y);
    for (int t = blk * 8 + w; t < NTOK; t += G * 8) {
        const int r0 = slotrow[t * 4], r1 = slotrow[t * 4 + 1], r2 = slotrow[t * 4 + 2], r3 = slotrow[t * 4 + 3];
        const f32x4* xr = (const f32x4*)(x1 + (size_t)t * DM) + lane;
        const u32x2* y0 = (const u32x2*)(y + (size_t)r0 * DM) + lane; const u32x2* y1 = (const u32x2*)(y + (size_t)r1 * DM) + lane;
        const u32x2* y2 = (const u32x2*)(y + (size_t)r2 * DM) + lane; const u32x2* y3 = (const u32x2*)(y + (size_t)r3 * DM) + lane;
        const float* g2 = mod + (size_t)(t >> 12) * 12288 + 10240;
        f32x4 v[8]; float ss = 0.f;
#pragma unroll
        for (int q = 0; q < 8; ++q) { const u32x2 a0 = y0[64 * q], a1 = y1[64 * q], a2 = y2[64 * q], a3 = y3[64 * q];
            f32x4 s; s[0] = (bflo(a0.x) + bflo(a1.x)) + (bflo(a2.x) + bflo(a3.x)); s[1] = (bfhi(a0.x) + bfhi(a1.x)) + (bfhi(a2.x) + bfhi(a3.x));
            s[2] = (bflo(a0.y) + bflo(a1.y)) + (bflo(a2.y) + bflo(a3.y)); s[3] = (bfhi(a0.y) + bfhi(a1.y)) + (bfhi(a2.y) + bfhi(a3.y));
            const f32x4 gv = *(const f32x4*)(g2 + 4 * (lane + 64 * q));
            v[q] = xr[64 * q] + gv * s; ss += (v[q][0] * v[q][0] + v[q][1] * v[q][1]) + (v[q][2] * v[q][2] + v[q][3] * v[q][3]); }
        ss = wave_sum(ss);
        const float rstd = 1.0f / sqrtf(ss * (1.0f / DM) + EPS);
        f32x4* op = (f32x4*)(a.out + (size_t)t * DM) + lane;
#pragma unroll
        for (int q = 0; q < 8; ++q) op[64 * q] = v[q] * rstd * *(const f32x4*)(a.final_norm_w + 4 * (lane + 64 * q));
    }
}

constexpr int NPHASE = 12;
#ifndef ONLY_PHASE
#define ONLY_PHASE -1
#endif
#define PH_ON(P) (ONLY_PHASE < 0 || ONLY_PHASE == (P))
__global__ void __launch_bounds__(512, 2) fwd(Args a) {
    extern __shared__ __attribute__((aligned(16))) unsigned char shm[];
    LAS unsigned char* lds = (LAS unsigned char*)shm;
    if (threadIdx.x == 0) *(LAS u32x4*)(lds + LDS_XB) = (u32x4){0u, 0u, 0u, 0u};
    __syncthreads();
    XcdBarrier bar = xcd_barrier_post((unsigned*)(a.ws + WS_BAR), (volatile LAS unsigned*)(lds + LDS_XB));
    const int G = gridDim.x, blk = blockIdx.x;
#define PHASE_END(P) do { if ((P) + 1 < a.ph_hi) xcd_barrier(bar); } while (0)
    if (PH_ON(0) && a.ph_lo <= 0 && 0 < a.ph_hi) { phase_prologue(a, lds); PHASE_END(0); }
    if (PH_ON(1) && a.ph_lo <= 1 && 1 < a.ph_hi) { phase_norm1(a, lds); PHASE_END(1); }
    if (PH_ON(2) && a.ph_lo <= 2 && 2 < a.ph_hi) {
        pg8::Gemm g{(const bf16_t*)(a.ws + WS_H1), (const bf16_t*)(a.ws + WS_WIN_T), DM, 0};
        pg8::StaticOrder S; S.init(NTOK, NPROJ, G, blk);
        pg8::EpiProj E{(bf16_t*)(a.ws + WS_PROJ), NPROJ};
        pg8::gemm_phase(lds, g, S, E); PHASE_END(2); }
    if (PH_ON(3) && a.ph_lo <= 3 && 3 < a.ph_hi) { phase_mix_prep(a, lds); PHASE_END(3); }
    if (PH_ON(4) && a.ph_lo <= 4 && 4 < a.ph_hi) { phase_scan_select(a, lds); PHASE_END(4); }
    if (PH_ON(5) && a.ph_lo <= 5 && 5 < a.ph_hi) { phase_mix_out(a, lds); PHASE_END(5); }
    if (PH_ON(6) && a.ph_lo <= 6 && 6 < a.ph_hi) {
        pg8::Gemm g{(const bf16_t*)(a.ws + WS_OCAT), (const bf16_t*)(a.ws + WS_WOUT_T), DM, 0};
        pg8::StaticOrder S; S.init(NTOK, DM, G, blk);
        pg8::EpiOut E{a.x, (const float*)(a.ws + WS_MOD) + 4096, (float*)(a.ws + WS_X1)};
        pg8::gemm_phase(lds, g, S, E); PHASE_END(6); }
    if (PH_ON(7) && a.ph_lo <= 7 && 7 < a.ph_hi) { phase_router(a, lds); PHASE_END(7); }
    if (PH_ON(8) && a.ph_lo <= 8 && 8 < a.ph_hi) { phase_gather(a, lds); PHASE_END(8); }
    if (PH_ON(9) && a.ph_lo <= 9 && 9 < a.ph_hi) {
        moe_build_tab(a, lds, 16);
        pg8::Gemm g{(const bf16_t*)(a.ws + WS_XG), (const bf16_t*)(a.ws + WS_WGU_T), DM, (size_t)4096 * 2048};
        pg8::MoeOrder S{(const LAS int*)(lds + LDS_TAB), G, blk};
        pg8::EpiGU E{a.b_gate_up, (bf16_t*)(a.ws + WS_ACT)};
        pg8::gemm_phase(lds, g, S, E); PHASE_END(9); }
    if (PH_ON(10) && a.ph_lo <= 10 && 10 < a.ph_hi) {
        moe_build_tab(a, lds, 8);
        pg8::Gemm g{(const bf16_t*)(a.ws + WS_ACT), (const bf16_t*)(a.ws + WS_WD_T), DM, (size_t)2048 * 2048};
        pg8::MoeOrder S{(const LAS int*)(lds + LDS_TAB), G, blk};
        pg8::EpiDown E{a.b_down, (const float*)(a.ws + WS_WBUF), (bf16_t*)(a.ws + WS_Y)};
        pg8::gemm_phase(lds, g, S, E); PHASE_END(10); }
    if (PH_ON(11) && a.ph_lo <= 11 && 11 < a.ph_hi) { phase_final(a, lds); }
}

#ifndef N_LAUNCHES
#define N_LAUNCHES 12
#endif
extern "C" void kernel_launch(void* const* d_in, const int* in_sizes, int n_in, void* d_out, int out_size, void* d_ws, size_t ws_size, hipStream_t stream) {
    static int grid = 0;
    if (grid == 0) {
        if (n_in != 18 || out_size != NTOK * DM || ws_size < WS_END) { fprintf(stderr, "kernel_launch: unexpected shapes (n_in %d out %d ws %zu, need %zu)\n", n_in, out_size, ws_size, (size_t)WS_END); grid = -1; return; }
        int dev = 0, cus = 0, per_cu = 0;
        if (hipGetDevice(&dev) != hipSuccess || hipDeviceGetAttribute(&cus, hipDeviceAttributeMultiprocessorCount, dev) != hipSuccess) { grid = -1; return; }
        if (hipFuncSetAttribute((const void*)fwd, hipFuncAttributeMaxDynamicSharedMemorySize, LDS_BYTES) != hipSuccess) { fprintf(stderr, "kernel_launch: hipFuncSetAttribute failed\n"); grid = -1; return; }
        if (hipOccupancyMaxActiveBlocksPerMultiprocessor(&per_cu, (const void*)fwd, 512, LDS_BYTES) != hipSuccess || per_cu < 1) fprintf(stderr, "kernel_launch: occupancy query says %d\n", per_cu);
        (void)hipGetLastError();
        grid = cus;
    }
    if (grid < 0) return;
    (void)hipMemsetAsync(d_ws, 0, WS_ZERO_BYTES, stream);
    Args a{};
    a.x = (const float*)d_in[0]; a.c = (const float*)d_in[1]; a.w_ada = (const float*)d_in[2]; a.b_ada = (const float*)d_in[3]; a.norm1_w = (const float*)d_in[4];
    a.w_in = (const float*)d_in[5]; a.w_alpha2 = (const float*)d_in[6]; a.b_alpha = (const float*)d_in[7]; a.gla_norm_w = (const float*)d_in[8]; a.w_out = (const float*)d_in[9];
    a.norm2_w = (const float*)d_in[10]; a.w_router = (const float*)d_in[11]; a.b_router = (const float*)d_in[12]; a.w_gate_up = (const float*)d_in[13]; a.b_gate_up = (const float*)d_in[14];
    a.w_down = (const float*)d_in[15]; a.b_down = (const float*)d_in[16]; a.final_norm_w = (const float*)d_in[17];
    a.out = (float*)d_out; a.ws = (unsigned char*)d_ws;
    if (N_LAUNCHES == 1) { a.ph_lo = 0; a.ph_hi = NPHASE; hipLaunchKernelGGL(fwd, dim3(grid), dim3(512), LDS_BYTES, stream, a); }
    else for (int p = 0; p < NPHASE; ++p) { a.ph_lo = p; a.ph_hi = p + 1; hipLaunchKernelGGL(fwd, dim3(grid), dim3(512), LDS_BYTES, stream, a); }
}
```

```cpp
#include <hip/hip_runtime.h>
#include <stdint.h>
#include <stdio.h>

#define LAS __attribute__((address_space(3)))
typedef unsigned short bf16_t;
typedef short bf16x8 __attribute__((ext_vector_type(8)));
typedef float f32x4 __attribute__((ext_vector_type(4)));
typedef float f32x2 __attribute__((ext_vector_type(2)));
typedef unsigned u32x4 __attribute__((ext_vector_type(4)));
typedef unsigned u32x2 __attribute__((ext_vector_type(2)));

constexpr int DM = 2048, NBATCH = 2, SEQ = 4096, NTOK = 8192;
constexpr int DIN = 6160, NPROJ = 6144;
constexpr int NE = 32, TOPK = 4;
constexpr int C_QA = 0, C_KA = 512, C_VA = 1024, C_GA = 2048, C_QB = 3072, C_KB = 4096, C_VB = 5120;
constexpr int MAXROWS = 40960;
constexpr float EPS = 1e-6f;

constexpr size_t MB = 1024ull * 1024ull;
constexpr size_t WS_BAR = 0;
constexpr size_t WS_CNT = 16384;
constexpr size_t WS_ZERO_BYTES = 20480;
constexpr size_t WS_MOD = 32768;
constexpr size_t WS_ROPE = 1 * MB;
constexpr size_t WS_H1 = 3 * MB;
constexpr size_t WS_GK = WS_H1 + 32 * MB;
constexpr size_t WS_PROJ = WS_GK + 16 * MB;
constexpr size_t WS_WIN_T = WS_PROJ + 96 * MB;
constexpr size_t WS_WOUT_T = WS_WIN_T + 24 * MB;
constexpr size_t WS_WGU_T = WS_WOUT_T + 8 * MB;
constexpr size_t WS_WD_T = WS_WGU_T + 512 * MB;
constexpr size_t WS_BCUM = WS_WD_T + 256 * MB;
constexpr size_t WS_DST = WS_BCUM + 16 * MB;
constexpr size_t WS_DEC = WS_DST + 64 * MB;
constexpr size_t WS_ST = WS_DEC + 1 * MB;
constexpr size_t WS_QBR = WS_ST + 32 * MB;
constexpr size_t WS_KBR = WS_QBR + 16 * MB;
constexpr size_t WS_VBT = WS_KBR + 16 * MB;
constexpr size_t WS_KMEAN = WS_VBT + 16 * MB;
constexpr size_t WS_SEL = WS_KMEAN + 1 * MB;
constexpr size_t WS_OCAT = WS_SEL + 1 * MB;
constexpr size_t WS_X1 = WS_OCAT + 32 * MB;
constexpr size_t WS_PAIR_E = WS_X1 + 64 * MB;
constexpr size_t WS_PAIR_POS = WS_PAIR_E + 1 * MB;
constexpr size_t WS_PAIR_W = WS_PAIR_POS + 1 * MB;
constexpr size_t WS_SLOTROW = WS_PAIR_W + 1 * MB;
constexpr size_t WS_WBUF = WS_SLOTROW + 1 * MB;
constexpr size_t WS_XG = WS_WBUF + 1 * MB;
constexpr size_t WS_ACT = WS_XG + 160 * MB;
constexpr size_t WS_Y = WS_ACT + 160 * MB;
constexpr size_t WS_END = WS_Y + 160 * MB;

constexpr int LDS_BYTES = 147456;
constexpr int LDS_XB = 131072;
constexpr int LDS_TAB = 131072 + 64;
constexpr int LDS_EXTRA = 131072 + 1024;

struct Args {
    const float* x; const float* c; const float* w_ada; const float* b_ada; const float* norm1_w; const float* w_in; const float* w_alpha2; const float* b_alpha;
    const float* gla_norm_w; const float* w_out; const float* norm2_w; const float* w_router; const float* b_router; const float* w_gate_up; const float* b_gate_up;
    const float* w_down; const float* b_down; const float* final_norm_w;
    float* out; unsigned char* ws;
    int ph_lo, ph_hi;
};

__device__ __forceinline__ unsigned cvt_pk_bf16(float lo, float hi) { unsigned r; asm("v_cvt_pk_bf16_f32 %0, %1, %2" : "=v"(r) : "v"(lo), "v"(hi)); return r; }
__device__ __forceinline__ bf16_t f2bf(float f) { return (bf16_t)(cvt_pk_bf16(f, 0.f) & 0xffffu); }
__device__ __forceinline__ float bf2f(bf16_t b) { return __uint_as_float(((unsigned)b) << 16); }
__device__ __forceinline__ float bflo(unsigned w) { return __uint_as_float(w << 16); }
__device__ __forceinline__ float bfhi(unsigned w) { return __uint_as_float(w & 0xffff0000u); }
__device__ __forceinline__ float wave_sum(float v) {
#pragma unroll
    for (int o = 1; o < 64; o <<= 1) v += __shfl_xor(v, o);
    return v;
}
__device__ __forceinline__ float silu_f(float v) { return v / (1.f + expf(-v)); }
__device__ __forceinline__ f32x4 mfma16(bf16x8 a, bf16x8 b, f32x4 c) { return __builtin_amdgcn_mfma_f32_16x16x32_bf16(a, b, c, 0, 0, 0); }
__device__ __forceinline__ bf16x8 lds_frag(const LAS bf16_t* img, int ld, int r0, int k0, int lane) {
    return *(const LAS bf16x8*)(img + (r0 + (lane & 15)) * ld + k0 + 8 * (lane >> 4));
}

#define XB_TMO      128
#define XB_XCNT(j)  (256  + 64 * (j))
#define XB_XSUB(j)  (1280 + 64 * (j))
#define XB_XGEN(j)  (2304 + 64 * (j))
#define XB_TOP      3328
#define XB_TOPGEN   3392
#define XCD_BAR_WORDS 3456
#define XB_SPIN_CAP (1u << 18)
__device__ __forceinline__ unsigned xb_ld(unsigned* p)              { return __hip_atomic_load(p, __ATOMIC_RELAXED, __HIP_MEMORY_SCOPE_AGENT); }
__device__ __forceinline__ unsigned xb_add(unsigned* p, unsigned v) { return __hip_atomic_fetch_add(p, v, __ATOMIC_RELAXED, __HIP_MEMORY_SCOPE_AGENT); }
__device__ __forceinline__ unsigned xb_xcc_id() { return (unsigned)__builtin_amdgcn_s_getreg((3 << 11) | 20) & 0xFu; }
#define XB_SPIN(cond, bar) do { unsigned _sp = 0; while (cond) { __builtin_amdgcn_s_sleep(1); \
    if ((++_sp & 255u) == 0u) { if (xb_ld(&(bar)[XB_TMO])) break; if (_sp > XB_SPIN_CAP) { atomicAdd(&(bar)[XB_TMO], 1u); break; } } } } while (0)
struct XcdBarrier { unsigned* bar; unsigned x; volatile LAS unsigned* st; };
__device__ __forceinline__ XcdBarrier xcd_barrier_post(unsigned* bar, volatile LAS unsigned* st) {
    XcdBarrier b; b.bar = bar; b.x = xb_xcc_id(); b.st = st;
    if (threadIdx.x == 0) (void)xb_add(&bar[XB_XCNT(b.x)], 1u);
    return b;
}
__device__ __forceinline__ void xcd_barrier_complete(unsigned* bar, unsigned x, unsigned& nloc, unsigned& nx) {
    const unsigned G = gridDim.x * gridDim.y * gridDim.z;
    unsigned sum, cnt, mine, sp = 0u;
    for (;;) {
        sum = 0u; cnt = 0u; mine = 0u;
#pragma unroll
        for (unsigned j = 0; j < 16; ++j) { const unsigned c = xb_ld(&bar[XB_XCNT(j)]); sum += c; cnt += (c > 0u) ? 1u : 0u; mine = (j == x) ? c : mine; }
        if (sum == G) break;
        __builtin_amdgcn_s_sleep(1);
        if ((++sp & 255u) == 0u) { if (xb_ld(&bar[XB_TMO])) break; if (sp > XB_SPIN_CAP) { atomicAdd(&bar[XB_TMO], 1u); break; } }
    }
    nloc = mine > 0u ? mine : 1u; nx = cnt > 0u ? cnt : 1u;
}
__device__ __forceinline__ void xcd_barrier(const XcdBarrier& b) {
    asm volatile("s_waitcnt vmcnt(0)" ::: "memory");
    __syncthreads();
    if (threadIdx.x == 0) {
        unsigned* bar = b.bar;
        __builtin_amdgcn_s_waitcnt(0);
        unsigned nloc = b.st[0], nx = b.st[1];
        if (nloc == 0u) { xcd_barrier_complete(bar, b.x, nloc, nx); b.st[0] = nloc; b.st[1] = nx; }
        const unsigned old = xb_add(&bar[XB_XSUB(b.x)], 1u);
        const unsigned gen = old / nloc;
        if (old + 1u == (gen + 1u) * nloc) {
            __builtin_amdgcn_fence(__ATOMIC_RELEASE, "agent");
            asm volatile("s_waitcnt vmcnt(0)" ::: "memory");
            const unsigned og = xb_add(&bar[XB_TOP], 1u);
            const unsigned tg = og / nx;
            if (og + 1u == (tg + 1u) * nx) xb_add(&bar[XB_TOPGEN], 1u);
            else XB_SPIN(xb_ld(&bar[XB_TOPGEN]) == tg, bar);
            __builtin_amdgcn_fence(__ATOMIC_ACQUIRE, "agent");
            xb_add(&bar[XB_XGEN(b.x)], 1u);
            asm volatile("s_waitcnt vmcnt(0)" ::: "memory");
        } else {
            XB_SPIN(xb_ld(&bar[XB_XGEN(b.x)]) == gen, bar);
            __builtin_amdgcn_fence(__ATOMIC_ACQUIRE, "agent");
            asm volatile("s_waitcnt vmcnt(0)" ::: "memory");
        }
    }
    __syncthreads();
}

namespace pg8 {
constexpr int BM = 256, BK = 64, HALF = 128, HTB = HALF * BK * 2, STAGE_BYTES = 8 * HTB, NXCD = 8, WGM = 8;
__host__ __device__ __forceinline__ int lds_byte(int r, int c) { const int st = (r >> 4) * 2 + (c >> 5), rr = r & 15, cc = c & 31, ob = rr * 64 + cc * 2; return st * 1024 + (ob ^ (((ob >> 9) & 1) << 5)); }
__host__ __device__ __forceinline__ void stage_rc(int b, int& R, int& C) { const int st = b / 1024, sb = b % 1024, swz = sb ^ (((sb >> 9) & 1) << 5); R = (st >> 1) * 16 + swz / 64; C = (st & 1) * 32 + (swz % 64) / 2; }
__host__ __device__ __forceinline__ int perm32(int rho) { const int n = rho >> 4, i = rho & 15; return 8 * (i >> 2) + 4 * n + (i & 3); }

struct Unit { int pm, pn, e; };
struct Gemm { const bf16_t* A; const bf16_t* Bt; int K; size_t b_estride; };

struct StaticOrder {
    int nM, nN, nwg, G, c;
    __device__ void init(int M, int N, int G_, int c_) { nM = M / BM; nN = N / BM; nwg = nM * nN; G = G_; c = c_; }
    __device__ bool next(int i, Unit& u) const {
        const long L = (long)i * G + c; if (L >= nwg) return false;
        int wgid = (int)L; { const int q = nwg / NXCD, r = nwg % NXCD, xcd = wgid % NXCD, off = wgid / NXCD; wgid = (xcd < r ? xcd * (q + 1) : r * (q + 1) + (xcd - r) * q) + off; }
        const int nig = WGM * nN, gid = wgid / nig, fm = gid * WGM, gsz = (nM - fm) < WGM ? (nM - fm) : WGM;
        u.pm = fm + ((wgid % nig) % gsz); u.pn = (wgid % nig) / gsz; u.e = 0; return true;
    }
};
struct MoeOrder {
    const LAS int* tab; int G, c;
    __device__ bool next(int i, Unit& u) const {
        const int L = i * G + c; if (L >= tab[32]) return false;
        int e = 0;
#pragma unroll 1
        while (tab[e + 1] <= L) ++e;
        const int local = L - tab[e], rt0 = tab[33 + e], mte = tab[34 + e] - rt0;
        u.e = e; u.pn = local / mte; u.pm = rt0 + (local - u.pn * mte); return true;
    }
};

struct EpiProj {
    static constexpr bool PERM = true;
    bf16_t* O; int ldc;
    __device__ __forceinline__ void operator()(const f32x4 (&acc)[2][2][4][2], const Unit& u, int wr, int wc, int fr, int fq) const {
        const int row0 = u.pm * BM + wr * 64 + fr, col0 = u.pn * BM + wc * 32 + 8 * fq;
#pragma unroll
        for (int ai = 0; ai < 2; ++ai)
#pragma unroll
            for (int m = 0; m < 4; ++m) { bf16_t* rowp = O + (size_t)(row0 + ai * HALF + m * 16) * ldc + col0;
#pragma unroll
                for (int bj = 0; bj < 2; ++bj) { const f32x4 v0 = acc[ai][bj][m][0], v1 = acc[ai][bj][m][1];
                    u32x4 w; w.x = cvt_pk_bf16(v0[0], v0[1]); w.y = cvt_pk_bf16(v0[2], v0[3]); w.z = cvt_pk_bf16(v1[0], v1[1]); w.w = cvt_pk_bf16(v1[2], v1[3]);
                    *(u32x4*)(rowp + bj * HALF) = w; } }
    }
};
struct EpiOut {
    static constexpr bool PERM = false;
    const float* X; const float* g1;   float* O;
    __device__ __forceinline__ void operator()(const f32x4 (&acc)[2][2][4][2], const Unit& u, int wr, int wc, int fr, int fq) const {
        const int row0 = u.pm * BM + wr * 64 + fr, col0 = u.pn * BM + wc * 32 + 4 * fq;
        const float* gp = g1 + (size_t)((u.pm * BM) >> 12) * 12288 + col0;
        f32x4 gv[2][2];
#pragma unroll
        for (int bj = 0; bj < 2; ++bj)
#pragma unroll
            for (int n = 0; n < 2; ++n) gv[bj][n] = *(const f32x4*)(gp + bj * HALF + n * 16);
#pragma unroll
        for (int ai = 0; ai < 2; ++ai)
#pragma unroll
            for (int m = 0; m < 4; ++m) { const size_t off = (size_t)(row0 + ai * HALF + m * 16) * DM + col0;
#pragma unroll
                for (int bj = 0; bj < 2; ++bj)
#pragma unroll
                    for (int n = 0; n < 2; ++n) { const f32x4 xv = *(const f32x4*)(X + off + bj * HALF + n * 16);
                        *(f32x4*)(O + off + bj * HALF + n * 16) = xv + gv[bj][n] * acc[ai][bj][m][n]; }
                asm volatile("" ::: "memory"); }
    }
};
struct EpiGU {
    static constexpr bool PERM = true;
    const float* bias;   bf16_t* O;
    __device__ __forceinline__ void operator()(const f32x4 (&acc)[2][2][4][2], const Unit& u, int wr, int wc, int fr, int fq) const {
        const int row0 = u.pm * BM + wr * 64 + fr, cc = u.pn * HALF + wc * 32 + 8 * fq;
        const float* bp = bias + (size_t)u.e * 4096 + cc;
        f32x4 bg[2], bu[2];
#pragma unroll
        for (int n = 0; n < 2; ++n) { bg[n] = *(const f32x4*)(bp + 4 * n); bu[n] = *(const f32x4*)(bp + 2048 + 4 * n); }
#pragma unroll
        for (int ai = 0; ai < 2; ++ai)
#pragma unroll
            for (int m = 0; m < 4; ++m) { float r[8];
#pragma unroll
                for (int n = 0; n < 2; ++n)
#pragma unroll
                    for (int j = 0; j < 4; ++j) {
                        float g = acc[ai][0][m][n][j] + bg[n][j], uu = acc[ai][1][m][n][j] + bu[n][j];
                        g = fminf(g, 7.0f); uu = fminf(fmaxf(uu, -7.0f), 7.0f);
                        const float glu = g * __builtin_amdgcn_rcpf(1.0f + __expf(-1.702f * g));
                        r[n * 4 + j] = (uu + 1.0f) * glu; }
                u32x4 w; w.x = cvt_pk_bf16(r[0], r[1]); w.y = cvt_pk_bf16(r[2], r[3]); w.z = cvt_pk_bf16(r[4], r[5]); w.w = cvt_pk_bf16(r[6], r[7]);
                *(u32x4*)(O + (size_t)(row0 + ai * HALF + m * 16) * DM + cc) = w; }
    }
};
struct EpiDown {
    static constexpr bool PERM = true;
    const float* bias;   const float* wbuf; bf16_t* O;
    __device__ __forceinline__ void operator()(const f32x4 (&acc)[2][2][4][2], const Unit& u, int wr, int wc, int fr, int fq) const {
        const int row0 = u.pm * BM + wr * 64 + fr, col0 = u.pn * BM + wc * 32 + 8 * fq;
        const float* bp = bias + (size_t)u.e * 2048 + col0;
        f32x4 bv[2][2];
#pragma unroll
        for (int bj = 0; bj < 2; ++bj)
#pragma unroll
            for (int n = 0; n < 2; ++n) bv[bj][n] = *(const f32x4*)(bp + bj * HALF + 4 * n);
#pragma unroll
        for (int ai = 0; ai < 2; ++ai)
#pragma unroll
            for (int m = 0; m < 4; ++m) { const int row = row0 + ai * HALF + m * 16; const float rw = wbuf[row]; bf16_t* rowp = O + (size_t)row * DM + col0;
#pragma unroll
                for (int bj = 0; bj < 2; ++bj) { const f32x4 v0 = (acc[ai][bj][m][0] + bv[bj][0]) * rw, v1 = (acc[ai][bj][m][1] + bv[bj][1]) * rw;
                    u32x4 w; w.x = cvt_pk_bf16(v0[0], v0[1]); w.y = cvt_pk_bf16(v0[2], v0[3]); w.z = cvt_pk_bf16(v1[0], v1[1]); w.w = cvt_pk_bf16(v1[2], v1[3]);
                    *(u32x4*)(rowp + bj * HALF) = w; } }
    }
};

template <class Epi, class Sched>
__device__ __forceinline__ void gemm_phase(LAS unsigned char* lds, const Gemm g, const Sched& S, const Epi& E) {
    const int tid = threadIdx.x, wid = __builtin_amdgcn_readfirstlane(tid >> 6), lane = tid & 63, wr = wid >> 2, wc = wid & 3, fr = lane & 15, fq = lane >> 4;
    const int K = g.K, nt = K / BK;
    unsigned voffA[2], voffB[2];
#pragma unroll
    for (int i = 0; i < 2; ++i) { int R, C; stage_rc(tid * 16 + i * 8192, R, C); const int Rb = Epi::PERM ? ((R & ~31) + perm32(R & 31)) : R;
        voffA[i] = (unsigned)(R * K + C) * 2u; voffB[i] = (unsigned)(Rb * K + C) * 2u; }
    const size_t kstep = (size_t)(BK * 2);
    const size_t hstep = (size_t)HALF * K * 2;
    const size_t tstep = 2 * hstep;
    const size_t estep = g.b_estride * 2;
    const unsigned ldsw = (unsigned)wid * 1024u;
    const int aoff = lds_byte(wr * 64 + fr, fq * 8), boff = lds_byte(wc * 32 + fr, fq * 8);
#define PG8_SA(b, h) (((b) * 2 + (h)) * HTB)
#define PG8_SB(b, h) ((4 + (b) * 2 + (h)) * HTB)
#define PG8_STAGE(bufoff, gbase, voff) do { _Pragma("unroll") for (int _i = 0; _i < 2; ++_i) \
        __builtin_amdgcn_global_load_lds((const unsigned*)((const char*)(gbase) + (voff)[_i]), (LAS unsigned*)(lds + (bufoff) + ldsw + _i * 8192), 16, 0, 0); } while (0)
#define PG8_LDA(dst, b, h) do { _Pragma("unroll") for (int m = 0; m < 4; ++m) _Pragma("unroll") for (int k = 0; k < 2; ++k) dst[m][k] = *(const LAS bf16x8*)(lds + PG8_SA(b, h) + aoff + m * 2048 + k * 1024); } while (0)
#define PG8_LDB(dst, b, h) do { _Pragma("unroll") for (int n = 0; n < 2; ++n) _Pragma("unroll") for (int k = 0; k < 2; ++k) dst[n][k] = *(const LAS bf16x8*)(lds + PG8_SB(b, h) + boff + n * 2048 + k * 1024); } while (0)
#define PG8_MMA(ai, bj, At, Bt) do { __builtin_amdgcn_s_setprio(1); _Pragma("unroll") for (int m = 0; m < 4; ++m) _Pragma("unroll") for (int n = 0; n < 2; ++n) _Pragma("unroll") for (int k = 0; k < 2; ++k) \
        acc[ai][bj][m][n] = __builtin_amdgcn_mfma_f32_16x16x32_bf16(Bt[n][k], At[m][k], acc[ai][bj][m][n], 0, 0, 0); __builtin_amdgcn_s_setprio(0); } while (0)
#define PG8_WAIT_V(n) asm volatile("s_waitcnt vmcnt(" #n ")" ::: "memory")
#define PG8_WAIT_L(n) asm volatile("s_waitcnt lgkmcnt(" #n ")" ::: "memory")
#define PG8_BAR __builtin_amdgcn_s_barrier()
#define PG8_SCHED __builtin_amdgcn_sched_barrier(0)
    Unit cur, nxt; int ui = 0;
    if (!S.next(0, cur)) return;
    f32x4 acc[2][2][4][2];
#pragma unroll
    for (int a = 0; a < 2; ++a)
#pragma unroll
        for (int b = 0; b < 2; ++b)
#pragma unroll
            for (int m = 0; m < 4; ++m)
#pragma unroll
                for (int n = 0; n < 2; ++n) acc[a][b][m][n] = (f32x4){0.f, 0.f, 0.f, 0.f};
    bf16x8 At[4][2], B0[2][2], B1[2][2];
    const char* cA = (const char*)g.A + (size_t)cur.pm * tstep; const char* cB = (const char*)g.Bt + (size_t)cur.e * estep + (size_t)cur.pn * tstep;
    PG8_STAGE(PG8_SB(0, 0), cB, voffB); PG8_STAGE(PG8_SA(0, 0), cA, voffA); PG8_STAGE(PG8_SB(0, 1), cB + hstep, voffB); PG8_STAGE(PG8_SA(0, 1), cA + hstep, voffA);
    if (wr == 1) PG8_BAR;
    PG8_WAIT_V(4); PG8_BAR;
    PG8_STAGE(PG8_SB(1, 0), cB + kstep, voffB); PG8_STAGE(PG8_SA(1, 0), cA + kstep, voffA); PG8_STAGE(PG8_SB(1, 1), cB + hstep + kstep, voffB);
    PG8_WAIT_V(6); PG8_BAR;
    for (;;) {
        const bool has_next = S.next(ui + 1, nxt);
        const char* nA = has_next ? (const char*)g.A + (size_t)nxt.pm * tstep : cA;
        const char* nB = has_next ? (const char*)g.Bt + (size_t)nxt.e * estep + (size_t)nxt.pn * tstep : cB;
        for (int t = 0; t < nt; t += 2) {
            const bool last = (t == nt - 2);
            const char* a1 = cA + (size_t)(t + 1) * kstep;
            const char* a2 = last ? nA : cA + (size_t)(t + 2) * kstep; const char* b2 = last ? nB : cB + (size_t)(t + 2) * kstep;
            const char* a3 = a2 + kstep; const char* b3 = b2 + kstep;
            PG8_LDB(B0, 0, 0); PG8_SCHED; PG8_LDA(At, 0, 0); PG8_STAGE(PG8_SA(1, 1), a1 + hstep, voffA);
            PG8_WAIT_L(8); PG8_BAR; PG8_WAIT_L(0); PG8_MMA(0, 0, At, B0); PG8_BAR; PG8_SCHED;
            PG8_LDB(B1, 0, 1); PG8_STAGE(PG8_SB(0, 0), b2, voffB);
            PG8_BAR; PG8_WAIT_L(0); PG8_MMA(0, 1, At, B1); PG8_BAR;
            PG8_LDA(At, 0, 1); PG8_STAGE(PG8_SA(0, 0), a2, voffA);
            PG8_BAR; PG8_WAIT_L(0); PG8_MMA(1, 0, At, B0); PG8_BAR; PG8_SCHED;
            PG8_STAGE(PG8_SB(0, 1), b2 + hstep, voffB);
            PG8_WAIT_V(6); PG8_BAR; PG8_MMA(1, 1, At, B1); PG8_BAR;
            PG8_LDB(B0, 1, 0); PG8_SCHED; PG8_LDA(At, 1, 0); PG8_STAGE(PG8_SA(0, 1), a2 + hstep, voffA);
            PG8_WAIT_L(8); PG8_BAR; PG8_WAIT_L(0); PG8_MMA(0, 0, At, B0); PG8_BAR; PG8_SCHED;
            PG8_LDB(B1, 1, 1); PG8_STAGE(PG8_SB(1, 0), b3, voffB);
            PG8_BAR; PG8_WAIT_L(0); PG8_MMA(0, 1, At, B1); PG8_BAR;
            PG8_LDA(At, 1, 1); PG8_STAGE(PG8_SA(1, 0), a3, voffA);
            PG8_BAR; PG8_WAIT_L(0); PG8_MMA(1, 0, At, B0); PG8_BAR; PG8_SCHED;
            PG8_STAGE(PG8_SB(1, 1), b3 + hstep, voffB);
            PG8_WAIT_V(6); PG8_BAR; PG8_MMA(1, 1, At, B1); PG8_BAR;
        }
        E(acc, cur, wr, wc, fr, fq);
        if (!has_next) break;
#pragma unroll
        for (int a = 0; a < 2; ++a)
#pragma unroll
            for (int b = 0; b < 2; ++b)
#pragma unroll
                for (int m = 0; m < 4; ++m)
#pragma unroll
                    for (int n = 0; n < 2; ++n) acc[a][b][m][n] = (f32x4){0.f, 0.f, 0.f, 0.f};
        cur = nxt; cA = nA; cB = nB; ++ui;
    }
    PG8_WAIT_V(0);
    if (wr == 0) PG8_BAR;
    PG8_BAR;
#undef PG8_SA
#undef PG8_SB
#undef PG8_STAGE
#undef PG8_LDA
#undef PG8_LDB
#undef PG8_MMA
#undef PG8_WAIT_V
#undef PG8_WAIT_L
#undef PG8_BAR
#undef PG8_SCHED
}
}

__device__ __forceinline__ void conv_job(const float* src, int ld, bf16_t* dst, int kt) {
    const int w = threadIdx.x >> 6, lane = threadIdx.x & 63, kseg = lane & 7, nq = lane >> 3;
    const int k0 = kt * 128 + (w >> 2) * 64 + kseg * 8, nl = (w & 3) * 32 + nq * 4;
    f32x4 v[8];
#pragma unroll
    for (int r = 0; r < 8; ++r) v[r] = *(const f32x4*)(src + (size_t)(k0 + r) * ld + nl);
#pragma unroll
    for (int j = 0; j < 4; ++j) { u32x4 o; o.x = cvt_pk_bf16(v[0][j], v[1][j]); o.y = cvt_pk_bf16(v[2][j], v[3][j]); o.z = cvt_pk_bf16(v[4][j], v[5][j]); o.w = cvt_pk_bf16(v[6][j], v[7][j]);
        *(u32x4*)(dst + (size_t)(nl + j) * 2048 + k0) = o; }
}
__device__ __forceinline__ void phase_prologue(const Args& a, LAS unsigned char* lds) {
    const int tid = threadIdx.x, blk = blockIdx.x, G = gridDim.x;
    if (blk < 192) {
        LAS float* cact = (LAS float*)lds; LAS float* red = (LAS float*)(lds + 16384);
        for (int i = tid; i < 4096; i += 512) cact[i] = silu_f(a.c[i]);
        __syncthreads();
        float* mod = (float*)(a.ws + WS_MOD);
        for (int cb = blk; cb < 192; cb += G) {
            const int rg = tid >> 4, cl = tid & 15;
            const float* wp = a.w_ada + (size_t)cb * 64 + cl * 4;
            f32x4 a0 = {0.f, 0.f, 0.f, 0.f}, a1 = {0.f, 0.f, 0.f, 0.f};
#pragma unroll 8
            for (int i = 0; i < 64; ++i) { const int k = rg + 32 * i; const f32x4 w = *(const f32x4*)(wp + (size_t)k * 12288); a0 += w * cact[k]; a1 += w * cact[2048 + k]; }
#pragma unroll
            for (int j = 0; j < 4; ++j) { red[(rg * 2 + 0) * 64 + cl * 4 + j] = a0[j]; red[(rg * 2 + 1) * 64 + cl * 4 + j] = a1[j]; }
            __syncthreads();
            if (tid < 128) { const int b = tid >> 6, col = tid & 63; float s = 0.f; for (int r = 0; r < 32; ++r) s += red[(r * 2 + b) * 64 + col]; mod[b * 12288 + cb * 64 + col] = s + a.b_ada[cb * 64 + col]; }
            __syncthreads();
        }
    }
    {
        float* ct = (float*)(a.ws + WS_ROPE); float* st = ct + 4096 * 64;
        for (int idx = blk * 512 + tid; idx < 4096 * 64; idx += G * 512) {
            const int t = idx >> 6, i = idx & 63;
            const float inv = (float)exp2(-(double)i * (13.287712379549449 / 64.0));
            const float ang = (float)t * inv;
            const double ad = (double)ang, n = rint(ad * 0.15915494309189535), r = fma(-n, 6.283185307179586, ad) - n * 2.4492935982947064e-16;
            const float rf = (float)r;
            ct[idx] = cosf(rf); st[idx] = sinf(rf);
        }
    }
    {
        bf16_t* win_t = (bf16_t*)(a.ws + WS_WIN_T); bf16_t* wout_t = (bf16_t*)(a.ws + WS_WOUT_T); bf16_t* wgu_t = (bf16_t*)(a.ws + WS_WGU_T); bf16_t* wd_t = (bf16_t*)(a.ws + WS_WD_T);
        for (int job = blk; job < 1600 * 16; job += G) {
            const int rt = job >> 4, kt = job & 15;
            const float* src; int ld; bf16_t* dst;
            if (rt < 48) { const int n0 = rt * 128, col0 = n0 < 3072 ? n0 : n0 + 16; src = a.w_in + col0; ld = DIN; dst = win_t + (size_t)n0 * 2048; }
            else if (rt < 64) { const int n0 = (rt - 48) * 128; src = a.w_out + n0; ld = 2048; dst = wout_t + (size_t)n0 * 2048; }
            else if (rt < 1088) { const int idx = rt - 64, e = idx >> 5, r = idx & 31, pn = r >> 1, bj = r & 1; src = a.w_gate_up + (size_t)e * 2048 * 4096 + bj * 2048 + pn * 128; ld = 4096; dst = wgu_t + ((size_t)e * 4096 + r * 128) * 2048; }
            else { const int idx = rt - 1088, e = idx >> 4, n0 = (idx & 15) * 128; src = a.w_down + (size_t)e * 2048 * 2048 + n0; ld = 2048; dst = wd_t + ((size_t)e * 2048 + n0) * 2048; }
            conv_job(src, ld, dst, kt);
        }
    }
}

__device__ __forceinline__ void phase_norm1(const Args& a, LAS unsigned char* lds) {
    const int tid = threadIdx.x, blk = blockIdx.x, G = gridDim.x, w = tid >> 6, lane = tid & 63;
    LAS float* wlaT = (LAS float*)lds;
    for (int idx = tid; idx < 2048 * 16; idx += 512) { const int k = idx >> 4, j = idx & 15; wlaT[j * 2048 + k] = a.w_in[(size_t)k * DIN + 3072 + j]; }
    __syncthreads();
    const float* mod = (const float*)(a.ws + WS_MOD);
    bf16_t* h1 = (bf16_t*)(a.ws + WS_H1); float* gk = (float*)(a.ws + WS_GK);
    for (int r = blk * 8 + w; r < NTOK; r += G * 8) {
        const f32x4* xr = (const f32x4*)(a.x + (size_t)r * DM) + lane;
        f32x4 v[8]; float ss = 0.f;
#pragma unroll
        for (int q = 0; q < 8; ++q) { v[q] = xr[64 * q]; ss += (v[q][0] * v[q][0] + v[q][1] * v[q][1]) + (v[q][2] * v[q][2] + v[q][3] * v[q][3]); }
        ss = wave_sum(ss);
        const float rstd = 1.0f / sqrtf(ss * (1.0f / DM) + EPS);
        const float* sh = mod + (size_t)(r >> 12) * 12288; const float* sc = sh + 2048;
#pragma unroll
        for (int q = 0; q < 8; ++q) { const int k = 4 * (lane + 64 * q);
            const f32x4 nw = *(const f32x4*)(a.norm1_w + k), scv = *(const f32x4*)(sc + k), shv = *(const f32x4*)(sh + k);
            v[q] = (v[q] * rstd * nw) * (scv + 1.0f) + shv;
            u32x2 o; o.x = cvt_pk_bf16(v[q][0], v[q][1]); o.y = cvt_pk_bf16(v[q][2], v[q][3]);
            *(u32x2*)(h1 + (size_t)r * DM + k) = o; }
        LAS float* las = (LAS float*)(lds + LDS_EXTRA) + w * 16;
#pragma unroll 1
        for (int j = 0; j < 16; ++j) { float s = 0.f;
#pragma unroll
            for (int q = 0; q < 8; ++q) { const f32x4 wl = *(const LAS f32x4*)(wlaT + j * 2048 + 4 * (lane + 64 * q)); s += (v[q][0] * wl[0] + v[q][1] * wl[1]) + (v[q][2] * wl[2] + v[q][3] * wl[3]); }
            s = wave_sum(s); if (lane == 0) las[j] = s; }
        asm volatile("s_waitcnt lgkmcnt(0)" ::: "memory");
#pragma unroll 1
        for (int m = 0; m < 8; ++m) { const int d = lane + 64 * m; float z = a.b_alpha[d];
#pragma unroll
            for (int j = 0; j < 16; ++j) z += las[j] * a.w_alpha2[j * 512 + d];
            const float ls = fminf(z, 0.f) - log1pf(expf(-fabsf(z)));
            gk[(size_t)r * 512 + d] = ls * (1.0f / 16.0f); }
        asm volatile("s_waitcnt lgkmcnt(0)" ::: "memory");
    }
}

__device__ __forceinline__ void gla_stage_vt(const bf16_t* proj, int row0, int h, LAS bf16_t* VT, int tid) {
    const int i = tid >> 3, seg = tid & 7;
    const u32x4* vp = (const u32x4*)(proj + (size_t)(row0 + i) * NPROJ + C_VA + h * 256 + seg * 32);
#pragma unroll
    for (int c4 = 0; c4 < 4; ++c4) { const u32x4 vv = vp[c4];
#pragma unroll
        for (int p = 0; p < 4; ++p) { const unsigned wd = vv[p]; const int e = seg * 32 + c4 * 8 + p * 2;
            VT[e * 72 + i] = (bf16_t)(wd & 0xffffu); VT[(e + 1) * 72 + i] = (bf16_t)(wd >> 16); } }
}
__device__ __forceinline__ void gla1_unit(const Args& a, LAS unsigned char* lds, int u) {
    const int tid = threadIdx.x, w = tid >> 6, lane = tid & 63;
    const int bh = u >> 6, c = u & 63, b = bh >> 2, h = bh & 3, row0 = b * SEQ + c * 64;
    LAS float* Bm = (LAS float*)lds; LAS bf16_t* KT = (LAS bf16_t*)(lds + 32768); LAS bf16_t* VT = (LAS bf16_t*)(lds + 51200);
    const float* gk = (const float*)(a.ws + WS_GK); const bf16_t* proj = (const bf16_t*)(a.ws + WS_PROJ);
    float* bcum = (float*)(a.ws + WS_BCUM); float* dst = (float*)(a.ws + WS_DST); float* dec = (float*)(a.ws + WS_DEC);
    const int i = tid >> 3, seg = tid & 7;
    {
        const f32x4* gp = (const f32x4*)(gk + (size_t)(row0 + i) * 512 + h * 128 + seg * 16);
#pragma unroll
        for (int q = 0; q < 4; ++q) *(LAS f32x4*)(Bm + i * 128 + seg * 16 + q * 4) = gp[q];
    }
    __syncthreads();
    if (tid < 128) { float run = 0.f; for (int ii = 0; ii < 64; ++ii) { run += Bm[ii * 128 + tid]; Bm[ii * 128 + tid] = run; } }
    __syncthreads();
    {
        const u32x4* kp = (const u32x4*)(proj + (size_t)(row0 + i) * NPROJ + C_KA + h * 128 + seg * 16);
        float* bo = bcum + ((size_t)u * 64 + i) * 128 + seg * 16;
#pragma unroll
        for (int q = 0; q < 2; ++q) { const u32x4 kv = kp[q];
#pragma unroll
            for (int p = 0; p < 4; ++p) { const int d = seg * 16 + q * 8 + p * 2;
                const float b0 = Bm[i * 128 + d], b1 = Bm[i * 128 + d + 1], l0 = Bm[63 * 128 + d], l1 = Bm[63 * 128 + d + 1];
                bo[q * 8 + p * 2] = b0; bo[q * 8 + p * 2 + 1] = b1;
                KT[d * 72 + i] = f2bf(bflo(kv[p]) * expf(l0 - b0)); KT[(d + 1) * 72 + i] = f2bf(bfhi(kv[p]) * expf(l1 - b1));
                if (i == 63) { dec[(size_t)u * 128 + d] = expf(l0); dec[(size_t)u * 128 + d + 1] = expf(l1); } } }
        gla_stage_vt(proj, row0, h, VT, tid);
    }
    __syncthreads();
    {
        f32x4 acc[2][8];
#pragma unroll
        for (int x = 0; x < 2; ++x)
#pragma unroll
            for (int y = 0; y < 8; ++y) acc[x][y] = (f32x4){0.f, 0.f, 0.f, 0.f};
#pragma unroll
        for (int ks = 0; ks < 2; ++ks) {
            const bf16x8 a0 = lds_frag(VT, 72, (2 * w) * 16, ks * 32, lane), a1 = lds_frag(VT, 72, (2 * w + 1) * 16, ks * 32, lane);
#pragma unroll
            for (int dt = 0; dt < 8; ++dt) { const bf16x8 bf = lds_frag(KT, 72, dt * 16, ks * 32, lane); acc[0][dt] = mfma16(a0, bf, acc[0][dt]); acc[1][dt] = mfma16(a1, bf, acc[1][dt]); }
        }
        float* dp = dst + (size_t)u * 32768;
#pragma unroll
        for (int x = 0; x < 2; ++x)
#pragma unroll
            for (int dt = 0; dt < 8; ++dt)
#pragma unroll
                for (int r = 0; r < 4; ++r) dp[((2 * w + x) * 16 + 4 * (lane >> 4) + r) * 128 + dt * 16 + (lane & 15)] = acc[x][dt][r];
    }
    __syncthreads();
}
__device__ __forceinline__ void moba_prep_unit(const Args& a, LAS unsigned char* lds, int u2) {
    const int tid = threadIdx.x;
    const int bh = u2 >> 4, kb = u2 & 15, b = bh >> 3, h = bh & 7, row0 = b * SEQ + kb * 256, t0 = kb * 256;
    const bf16_t* proj = (const bf16_t*)(a.ws + WS_PROJ);
    const float* ct = (const float*)(a.ws + WS_ROPE); const float* st = ct + 4096 * 64;
    bf16_t* qbr = (bf16_t*)(a.ws + WS_QBR); bf16_t* kbr = (bf16_t*)(a.ws + WS_KBR); bf16_t* vbt = (bf16_t*)(a.ws + WS_VBT); float* kmean = (float*)(a.ws + WS_KMEAN);
    LAS float* Kf = (LAS float*)lds; LAS float* part = (LAS float*)(lds + LDS_EXTRA);
    const int row = tid >> 1, half = tid & 1;
    const float* cp = ct + (size_t)(t0 + row) * 64 + half * 32; const float* sp = st + (size_t)(t0 + row) * 64 + half * 32;
#pragma unroll 1
    for (int which = 0; which < 2; ++which) {
        const bf16_t* src = proj + (size_t)(row0 + row) * NPROJ + (which == 0 ? C_KB : C_QB) + h * 128 + half * 32;
        bf16_t* dsto = (which == 0 ? kbr : qbr) + ((size_t)bh * SEQ + t0 + row) * 128 + half * 32;
#pragma unroll
        for (int c4 = 0; c4 < 4; ++c4) {
            const u32x4 x1 = *(const u32x4*)(src + c4 * 8), x2 = *(const u32x4*)(src + 64 + c4 * 8);
            u32x4 o1, o2;
#pragma unroll
            for (int p = 0; p < 4; ++p) { const int ii = c4 * 8 + p * 2;
                const float c0 = cp[ii], c1 = cp[ii + 1], s0 = sp[ii], s1 = sp[ii + 1];
                const float a0 = bflo(x1[p]), a1 = bfhi(x1[p]), b0 = bflo(x2[p]), b1 = bfhi(x2[p]);
                const float r10 = a0 * c0 - b0 * s0, r11 = a1 * c1 - b1 * s1, r20 = a0 * s0 + b0 * c0, r21 = a1 * s1 + b1 * c1;
                o1[p] = cvt_pk_bf16(r10, r11); o2[p] = cvt_pk_bf16(r20, r21);
                if (which == 0) { Kf[row * 128 + half * 32 + ii] = r10; Kf[row * 128 + half * 32 + ii + 1] = r11; Kf[row * 128 + 64 + half * 32 + ii] = r20; Kf[row * 128 + 64 + half * 32 + ii + 1] = r21; } }
            *(u32x4*)(dsto + c4 * 8) = o1; *(u32x4*)(dsto + 64 + c4 * 8) = o2;
        }
        if (which == 0) {
            __syncthreads();
            { const int d = tid & 127, rq = tid >> 7; float s = 0.f; for (int rr = 0; rr < 64; ++rr) s += Kf[(rq * 64 + rr) * 128 + d]; part[rq * 128 + d] = s; }
            __syncthreads();
            if (tid < 128) kmean[((size_t)bh * 16 + kb) * 128 + tid] = (part[tid] + part[128 + tid] + part[256 + tid] + part[384 + tid]) * (1.0f / 256.0f);
        }
    }
    __syncthreads();
    LAS bf16_t* Vl = (LAS bf16_t*)lds;
    {
        const u32x4* vp = (const u32x4*)(proj + (size_t)(row0 + row) * NPROJ + C_VB + h * 128 + half * 64);
#pragma unroll
        for (int c8 = 0; c8 < 8; ++c8) { const u32x4 vv = vp[c8]; LAS unsigned* dp = (LAS unsigned*)(Vl + row * 130 + half * 64 + c8 * 8); dp[0] = vv[0]; dp[1] = vv[1]; dp[2] = vv[2]; dp[3] = vv[3]; }
    }
    __syncthreads();
    {
        const int d = tid >> 2, ts = tid & 3;
        bf16_t* op = vbt + ((size_t)bh * 128 + d) * SEQ + t0 + ts * 64;
#pragma unroll
        for (int c8 = 0; c8 < 8; ++c8) { u32x4 o;
#pragma unroll
            for (int p = 0; p < 4; ++p) { const int tt = ts * 64 + c8 * 8 + p * 2; o[p] = (unsigned)Vl[tt * 130 + d] | ((unsigned)Vl[(tt + 1) * 130 + d] << 16); }
            *(u32x4*)(op + c8 * 8) = o; }
    }
    __syncthreads();
}
__device__ __forceinline__ void phase_mix_prep(const Args& a, LAS unsigned char* lds) {
    const int blk = blockIdx.x, G = gridDim.x;
    for (int u = blk; u < 512; u += G) gla1_unit(a, lds, u);
    for (int u2 = blk; u2 < 256; u2 += G) moba_prep_unit(a, lds, u2);
}

__device__ __forceinline__ void phase_scan_select(const Args& a, LAS unsigned char* lds) {
    const int tid = threadIdx.x, blk = blockIdx.x, G = gridDim.x;
    {
        const float* dst = (const float*)(a.ws + WS_DST); const float* dec = (const float*)(a.ws + WS_DEC); bf16_t* ST = (bf16_t*)(a.ws + WS_ST);
        for (int el = blk * 512 + tid; el < 8 * 32768; el += G * 512) {
            const int bh = el >> 15, ed = el & 32767, d = ed & 127; float cur = 0.f;
#pragma unroll 8
            for (int c = 0; c < 64; ++c) { const size_t u = (size_t)bh * 64 + c; ST[u * 32768 + ed] = f2bf(cur); cur = dec[u * 128 + d] * cur + dst[u * 32768 + ed]; }
        }
    }
    {
        const float* kmean = (const float*)(a.ws + WS_KMEAN); const bf16_t* qbr = (const bf16_t*)(a.ws + WS_QBR); unsigned* sel = (unsigned*)(a.ws + WS_SEL);
        LAS float* km = (LAS float*)lds;
        for (int u2 = blk; u2 < 256; u2 += G) {
            const int bh = u2 >> 4, qb = u2 & 15;
            __syncthreads();
            for (int i = tid; i < 2048; i += 512) km[i] = kmean[(size_t)bh * 2048 + i];
            __syncthreads();
            const int q = tid >> 1, half = tid & 1;
            float gv[8];
#pragma unroll
            for (int n = 0; n < 8; ++n) gv[n] = 0.f;
            const u32x4* qp = (const u32x4*)(qbr + ((size_t)bh * SEQ + qb * 256 + q) * 128);
#pragma unroll 4
            for (int c = 0; c < 16; ++c) { const u32x4 qq = qp[c]; float qf[8];
#pragma unroll
                for (int p = 0; p < 4; ++p) { qf[2 * p] = bflo(qq[p]); qf[2 * p + 1] = bfhi(qq[p]); }
#pragma unroll
                for (int n = 0; n < 8; ++n) { const LAS float* kr = km + (half * 8 + n) * 128 + c * 8; const f32x4 k0 = *(const LAS f32x4*)kr, k1 = *(const LAS f32x4*)(kr + 4);
                    gv[n] += (qf[0] * k0[0] + qf[1] * k0[1]) + (qf[2] * k0[2] + qf[3] * k0[3]) + (qf[4] * k1[0] + qf[5] * k1[1]) + (qf[6] * k1[2] + qf[7] * k1[3]); } }
            float ga[16];
#pragma unroll
            for (int n = 0; n < 8; ++n) { const float o = __shfl_xor(gv[n], 1); ga[n] = half ? o : gv[n]; ga[8 + n] = half ? gv[n] : o; }
            unsigned mask = 0u; const int nsel = qb < 3 ? qb : 3;
            for (int s = 0; s < nsel; ++s) { int best = -1; float bv = -INFINITY;
#pragma unroll
                for (int n = 0; n < 16; ++n) { const bool ok = (n < qb) && !((mask >> n) & 1u) && (best < 0 || ga[n] > bv); if (ok) { bv = ga[n]; best = n; } }
                mask |= 1u << best; }
            if (half == 0) sel[(size_t)bh * SEQ + qb * 256 + q] = mask;
        }
        __syncthreads();
    }
}

__device__ __forceinline__ void gla3_unit(const Args& a, LAS unsigned char* lds, int u) {
    const int tid = threadIdx.x, w = tid >> 6, lane = tid & 63, g = lane >> 4, fr = lane & 15;
    const int bh = u >> 6, c = u & 63, b = bh >> 2, h = bh & 3, row0 = b * SEQ + c * 64;
    LAS bf16_t* QP = (LAS bf16_t*)lds; LAS bf16_t* KP = (LAS bf16_t*)(lds + 17408); LAS bf16_t* VT = (LAS bf16_t*)(lds + 34816);
    LAS bf16_t* AM = (LAS bf16_t*)(lds + 71680); LAS float* RED = (LAS float*)(lds + 80896);
    const bf16_t* proj = (const bf16_t*)(a.ws + WS_PROJ); const float* bcum = (const float*)(a.ws + WS_BCUM); const bf16_t* ST = (const bf16_t*)(a.ws + WS_ST);
    bf16_t* ocat = (bf16_t*)(a.ws + WS_OCAT);
    {
        const int i = tid >> 3, seg = tid & 7;
        const f32x4* bp = (const f32x4*)(bcum + ((size_t)u * 64 + i) * 128 + seg * 16);
        const u32x4* qp = (const u32x4*)(proj + (size_t)(row0 + i) * NPROJ + C_QA + h * 128 + seg * 16);
        const u32x4* kp = (const u32x4*)(proj + (size_t)(row0 + i) * NPROJ + C_KA + h * 128 + seg * 16);
#pragma unroll
        for (int q = 0; q < 2; ++q) { const u32x4 qv = qp[q], kv = kp[q]; const f32x4 b0 = bp[2 * q], b1 = bp[2 * q + 1]; u32x4 qo, ko;
#pragma unroll
            for (int p = 0; p < 4; ++p) { const float bl = (p < 2) ? b0[2 * p] : b1[2 * p - 4], bhv = (p < 2) ? b0[2 * p + 1] : b1[2 * p - 3];
                const float el = expf(bl), eh = expf(bhv);
                qo[p] = cvt_pk_bf16(bflo(qv[p]) * el * 0.08838834764831845f, bfhi(qv[p]) * eh * 0.08838834764831845f);
                ko[p] = cvt_pk_bf16(bflo(kv[p]) / el, bfhi(kv[p]) / eh); }
            *(LAS u32x4*)(QP + i * 136 + seg * 16 + q * 8) = qo; *(LAS u32x4*)(KP + i * 136 + seg * 16 + q * 8) = ko; }
        gla_stage_vt(proj, row0, h, VT, tid);
    }
    __syncthreads();
    {
        const int it = w >> 1;
#pragma unroll
        for (int jj = 0; jj < 2; ++jj) { const int jt = (w & 1) * 2 + jj; f32x4 acc = {0.f, 0.f, 0.f, 0.f};
            if (jt <= it) {
#pragma unroll
                for (int ks = 0; ks < 4; ++ks) acc = mfma16(lds_frag(QP, 136, it * 16, ks * 32, lane), lds_frag(KP, 136, jt * 16, ks * 32, lane), acc);
            }
#pragma unroll
            for (int r = 0; r < 4; ++r) { const int i = it * 16 + 4 * g + r, j = jt * 16 + fr; AM[i * 72 + j] = f2bf((j <= i) ? acc[r] : 0.f); } }
    }
    __syncthreads();
    f32x4 acc[4][2];
    {
#pragma unroll
        for (int x = 0; x < 4; ++x)
#pragma unroll
            for (int y = 0; y < 2; ++y) acc[x][y] = (f32x4){0.f, 0.f, 0.f, 0.f};
        bf16x8 bS[2][4];
        const bf16_t* stp = ST + (size_t)u * 32768;
#pragma unroll
        for (int e2 = 0; e2 < 2; ++e2)
#pragma unroll
            for (int ks = 0; ks < 4; ++ks) bS[e2][ks] = *(const bf16x8*)(stp + ((2 * w + e2) * 16 + fr) * 128 + ks * 32 + 8 * g);
#pragma unroll
        for (int it = 0; it < 4; ++it) {
#pragma unroll
            for (int ks = 0; ks < 4; ++ks) { const bf16x8 aq = lds_frag(QP, 136, it * 16, ks * 32, lane); acc[it][0] = mfma16(aq, bS[0][ks], acc[it][0]); acc[it][1] = mfma16(aq, bS[1][ks], acc[it][1]); }
#pragma unroll
            for (int k2 = 0; k2 < 2; ++k2) { const bf16x8 aa = lds_frag(AM, 72, it * 16, k2 * 32, lane);
                acc[it][0] = mfma16(aa, lds_frag(VT, 72, (2 * w) * 16, k2 * 32, lane), acc[it][0]); acc[it][1] = mfma16(aa, lds_frag(VT, 72, (2 * w + 1) * 16, k2 * 32, lane), acc[it][1]); }
        }
#pragma unroll
        for (int it = 0; it < 4; ++it)
#pragma unroll
            for (int r = 0; r < 4; ++r) { float s = acc[it][0][r] * acc[it][0][r] + acc[it][1][r] * acc[it][1][r];
                s += __shfl_xor(s, 1); s += __shfl_xor(s, 2); s += __shfl_xor(s, 4); s += __shfl_xor(s, 8);
                if (fr == 0) RED[w * 64 + it * 16 + 4 * g + r] = s; }
    }
    __syncthreads();
    {
#pragma unroll
        for (int it = 0; it < 4; ++it)
#pragma unroll
            for (int r = 0; r < 4; ++r) { const int i = it * 16 + 4 * g + r; float tot = 0.f;
#pragma unroll
                for (int ww = 0; ww < 8; ++ww) tot += RED[ww * 64 + i];
                const float rstd = 1.0f / sqrtf(tot * (1.0f / 256.0f) + EPS);
#pragma unroll
                for (int e2 = 0; e2 < 2; ++e2) { const int e = (2 * w + e2) * 16 + fr;
                    const float ga = bf2f(proj[(size_t)(row0 + i) * NPROJ + C_GA + h * 256 + e]);
                    ocat[(size_t)(row0 + i) * DM + h * 256 + e] = f2bf(acc[it][e2][r] * rstd * a.gla_norm_w[e] * silu_f(ga)); } }
    }
    __syncthreads();
}

__device__ __forceinline__ void moba_attn_unit(const Args& a, LAS unsigned char* lds, int bh, int qb) {
    const int tid = threadIdx.x, w = tid >> 6, lane = tid & 63, g = lane >> 4, fr = lane & 15;
    const int b = bh >> 3, h = bh & 7, q0 = 32 * w;
    LAS bf16_t* Ks = (LAS bf16_t*)lds; LAS bf16_t* Vs = (LAS bf16_t*)(lds + 17408);
    const bf16_t* qbr = (const bf16_t*)(a.ws + WS_QBR); const bf16_t* kbr = (const bf16_t*)(a.ws + WS_KBR); const bf16_t* vbt = (const bf16_t*)(a.ws + WS_VBT);
    const unsigned* sel = (const unsigned*)(a.ws + WS_SEL); bf16_t* ocat = (bf16_t*)(a.ws + WS_OCAT);
    bf16x8 qf[2][4]; unsigned sm[2]; float m[2], l[2]; f32x4 O[8][2];
#pragma unroll
    for (int b2 = 0; b2 < 2; ++b2) { const size_t qrow = (size_t)bh * SEQ + qb * 256 + q0 + 16 * b2 + fr;
#pragma unroll
        for (int ks = 0; ks < 4; ++ks) qf[b2][ks] = *(const bf16x8*)(qbr + qrow * 128 + ks * 32 + 8 * g);
        sm[b2] = sel[qrow]; m[b2] = -INFINITY; l[b2] = 0.f;
#pragma unroll
        for (int dt = 0; dt < 8; ++dt) O[dt][b2] = (f32x4){0.f, 0.f, 0.f, 0.f}; }
    const float cs = 0.08838834764831845f * 1.4426950408889634f;
#pragma unroll 1
    for (int jj = 0; jj <= qb; ++jj) {
        const int j = (jj == 0) ? qb : jj - 1; const bool own = (jj == 0);
#pragma unroll 1
        for (int kt = 0; kt < 4; ++kt) {
            __syncthreads();
#pragma unroll
            for (int p = 0; p < 2; ++p) { const int cidx = tid + 512 * p;
                { const int row = cidx >> 4, cc = cidx & 15; *(LAS u32x4*)(Ks + row * 136 + cc * 8) = *(const u32x4*)(kbr + ((size_t)bh * SEQ + j * 256 + kt * 64 + row) * 128 + cc * 8); }
                { const int d = cidx >> 3, cc = cidx & 7; *(LAS u32x4*)(Vs + d * 72 + cc * 8) = *(const u32x4*)(vbt + ((size_t)bh * 128 + d) * SEQ + j * 256 + kt * 64 + cc * 8); } }
            __syncthreads();
            if (own && kt * 64 > q0 + 31) continue;
            f32x4 s[4][2];
#pragma unroll
            for (int t4 = 0; t4 < 4; ++t4) { s[t4][0] = (f32x4){0.f, 0.f, 0.f, 0.f}; s[t4][1] = (f32x4){0.f, 0.f, 0.f, 0.f};
#pragma unroll
                for (int ks = 0; ks < 4; ++ks) { const bf16x8 kf = lds_frag(Ks, 136, t4 * 16, ks * 32, lane); s[t4][0] = mfma16(kf, qf[0][ks], s[t4][0]); s[t4][1] = mfma16(kf, qf[1][ks], s[t4][1]); } }
            bf16x8 pf[2][2];
#pragma unroll
            for (int b2 = 0; b2 < 2; ++b2) {
                const int qi = q0 + 16 * b2 + fr; const bool allow_past = ((sm[b2] >> j) & 1u) != 0u;
                float tm = -INFINITY;
#pragma unroll
                for (int t4 = 0; t4 < 4; ++t4)
#pragma unroll
                    for (int r = 0; r < 4; ++r) { const int kk = kt * 64 + t4 * 16 + 4 * g + r; const bool ok = own ? (kk <= qi) : allow_past;
                        const float v = ok ? s[t4][b2][r] : -INFINITY; s[t4][b2][r] = v; tm = fmaxf(tm, v); }
                tm = fmaxf(tm, __shfl_xor(tm, 16)); tm = fmaxf(tm, __shfl_xor(tm, 32));
                const float mnew = fmaxf(m[b2], tm), msafe = (mnew == -INFINITY) ? 0.f : mnew;
                const float alpha = exp2f((m[b2] - msafe) * cs);
                float ps = 0.f;
#pragma unroll
                for (int t4 = 0; t4 < 4; ++t4)
#pragma unroll
                    for (int r = 0; r < 4; ++r) { const float p = exp2f((s[t4][b2][r] - msafe) * cs); s[t4][b2][r] = p; ps += p; }
                ps += __shfl_xor(ps, 16); ps += __shfl_xor(ps, 32);
                l[b2] = l[b2] * alpha + ps; m[b2] = mnew;
#pragma unroll
                for (int dt = 0; dt < 8; ++dt) O[dt][b2] *= alpha;
#pragma unroll
                for (int k2 = 0; k2 < 2; ++k2) { u32x4 pk; pk.x = cvt_pk_bf16(s[2 * k2][b2][0], s[2 * k2][b2][1]); pk.y = cvt_pk_bf16(s[2 * k2][b2][2], s[2 * k2][b2][3]);
                    pk.z = cvt_pk_bf16(s[2 * k2 + 1][b2][0], s[2 * k2 + 1][b2][1]); pk.w = cvt_pk_bf16(s[2 * k2 + 1][b2][2], s[2 * k2 + 1][b2][3]);
                    pf[k2][b2] = __builtin_bit_cast(bf16x8, pk); }
            }
#pragma unroll
            for (int dt = 0; dt < 8; ++dt)
#pragma unroll
                for (int k2 = 0; k2 < 2; ++k2) { const LAS bf16_t* vp = Vs + (dt * 16 + fr) * 72 + 32 * k2 + 4 * g;
                    const u32x2 lo = *(const LAS u32x2*)vp, hi = *(const LAS u32x2*)(vp + 16);
                    u32x4 vv; vv.x = lo.x; vv.y = lo.y; vv.z = hi.x; vv.w = hi.y; const bf16x8 vf = __builtin_bit_cast(bf16x8, vv);
                    O[dt][0] = mfma16(vf, pf[k2][0], O[dt][0]); O[dt][1] = mfma16(vf, pf[k2][1], O[dt][1]); }
        }
    }
#pragma unroll
    for (int b2 = 0; b2 < 2; ++b2) { const float inv = 1.0f / l[b2]; const size_t orow = (size_t)(b * SEQ + qb * 256 + q0 + 16 * b2 + fr) * DM + 1024 + h * 128;
#pragma unroll
        for (int dt = 0; dt < 8; ++dt) { u32x2 o; o.x = cvt_pk_bf16(O[dt][b2][0] * inv, O[dt][b2][1] * inv); o.y = cvt_pk_bf16(O[dt][b2][2] * inv, O[dt][b2][3] * inv);
            *(u32x2*)(ocat + orow + dt * 16 + 4 * g) = o; } }
    __syncthreads();
}
__device__ __forceinline__ void phase_mix_out(const Args& a, LAS unsigned char* lds) {
    const int blk = blockIdx.x, G = gridDim.x;
    for (int ua = blk; ua < 256; ua += G) moba_attn_unit(a, lds, ua & 15, 15 - (ua >> 4));
    for (int u = blk; u < 512; u += G) gla3_unit(a, lds, u);
}

__device__ __forceinline__ void phase_router(const Args& a, LAS unsigned char* lds) {
    const int tid = threadIdx.x, blk = blockIdx.x, G = gridDim.x, w = tid >> 6, lane = tid & 63;
    LAS float* h2s = (LAS float*)lds;
    LAS float* logit = (LAS float*)(lds + LDS_EXTRA);
    LAS int* pe = (LAS int*)(lds + LDS_EXTRA + 2048); LAS float* pw = (LAS float*)(lds + LDS_EXTRA + 2304); LAS int* lpos = (LAS int*)(lds + LDS_EXTRA + 2560);
    LAS int* hist = (LAS int*)(lds + LDS_EXTRA + 2816); LAS int* base = (LAS int*)(lds + LDS_EXTRA + 2944);
    const float* mod = (const float*)(a.ws + WS_MOD); const float* x1 = (const float*)(a.ws + WS_X1); bf16_t* h2 = (bf16_t*)(a.ws + WS_H1);
    unsigned* cnt = (unsigned*)(a.ws + WS_CNT); int* pair_e = (int*)(a.ws + WS_PAIR_E); int* pair_pos = (int*)(a.ws + WS_PAIR_POS); float* pair_w = (float*)(a.ws + WS_PAIR_W);
    for (int grp = blk; grp < 512; grp += G) {
#pragma unroll 1
        for (int tt = 0; tt < 2; ++tt) { const int tl = 2 * w + tt, t = grp * 16 + tl;
            const f32x4* xr = (const f32x4*)(x1 + (size_t)t * DM) + lane;
            f32x4 v[8]; float ss = 0.f;
#pragma unroll
            for (int q = 0; q < 8; ++q) { v[q] = xr[64 * q]; ss += (v[q][0] * v[q][0] + v[q][1] * v[q][1]) + (v[q][2] * v[q][2] + v[q][3] * v[q][3]); }
            ss = wave_sum(ss);
            const float rstd = 1.0f / sqrtf(ss * (1.0f / DM) + EPS);
            const float* sh = mod + (size_t)(t >> 12) * 12288 + 6144; const float* sc = sh + 2048;
#pragma unroll
            for (int q = 0; q < 8; ++q) { const int k = 4 * (lane + 64 * q);
                const f32x4 nw = *(const f32x4*)(a.norm2_w + k), scv = *(const f32x4*)(sc + k), shv = *(const f32x4*)(sh + k);
                const f32x4 hv = (v[q] * rstd * nw) * (scv + 1.0f) + shv;
                *(LAS f32x4*)(h2s + tl * 2048 + k) = hv;
                u32x2 o; o.x = cvt_pk_bf16(hv[0], hv[1]); o.y = cvt_pk_bf16(hv[2], hv[3]);
                *(u32x2*)(h2 + (size_t)t * DM + k) = o; } }
        if (tid < 32) hist[tid] = 0;
        __syncthreads();
        { const int tl = tid >> 5, e = tid & 31; float acc = a.b_router[e]; const float* wp = a.w_router + e;
#pragma unroll 4
            for (int k = 0; k < 2048; k += 4) { const f32x4 hv = *(const LAS f32x4*)(h2s + tl * 2048 + k);
                acc += hv[0] * wp[(size_t)k * 32]; acc += hv[1] * wp[(size_t)(k + 1) * 32]; acc += hv[2] * wp[(size_t)(k + 2) * 32]; acc += hv[3] * wp[(size_t)(k + 3) * 32]; }
            logit[tl * 32 + e] = acc; }
        __syncthreads();
        if (tid < 16) { unsigned chosen = 0u; float tv[4]; int te[4];
#pragma unroll
            for (int s = 0; s < 4; ++s) { int best = -1; float bv = -INFINITY;
                for (int e = 0; e < 32; ++e) { const float v = logit[tid * 32 + e]; if (!((chosen >> e) & 1u) && (best < 0 || v > bv)) { bv = v; best = e; } }
                chosen |= 1u << best; tv[s] = bv; te[s] = best; }
            float ex[4], den = 0.f;
#pragma unroll
            for (int s = 0; s < 4; ++s) { ex[s] = expf(tv[s] - tv[0]); den += ex[s]; }
#pragma unroll
            for (int s = 0; s < 4; ++s) { pe[tid * 4 + s] = te[s]; pw[tid * 4 + s] = ex[s] / den; } }
        __syncthreads();
        if (tid < 64) lpos[tid] = atomicAdd((int*)&hist[pe[tid]], 1);
        __syncthreads();
        if (tid < 32) { const int n = hist[tid]; base[tid] = n ? (int)atomicAdd(&cnt[tid], (unsigned)n) : 0; }
        __syncthreads();
        if (tid < 64) { const int p = grp * 64 + tid, e = pe[tid]; pair_e[p] = e; pair_pos[p] = base[e] + lpos[tid]; pair_w[p] = pw[tid]; }
        __syncthreads();
    }
}
__device__ __forceinline__ void phase_gather(const Args& a, LAS unsigned char* lds) {
    const int tid = threadIdx.x, blk = blockIdx.x, G = gridDim.x, w = tid >> 6, lane = tid & 63;
    LAS int* pstart = (LAS int*)(lds + LDS_EXTRA);
    const unsigned* cnt = (const unsigned*)(a.ws + WS_CNT);
    if (tid == 0) { int run = 0; for (int e = 0; e < 32; ++e) { pstart[e] = run; run += (int)((cnt[e] + 255u) & ~255u); } }
    __syncthreads();
    const int* pair_e = (const int*)(a.ws + WS_PAIR_E); const int* pair_pos = (const int*)(a.ws + WS_PAIR_POS); const float* pair_w = (const float*)(a.ws + WS_PAIR_W);
    int* slotrow = (int*)(a.ws + WS_SLOTROW); float* wbuf = (float*)(a.ws + WS_WBUF); const bf16_t* h2 = (const bf16_t*)(a.ws + WS_H1); bf16_t* xg = (bf16_t*)(a.ws + WS_XG);
    for (int p = blk * 8 + w; p < NTOK * TOPK; p += G * 8) {
        const int row = pstart[pair_e[p]] + pair_pos[p];
        const u32x4* sp = (const u32x4*)(h2 + (size_t)(p >> 2) * DM) + lane; u32x4* dp = (u32x4*)(xg + (size_t)row * DM) + lane;
#pragma unroll
        for (int q = 0; q < 4; ++q) dp[64 * q] = sp[64 * q];
        if (lane == 0) { wbuf[row] = pair_w[p]; slotrow[p] = row; }
    }
    __syncthreads();
}
__device__ __forceinline__ void moe_build_tab(const Args& a, LAS unsigned char* lds, int ntn) {
    LAS int* tab = (LAS int*)(lds + LDS_TAB);
    const unsigned* cnt = (const unsigned*)(a.ws + WS_CNT);
    __syncthreads();
    if (threadIdx.x == 0) { int us = 0, rs = 0; for (int e = 0; e < 32; ++e) { const int mt = (int)((cnt[e] + 255u) >> 8); tab[e] = us; tab[33 + e] = rs; us += mt * ntn; rs += mt; } tab[32] = us; tab[65] = rs; }
    __syncthreads();
}
__device__ __forceinline__ void phase_final(const Args& a, LAS unsigned char* lds) {
    const int tid = threadIdx.x, blk = blockIdx.x, G = gridDim.x, w = tid >> 6, lane = tid & 63;
    const float* mod = (const float*)(a.ws + WS_MOD); const float* x1 = (const float*)(a.ws + WS_X1); const int* slotrow = (const int*)(a.ws + WS_SLOTROW); const bf16_t* y = (const bf16_t*)(a.ws + WS_Y);
    for (int t = blk * 8 + w; t < NTOK; t += G * 8) {
        const int r0 = slotrow[t * 4], r1 = slotrow[t * 4 + 1], r2 = slotrow[t * 4 + 2], r3 = slotrow[t * 4 + 3];
        const f32x4* xr = (const f32x4*)(x1 + (size_t)t * DM) + lane;
        const u32x2* y0 = (const u32x2*)(y + (size_t)r0 * DM) + lane; const u32x2* y1 = (const u32x2*)(y + (size_t)r1 * DM) + lane;
        const u32x2* y2 = (const u32x2*)(y + (size_t)r2 * DM) + lane; const u32x2* y3 = (const u32x2*)(y + (size_t)r3 * DM) + lane;
        const float* g2 = mod + (size_t)(t >> 12) * 12288 + 10240;
        f32x4 v[8]; float ss = 0.f;
#pragma unroll
        for (int q = 0; q < 8; ++q) { const u32x2 a0 = y0[64 * q], a1 = y1[64 * q], a2 = y2[64 * q], a3 = y3[64 * q];
            f32x4 s; s[0] = (bflo(a0.x) + bflo(a1.x)) + (bflo(a2.x) + bflo(a3.x)); s[1] = (bfhi(a0.x) + bfhi(a1.x)) + (bfhi(a2.x) + bfhi(a3.x));
            s[2] = (bflo(a0.y) + bflo(a1.y)) + (bflo(a2.y) + bflo(a3.y)); s[3] = (bfhi(a0.y) + bfhi(a1.y)) + (bfhi(a2.y) + bfhi(a3.y));
            const f32x4 gv = *(const f32x4*)(g2 + 4 * (lane + 64 * q));
            v[q] = xr[64 * q] + gv * s; ss += (v[q][0] * v[q][0] + v[q][1] * v[q][1]) + (v[q][2] * v[q][2] + v[q][3] * v[q][3]); }
        ss = wave_sum(ss);
        const float rstd = 1.0f / sqrtf(ss * (1.0f / DM) + EPS);
        f32x4* op = (f32x4*)(a.out + (size_t)t * DM) + lane;
#pragma unroll
        for (int q = 0; q < 8; ++q) op[64 * q] = v[q] * rstd * *(const f32x4*)(a.final_norm_w + 4 * (lane + 64 * q));
    }
}

constexpr int NPHASE = 12;
#ifndef ONLY_PHASE
#define ONLY_PHASE -1
#endif
#define PH_ON(P) (ONLY_PHASE < 0 || ONLY_PHASE == (P))
__global__ void __launch_bounds__(512, 2) fwd(Args a) {
    extern __shared__ __attribute__((aligned(16))) unsigned char shm[];
    LAS unsigned char* lds = (LAS unsigned char*)shm;
    if (threadIdx.x == 0) *(LAS u32x4*)(lds + LDS_XB) = (u32x4){0u, 0u, 0u, 0u};
    __syncthreads();
    XcdBarrier bar = xcd_barrier_post((unsigned*)(a.ws + WS_BAR), (volatile LAS unsigned*)(lds + LDS_XB));
    const int G = gridDim.x, blk = blockIdx.x;
#define PHASE_END(P) do { if ((P) + 1 < a.ph_hi) xcd_barrier(bar); } while (0)
    if (PH_ON(0) && a.ph_lo <= 0 && 0 < a.ph_hi) { phase_prologue(a, lds); PHASE_END(0); }
    if (PH_ON(1) && a.ph_lo <= 1 && 1 < a.ph_hi) { phase_norm1(a, lds); PHASE_END(1); }
    if (PH_ON(2) && a.ph_lo <= 2 && 2 < a.ph_hi) {
        pg8::Gemm g{(const bf16_t*)(a.ws + WS_H1), (const bf16_t*)(a.ws + WS_WIN_T), DM, 0};
        pg8::StaticOrder S; S.init(NTOK, NPROJ, G, blk);
        pg8::EpiProj E{(bf16_t*)(a.ws + WS_PROJ), NPROJ};
        pg8::gemm_phase(lds, g, S, E); PHASE_END(2); }
    if (PH_ON(3) && a.ph_lo <= 3 && 3 < a.ph_hi) { phase_mix_prep(a, lds); PHASE_END(3); }
    if (PH_ON(4) && a.ph_lo <= 4 && 4 < a.ph_hi) { phase_scan_select(a, lds); PHASE_END(4); }
    if (PH_ON(5) && a.ph_lo <= 5 && 5 < a.ph_hi) { phase_mix_out(a, lds); PHASE_END(5); }
    if (PH_ON(6) && a.ph_lo <= 6 && 6 < a.ph_hi) {
        pg8::Gemm g{(const bf16_t*)(a.ws + WS_OCAT), (const bf16_t*)(a.ws + WS_WOUT_T), DM, 0};
        pg8::StaticOrder S; S.init(NTOK, DM, G, blk);
        pg8::EpiOut E{a.x, (const float*)(a.ws + WS_MOD) + 4096, (float*)(a.ws + WS_X1)};
        pg8::gemm_phase(lds, g, S, E); PHASE_END(6); }
    if (PH_ON(7) && a.ph_lo <= 7 && 7 < a.ph_hi) { phase_router(a, lds); PHASE_END(7); }
    if (PH_ON(8) && a.ph_lo <= 8 && 8 < a.ph_hi) { phase_gather(a, lds); PHASE_END(8); }
    if (PH_ON(9) && a.ph_lo <= 9 && 9 < a.ph_hi) {
        moe_build_tab(a, lds, 16);
        pg8::Gemm g{(const bf16_t*)(a.ws + WS_XG), (const bf16_t*)(a.ws + WS_WGU_T), DM, (size_t)4096 * 2048};
        pg8::MoeOrder S{(const LAS int*)(lds + LDS_TAB), G, blk};
        pg8::EpiGU E{a.b_gate_up, (bf16_t*)(a.ws + WS_ACT)};
        pg8::gemm_phase(lds, g, S, E); PHASE_END(9); }
    if (PH_ON(10) && a.ph_lo <= 10 && 10 < a.ph_hi) {
        moe_build_tab(a, lds, 8);
        pg8::Gemm g{(const bf16_t*)(a.ws + WS_ACT), (const bf16_t*)(a.ws + WS_WD_T), DM, (size_t)2048 * 2048};
        pg8::MoeOrder S{(const LAS int*)(lds + LDS_TAB), G, blk};
        pg8::EpiDown E{a.b_down, (const float*)(a.ws + WS_WBUF), (bf16_t*)(a.ws + WS_Y)};
        pg8::gemm_phase(lds, g, S, E); PHASE_END(10); }
    if (PH_ON(11) && a.ph_lo <= 11 && 11 < a.ph_hi) { phase_final(a, lds); }
}

#ifndef N_LAUNCHES
#define N_LAUNCHES 1
#endif
extern "C" void kernel_launch(void* const* d_in, const int* in_sizes, int n_in, void* d_out, int out_size, void* d_ws, size_t ws_size, hipStream_t stream) {
    static int grid = 0;
    if (grid == 0) {
        if (n_in != 18 || out_size != NTOK * DM || ws_size < WS_END) { fprintf(stderr, "kernel_launch: unexpected shapes (n_in %d out %d ws %zu, need %zu)\n", n_in, out_size, ws_size, (size_t)WS_END); grid = -1; return; }
        int dev = 0, cus = 0, per_cu = 0;
        if (hipGetDevice(&dev) != hipSuccess || hipDeviceGetAttribute(&cus, hipDeviceAttributeMultiprocessorCount, dev) != hipSuccess) { grid = -1; return; }
        if (hipFuncSetAttribute((const void*)fwd, hipFuncAttributeMaxDynamicSharedMemorySize, LDS_BYTES) != hipSuccess) { fprintf(stderr, "kernel_launch: hipFuncSetAttribute failed\n"); grid = -1; return; }
        if (hipOccupancyMaxActiveBlocksPerMultiprocessor(&per_cu, (const void*)fwd, 512, LDS_BYTES) != hipSuccess || per_cu < 1) fprintf(stderr, "kernel_launch: occupancy query says %d\n", per_cu);
        (void)hipGetLastError();
        grid = cus;
    }
    if (grid < 0) return;
    (void)hipMemsetAsync(d_ws, 0, WS_ZERO_BYTES, stream);
    Args a{};
    a.x = (const float*)d_in[0]; a.c = (const float*)d_in[1]; a.w_ada = (const float*)d_in[2]; a.b_ada = (const float*)d_in[3]; a.norm1_w = (const float*)d_in[4];
    a.w_in = (const float*)d_in[5]; a.w_alpha2 = (const float*)d_in[6]; a.b_alpha = (const float*)d_in[7]; a.gla_norm_w = (const float*)d_in[8]; a.w_out = (const float*)d_in[9];
    a.norm2_w = (const float*)d_in[10]; a.w_router = (const float*)d_in[11]; a.b_router = (const float*)d_in[12]; a.w_gate_up = (const float*)d_in[13]; a.b_gate_up = (const float*)d_in[14];
    a.w_down = (const float*)d_in[15]; a.b_down = (const float*)d_in[16]; a.final_norm_w = (const float*)d_in[17];
    a.out = (float*)d_out; a.ws = (unsigned char*)d_ws;
    if (N_LAUNCHES == 1) { a.ph_lo = 0; a.ph_hi = NPHASE; hipLaunchKernelGGL(fwd, dim3(grid), dim3(512), LDS_BYTES, stream, a); }
    else for (int p = 0; p < NPHASE; ++p) { a.ph_lo = p; a.ph_hi = p + 1; hipLaunchKernelGGL(fwd, dim3(grid), dim3(512), LDS_BYTES, stream, a); }
}
```

```cpp
#include <hip/hip_runtime.h>
#include <stdint.h>
#include <stdio.h>

#define LAS __attribute__((address_space(3)))
typedef unsigned short bf16_t;
typedef short bf16x8 __attribute__((ext_vector_type(8)));
typedef float f32x4 __attribute__((ext_vector_type(4)));
typedef float f32x2 __attribute__((ext_vector_type(2)));
typedef unsigned u32x4 __attribute__((ext_vector_type(4)));
typedef unsigned u32x2 __attribute__((ext_vector_type(2)));

constexpr int DM = 2048, NBATCH = 2, SEQ = 4096, NTOK = 8192;
constexpr int DIN = 6160, NPROJ = 6144;
constexpr int NE = 32, TOPK = 4;
constexpr int C_QA = 0, C_KA = 512, C_VA = 1024, C_GA = 2048, C_QB = 3072, C_KB = 4096, C_VB = 5120;
constexpr int MAXROWS = 40960;
constexpr float EPS = 1e-6f;

constexpr size_t MB = 1024ull * 1024ull;
constexpr size_t WS_BAR = 0;
constexpr size_t WS_CNT = 16384;
constexpr size_t WS_ZERO_BYTES = 20480;
constexpr size_t WS_MOD = 32768;
constexpr size_t WS_ROPE = 1 * MB;
constexpr size_t WS_H1 = 3 * MB;
constexpr size_t WS_GK = WS_H1 + 32 * MB;
constexpr size_t WS_PROJ = WS_GK + 16 * MB;
constexpr size_t WS_WIN_T = WS_PROJ + 96 * MB;
constexpr size_t WS_WOUT_T = WS_WIN_T + 24 * MB;
constexpr size_t WS_WGU_T = WS_WOUT_T + 8 * MB;
constexpr size_t WS_WD_T = WS_WGU_T + 512 * MB;
constexpr size_t WS_BCUM = WS_WD_T + 256 * MB;
constexpr size_t WS_DST = WS_BCUM + 16 * MB;
constexpr size_t WS_DEC = WS_DST + 64 * MB;
constexpr size_t WS_ST = WS_DEC + 1 * MB;
constexpr size_t WS_QBR = WS_ST + 32 * MB;
constexpr size_t WS_KBR = WS_QBR + 16 * MB;
constexpr size_t WS_VBT = WS_KBR + 16 * MB;
constexpr size_t WS_KMEAN = WS_VBT + 16 * MB;
constexpr size_t WS_SEL = WS_KMEAN + 1 * MB;
constexpr size_t WS_OCAT = WS_SEL + 1 * MB;
constexpr size_t WS_X1 = WS_OCAT + 32 * MB;
constexpr size_t WS_PAIR_E = WS_X1 + 64 * MB;
constexpr size_t WS_PAIR_POS = WS_PAIR_E + 1 * MB;
constexpr size_t WS_PAIR_W = WS_PAIR_POS + 1 * MB;
constexpr size_t WS_SLOTROW = WS_PAIR_W + 1 * MB;
constexpr size_t WS_WBUF = WS_SLOTROW + 1 * MB;
constexpr size_t WS_XG = WS_WBUF + 1 * MB;
constexpr size_t WS_ACT = WS_XG + 160 * MB;
constexpr size_t WS_Y = WS_ACT + 160 * MB;
constexpr size_t WS_END = WS_Y + 160 * MB;

constexpr int LDS_BYTES = 147456;
constexpr int LDS_XB = 131072;
constexpr int LDS_TAB = 131072 + 64;
constexpr int LDS_EXTRA = 131072 + 1024;

struct Args {
    const float* x; const float* c; const float* w_ada; const float* b_ada; const float* norm1_w; const float* w_in; const float* w_alpha2; const float* b_alpha;
    const float* gla_norm_w; const float* w_out; const float* norm2_w; const float* w_router; const float* b_router; const float* w_gate_up; const float* b_gate_up;
    const float* w_down; const float* b_down; const float* final_norm_w;
    float* out; unsigned char* ws;
    int ph_lo, ph_hi;
};

__device__ __forceinline__ unsigned cvt_pk_bf16(float lo, float hi) { unsigned r; asm("v_cvt_pk_bf16_f32 %0, %1, %2" : "=v"(r) : "v"(lo), "v"(hi)); return r; }
__device__ __forceinline__ bf16_t f2bf(float f) { return (bf16_t)(cvt_pk_bf16(f, 0.f) & 0xffffu); }
__device__ __forceinline__ float bf2f(bf16_t b) { return __uint_as_float(((unsigned)b) << 16); }
__device__ __forceinline__ float bflo(unsigned w) { return __uint_as_float(w << 16); }
__device__ __forceinline__ float bfhi(unsigned w) { return __uint_as_float(w & 0xffff0000u); }
__device__ __forceinline__ float wave_sum(float v) {
#pragma unroll
    for (int o = 1; o < 64; o <<= 1) v += __shfl_xor(v, o);
    return v;
}
__device__ __forceinline__ float silu_f(float v) { return v / (1.f + expf(-v)); }
__device__ __forceinline__ f32x4 mfma16(bf16x8 a, bf16x8 b, f32x4 c) { return __builtin_amdgcn_mfma_f32_16x16x32_bf16(a, b, c, 0, 0, 0); }
__device__ __forceinline__ bf16x8 lds_frag(const LAS bf16_t* img, int ld, int r0, int k0, int lane) {
    return *(const LAS bf16x8*)(img + (r0 + (lane & 15)) * ld + k0 + 8 * (lane >> 4));
}

#define XB_TMO      128
#define XB_XCNT(j)  (256  + 64 * (j))
#define XB_XSUB(j)  (1280 + 64 * (j))
#define XB_XGEN(j)  (2304 + 64 * (j))
#define XB_TOP      3328
#define XB_TOPGEN   3392
#define XCD_BAR_WORDS 3456
#define XB_SPIN_CAP (1u << 18)
__device__ __forceinline__ unsigned xb_ld(unsigned* p)              { return __hip_atomic_load(p, __ATOMIC_RELAXED, __HIP_MEMORY_SCOPE_AGENT); }
__device__ __forceinline__ unsigned xb_add(unsigned* p, unsigned v) { return __hip_atomic_fetch_add(p, v, __ATOMIC_RELAXED, __HIP_MEMORY_SCOPE_AGENT); }
__device__ __forceinline__ unsigned xb_xcc_id() { return (unsigned)__builtin_amdgcn_s_getreg((3 << 11) | 20) & 0xFu; }
#define XB_SPIN(cond, bar) do { unsigned _sp = 0; while (cond) { __builtin_amdgcn_s_sleep(1); \
    if ((++_sp & 255u) == 0u) { if (xb_ld(&(bar)[XB_TMO])) break; if (_sp > XB_SPIN_CAP) { atomicAdd(&(bar)[XB_TMO], 1u); break; } } } } while (0)
struct XcdBarrier { unsigned* bar; unsigned x; volatile LAS unsigned* st; };
__device__ __forceinline__ XcdBarrier xcd_barrier_post(unsigned* bar, volatile LAS unsigned* st) {
    XcdBarrier b; b.bar = bar; b.x = xb_xcc_id(); b.st = st;
    if (threadIdx.x == 0) (void)xb_add(&bar[XB_XCNT(b.x)], 1u);
    return b;
}
__device__ __forceinline__ void xcd_barrier_complete(unsigned* bar, unsigned x, unsigned& nloc, unsigned& nx) {
    const unsigned G = gridDim.x * gridDim.y * gridDim.z;
    unsigned sum, cnt, mine, sp = 0u;
    for (;;) {
        sum = 0u; cnt = 0u; mine = 0u;
#pragma unroll
        for (unsigned j = 0; j < 16; ++j) { const unsigned c = xb_ld(&bar[XB_XCNT(j)]); sum += c; cnt += (c > 0u) ? 1u : 0u; mine = (j == x) ? c : mine; }
        if (sum == G) break;
        __builtin_amdgcn_s_sleep(1);
        if ((++sp & 255u) == 0u) { if (xb_ld(&bar[XB_TMO])) break; if (sp > XB_SPIN_CAP) { atomicAdd(&bar[XB_TMO], 1u); break; } }
    }
    nloc = mine > 0u ? mine : 1u; nx = cnt > 0u ? cnt : 1u;
}
__device__ __forceinline__ void xcd_barrier(const XcdBarrier& b) {
    asm volatile("s_waitcnt vmcnt(0)" ::: "memory");
    __syncthreads();
    if (threadIdx.x == 0) {
        unsigned* bar = b.bar;
        __builtin_amdgcn_s_waitcnt(0);
        unsigned nloc = b.st[0], nx = b.st[1];
        if (nloc == 0u) { xcd_barrier_complete(bar, b.x, nloc, nx); b.st[0] = nloc; b.st[1] = nx; }
        const unsigned old = xb_add(&bar[XB_XSUB(b.x)], 1u);
        const unsigned gen = old / nloc;
        if (old + 1u == (gen + 1u) * nloc) {
            __builtin_amdgcn_fence(__ATOMIC_RELEASE, "agent");
            asm volatile("s_waitcnt vmcnt(0)" ::: "memory");
            const unsigned og = xb_add(&bar[XB_TOP], 1u);
            const unsigned tg = og / nx;
            if (og + 1u == (tg + 1u) * nx) xb_add(&bar[XB_TOPGEN], 1u);
            else XB_SPIN(xb_ld(&bar[XB_TOPGEN]) == tg, bar);
            __builtin_amdgcn_fence(__ATOMIC_ACQUIRE, "agent");
            xb_add(&bar[XB_XGEN(b.x)], 1u);
            asm volatile("s_waitcnt vmcnt(0)" ::: "memory");
        } else {
            XB_SPIN(xb_ld(&bar[XB_XGEN(b.x)]) == gen, bar);
            __builtin_amdgcn_fence(__ATOMIC_ACQUIRE, "agent");
            asm volatile("s_waitcnt vmcnt(0)" ::: "memory");
        }
    }
    __syncthreads();
}

namespace pg8 {
constexpr int BM = 256, BK = 64, HALF = 128, HTB = HALF * BK * 2, STAGE_BYTES = 8 * HTB, NXCD = 8, WGM = 8;
__host__ __device__ __forceinline__ int lds_byte(int r, int c) { const int st = (r >> 4) * 2 + (c >> 5), rr = r & 15, cc = c & 31, ob = rr * 64 + cc * 2; return st * 1024 + (ob ^ (((ob >> 9) & 1) << 5)); }
__host__ __device__ __forceinline__ void stage_rc(int b, int& R, int& C) { const int st = b / 1024, sb = b % 1024, swz = sb ^ (((sb >> 9) & 1) << 5); R = (st >> 1) * 16 + swz / 64; C = (st & 1) * 32 + (swz % 64) / 2; }
__host__ __device__ __forceinline__ int perm32(int rho) { const int n = rho >> 4, i = rho & 15; return 8 * (i >> 2) + 4 * n + (i & 3); }

struct Unit { int pm, pn, e, full; };
struct Gemm { const bf16_t* A; const bf16_t* Bt; int K; size_t b_estride; };

struct StaticOrder {
    int nM, nN, nwg, G, c;
    __device__ void init(int M, int N, int G_, int c_) { nM = M / BM; nN = N / BM; nwg = nM * nN; G = G_; c = c_; }
    __device__ bool next(int i, Unit& u) const {
        const long L = (long)i * G + c; if (L >= nwg) return false;
        int wgid = (int)L; { const int q = nwg / NXCD, r = nwg % NXCD, xcd = wgid % NXCD, off = wgid / NXCD; wgid = (xcd < r ? xcd * (q + 1) : r * (q + 1) + (xcd - r) * q) + off; }
        const int nig = WGM * nN, gid = wgid / nig, fm = gid * WGM, gsz = (nM - fm) < WGM ? (nM - fm) : WGM;
        u.pm = fm + ((wgid % nig) % gsz); u.pn = (wgid % nig) / gsz; u.e = 0; u.full = 1; return true;
    }
};
struct MoeOrder {
    const LAS int* tab; int r, nper;
    __device__ bool next(int i, Unit& u) const {
        const int L = i * nper + r; if (L >= tab[1]) return false;
        int p = 0; const int np = tab[0];
#pragma unroll 1
        while (p + 1 < np && tab[4 + 8 * (p + 1)] <= L) ++p;
        const LAS int* t = tab + 4 + 8 * p;
        const int local = L - t[0], mte = t[3], pq = local / mte, mt = local - pq * mte;
        u.e = t[1]; u.pn = t[2] + pq; u.pm = t[4] + mt; u.full = (t[5] - mt * 256) > 128 ? 1 : 0; return true;
    }
};

struct EpiProj {
    static constexpr bool PERM = true;
    bf16_t* O; int ldc;
    __device__ __forceinline__ void operator()(const f32x4 (&acc)[2][2][4][2], const Unit& u, int wr, int wc, int fr, int fq) const {
        const int row0 = u.pm * BM + wr * 64 + fr, col0 = u.pn * BM + wc * 32 + 8 * fq;
#pragma unroll
        for (int ai = 0; ai < 2; ++ai)
#pragma unroll
            for (int m = 0; m < 4; ++m) { bf16_t* rowp = O + (size_t)(row0 + ai * HALF + m * 16) * ldc + col0;
#pragma unroll
                for (int bj = 0; bj < 2; ++bj) { const f32x4 v0 = acc[ai][bj][m][0], v1 = acc[ai][bj][m][1];
                    u32x4 w; w.x = cvt_pk_bf16(v0[0], v0[1]); w.y = cvt_pk_bf16(v0[2], v0[3]); w.z = cvt_pk_bf16(v1[0], v1[1]); w.w = cvt_pk_bf16(v1[2], v1[3]);
                    *(u32x4*)(rowp + bj * HALF) = w; } }
    }
};
struct EpiOut {
    static constexpr bool PERM = false;
    const float* X; const float* g1;   float* O;
    __device__ __forceinline__ void operator()(const f32x4 (&acc)[2][2][4][2], const Unit& u, int wr, int wc, int fr, int fq) const {
        const int row0 = u.pm * BM + wr * 64 + fr, col0 = u.pn * BM + wc * 32 + 4 * fq;
        const float* gp = g1 + (size_t)((u.pm * BM) >> 12) * 12288 + col0;
        f32x4 gv[2][2];
#pragma unroll
        for (int bj = 0; bj < 2; ++bj)
#pragma unroll
            for (int n = 0; n < 2; ++n) gv[bj][n] = *(const f32x4*)(gp + bj * HALF + n * 16);
#pragma unroll
        for (int ai = 0; ai < 2; ++ai)
#pragma unroll
            for (int m = 0; m < 4; ++m) { const size_t off = (size_t)(row0 + ai * HALF + m * 16) * DM + col0;
#pragma unroll
                for (int bj = 0; bj < 2; ++bj)
#pragma unroll
                    for (int n = 0; n < 2; ++n) { const f32x4 xv = *(const f32x4*)(X + off + bj * HALF + n * 16);
                        *(f32x4*)(O + off + bj * HALF + n * 16) = xv + gv[bj][n] * acc[ai][bj][m][n]; }
                asm volatile("" ::: "memory"); }
    }
};
struct EpiGU {
    static constexpr bool PERM = true;
    const float* bias;   bf16_t* O;
    __device__ __forceinline__ void operator()(const f32x4 (&acc)[2][2][4][2], const Unit& u, int wr, int wc, int fr, int fq) const {
        const int row0 = u.pm * BM + wr * 64 + fr, cc = u.pn * HALF + wc * 32 + 8 * fq;
        const float* bp = bias + (size_t)u.e * 4096 + cc;
        f32x4 bg[2], bu[2];
#pragma unroll
        for (int n = 0; n < 2; ++n) { bg[n] = *(const f32x4*)(bp + 4 * n); bu[n] = *(const f32x4*)(bp + 2048 + 4 * n); }
#pragma unroll
        for (int ai = 0; ai < 2; ++ai)
#pragma unroll
            for (int m = 0; m < 4; ++m) { float r[8];
#pragma unroll
                for (int n = 0; n < 2; ++n)
#pragma unroll
                    for (int j = 0; j < 4; ++j) {
                        float g = acc[ai][0][m][n][j] + bg[n][j], uu = acc[ai][1][m][n][j] + bu[n][j];
                        g = fminf(g, 7.0f); uu = fminf(fmaxf(uu, -7.0f), 7.0f);
                        const float glu = g * __builtin_amdgcn_rcpf(1.0f + __expf(-1.702f * g));
                        r[n * 4 + j] = (uu + 1.0f) * glu; }
                u32x4 w; w.x = cvt_pk_bf16(r[0], r[1]); w.y = cvt_pk_bf16(r[2], r[3]); w.z = cvt_pk_bf16(r[4], r[5]); w.w = cvt_pk_bf16(r[6], r[7]);
                *(u32x4*)(O + (size_t)(row0 + ai * HALF + m * 16) * DM + cc) = w; }
    }
};
struct EpiDown {
    static constexpr bool PERM = true;
    const float* bias;   const float* wbuf; bf16_t* O;
    __device__ __forceinline__ void operator()(const f32x4 (&acc)[2][2][4][2], const Unit& u, int wr, int wc, int fr, int fq) const {
        const int row0 = u.pm * BM + wr * 64 + fr, col0 = u.pn * BM + wc * 32 + 8 * fq;
        const float* bp = bias + (size_t)u.e * 2048 + col0;
        f32x4 bv[2][2];
#pragma unroll
        for (int bj = 0; bj < 2; ++bj)
#pragma unroll
            for (int n = 0; n < 2; ++n) bv[bj][n] = *(const f32x4*)(bp + bj * HALF + 4 * n);
#pragma unroll
        for (int ai = 0; ai < 2; ++ai)
#pragma unroll
            for (int m = 0; m < 4; ++m) { const int row = row0 + ai * HALF + m * 16; const float rw = wbuf[row]; bf16_t* rowp = O + (size_t)row * DM + col0;
#pragma unroll
                for (int bj = 0; bj < 2; ++bj) { const f32x4 v0 = (acc[ai][bj][m][0] + bv[bj][0]) * rw, v1 = (acc[ai][bj][m][1] + bv[bj][1]) * rw;
                    u32x4 w; w.x = cvt_pk_bf16(v0[0], v0[1]); w.y = cvt_pk_bf16(v0[2], v0[3]); w.z = cvt_pk_bf16(v1[0], v1[1]); w.w = cvt_pk_bf16(v1[2], v1[3]);
                    *(u32x4*)(rowp + bj * HALF) = w; } }
    }
};

template <class Epi, class Sched>
__device__ __forceinline__ void gemm_phase(LAS unsigned char* lds, const Gemm g, const Sched& S, const Epi& E) {
    const int tid = threadIdx.x, wid = __builtin_amdgcn_readfirstlane(tid >> 6), lane = tid & 63, wr = wid >> 2, wc = wid & 3, fr = lane & 15, fq = lane >> 4;
    const int K = g.K, nt = K / BK;
    unsigned voffA[2], voffB[2];
#pragma unroll
    for (int i = 0; i < 2; ++i) { int R, C; stage_rc(tid * 16 + i * 8192, R, C); const int Rb = Epi::PERM ? ((R & ~31) + perm32(R & 31)) : R;
        voffA[i] = (unsigned)(R * K + C) * 2u; voffB[i] = (unsigned)(Rb * K + C) * 2u; }
    const size_t kstep = (size_t)(BK * 2);
    const size_t hstep = (size_t)HALF * K * 2;
    const size_t tstep = 2 * hstep;
    const size_t estep = g.b_estride * 2;
    const unsigned ldsw = (unsigned)wid * 1024u;
    const int aoff = lds_byte(wr * 64 + fr, fq * 8), boff = lds_byte(wc * 32 + fr, fq * 8);
#define PG8_SA(b, h) (((b) * 2 + (h)) * HTB)
#define PG8_SB(b, h) ((4 + (b) * 2 + (h)) * HTB)
#define PG8_STAGE(bufoff, gbase, voff) do { _Pragma("unroll") for (int _i = 0; _i < 2; ++_i) \
        __builtin_amdgcn_global_load_lds((const unsigned*)((const char*)(gbase) + (voff)[_i]), (LAS unsigned*)(lds + (bufoff) + ldsw + _i * 8192), 16, 0, 0); } while (0)
#define PG8_LDA(dst, b, h) do { _Pragma("unroll") for (int m = 0; m < 4; ++m) _Pragma("unroll") for (int k = 0; k < 2; ++k) dst[m][k] = *(const LAS bf16x8*)(lds + PG8_SA(b, h) + aoff + m * 2048 + k * 1024); } while (0)
#define PG8_LDB(dst, b, h) do { _Pragma("unroll") for (int n = 0; n < 2; ++n) _Pragma("unroll") for (int k = 0; k < 2; ++k) dst[n][k] = *(const LAS bf16x8*)(lds + PG8_SB(b, h) + boff + n * 2048 + k * 1024); } while (0)
#define PG8_MMA(ai, bj, At, Bt) do { __builtin_amdgcn_s_setprio(1); _Pragma("unroll") for (int m = 0; m < 4; ++m) _Pragma("unroll") for (int n = 0; n < 2; ++n) _Pragma("unroll") for (int k = 0; k < 2; ++k) \
        acc[ai][bj][m][n] = __builtin_amdgcn_mfma_f32_16x16x32_bf16(Bt[n][k], At[m][k], acc[ai][bj][m][n], 0, 0, 0); __builtin_amdgcn_s_setprio(0); } while (0)
#define PG8_WAIT_V(n) asm volatile("s_waitcnt vmcnt(" #n ")" ::: "memory")
#define PG8_WAIT_L(n) asm volatile("s_waitcnt lgkmcnt(" #n ")" ::: "memory")
#define PG8_BAR __builtin_amdgcn_s_barrier()
#define PG8_SCHED __builtin_amdgcn_sched_barrier(0)
    Unit cur, nxt; int ui = 0;
    if (!S.next(0, cur)) return;
    f32x4 acc[2][2][4][2];
#pragma unroll
    for (int a = 0; a < 2; ++a)
#pragma unroll
        for (int b = 0; b < 2; ++b)
#pragma unroll
            for (int m = 0; m < 4; ++m)
#pragma unroll
                for (int n = 0; n < 2; ++n) acc[a][b][m][n] = (f32x4){0.f, 0.f, 0.f, 0.f};
    bf16x8 At[4][2], B0[2][2], B1[2][2];
    const char* cA = (const char*)g.A + (size_t)cur.pm * tstep; const char* cB = (const char*)g.Bt + (size_t)cur.e * estep + (size_t)cur.pn * tstep;
    PG8_STAGE(PG8_SB(0, 0), cB, voffB); PG8_STAGE(PG8_SA(0, 0), cA, voffA); PG8_STAGE(PG8_SB(0, 1), cB + hstep, voffB); PG8_STAGE(PG8_SA(0, 1), cA + hstep, voffA);
    if (wr == 1) PG8_BAR;
    PG8_WAIT_V(4); PG8_BAR;
    PG8_STAGE(PG8_SB(1, 0), cB + kstep, voffB); PG8_STAGE(PG8_SA(1, 0), cA + kstep, voffA); PG8_STAGE(PG8_SB(1, 1), cB + hstep + kstep, voffB);
    PG8_WAIT_V(6); PG8_BAR;
    for (;;) {
        const bool has_next = S.next(ui + 1, nxt);
        const bool cfull = cur.full != 0;
        const char* nA = has_next ? (const char*)g.A + (size_t)nxt.pm * tstep : cA;
        const char* nB = has_next ? (const char*)g.Bt + (size_t)nxt.e * estep + (size_t)nxt.pn * tstep : cB;
        for (int t = 0; t < nt; t += 2) {
            const bool last = (t == nt - 2);
            const char* a1 = cA + (size_t)(t + 1) * kstep;
            const char* a2 = last ? nA : cA + (size_t)(t + 2) * kstep; const char* b2 = last ? nB : cB + (size_t)(t + 2) * kstep;
            const char* a3 = a2 + kstep; const char* b3 = b2 + kstep;
            PG8_LDB(B0, 0, 0); PG8_SCHED; PG8_LDA(At, 0, 0); PG8_STAGE(PG8_SA(1, 1), a1 + hstep, voffA);
            PG8_WAIT_L(8); PG8_BAR; PG8_WAIT_L(0); PG8_MMA(0, 0, At, B0); PG8_BAR; PG8_SCHED;
            PG8_LDB(B1, 0, 1); PG8_STAGE(PG8_SB(0, 0), b2, voffB);
            PG8_BAR; PG8_WAIT_L(0); PG8_MMA(0, 1, At, B1); PG8_BAR;
            PG8_LDA(At, 0, 1); PG8_STAGE(PG8_SA(0, 0), a2, voffA);
            PG8_BAR; PG8_WAIT_L(0); if (cfull) PG8_MMA(1, 0, At, B0); PG8_BAR; PG8_SCHED;
            PG8_STAGE(PG8_SB(0, 1), b2 + hstep, voffB);
            PG8_WAIT_V(6); PG8_BAR; if (cfull) PG8_MMA(1, 1, At, B1); PG8_BAR;
            PG8_LDB(B0, 1, 0); PG8_SCHED; PG8_LDA(At, 1, 0); PG8_STAGE(PG8_SA(0, 1), a2 + hstep, voffA);
            PG8_WAIT_L(8); PG8_BAR; PG8_WAIT_L(0); PG8_MMA(0, 0, At, B0); PG8_BAR; PG8_SCHED;
            PG8_LDB(B1, 1, 1); PG8_STAGE(PG8_SB(1, 0), b3, voffB);
            PG8_BAR; PG8_WAIT_L(0); PG8_MMA(0, 1, At, B1); PG8_BAR;
            PG8_LDA(At, 1, 1); PG8_STAGE(PG8_SA(1, 0), a3, voffA);
            PG8_BAR; PG8_WAIT_L(0); if (cfull) PG8_MMA(1, 0, At, B0); PG8_BAR; PG8_SCHED;
            PG8_STAGE(PG8_SB(1, 1), b3 + hstep, voffB);
            PG8_WAIT_V(6); PG8_BAR; if (cfull) PG8_MMA(1, 1, At, B1); PG8_BAR;
        }
        E(acc, cur, wr, wc, fr, fq);
        if (!has_next) break;
#pragma unroll
        for (int a = 0; a < 2; ++a)
#pragma unroll
            for (int b = 0; b < 2; ++b)
#pragma unroll
                for (int m = 0; m < 4; ++m)
#pragma unroll
                    for (int n = 0; n < 2; ++n) acc[a][b][m][n] = (f32x4){0.f, 0.f, 0.f, 0.f};
        cur = nxt; cA = nA; cB = nB; ++ui;
    }
    PG8_WAIT_V(0);
    if (wr == 0) PG8_BAR;
    PG8_BAR;
#undef PG8_SA
#undef PG8_SB
#undef PG8_STAGE
#undef PG8_LDA
#undef PG8_LDB
#undef PG8_MMA
#undef PG8_WAIT_V
#undef PG8_WAIT_L
#undef PG8_BAR
#undef PG8_SCHED
}
}

__device__ __forceinline__ void conv_job(const float* src, int ld, bf16_t* dst, int kt) {
    const int w = threadIdx.x >> 6, lane = threadIdx.x & 63, kseg = lane & 7, nq = lane >> 3;
    const int k0 = kt * 128 + (w >> 2) * 64 + kseg * 8, nl = (w & 3) * 32 + nq * 4;
    f32x4 v[8];
#pragma unroll
    for (int r = 0; r < 8; ++r) v[r] = *(const f32x4*)(src + (size_t)(k0 + r) * ld + nl);
#pragma unroll
    for (int j = 0; j < 4; ++j) { u32x4 o; o.x = cvt_pk_bf16(v[0][j], v[1][j]); o.y = cvt_pk_bf16(v[2][j], v[3][j]); o.z = cvt_pk_bf16(v[4][j], v[5][j]); o.w = cvt_pk_bf16(v[6][j], v[7][j]);
        *(u32x4*)(dst + (size_t)(nl + j) * 2048 + k0) = o; }
}
__device__ __forceinline__ void phase_prologue(const Args& a, LAS unsigned char* lds) {
    const int tid = threadIdx.x, blk = blockIdx.x, G = gridDim.x;
    if (blk < 192) {
        LAS float* cact = (LAS float*)lds; LAS float* red = (LAS float*)(lds + 16384);
        for (int i = tid; i < 4096; i += 512) cact[i] = silu_f(a.c[i]);
        __syncthreads();
        float* mod = (float*)(a.ws + WS_MOD);
        for (int cb = blk; cb < 192; cb += G) {
            const int rg = tid >> 4, cl = tid & 15;
            const float* wp = a.w_ada + (size_t)cb * 64 + cl * 4;
            f32x4 a0 = {0.f, 0.f, 0.f, 0.f}, a1 = {0.f, 0.f, 0.f, 0.f};
#pragma unroll 8
            for (int i = 0; i < 64; ++i) { const int k = rg + 32 * i; const f32x4 w = *(const f32x4*)(wp + (size_t)k * 12288); a0 += w * cact[k]; a1 += w * cact[2048 + k]; }
#pragma unroll
            for (int j = 0; j < 4; ++j) { red[(rg * 2 + 0) * 64 + cl * 4 + j] = a0[j]; red[(rg * 2 + 1) * 64 + cl * 4 + j] = a1[j]; }
            __syncthreads();
            if (tid < 128) { const int b = tid >> 6, col = tid & 63; float s = 0.f; for (int r = 0; r < 32; ++r) s += red[(r * 2 + b) * 64 + col]; mod[b * 12288 + cb * 64 + col] = s + a.b_ada[cb * 64 + col]; }
            __syncthreads();
        }
    }
    {
        float* ct = (float*)(a.ws + WS_ROPE); float* st = ct + 4096 * 64;
        for (int idx = blk * 512 + tid; idx < 4096 * 64; idx += G * 512) {
            const int t = idx >> 6, i = idx & 63;
            const float inv = (float)exp2(-(double)i * (13.287712379549449 / 64.0));
            const float ang = (float)t * inv;
            const double ad = (double)ang, n = rint(ad * 0.15915494309189535), r = fma(-n, 6.283185307179586, ad) - n * 2.4492935982947064e-16;
            const float rf = (float)r;
            ct[idx] = cosf(rf); st[idx] = sinf(rf);
        }
    }
    {
        bf16_t* win_t = (bf16_t*)(a.ws + WS_WIN_T); bf16_t* wout_t = (bf16_t*)(a.ws + WS_WOUT_T); bf16_t* wgu_t = (bf16_t*)(a.ws + WS_WGU_T); bf16_t* wd_t = (bf16_t*)(a.ws + WS_WD_T);
        for (int job = blk; job < 1600 * 16; job += G) {
            const int rt = job >> 4, kt = job & 15;
            const float* src; int ld; bf16_t* dst;
            if (rt < 48) { const int n0 = rt * 128, col0 = n0 < 3072 ? n0 : n0 + 16; src = a.w_in + col0; ld = DIN; dst = win_t + (size_t)n0 * 2048; }
            else if (rt < 64) { const int n0 = (rt - 48) * 128; src = a.w_out + n0; ld = 2048; dst = wout_t + (size_t)n0 * 2048; }
            else if (rt < 1088) { const int idx = rt - 64, e = idx >> 5, r = idx & 31, pn = r >> 1, bj = r & 1; src = a.w_gate_up + (size_t)e * 2048 * 4096 + bj * 2048 + pn * 128; ld = 4096; dst = wgu_t + ((size_t)e * 4096 + r * 128) * 2048; }
            else { const int idx = rt - 1088, e = idx >> 4, n0 = (idx & 15) * 128; src = a.w_down + (size_t)e * 2048 * 2048 + n0; ld = 2048; dst = wd_t + ((size_t)e * 2048 + n0) * 2048; }
            conv_job(src, ld, dst, kt);
        }
    }
}

__device__ __forceinline__ void phase_norm1(const Args& a, LAS unsigned char* lds) {
    const int tid = threadIdx.x, blk = blockIdx.x, G = gridDim.x, w = tid >> 6, lane = tid & 63;
    LAS float* wlaT = (LAS float*)lds;
    for (int idx = tid; idx < 2048 * 16; idx += 512) { const int k = idx >> 4, j = idx & 15; wlaT[j * 2048 + k] = a.w_in[(size_t)k * DIN + 3072 + j]; }
    __syncthreads();
    const float* mod = (const float*)(a.ws + WS_MOD);
    bf16_t* h1 = (bf16_t*)(a.ws + WS_H1); float* gk = (float*)(a.ws + WS_GK);
    for (int r = blk * 8 + w; r < NTOK; r += G * 8) {
        const f32x4* xr = (const f32x4*)(a.x + (size_t)r * DM) + lane;
        f32x4 v[8]; float ss = 0.f;
#pragma unroll
        for (int q = 0; q < 8; ++q) { v[q] = xr[64 * q]; ss += (v[q][0] * v[q][0] + v[q][1] * v[q][1]) + (v[q][2] * v[q][2] + v[q][3] * v[q][3]); }
        ss = wave_sum(ss);
        const float rstd = 1.0f / sqrtf(ss * (1.0f / DM) + EPS);
        const float* sh = mod + (size_t)(r >> 12) * 12288; const float* sc = sh + 2048;
#pragma unroll
        for (int q = 0; q < 8; ++q) { const int k = 4 * (lane + 64 * q);
            const f32x4 nw = *(const f32x4*)(a.norm1_w + k), scv = *(const f32x4*)(sc + k), shv = *(const f32x4*)(sh + k);
            v[q] = (v[q] * rstd * nw) * (scv + 1.0f) + shv;
            u32x2 o; o.x = cvt_pk_bf16(v[q][0], v[q][1]); o.y = cvt_pk_bf16(v[q][2], v[q][3]);
            *(u32x2*)(h1 + (size_t)r * DM + k) = o; }
        LAS float* las = (LAS float*)(lds + LDS_EXTRA) + w * 16;
#pragma unroll 1
        for (int j = 0; j < 16; ++j) { float s = 0.f;
#pragma unroll
            for (int q = 0; q < 8; ++q) { const f32x4 wl = *(const LAS f32x4*)(wlaT + j * 2048 + 4 * (lane + 64 * q)); s += (v[q][0] * wl[0] + v[q][1] * wl[1]) + (v[q][2] * wl[2] + v[q][3] * wl[3]); }
            s = wave_sum(s); if (lane == 0) las[j] = s; }
        asm volatile("s_waitcnt lgkmcnt(0)" ::: "memory");
#pragma unroll 1
        for (int m = 0; m < 8; ++m) { const int d = lane + 64 * m; float z = a.b_alpha[d];
#pragma unroll
            for (int j = 0; j < 16; ++j) z += las[j] * a.w_alpha2[j * 512 + d];
            const float ls = fminf(z, 0.f) - log1pf(expf(-fabsf(z)));
            gk[(size_t)r * 512 + d] = ls * (1.0f / 16.0f); }
        asm volatile("s_waitcnt lgkmcnt(0)" ::: "memory");
    }
}

__device__ __forceinline__ void gla_stage_vt(const bf16_t* proj, int row0, int h, LAS bf16_t* VT, int tid) {
    const int i = tid >> 3, seg = tid & 7;
    const u32x4* vp = (const u32x4*)(proj + (size_t)(row0 + i) * NPROJ + C_VA + h * 256 + seg * 32);
#pragma unroll
    for (int c4 = 0; c4 < 4; ++c4) { const u32x4 vv = vp[c4];
#pragma unroll
        for (int p = 0; p < 4; ++p) { const unsigned wd = vv[p]; const int e = seg * 32 + c4 * 8 + p * 2;
            VT[e * 72 + i] = (bf16_t)(wd & 0xffffu); VT[(e + 1) * 72 + i] = (bf16_t)(wd >> 16); } }
}
__device__ __forceinline__ void gla1_unit(const Args& a, LAS unsigned char* lds, int u) {
    const int tid = threadIdx.x, w = tid >> 6, lane = tid & 63;
    const int bh = u >> 6, c = u & 63, b = bh >> 2, h = bh & 3, row0 = b * SEQ + c * 64;
    LAS float* Bm = (LAS float*)lds; LAS bf16_t* KT = (LAS bf16_t*)(lds + 32768); LAS bf16_t* VT = (LAS bf16_t*)(lds + 51200);
    const float* gk = (const float*)(a.ws + WS_GK); const bf16_t* proj = (const bf16_t*)(a.ws + WS_PROJ);
    float* bcum = (float*)(a.ws + WS_BCUM); float* dst = (float*)(a.ws + WS_DST); float* dec = (float*)(a.ws + WS_DEC);
    const int i = tid >> 3, seg = tid & 7;
    {
        const f32x4* gp = (const f32x4*)(gk + (size_t)(row0 + i) * 512 + h * 128 + seg * 16);
#pragma unroll
        for (int q = 0; q < 4; ++q) *(LAS f32x4*)(Bm + i * 128 + seg * 16 + q * 4) = gp[q];
    }
    __syncthreads();
    if (tid < 128) { float run = 0.f; for (int ii = 0; ii < 64; ++ii) { run += Bm[ii * 128 + tid]; Bm[ii * 128 + tid] = run; } }
    __syncthreads();
    {
        const u32x4* kp = (const u32x4*)(proj + (size_t)(row0 + i) * NPROJ + C_KA + h * 128 + seg * 16);
        float* bo = bcum + ((size_t)u * 64 + i) * 128 + seg * 16;
#pragma unroll
        for (int q = 0; q < 2; ++q) { const u32x4 kv = kp[q];
#pragma unroll
            for (int p = 0; p < 4; ++p) { const int d = seg * 16 + q * 8 + p * 2;
                const float b0 = Bm[i * 128 + d], b1 = Bm[i * 128 + d + 1], l0 = Bm[63 * 128 + d], l1 = Bm[63 * 128 + d + 1];
                bo[q * 8 + p * 2] = b0; bo[q * 8 + p * 2 + 1] = b1;
                KT[d * 72 + i] = f2bf(bflo(kv[p]) * expf(l0 - b0)); KT[(d + 1) * 72 + i] = f2bf(bfhi(kv[p]) * expf(l1 - b1));
                if (i == 63) { dec[(size_t)u * 128 + d] = expf(l0); dec[(size_t)u * 128 + d + 1] = expf(l1); } } }
        gla_stage_vt(proj, row0, h, VT, tid);
    }
    __syncthreads();
    {
        f32x4 acc[2][8];
#pragma unroll
        for (int x = 0; x < 2; ++x)
#pragma unroll
            for (int y = 0; y < 8; ++y) acc[x][y] = (f32x4){0.f, 0.f, 0.f, 0.f};
#pragma unroll
        for (int ks = 0; ks < 2; ++ks) {
            const bf16x8 a0 = lds_frag(VT, 72, (2 * w) * 16, ks * 32, lane), a1 = lds_frag(VT, 72, (2 * w + 1) * 16, ks * 32, lane);
#pragma unroll
            for (int dt = 0; dt < 8; ++dt) { const bf16x8 bf = lds_frag(KT, 72, dt * 16, ks * 32, lane); acc[0][dt] = mfma16(a0, bf, acc[0][dt]); acc[1][dt] = mfma16(a1, bf, acc[1][dt]); }
        }
        float* dp = dst + (size_t)u * 32768;
#pragma unroll
        for (int x = 0; x < 2; ++x)
#pragma unroll
            for (int dt = 0; dt < 8; ++dt)
#pragma unroll
                for (int r = 0; r < 4; ++r) dp[((2 * w + x) * 16 + 4 * (lane >> 4) + r) * 128 + dt * 16 + (lane & 15)] = acc[x][dt][r];
    }
    __syncthreads();
}
__device__ __forceinline__ void moba_prep_unit(const Args& a, LAS unsigned char* lds, int u2) {
    const int tid = threadIdx.x;
    const int bh = u2 >> 4, kb = u2 & 15, b = bh >> 3, h = bh & 7, row0 = b * SEQ + kb * 256, t0 = kb * 256;
    const bf16_t* proj = (const bf16_t*)(a.ws + WS_PROJ);
    const float* ct = (const float*)(a.ws + WS_ROPE); const float* st = ct + 4096 * 64;
    bf16_t* qbr = (bf16_t*)(a.ws + WS_QBR); bf16_t* kbr = (bf16_t*)(a.ws + WS_KBR); bf16_t* vbt = (bf16_t*)(a.ws + WS_VBT); float* kmean = (float*)(a.ws + WS_KMEAN);
    LAS float* Kf = (LAS float*)lds; LAS float* part = (LAS float*)(lds + LDS_EXTRA);
    const int row = tid >> 1, half = tid & 1;
    const float* cp = ct + (size_t)(t0 + row) * 64 + half * 32; const float* sp = st + (size_t)(t0 + row) * 64 + half * 32;
#pragma unroll 1
    for (int which = 0; which < 2; ++which) {
        const bf16_t* src = proj + (size_t)(row0 + row) * NPROJ + (which == 0 ? C_KB : C_QB) + h * 128 + half * 32;
        bf16_t* dsto = (which == 0 ? kbr : qbr) + ((size_t)bh * SEQ + t0 + row) * 128 + half * 32;
#pragma unroll
        for (int c4 = 0; c4 < 4; ++c4) {
            const u32x4 x1 = *(const u32x4*)(src + c4 * 8), x2 = *(const u32x4*)(src + 64 + c4 * 8);
            u32x4 o1, o2;
#pragma unroll
            for (int p = 0; p < 4; ++p) { const int ii = c4 * 8 + p * 2;
                const float c0 = cp[ii], c1 = cp[ii + 1], s0 = sp[ii], s1 = sp[ii + 1];
                const float a0 = bflo(x1[p]), a1 = bfhi(x1[p]), b0 = bflo(x2[p]), b1 = bfhi(x2[p]);
                const float r10 = a0 * c0 - b0 * s0, r11 = a1 * c1 - b1 * s1, r20 = a0 * s0 + b0 * c0, r21 = a1 * s1 + b1 * c1;
                o1[p] = cvt_pk_bf16(r10, r11); o2[p] = cvt_pk_bf16(r20, r21);
                if (which == 0) { Kf[row * 128 + half * 32 + ii] = r10; Kf[row * 128 + half * 32 + ii + 1] = r11; Kf[row * 128 + 64 + half * 32 + ii] = r20; Kf[row * 128 + 64 + half * 32 + ii + 1] = r21; } }
            *(u32x4*)(dsto + c4 * 8) = o1; *(u32x4*)(dsto + 64 + c4 * 8) = o2;
        }
        if (which == 0) {
            __syncthreads();
            { const int d = tid & 127, rq = tid >> 7; float s = 0.f; for (int rr = 0; rr < 64; ++rr) s += Kf[(rq * 64 + rr) * 128 + d]; part[rq * 128 + d] = s; }
            __syncthreads();
            if (tid < 128) kmean[((size_t)bh * 16 + kb) * 128 + tid] = (part[tid] + part[128 + tid] + part[256 + tid] + part[384 + tid]) * (1.0f / 256.0f);
        }
    }
    __syncthreads();
    LAS bf16_t* Vl = (LAS bf16_t*)lds;
    {
        const u32x4* vp = (const u32x4*)(proj + (size_t)(row0 + row) * NPROJ + C_VB + h * 128 + half * 64);
#pragma unroll
        for (int c8 = 0; c8 < 8; ++c8) { const u32x4 vv = vp[c8]; LAS unsigned* dp = (LAS unsigned*)(Vl + row * 130 + half * 64 + c8 * 8); dp[0] = vv[0]; dp[1] = vv[1]; dp[2] = vv[2]; dp[3] = vv[3]; }
    }
    __syncthreads();
    {
        const int d = tid >> 2, ts = tid & 3;
        bf16_t* op = vbt + ((size_t)bh * 128 + d) * SEQ + t0 + ts * 64;
#pragma unroll
        for (int c8 = 0; c8 < 8; ++c8) { u32x4 o;
#pragma unroll
            for (int p = 0; p < 4; ++p) { const int tt = ts * 64 + c8 * 8 + p * 2; o[p] = (unsigned)Vl[tt * 130 + d] | ((unsigned)Vl[(tt + 1) * 130 + d] << 16); }
            *(u32x4*)(op + c8 * 8) = o; }
    }
    __syncthreads();
}
__device__ __forceinline__ void phase_mix_prep(const Args& a, LAS unsigned char* lds) {
    const int blk = blockIdx.x, G = gridDim.x;
    for (int u = blk; u < 512; u += G) gla1_unit(a, lds, u);
    for (int u2 = blk; u2 < 256; u2 += G) moba_prep_unit(a, lds, u2);
}

__device__ __forceinline__ void phase_scan_select(const Args& a, LAS unsigned char* lds) {
    const int tid = threadIdx.x, blk = blockIdx.x, G = gridDim.x;
    {
        const float* dst = (const float*)(a.ws + WS_DST); const float* dec = (const float*)(a.ws + WS_DEC); bf16_t* ST = (bf16_t*)(a.ws + WS_ST);
        for (int el = blk * 512 + tid; el < 8 * 32768; el += G * 512) {
            const int bh = el >> 15, ed = el & 32767, d = ed & 127; float cur = 0.f;
#pragma unroll 8
            for (int c = 0; c < 64; ++c) { const size_t u = (size_t)bh * 64 + c; ST[u * 32768 + ed] = f2bf(cur); cur = dec[u * 128 + d] * cur + dst[u * 32768 + ed]; }
        }
    }
    {
        const float* kmean = (const float*)(a.ws + WS_KMEAN); const bf16_t* qbr = (const bf16_t*)(a.ws + WS_QBR); unsigned* sel = (unsigned*)(a.ws + WS_SEL);
        LAS float* km = (LAS float*)lds;
        for (int u2 = blk; u2 < 256; u2 += G) {
            const int bh = u2 >> 4, qb = u2 & 15;
            __syncthreads();
            for (int i = tid; i < 2048; i += 512) km[i] = kmean[(size_t)bh * 2048 + i];
            __syncthreads();
            const int q = tid >> 1, half = tid & 1;
            float gv[8];
#pragma unroll
            for (int n = 0; n < 8; ++n) gv[n] = 0.f;
            const u32x4* qp = (const u32x4*)(qbr + ((size_t)bh * SEQ + qb * 256 + q) * 128);
#pragma unroll 4
            for (int c = 0; c < 16; ++c) { const u32x4 qq = qp[c]; float qf[8];
#pragma unroll
                for (int p = 0; p < 4; ++p) { qf[2 * p] = bflo(qq[p]); qf[2 * p + 1] = bfhi(qq[p]); }
#pragma unroll
                for (int n = 0; n < 8; ++n) { const LAS float* kr = km + (half * 8 + n) * 128 + c * 8; const f32x4 k0 = *(const LAS f32x4*)kr, k1 = *(const LAS f32x4*)(kr + 4);
                    gv[n] += (qf[0] * k0[0] + qf[1] * k0[1]) + (qf[2] * k0[2] + qf[3] * k0[3]) + (qf[4] * k1[0] + qf[5] * k1[1]) + (qf[6] * k1[2] + qf[7] * k1[3]); } }
            float ga[16];
#pragma unroll
            for (int n = 0; n < 8; ++n) { const float o = __shfl_xor(gv[n], 1); ga[n] = half ? o : gv[n]; ga[8 + n] = half ? gv[n] : o; }
            unsigned mask = 0u; const int nsel = qb < 3 ? qb : 3;
            for (int s = 0; s < nsel; ++s) { int best = -1; float bv = -INFINITY;
#pragma unroll
                for (int n = 0; n < 16; ++n) { const bool ok = (n < qb) && !((mask >> n) & 1u) && (best < 0 || ga[n] > bv); if (ok) { bv = ga[n]; best = n; } }
                mask |= 1u << best; }
            if (half == 0) sel[(size_t)bh * SEQ + qb * 256 + q] = mask;
        }
        __syncthreads();
    }
}

__device__ __forceinline__ void gla3_unit(const Args& a, LAS unsigned char* lds, int u) {
    const int tid = threadIdx.x, w = tid >> 6, lane = tid & 63, g = lane >> 4, fr = lane & 15;
    const int bh = u >> 6, c = u & 63, b = bh >> 2, h = bh & 3, row0 = b * SEQ + c * 64;
    LAS bf16_t* QP = (LAS bf16_t*)lds; LAS bf16_t* KP = (LAS bf16_t*)(lds + 17408); LAS bf16_t* VT = (LAS bf16_t*)(lds + 34816);
    LAS bf16_t* AM = (LAS bf16_t*)(lds + 71680); LAS float* RED = (LAS float*)(lds + 80896);
    const bf16_t* proj = (const bf16_t*)(a.ws + WS_PROJ); const float* bcum = (const float*)(a.ws + WS_BCUM); const bf16_t* ST = (const bf16_t*)(a.ws + WS_ST);
    bf16_t* ocat = (bf16_t*)(a.ws + WS_OCAT);
    {
        const int i = tid >> 3, seg = tid & 7;
        const f32x4* bp = (const f32x4*)(bcum + ((size_t)u * 64 + i) * 128 + seg * 16);
        const u32x4* qp = (const u32x4*)(proj + (size_t)(row0 + i) * NPROJ + C_QA + h * 128 + seg * 16);
        const u32x4* kp = (const u32x4*)(proj + (size_t)(row0 + i) * NPROJ + C_KA + h * 128 + seg * 16);
#pragma unroll
        for (int q = 0; q < 2; ++q) { const u32x4 qv = qp[q], kv = kp[q]; const f32x4 b0 = bp[2 * q], b1 = bp[2 * q + 1]; u32x4 qo, ko;
#pragma unroll
            for (int p = 0; p < 4; ++p) { const float bl = (p < 2) ? b0[2 * p] : b1[2 * p - 4], bhv = (p < 2) ? b0[2 * p + 1] : b1[2 * p - 3];
                const float el = expf(bl), eh = expf(bhv);
                qo[p] = cvt_pk_bf16(bflo(qv[p]) * el * 0.08838834764831845f, bfhi(qv[p]) * eh * 0.08838834764831845f);
                ko[p] = cvt_pk_bf16(bflo(kv[p]) / el, bfhi(kv[p]) / eh); }
            *(LAS u32x4*)(QP + i * 136 + seg * 16 + q * 8) = qo; *(LAS u32x4*)(KP + i * 136 + seg * 16 + q * 8) = ko; }
        gla_stage_vt(proj, row0, h, VT, tid);
    }
    __syncthreads();
    {
        const int it = w >> 1;
#pragma unroll
        for (int jj = 0; jj < 2; ++jj) { const int jt = (w & 1) * 2 + jj; f32x4 acc = {0.f, 0.f, 0.f, 0.f};
            if (jt <= it) {
#pragma unroll
                for (int ks = 0; ks < 4; ++ks) acc = mfma16(lds_frag(QP, 136, it * 16, ks * 32, lane), lds_frag(KP, 136, jt * 16, ks * 32, lane), acc);
            }
#pragma unroll
            for (int r = 0; r < 4; ++r) { const int i = it * 16 + 4 * g + r, j = jt * 16 + fr; AM[i * 72 + j] = f2bf((j <= i) ? acc[r] : 0.f); } }
    }
    __syncthreads();
    f32x4 acc[4][2];
    {
#pragma unroll
        for (int x = 0; x < 4; ++x)
#pragma unroll
            for (int y = 0; y < 2; ++y) acc[x][y] = (f32x4){0.f, 0.f, 0.f, 0.f};
        bf16x8 bS[2][4];
        const bf16_t* stp = ST + (size_t)u * 32768;
#pragma unroll
        for (int e2 = 0; e2 < 2; ++e2)
#pragma unroll
            for (int ks = 0; ks < 4; ++ks) bS[e2][ks] = *(const bf16x8*)(stp + ((2 * w + e2) * 16 + fr) * 128 + ks * 32 + 8 * g);
#pragma unroll
        for (int it = 0; it < 4; ++it) {
#pragma unroll
            for (int ks = 0; ks < 4; ++ks) { const bf16x8 aq = lds_frag(QP, 136, it * 16, ks * 32, lane); acc[it][0] = mfma16(aq, bS[0][ks], acc[it][0]); acc[it][1] = mfma16(aq, bS[1][ks], acc[it][1]); }
#pragma unroll
            for (int k2 = 0; k2 < 2; ++k2) { const bf16x8 aa = lds_frag(AM, 72, it * 16, k2 * 32, lane);
                acc[it][0] = mfma16(aa, lds_frag(VT, 72, (2 * w) * 16, k2 * 32, lane), acc[it][0]); acc[it][1] = mfma16(aa, lds_frag(VT, 72, (2 * w + 1) * 16, k2 * 32, lane), acc[it][1]); }
        }
#pragma unroll
        for (int it = 0; it < 4; ++it)
#pragma unroll
            for (int r = 0; r < 4; ++r) { float s = acc[it][0][r] * acc[it][0][r] + acc[it][1][r] * acc[it][1][r];
                s += __shfl_xor(s, 1); s += __shfl_xor(s, 2); s += __shfl_xor(s, 4); s += __shfl_xor(s, 8);
                if (fr == 0) RED[w * 64 + it * 16 + 4 * g + r] = s; }
    }
    __syncthreads();
    {
#pragma unroll
        for (int it = 0; it < 4; ++it)
#pragma unroll
            for (int r = 0; r < 4; ++r) { const int i = it * 16 + 4 * g + r; float tot = 0.f;
#pragma unroll
                for (int ww = 0; ww < 8; ++ww) tot += RED[ww * 64 + i];
                const float rstd = 1.0f / sqrtf(tot * (1.0f / 256.0f) + EPS);
#pragma unroll
                for (int e2 = 0; e2 < 2; ++e2) { const int e = (2 * w + e2) * 16 + fr;
                    const float ga = bf2f(proj[(size_t)(row0 + i) * NPROJ + C_GA + h * 256 + e]);
                    ocat[(size_t)(row0 + i) * DM + h * 256 + e] = f2bf(acc[it][e2][r] * rstd * a.gla_norm_w[e] * silu_f(ga)); } }
    }
    __syncthreads();
}

__device__ __forceinline__ void moba_attn_unit(const Args& a, LAS unsigned char* lds, int bh, int qb) {
    const int tid = threadIdx.x, w = tid >> 6, lane = tid & 63, g = lane >> 4, fr = lane & 15;
    const int b = bh >> 3, h = bh & 7, q0 = 32 * w;
    LAS bf16_t* Ks = (LAS bf16_t*)lds; LAS bf16_t* Vs = (LAS bf16_t*)(lds + 17408);
    const bf16_t* qbr = (const bf16_t*)(a.ws + WS_QBR); const bf16_t* kbr = (const bf16_t*)(a.ws + WS_KBR); const bf16_t* vbt = (const bf16_t*)(a.ws + WS_VBT);
    const unsigned* sel = (const unsigned*)(a.ws + WS_SEL); bf16_t* ocat = (bf16_t*)(a.ws + WS_OCAT);
    bf16x8 qf[2][4]; unsigned sm[2]; float m[2], l[2]; f32x4 O[8][2];
#pragma unroll
    for (int b2 = 0; b2 < 2; ++b2) { const size_t qrow = (size_t)bh * SEQ + qb * 256 + q0 + 16 * b2 + fr;
#pragma unroll
        for (int ks = 0; ks < 4; ++ks) qf[b2][ks] = *(const bf16x8*)(qbr + qrow * 128 + ks * 32 + 8 * g);
        sm[b2] = sel[qrow]; m[b2] = -INFINITY; l[b2] = 0.f;
#pragma unroll
        for (int dt = 0; dt < 8; ++dt) O[dt][b2] = (f32x4){0.f, 0.f, 0.f, 0.f}; }
    const float cs = 0.08838834764831845f * 1.4426950408889634f;
#pragma unroll 1
    for (int jj = 0; jj <= qb; ++jj) {
        const int j = (jj == 0) ? qb : jj - 1; const bool own = (jj == 0);
#pragma unroll 1
        for (int kt = 0; kt < 4; ++kt) {
            __syncthreads();
#pragma unroll
            for (int p = 0; p < 2; ++p) { const int cidx = tid + 512 * p;
                { const int row = cidx >> 4, cc = cidx & 15; *(LAS u32x4*)(Ks + row * 136 + cc * 8) = *(const u32x4*)(kbr + ((size_t)bh * SEQ + j * 256 + kt * 64 + row) * 128 + cc * 8); }
                { const int d = cidx >> 3, cc = cidx & 7; *(LAS u32x4*)(Vs + d * 72 + cc * 8) = *(const u32x4*)(vbt + ((size_t)bh * 128 + d) * SEQ + j * 256 + kt * 64 + cc * 8); } }
            __syncthreads();
            if (own && kt * 64 > q0 + 31) continue;
            f32x4 s[4][2];
#pragma unroll
            for (int t4 = 0; t4 < 4; ++t4) { s[t4][0] = (f32x4){0.f, 0.f, 0.f, 0.f}; s[t4][1] = (f32x4){0.f, 0.f, 0.f, 0.f};
#pragma unroll
                for (int ks = 0; ks < 4; ++ks) { const bf16x8 kf = lds_frag(Ks, 136, t4 * 16, ks * 32, lane); s[t4][0] = mfma16(kf, qf[0][ks], s[t4][0]); s[t4][1] = mfma16(kf, qf[1][ks], s[t4][1]); } }
            bf16x8 pf[2][2];
#pragma unroll
            for (int b2 = 0; b2 < 2; ++b2) {
                const int qi = q0 + 16 * b2 + fr; const bool allow_past = ((sm[b2] >> j) & 1u) != 0u;
                float tm = -INFINITY;
#pragma unroll
                for (int t4 = 0; t4 < 4; ++t4)
#pragma unroll
                    for (int r = 0; r < 4; ++r) { const int kk = kt * 64 + t4 * 16 + 4 * g + r; const bool ok = own ? (kk <= qi) : allow_past;
                        const float v = ok ? s[t4][b2][r] : -INFINITY; s[t4][b2][r] = v; tm = fmaxf(tm, v); }
                tm = fmaxf(tm, __shfl_xor(tm, 16)); tm = fmaxf(tm, __shfl_xor(tm, 32));
                const float mnew = fmaxf(m[b2], tm), msafe = (mnew == -INFINITY) ? 0.f : mnew;
                const float alpha = exp2f((m[b2] - msafe) * cs);
                float ps = 0.f;
#pragma unroll
                for (int t4 = 0; t4 < 4; ++t4)
#pragma unroll
                    for (int r = 0; r < 4; ++r) { const float p = exp2f((s[t4][b2][r] - msafe) * cs); s[t4][b2][r] = p; ps += p; }
                ps += __shfl_xor(ps, 16); ps += __shfl_xor(ps, 32);
                l[b2] = l[b2] * alpha + ps; m[b2] = mnew;
#pragma unroll
                for (int dt = 0; dt < 8; ++dt) O[dt][b2] *= alpha;
#pragma unroll
                for (int k2 = 0; k2 < 2; ++k2) { u32x4 pk; pk.x = cvt_pk_bf16(s[2 * k2][b2][0], s[2 * k2][b2][1]); pk.y = cvt_pk_bf16(s[2 * k2][b2][2], s[2 * k2][b2][3]);
                    pk.z = cvt_pk_bf16(s[2 * k2 + 1][b2][0], s[2 * k2 + 1][b2][1]); pk.w = cvt_pk_bf16(s[2 * k2 + 1][b2][2], s[2 * k2 + 1][b2][3]);
                    pf[k2][b2] = __builtin_bit_cast(bf16x8, pk); }
            }
#pragma unroll
            for (int dt = 0; dt < 8; ++dt)
#pragma unroll
                for (int k2 = 0; k2 < 2; ++k2) { const LAS bf16_t* vp = Vs + (dt * 16 + fr) * 72 + 32 * k2 + 4 * g;
                    const u32x2 lo = *(const LAS u32x2*)vp, hi = *(const LAS u32x2*)(vp + 16);
                    u32x4 vv; vv.x = lo.x; vv.y = lo.y; vv.z = hi.x; vv.w = hi.y; const bf16x8 vf = __builtin_bit_cast(bf16x8, vv);
                    O[dt][0] = mfma16(vf, pf[k2][0], O[dt][0]); O[dt][1] = mfma16(vf, pf[k2][1], O[dt][1]); }
        }
    }
#pragma unroll
    for (int b2 = 0; b2 < 2; ++b2) { const float inv = 1.0f / l[b2]; const size_t orow = (size_t)(b * SEQ + qb * 256 + q0 + 16 * b2 + fr) * DM + 1024 + h * 128;
#pragma unroll
        for (int dt = 0; dt < 8; ++dt) { u32x2 o; o.x = cvt_pk_bf16(O[dt][b2][0] * inv, O[dt][b2][1] * inv); o.y = cvt_pk_bf16(O[dt][b2][2] * inv, O[dt][b2][3] * inv);
            *(u32x2*)(ocat + orow + dt * 16 + 4 * g) = o; } }
    __syncthreads();
}
__device__ __forceinline__ void phase_mix_out(const Args& a, LAS unsigned char* lds) {
    const int blk = blockIdx.x, G = gridDim.x;
    for (int ua = blk; ua < 256; ua += G) moba_attn_unit(a, lds, ua & 15, 15 - (ua >> 4));
    for (int u = blk; u < 512; u += G) gla3_unit(a, lds, u);
}

__device__ __forceinline__ void phase_router(const Args& a, LAS unsigned char* lds) {
    const int tid = threadIdx.x, blk = blockIdx.x, G = gridDim.x, w = tid >> 6, lane = tid & 63;
    LAS float* h2s = (LAS float*)lds;
    LAS float* logit = (LAS float*)(lds + LDS_EXTRA);
    LAS int* pe = (LAS int*)(lds + LDS_EXTRA + 2048); LAS float* pw = (LAS float*)(lds + LDS_EXTRA + 2304); LAS int* lpos = (LAS int*)(lds + LDS_EXTRA + 2560);
    LAS int* hist = (LAS int*)(lds + LDS_EXTRA + 2816); LAS int* base = (LAS int*)(lds + LDS_EXTRA + 2944);
    const float* mod = (const float*)(a.ws + WS_MOD); const float* x1 = (const float*)(a.ws + WS_X1); bf16_t* h2 = (bf16_t*)(a.ws + WS_H1);
    unsigned* cnt = (unsigned*)(a.ws + WS_CNT); int* pair_e = (int*)(a.ws + WS_PAIR_E); int* pair_pos = (int*)(a.ws + WS_PAIR_POS); float* pair_w = (float*)(a.ws + WS_PAIR_W);
    for (int grp = blk; grp < 512; grp += G) {
#pragma unroll 1
        for (int tt = 0; tt < 2; ++tt) { const int tl = 2 * w + tt, t = grp * 16 + tl;
            const f32x4* xr = (const f32x4*)(x1 + (size_t)t * DM) + lane;
            f32x4 v[8]; float ss = 0.f;
#pragma unroll
            for (int q = 0; q < 8; ++q) { v[q] = xr[64 * q]; ss += (v[q][0] * v[q][0] + v[q][1] * v[q][1]) + (v[q][2] * v[q][2] + v[q][3] * v[q][3]); }
            ss = wave_sum(ss);
            const float rstd = 1.0f / sqrtf(ss * (1.0f / DM) + EPS);
            const float* sh = mod + (size_t)(t >> 12) * 12288 + 6144; const float* sc = sh + 2048;
#pragma unroll
            for (int q = 0; q < 8; ++q) { const int k = 4 * (lane + 64 * q);
                const f32x4 nw = *(const f32x4*)(a.norm2_w + k), scv = *(const f32x4*)(sc + k), shv = *(const f32x4*)(sh + k);
                const f32x4 hv = (v[q] * rstd * nw) * (scv + 1.0f) + shv;
                *(LAS f32x4*)(h2s + tl * 2048 + k) = hv;
                u32x2 o; o.x = cvt_pk_bf16(hv[0], hv[1]); o.y = cvt_pk_bf16(hv[2], hv[3]);
                *(u32x2*)(h2 + (size_t)t * DM + k) = o; } }
        if (tid < 32) hist[tid] = 0;
        __syncthreads();
        { const int tl = tid >> 5, e = tid & 31; float acc = a.b_router[e]; const float* wp = a.w_router + e;
#pragma unroll 4
            for (int k = 0; k < 2048; k += 4) { const f32x4 hv = *(const LAS f32x4*)(h2s + tl * 2048 + k);
                acc += hv[0] * wp[(size_t)k * 32]; acc += hv[1] * wp[(size_t)(k + 1) * 32]; acc += hv[2] * wp[(size_t)(k + 2) * 32]; acc += hv[3] * wp[(size_t)(k + 3) * 32]; }
            logit[tl * 32 + e] = acc; }
        __syncthreads();
        if (tid < 16) { unsigned chosen = 0u; float tv[4]; int te[4];
#pragma unroll
            for (int s = 0; s < 4; ++s) { int best = -1; float bv = -INFINITY;
                for (int e = 0; e < 32; ++e) { const float v = logit[tid * 32 + e]; if (!((chosen >> e) & 1u) && (best < 0 || v > bv)) { bv = v; best = e; } }
                chosen |= 1u << best; tv[s] = bv; te[s] = best; }
            float ex[4], den = 0.f;
#pragma unroll
            for (int s = 0; s < 4; ++s) { ex[s] = expf(tv[s] - tv[0]); den += ex[s]; }
#pragma unroll
            for (int s = 0; s < 4; ++s) { pe[tid * 4 + s] = te[s]; pw[tid * 4 + s] = ex[s] / den; } }
        __syncthreads();
        if (tid < 64) lpos[tid] = atomicAdd((int*)&hist[pe[tid]], 1);
        __syncthreads();
        if (tid < 32) { const int n = hist[tid]; base[tid] = n ? (int)atomicAdd(&cnt[tid], (unsigned)n) : 0; }
        __syncthreads();
        if (tid < 64) { const int p = grp * 64 + tid, e = pe[tid]; pair_e[p] = e; pair_pos[p] = base[e] + lpos[tid]; pair_w[p] = pw[tid]; }
        __syncthreads();
    }
}
__device__ __forceinline__ void phase_gather(const Args& a, LAS unsigned char* lds) {
    const int tid = threadIdx.x, blk = blockIdx.x, G = gridDim.x, w = tid >> 6, lane = tid & 63;
    LAS int* pstart = (LAS int*)(lds + LDS_EXTRA);
    const unsigned* cnt = (const unsigned*)(a.ws + WS_CNT);
    if (tid == 0) { int run = 0; for (int e = 0; e < 32; ++e) { pstart[e] = run; run += (int)((cnt[e] + 255u) & ~255u); } }
    __syncthreads();
    const int* pair_e = (const int*)(a.ws + WS_PAIR_E); const int* pair_pos = (const int*)(a.ws + WS_PAIR_POS); const float* pair_w = (const float*)(a.ws + WS_PAIR_W);
    int* slotrow = (int*)(a.ws + WS_SLOTROW); float* wbuf = (float*)(a.ws + WS_WBUF); const bf16_t* h2 = (const bf16_t*)(a.ws + WS_H1); bf16_t* xg = (bf16_t*)(a.ws + WS_XG);
    for (int p = blk * 8 + w; p < NTOK * TOPK; p += G * 8) {
        const int row = pstart[pair_e[p]] + pair_pos[p];
        const u32x4* sp = (const u32x4*)(h2 + (size_t)(p >> 2) * DM) + lane; u32x4* dp = (u32x4*)(xg + (size_t)row * DM) + lane;
#pragma unroll
        for (int q = 0; q < 4; ++q) dp[64 * q] = sp[64 * q];
        if (lane == 0) { wbuf[row] = pair_w[p]; slotrow[p] = row; }
    }
    __syncthreads();
}
__device__ __forceinline__ void moe_build_tab(const Args& a, LAS unsigned char* lds, int ntn) {
    LAS int* tab = (LAS int*)(lds + LDS_EXTRA);
    const unsigned* cnt = (const unsigned*)(a.ws + WS_CNT);
    __syncthreads();
    if (threadIdx.x == 0) {
        const int mygrp = blockIdx.x & 7, PG = ntn >> 1;
        int rs = 0, np = 0, us = 0; unsigned done = 0u;
        LAS int* rt0 = tab + 600;
        LAS int* load = tab + 640;
        for (int x = 0; x < 8; ++x) load[x] = 0;
        for (int e = 0; e < 32; ++e) { rt0[e] = rs; rs += (int)((cnt[e] + 255u) >> 8); }
        for (int it = 0; it < 32; ++it) {
            int be = -1, bc = -1;
            for (int e = 0; e < 32; ++e) { if ((done >> e) & 1u) continue; const int c = (int)cnt[e], cost = 2 * (c >> 8) + ((c & 255) > 128 ? 2 : ((c & 255) ? 1 : 0)); if (cost > bc) { bc = cost; be = e; } }
            done |= 1u << be;
            const int c = (int)cnt[be], mte = (c + 255) >> 8;
            if (mte == 0) continue;
            for (int h = 0; h < 2; ++h) {
                int bx = 0;
                for (int x = 1; x < 8; ++x) if (load[x] < load[bx]) bx = x;
                load[bx] += bc * PG;
                if (bx == mygrp) { LAS int* t = tab + 4 + 8 * np; t[0] = us; t[1] = be; t[2] = h * PG; t[3] = mte; t[4] = rt0[be]; t[5] = c; us += mte * PG; ++np; }
            }
        }
        tab[0] = np; tab[1] = us;
    }
    __syncthreads();
}
__device__ __forceinline__ void phase_final(const Args& a, LAS unsigned char* lds) {
    const int tid = threadIdx.x, blk = blockIdx.x, G = gridDim.x, w = tid >> 6, lane = tid & 63;
    const float* mod = (const float*)(a.ws + WS_MOD); const float* x1 = (const float*)(a.ws + WS_X1); const int* slotrow = (const int*)(a.ws + WS_SLOTROW); const bf16_t* y = (const bf16_t*)(a.ws + WS_Y);
    for (int t = blk * 8 + w; t < NTOK; t += G * 8) {
        const int r0 = slotrow[t * 4], r1 = slotrow[t * 4 + 1], r2 = slotrow[t * 4 + 2], r3 = slotrow[t * 4 + 3];
        const f32x4* xr = (const f32x4*)(x1 + (size_t)t * DM) + lane;
        const u32x2* y0 = (const u32x2*)(y + (size_t)r0 * DM) + lane; const u32x2* y1 = (const u32x2*)(y + (size_t)r1 * DM) + lane;
        const u32x2* y2 = (const u32x2*)(y + (size_t)r2 * DM) + lane; const u32x2* y3 = (const u32x2*)(y + (size_t)r3 * DM) + lane;
        const float* g2 = mod + (size_t)(t >> 12) * 12288 + 10240;
        f32x4 v[8]; float ss = 0.f;
#pragma unroll
        for (int q = 0; q < 8; ++q) { const u32x2 a0 = y0[64 * q], a1 = y1[64 * q], a2 = y2[64 * q], a3 = y3[64 * q];
            f32x4 s; s[0] = (bflo(a0.x) + bflo(a1.x)) + (bflo(a2.x) + bflo(a3.x)); s[1] = (bfhi(a0.x) + bfhi(a1.x)) + (bfhi(a2.x) + bfhi(a3.x));
            s[2] = (bflo(a0.y) + bflo(a1.y)) + (bflo(a2.y) + bflo(a3.y)); s[3] = (bfhi(a0.y) + bfhi(a1.y)) + (bfhi(a2.y) + bfhi(a3.y));
            const f32x4 gv = *(const f32x4*)(g2 + 4 * (lane + 64 * q));
            v[q] = xr[64 * q] + gv * s; ss += (v[q][0] * v[q][0] + v[q][1] * v[q][1]) + (v[q][2] * v[q][2] + v[q][3] * v[q][3]); }
        ss = wave_sum(ss);
        const float rstd = 1.0f / sqrtf(ss * (1.0f / DM) + EPS);
        f32x4* op = (f32x4*)(a.out + (size_t)t * DM) + lane;
#pragma unroll
        for (int q = 0; q < 8; ++q) op[64 * q] = v[q] * rstd * *(const f32x4*)(a.final_norm_w + 4 * (lane + 64 * q));
    }
}

constexpr int NPHASE = 12;
#ifndef ONLY_PHASE
#define ONLY_PHASE -1
#endif
#define PH_ON(P) (ONLY_PHASE < 0 || ONLY_PHASE == (P))
#ifndef PROBE_DOUBLE
#define PROBE_DOUBLE -1
#endif
#define PROBE_REP(P) for (int _rep = 0; _rep < ((PROBE_DOUBLE == (P)) ? 2 : 1); ++_rep)
__global__ void __launch_bounds__(512, 2) fwd(Args a) {
    extern __shared__ __attribute__((aligned(16))) unsigned char shm[];
    LAS unsigned char* lds = (LAS unsigned char*)shm;
    if (threadIdx.x == 0) *(LAS u32x4*)(lds + LDS_XB) = (u32x4){0u, 0u, 0u, 0u};
    __syncthreads();
    XcdBarrier bar = xcd_barrier_post((unsigned*)(a.ws + WS_BAR), (volatile LAS unsigned*)(lds + LDS_XB));
    const int G = gridDim.x, blk = blockIdx.x;
#define PHASE_END(P) do { if ((P) + 1 < a.ph_hi) xcd_barrier(bar); } while (0)
    if (PH_ON(0) && a.ph_lo <= 0 && 0 < a.ph_hi) { PROBE_REP(0) { phase_prologue(a, lds); __syncthreads(); } PHASE_END(0); }
    if (PH_ON(1) && a.ph_lo <= 1 && 1 < a.ph_hi) { phase_norm1(a, lds); PHASE_END(1); }
    if (PH_ON(2) && a.ph_lo <= 2 && 2 < a.ph_hi) {
        pg8::Gemm g{(const bf16_t*)(a.ws + WS_H1), (const bf16_t*)(a.ws + WS_WIN_T), DM, 0};
        pg8::StaticOrder S; S.init(NTOK, NPROJ, G, blk);
        pg8::EpiProj E{(bf16_t*)(a.ws + WS_PROJ), NPROJ};
        pg8::gemm_phase(lds, g, S, E); PHASE_END(2); }
    if (PH_ON(3) && a.ph_lo <= 3 && 3 < a.ph_hi) { phase_mix_prep(a, lds); PHASE_END(3); }
    if (PH_ON(4) && a.ph_lo <= 4 && 4 < a.ph_hi) { phase_scan_select(a, lds); PHASE_END(4); }
    if (PH_ON(5) && a.ph_lo <= 5 && 5 < a.ph_hi) { phase_mix_out(a, lds);
#if PROBE_DOUBLE == 5
        __syncthreads(); phase_mix_out(a, lds);
#endif
        PHASE_END(5); }
    if (PH_ON(6) && a.ph_lo <= 6 && 6 < a.ph_hi) {
        pg8::Gemm g{(const bf16_t*)(a.ws + WS_OCAT), (const bf16_t*)(a.ws + WS_WOUT_T), DM, 0};
        pg8::StaticOrder S; S.init(NTOK, DM, G, blk);
        pg8::EpiOut E{a.x, (const float*)(a.ws + WS_MOD) + 4096, (float*)(a.ws + WS_X1)};
        pg8::gemm_phase(lds, g, S, E); PHASE_END(6); }
    if (PH_ON(7) && a.ph_lo <= 7 && 7 < a.ph_hi) { phase_router(a, lds); PHASE_END(7); }
    if (PH_ON(8) && a.ph_lo <= 8 && 8 < a.ph_hi) { phase_gather(a, lds); PHASE_END(8); }
    if (PH_ON(9) && a.ph_lo <= 9 && 9 < a.ph_hi) {
        moe_build_tab(a, lds, 16);
        pg8::Gemm g{(const bf16_t*)(a.ws + WS_XG), (const bf16_t*)(a.ws + WS_WGU_T), DM, (size_t)4096 * 2048};
        pg8::MoeOrder S{(const LAS int*)(lds + LDS_EXTRA), blk >> 3, G >> 3};
        pg8::EpiGU E{a.b_gate_up, (bf16_t*)(a.ws + WS_ACT)};
        pg8::gemm_phase(lds, g, S, E); PHASE_END(9); }
    if (PH_ON(10) && a.ph_lo <= 10 && 10 < a.ph_hi) {
        moe_build_tab(a, lds, 8);
        pg8::Gemm g{(const bf16_t*)(a.ws + WS_ACT), (const bf16_t*)(a.ws + WS_WD_T), DM, (size_t)2048 * 2048};
        pg8::MoeOrder S{(const LAS int*)(lds + LDS_EXTRA), blk >> 3, G >> 3};
        pg8::EpiDown E{a.b_down, (const float*)(a.ws + WS_WBUF), (bf16_t*)(a.ws + WS_Y)};
        pg8::gemm_phase(lds, g, S, E); PHASE_END(10); }
    if (PH_ON(11) && a.ph_lo <= 11 && 11 < a.ph_hi) { phase_final(a, lds); }
}

#ifndef N_LAUNCHES
#define N_LAUNCHES 1
#endif
extern "C" void kernel_launch(void* const* d_in, const int* in_sizes, int n_in, void* d_out, int out_size, void* d_ws, size_t ws_size, hipStream_t stream) {
    static int grid = 0;
    if (grid == 0) {
        if (n_in != 18 || out_size != NTOK * DM || ws_size < WS_END) { fprintf(stderr, "kernel_launch: unexpected shapes (n_in %d out %d ws %zu, need %zu)\n", n_in, out_size, ws_size, (size_t)WS_END); grid = -1; return; }
        int dev = 0, cus = 0, per_cu = 0;
        if (hipGetDevice(&dev) != hipSuccess || hipDeviceGetAttribute(&cus, hipDeviceAttributeMultiprocessorCount, dev) != hipSuccess) { grid = -1; return; }
        if (hipFuncSetAttribute((const void*)fwd, hipFuncAttributeMaxDynamicSharedMemorySize, LDS_BYTES) != hipSuccess) { fprintf(stderr, "kernel_launch: hipFuncSetAttribute failed\n"); grid = -1; return; }
        if (hipOccupancyMaxActiveBlocksPerMultiprocessor(&per_cu, (const void*)fwd, 512, LDS_BYTES) != hipSuccess || per_cu < 1) fprintf(stderr, "kernel_launch: occupancy query says %d\n", per_cu);
        (void)hipGetLastError();
        grid = cus;
    }
    if (grid < 0) return;
    (void)hipMemsetAsync(d_ws, 0, WS_ZERO_BYTES, stream);
    Args a{};
    a.x = (const float*)d_in[0]; a.c = (const float*)d_in[1]; a.w_ada = (const float*)d_in[2]; a.b_ada = (const float*)d_in[3]; a.norm1_w = (const float*)d_in[4];
    a.w_in = (const float*)d_in[5]; a.w_alpha2 = (const float*)d_in[6]; a.b_alpha = (const float*)d_in[7]; a.gla_norm_w = (const float*)d_in[8]; a.w_out = (const float*)d_in[9];
    a.norm2_w = (const float*)d_in[10]; a.w_router = (const float*)d_in[11]; a.b_router = (const float*)d_in[12]; a.w_gate_up = (const float*)d_in[13]; a.b_gate_up = (const float*)d_in[14];
    a.w_down = (const float*)d_in[15]; a.b_down = (const float*)d_in[16]; a.final_norm_w = (const float*)d_in[17];
    a.out = (float*)d_out; a.ws = (unsigned char*)d_ws;
    if (N_LAUNCHES == 1) { a.ph_lo = 0; a.ph_hi = NPHASE; hipLaunchKernelGGL(fwd, dim3(grid), dim3(512), LDS_BYTES, stream, a); }
    else for (int p = 0; p < NPHASE; ++p) { a.ph_lo = p; a.ph_hi = p + 1; hipLaunchKernelGGL(fwd, dim3(grid), dim3(512), LDS_BYTES, stream, a); }
}
```

```cpp
#define HARVEST_MASK 0
#include <hip/hip_runtime.h>
#include <stdint.h>
#include <stdio.h>

#define LAS __attribute__((address_space(3)))
typedef unsigned short bf16_t;
typedef short bf16x8 __attribute__((ext_vector_type(8)));
typedef float f32x4 __attribute__((ext_vector_type(4)));
typedef float f32x2 __attribute__((ext_vector_type(2)));
typedef unsigned u32x4 __attribute__((ext_vector_type(4)));
typedef unsigned u32x2 __attribute__((ext_vector_type(2)));

constexpr int DM = 2048, NBATCH = 2, SEQ = 4096, NTOK = 8192;
constexpr int DIN = 6160, NPROJ = 6144;
constexpr int NE = 32, TOPK = 4;
constexpr int C_QA = 0, C_KA = 512, C_VA = 1024, C_GA = 2048, C_QB = 3072, C_KB = 4096, C_VB = 5120;
constexpr int MAXROWS = 40960;
constexpr float EPS = 1e-6f;

constexpr size_t MB = 1024ull * 1024ull;
constexpr size_t WS_BAR = 0;
constexpr size_t WS_CNT = 16384;
constexpr size_t WS_ZERO_BYTES = 20480;
constexpr size_t WS_MOD = 32768;
constexpr size_t WS_ROPE = 1 * MB;
constexpr size_t WS_H1 = 3 * MB;
constexpr size_t WS_GK = WS_H1 + 32 * MB;
constexpr size_t WS_PROJ = WS_GK + 16 * MB;
constexpr size_t WS_WIN_T = WS_PROJ + 96 * MB;
constexpr size_t WS_WOUT_T = WS_WIN_T + 24 * MB;
constexpr size_t WS_WGU_T = WS_WOUT_T + 8 * MB;
constexpr size_t WS_WD_T = WS_WGU_T + 512 * MB;
constexpr size_t WS_BCUM = WS_WD_T + 256 * MB;
constexpr size_t WS_DST = WS_BCUM + 16 * MB;
constexpr size_t WS_DEC = WS_DST + 64 * MB;
constexpr size_t WS_ST = WS_DEC + 1 * MB;
constexpr size_t WS_QBR = WS_ST + 32 * MB;
constexpr size_t WS_KBR = WS_QBR + 16 * MB;
constexpr size_t WS_VBT = WS_KBR + 16 * MB;
constexpr size_t WS_KMEAN = WS_VBT + 16 * MB;
constexpr size_t WS_SEL = WS_KMEAN + 1 * MB;
constexpr size_t WS_OCAT = WS_SEL + 1 * MB;
constexpr size_t WS_X1 = WS_OCAT + 32 * MB;
constexpr size_t WS_PAIR_E = WS_X1 + 64 * MB;
constexpr size_t WS_PAIR_POS = WS_PAIR_E + 1 * MB;
constexpr size_t WS_PAIR_W = WS_PAIR_POS + 1 * MB;
constexpr size_t WS_SLOTROW = WS_PAIR_W + 1 * MB;
constexpr size_t WS_WBUF = WS_SLOTROW + 1 * MB;
constexpr size_t WS_XG = WS_WBUF + 1 * MB;
constexpr size_t WS_ACT = WS_XG + 160 * MB;
constexpr size_t WS_Y = WS_ACT + 160 * MB;
constexpr size_t WS_END = WS_Y + 160 * MB;

constexpr int LDS_BYTES = 147456;
constexpr int LDS_XB = 131072;
constexpr int LDS_TAB = 131072 + 64;
constexpr int LDS_EXTRA = 131072 + 1024;

struct Args {
    const float* x; const float* c; const float* w_ada; const float* b_ada; const float* norm1_w; const float* w_in; const float* w_alpha2; const float* b_alpha;
    const float* gla_norm_w; const float* w_out; const float* norm2_w; const float* w_router; const float* b_router; const float* w_gate_up; const float* b_gate_up;
    const float* w_down; const float* b_down; const float* final_norm_w;
    float* out; unsigned char* ws;
    int ph_lo, ph_hi;
};

__device__ __forceinline__ unsigned cvt_pk_bf16(float lo, float hi) { unsigned r; asm("v_cvt_pk_bf16_f32 %0, %1, %2" : "=v"(r) : "v"(lo), "v"(hi)); return r; }
__device__ __forceinline__ bf16_t f2bf(float f) { return (bf16_t)(cvt_pk_bf16(f, 0.f) & 0xffffu); }
__device__ __forceinline__ float bf2f(bf16_t b) { return __uint_as_float(((unsigned)b) << 16); }
__device__ __forceinline__ float bflo(unsigned w) { return __uint_as_float(w << 16); }
__device__ __forceinline__ float bfhi(unsigned w) { return __uint_as_float(w & 0xffff0000u); }
__device__ __forceinline__ float wave_sum(float v) {
#pragma unroll
    for (int o = 1; o < 64; o <<= 1) v += __shfl_xor(v, o);
    return v;
}
#ifndef FP8_EMU
#define FP8_EMU 0
#endif
__device__ __forceinline__ float q8(float x) { return __builtin_amdgcn_cvt_f32_fp8(__builtin_amdgcn_cvt_pk_fp8_f32(x, x, 0, false), 0); }
__device__ __forceinline__ float silu_f(float v) { return v / (1.f + expf(-v)); }
__device__ __forceinline__ f32x4 mfma16(bf16x8 a, bf16x8 b, f32x4 c) { return __builtin_amdgcn_mfma_f32_16x16x32_bf16(a, b, c, 0, 0, 0); }
__device__ __forceinline__ bf16x8 lds_frag(const LAS bf16_t* img, int ld, int r0, int k0, int lane) {
    return *(const LAS bf16x8*)(img + (r0 + (lane & 15)) * ld + k0 + 8 * (lane >> 4));
}

#define XB_TMO      128
#define XB_XCNT(j)  (256  + 64 * (j))
#define XB_XSUB(j)  (1280 + 64 * (j))
#define XB_XGEN(j)  (2304 + 64 * (j))
#define XB_TOP      3328
#define XB_TOPGEN   3392
#define XCD_BAR_WORDS 3456
#define XB_SPIN_CAP (1u << 18)
__device__ __forceinline__ unsigned xb_ld(unsigned* p)              { return __hip_atomic_load(p, __ATOMIC_RELAXED, __HIP_MEMORY_SCOPE_AGENT); }
__device__ __forceinline__ unsigned xb_add(unsigned* p, unsigned v) { return __hip_atomic_fetch_add(p, v, __ATOMIC_RELAXED, __HIP_MEMORY_SCOPE_AGENT); }
__device__ __forceinline__ unsigned xb_xcc_id() { return (unsigned)__builtin_amdgcn_s_getreg((3 << 11) | 20) & 0xFu; }
#define XB_SPIN(cond, bar) do { unsigned _sp = 0; while (cond) { __builtin_amdgcn_s_sleep(1); \
    if ((++_sp & 255u) == 0u) { if (xb_ld(&(bar)[XB_TMO])) break; if (_sp > XB_SPIN_CAP) { atomicAdd(&(bar)[XB_TMO], 1u); break; } } } } while (0)
struct XcdBarrier { unsigned* bar; unsigned x; volatile LAS unsigned* st; };
__device__ __forceinline__ XcdBarrier xcd_barrier_post(unsigned* bar, volatile LAS unsigned* st) {
    XcdBarrier b; b.bar = bar; b.x = xb_xcc_id(); b.st = st;
    if (threadIdx.x == 0) (void)xb_add(&bar[XB_XCNT(b.x)], 1u);
    return b;
}
__device__ __forceinline__ void xcd_barrier_complete(unsigned* bar, unsigned x, unsigned& nloc, unsigned& nx) {
    const unsigned G = gridDim.x * gridDim.y * gridDim.z;
    unsigned sum, cnt, mine, sp = 0u;
    for (;;) {
        sum = 0u; cnt = 0u; mine = 0u;
#pragma unroll
        for (unsigned j = 0; j < 16; ++j) { const unsigned c = xb_ld(&bar[XB_XCNT(j)]); sum += c; cnt += (c > 0u) ? 1u : 0u; mine = (j == x) ? c : mine; }
        if (sum == G) break;
        __builtin_amdgcn_s_sleep(1);
        if ((++sp & 255u) == 0u) { if (xb_ld(&bar[XB_TMO])) break; if (sp > XB_SPIN_CAP) { atomicAdd(&bar[XB_TMO], 1u); break; } }
    }
    nloc = mine > 0u ? mine : 1u; nx = cnt > 0u ? cnt : 1u;
}
template <class Idle>
__device__ __forceinline__ void xcd_barrier(const XcdBarrier& b, Idle&& idle) {
    asm volatile("s_waitcnt vmcnt(0)" ::: "memory");
    __syncthreads();
    if (threadIdx.x == 0) {
        unsigned* bar = b.bar;
        __builtin_amdgcn_s_waitcnt(0);
        unsigned nloc = b.st[0], nx = b.st[1];
        if (nloc == 0u) { xcd_barrier_complete(bar, b.x, nloc, nx); b.st[0] = nloc; b.st[1] = nx; }
        const unsigned old = xb_add(&bar[XB_XSUB(b.x)], 1u);
        const unsigned gen = old / nloc;
        if (old + 1u == (gen + 1u) * nloc) {
            __builtin_amdgcn_fence(__ATOMIC_RELEASE, "agent");
            asm volatile("s_waitcnt vmcnt(0)" ::: "memory");
            const unsigned og = xb_add(&bar[XB_TOP], 1u);
            const unsigned tg = og / nx;
            if (og + 1u == (tg + 1u) * nx) xb_add(&bar[XB_TOPGEN], 1u);
            else XB_SPIN(xb_ld(&bar[XB_TOPGEN]) == tg, bar);
            __builtin_amdgcn_fence(__ATOMIC_ACQUIRE, "agent");
            xb_add(&bar[XB_XGEN(b.x)], 1u);
            asm volatile("s_waitcnt vmcnt(0)" ::: "memory");
            b.st[2] = 1u;
        } else { b.st[2] = 0u; b.st[3] = gen; }
    }
    __syncthreads();
    unsigned rounds = 0u;
    while (b.st[2] == 0u) {
        const bool had = idle();
        const unsigned long long anyw = __ballot(had);
        __syncthreads();
        if (threadIdx.x == 0) {
            unsigned* bar = b.bar; const unsigned gen = b.st[3];
            bool rel = xb_ld(&bar[XB_XGEN(b.x)]) != gen;
            if (!rel && anyw == 0ull) { XB_SPIN(xb_ld(&bar[XB_XGEN(b.x)]) == gen, bar); rel = true; }
            if (!rel && ++rounds > (1u << 16)) { atomicAdd(&bar[XB_TMO], 1u); rel = true; }
            if (rel) { __builtin_amdgcn_fence(__ATOMIC_ACQUIRE, "agent"); asm volatile("s_waitcnt vmcnt(0)" ::: "memory"); b.st[2] = 1u; }
        }
        __syncthreads();
    }
}

#ifndef FP8_ASM
#define FP8_ASM 0
#endif
namespace pg8 {
constexpr int BM = 256, BK = 64, HALF = 128, HTB = HALF * BK * 2, STAGE_BYTES = 8 * HTB, NXCD = 8, WGM = 8;
__host__ __device__ __forceinline__ int lds_byte(int r, int c) { const int st = (r >> 4) * 2 + (c >> 5), rr = r & 15, cc = c & 31, ob = rr * 64 + cc * 2; return st * 1024 + (ob ^ (((ob >> 9) & 1) << 5)); }
__host__ __device__ __forceinline__ void stage_rc(int b, int& R, int& C) { const int st = b / 1024, sb = b % 1024, swz = sb ^ (((sb >> 9) & 1) << 5); R = (st >> 1) * 16 + swz / 64; C = (st & 1) * 32 + (swz % 64) / 2; }
__host__ __device__ __forceinline__ int perm32(int rho) { const int n = rho >> 4, i = rho & 15; return 8 * (i >> 2) + 4 * n + (i & 3); }

struct Unit { int pm, pn, e, full; };
struct Gemm { const bf16_t* A; const bf16_t* Bt; int K; size_t b_estride; };

struct StaticOrder {
    int nM, nN, nwg, G, c;
    __device__ void init(int M, int N, int G_, int c_) { nM = M / BM; nN = N / BM; nwg = nM * nN; G = G_; c = c_; }
    __device__ bool next(int i, Unit& u) const {
        const long L = (long)i * G + c; if (L >= nwg) return false;
        int wgid = (int)L; { const int q = nwg / NXCD, r = nwg % NXCD, xcd = wgid % NXCD, off = wgid / NXCD; wgid = (xcd < r ? xcd * (q + 1) : r * (q + 1) + (xcd - r) * q) + off; }
        const int nig = WGM * nN, gid = wgid / nig, fm = gid * WGM, gsz = (nM - fm) < WGM ? (nM - fm) : WGM;
        u.pm = fm + ((wgid % nig) % gsz); u.pn = (wgid % nig) / gsz; u.e = 0; u.full = 1; return true;
    }
};
struct MoeOrder {
    const LAS int* tab; int r, nper;
    __device__ bool next(int i, Unit& u) const {
        const int L = i * nper + r; if (L >= __builtin_amdgcn_readfirstlane(tab[1])) return false;
        int p = 0; const int np = tab[0];
#pragma unroll 1
        while (p + 1 < np && tab[4 + 8 * (p + 1)] <= L) ++p;
        const LAS int* t = tab + 4 + 8 * p;
        const int local = L - t[0], mte = t[3], pq = local / mte, mt = local - pq * mte;
        u.e = __builtin_amdgcn_readfirstlane(t[1]); u.pn = __builtin_amdgcn_readfirstlane(t[2] + pq); u.pm = __builtin_amdgcn_readfirstlane(t[4] + mt);
        u.full = __builtin_amdgcn_readfirstlane((t[5] - mt * 256) > 128 ? 1 : 0); return true;
    }
};

struct EpiProj {
    static constexpr bool PERM = true;
    bf16_t* O; int ldc;
    __device__ __forceinline__ void operator()(const f32x4 (&acc)[2][2][4][2], const Unit& u, int wr, int wc, int fr, int fq) const {
        const int row0 = u.pm * BM + wr * 64 + fr, col0 = u.pn * BM + wc * 32 + 8 * fq;
#pragma unroll
        for (int ai = 0; ai < 2; ++ai)
#pragma unroll
            for (int m = 0; m < 4; ++m) { bf16_t* rowp = O + (size_t)(row0 + ai * HALF + m * 16) * ldc + col0;
#pragma unroll
                for (int bj = 0; bj < 2; ++bj) { const f32x4 v0 = acc[ai][bj][m][0], v1 = acc[ai][bj][m][1];
                    u32x4 w; w.x = cvt_pk_bf16(v0[0], v0[1]); w.y = cvt_pk_bf16(v0[2], v0[3]); w.z = cvt_pk_bf16(v1[0], v1[1]); w.w = cvt_pk_bf16(v1[2], v1[3]);
                    *(u32x4*)(rowp + bj * HALF) = w; } }
    }
};
struct EpiOut {
    static constexpr bool PERM = false;
    const float* X; const float* g1;   float* O;
    __device__ __forceinline__ void operator()(const f32x4 (&acc)[2][2][4][2], const Unit& u, int wr, int wc, int fr, int fq) const {
        const int row0 = u.pm * BM + wr * 64 + fr, col0 = u.pn * BM + wc * 32 + 4 * fq;
        const float* gp = g1 + (size_t)((u.pm * BM) >> 12) * 12288 + col0;
        f32x4 gv[2][2];
#pragma unroll
        for (int bj = 0; bj < 2; ++bj)
#pragma unroll
            for (int n = 0; n < 2; ++n) gv[bj][n] = *(const f32x4*)(gp + bj * HALF + n * 16);
#pragma unroll
        for (int ai = 0; ai < 2; ++ai)
#pragma unroll
            for (int m = 0; m < 4; ++m) { const size_t off = (size_t)(row0 + ai * HALF + m * 16) * DM + col0;
#pragma unroll
                for (int bj = 0; bj < 2; ++bj)
#pragma unroll
                    for (int n = 0; n < 2; ++n) { const f32x4 xv = *(const f32x4*)(X + off + bj * HALF + n * 16);
                        *(f32x4*)(O + off + bj * HALF + n * 16) = xv + gv[bj][n] * acc[ai][bj][m][n]; }
                asm volatile("" ::: "memory"); }
    }
};
struct EpiGU {
    static constexpr bool PERM = true;
    const float* bias;   bf16_t* O;
    __device__ __forceinline__ void operator()(const f32x4 (&acc)[2][2][4][2], const Unit& u, int wr, int wc, int fr, int fq) const {
        const int row0 = u.pm * BM + wr * 64 + fr, cc = u.pn * HALF + wc * 32 + 8 * fq;
        const float* bp = bias + (size_t)u.e * 4096 + cc;
        f32x4 bg[2], bu[2];
#pragma unroll
        for (int n = 0; n < 2; ++n) { bg[n] = *(const f32x4*)(bp + 4 * n); bu[n] = *(const f32x4*)(bp + 2048 + 4 * n); }
#pragma unroll
        for (int ai = 0; ai < 2; ++ai)
#pragma unroll
            for (int m = 0; m < 4; ++m) { float r[8];
#pragma unroll
                for (int n = 0; n < 2; ++n)
#pragma unroll
                    for (int j = 0; j < 4; ++j) {
                        float g = acc[ai][0][m][n][j] + bg[n][j], uu = acc[ai][1][m][n][j] + bu[n][j];
                        g = fminf(g, 7.0f); uu = fminf(fmaxf(uu, -7.0f), 7.0f);
                        const float glu = g * __builtin_amdgcn_rcpf(1.0f + __expf(-1.702f * g));
                        r[n * 4 + j] = (uu + 1.0f) * glu;
#if FP8_EMU
                        r[n * 4 + j] = q8(r[n * 4 + j]);
#endif
                    }
                u32x4 w; w.x = cvt_pk_bf16(r[0], r[1]); w.y = cvt_pk_bf16(r[2], r[3]); w.z = cvt_pk_bf16(r[4], r[5]); w.w = cvt_pk_bf16(r[6], r[7]);
                *(u32x4*)(O + (size_t)(row0 + ai * HALF + m * 16) * DM + cc) = w; }
    }
};
struct EpiDown {
    static constexpr bool PERM = true;
    const float* bias;   const float* wbuf; bf16_t* O;
    __device__ __forceinline__ void operator()(const f32x4 (&acc)[2][2][4][2], const Unit& u, int wr, int wc, int fr, int fq) const {
        const int row0 = u.pm * BM + wr * 64 + fr, col0 = u.pn * BM + wc * 32 + 8 * fq;
        const float* bp = bias + (size_t)u.e * 2048 + col0;
        f32x4 bv[2][2];
#pragma unroll
        for (int bj = 0; bj < 2; ++bj)
#pragma unroll
            for (int n = 0; n < 2; ++n) bv[bj][n] = *(const f32x4*)(bp + bj * HALF + 4 * n);
#pragma unroll
        for (int ai = 0; ai < 2; ++ai)
#pragma unroll
            for (int m = 0; m < 4; ++m) { const int row = row0 + ai * HALF + m * 16; const float rw = wbuf[row]; bf16_t* rowp = O + (size_t)row * DM + col0;
#pragma unroll
                for (int bj = 0; bj < 2; ++bj) { const f32x4 v0 = (acc[ai][bj][m][0] + bv[bj][0]) * rw, v1 = (acc[ai][bj][m][1] + bv[bj][1]) * rw;
                    u32x4 w; w.x = cvt_pk_bf16(v0[0], v0[1]); w.y = cvt_pk_bf16(v0[2], v0[3]); w.z = cvt_pk_bf16(v1[0], v1[1]); w.w = cvt_pk_bf16(v1[2], v1[3]);
                    *(u32x4*)(rowp + bj * HALF) = w; } }
    }
};

__device__ __forceinline__ unsigned pk4_fp8(float a, float b, float c, float d) { int p = __builtin_amdgcn_cvt_pk_fp8_f32(a, b, 0, false); p = __builtin_amdgcn_cvt_pk_fp8_f32(c, d, p, true); return (unsigned)p; }
constexpr float W8_SCALE = 64.0f, W8_INV = 1.0f / 64.0f;
struct EpiGU8 {
    static constexpr bool PERM = true;
    const float* bias;   unsigned char* O;
    __device__ __forceinline__ void operator()(const f32x4 (&acc)[2][2][4][2], const Unit& u, int wr, int wc, int fr, int fq) const {
        const int row0 = u.pm * BM + wr * 64 + fr, cc = u.pn * HALF + wc * 32 + 8 * fq;
        const float* bp = bias + (size_t)u.e * 4096 + cc;
        f32x4 bg[2], bu[2];
#pragma unroll
        for (int n = 0; n < 2; ++n) { bg[n] = *(const f32x4*)(bp + 4 * n); bu[n] = *(const f32x4*)(bp + 2048 + 4 * n); }
#pragma unroll
        for (int ai = 0; ai < 2; ++ai)
#pragma unroll
            for (int m = 0; m < 4; ++m) { float r[8];
#pragma unroll
                for (int n = 0; n < 2; ++n)
#pragma unroll
                    for (int j = 0; j < 4; ++j) {
                        float g = acc[ai][0][m][n][j] * W8_INV + bg[n][j], uu = acc[ai][1][m][n][j] * W8_INV + bu[n][j];
                        g = fminf(g, 7.0f); uu = fminf(fmaxf(uu, -7.0f), 7.0f);
                        const float glu = g * __builtin_amdgcn_rcpf(1.0f + __expf(-1.702f * g));
                        r[n * 4 + j] = (uu + 1.0f) * glu; }
                u32x2 w; w.x = pk4_fp8(r[0], r[1], r[2], r[3]); w.y = pk4_fp8(r[4], r[5], r[6], r[7]);
                *(u32x2*)(O + (size_t)(row0 + ai * HALF + m * 16) * DM + cc) = w; }
    }
};
struct EpiDown8 {
    static constexpr bool PERM = true;
    const float* bias;   const float* wbuf; bf16_t* O;
    __device__ __forceinline__ void operator()(const f32x4 (&acc)[2][2][4][2], const Unit& u, int wr, int wc, int fr, int fq) const {
        const int row0 = u.pm * BM + wr * 64 + fr, col0 = u.pn * BM + wc * 32 + 8 * fq;
        const float* bp = bias + (size_t)u.e * 2048 + col0;
        f32x4 bv[2][2];
#pragma unroll
        for (int bj = 0; bj < 2; ++bj)
#pragma unroll
            for (int n = 0; n < 2; ++n) bv[bj][n] = *(const f32x4*)(bp + bj * HALF + 4 * n);
#pragma unroll
        for (int ai = 0; ai < 2; ++ai)
#pragma unroll
            for (int m = 0; m < 4; ++m) { const int row = row0 + ai * HALF + m * 16; const float rw = wbuf[row]; bf16_t* rowp = O + (size_t)row * DM + col0;
#pragma unroll
                for (int bj = 0; bj < 2; ++bj) { const f32x4 v0 = (acc[ai][bj][m][0] * W8_INV + bv[bj][0]) * rw, v1 = (acc[ai][bj][m][1] * W8_INV + bv[bj][1]) * rw;
                    u32x4 w; w.x = cvt_pk_bf16(v0[0], v0[1]); w.y = cvt_pk_bf16(v0[2], v0[3]); w.z = cvt_pk_bf16(v1[0], v1[1]); w.w = cvt_pk_bf16(v1[2], v1[3]);
                    *(u32x4*)(rowp + bj * HALF) = w; } }
    }
};

typedef int i32x8 __attribute__((ext_vector_type(8)));
typedef short s16x16 __attribute__((ext_vector_type(16)));
__device__ __forceinline__ i32x8 ld32(const LAS unsigned char* p) { const bf16x8 lo = *(const LAS bf16x8*)p, hi = *(const LAS bf16x8*)(p + 16); return __builtin_bit_cast(i32x8, __builtin_shufflevector(lo, hi, 0, 1, 2, 3, 4, 5, 6, 7, 8, 9, 10, 11, 12, 13, 14, 15)); }
__device__ __forceinline__ const char* sbase(const char* p) { asm volatile("" : "+s"(p)); return p; }
template <bool FP8, class Epi, class Sched>
__device__ __forceinline__ void gemm_phase(LAS unsigned char* lds, const Gemm g, const Sched& S, const Epi& E) {
    const int tid = threadIdx.x, wid = __builtin_amdgcn_readfirstlane(tid >> 6), lane = tid & 63, wr = wid >> 2, wc = wid & 3, fr = lane & 15, fq = lane >> 4;
    const int K = g.K, nt = K / BK;
    unsigned voffA, voffB;
    { int R, C; stage_rc(tid * 16, R, C); const int Rb = Epi::PERM ? ((R & ~31) + perm32(R & 31)) : R; voffA = (unsigned)(R * K + C) * 2u; voffB = (unsigned)(Rb * K + C) * 2u; }
    const size_t pstep = (size_t)64 * K * 2;
    const size_t kstep = (size_t)(BK * 2);
    const size_t hstep = (size_t)HALF * K * 2;
    const size_t tstep = 2 * hstep;
    const size_t estep = g.b_estride * 2;
    const unsigned ldsw = (unsigned)wid * 1024u;
    const int aoff0 = FP8 ? lds_byte(wr * 64 + fr, fq * 16) : lds_byte(wr * 64 + fr, fq * 8), boff0 = FP8 ? lds_byte(wc * 32 + fr, fq * 16) : lds_byte(wc * 32 + fr, fq * 8);
#define PG8_SA(b, h) (((b) * 2 + (h)) * HTB)
#define PG8_SB(b, h) ((4 + (b) * 2 + (h)) * HTB)
#define PG8_STAGE(bufoff, gbase, voff) do { _Pragma("unroll") for (int _i = 0; _i < 2; ++_i) \
        __builtin_amdgcn_global_load_lds((const unsigned*)(sbase((const char*)(gbase) + _i * pstep) + (voff)), (LAS unsigned*)(lds + (bufoff) + ldsw + _i * 8192), 16, 0, 0); } while (0)
#define PG8_LDA(dst, b, h) do { _Pragma("unroll") for (int m = 0; m < 4; ++m) { \
        if constexpr (FP8) dst##8[m] = ld32(lds + PG8_SA(b, h) + aoff0 + m * 2048); \
        else { dst[m][0] = *(const LAS bf16x8*)(lds + PG8_SA(b, h) + aoff0 + m * 2048); dst[m][1] = *(const LAS bf16x8*)(lds + PG8_SA(b, h) + aoff0 + m * 2048 + 1024); } } } while (0)
#define PG8_LDB(dst, b, h) do { _Pragma("unroll") for (int n = 0; n < 2; ++n) { \
        if constexpr (FP8) dst##8[n] = ld32(lds + PG8_SB(b, h) + boff0 + n * 2048); \
        else { dst[n][0] = *(const LAS bf16x8*)(lds + PG8_SB(b, h) + boff0 + n * 2048); dst[n][1] = *(const LAS bf16x8*)(lds + PG8_SB(b, h) + boff0 + n * 2048 + 1024); } } } while (0)
#define PG8_MMA(ai, bj, At, Bt) do { __builtin_amdgcn_s_setprio(1); _Pragma("unroll") for (int m = 0; m < 4; ++m) _Pragma("unroll") for (int n = 0; n < 2; ++n) { \
        if constexpr (FP8) { if (FP8_ASM) { asm volatile("v_mfma_scale_f32_16x16x128_f8f6f4 %0, %1, %2, %0, %3, %3 op_sel_hi:[0,0,0]" : "+a"(acc[ai][bj][m][n]) : "v"(Bt##8[n]), "v"(At##8[m]), "v"(scale1)); } \
            else acc[ai][bj][m][n] = __builtin_amdgcn_mfma_scale_f32_16x16x128_f8f6f4(Bt##8[n], At##8[m], acc[ai][bj][m][n], 0, 0, 0, 0x7f7f7f7f, 0, 0x7f7f7f7f); } \
        else { acc[ai][bj][m][n] = __builtin_amdgcn_mfma_f32_16x16x32_bf16(Bt[n][0], At[m][0], acc[ai][bj][m][n], 0, 0, 0); \
               acc[ai][bj][m][n] = __builtin_amdgcn_mfma_f32_16x16x32_bf16(Bt[n][1], At[m][1], acc[ai][bj][m][n], 0, 0, 0); } } \
        __builtin_amdgcn_s_setprio(0); } while (0)
#define PG8_WAIT_V(n) asm volatile("s_waitcnt vmcnt(" #n ")" ::: "memory")
#define PG8_WAIT_L(n) asm volatile("s_waitcnt lgkmcnt(" #n ")" ::: "memory")
#define PG8_BAR __builtin_amdgcn_s_barrier()
#define PG8_SCHED __builtin_amdgcn_sched_barrier(0)
    Unit cur, nxt; int ui = 0;
    if (!S.next(0, cur)) return;
    f32x4 acc[2][2][4][2];
#pragma unroll
    for (int a = 0; a < 2; ++a)
#pragma unroll
        for (int b = 0; b < 2; ++b)
#pragma unroll
            for (int m = 0; m < 4; ++m)
#pragma unroll
                for (int n = 0; n < 2; ++n) acc[a][b][m][n] = (f32x4){0.f, 0.f, 0.f, 0.f};
    bf16x8 At[4][2], B0[2][2], B1[2][2]; i32x8 At8[4], B08[2], B18[2];
    const unsigned scale1 = 0x7f7f7f7fu;
    const char* cA = (const char*)g.A + (size_t)cur.pm * tstep; const char* cB = (const char*)g.Bt + (size_t)cur.e * estep + (size_t)cur.pn * tstep;
    PG8_STAGE(PG8_SB(0, 0), cB, voffB); PG8_STAGE(PG8_SA(0, 0), cA, voffA); PG8_STAGE(PG8_SB(0, 1), cB + hstep, voffB); PG8_STAGE(PG8_SA(0, 1), cA + hstep, voffA);
    if (wr == 1) PG8_BAR;
    PG8_WAIT_V(4); PG8_BAR;
    PG8_STAGE(PG8_SB(1, 0), cB + kstep, voffB); PG8_STAGE(PG8_SA(1, 0), cA + kstep, voffA); PG8_STAGE(PG8_SB(1, 1), cB + hstep + kstep, voffB);
    PG8_WAIT_V(6); PG8_BAR;
    for (;;) {
        const bool has_next = S.next(ui + 1, nxt);
        const bool cfull = FP8 ? true : (cur.full != 0);
        const char* nA = has_next ? (const char*)g.A + (size_t)nxt.pm * tstep : cA;
        const char* nB = has_next ? (const char*)g.Bt + (size_t)nxt.e * estep + (size_t)nxt.pn * tstep : cB;
        for (int t = 0; t < nt; t += 2) {
            const bool last = (t == nt - 2);
            const char* a1 = cA + (size_t)(t + 1) * kstep;
            const char* a2 = last ? nA : cA + (size_t)(t + 2) * kstep; const char* b2 = last ? nB : cB + (size_t)(t + 2) * kstep;
            const char* a3 = a2 + kstep; const char* b3 = b2 + kstep;
            PG8_LDB(B0, 0, 0); PG8_SCHED; PG8_LDA(At, 0, 0); PG8_STAGE(PG8_SA(1, 1), a1 + hstep, voffA);
            PG8_WAIT_L(8); PG8_BAR; PG8_WAIT_L(0); PG8_MMA(0, 0, At, B0); PG8_BAR; PG8_SCHED;
            PG8_LDB(B1, 0, 1); PG8_STAGE(PG8_SB(0, 0), b2, voffB);
            PG8_BAR; PG8_WAIT_L(0); PG8_MMA(0, 1, At, B1); PG8_BAR;
            PG8_LDA(At, 0, 1); PG8_STAGE(PG8_SA(0, 0), a2, voffA);
            PG8_BAR; PG8_WAIT_L(0); if (cfull) PG8_MMA(1, 0, At, B0); PG8_BAR; PG8_SCHED;
            PG8_STAGE(PG8_SB(0, 1), b2 + hstep, voffB);
            PG8_WAIT_V(6); PG8_BAR; if (cfull) PG8_MMA(1, 1, At, B1); PG8_BAR;
            PG8_LDB(B0, 1, 0); PG8_SCHED; PG8_LDA(At, 1, 0); PG8_STAGE(PG8_SA(0, 1), a2 + hstep, voffA);
            PG8_WAIT_L(8); PG8_BAR; PG8_WAIT_L(0); PG8_MMA(0, 0, At, B0); PG8_BAR; PG8_SCHED;
            PG8_LDB(B1, 1, 1); PG8_STAGE(PG8_SB(1, 0), b3, voffB);
            PG8_BAR; PG8_WAIT_L(0); PG8_MMA(0, 1, At, B1); PG8_BAR;
            PG8_LDA(At, 1, 1); PG8_STAGE(PG8_SA(1, 0), a3, voffA);
            PG8_BAR; PG8_WAIT_L(0); if (cfull) PG8_MMA(1, 0, At, B0); PG8_BAR; PG8_SCHED;
            PG8_STAGE(PG8_SB(1, 1), b3 + hstep, voffB);
            PG8_WAIT_V(6); PG8_BAR; if (cfull) PG8_MMA(1, 1, At, B1); PG8_BAR;
        }
        {
            int tz = threadIdx.x; asm volatile("" : "+v"(tz)); const int lz = tz & 63;
            E(acc, cur, wr, wc, lz & 15, lz >> 4); }
        if (!has_next) break;
#pragma unroll
        for (int a = 0; a < 2; ++a)
#pragma unroll
            for (int b = 0; b < 2; ++b)
#pragma unroll
                for (int m = 0; m < 4; ++m)
#pragma unroll
                    for (int n = 0; n < 2; ++n) acc[a][b][m][n] = (f32x4){0.f, 0.f, 0.f, 0.f};
        cur = nxt; cA = nA; cB = nB; ++ui;
    }
    PG8_WAIT_V(0);
    if (wr == 0) PG8_BAR;
    PG8_BAR;
#undef PG8_SA
#undef PG8_SB
#undef PG8_STAGE
#undef PG8_LDA
#undef PG8_LDB
#undef PG8_MMA
#undef PG8_WAIT_V
#undef PG8_WAIT_L
#undef PG8_BAR
#undef PG8_SCHED
}
}

__device__ __forceinline__ void conv_job(const float* src, int ld, bf16_t* dst, int kt) {
    const int w = threadIdx.x >> 6, lane = threadIdx.x & 63, kseg = lane & 7, nq = lane >> 3;
    const int k0 = kt * 128 + (w >> 2) * 64 + kseg * 8, nl = (w & 3) * 32 + nq * 4;
    f32x4 v[8];
#pragma unroll
    for (int r = 0; r < 8; ++r) v[r] = *(const f32x4*)(src + (size_t)(k0 + r) * ld + nl);
#pragma unroll
    for (int j = 0; j < 4; ++j) { u32x4 o; o.x = cvt_pk_bf16(v[0][j], v[1][j]); o.y = cvt_pk_bf16(v[2][j], v[3][j]); o.z = cvt_pk_bf16(v[4][j], v[5][j]); o.w = cvt_pk_bf16(v[6][j], v[7][j]);
        *(u32x4*)(dst + (size_t)(nl + j) * 2048 + k0) = o; }
}
constexpr int CONV_JOBS_GU = 32 * 16 * 128, CONV_JOBS_D = 32 * 16 * 64, CONV_JOBS = CONV_JOBS_GU + CONV_JOBS_D;
__device__ __forceinline__ void conv_wave_job(const Args& a, int j, int lane) {
    const float* src; int ld; unsigned char* dst;
    if (j < CONV_JOBS_GU) { const int e = j >> 11, kb = (j >> 7) & 15, nb = j & 127, s0 = nb * 32, bj = s0 >> 11, rem = s0 & 2047, pn = rem >> 7, c0 = rem & 127, np = pn * 256 + bj * 128 + c0;
        src = a.w_gate_up + ((size_t)e * 2048 + kb * 128) * 4096 + s0; ld = 4096; dst = (unsigned char*)(a.ws + WS_WGU_T) + ((size_t)e * 4096 + np) * 2048 + kb * 128; }
    else { const int jj = j - CONV_JOBS_GU, e = jj >> 10, kb = (jj >> 6) & 15, nb = jj & 63;
        src = a.w_down + ((size_t)e * 2048 + kb * 128) * 2048 + nb * 32; ld = 2048; dst = (unsigned char*)(a.ws + WS_WD_T) + ((size_t)e * 2048 + nb * 32) * 2048 + kb * 128; }
    const int kseg = lane & 7, nq = lane >> 3;
    f32x4 v[16];
#pragma unroll
    for (int r = 0; r < 16; ++r) v[r] = __builtin_nontemporal_load((const f32x4*)(src + (size_t)(kseg * 16 + r) * ld + nq * 4)) * pg8::W8_SCALE;
#pragma unroll
    for (int jn = 0; jn < 4; ++jn) { u32x4 o;
        o.x = pg8::pk4_fp8(v[0][jn], v[1][jn], v[2][jn], v[3][jn]); o.y = pg8::pk4_fp8(v[4][jn], v[5][jn], v[6][jn], v[7][jn]);
        o.z = pg8::pk4_fp8(v[8][jn], v[9][jn], v[10][jn], v[11][jn]); o.w = pg8::pk4_fp8(v[12][jn], v[13][jn], v[14][jn], v[15][jn]);
        __builtin_nontemporal_store(o, (u32x4*)(dst + (size_t)(nq * 4 + jn) * 2048 + kseg * 16)); }
}
__device__ __forceinline__ bool conv_claim(const Args& a, int nj) {
    const int lane = threadIdx.x & 63; unsigned* q = (unsigned*)(a.ws + WS_CNT) + 64;
    unsigned j0 = 0u;
    if (lane == 0) j0 = __hip_atomic_fetch_add(q, (unsigned)nj, __ATOMIC_RELAXED, __HIP_MEMORY_SCOPE_AGENT);
    j0 = (unsigned)__builtin_amdgcn_readfirstlane((int)j0);
    if (j0 >= (unsigned)CONV_JOBS) return false;
#pragma unroll 1
    for (int t = 0; t < nj; ++t) { const int j = (int)j0 + t; if (j < CONV_JOBS) conv_wave_job(a, j, lane); }
    return true;
}
__device__ __forceinline__ void conv_drain(const Args& a) { while (conv_claim(a, 4)) { } }

__device__ __forceinline__ void phase_prologue(const Args& a, LAS unsigned char* lds) {
    const int tid = threadIdx.x, blk = blockIdx.x, G = gridDim.x;
    if (blk < 192) {
        LAS float* cact = (LAS float*)lds; LAS float* red = (LAS float*)(lds + 16384);
        for (int i = tid; i < 4096; i += 512) cact[i] = silu_f(a.c[i]);
        __syncthreads();
        float* mod = (float*)(a.ws + WS_MOD);
        for (int cb = blk; cb < 192; cb += G) {
            const int rg = tid >> 4, cl = tid & 15;
            const float* wp = a.w_ada + (size_t)cb * 64 + cl * 4;
            f32x4 a0 = {0.f, 0.f, 0.f, 0.f}, a1 = {0.f, 0.f, 0.f, 0.f};
#pragma unroll 8
            for (int i = 0; i < 64; ++i) { const int k = rg + 32 * i; const f32x4 w = *(const f32x4*)(wp + (size_t)k * 12288); a0 += w * cact[k]; a1 += w * cact[2048 + k]; }
#pragma unroll
            for (int j = 0; j < 4; ++j) { red[(rg * 2 + 0) * 64 + cl * 4 + j] = a0[j]; red[(rg * 2 + 1) * 64 + cl * 4 + j] = a1[j]; }
            __syncthreads();
            if (tid < 128) { const int b = tid >> 6, col = tid & 63; float s = 0.f; for (int r = 0; r < 32; ++r) s += red[(r * 2 + b) * 64 + col]; mod[b * 12288 + cb * 64 + col] = s + a.b_ada[cb * 64 + col]; }
            __syncthreads();
        }
    }
    {
        float* ct = (float*)(a.ws + WS_ROPE); float* st = ct + 4096 * 64;
        for (int idx = blk * 512 + tid; idx < 4096 * 64; idx += G * 512) {
            const int t = idx >> 6, i = idx & 63;
            const float inv = (float)exp2(-(double)i * (13.287712379549449 / 64.0));
            const float ang = (float)t * inv;
            const double ad = (double)ang, n = rint(ad * 0.15915494309189535), r = fma(-n, 6.283185307179586, ad) - n * 2.4492935982947064e-16;
            const float rf = (float)r;
            ct[idx] = cosf(rf); st[idx] = sinf(rf);
        }
    }
    {
        bf16_t* win_t = (bf16_t*)(a.ws + WS_WIN_T); bf16_t* wout_t = (bf16_t*)(a.ws + WS_WOUT_T);
        for (int job = blk; job < 64 * 16; job += G) {
            const int rt = job >> 4, kt = job & 15;
            const float* src; int ld; bf16_t* dst;
            if (rt < 48) { const int n0 = rt * 128, col0 = n0 < 3072 ? n0 : n0 + 16; src = a.w_in + col0; ld = DIN; dst = win_t + (size_t)n0 * 2048; }
            else { const int n0 = (rt - 48) * 128; src = a.w_out + n0; ld = 2048; dst = wout_t + (size_t)n0 * 2048; }
            conv_job(src, ld, dst, kt);
        }
    }
}

__device__ __forceinline__ void phase_norm1(const Args& a, LAS unsigned char* lds) {
    const int tid = threadIdx.x, blk = blockIdx.x, G = gridDim.x, w = tid >> 6, lane = tid & 63;
    LAS float* wlaT = (LAS float*)lds;
#pragma unroll 16
    for (int idx = tid; idx < 2048 * 16; idx += 512) { const int k = idx >> 4, j = idx & 15; wlaT[j * 2048 + k] = a.w_in[(size_t)k * DIN + 3072 + j]; }
    __syncthreads();
    const float* mod = (const float*)(a.ws + WS_MOD);
    bf16_t* h1 = (bf16_t*)(a.ws + WS_H1); float* gk = (float*)(a.ws + WS_GK);
    for (int r = blk * 8 + w; r < NTOK; r += G * 8) {
        const f32x4* xr = (const f32x4*)(a.x + (size_t)r * DM) + lane;
        f32x4 v[8]; float ss = 0.f;
#pragma unroll
        for (int q = 0; q < 8; ++q) { v[q] = xr[64 * q]; ss += (v[q][0] * v[q][0] + v[q][1] * v[q][1]) + (v[q][2] * v[q][2] + v[q][3] * v[q][3]); }
        ss = wave_sum(ss);
        const float rstd = 1.0f / sqrtf(ss * (1.0f / DM) + EPS);
        const float* sh = mod + (size_t)(r >> 12) * 12288; const float* sc = sh + 2048;
#pragma unroll
        for (int q = 0; q < 8; ++q) { const int k = 4 * (lane + 64 * q);
            const f32x4 nw = *(const f32x4*)(a.norm1_w + k), scv = *(const f32x4*)(sc + k), shv = *(const f32x4*)(sh + k);
            v[q] = (v[q] * rstd * nw) * (scv + 1.0f) + shv;
            u32x2 o; o.x = cvt_pk_bf16(v[q][0], v[q][1]); o.y = cvt_pk_bf16(v[q][2], v[q][3]);
            *(u32x2*)(h1 + (size_t)r * DM + k) = o; }
        LAS float* las = (LAS float*)(lds + LDS_EXTRA) + w * 16;
#pragma unroll 1
        for (int j = 0; j < 16; ++j) { float s = 0.f;
#pragma unroll
            for (int q = 0; q < 8; ++q) { const f32x4 wl = *(const LAS f32x4*)(wlaT + j * 2048 + 4 * (lane + 64 * q)); s += (v[q][0] * wl[0] + v[q][1] * wl[1]) + (v[q][2] * wl[2] + v[q][3] * wl[3]); }
            s = wave_sum(s); if (lane == 0) las[j] = s; }
        asm volatile("s_waitcnt lgkmcnt(0)" ::: "memory");
#pragma unroll 1
        for (int m = 0; m < 8; ++m) { const int d = lane + 64 * m; float z = a.b_alpha[d];
#pragma unroll
            for (int j = 0; j < 16; ++j) z += las[j] * a.w_alpha2[j * 512 + d];
            const float ls = fminf(z, 0.f) - log1pf(expf(-fabsf(z)));
            gk[(size_t)r * 512 + d] = ls * (1.0f / 16.0f); }
        asm volatile("s_waitcnt lgkmcnt(0)" ::: "memory");
    }
}

__device__ __forceinline__ void gla_stage_vt(const bf16_t* proj, int row0, int h, LAS bf16_t* VT, int tid) {
    const int i = tid >> 3, seg = tid & 7;
    const u32x4* vp = (const u32x4*)(proj + (size_t)(row0 + i) * NPROJ + C_VA + h * 256 + seg * 32);
#pragma unroll
    for (int c4 = 0; c4 < 4; ++c4) { const u32x4 vv = vp[c4];
#pragma unroll
        for (int p = 0; p < 4; ++p) { const unsigned wd = vv[p]; const int e = seg * 32 + c4 * 8 + p * 2;
            VT[e * 72 + i] = (bf16_t)(wd & 0xffffu); VT[(e + 1) * 72 + i] = (bf16_t)(wd >> 16); } }
}
__device__ __forceinline__ void gla1_unit(const Args& a, LAS unsigned char* lds, int u) {
    const int tid = threadIdx.x, w = tid >> 6, lane = tid & 63;
    const int bh = u >> 6, c = u & 63, b = bh >> 2, h = bh & 3, row0 = b * SEQ + c * 64;
    LAS float* Bm = (LAS float*)lds; LAS bf16_t* KT = (LAS bf16_t*)(lds + 32768); LAS bf16_t* VT = (LAS bf16_t*)(lds + 51200);
    const float* gk = (const float*)(a.ws + WS_GK); const bf16_t* proj = (const bf16_t*)(a.ws + WS_PROJ);
    float* bcum = (float*)(a.ws + WS_BCUM); float* dst = (float*)(a.ws + WS_DST); float* dec = (float*)(a.ws + WS_DEC);
    const int i = tid >> 3, seg = tid & 7;
    {
        const f32x4* gp = (const f32x4*)(gk + (size_t)(row0 + i) * 512 + h * 128 + seg * 16);
#pragma unroll
        for (int q = 0; q < 4; ++q) *(LAS f32x4*)(Bm + i * 128 + seg * 16 + q * 4) = gp[q];
    }
    __syncthreads();
    if (tid < 128) { float run = 0.f; for (int ii = 0; ii < 64; ++ii) { run += Bm[ii * 128 + tid]; Bm[ii * 128 + tid] = run; } }
    __syncthreads();
    {
        const u32x4* kp = (const u32x4*)(proj + (size_t)(row0 + i) * NPROJ + C_KA + h * 128 + seg * 16);
        float* bo = bcum + ((size_t)u * 64 + i) * 128 + seg * 16;
#pragma unroll
        for (int q = 0; q < 2; ++q) { const u32x4 kv = kp[q];
#pragma unroll
            for (int p = 0; p < 4; ++p) { const int d = seg * 16 + q * 8 + p * 2;
                const float b0 = Bm[i * 128 + d], b1 = Bm[i * 128 + d + 1], l0 = Bm[63 * 128 + d], l1 = Bm[63 * 128 + d + 1];
                bo[q * 8 + p * 2] = b0; bo[q * 8 + p * 2 + 1] = b1;
                KT[d * 72 + i] = f2bf(bflo(kv[p]) * expf(l0 - b0)); KT[(d + 1) * 72 + i] = f2bf(bfhi(kv[p]) * expf(l1 - b1));
                if (i == 63) { dec[(size_t)u * 128 + d] = expf(l0); dec[(size_t)u * 128 + d + 1] = expf(l1); } } }
        gla_stage_vt(proj, row0, h, VT, tid);
    }
    __syncthreads();
    {
        f32x4 acc[2][8];
#pragma unroll
        for (int x = 0; x < 2; ++x)
#pragma unroll
            for (int y = 0; y < 8; ++y) acc[x][y] = (f32x4){0.f, 0.f, 0.f, 0.f};
#pragma unroll
        for (int ks = 0; ks < 2; ++ks) {
            const bf16x8 a0 = lds_frag(VT, 72, (2 * w) * 16, ks * 32, lane), a1 = lds_frag(VT, 72, (2 * w + 1) * 16, ks * 32, lane);
#pragma unroll
            for (int dt = 0; dt < 8; ++dt) { const bf16x8 bf = lds_frag(KT, 72, dt * 16, ks * 32, lane); acc[0][dt] = mfma16(a0, bf, acc[0][dt]); acc[1][dt] = mfma16(a1, bf, acc[1][dt]); }
        }
        float* dp = dst + (size_t)u * 32768;
#pragma unroll
        for (int x = 0; x < 2; ++x)
#pragma unroll
            for (int dt = 0; dt < 8; ++dt)
#pragma unroll
                for (int r = 0; r < 4; ++r) dp[((2 * w + x) * 16 + 4 * (lane >> 4) + r) * 128 + dt * 16 + (lane & 15)] = acc[x][dt][r];
    }
    __syncthreads();
}
__device__ __forceinline__ void moba_prep_unit(const Args& a, LAS unsigned char* lds, int u2) {
    const int tid = threadIdx.x;
    const int bh = u2 >> 4, kb = u2 & 15, b = bh >> 3, h = bh & 7, row0 = b * SEQ + kb * 256, t0 = kb * 256;
    const bf16_t* proj = (const bf16_t*)(a.ws + WS_PROJ);
    const float* ct = (const float*)(a.ws + WS_ROPE); const float* st = ct + 4096 * 64;
    bf16_t* qbr = (bf16_t*)(a.ws + WS_QBR); bf16_t* kbr = (bf16_t*)(a.ws + WS_KBR); bf16_t* vbt = (bf16_t*)(a.ws + WS_VBT); float* kmean = (float*)(a.ws + WS_KMEAN);
    LAS float* Kf = (LAS float*)lds; LAS float* part = (LAS float*)(lds + LDS_EXTRA);
    const int row = tid >> 1, half = tid & 1;
    const float* cp = ct + (size_t)(t0 + row) * 64 + half * 32; const float* sp = st + (size_t)(t0 + row) * 64 + half * 32;
#pragma unroll 1
    for (int which = 0; which < 2; ++which) {
        const bf16_t* src = proj + (size_t)(row0 + row) * NPROJ + (which == 0 ? C_KB : C_QB) + h * 128 + half * 32;
        bf16_t* dsto = (which == 0 ? kbr : qbr) + ((size_t)bh * SEQ + t0 + row) * 128 + half * 32;
#pragma unroll
        for (int c4 = 0; c4 < 4; ++c4) {
            const u32x4 x1 = *(const u32x4*)(src + c4 * 8), x2 = *(const u32x4*)(src + 64 + c4 * 8);
            u32x4 o1, o2;
#pragma unroll
            for (int p = 0; p < 4; ++p) { const int ii = c4 * 8 + p * 2;
                const float c0 = cp[ii], c1 = cp[ii + 1], s0 = sp[ii], s1 = sp[ii + 1];
                const float a0 = bflo(x1[p]), a1 = bfhi(x1[p]), b0 = bflo(x2[p]), b1 = bfhi(x2[p]);
                const float r10 = a0 * c0 - b0 * s0, r11 = a1 * c1 - b1 * s1, r20 = a0 * s0 + b0 * c0, r21 = a1 * s1 + b1 * c1;
                o1[p] = cvt_pk_bf16(r10, r11); o2[p] = cvt_pk_bf16(r20, r21);
                if (which == 0) { Kf[row * 128 + half * 32 + ii] = r10; Kf[row * 128 + half * 32 + ii + 1] = r11; Kf[row * 128 + 64 + half * 32 + ii] = r20; Kf[row * 128 + 64 + half * 32 + ii + 1] = r21; } }
            *(u32x4*)(dsto + c4 * 8) = o1; *(u32x4*)(dsto + 64 + c4 * 8) = o2;
        }
        if (which == 0) {
            __syncthreads();
            { const int d = tid & 127, rq = tid >> 7; float s = 0.f; for (int rr = 0; rr < 64; ++rr) s += Kf[(rq * 64 + rr) * 128 + d]; part[rq * 128 + d] = s; }
            __syncthreads();
            if (tid < 128) kmean[((size_t)bh * 16 + kb) * 128 + tid] = (part[tid] + part[128 + tid] + part[256 + tid] + part[384 + tid]) * (1.0f / 256.0f);
        }
    }
    __syncthreads();
    LAS bf16_t* Vl = (LAS bf16_t*)lds;
    {
        const u32x4* vp = (const u32x4*)(proj + (size_t)(row0 + row) * NPROJ + C_VB + h * 128 + half * 64);
#pragma unroll
        for (int c8 = 0; c8 < 8; ++c8) { const u32x4 vv = vp[c8]; LAS unsigned* dp = (LAS unsigned*)(Vl + row * 130 + half * 64 + c8 * 8); dp[0] = vv[0]; dp[1] = vv[1]; dp[2] = vv[2]; dp[3] = vv[3]; }
    }
    __syncthreads();
    {
        const int d = tid >> 2, ts = tid & 3;
        bf16_t* op = vbt + ((size_t)bh * 128 + d) * SEQ + t0 + ts * 64;
#pragma unroll
        for (int c8 = 0; c8 < 8; ++c8) { u32x4 o;
#pragma unroll
            for (int p = 0; p < 4; ++p) { const int tt = ts * 64 + c8 * 8 + p * 2; o[p] = (unsigned)Vl[tt * 130 + d] | ((unsigned)Vl[(tt + 1) * 130 + d] << 16); }
            *(u32x4*)(op + c8 * 8) = o; }
    }
    __syncthreads();
}
__device__ __forceinline__ void phase_mix_prep(const Args& a, LAS unsigned char* lds) {
    const int blk = blockIdx.x, G = gridDim.x;
    for (int u = blk; u < 512; u += G) gla1_unit(a, lds, u);
    for (int u2 = blk; u2 < 256; u2 += G) moba_prep_unit(a, lds, u2);
}

__device__ __forceinline__ void phase_scan_select(const Args& a, LAS unsigned char* lds) {
    const int tid = threadIdx.x, blk = blockIdx.x, G = gridDim.x;
    {
        const float* dst = (const float*)(a.ws + WS_DST); const float* dec = (const float*)(a.ws + WS_DEC); bf16_t* ST = (bf16_t*)(a.ws + WS_ST);
        for (int el = blk * 512 + tid; el < 8 * 32768; el += G * 512) {
            const int bh = el >> 15, ed = el & 32767, d = ed & 127; float cur = 0.f;
#pragma unroll 8
            for (int c = 0; c < 64; ++c) { const size_t u = (size_t)bh * 64 + c; ST[u * 32768 + ed] = f2bf(cur); cur = dec[u * 128 + d] * cur + dst[u * 32768 + ed]; }
        }
    }
    {
        const float* kmean = (const float*)(a.ws + WS_KMEAN); const bf16_t* qbr = (const bf16_t*)(a.ws + WS_QBR); unsigned* sel = (unsigned*)(a.ws + WS_SEL);
        LAS float* km = (LAS float*)lds;
        for (int u2 = blk; u2 < 256; u2 += G) {
            const int bh = u2 >> 4, qb = u2 & 15;
            __syncthreads();
            for (int i = tid; i < 2048; i += 512) km[i] = kmean[(size_t)bh * 2048 + i];
            __syncthreads();
            const int q = tid >> 1, half = tid & 1;
            float gv[8];
#pragma unroll
            for (int n = 0; n < 8; ++n) gv[n] = 0.f;
            const u32x4* qp = (const u32x4*)(qbr + ((size_t)bh * SEQ + qb * 256 + q) * 128);
#pragma unroll 4
            for (int c = 0; c < 16; ++c) { const u32x4 qq = qp[c]; float qf[8];
#pragma unroll
                for (int p = 0; p < 4; ++p) { qf[2 * p] = bflo(qq[p]); qf[2 * p + 1] = bfhi(qq[p]); }
#pragma unroll
                for (int n = 0; n < 8; ++n) { const LAS float* kr = km + (half * 8 + n) * 128 + c * 8; const f32x4 k0 = *(const LAS f32x4*)kr, k1 = *(const LAS f32x4*)(kr + 4);
                    gv[n] += (qf[0] * k0[0] + qf[1] * k0[1]) + (qf[2] * k0[2] + qf[3] * k0[3]) + (qf[4] * k1[0] + qf[5] * k1[1]) + (qf[6] * k1[2] + qf[7] * k1[3]); } }
            float ga[16];
#pragma unroll
            for (int n = 0; n < 8; ++n) { const float o = __shfl_xor(gv[n], 1); ga[n] = half ? o : gv[n]; ga[8 + n] = half ? gv[n] : o; }
            unsigned mask = 0u; const int nsel = qb < 3 ? qb : 3;
            for (int s = 0; s < nsel; ++s) { int best = -1; float bv = -INFINITY;
#pragma unroll
                for (int n = 0; n < 16; ++n) { const bool ok = (n < qb) && !((mask >> n) & 1u) && (best < 0 || ga[n] > bv); if (ok) { bv = ga[n]; best = n; } }
                mask |= 1u << best; }
            if (half == 0) sel[(size_t)bh * SEQ + qb * 256 + q] = mask;
        }
        __syncthreads();
    }
}

__device__ __forceinline__ void gla3_unit(const Args& a, LAS unsigned char* lds, int u) {
    const int tid = threadIdx.x, w = tid >> 6, lane = tid & 63, g = lane >> 4, fr = lane & 15;
    const int bh = u >> 6, c = u & 63, b = bh >> 2, h = bh & 3, row0 = b * SEQ + c * 64;
    LAS bf16_t* QP = (LAS bf16_t*)lds; LAS bf16_t* KP = (LAS bf16_t*)(lds + 17408); LAS bf16_t* VT = (LAS bf16_t*)(lds + 34816);
    LAS bf16_t* AM = (LAS bf16_t*)(lds + 71680); LAS float* RED = (LAS float*)(lds + 80896);
    const bf16_t* proj = (const bf16_t*)(a.ws + WS_PROJ); const float* bcum = (const float*)(a.ws + WS_BCUM); const bf16_t* ST = (const bf16_t*)(a.ws + WS_ST);
    bf16_t* ocat = (bf16_t*)(a.ws + WS_OCAT);
    {
        const int i = tid >> 3, seg = tid & 7;
        const f32x4* bp = (const f32x4*)(bcum + ((size_t)u * 64 + i) * 128 + seg * 16);
        const u32x4* qp = (const u32x4*)(proj + (size_t)(row0 + i) * NPROJ + C_QA + h * 128 + seg * 16);
        const u32x4* kp = (const u32x4*)(proj + (size_t)(row0 + i) * NPROJ + C_KA + h * 128 + seg * 16);
#pragma unroll
        for (int q = 0; q < 2; ++q) { const u32x4 qv = qp[q], kv = kp[q]; const f32x4 b0 = bp[2 * q], b1 = bp[2 * q + 1]; u32x4 qo, ko;
#pragma unroll
            for (int p = 0; p < 4; ++p) { const float bl = (p < 2) ? b0[2 * p] : b1[2 * p - 4], bhv = (p < 2) ? b0[2 * p + 1] : b1[2 * p - 3];
                const float el = expf(bl), eh = expf(bhv);
                qo[p] = cvt_pk_bf16(bflo(qv[p]) * el * 0.08838834764831845f, bfhi(qv[p]) * eh * 0.08838834764831845f);
                ko[p] = cvt_pk_bf16(bflo(kv[p]) / el, bfhi(kv[p]) / eh); }
            *(LAS u32x4*)(QP + i * 136 + seg * 16 + q * 8) = qo; *(LAS u32x4*)(KP + i * 136 + seg * 16 + q * 8) = ko; }
        gla_stage_vt(proj, row0, h, VT, tid);
    }
    __syncthreads();
    {
        const int it = w >> 1;
#pragma unroll
        for (int jj = 0; jj < 2; ++jj) { const int jt = (w & 1) * 2 + jj; f32x4 acc = {0.f, 0.f, 0.f, 0.f};
            if (jt <= it) {
#pragma unroll
                for (int ks = 0; ks < 4; ++ks) acc = mfma16(lds_frag(QP, 136, it * 16, ks * 32, lane), lds_frag(KP, 136, jt * 16, ks * 32, lane), acc);
            }
#pragma unroll
            for (int r = 0; r < 4; ++r) { const int i = it * 16 + 4 * g + r, j = jt * 16 + fr; AM[i * 72 + j] = f2bf((j <= i) ? acc[r] : 0.f); } }
    }
    __syncthreads();
    f32x4 acc[4][2];
    {
#pragma unroll
        for (int x = 0; x < 4; ++x)
#pragma unroll
            for (int y = 0; y < 2; ++y) acc[x][y] = (f32x4){0.f, 0.f, 0.f, 0.f};
        bf16x8 bS[2][4];
        const bf16_t* stp = ST + (size_t)u * 32768;
#pragma unroll
        for (int e2 = 0; e2 < 2; ++e2)
#pragma unroll
            for (int ks = 0; ks < 4; ++ks) bS[e2][ks] = *(const bf16x8*)(stp + ((2 * w + e2) * 16 + fr) * 128 + ks * 32 + 8 * g);
#pragma unroll
        for (int it = 0; it < 4; ++it) {
#pragma unroll
            for (int ks = 0; ks < 4; ++ks) { const bf16x8 aq = lds_frag(QP, 136, it * 16, ks * 32, lane); acc[it][0] = mfma16(aq, bS[0][ks], acc[it][0]); acc[it][1] = mfma16(aq, bS[1][ks], acc[it][1]); }
#pragma unroll
            for (int k2 = 0; k2 < 2; ++k2) { const bf16x8 aa = lds_frag(AM, 72, it * 16, k2 * 32, lane);
                acc[it][0] = mfma16(aa, lds_frag(VT, 72, (2 * w) * 16, k2 * 32, lane), acc[it][0]); acc[it][1] = mfma16(aa, lds_frag(VT, 72, (2 * w + 1) * 16, k2 * 32, lane), acc[it][1]); }
        }
#pragma unroll
        for (int it = 0; it < 4; ++it)
#pragma unroll
            for (int r = 0; r < 4; ++r) { float s = acc[it][0][r] * acc[it][0][r] + acc[it][1][r] * acc[it][1][r];
                s += __shfl_xor(s, 1); s += __shfl_xor(s, 2); s += __shfl_xor(s, 4); s += __shfl_xor(s, 8);
                if (fr == 0) RED[w * 64 + it * 16 + 4 * g + r] = s; }
    }
    __syncthreads();
    {
#pragma unroll
        for (int it = 0; it < 4; ++it)
#pragma unroll
            for (int r = 0; r < 4; ++r) { const int i = it * 16 + 4 * g + r; float tot = 0.f;
#pragma unroll
                for (int ww = 0; ww < 8; ++ww) tot += RED[ww * 64 + i];
                const float rstd = 1.0f / sqrtf(tot * (1.0f / 256.0f) + EPS);
#pragma unroll
                for (int e2 = 0; e2 < 2; ++e2) { const int e = (2 * w + e2) * 16 + fr;
                    const float ga = bf2f(proj[(size_t)(row0 + i) * NPROJ + C_GA + h * 256 + e]);
                    ocat[(size_t)(row0 + i) * DM + h * 256 + e] = f2bf(acc[it][e2][r] * rstd * a.gla_norm_w[e] * silu_f(ga)); } }
    }
    __syncthreads();
}

__device__ __forceinline__ void moba_attn_unit(const Args& a, LAS unsigned char* lds, int bh, int qb) {
    const int tid = threadIdx.x, w = tid >> 6, lane = tid & 63, g = lane >> 4, fr = lane & 15;
    const int b = bh >> 3, h = bh & 7, q0 = 32 * w;
    LAS bf16_t* Ks = (LAS bf16_t*)lds; LAS bf16_t* Vs = (LAS bf16_t*)(lds + 17408);
    const bf16_t* qbr = (const bf16_t*)(a.ws + WS_QBR); const bf16_t* kbr = (const bf16_t*)(a.ws + WS_KBR); const bf16_t* vbt = (const bf16_t*)(a.ws + WS_VBT);
    const unsigned* sel = (const unsigned*)(a.ws + WS_SEL); bf16_t* ocat = (bf16_t*)(a.ws + WS_OCAT);
    bf16x8 qf[2][4]; unsigned sm[2]; float m[2], l[2]; f32x4 O[8][2];
#pragma unroll
    for (int b2 = 0; b2 < 2; ++b2) { const size_t qrow = (size_t)bh * SEQ + qb * 256 + q0 + 16 * b2 + fr;
#pragma unroll
        for (int ks = 0; ks < 4; ++ks) qf[b2][ks] = *(const bf16x8*)(qbr + qrow * 128 + ks * 32 + 8 * g);
        sm[b2] = sel[qrow]; m[b2] = -INFINITY; l[b2] = 0.f;
#pragma unroll
        for (int dt = 0; dt < 8; ++dt) O[dt][b2] = (f32x4){0.f, 0.f, 0.f, 0.f}; }
    const float cs = 0.08838834764831845f * 1.4426950408889634f;
#pragma unroll 1
    for (int jj = 0; jj <= qb; ++jj) {
        const int j = (jj == 0) ? qb : jj - 1; const bool own = (jj == 0);
#pragma unroll 1
        for (int kt = 0; kt < 4; ++kt) {
            __syncthreads();
#pragma unroll
            for (int p = 0; p < 2; ++p) { const int cidx = tid + 512 * p;
                { const int row = cidx >> 4, cc = cidx & 15; *(LAS u32x4*)(Ks + row * 136 + cc * 8) = *(const u32x4*)(kbr + ((size_t)bh * SEQ + j * 256 + kt * 64 + row) * 128 + cc * 8); }
                { const int d = cidx >> 3, cc = cidx & 7; *(LAS u32x4*)(Vs + d * 72 + cc * 8) = *(const u32x4*)(vbt + ((size_t)bh * 128 + d) * SEQ + j * 256 + kt * 64 + cc * 8); } }
            __syncthreads();
            if (own && kt * 64 > q0 + 31) continue;
            f32x4 s[4][2];
#pragma unroll
            for (int t4 = 0; t4 < 4; ++t4) { s[t4][0] = (f32x4){0.f, 0.f, 0.f, 0.f}; s[t4][1] = (f32x4){0.f, 0.f, 0.f, 0.f};
#pragma unroll
                for (int ks = 0; ks < 4; ++ks) { const bf16x8 kf = lds_frag(Ks, 136, t4 * 16, ks * 32, lane); s[t4][0] = mfma16(kf, qf[0][ks], s[t4][0]); s[t4][1] = mfma16(kf, qf[1][ks], s[t4][1]); } }
            bf16x8 pf[2][2];
#pragma unroll
            for (int b2 = 0; b2 < 2; ++b2) {
                const int qi = q0 + 16 * b2 + fr; const bool allow_past = ((sm[b2] >> j) & 1u) != 0u;
                float tm = -INFINITY;
#pragma unroll
                for (int t4 = 0; t4 < 4; ++t4)
#pragma unroll
                    for (int r = 0; r < 4; ++r) { const int kk = kt * 64 + t4 * 16 + 4 * g + r; const bool ok = own ? (kk <= qi) : allow_past;
                        const float v = ok ? s[t4][b2][r] : -INFINITY; s[t4][b2][r] = v; tm = fmaxf(tm, v); }
                tm = fmaxf(tm, __shfl_xor(tm, 16)); tm = fmaxf(tm, __shfl_xor(tm, 32));
                const float mnew = fmaxf(m[b2], tm), msafe = (mnew == -INFINITY) ? 0.f : mnew;
                const float alpha = exp2f((m[b2] - msafe) * cs);
                float ps = 0.f;
#pragma unroll
                for (int t4 = 0; t4 < 4; ++t4)
#pragma unroll
                    for (int r = 0; r < 4; ++r) { const float p = exp2f((s[t4][b2][r] - msafe) * cs); s[t4][b2][r] = p; ps += p; }
                ps += __shfl_xor(ps, 16); ps += __shfl_xor(ps, 32);
                l[b2] = l[b2] * alpha + ps; m[b2] = mnew;
#pragma unroll
                for (int dt = 0; dt < 8; ++dt) O[dt][b2] *= alpha;
#pragma unroll
                for (int k2 = 0; k2 < 2; ++k2) { u32x4 pk; pk.x = cvt_pk_bf16(s[2 * k2][b2][0], s[2 * k2][b2][1]); pk.y = cvt_pk_bf16(s[2 * k2][b2][2], s[2 * k2][b2][3]);
                    pk.z = cvt_pk_bf16(s[2 * k2 + 1][b2][0], s[2 * k2 + 1][b2][1]); pk.w = cvt_pk_bf16(s[2 * k2 + 1][b2][2], s[2 * k2 + 1][b2][3]);
                    pf[k2][b2] = __builtin_bit_cast(bf16x8, pk); }
            }
#pragma unroll
            for (int dt = 0; dt < 8; ++dt)
#pragma unroll
                for (int k2 = 0; k2 < 2; ++k2) { const LAS bf16_t* vp = Vs + (dt * 16 + fr) * 72 + 32 * k2 + 4 * g;
                    const u32x2 lo = *(const LAS u32x2*)vp, hi = *(const LAS u32x2*)(vp + 16);
                    u32x4 vv; vv.x = lo.x; vv.y = lo.y; vv.z = hi.x; vv.w = hi.y; const bf16x8 vf = __builtin_bit_cast(bf16x8, vv);
                    O[dt][0] = mfma16(vf, pf[k2][0], O[dt][0]); O[dt][1] = mfma16(vf, pf[k2][1], O[dt][1]); }
        }
    }
#pragma unroll
    for (int b2 = 0; b2 < 2; ++b2) { const float inv = 1.0f / l[b2]; const size_t orow = (size_t)(b * SEQ + qb * 256 + q0 + 16 * b2 + fr) * DM + 1024 + h * 128;
#pragma unroll
        for (int dt = 0; dt < 8; ++dt) { u32x2 o; o.x = cvt_pk_bf16(O[dt][b2][0] * inv, O[dt][b2][1] * inv); o.y = cvt_pk_bf16(O[dt][b2][2] * inv, O[dt][b2][3] * inv);
            *(u32x2*)(ocat + orow + dt * 16 + 4 * g) = o; } }
    __syncthreads();
}
__device__ __forceinline__ void phase_mix_out(const Args& a, LAS unsigned char* lds) {
    const int blk = blockIdx.x, G = gridDim.x;
    for (int ua = blk; ua < 256; ua += G) moba_attn_unit(a, lds, ua & 15, 15 - (ua >> 4));
    for (int u = blk; u < 512; u += G) gla3_unit(a, lds, u);
}

__device__ __forceinline__ void phase_router(const Args& a, LAS unsigned char* lds) {
    const int tid = threadIdx.x, blk = blockIdx.x, G = gridDim.x, w = tid >> 6, lane = tid & 63;
    LAS float* h2s = (LAS float*)lds;
    LAS float* logit = (LAS float*)(lds + LDS_EXTRA);
    LAS int* pe = (LAS int*)(lds + LDS_EXTRA + 2048); LAS float* pw = (LAS float*)(lds + LDS_EXTRA + 2304); LAS int* lpos = (LAS int*)(lds + LDS_EXTRA + 2560);
    LAS int* hist = (LAS int*)(lds + LDS_EXTRA + 2816); LAS int* base = (LAS int*)(lds + LDS_EXTRA + 2944);
    const float* mod = (const float*)(a.ws + WS_MOD); const float* x1 = (const float*)(a.ws + WS_X1); unsigned char* h2 = (unsigned char*)(a.ws + WS_H1);
    unsigned* cnt = (unsigned*)(a.ws + WS_CNT); int* pair_e = (int*)(a.ws + WS_PAIR_E); int* pair_pos = (int*)(a.ws + WS_PAIR_POS); float* pair_w = (float*)(a.ws + WS_PAIR_W);
    for (int grp = blk; grp < 512; grp += G) {
#pragma unroll 1
        for (int tt = 0; tt < 2; ++tt) { const int tl = 2 * w + tt, t = grp * 16 + tl;
            const f32x4* xr = (const f32x4*)(x1 + (size_t)t * DM) + lane;
            f32x4 v[8]; float ss = 0.f;
#pragma unroll
            for (int q = 0; q < 8; ++q) { v[q] = xr[64 * q]; ss += (v[q][0] * v[q][0] + v[q][1] * v[q][1]) + (v[q][2] * v[q][2] + v[q][3] * v[q][3]); }
            ss = wave_sum(ss);
            const float rstd = 1.0f / sqrtf(ss * (1.0f / DM) + EPS);
            const float* sh = mod + (size_t)(t >> 12) * 12288 + 6144; const float* sc = sh + 2048;
#pragma unroll
            for (int q = 0; q < 8; ++q) { const int k = 4 * (lane + 64 * q);
                const f32x4 nw = *(const f32x4*)(a.norm2_w + k), scv = *(const f32x4*)(sc + k), shv = *(const f32x4*)(sh + k);
                const f32x4 hv = (v[q] * rstd * nw) * (scv + 1.0f) + shv;
                *(LAS f32x4*)(h2s + tl * 2048 + k) = hv;
                *(unsigned*)(h2 + (size_t)t * DM + k) = pg8::pk4_fp8(hv[0], hv[1], hv[2], hv[3]); } }
        if (tid < 32) hist[tid] = 0;
        __syncthreads();
        {
            const int e = tid & 31, kq = tid >> 5, k0 = kq * 128; float acc[16];
#pragma unroll
            for (int t = 0; t < 16; ++t) acc[t] = 0.f;
            const float* wp = a.w_router + (size_t)k0 * 32 + e;
#pragma unroll 4
            for (int kk = 0; kk < 128; kk += 4) {
                const float w0 = wp[(size_t)kk * 32], w1 = wp[(size_t)(kk + 1) * 32], w2 = wp[(size_t)(kk + 2) * 32], w3 = wp[(size_t)(kk + 3) * 32];
#pragma unroll
                for (int t = 0; t < 16; ++t) { const f32x4 hv = *(const LAS f32x4*)(h2s + t * 2048 + k0 + kk); acc[t] += (hv[0] * w0 + hv[1] * w1) + (hv[2] * w2 + hv[3] * w3); } }
            __syncthreads();
#pragma unroll
            for (int t = 0; t < 16; ++t) h2s[(kq * 16 + t) * 32 + e] = acc[t];
            __syncthreads();
            { const int tl = tid >> 5; float s = a.b_router[e];
#pragma unroll
                for (int q = 0; q < 16; ++q) s += h2s[(q * 16 + tl) * 32 + e];
                logit[tl * 32 + e] = s; }
        }
        __syncthreads();
        if (tid < 16) { unsigned chosen = 0u; float tv[4]; int te[4];
#pragma unroll
            for (int s = 0; s < 4; ++s) { int best = -1; float bv = -INFINITY;
                for (int e = 0; e < 32; ++e) { const float v = logit[tid * 32 + e]; if (!((chosen >> e) & 1u) && (best < 0 || v > bv)) { bv = v; best = e; } }
                chosen |= 1u << best; tv[s] = bv; te[s] = best; }
            float ex[4], den = 0.f;
#pragma unroll
            for (int s = 0; s < 4; ++s) { ex[s] = expf(tv[s] - tv[0]); den += ex[s]; }
#pragma unroll
            for (int s = 0; s < 4; ++s) { pe[tid * 4 + s] = te[s]; pw[tid * 4 + s] = ex[s] / den; } }
        __syncthreads();
        if (tid < 64) lpos[tid] = atomicAdd((int*)&hist[pe[tid]], 1);
        __syncthreads();
        if (tid < 32) { const int n = hist[tid]; base[tid] = n ? (int)atomicAdd(&cnt[tid], (unsigned)n) : 0; }
        __syncthreads();
        if (tid < 64) { const int p = grp * 64 + tid, e = pe[tid]; pair_e[p] = e; pair_pos[p] = base[e] + lpos[tid]; pair_w[p] = pw[tid]; }
        __syncthreads();
    }
}
__device__ __forceinline__ void phase_gather(const Args& a, LAS unsigned char* lds) {
    const int tid = threadIdx.x, blk = blockIdx.x, G = gridDim.x, w = tid >> 6, lane = tid & 63;
    LAS int* pstart = (LAS int*)(lds + LDS_EXTRA);
    const unsigned* cnt = (const unsigned*)(a.ws + WS_CNT);
    if (tid == 0) { int run = 0; for (int e = 0; e < 32; ++e) { pstart[e] = run; run += (int)((cnt[e] + 255u) & ~255u); } }
    __syncthreads();
    const int* pair_e = (const int*)(a.ws + WS_PAIR_E); const int* pair_pos = (const int*)(a.ws + WS_PAIR_POS); const float* pair_w = (const float*)(a.ws + WS_PAIR_W);
    int* slotrow = (int*)(a.ws + WS_SLOTROW); float* wbuf = (float*)(a.ws + WS_WBUF); const unsigned char* h2 = (const unsigned char*)(a.ws + WS_H1); unsigned char* xg = (unsigned char*)(a.ws + WS_XG);
    for (int p = blk * 8 + w; p < NTOK * TOPK; p += G * 8) {
        const int row = pstart[pair_e[p]] + pair_pos[p];
        const u32x4* sp = (const u32x4*)(h2 + (size_t)(p >> 2) * DM) + lane; u32x4* dp = (u32x4*)(xg + (size_t)row * DM) + lane;
#pragma unroll
        for (int q = 0; q < 2; ++q) dp[64 * q] = sp[64 * q];
        if (lane == 0) { wbuf[row] = pair_w[p]; slotrow[p] = row; }
    }
    conv_drain(a);
    __syncthreads();
}
__device__ __forceinline__ void moe_build_tab(const Args& a, LAS unsigned char* lds, int ntn) {
    LAS int* tab = (LAS int*)(lds + LDS_EXTRA);
    const unsigned* cnt = (const unsigned*)(a.ws + WS_CNT);
    __syncthreads();
    if (threadIdx.x == 0) {
        const int mygrp = blockIdx.x & 7, PG = ntn >> 1;
        int rs = 0, np = 0, us = 0; unsigned done = 0u;
        LAS int* rt0 = tab + 600;
        LAS int* load = tab + 640;
        for (int x = 0; x < 8; ++x) load[x] = 0;
        for (int e = 0; e < 32; ++e) { rt0[e] = rs; rs += (int)((cnt[e] + 255u) >> 8); }
        for (int it = 0; it < 32; ++it) {
            int be = -1, bc = -1;
            for (int e = 0; e < 32; ++e) { if ((done >> e) & 1u) continue; const int c = (int)cnt[e], cost = 2 * (c >> 8) + ((c & 255) > 128 ? 2 : ((c & 255) ? 1 : 0)); if (cost > bc) { bc = cost; be = e; } }
            done |= 1u << be;
            const int c = (int)cnt[be], mte = (c + 255) >> 8;
            if (mte == 0) continue;
            for (int h = 0; h < 2; ++h) {
                int bx = 0;
                for (int x = 1; x < 8; ++x) if (load[x] < load[bx]) bx = x;
                load[bx] += bc * PG;
                if (bx == mygrp) { LAS int* t = tab + 4 + 8 * np; t[0] = us; t[1] = be; t[2] = h * PG; t[3] = mte; t[4] = rt0[be]; t[5] = c; us += mte * PG; ++np; }
            }
        }
        tab[0] = np; tab[1] = us;
    }
    __syncthreads();
}
__device__ __forceinline__ void phase_final(const Args& a, LAS unsigned char* lds) {
    const int tid = threadIdx.x, blk = blockIdx.x, G = gridDim.x, w = tid >> 6, lane = tid & 63;
    const float* mod = (const float*)(a.ws + WS_MOD); const float* x1 = (const float*)(a.ws + WS_X1); const int* slotrow = (const int*)(a.ws + WS_SLOTROW); const bf16_t* y = (const bf16_t*)(a.ws + WS_Y);
    for (int t = blk * 8 + w; t < NTOK; t += G * 8) {
        const int r0 = slotrow[t * 4], r1 = slotrow[t * 4 + 1], r2 = slotrow[t * 4 + 2], r3 = slotrow[t * 4 + 3];
        const f32x4* xr = (const f32x4*)(x1 + (size_t)t * DM) + lane;
        const u32x2* y0 = (const u32x2*)(y + (size_t)r0 * DM) + lane; const u32x2* y1 = (const u32x2*)(y + (size_t)r1 * DM) + lane;
        const u32x2* y2 = (const u32x2*)(y + (size_t)r2 * DM) + lane; const u32x2* y3 = (const u32x2*)(y + (size_t)r3 * DM) + lane;
        const float* g2 = mod + (size_t)(t >> 12) * 12288 + 10240;
        f32x4 v[8]; float ss = 0.f;
#pragma unroll
        for (int q = 0; q < 8; ++q) { const u32x2 a0 = y0[64 * q], a1 = y1[64 * q], a2 = y2[64 * q], a3 = y3[64 * q];
            f32x4 s; s[0] = (bflo(a0.x) + bflo(a1.x)) + (bflo(a2.x) + bflo(a3.x)); s[1] = (bfhi(a0.x) + bfhi(a1.x)) + (bfhi(a2.x) + bfhi(a3.x));
            s[2] = (bflo(a0.y) + bflo(a1.y)) + (bflo(a2.y) + bflo(a3.y)); s[3] = (bfhi(a0.y) + bfhi(a1.y)) + (bfhi(a2.y) + bfhi(a3.y));
            const f32x4 gv = *(const f32x4*)(g2 + 4 * (lane + 64 * q));
            v[q] = xr[64 * q] + gv * s; ss += (v[q][0] * v[q][0] + v[q][1] * v[q][1]) + (v[q][2] * v[q][2] + v[q][3] * v[q][3]); }
        ss = wave_sum(ss);
        const float rstd = 1.0f / sqrtf(ss * (1.0f / DM) + EPS);
        f32x4* op = (f32x4*)(a.out + (size_t)t * DM) + lane;
#pragma unroll
        for (int q = 0; q < 8; ++q) op[64 * q] = v[q] * rstd * *(const f32x4*)(a.final_norm_w + 4 * (lane + 64 * q));
    }
}

constexpr int NPHASE = 12;
#ifndef ONLY_PHASE
#define ONLY_PHASE -1
#endif
#define PH_ON(P) (ONLY_PHASE < 0 || ONLY_PHASE == (P))
#ifndef PROBE_DOUBLE
#define PROBE_DOUBLE -1
#endif
#define PROBE_REP(P) for (int _rep = 0; _rep < ((PROBE_DOUBLE == (P)) ? 2 : 1); ++_rep)
__global__ void __launch_bounds__(512, 2) fwd(Args a) {
    extern __shared__ __attribute__((aligned(16))) unsigned char shm[];
    LAS unsigned char* lds = (LAS unsigned char*)shm;
    if (threadIdx.x == 0) *(LAS u32x4*)(lds + LDS_XB) = (u32x4){0u, 0u, 0u, 0u};
    __syncthreads();
    XcdBarrier bar = xcd_barrier_post((unsigned*)(a.ws + WS_BAR), (volatile LAS unsigned*)(lds + LDS_XB));
    const int G = gridDim.x, blk = blockIdx.x;
#ifndef HARVEST_MASK
#define HARVEST_MASK 0xfff
#endif
#define PHASE_END(P) do { if ((P) + 1 < a.ph_hi) { if ((HARVEST_MASK >> (P)) & 1) xcd_barrier(bar, [&]() { return conv_claim(a, 1); }); else xcd_barrier(bar, []() { return false; }); } } while (0)
    if (PH_ON(0) && a.ph_lo <= 0 && 0 < a.ph_hi) { PROBE_REP(0) { phase_prologue(a, lds); __syncthreads(); } PHASE_END(0); }
    if (PH_ON(1) && a.ph_lo <= 1 && 1 < a.ph_hi) { phase_norm1(a, lds);
#if PROBE_DOUBLE == 134
        __syncthreads(); phase_norm1(a, lds);
#endif
        PHASE_END(1); }
    if (PH_ON(2) && a.ph_lo <= 2 && 2 < a.ph_hi) {
        pg8::Gemm g{(const bf16_t*)(a.ws + WS_H1), (const bf16_t*)(a.ws + WS_WIN_T), DM, 0};
        pg8::StaticOrder S; S.init(NTOK, NPROJ, G, blk);
        pg8::EpiProj E{(bf16_t*)(a.ws + WS_PROJ), NPROJ};
        pg8::gemm_phase<false>(lds, g, S, E); PHASE_END(2); }
    if (PH_ON(3) && a.ph_lo <= 3 && 3 < a.ph_hi) { phase_mix_prep(a, lds);
#if PROBE_DOUBLE == 134
        __syncthreads(); phase_mix_prep(a, lds);
#endif
        PHASE_END(3); }
    if (PH_ON(4) && a.ph_lo <= 4 && 4 < a.ph_hi) { phase_scan_select(a, lds);
#if PROBE_DOUBLE == 134
        __syncthreads(); phase_scan_select(a, lds);
#endif
        PHASE_END(4); }
    if (PH_ON(5) && a.ph_lo <= 5 && 5 < a.ph_hi) { phase_mix_out(a, lds);
#if PROBE_DOUBLE == 5
        __syncthreads(); phase_mix_out(a, lds);
#endif
        PHASE_END(5); }
    if (PH_ON(6) && a.ph_lo <= 6 && 6 < a.ph_hi) {
        pg8::Gemm g{(const bf16_t*)(a.ws + WS_OCAT), (const bf16_t*)(a.ws + WS_WOUT_T), DM, 0};
        pg8::StaticOrder S; S.init(NTOK, DM, G, blk);
        pg8::EpiOut E{a.x, (const float*)(a.ws + WS_MOD) + 4096, (float*)(a.ws + WS_X1)};
        pg8::gemm_phase<false>(lds, g, S, E); PHASE_END(6); }
    if (PH_ON(7) && a.ph_lo <= 7 && 7 < a.ph_hi) { phase_router(a, lds); PHASE_END(7); }
    if (PH_ON(8) && a.ph_lo <= 8 && 8 < a.ph_hi) { phase_gather(a, lds);
#if PROBE_DOUBLE == 811
        __syncthreads(); phase_gather(a, lds);
#endif
        PHASE_END(8); }
    if (PH_ON(9) && a.ph_lo <= 9 && 9 < a.ph_hi) {
        moe_build_tab(a, lds, 16);
        pg8::Gemm g{(const bf16_t*)(a.ws + WS_XG), (const bf16_t*)(a.ws + WS_WGU_T), DM / 2, (size_t)4096 * 1024};
        pg8::MoeOrder S{(const LAS int*)(lds + LDS_EXTRA), blk >> 3, G >> 3};
        pg8::EpiGU8 E{a.b_gate_up, (unsigned char*)(a.ws + WS_ACT)};
        pg8::gemm_phase<true>(lds, g, S, E);
#if PROBE_DOUBLE == 9
        __syncthreads(); pg8::gemm_phase<true>(lds, g, S, E);
#endif
        PHASE_END(9); }
    if (PH_ON(10) && a.ph_lo <= 10 && 10 < a.ph_hi) {
        moe_build_tab(a, lds, 8);
        pg8::Gemm g{(const bf16_t*)(a.ws + WS_ACT), (const bf16_t*)(a.ws + WS_WD_T), DM / 2, (size_t)2048 * 1024};
        pg8::MoeOrder S{(const LAS int*)(lds + LDS_EXTRA), blk >> 3, G >> 3};
        pg8::EpiDown8 E{a.b_down, (const float*)(a.ws + WS_WBUF), (bf16_t*)(a.ws + WS_Y)};
        pg8::gemm_phase<true>(lds, g, S, E);
        PHASE_END(10); }
    if (PH_ON(11) && a.ph_lo <= 11 && 11 < a.ph_hi) { phase_final(a, lds);
#if PROBE_DOUBLE == 811
        __syncthreads(); phase_final(a, lds);
#endif
    }
}

#ifndef N_LAUNCHES
#define N_LAUNCHES 1
#endif
extern "C" void kernel_launch(void* const* d_in, const int* in_sizes, int n_in, void* d_out, int out_size, void* d_ws, size_t ws_size, hipStream_t stream) {
    static int grid = 0;
    if (grid == 0) {
        if (n_in != 18 || out_size != NTOK * DM || ws_size < WS_END) { fprintf(stderr, "kernel_launch: unexpected shapes (n_in %d out %d ws %zu, need %zu)\n", n_in, out_size, ws_size, (size_t)WS_END); grid = -1; return; }
        int dev = 0, cus = 0, per_cu = 0;
        if (hipGetDevice(&dev) != hipSuccess || hipDeviceGetAttribute(&cus, hipDeviceAttributeMultiprocessorCount, dev) != hipSuccess) { grid = -1; return; }
        if (hipFuncSetAttribute((const void*)fwd, hipFuncAttributeMaxDynamicSharedMemorySize, LDS_BYTES) != hipSuccess) { fprintf(stderr, "kernel_launch: hipFuncSetAttribute failed\n"); grid = -1; return; }
        if (hipOccupancyMaxActiveBlocksPerMultiprocessor(&per_cu, (const void*)fwd, 512, LDS_BYTES) != hipSuccess || per_cu < 1) fprintf(stderr, "kernel_launch: occupancy query says %d\n", per_cu);
        (void)hipGetLastError();
        grid = cus;
    }
    if (grid < 0) return;
    (void)hipMemsetAsync(d_ws, 0, WS_ZERO_BYTES, stream);
    Args a{};
    a.x = (const float*)d_in[0]; a.c = (const float*)d_in[1]; a.w_ada = (const float*)d_in[2]; a.b_ada = (const float*)d_in[3]; a.norm1_w = (const float*)d_in[4];
    a.w_in = (const float*)d_in[5]; a.w_alpha2 = (const float*)d_in[6]; a.b_alpha = (const float*)d_in[7]; a.gla_norm_w = (const float*)d_in[8]; a.w_out = (const float*)d_in[9];
    a.norm2_w = (const float*)d_in[10]; a.w_router = (const float*)d_in[11]; a.b_router = (const float*)d_in[12]; a.w_gate_up = (const float*)d_in[13]; a.b_gate_up = (const float*)d_in[14];
    a.w_down = (const float*)d_in[15]; a.b_down = (const float*)d_in[16]; a.final_norm_w = (const float*)d_in[17];
    a.out = (float*)d_out; a.ws = (unsigned char*)d_ws;
    if (N_LAUNCHES == 1) { a.ph_lo = 0; a.ph_hi = NPHASE; hipLaunchKernelGGL(fwd, dim3(grid), dim3(512), LDS_BYTES, stream, a); }
    else for (int p = 0; p < NPHASE; ++p) { a.ph_lo = p; a.ph_hi = p + 1; hipLaunchKernelGGL(fwd, dim3(grid), dim3(512), LDS_BYTES, stream, a); }
}
```

```cpp
#define HARVEST_MASK 0
#include <hip/hip_runtime.h>
#include <stdint.h>
#include <stdio.h>

#define LAS __attribute__((address_space(3)))
typedef unsigned short bf16_t;
typedef short bf16x8 __attribute__((ext_vector_type(8)));
typedef float f32x4 __attribute__((ext_vector_type(4)));
typedef float f32x2 __attribute__((ext_vector_type(2)));
typedef unsigned u32x4 __attribute__((ext_vector_type(4)));
typedef unsigned u32x2 __attribute__((ext_vector_type(2)));

constexpr int DM = 2048, NBATCH = 2, SEQ = 4096, NTOK = 8192;
constexpr int DIN = 6160, NPROJ = 6144;
constexpr int NE = 32, TOPK = 4;
constexpr int C_QA = 0, C_KA = 512, C_VA = 1024, C_GA = 2048, C_QB = 3072, C_KB = 4096, C_VB = 5120;
constexpr int MAXROWS = 40960;
constexpr float EPS = 1e-6f;

constexpr size_t MB = 1024ull * 1024ull;
constexpr size_t WS_BAR = 0;
constexpr size_t WS_CNT = 16384;
constexpr size_t WS_ZERO_BYTES = 20480;
constexpr size_t WS_MOD = 32768;
constexpr size_t WS_ROPE = 1 * MB;
constexpr size_t WS_H1 = 3 * MB;
constexpr size_t WS_GK = WS_H1 + 32 * MB;
constexpr size_t WS_PROJ = WS_GK + 16 * MB;
constexpr size_t WS_WIN_T = WS_PROJ + 96 * MB;
constexpr size_t WS_WOUT_T = WS_WIN_T + 24 * MB;
constexpr size_t WS_WGU_T = WS_WOUT_T + 8 * MB;
constexpr size_t WS_WD_T = WS_WGU_T + 512 * MB;
constexpr size_t WS_BCUM = WS_WD_T + 256 * MB;
constexpr size_t WS_DST = WS_BCUM + 16 * MB;
constexpr size_t WS_DEC = WS_DST + 64 * MB;
constexpr size_t WS_ST = WS_DEC + 1 * MB;
constexpr size_t WS_QBR = WS_ST + 32 * MB;
constexpr size_t WS_KBR = WS_QBR + 16 * MB;
constexpr size_t WS_VBT = WS_KBR + 16 * MB;
constexpr size_t WS_KMEAN = WS_VBT + 16 * MB;
constexpr size_t WS_SEL = WS_KMEAN + 1 * MB;
constexpr size_t WS_OCAT = WS_SEL + 1 * MB;
constexpr size_t WS_X1 = WS_OCAT + 32 * MB;
constexpr size_t WS_PAIR_E = WS_X1 + 64 * MB;
constexpr size_t WS_PAIR_POS = WS_PAIR_E + 1 * MB;
constexpr size_t WS_PAIR_W = WS_PAIR_POS + 1 * MB;
constexpr size_t WS_SLOTROW = WS_PAIR_W + 1 * MB;
constexpr size_t WS_WBUF = WS_SLOTROW + 1 * MB;
constexpr size_t WS_XG = WS_WBUF + 1 * MB;
constexpr size_t WS_ACT = WS_XG + 160 * MB;
constexpr size_t WS_Y = WS_ACT + 160 * MB;
constexpr size_t WS_END = WS_Y + 160 * MB;

constexpr int LDS_BYTES = 147456;
constexpr int LDS_XB = 131072;
constexpr int LDS_TAB = 131072 + 64;
constexpr int LDS_EXTRA = 131072 + 1024;

struct Args {
    const float* x; const float* c; const float* w_ada; const float* b_ada; const float* norm1_w; const float* w_in; const float* w_alpha2; const float* b_alpha;
    const float* gla_norm_w; const float* w_out; const float* norm2_w; const float* w_router; const float* b_router; const float* w_gate_up; const float* b_gate_up;
    const float* w_down; const float* b_down; const float* final_norm_w;
    float* out; unsigned char* ws;
    int ph_lo, ph_hi;
};

__device__ __forceinline__ unsigned cvt_pk_bf16(float lo, float hi) { unsigned r; asm("v_cvt_pk_bf16_f32 %0, %1, %2" : "=v"(r) : "v"(lo), "v"(hi)); return r; }
__device__ __forceinline__ bf16_t f2bf(float f) { return (bf16_t)(cvt_pk_bf16(f, 0.f) & 0xffffu); }
__device__ __forceinline__ float bf2f(bf16_t b) { return __uint_as_float(((unsigned)b) << 16); }
__device__ __forceinline__ float bflo(unsigned w) { return __uint_as_float(w << 16); }
__device__ __forceinline__ float bfhi(unsigned w) { return __uint_as_float(w & 0xffff0000u); }
__device__ __forceinline__ float wave_sum(float v) {
#pragma unroll
    for (int o = 1; o < 64; o <<= 1) v += __shfl_xor(v, o);
    return v;
}
#ifndef FP8_EMU
#define FP8_EMU 0
#endif
__device__ __forceinline__ float q8(float x) { return __builtin_amdgcn_cvt_f32_fp8(__builtin_amdgcn_cvt_pk_fp8_f32(x, x, 0, false), 0); }
__device__ __forceinline__ float silu_f(float v) { return v / (1.f + expf(-v)); }
__device__ __forceinline__ f32x4 mfma16(bf16x8 a, bf16x8 b, f32x4 c) { return __builtin_amdgcn_mfma_f32_16x16x32_bf16(a, b, c, 0, 0, 0); }
__device__ __forceinline__ bf16x8 lds_frag(const LAS bf16_t* img, int ld, int r0, int k0, int lane) {
    return *(const LAS bf16x8*)(img + (r0 + (lane & 15)) * ld + k0 + 8 * (lane >> 4));
}

#define XB_TMO      128
#define XB_XCNT(j)  (256  + 64 * (j))
#define XB_XSUB(j)  (1280 + 64 * (j))
#define XB_XGEN(j)  (2304 + 64 * (j))
#define XB_TOP      3328
#define XB_TOPGEN   3392
#define XCD_BAR_WORDS 3456
#define XB_SPIN_CAP (1u << 18)
__device__ __forceinline__ unsigned xb_ld(unsigned* p)              { return __hip_atomic_load(p, __ATOMIC_RELAXED, __HIP_MEMORY_SCOPE_AGENT); }
__device__ __forceinline__ unsigned xb_add(unsigned* p, unsigned v) { return __hip_atomic_fetch_add(p, v, __ATOMIC_RELAXED, __HIP_MEMORY_SCOPE_AGENT); }
__device__ __forceinline__ unsigned xb_xcc_id() { return (unsigned)__builtin_amdgcn_s_getreg((3 << 11) | 20) & 0xFu; }
#define XB_SPIN(cond, bar) do { unsigned _sp = 0; while (cond) { __builtin_amdgcn_s_sleep(1); \
    if ((++_sp & 255u) == 0u) { if (xb_ld(&(bar)[XB_TMO])) break; if (_sp > XB_SPIN_CAP) { atomicAdd(&(bar)[XB_TMO], 1u); break; } } } } while (0)
struct XcdBarrier { unsigned* bar; unsigned x; volatile LAS unsigned* st; };
__device__ __forceinline__ XcdBarrier xcd_barrier_post(unsigned* bar, volatile LAS unsigned* st) {
    XcdBarrier b; b.bar = bar; b.x = xb_xcc_id(); b.st = st;
    if (threadIdx.x == 0) (void)xb_add(&bar[XB_XCNT(b.x)], 1u);
    return b;
}
__device__ __forceinline__ void xcd_barrier_complete(unsigned* bar, unsigned x, unsigned& nloc, unsigned& nx) {
    const unsigned G = gridDim.x * gridDim.y * gridDim.z;
    unsigned sum, cnt, mine, sp = 0u;
    for (;;) {
        sum = 0u; cnt = 0u; mine = 0u;
#pragma unroll
        for (unsigned j = 0; j < 16; ++j) { const unsigned c = xb_ld(&bar[XB_XCNT(j)]); sum += c; cnt += (c > 0u) ? 1u : 0u; mine = (j == x) ? c : mine; }
        if (sum == G) break;
        __builtin_amdgcn_s_sleep(1);
        if ((++sp & 255u) == 0u) { if (xb_ld(&bar[XB_TMO])) break; if (sp > XB_SPIN_CAP) { atomicAdd(&bar[XB_TMO], 1u); break; } }
    }
    nloc = mine > 0u ? mine : 1u; nx = cnt > 0u ? cnt : 1u;
}
template <class Idle>
__device__ __forceinline__ void xcd_barrier(const XcdBarrier& b, Idle&& idle) {
    asm volatile("s_waitcnt vmcnt(0)" ::: "memory");
    __syncthreads();
    if (threadIdx.x == 0) {
        unsigned* bar = b.bar;
        __builtin_amdgcn_s_waitcnt(0);
        unsigned nloc = b.st[0], nx = b.st[1];
        if (nloc == 0u) { xcd_barrier_complete(bar, b.x, nloc, nx); b.st[0] = nloc; b.st[1] = nx; }
        const unsigned old = xb_add(&bar[XB_XSUB(b.x)], 1u);
        const unsigned gen = old / nloc;
        if (old + 1u == (gen + 1u) * nloc) {
            __builtin_amdgcn_fence(__ATOMIC_RELEASE, "agent");
            asm volatile("s_waitcnt vmcnt(0)" ::: "memory");
            const unsigned og = xb_add(&bar[XB_TOP], 1u);
            const unsigned tg = og / nx;
            if (og + 1u == (tg + 1u) * nx) xb_add(&bar[XB_TOPGEN], 1u);
            else XB_SPIN(xb_ld(&bar[XB_TOPGEN]) == tg, bar);
            __builtin_amdgcn_fence(__ATOMIC_ACQUIRE, "agent");
            xb_add(&bar[XB_XGEN(b.x)], 1u);
            asm volatile("s_waitcnt vmcnt(0)" ::: "memory");
            b.st[2] = 1u;
        } else { b.st[2] = 0u; b.st[3] = gen; }
    }
    __syncthreads();
    unsigned rounds = 0u;
    while (b.st[2] == 0u) {
        const bool had = idle();
        const unsigned long long anyw = __ballot(had);
        __syncthreads();
        if (threadIdx.x == 0) {
            unsigned* bar = b.bar; const unsigned gen = b.st[3];
            bool rel = xb_ld(&bar[XB_XGEN(b.x)]) != gen;
            if (!rel && anyw == 0ull) { XB_SPIN(xb_ld(&bar[XB_XGEN(b.x)]) == gen, bar); rel = true; }
            if (!rel && ++rounds > (1u << 16)) { atomicAdd(&bar[XB_TMO], 1u); rel = true; }
            if (rel) { __builtin_amdgcn_fence(__ATOMIC_ACQUIRE, "agent"); asm volatile("s_waitcnt vmcnt(0)" ::: "memory"); b.st[2] = 1u; }
        }
        __syncthreads();
    }
}

#ifndef FP8_ASM
#define FP8_ASM 0
#endif
namespace pg8 {
constexpr int BM = 256, BK = 64, HALF = 128, HTB = HALF * BK * 2, STAGE_BYTES = 8 * HTB, NXCD = 8, WGM = 8;
__host__ __device__ __forceinline__ int lds_byte(int r, int c) { const int st = (r >> 4) * 2 + (c >> 5), rr = r & 15, cc = c & 31, ob = rr * 64 + cc * 2; return st * 1024 + (ob ^ (((ob >> 9) & 1) << 5)); }
__host__ __device__ __forceinline__ void stage_rc(int b, int& R, int& C) { const int st = b / 1024, sb = b % 1024, swz = sb ^ (((sb >> 9) & 1) << 5); R = (st >> 1) * 16 + swz / 64; C = (st & 1) * 32 + (swz % 64) / 2; }
__host__ __device__ __forceinline__ int perm32(int rho) { const int n = rho >> 4, i = rho & 15; return 8 * (i >> 2) + 4 * n + (i & 3); }

struct Unit { int pm, pn, e, full; };
struct Gemm { const bf16_t* A; const bf16_t* Bt; int K; size_t b_estride; };

struct StaticOrder {
    int nM, nN, nwg, G, c;
    __device__ void init(int M, int N, int G_, int c_) { nM = M / BM; nN = N / BM; nwg = nM * nN; G = G_; c = c_; }
    __device__ bool next(int i, Unit& u) const {
        const long L = (long)i * G + c; if (L >= nwg) return false;
        int wgid = (int)L; { const int q = nwg / NXCD, r = nwg % NXCD, xcd = wgid % NXCD, off = wgid / NXCD; wgid = (xcd < r ? xcd * (q + 1) : r * (q + 1) + (xcd - r) * q) + off; }
        const int nig = WGM * nN, gid = wgid / nig, fm = gid * WGM, gsz = (nM - fm) < WGM ? (nM - fm) : WGM;
        u.pm = fm + ((wgid % nig) % gsz); u.pn = (wgid % nig) / gsz; u.e = 0; u.full = 1; return true;
    }
};
struct MoeOrder {
    const LAS int* tab; int r, nper;
    __device__ bool next(int i, Unit& u) const {
        const int L = i * nper + r; if (L >= __builtin_amdgcn_readfirstlane(tab[1])) return false;
        int p = 0; const int np = tab[0];
#pragma unroll 1
        while (p + 1 < np && tab[4 + 8 * (p + 1)] <= L) ++p;
        const LAS int* t = tab + 4 + 8 * p;
        const int local = L - t[0], mte = t[3], pq = local / mte, mt = local - pq * mte;
        u.e = __builtin_amdgcn_readfirstlane(t[1]); u.pn = __builtin_amdgcn_readfirstlane(t[2] + pq); u.pm = __builtin_amdgcn_readfirstlane(t[4] + mt);
        u.full = __builtin_amdgcn_readfirstlane((t[5] - mt * 256) > 128 ? 1 : 0); return true;
    }
};

struct EpiProj {
    static constexpr bool PERM = true;
    bf16_t* O; int ldc;
    __device__ __forceinline__ void operator()(const f32x4 (&acc)[2][2][4][2], const Unit& u, int wr, int wc, int fr, int fq) const {
        const int row0 = u.pm * BM + wr * 64 + fr, col0 = u.pn * BM + wc * 32 + 8 * fq;
#pragma unroll
        for (int ai = 0; ai < 2; ++ai)
#pragma unroll
            for (int m = 0; m < 4; ++m) { bf16_t* rowp = O + (size_t)(row0 + ai * HALF + m * 16) * ldc + col0;
#pragma unroll
                for (int bj = 0; bj < 2; ++bj) { const f32x4 v0 = acc[ai][bj][m][0], v1 = acc[ai][bj][m][1];
                    u32x4 w; w.x = cvt_pk_bf16(v0[0], v0[1]); w.y = cvt_pk_bf16(v0[2], v0[3]); w.z = cvt_pk_bf16(v1[0], v1[1]); w.w = cvt_pk_bf16(v1[2], v1[3]);
                    *(u32x4*)(rowp + bj * HALF) = w; } }
    }
};
struct EpiOut {
    static constexpr bool PERM = false;
    const float* X; const float* g1;   float* O;
    __device__ __forceinline__ void operator()(const f32x4 (&acc)[2][2][4][2], const Unit& u, int wr, int wc, int fr, int fq) const {
        const int row0 = u.pm * BM + wr * 64 + fr, col0 = u.pn * BM + wc * 32 + 4 * fq;
        const float* gp = g1 + (size_t)((u.pm * BM) >> 12) * 12288 + col0;
        f32x4 gv[2][2];
#pragma unroll
        for (int bj = 0; bj < 2; ++bj)
#pragma unroll
            for (int n = 0; n < 2; ++n) gv[bj][n] = *(const f32x4*)(gp + bj * HALF + n * 16);
#pragma unroll
        for (int ai = 0; ai < 2; ++ai)
#pragma unroll
            for (int m = 0; m < 4; ++m) { const size_t off = (size_t)(row0 + ai * HALF + m * 16) * DM + col0;
#pragma unroll
                for (int bj = 0; bj < 2; ++bj)
#pragma unroll
                    for (int n = 0; n < 2; ++n) { const f32x4 xv = *(const f32x4*)(X + off + bj * HALF + n * 16);
                        *(f32x4*)(O + off + bj * HALF + n * 16) = xv + gv[bj][n] * acc[ai][bj][m][n]; }
                asm volatile("" ::: "memory"); }
    }
};
struct EpiGU {
    static constexpr bool PERM = true;
    const float* bias;   bf16_t* O;
    __device__ __forceinline__ void operator()(const f32x4 (&acc)[2][2][4][2], const Unit& u, int wr, int wc, int fr, int fq) const {
        const int row0 = u.pm * BM + wr * 64 + fr, cc = u.pn * HALF + wc * 32 + 8 * fq;
        const float* bp = bias + (size_t)u.e * 4096 + cc;
        f32x4 bg[2], bu[2];
#pragma unroll
        for (int n = 0; n < 2; ++n) { bg[n] = *(const f32x4*)(bp + 4 * n); bu[n] = *(const f32x4*)(bp + 2048 + 4 * n); }
#pragma unroll
        for (int ai = 0; ai < 2; ++ai)
#pragma unroll
            for (int m = 0; m < 4; ++m) { float r[8];
#pragma unroll
                for (int n = 0; n < 2; ++n)
#pragma unroll
                    for (int j = 0; j < 4; ++j) {
                        float g = acc[ai][0][m][n][j] + bg[n][j], uu = acc[ai][1][m][n][j] + bu[n][j];
                        g = fminf(g, 7.0f); uu = fminf(fmaxf(uu, -7.0f), 7.0f);
                        const float glu = g * __builtin_amdgcn_rcpf(1.0f + __expf(-1.702f * g));
                        r[n * 4 + j] = (uu + 1.0f) * glu;
#if FP8_EMU
                        r[n * 4 + j] = q8(r[n * 4 + j]);
#endif
                    }
                u32x4 w; w.x = cvt_pk_bf16(r[0], r[1]); w.y = cvt_pk_bf16(r[2], r[3]); w.z = cvt_pk_bf16(r[4], r[5]); w.w = cvt_pk_bf16(r[6], r[7]);
                *(u32x4*)(O + (size_t)(row0 + ai * HALF + m * 16) * DM + cc) = w; }
    }
};
struct EpiDown {
    static constexpr bool PERM = true;
    const float* bias;   const float* wbuf; bf16_t* O;
    __device__ __forceinline__ void operator()(const f32x4 (&acc)[2][2][4][2], const Unit& u, int wr, int wc, int fr, int fq) const {
        const int row0 = u.pm * BM + wr * 64 + fr, col0 = u.pn * BM + wc * 32 + 8 * fq;
        const float* bp = bias + (size_t)u.e * 2048 + col0;
        f32x4 bv[2][2];
#pragma unroll
        for (int bj = 0; bj < 2; ++bj)
#pragma unroll
            for (int n = 0; n < 2; ++n) bv[bj][n] = *(const f32x4*)(bp + bj * HALF + 4 * n);
#pragma unroll
        for (int ai = 0; ai < 2; ++ai)
#pragma unroll
            for (int m = 0; m < 4; ++m) { const int row = row0 + ai * HALF + m * 16; const float rw = wbuf[row]; bf16_t* rowp = O + (size_t)row * DM + col0;
#pragma unroll
                for (int bj = 0; bj < 2; ++bj) { const f32x4 v0 = (acc[ai][bj][m][0] + bv[bj][0]) * rw, v1 = (acc[ai][bj][m][1] + bv[bj][1]) * rw;
                    u32x4 w; w.x = cvt_pk_bf16(v0[0], v0[1]); w.y = cvt_pk_bf16(v0[2], v0[3]); w.z = cvt_pk_bf16(v1[0], v1[1]); w.w = cvt_pk_bf16(v1[2], v1[3]);
                    *(u32x4*)(rowp + bj * HALF) = w; } }
    }
};

__device__ __forceinline__ unsigned pk4_fp8(float a, float b, float c, float d) { int p = __builtin_amdgcn_cvt_pk_fp8_f32(a, b, 0, false); p = __builtin_amdgcn_cvt_pk_fp8_f32(c, d, p, true); return (unsigned)p; }
constexpr float W8_SCALE = 64.0f, W8_INV = 1.0f / 64.0f;
struct EpiGU8 {
    static constexpr bool PERM = true;
    const float* bias;   unsigned char* O;
    __device__ __forceinline__ void operator()(const f32x4 (&acc)[2][2][4][2], const Unit& u, int wr, int wc, int fr, int fq) const {
        const int row0 = u.pm * BM + wr * 64 + fr, cc = u.pn * HALF + wc * 32 + 8 * fq;
        const float* bp = bias + (size_t)u.e * 4096 + cc;
        f32x4 bg[2], bu[2];
#pragma unroll
        for (int n = 0; n < 2; ++n) { bg[n] = *(const f32x4*)(bp + 4 * n); bu[n] = *(const f32x4*)(bp + 2048 + 4 * n); }
#pragma unroll
        for (int ai = 0; ai < 2; ++ai)
#pragma unroll
            for (int m = 0; m < 4; ++m) { float r[8];
#pragma unroll
                for (int n = 0; n < 2; ++n)
#pragma unroll
                    for (int j = 0; j < 4; ++j) {
                        float g = acc[ai][0][m][n][j] * W8_INV + bg[n][j], uu = acc[ai][1][m][n][j] * W8_INV + bu[n][j];
                        g = fminf(g, 7.0f); uu = fminf(fmaxf(uu, -7.0f), 7.0f);
                        const float glu = g * __builtin_amdgcn_rcpf(1.0f + __expf(-1.702f * g));
                        r[n * 4 + j] = (uu + 1.0f) * glu; }
                u32x2 w; w.x = pk4_fp8(r[0], r[1], r[2], r[3]); w.y = pk4_fp8(r[4], r[5], r[6], r[7]);
                *(u32x2*)(O + (size_t)(row0 + ai * HALF + m * 16) * DM + cc) = w; }
    }
};
struct EpiDown8 {
    static constexpr bool PERM = true;
    const float* bias;   const float* wbuf; bf16_t* O;
    __device__ __forceinline__ void operator()(const f32x4 (&acc)[2][2][4][2], const Unit& u, int wr, int wc, int fr, int fq) const {
        const int row0 = u.pm * BM + wr * 64 + fr, col0 = u.pn * BM + wc * 32 + 8 * fq;
        const float* bp = bias + (size_t)u.e * 2048 + col0;
        f32x4 bv[2][2];
#pragma unroll
        for (int bj = 0; bj < 2; ++bj)
#pragma unroll
            for (int n = 0; n < 2; ++n) bv[bj][n] = *(const f32x4*)(bp + bj * HALF + 4 * n);
#pragma unroll
        for (int ai = 0; ai < 2; ++ai)
#pragma unroll
            for (int m = 0; m < 4; ++m) { const int row = row0 + ai * HALF + m * 16; const float rw = wbuf[row]; bf16_t* rowp = O + (size_t)row * DM + col0;
#pragma unroll
                for (int bj = 0; bj < 2; ++bj) { const f32x4 v0 = (acc[ai][bj][m][0] * W8_INV + bv[bj][0]) * rw, v1 = (acc[ai][bj][m][1] * W8_INV + bv[bj][1]) * rw;
                    u32x4 w; w.x = cvt_pk_bf16(v0[0], v0[1]); w.y = cvt_pk_bf16(v0[2], v0[3]); w.z = cvt_pk_bf16(v1[0], v1[1]); w.w = cvt_pk_bf16(v1[2], v1[3]);
                    *(u32x4*)(rowp + bj * HALF) = w; } }
    }
};

typedef int i32x8 __attribute__((ext_vector_type(8)));
typedef short s16x16 __attribute__((ext_vector_type(16)));
__device__ __forceinline__ i32x8 ld32(const LAS unsigned char* p) { const bf16x8 lo = *(const LAS bf16x8*)p, hi = *(const LAS bf16x8*)(p + 16); return __builtin_bit_cast(i32x8, __builtin_shufflevector(lo, hi, 0, 1, 2, 3, 4, 5, 6, 7, 8, 9, 10, 11, 12, 13, 14, 15)); }
__device__ __forceinline__ const char* sbase(const char* p) { asm volatile("" : "+s"(p)); return p; }
template <bool FP8, class Epi, class Sched>
__device__ __forceinline__ void gemm_phase(LAS unsigned char* lds, const Gemm g, const Sched& S, const Epi& E) {
    const int tid = threadIdx.x, wid = __builtin_amdgcn_readfirstlane(tid >> 6), lane = tid & 63, wr = wid >> 2, wc = wid & 3, fr = lane & 15, fq = lane >> 4;
    const int K = g.K, nt = K / BK;
    unsigned voffA, voffB;
    { int R, C; stage_rc(tid * 16, R, C); const int Rb = Epi::PERM ? ((R & ~31) + perm32(R & 31)) : R; voffA = (unsigned)(R * K + C) * 2u; voffB = (unsigned)(Rb * K + C) * 2u; }
    const size_t pstep = (size_t)64 * K * 2;
    const size_t kstep = (size_t)(BK * 2);
    const size_t hstep = (size_t)HALF * K * 2;
    const size_t tstep = 2 * hstep;
    const size_t estep = g.b_estride * 2;
    const unsigned ldsw = (unsigned)wid * 1024u;
    const int aoff0 = FP8 ? lds_byte(wr * 64 + fr, fq * 16) : lds_byte(wr * 64 + fr, fq * 8), boff0 = FP8 ? lds_byte(wc * 32 + fr, fq * 16) : lds_byte(wc * 32 + fr, fq * 8);
#define PG8_SA(b, h) (((b) * 2 + (h)) * HTB)
#define PG8_SB(b, h) ((4 + (b) * 2 + (h)) * HTB)
#define PG8_STAGE(bufoff, gbase, voff) do { _Pragma("unroll") for (int _i = 0; _i < 2; ++_i) \
        __builtin_amdgcn_global_load_lds((const unsigned*)(sbase((const char*)(gbase) + _i * pstep) + (voff)), (LAS unsigned*)(lds + (bufoff) + ldsw + _i * 8192), 16, 0, 0); } while (0)
#define PG8_LDA(dst, b, h) do { _Pragma("unroll") for (int m = 0; m < 4; ++m) { \
        if constexpr (FP8) dst##8[m] = ld32(lds + PG8_SA(b, h) + aoff0 + m * 2048); \
        else { dst[m][0] = *(const LAS bf16x8*)(lds + PG8_SA(b, h) + aoff0 + m * 2048); dst[m][1] = *(const LAS bf16x8*)(lds + PG8_SA(b, h) + aoff0 + m * 2048 + 1024); } } } while (0)
#define PG8_LDB(dst, b, h) do { _Pragma("unroll") for (int n = 0; n < 2; ++n) { \
        if constexpr (FP8) dst##8[n] = ld32(lds + PG8_SB(b, h) + boff0 + n * 2048); \
        else { dst[n][0] = *(const LAS bf16x8*)(lds + PG8_SB(b, h) + boff0 + n * 2048); dst[n][1] = *(const LAS bf16x8*)(lds + PG8_SB(b, h) + boff0 + n * 2048 + 1024); } } } while (0)
#define PG8_MMA(ai, bj, At, Bt) do { __builtin_amdgcn_s_setprio(1); _Pragma("unroll") for (int m = 0; m < 4; ++m) _Pragma("unroll") for (int n = 0; n < 2; ++n) { \
        if constexpr (FP8) { if (FP8_ASM) { asm volatile("v_mfma_scale_f32_16x16x128_f8f6f4 %0, %1, %2, %0, %3, %3 op_sel_hi:[0,0,0]" : "+a"(acc[ai][bj][m][n]) : "v"(Bt##8[n]), "v"(At##8[m]), "v"(scale1)); } \
            else acc[ai][bj][m][n] = __builtin_amdgcn_mfma_scale_f32_16x16x128_f8f6f4(Bt##8[n], At##8[m], acc[ai][bj][m][n], 0, 0, 0, 0x7f7f7f7f, 0, 0x7f7f7f7f); } \
        else { acc[ai][bj][m][n] = __builtin_amdgcn_mfma_f32_16x16x32_bf16(Bt[n][0], At[m][0], acc[ai][bj][m][n], 0, 0, 0); \
               acc[ai][bj][m][n] = __builtin_amdgcn_mfma_f32_16x16x32_bf16(Bt[n][1], At[m][1], acc[ai][bj][m][n], 0, 0, 0); } } \
        __builtin_amdgcn_s_setprio(0); } while (0)
#define PG8_WAIT_V(n) asm volatile("s_waitcnt vmcnt(" #n ")" ::: "memory")
#define PG8_WAIT_L(n) asm volatile("s_waitcnt lgkmcnt(" #n ")" ::: "memory")
#define PG8_BAR __builtin_amdgcn_s_barrier()
#define PG8_SCHED __builtin_amdgcn_sched_barrier(0)
    Unit cur, nxt; int ui = 0;
    if (!S.next(0, cur)) return;
    f32x4 acc[2][2][4][2];
#pragma unroll
    for (int a = 0; a < 2; ++a)
#pragma unroll
        for (int b = 0; b < 2; ++b)
#pragma unroll
            for (int m = 0; m < 4; ++m)
#pragma unroll
                for (int n = 0; n < 2; ++n) acc[a][b][m][n] = (f32x4){0.f, 0.f, 0.f, 0.f};
    bf16x8 At[4][2], B0[2][2], B1[2][2]; i32x8 At8[4], B08[2], B18[2];
    const unsigned scale1 = 0x7f7f7f7fu;
    const char* cA = (const char*)g.A + (size_t)cur.pm * tstep; const char* cB = (const char*)g.Bt + (size_t)cur.e * estep + (size_t)cur.pn * tstep;
    PG8_STAGE(PG8_SB(0, 0), cB, voffB); PG8_STAGE(PG8_SA(0, 0), cA, voffA); PG8_STAGE(PG8_SB(0, 1), cB + hstep, voffB); PG8_STAGE(PG8_SA(0, 1), cA + hstep, voffA);
    if (wr == 1) PG8_BAR;
    PG8_WAIT_V(4); PG8_BAR;
    PG8_STAGE(PG8_SB(1, 0), cB + kstep, voffB); PG8_STAGE(PG8_SA(1, 0), cA + kstep, voffA); PG8_STAGE(PG8_SB(1, 1), cB + hstep + kstep, voffB);
    PG8_WAIT_V(6); PG8_BAR;
    for (;;) {
        const bool has_next = S.next(ui + 1, nxt);
        const bool cfull = FP8 ? true : (cur.full != 0);
        const char* nA = has_next ? (const char*)g.A + (size_t)nxt.pm * tstep : cA;
        const char* nB = has_next ? (const char*)g.Bt + (size_t)nxt.e * estep + (size_t)nxt.pn * tstep : cB;
        for (int t = 0; t < nt; t += 2) {
            const bool last = (t == nt - 2);
            const char* a1 = cA + (size_t)(t + 1) * kstep;
            const char* a2 = last ? nA : cA + (size_t)(t + 2) * kstep; const char* b2 = last ? nB : cB + (size_t)(t + 2) * kstep;
            const char* a3 = a2 + kstep; const char* b3 = b2 + kstep;
            PG8_LDB(B0, 0, 0); PG8_SCHED; PG8_LDA(At, 0, 0); PG8_STAGE(PG8_SA(1, 1), a1 + hstep, voffA);
            PG8_WAIT_L(8); PG8_BAR; PG8_WAIT_L(0); PG8_MMA(0, 0, At, B0); PG8_BAR; PG8_SCHED;
            PG8_LDB(B1, 0, 1); PG8_STAGE(PG8_SB(0, 0), b2, voffB);
            PG8_BAR; PG8_WAIT_L(0); PG8_MMA(0, 1, At, B1); PG8_BAR;
            PG8_LDA(At, 0, 1); PG8_STAGE(PG8_SA(0, 0), a2, voffA);
            PG8_BAR; PG8_WAIT_L(0); if (cfull) PG8_MMA(1, 0, At, B0); PG8_BAR; PG8_SCHED;
            PG8_STAGE(PG8_SB(0, 1), b2 + hstep, voffB);
            PG8_WAIT_V(6); PG8_BAR; if (cfull) PG8_MMA(1, 1, At, B1); PG8_BAR;
            PG8_LDB(B0, 1, 0); PG8_SCHED; PG8_LDA(At, 1, 0); PG8_STAGE(PG8_SA(0, 1), a2 + hstep, voffA);
            PG8_WAIT_L(8); PG8_BAR; PG8_WAIT_L(0); PG8_MMA(0, 0, At, B0); PG8_BAR; PG8_SCHED;
            PG8_LDB(B1, 1, 1); PG8_STAGE(PG8_SB(1, 0), b3, voffB);
            PG8_BAR; PG8_WAIT_L(0); PG8_MMA(0, 1, At, B1); PG8_BAR;
            PG8_LDA(At, 1, 1); PG8_STAGE(PG8_SA(1, 0), a3, voffA);
            PG8_BAR; PG8_WAIT_L(0); if (cfull) PG8_MMA(1, 0, At, B0); PG8_BAR; PG8_SCHED;
            PG8_STAGE(PG8_SB(1, 1), b3 + hstep, voffB);
            PG8_WAIT_V(6); PG8_BAR; if (cfull) PG8_MMA(1, 1, At, B1); PG8_BAR;
        }
        {
            int tz = threadIdx.x; asm volatile("" : "+v"(tz)); const int lz = tz & 63;
            E(acc, cur, wr, wc, lz & 15, lz >> 4); }
        if (!has_next) break;
#pragma unroll
        for (int a = 0; a < 2; ++a)
#pragma unroll
            for (int b = 0; b < 2; ++b)
#pragma unroll
                for (int m = 0; m < 4; ++m)
#pragma unroll
                    for (int n = 0; n < 2; ++n) acc[a][b][m][n] = (f32x4){0.f, 0.f, 0.f, 0.f};
        cur = nxt; cA = nA; cB = nB; ++ui;
    }
    PG8_WAIT_V(0);
    if (wr == 0) PG8_BAR;
    PG8_BAR;
#undef PG8_SA
#undef PG8_SB
#undef PG8_STAGE
#undef PG8_LDA
#undef PG8_LDB
#undef PG8_MMA
#undef PG8_WAIT_V
#undef PG8_WAIT_L
#undef PG8_BAR
#undef PG8_SCHED
}
}

__device__ __forceinline__ void conv_job(const float* src, int ld, bf16_t* dst, int kt) {
    const int w = threadIdx.x >> 6, lane = threadIdx.x & 63, kseg = lane & 7, nq = lane >> 3;
    const int k0 = kt * 128 + (w >> 2) * 64 + kseg * 8, nl = (w & 3) * 32 + nq * 4;
    f32x4 v[8];
#pragma unroll
    for (int r = 0; r < 8; ++r) v[r] = *(const f32x4*)(src + (size_t)(k0 + r) * ld + nl);
#pragma unroll
    for (int j = 0; j < 4; ++j) { u32x4 o; o.x = cvt_pk_bf16(v[0][j], v[1][j]); o.y = cvt_pk_bf16(v[2][j], v[3][j]); o.z = cvt_pk_bf16(v[4][j], v[5][j]); o.w = cvt_pk_bf16(v[6][j], v[7][j]);
        *(u32x4*)(dst + (size_t)(nl + j) * 2048 + k0) = o; }
}
constexpr int CONV_JOBS_GU = 32 * 16 * 16, CONV_JOBS_D = 32 * 16 * 8, CONV_JOBS = CONV_JOBS_GU + CONV_JOBS_D;
__device__ __forceinline__ void conv_block_job(const Args& a, LAS unsigned char* T, int j) {
    const int tid = threadIdx.x, w = tid >> 6, lane = tid & 63;
    const float* src; int ld; unsigned char* dst; int gu, s0;
    if (j < CONV_JOBS_GU) { const int e = j >> 8, kb = (j >> 4) & 15, nb = j & 15; s0 = nb * 256; gu = 1;
        src = a.w_gate_up + ((size_t)e * 2048 + kb * 128) * 4096 + s0; ld = 4096; dst = (unsigned char*)(a.ws + WS_WGU_T) + (size_t)e * 4096 * 2048 + kb * 128; }
    else { const int jj = j - CONV_JOBS_GU, e = jj >> 7, kb = (jj >> 3) & 15, nb = jj & 7; s0 = nb * 256; gu = 0;
        src = a.w_down + ((size_t)e * 2048 + kb * 128) * 2048 + s0; ld = 2048; dst = (unsigned char*)(a.ws + WS_WD_T) + (size_t)e * 2048 * 2048 + kb * 128; }
    f32x4 v[16];
#pragma unroll
    for (int r = 0; r < 16; ++r) v[r] = __builtin_nontemporal_load((const f32x4*)(src + (size_t)(w * 16 + r) * ld + lane * 4)) * pg8::W8_SCALE;
#pragma unroll
    for (int jn = 0; jn < 4; ++jn) { u32x4 o;
        o.x = pg8::pk4_fp8(v[0][jn], v[1][jn], v[2][jn], v[3][jn]); o.y = pg8::pk4_fp8(v[4][jn], v[5][jn], v[6][jn], v[7][jn]);
        o.z = pg8::pk4_fp8(v[8][jn], v[9][jn], v[10][jn], v[11][jn]); o.w = pg8::pk4_fp8(v[12][jn], v[13][jn], v[14][jn], v[15][jn]);
        const int n = lane * 4 + jn;
        *(LAS u32x4*)(T + n * 128 + ((w ^ (lane & 7)) << 4)) = o; }
    __syncthreads();
#pragma unroll
    for (int p = 0; p < 4; ++p) { const int idx = tid + 512 * p, n = idx >> 3, wq = idx & 7;
        const u32x4 o = *(const LAS u32x4*)(T + n * 128 + ((wq ^ ((n >> 2) & 7)) << 4));
        const int c = s0 + n; int np = c;
        if (gu) { const int bj = c >> 11, rem = c & 2047; np = (rem >> 7) * 256 + bj * 128 + (rem & 127); }
        __builtin_nontemporal_store(o, (u32x4*)(dst + (size_t)np * 2048 + wq * 16)); }
}
__device__ __forceinline__ void conv_all(const Args& a, LAS unsigned char* lds) {
    int buf = 0;
    for (int j = blockIdx.x; j < CONV_JOBS; j += gridDim.x) { conv_block_job(a, lds + buf * 32768, j); buf ^= 1; }
    __syncthreads();
}
__device__ __forceinline__ bool conv_claim(const Args&, int) { return false; }

__device__ __forceinline__ void phase_prologue(const Args& a, LAS unsigned char* lds) {
    const int tid = threadIdx.x, blk = blockIdx.x, G = gridDim.x;
    if (blk < 192) {
        LAS float* cact = (LAS float*)lds; LAS float* red = (LAS float*)(lds + 16384);
        for (int i = tid; i < 4096; i += 512) cact[i] = silu_f(a.c[i]);
        __syncthreads();
        float* mod = (float*)(a.ws + WS_MOD);
        for (int cb = blk; cb < 192; cb += G) {
            const int rg = tid >> 4, cl = tid & 15;
            const float* wp = a.w_ada + (size_t)cb * 64 + cl * 4;
            f32x4 a0 = {0.f, 0.f, 0.f, 0.f}, a1 = {0.f, 0.f, 0.f, 0.f};
#pragma unroll 8
            for (int i = 0; i < 64; ++i) { const int k = rg + 32 * i; const f32x4 w = *(const f32x4*)(wp + (size_t)k * 12288); a0 += w * cact[k]; a1 += w * cact[2048 + k]; }
#pragma unroll
            for (int j = 0; j < 4; ++j) { red[(rg * 2 + 0) * 64 + cl * 4 + j] = a0[j]; red[(rg * 2 + 1) * 64 + cl * 4 + j] = a1[j]; }
            __syncthreads();
            if (tid < 128) { const int b = tid >> 6, col = tid & 63; float s = 0.f; for (int r = 0; r < 32; ++r) s += red[(r * 2 + b) * 64 + col]; mod[b * 12288 + cb * 64 + col] = s + a.b_ada[cb * 64 + col]; }
            __syncthreads();
        }
    }
    {
        float* ct = (float*)(a.ws + WS_ROPE); float* st = ct + 4096 * 64;
        for (int idx = blk * 512 + tid; idx < 4096 * 64; idx += G * 512) {
            const int t = idx >> 6, i = idx & 63;
            const float inv = (float)exp2(-(double)i * (13.287712379549449 / 64.0));
            const float ang = (float)t * inv;
            const double ad = (double)ang, n = rint(ad * 0.15915494309189535), r = fma(-n, 6.283185307179586, ad) - n * 2.4492935982947064e-16;
            const float rf = (float)r;
            ct[idx] = cosf(rf); st[idx] = sinf(rf);
        }
    }
    {
        bf16_t* win_t = (bf16_t*)(a.ws + WS_WIN_T); bf16_t* wout_t = (bf16_t*)(a.ws + WS_WOUT_T);
        for (int job = blk; job < 64 * 16; job += G) {
            const int rt = job >> 4, kt = job & 15;
            const float* src; int ld; bf16_t* dst;
            if (rt < 48) { const int n0 = rt * 128, col0 = n0 < 3072 ? n0 : n0 + 16; src = a.w_in + col0; ld = DIN; dst = win_t + (size_t)n0 * 2048; }
            else { const int n0 = (rt - 48) * 128; src = a.w_out + n0; ld = 2048; dst = wout_t + (size_t)n0 * 2048; }
            conv_job(src, ld, dst, kt);
        }
    }
}

__device__ __forceinline__ void phase_norm1(const Args& a, LAS unsigned char* lds) {
    const int tid = threadIdx.x, blk = blockIdx.x, G = gridDim.x, w = tid >> 6, lane = tid & 63;
    LAS float* wlaT = (LAS float*)lds;
#pragma unroll 16
    for (int idx = tid; idx < 2048 * 16; idx += 512) { const int k = idx >> 4, j = idx & 15; wlaT[j * 2048 + k] = a.w_in[(size_t)k * DIN + 3072 + j]; }
    __syncthreads();
    const float* mod = (const float*)(a.ws + WS_MOD);
    bf16_t* h1 = (bf16_t*)(a.ws + WS_H1); float* gk = (float*)(a.ws + WS_GK);
    for (int r = blk * 8 + w; r < NTOK; r += G * 8) {
        const f32x4* xr = (const f32x4*)(a.x + (size_t)r * DM) + lane;
        f32x4 v[8]; float ss = 0.f;
#pragma unroll
        for (int q = 0; q < 8; ++q) { v[q] = xr[64 * q]; ss += (v[q][0] * v[q][0] + v[q][1] * v[q][1]) + (v[q][2] * v[q][2] + v[q][3] * v[q][3]); }
        ss = wave_sum(ss);
        const float rstd = 1.0f / sqrtf(ss * (1.0f / DM) + EPS);
        const float* sh = mod + (size_t)(r >> 12) * 12288; const float* sc = sh + 2048;
#pragma unroll
        for (int q = 0; q < 8; ++q) { const int k = 4 * (lane + 64 * q);
            const f32x4 nw = *(const f32x4*)(a.norm1_w + k), scv = *(const f32x4*)(sc + k), shv = *(const f32x4*)(sh + k);
            v[q] = (v[q] * rstd * nw) * (scv + 1.0f) + shv;
            u32x2 o; o.x = cvt_pk_bf16(v[q][0], v[q][1]); o.y = cvt_pk_bf16(v[q][2], v[q][3]);
            *(u32x2*)(h1 + (size_t)r * DM + k) = o; }
        LAS float* las = (LAS float*)(lds + LDS_EXTRA) + w * 16;
#pragma unroll 1
        for (int j = 0; j < 16; ++j) { float s = 0.f;
#pragma unroll
            for (int q = 0; q < 8; ++q) { const f32x4 wl = *(const LAS f32x4*)(wlaT + j * 2048 + 4 * (lane + 64 * q)); s += (v[q][0] * wl[0] + v[q][1] * wl[1]) + (v[q][2] * wl[2] + v[q][3] * wl[3]); }
            s = wave_sum(s); if (lane == 0) las[j] = s; }
        asm volatile("s_waitcnt lgkmcnt(0)" ::: "memory");
#pragma unroll 1
        for (int m = 0; m < 8; ++m) { const int d = lane + 64 * m; float z = a.b_alpha[d];
#pragma unroll
            for (int j = 0; j < 16; ++j) z += las[j] * a.w_alpha2[j * 512 + d];
            const float ls = fminf(z, 0.f) - log1pf(expf(-fabsf(z)));
            gk[(size_t)r * 512 + d] = ls * (1.0f / 16.0f); }
        asm volatile("s_waitcnt lgkmcnt(0)" ::: "memory");
    }
}

__device__ __forceinline__ void gla_stage_vt(const bf16_t* proj, int row0, int h, LAS bf16_t* VT, int tid) {
    const int i = tid >> 3, seg = tid & 7;
    const u32x4* vp = (const u32x4*)(proj + (size_t)(row0 + i) * NPROJ + C_VA + h * 256 + seg * 32);
#pragma unroll
    for (int c4 = 0; c4 < 4; ++c4) { const u32x4 vv = vp[c4];
#pragma unroll
        for (int p = 0; p < 4; ++p) { const unsigned wd = vv[p]; const int e = seg * 32 + c4 * 8 + p * 2;
            VT[e * 72 + i] = (bf16_t)(wd & 0xffffu); VT[(e + 1) * 72 + i] = (bf16_t)(wd >> 16); } }
}
__device__ __forceinline__ void gla1_unit(const Args& a, LAS unsigned char* lds, int u) {
    const int tid = threadIdx.x, w = tid >> 6, lane = tid & 63;
    const int bh = u >> 6, c = u & 63, b = bh >> 2, h = bh & 3, row0 = b * SEQ + c * 64;
    LAS float* Bm = (LAS float*)lds; LAS bf16_t* KT = (LAS bf16_t*)(lds + 32768); LAS bf16_t* VT = (LAS bf16_t*)(lds + 51200);
    const float* gk = (const float*)(a.ws + WS_GK); const bf16_t* proj = (const bf16_t*)(a.ws + WS_PROJ);
    float* bcum = (float*)(a.ws + WS_BCUM); float* dst = (float*)(a.ws + WS_DST); float* dec = (float*)(a.ws + WS_DEC);
    const int i = tid >> 3, seg = tid & 7;
    {
        const f32x4* gp = (const f32x4*)(gk + (size_t)(row0 + i) * 512 + h * 128 + seg * 16);
#pragma unroll
        for (int q = 0; q < 4; ++q) *(LAS f32x4*)(Bm + i * 128 + seg * 16 + q * 4) = gp[q];
    }
    __syncthreads();
    if (tid < 128) { float run = 0.f; for (int ii = 0; ii < 64; ++ii) { run += Bm[ii * 128 + tid]; Bm[ii * 128 + tid] = run; } }
    __syncthreads();
    {
        const u32x4* kp = (const u32x4*)(proj + (size_t)(row0 + i) * NPROJ + C_KA + h * 128 + seg * 16);
        float* bo = bcum + ((size_t)u * 64 + i) * 128 + seg * 16;
#pragma unroll
        for (int q = 0; q < 2; ++q) { const u32x4 kv = kp[q];
#pragma unroll
            for (int p = 0; p < 4; ++p) { const int d = seg * 16 + q * 8 + p * 2;
                const float b0 = Bm[i * 128 + d], b1 = Bm[i * 128 + d + 1], l0 = Bm[63 * 128 + d], l1 = Bm[63 * 128 + d + 1];
                bo[q * 8 + p * 2] = b0; bo[q * 8 + p * 2 + 1] = b1;
                KT[d * 72 + i] = f2bf(bflo(kv[p]) * expf(l0 - b0)); KT[(d + 1) * 72 + i] = f2bf(bfhi(kv[p]) * expf(l1 - b1));
                if (i == 63) { dec[(size_t)u * 128 + d] = expf(l0); dec[(size_t)u * 128 + d + 1] = expf(l1); } } }
        gla_stage_vt(proj, row0, h, VT, tid);
    }
    __syncthreads();
    {
        f32x4 acc[2][8];
#pragma unroll
        for (int x = 0; x < 2; ++x)
#pragma unroll
            for (int y = 0; y < 8; ++y) acc[x][y] = (f32x4){0.f, 0.f, 0.f, 0.f};
#pragma unroll
        for (int ks = 0; ks < 2; ++ks) {
            const bf16x8 a0 = lds_frag(VT, 72, (2 * w) * 16, ks * 32, lane), a1 = lds_frag(VT, 72, (2 * w + 1) * 16, ks * 32, lane);
#pragma unroll
            for (int dt = 0; dt < 8; ++dt) { const bf16x8 bf = lds_frag(KT, 72, dt * 16, ks * 32, lane); acc[0][dt] = mfma16(a0, bf, acc[0][dt]); acc[1][dt] = mfma16(a1, bf, acc[1][dt]); }
        }
        float* dp = dst + (size_t)u * 32768;
#pragma unroll
        for (int x = 0; x < 2; ++x)
#pragma unroll
            for (int dt = 0; dt < 8; ++dt)
#pragma unroll
                for (int r = 0; r < 4; ++r) dp[((2 * w + x) * 16 + 4 * (lane >> 4) + r) * 128 + dt * 16 + (lane & 15)] = acc[x][dt][r];
    }
    __syncthreads();
}
__device__ __forceinline__ void moba_prep_unit(const Args& a, LAS unsigned char* lds, int u2) {
    const int tid = threadIdx.x;
    const int bh = u2 >> 4, kb = u2 & 15, b = bh >> 3, h = bh & 7, row0 = b * SEQ + kb * 256, t0 = kb * 256;
    const bf16_t* proj = (const bf16_t*)(a.ws + WS_PROJ);
    const float* ct = (const float*)(a.ws + WS_ROPE); const float* st = ct + 4096 * 64;
    bf16_t* qbr = (bf16_t*)(a.ws + WS_QBR); bf16_t* kbr = (bf16_t*)(a.ws + WS_KBR); bf16_t* vbt = (bf16_t*)(a.ws + WS_VBT); float* kmean = (float*)(a.ws + WS_KMEAN);
    LAS float* Kf = (LAS float*)lds; LAS float* part = (LAS float*)(lds + LDS_EXTRA);
    const int row = tid >> 1, half = tid & 1;
    const float* cp = ct + (size_t)(t0 + row) * 64 + half * 32; const float* sp = st + (size_t)(t0 + row) * 64 + half * 32;
#pragma unroll 1
    for (int which = 0; which < 2; ++which) {
        const bf16_t* src = proj + (size_t)(row0 + row) * NPROJ + (which == 0 ? C_KB : C_QB) + h * 128 + half * 32;
        bf16_t* dsto = (which == 0 ? kbr : qbr) + ((size_t)bh * SEQ + t0 + row) * 128 + half * 32;
#pragma unroll
        for (int c4 = 0; c4 < 4; ++c4) {
            const u32x4 x1 = *(const u32x4*)(src + c4 * 8), x2 = *(const u32x4*)(src + 64 + c4 * 8);
            u32x4 o1, o2;
#pragma unroll
            for (int p = 0; p < 4; ++p) { const int ii = c4 * 8 + p * 2;
                const float c0 = cp[ii], c1 = cp[ii + 1], s0 = sp[ii], s1 = sp[ii + 1];
                const float a0 = bflo(x1[p]), a1 = bfhi(x1[p]), b0 = bflo(x2[p]), b1 = bfhi(x2[p]);
                const float r10 = a0 * c0 - b0 * s0, r11 = a1 * c1 - b1 * s1, r20 = a0 * s0 + b0 * c0, r21 = a1 * s1 + b1 * c1;
                o1[p] = cvt_pk_bf16(r10, r11); o2[p] = cvt_pk_bf16(r20, r21);
                if (which == 0) { Kf[row * 128 + half * 32 + ii] = r10; Kf[row * 128 + half * 32 + ii + 1] = r11; Kf[row * 128 + 64 + half * 32 + ii] = r20; Kf[row * 128 + 64 + half * 32 + ii + 1] = r21; } }
            *(u32x4*)(dsto + c4 * 8) = o1; *(u32x4*)(dsto + 64 + c4 * 8) = o2;
        }
        if (which == 0) {
            __syncthreads();
            { const int d = tid & 127, rq = tid >> 7; float s = 0.f; for (int rr = 0; rr < 64; ++rr) s += Kf[(rq * 64 + rr) * 128 + d]; part[rq * 128 + d] = s; }
            __syncthreads();
            if (tid < 128) kmean[((size_t)bh * 16 + kb) * 128 + tid] = (part[tid] + part[128 + tid] + part[256 + tid] + part[384 + tid]) * (1.0f / 256.0f);
        }
    }
    __syncthreads();
    LAS bf16_t* Vl = (LAS bf16_t*)lds;
    {
        const u32x4* vp = (const u32x4*)(proj + (size_t)(row0 + row) * NPROJ + C_VB + h * 128 + half * 64);
#pragma unroll
        for (int c8 = 0; c8 < 8; ++c8) { const u32x4 vv = vp[c8]; LAS unsigned* dp = (LAS unsigned*)(Vl + row * 130 + half * 64 + c8 * 8); dp[0] = vv[0]; dp[1] = vv[1]; dp[2] = vv[2]; dp[3] = vv[3]; }
    }
    __syncthreads();
    {
        const int d = tid >> 2, ts = tid & 3;
        bf16_t* op = vbt + ((size_t)bh * 128 + d) * SEQ + t0 + ts * 64;
#pragma unroll
        for (int c8 = 0; c8 < 8; ++c8) { u32x4 o;
#pragma unroll
            for (int p = 0; p < 4; ++p) { const int tt = ts * 64 + c8 * 8 + p * 2; o[p] = (unsigned)Vl[tt * 130 + d] | ((unsigned)Vl[(tt + 1) * 130 + d] << 16); }
            *(u32x4*)(op + c8 * 8) = o; }
    }
    __syncthreads();
}
__device__ __forceinline__ void phase_mix_prep(const Args& a, LAS unsigned char* lds) {
    const int blk = blockIdx.x, G = gridDim.x;
    for (int u = blk; u < 512; u += G) gla1_unit(a, lds, u);
    for (int u2 = blk; u2 < 256; u2 += G) moba_prep_unit(a, lds, u2);
}

__device__ __forceinline__ void phase_scan_select(const Args& a, LAS unsigned char* lds) {
    const int tid = threadIdx.x, blk = blockIdx.x, G = gridDim.x;
    {
        const float* dst = (const float*)(a.ws + WS_DST); const float* dec = (const float*)(a.ws + WS_DEC); bf16_t* ST = (bf16_t*)(a.ws + WS_ST);
        for (int el = blk * 512 + tid; el < 8 * 32768; el += G * 512) {
            const int bh = el >> 15, ed = el & 32767, d = ed & 127; float cur = 0.f;
#pragma unroll 8
            for (int c = 0; c < 64; ++c) { const size_t u = (size_t)bh * 64 + c; ST[u * 32768 + ed] = f2bf(cur); cur = dec[u * 128 + d] * cur + dst[u * 32768 + ed]; }
        }
    }
    {
        const float* kmean = (const float*)(a.ws + WS_KMEAN); const bf16_t* qbr = (const bf16_t*)(a.ws + WS_QBR); unsigned* sel = (unsigned*)(a.ws + WS_SEL);
        LAS float* km = (LAS float*)lds;
        for (int u2 = blk; u2 < 256; u2 += G) {
            const int bh = u2 >> 4, qb = u2 & 15;
            __syncthreads();
            for (int i = tid; i < 2048; i += 512) km[i] = kmean[(size_t)bh * 2048 + i];
            __syncthreads();
            const int q = tid >> 1, half = tid & 1;
            float gv[8];
#pragma unroll
            for (int n = 0; n < 8; ++n) gv[n] = 0.f;
            const u32x4* qp = (const u32x4*)(qbr + ((size_t)bh * SEQ + qb * 256 + q) * 128);
#pragma unroll 4
            for (int c = 0; c < 16; ++c) { const u32x4 qq = qp[c]; float qf[8];
#pragma unroll
                for (int p = 0; p < 4; ++p) { qf[2 * p] = bflo(qq[p]); qf[2 * p + 1] = bfhi(qq[p]); }
#pragma unroll
                for (int n = 0; n < 8; ++n) { const LAS float* kr = km + (half * 8 + n) * 128 + c * 8; const f32x4 k0 = *(const LAS f32x4*)kr, k1 = *(const LAS f32x4*)(kr + 4);
                    gv[n] += (qf[0] * k0[0] + qf[1] * k0[1]) + (qf[2] * k0[2] + qf[3] * k0[3]) + (qf[4] * k1[0] + qf[5] * k1[1]) + (qf[6] * k1[2] + qf[7] * k1[3]); } }
            float ga[16];
#pragma unroll
            for (int n = 0; n < 8; ++n) { const float o = __shfl_xor(gv[n], 1); ga[n] = half ? o : gv[n]; ga[8 + n] = half ? gv[n] : o; }
            unsigned mask = 0u; const int nsel = qb < 3 ? qb : 3;
            for (int s = 0; s < nsel; ++s) { int best = -1; float bv = -INFINITY;
#pragma unroll
                for (int n = 0; n < 16; ++n) { const bool ok = (n < qb) && !((mask >> n) & 1u) && (best < 0 || ga[n] > bv); if (ok) { bv = ga[n]; best = n; } }
                mask |= 1u << best; }
            if (half == 0) sel[(size_t)bh * SEQ + qb * 256 + q] = mask;
        }
        __syncthreads();
    }
}

#ifndef CHECK_MODE
#define CHECK_MODE 0
#endif
constexpr size_t WS_CHK = 18432;
constexpr size_t WS_CHKO = WS_Y + 160 * MB;
#if CHECK_MODE
__device__ __forceinline__ void phase_check(const Args& a, LAS unsigned char* lds) {
    const int tid = threadIdx.x, blk = blockIdx.x, G = gridDim.x, w = tid >> 6, lane = tid & 63;
    const bf16_t* proj = (const bf16_t*)(a.ws + WS_PROJ); const bf16_t* ocat = (const bf16_t*)(a.ws + WS_OCAT);
    float* chk = (float*)(a.ws + WS_CHK);
#if CHECK_MODE == 1
    const float* ct = (const float*)(a.ws + WS_ROPE); const float* st = ct + 4096 * 64;
    for (int task = blk * 8 + w; task < 67 * 16; task += G * 8) {
        const int s = task >> 4, bh = task & 15, b = bh >> 3, h = bh & 7, t = 61 * s + 7, qblk = t >> 8;
        const bf16_t* qrow = proj + (size_t)(b * SEQ + t) * NPROJ + C_QB + h * 128;
        const float c = ct[t * 64 + lane], sn = st[t * 64 + lane];
        const float q1 = bf2f(qrow[lane]), q2 = bf2f(qrow[lane + 64]);
        const float qa = q1 * c - q2 * sn, qb2 = q1 * sn + q2 * c;
        float gate[16];
#pragma unroll 1
        for (int n = 0; n < 16; ++n) { float g = -INFINITY;
            if (n < qblk) { float m1 = 0.f, m2 = 0.f;
                for (int kk = 0; kk < 256; ++kk) { const int tk = n * 256 + kk; const bf16_t* krow = proj + (size_t)(b * SEQ + tk) * NPROJ + C_KB + h * 128;
                    const float k1 = bf2f(krow[lane]), k2 = bf2f(krow[lane + 64]), ck = ct[tk * 64 + lane], sk = st[tk * 64 + lane];
                    m1 += k1 * ck - k2 * sk; m2 += k1 * sk + k2 * ck; }
                g = wave_sum(qa * (m1 * (1.0f / 256.0f)) + qb2 * (m2 * (1.0f / 256.0f))); }
#pragma unroll
            for (int z = 0; z < 16; ++z) if (z == n) gate[z] = g; }
        unsigned mask = 0u; const int nsel = qblk < 3 ? qblk : 3;
        for (int it = 0; it < nsel; ++it) { int best = -1; float bv = -INFINITY;
#pragma unroll
            for (int n = 0; n < 16; ++n) { const bool ok = (n < qblk) && !((mask >> n) & 1u) && (best < 0 || gate[n] > bv); if (ok) { bv = gate[n]; best = n; } }
            mask |= 1u << best; }
        { const unsigned fastsel = ((const unsigned*)(a.ws + WS_SEL))[(size_t)bh * SEQ + t];
          if (fastsel != mask) { if (lane == 0) atomicAdd(&chk[2], 1.0f); continue; } }
        mask |= 1u << qblk;
        float m = -INFINITY, l = 0.f, o1 = 0.f, o2 = 0.f;
        for (int n = 0; n <= qblk; ++n) { if (!((mask >> n) & 1u)) continue;
            for (int kk = 0; kk < 256; ++kk) { const int tk = n * 256 + kk; if (tk > t) break;
                const bf16_t* krow = proj + (size_t)(b * SEQ + tk) * NPROJ + C_KB + h * 128; const bf16_t* vrow = proj + (size_t)(b * SEQ + tk) * NPROJ + C_VB + h * 128;
                const float k1 = bf2f(krow[lane]), k2 = bf2f(krow[lane + 64]), ck = ct[tk * 64 + lane], sk = st[tk * 64 + lane];
                const float sc = wave_sum(qa * (k1 * ck - k2 * sk) + qb2 * (k1 * sk + k2 * ck)) * 0.08838834764831845f;
                const float mn = fmaxf(m, sc), al = expf(m - mn), p = expf(sc - mn);
                l = l * al + p; o1 = o1 * al + p * bf2f(vrow[lane]); o2 = o2 * al + p * bf2f(vrow[lane + 64]); m = mn; } }
        o1 /= l; o2 /= l;
        const bf16_t* frow = ocat + (size_t)(b * SEQ + t) * DM + 1024 + h * 128;
        const float f1 = bf2f(frow[lane]), f2 = bf2f(frow[lane + 64]);
        const float num = wave_sum((f1 - o1) * (f1 - o1) + (f2 - o2) * (f2 - o2)), den = wave_sum(o1 * o1 + o2 * o2);
        if (lane == 0) { atomicAdd(&chk[0], num); atomicAdd(&chk[1], den); }
    }
#else
    const int cb = 1, ch = 2; const float* gk = (const float*)(a.ws + WS_GK); float* oref = (float*)(a.ws + WS_CHKO);
    for (int e = blk * 8 + w; e < 256; e += G * 8) {
        float s1 = 0.f, s2 = 0.f;
        for (int t = 0; t < SEQ; ++t) { const size_t row = (size_t)(cb * SEQ + t);
            const bf16_t* pr = proj + row * NPROJ;
            const float a1 = expf(gk[row * 512 + ch * 128 + lane]), a2 = expf(gk[row * 512 + ch * 128 + lane + 64]);
            const float k1 = bf2f(pr[C_KA + ch * 128 + lane]), k2 = bf2f(pr[C_KA + ch * 128 + lane + 64]), v = bf2f(pr[C_VA + ch * 256 + e]);
            const float q1 = bf2f(pr[C_QA + ch * 128 + lane]) * 0.08838834764831845f, q2 = bf2f(pr[C_QA + ch * 128 + lane + 64]) * 0.08838834764831845f;
            s1 = a1 * s1 + k1 * v; s2 = a2 * s2 + k2 * v;
            const float o = wave_sum(q1 * s1 + q2 * s2);
            if (lane == 0) oref[(size_t)t * 256 + e] = o; }
    }
#endif
}
__device__ __forceinline__ void phase_check2(const Args& a, LAS unsigned char* lds) {
#if CHECK_MODE == 2
    const int tid = threadIdx.x, blk = blockIdx.x, G = gridDim.x, w = tid >> 6, lane = tid & 63;
    const int cb = 1, ch = 2; const float* oref = (const float*)(a.ws + WS_CHKO); float* chk = (float*)(a.ws + WS_CHK);
    const bf16_t* proj = (const bf16_t*)(a.ws + WS_PROJ); const bf16_t* ocat = (const bf16_t*)(a.ws + WS_OCAT);
    for (int t = blk * 8 + w; t < SEQ; t += G * 8) { float o[4], ss = 0.f;
#pragma unroll
        for (int q = 0; q < 4; ++q) { o[q] = oref[(size_t)t * 256 + lane + 64 * q]; ss += o[q] * o[q]; }
        ss = wave_sum(ss); const float rstd = 1.0f / sqrtf(ss * (1.0f / 256.0f) + EPS); float num = 0.f, den = 0.f;
#pragma unroll
        for (int q = 0; q < 4; ++q) { const int e = lane + 64 * q; const size_t row = (size_t)(cb * SEQ + t);
            const float ga = bf2f(proj[row * NPROJ + C_GA + ch * 256 + e]), ref = o[q] * rstd * a.gla_norm_w[e] * silu_f(ga), f = bf2f(ocat[row * DM + ch * 256 + e]);
            num += (f - ref) * (f - ref); den += ref * ref; }
        num = wave_sum(num); den = wave_sum(den);
        if (lane == 0) { atomicAdd(&chk[0], num); atomicAdd(&chk[1], den); } }
#endif
}
#endif

__device__ __forceinline__ void gla3_unit(const Args& a, LAS unsigned char* lds, int u) {
    const int tid = threadIdx.x, w = tid >> 6, lane = tid & 63, g = lane >> 4, fr = lane & 15;
    const int bh = u >> 6, c = u & 63, b = bh >> 2, h = bh & 3, row0 = b * SEQ + c * 64;
    LAS bf16_t* QP = (LAS bf16_t*)lds; LAS bf16_t* KP = (LAS bf16_t*)(lds + 17408); LAS bf16_t* VT = (LAS bf16_t*)(lds + 34816);
    LAS bf16_t* AM = (LAS bf16_t*)(lds + 71680); LAS float* RED = (LAS float*)(lds + 80896);
    const bf16_t* proj = (const bf16_t*)(a.ws + WS_PROJ); const float* bcum = (const float*)(a.ws + WS_BCUM); const bf16_t* ST = (const bf16_t*)(a.ws + WS_ST);
    bf16_t* ocat = (bf16_t*)(a.ws + WS_OCAT);
    {
        const int i = tid >> 3, seg = tid & 7;
        const f32x4* bp = (const f32x4*)(bcum + ((size_t)u * 64 + i) * 128 + seg * 16);
        const u32x4* qp = (const u32x4*)(proj + (size_t)(row0 + i) * NPROJ + C_QA + h * 128 + seg * 16);
        const u32x4* kp = (const u32x4*)(proj + (size_t)(row0 + i) * NPROJ + C_KA + h * 128 + seg * 16);
#pragma unroll
        for (int q = 0; q < 2; ++q) { const u32x4 qv = qp[q], kv = kp[q]; const f32x4 b0 = bp[2 * q], b1 = bp[2 * q + 1]; u32x4 qo, ko;
#pragma unroll
            for (int p = 0; p < 4; ++p) { const float bl = (p < 2) ? b0[2 * p] : b1[2 * p - 4], bhv = (p < 2) ? b0[2 * p + 1] : b1[2 * p - 3];
                const float el = expf(bl), eh = expf(bhv);
                qo[p] = cvt_pk_bf16(bflo(qv[p]) * el * 0.08838834764831845f, bfhi(qv[p]) * eh * 0.08838834764831845f);
                ko[p] = cvt_pk_bf16(bflo(kv[p]) / el, bfhi(kv[p]) / eh); }
            *(LAS u32x4*)(QP + i * 136 + seg * 16 + q * 8) = qo; *(LAS u32x4*)(KP + i * 136 + seg * 16 + q * 8) = ko; }
        gla_stage_vt(proj, row0, h, VT, tid);
    }
    __syncthreads();
    {
        const int it = w >> 1;
#pragma unroll
        for (int jj = 0; jj < 2; ++jj) { const int jt = (w & 1) * 2 + jj; f32x4 acc = {0.f, 0.f, 0.f, 0.f};
            if (jt <= it) {
#pragma unroll
                for (int ks = 0; ks < 4; ++ks) acc = mfma16(lds_frag(QP, 136, it * 16, ks * 32, lane), lds_frag(KP, 136, jt * 16, ks * 32, lane), acc);
            }
#pragma unroll
            for (int r = 0; r < 4; ++r) { const int i = it * 16 + 4 * g + r, j = jt * 16 + fr; AM[i * 72 + j] = f2bf((j <= i) ? acc[r] : 0.f); } }
    }
    __syncthreads();
    f32x4 acc[4][2];
    {
#pragma unroll
        for (int x = 0; x < 4; ++x)
#pragma unroll
            for (int y = 0; y < 2; ++y) acc[x][y] = (f32x4){0.f, 0.f, 0.f, 0.f};
        bf16x8 bS[2][4];
        const bf16_t* stp = ST + (size_t)u * 32768;
#pragma unroll
        for (int e2 = 0; e2 < 2; ++e2)
#pragma unroll
            for (int ks = 0; ks < 4; ++ks) bS[e2][ks] = *(const bf16x8*)(stp + ((2 * w + e2) * 16 + fr) * 128 + ks * 32 + 8 * g);
#pragma unroll
        for (int it = 0; it < 4; ++it) {
#pragma unroll
            for (int ks = 0; ks < 4; ++ks) { const bf16x8 aq = lds_frag(QP, 136, it * 16, ks * 32, lane); acc[it][0] = mfma16(aq, bS[0][ks], acc[it][0]); acc[it][1] = mfma16(aq, bS[1][ks], acc[it][1]); }
#pragma unroll
            for (int k2 = 0; k2 < 2; ++k2) { const bf16x8 aa = lds_frag(AM, 72, it * 16, k2 * 32, lane);
                acc[it][0] = mfma16(aa, lds_frag(VT, 72, (2 * w) * 16, k2 * 32, lane), acc[it][0]); acc[it][1] = mfma16(aa, lds_frag(VT, 72, (2 * w + 1) * 16, k2 * 32, lane), acc[it][1]); }
        }
#pragma unroll
        for (int it = 0; it < 4; ++it)
#pragma unroll
            for (int r = 0; r < 4; ++r) { float s = acc[it][0][r] * acc[it][0][r] + acc[it][1][r] * acc[it][1][r];
                s += __shfl_xor(s, 1); s += __shfl_xor(s, 2); s += __shfl_xor(s, 4); s += __shfl_xor(s, 8);
                if (fr == 0) RED[w * 64 + it * 16 + 4 * g + r] = s; }
    }
    __syncthreads();
    {
#pragma unroll
        for (int it = 0; it < 4; ++it)
#pragma unroll
            for (int r = 0; r < 4; ++r) { const int i = it * 16 + 4 * g + r; float tot = 0.f;
#pragma unroll
                for (int ww = 0; ww < 8; ++ww) tot += RED[ww * 64 + i];
                const float rstd = 1.0f / sqrtf(tot * (1.0f / 256.0f) + EPS);
#pragma unroll
                for (int e2 = 0; e2 < 2; ++e2) { const int e = (2 * w + e2) * 16 + fr;
                    const float ga = bf2f(proj[(size_t)(row0 + i) * NPROJ + C_GA + h * 256 + e]);
                    ocat[(size_t)(row0 + i) * DM + h * 256 + e] = f2bf(acc[it][e2][r] * rstd * a.gla_norm_w[e] * silu_f(ga)); } }
    }
    __syncthreads();
}

__device__ __forceinline__ void moba_attn_unit(const Args& a, LAS unsigned char* lds, int bh, int qb, int half) {
    const int tid = threadIdx.x, w = tid >> 6, lane = tid & 63, g = lane >> 4, fr = lane & 15;
    const int b = bh >> 3, h = bh & 7, rg = w & 3, par = w >> 2, qbase = 128 * half + 32 * rg;
    const bf16_t* qbr = (const bf16_t*)(a.ws + WS_QBR); const bf16_t* kbr = (const bf16_t*)(a.ws + WS_KBR); const bf16_t* vbt = (const bf16_t*)(a.ws + WS_VBT);
    const unsigned* sel = (const unsigned*)(a.ws + WS_SEL); bf16_t* ocat = (bf16_t*)(a.ws + WS_OCAT);
    const int nown = 2 * half + 2, nsteps = (nown + 4 * qb) >> 1;
    bf16x8 qf[2][4]; unsigned sm[2]; float m[2], l[2]; f32x4 O[8][2];
#pragma unroll
    for (int b2 = 0; b2 < 2; ++b2) { const size_t qrow = (size_t)bh * SEQ + qb * 256 + qbase + 16 * b2 + fr;
#pragma unroll
        for (int ks = 0; ks < 4; ++ks) qf[b2][ks] = *(const bf16x8*)(qbr + qrow * 128 + ks * 32 + 8 * g);
        sm[b2] = sel[qrow]; m[b2] = -INFINITY; l[b2] = 0.f;
#pragma unroll
        for (int dt = 0; dt < 8; ++dt) O[dt][b2] = (f32x4){0.f, 0.f, 0.f, 0.f}; }
    const float cs = 0.08838834764831845f * 1.4426950408889634f;
    u32x4 pk[2][2], pv[2][2];
    auto tile_jk = [&](int ti, int& j, int& kt) { if (ti < nown) { j = qb; kt = ti; } else { const int tj = ti - nown; j = tj >> 2; kt = tj & 3; } };
    auto prefetch = [&](int s) {
#pragma unroll
        for (int t2 = 0; t2 < 2; ++t2) { int j, kt; tile_jk(2 * s + t2, j, kt);
#pragma unroll
            for (int p = 0; p < 2; ++p) { const int cidx = tid + 512 * p;
                { const int row = cidx >> 4, cc = cidx & 15; pk[t2][p] = *(const u32x4*)(kbr + ((size_t)bh * SEQ + j * 256 + kt * 64 + row) * 128 + cc * 8); }
                { const int d = cidx >> 3, cc = cidx & 7; pv[t2][p] = *(const u32x4*)(vbt + ((size_t)bh * 128 + d) * SEQ + j * 256 + kt * 64 + cc * 8); } } } };
    prefetch(0);
#pragma unroll 1
    for (int s = 0; s < nsteps; ++s) {
        __syncthreads();
#pragma unroll
        for (int t2 = 0; t2 < 2; ++t2) { LAS bf16_t* Kst = (LAS bf16_t*)(lds + t2 * 35840); LAS bf16_t* Vst = (LAS bf16_t*)(lds + t2 * 35840 + 17408);
#pragma unroll
            for (int p = 0; p < 2; ++p) { const int cidx = tid + 512 * p;
                { const int row = cidx >> 4, cc = cidx & 15; *(LAS u32x4*)(Kst + row * 136 + cc * 8) = pk[t2][p]; }
                { const int d = cidx >> 3, cc = cidx & 7; *(LAS u32x4*)(Vst + d * 72 + cc * 8) = pv[t2][p]; } } }
        if (s + 1 < nsteps) prefetch(s + 1);
        __syncthreads();
        int j, kt; tile_jk(2 * s + par, j, kt);
        const bool own = (2 * s + par) < nown;
        if (own && kt * 64 > qbase + 31) continue;
        const LAS bf16_t* Ks = (const LAS bf16_t*)(lds + par * 35840); const LAS bf16_t* Vs = (const LAS bf16_t*)(lds + par * 35840 + 17408);
        f32x4 sc[4][2];
#pragma unroll
        for (int t4 = 0; t4 < 4; ++t4) { sc[t4][0] = (f32x4){0.f, 0.f, 0.f, 0.f}; sc[t4][1] = (f32x4){0.f, 0.f, 0.f, 0.f};
#pragma unroll
            for (int ks = 0; ks < 4; ++ks) { const bf16x8 kf = lds_frag(Ks, 136, t4 * 16, ks * 32, lane); sc[t4][0] = mfma16(kf, qf[0][ks], sc[t4][0]); sc[t4][1] = mfma16(kf, qf[1][ks], sc[t4][1]); } }
        bf16x8 pf[2][2];
#pragma unroll
        for (int b2 = 0; b2 < 2; ++b2) {
            const int qi = qbase + 16 * b2 + fr; const bool allow_past = ((sm[b2] >> j) & 1u) != 0u;
            float tm = -INFINITY;
#pragma unroll
            for (int t4 = 0; t4 < 4; ++t4)
#pragma unroll
                for (int r = 0; r < 4; ++r) { const int kk = kt * 64 + t4 * 16 + 4 * g + r; const bool ok = own ? (kk <= qi) : allow_past;
                    const float v = ok ? sc[t4][b2][r] : -INFINITY; sc[t4][b2][r] = v; tm = fmaxf(tm, v); }
            tm = fmaxf(tm, __shfl_xor(tm, 16)); tm = fmaxf(tm, __shfl_xor(tm, 32));
            const float mnew = fmaxf(m[b2], tm), msafe = (mnew == -INFINITY) ? 0.f : mnew;
            const float alpha = exp2f((m[b2] - msafe) * cs);
            float ps = 0.f;
#pragma unroll
            for (int t4 = 0; t4 < 4; ++t4)
#pragma unroll
                for (int r = 0; r < 4; ++r) { const float pe = exp2f((sc[t4][b2][r] - msafe) * cs); sc[t4][b2][r] = pe; ps += pe; }
            ps += __shfl_xor(ps, 16); ps += __shfl_xor(ps, 32);
            l[b2] = l[b2] * alpha + ps; m[b2] = mnew;
#pragma unroll
            for (int dt = 0; dt < 8; ++dt) O[dt][b2] *= alpha;
#pragma unroll
            for (int k2 = 0; k2 < 2; ++k2) { u32x4 pkk; pkk.x = cvt_pk_bf16(sc[2 * k2][b2][0], sc[2 * k2][b2][1]); pkk.y = cvt_pk_bf16(sc[2 * k2][b2][2], sc[2 * k2][b2][3]);
                pkk.z = cvt_pk_bf16(sc[2 * k2 + 1][b2][0], sc[2 * k2 + 1][b2][1]); pkk.w = cvt_pk_bf16(sc[2 * k2 + 1][b2][2], sc[2 * k2 + 1][b2][3]);
                pf[k2][b2] = __builtin_bit_cast(bf16x8, pkk); }
        }
#pragma unroll
        for (int dt = 0; dt < 8; ++dt)
#pragma unroll
            for (int k2 = 0; k2 < 2; ++k2) { const LAS bf16_t* vp = Vs + (dt * 16 + fr) * 72 + 32 * k2 + 4 * g;
                const u32x2 lo = *(const LAS u32x2*)vp, hi = *(const LAS u32x2*)(vp + 16);
                u32x4 vv; vv.x = lo.x; vv.y = lo.y; vv.z = hi.x; vv.w = hi.y; const bf16x8 vf = __builtin_bit_cast(bf16x8, vv);
                O[dt][0] = mfma16(vf, pf[k2][0], O[dt][0]); O[dt][1] = mfma16(vf, pf[k2][1], O[dt][1]); }
    }
    __syncthreads();
    LAS float* X = (LAS float*)lds + rg * (68 * 64) + lane;
    if (par == 1) {
#pragma unroll
        for (int b2 = 0; b2 < 2; ++b2) { X[(64 + b2) * 64] = m[b2]; X[(66 + b2) * 64] = l[b2];
#pragma unroll
            for (int dt = 0; dt < 8; ++dt)
#pragma unroll
                for (int r = 0; r < 4; ++r) X[((dt * 2 + b2) * 4 + r) * 64] = O[dt][b2][r]; } }
    __syncthreads();
    if (par == 0) {
#pragma unroll
        for (int b2 = 0; b2 < 2; ++b2) { const float m1 = X[(64 + b2) * 64], l1 = X[(66 + b2) * 64];
            const float mm = fmaxf(m[b2], m1), a0 = exp2f((m[b2] - mm) * cs), a1 = (m1 == -INFINITY) ? 0.f : exp2f((m1 - mm) * cs);
            const float inv = 1.0f / (l[b2] * a0 + l1 * a1);
            const size_t orow = (size_t)(b * SEQ + qb * 256 + qbase + 16 * b2 + fr) * DM + 1024 + h * 128;
#pragma unroll
            for (int dt = 0; dt < 8; ++dt) { float o4[4];
#pragma unroll
                for (int r = 0; r < 4; ++r) o4[r] = (O[dt][b2][r] * a0 + X[((dt * 2 + b2) * 4 + r) * 64] * a1) * inv;
                u32x2 o; o.x = cvt_pk_bf16(o4[0], o4[1]); o.y = cvt_pk_bf16(o4[2], o4[3]);
                *(u32x2*)(ocat + orow + dt * 16 + 4 * g) = o; } } }
    __syncthreads();
}
__device__ __forceinline__ void phase_mix_out(const Args& a, LAS unsigned char* lds) {
    const int blk = blockIdx.x, G = gridDim.x;
    for (int u = blk; u < 256; u += G) {
        { const int c = u >> 4; moba_attn_unit(a, lds, u & 15, (31 - c) >> 1, (31 - c) & 1); }
        { const int u2 = 511 - u, c = u2 >> 4; moba_attn_unit(a, lds, u2 & 15, (31 - c) >> 1, (31 - c) & 1); }
    }
    for (int u = blk; u < 512; u += G) gla3_unit(a, lds, u);
}

__device__ __forceinline__ void phase_router(const Args& a, LAS unsigned char* lds) {
    const int tid = threadIdx.x, blk = blockIdx.x, G = gridDim.x, w = tid >> 6, lane = tid & 63;
    LAS float* h2s = (LAS float*)lds;
    LAS float* logit = (LAS float*)(lds + LDS_EXTRA);
    LAS int* pe = (LAS int*)(lds + LDS_EXTRA + 2048); LAS float* pw = (LAS float*)(lds + LDS_EXTRA + 2304); LAS int* lpos = (LAS int*)(lds + LDS_EXTRA + 2560);
    LAS int* hist = (LAS int*)(lds + LDS_EXTRA + 2816); LAS int* base = (LAS int*)(lds + LDS_EXTRA + 2944);
    const float* mod = (const float*)(a.ws + WS_MOD); const float* x1 = (const float*)(a.ws + WS_X1); unsigned char* h2 = (unsigned char*)(a.ws + WS_H1);
    unsigned* cnt = (unsigned*)(a.ws + WS_CNT); int* pair_e = (int*)(a.ws + WS_PAIR_E); int* pair_pos = (int*)(a.ws + WS_PAIR_POS); float* pair_w = (float*)(a.ws + WS_PAIR_W);
    for (int grp = blk; grp < 512; grp += G) {
#pragma unroll 1
        for (int tt = 0; tt < 2; ++tt) { const int tl = 2 * w + tt, t = grp * 16 + tl;
            const f32x4* xr = (const f32x4*)(x1 + (size_t)t * DM) + lane;
            f32x4 v[8]; float ss = 0.f;
#pragma unroll
            for (int q = 0; q < 8; ++q) { v[q] = xr[64 * q]; ss += (v[q][0] * v[q][0] + v[q][1] * v[q][1]) + (v[q][2] * v[q][2] + v[q][3] * v[q][3]); }
            ss = wave_sum(ss);
            const float rstd = 1.0f / sqrtf(ss * (1.0f / DM) + EPS);
            const float* sh = mod + (size_t)(t >> 12) * 12288 + 6144; const float* sc = sh + 2048;
#pragma unroll
            for (int q = 0; q < 8; ++q) { const int k = 4 * (lane + 64 * q);
                const f32x4 nw = *(const f32x4*)(a.norm2_w + k), scv = *(const f32x4*)(sc + k), shv = *(const f32x4*)(sh + k);
                const f32x4 hv = (v[q] * rstd * nw) * (scv + 1.0f) + shv;
                *(LAS f32x4*)(h2s + tl * 2048 + k) = hv;
                *(unsigned*)(h2 + (size_t)t * DM + k) = pg8::pk4_fp8(hv[0], hv[1], hv[2], hv[3]); } }
        if (tid < 32) hist[tid] = 0;
        __syncthreads();
        {
            const int e = tid & 31, kq = tid >> 5, k0 = kq * 128; float acc[16];
#pragma unroll
            for (int t = 0; t < 16; ++t) acc[t] = 0.f;
            const float* wp = a.w_router + (size_t)k0 * 32 + e;
#pragma unroll 4
            for (int kk = 0; kk < 128; kk += 4) {
                const float w0 = wp[(size_t)kk * 32], w1 = wp[(size_t)(kk + 1) * 32], w2 = wp[(size_t)(kk + 2) * 32], w3 = wp[(size_t)(kk + 3) * 32];
#pragma unroll
                for (int t = 0; t < 16; ++t) { const f32x4 hv = *(const LAS f32x4*)(h2s + t * 2048 + k0 + kk); acc[t] += (hv[0] * w0 + hv[1] * w1) + (hv[2] * w2 + hv[3] * w3); } }
            __syncthreads();
#pragma unroll
            for (int t = 0; t < 16; ++t) h2s[(kq * 16 + t) * 32 + e] = acc[t];
            __syncthreads();
            { const int tl = tid >> 5; float s = a.b_router[e];
#pragma unroll
                for (int q = 0; q < 16; ++q) s += h2s[(q * 16 + tl) * 32 + e];
                logit[tl * 32 + e] = s; }
        }
        __syncthreads();
        if (tid < 16) { unsigned chosen = 0u; float tv[4]; int te[4];
#pragma unroll
            for (int s = 0; s < 4; ++s) { int best = -1; float bv = -INFINITY;
                for (int e = 0; e < 32; ++e) { const float v = logit[tid * 32 + e]; if (!((chosen >> e) & 1u) && (best < 0 || v > bv)) { bv = v; best = e; } }
                chosen |= 1u << best; tv[s] = bv; te[s] = best; }
            float ex[4], den = 0.f;
#pragma unroll
            for (int s = 0; s < 4; ++s) { ex[s] = expf(tv[s] - tv[0]); den += ex[s]; }
#pragma unroll
            for (int s = 0; s < 4; ++s) { pe[tid * 4 + s] = te[s]; pw[tid * 4 + s] = ex[s] / den; } }
        __syncthreads();
        if (tid < 64) lpos[tid] = atomicAdd((int*)&hist[pe[tid]], 1);
        __syncthreads();
        if (tid < 32) { const int n = hist[tid]; base[tid] = n ? (int)atomicAdd(&cnt[tid], (unsigned)n) : 0; }
        __syncthreads();
        if (tid < 64) { const int p = grp * 64 + tid, e = pe[tid]; pair_e[p] = e; pair_pos[p] = base[e] + lpos[tid]; pair_w[p] = pw[tid]; }
        __syncthreads();
    }
}
__device__ __forceinline__ void phase_gather(const Args& a, LAS unsigned char* lds) {
    const int tid = threadIdx.x, blk = blockIdx.x, G = gridDim.x, w = tid >> 6, lane = tid & 63;
    LAS int* pstart = (LAS int*)(lds + LDS_EXTRA);
    const unsigned* cnt = (const unsigned*)(a.ws + WS_CNT);
    if (tid == 0) { int run = 0; for (int e = 0; e < 32; ++e) { pstart[e] = run; run += (int)((cnt[e] + 255u) & ~255u); } }
    __syncthreads();
    const int* pair_e = (const int*)(a.ws + WS_PAIR_E); const int* pair_pos = (const int*)(a.ws + WS_PAIR_POS); const float* pair_w = (const float*)(a.ws + WS_PAIR_W);
    int* slotrow = (int*)(a.ws + WS_SLOTROW); float* wbuf = (float*)(a.ws + WS_WBUF); const unsigned char* h2 = (const unsigned char*)(a.ws + WS_H1); unsigned char* xg = (unsigned char*)(a.ws + WS_XG);
    for (int p = blk * 8 + w; p < NTOK * TOPK; p += G * 8) {
        const int row = pstart[pair_e[p]] + pair_pos[p];
        const u32x4* sp = (const u32x4*)(h2 + (size_t)(p >> 2) * DM) + lane; u32x4* dp = (u32x4*)(xg + (size_t)row * DM) + lane;
#pragma unroll
        for (int q = 0; q < 2; ++q) dp[64 * q] = sp[64 * q];
        if (lane == 0) { wbuf[row] = pair_w[p]; slotrow[p] = row; }
    }
    __syncthreads();
    conv_all(a, lds);
#if PROBE_DOUBLE == 88
    conv_all(a, lds);
#endif
}
__device__ __forceinline__ void moe_build_tab(const Args& a, LAS unsigned char* lds, int ntn) {
    LAS int* tab = (LAS int*)(lds + LDS_EXTRA);
    const unsigned* cnt = (const unsigned*)(a.ws + WS_CNT);
    __syncthreads();
    if (threadIdx.x == 0) {
        const int mygrp = blockIdx.x & 7, PG = ntn >> 1;
        int rs = 0, np = 0, us = 0; unsigned done = 0u;
        LAS int* rt0 = tab + 600;
        LAS int* load = tab + 640;
        for (int x = 0; x < 8; ++x) load[x] = 0;
        for (int e = 0; e < 32; ++e) { rt0[e] = rs; rs += (int)((cnt[e] + 255u) >> 8); }
        for (int it = 0; it < 32; ++it) {
            int be = -1, bc = -1;
            for (int e = 0; e < 32; ++e) { if ((done >> e) & 1u) continue; const int c = (int)cnt[e], cost = 2 * (c >> 8) + ((c & 255) > 128 ? 2 : ((c & 255) ? 1 : 0)); if (cost > bc) { bc = cost; be = e; } }
            done |= 1u << be;
            const int c = (int)cnt[be], mte = (c + 255) >> 8;
            if (mte == 0) continue;
            for (int h = 0; h < 2; ++h) {
                int bx = 0;
                for (int x = 1; x < 8; ++x) if (load[x] < load[bx]) bx = x;
                load[bx] += bc * PG;
                if (bx == mygrp) { LAS int* t = tab + 4 + 8 * np; t[0] = us; t[1] = be; t[2] = h * PG; t[3] = mte; t[4] = rt0[be]; t[5] = c; us += mte * PG; ++np; }
            }
        }
        tab[0] = np; tab[1] = us;
    }
    __syncthreads();
}
__device__ __forceinline__ void phase_final(const Args& a, LAS unsigned char* lds) {
    const int tid = threadIdx.x, blk = blockIdx.x, G = gridDim.x, w = tid >> 6, lane = tid & 63;
    const float* mod = (const float*)(a.ws + WS_MOD); const float* x1 = (const float*)(a.ws + WS_X1); const int* slotrow = (const int*)(a.ws + WS_SLOTROW); const bf16_t* y = (const bf16_t*)(a.ws + WS_Y);
    float chk_scale = 1.0f;
#if CHECK_MODE
    { const float* chk = (const float*)(a.ws + WS_CHK); const float rel = sqrtf(chk[0] / fmaxf(chk[1], 1e-30f)) + (chk[2] > 60.0f ? 1.0f : 0.0f); chk_scale = 1.0f + 10.0f * rel; }
#endif
    for (int t = blk * 8 + w; t < NTOK; t += G * 8) {
        const int r0 = slotrow[t * 4], r1 = slotrow[t * 4 + 1], r2 = slotrow[t * 4 + 2], r3 = slotrow[t * 4 + 3];
        const f32x4* xr = (const f32x4*)(x1 + (size_t)t * DM) + lane;
        const u32x2* y0 = (const u32x2*)(y + (size_t)r0 * DM) + lane; const u32x2* y1 = (const u32x2*)(y + (size_t)r1 * DM) + lane;
        const u32x2* y2 = (const u32x2*)(y + (size_t)r2 * DM) + lane; const u32x2* y3 = (const u32x2*)(y + (size_t)r3 * DM) + lane;
        const float* g2 = mod + (size_t)(t >> 12) * 12288 + 10240;
        f32x4 v[8]; float ss = 0.f;
#pragma unroll
        for (int q = 0; q < 8; ++q) { const u32x2 a0 = y0[64 * q], a1 = y1[64 * q], a2 = y2[64 * q], a3 = y3[64 * q];
            f32x4 s; s[0] = (bflo(a0.x) + bflo(a1.x)) + (bflo(a2.x) + bflo(a3.x)); s[1] = (bfhi(a0.x) + bfhi(a1.x)) + (bfhi(a2.x) + bfhi(a3.x));
            s[2] = (bflo(a0.y) + bflo(a1.y)) + (bflo(a2.y) + bflo(a3.y)); s[3] = (bfhi(a0.y) + bfhi(a1.y)) + (bfhi(a2.y) + bfhi(a3.y));
            const f32x4 gv = *(const f32x4*)(g2 + 4 * (lane + 64 * q));
            v[q] = xr[64 * q] + gv * s; ss += (v[q][0] * v[q][0] + v[q][1] * v[q][1]) + (v[q][2] * v[q][2] + v[q][3] * v[q][3]); }
        ss = wave_sum(ss);
        const float rstd = 1.0f / sqrtf(ss * (1.0f / DM) + EPS);
        f32x4* op = (f32x4*)(a.out + (size_t)t * DM) + lane;
#pragma unroll
        for (int q = 0; q < 8; ++q) op[64 * q] = v[q] * (rstd * chk_scale) * *(const f32x4*)(a.final_norm_w + 4 * (lane + 64 * q));
    }
}

constexpr int NPHASE = 12;
#ifndef ONLY_PHASE
#define ONLY_PHASE -1
#endif
#define PH_ON(P) (ONLY_PHASE < 0 || ONLY_PHASE == (P))
#ifndef PROBE_DOUBLE
#define PROBE_DOUBLE -1
#endif
#define PROBE_REP(P) for (int _rep = 0; _rep < ((PROBE_DOUBLE == (P)) ? 2 : 1); ++_rep)
__global__ void __launch_bounds__(512, 2) fwd(Args a) {
    extern __shared__ __attribute__((aligned(16))) unsigned char shm[];
    LAS unsigned char* lds = (LAS unsigned char*)shm;
    if (threadIdx.x == 0) *(LAS u32x4*)(lds + LDS_XB) = (u32x4){0u, 0u, 0u, 0u};
    __syncthreads();
    XcdBarrier bar = xcd_barrier_post((unsigned*)(a.ws + WS_BAR), (volatile LAS unsigned*)(lds + LDS_XB));
    const int G = gridDim.x, blk = blockIdx.x;
#ifndef HARVEST_MASK
#define HARVEST_MASK 0xfff
#endif
#define PHASE_END(P) do { if ((P) + 1 < a.ph_hi) { if ((HARVEST_MASK >> (P)) & 1) xcd_barrier(bar, [&]() { return conv_claim(a, 1); }); else xcd_barrier(bar, []() { return false; }); } } while (0)
    if (PH_ON(0) && a.ph_lo <= 0 && 0 < a.ph_hi) { PROBE_REP(0) { phase_prologue(a, lds); __syncthreads(); } PHASE_END(0); }
    if (PH_ON(1) && a.ph_lo <= 1 && 1 < a.ph_hi) { phase_norm1(a, lds);
#if PROBE_DOUBLE == 134
        __syncthreads(); phase_norm1(a, lds);
#endif
        PHASE_END(1); }
    if (PH_ON(2) && a.ph_lo <= 2 && 2 < a.ph_hi) {
        pg8::Gemm g{(const bf16_t*)(a.ws + WS_H1), (const bf16_t*)(a.ws + WS_WIN_T), DM, 0};
        pg8::StaticOrder S; S.init(NTOK, NPROJ, G, blk);
        pg8::EpiProj E{(bf16_t*)(a.ws + WS_PROJ), NPROJ};
        pg8::gemm_phase<false>(lds, g, S, E);
#if PROBE_DOUBLE == 26
        __syncthreads(); pg8::gemm_phase<false>(lds, g, S, E);
#endif
        PHASE_END(2); }
    if (PH_ON(3) && a.ph_lo <= 3 && 3 < a.ph_hi) { phase_mix_prep(a, lds);
#if PROBE_DOUBLE == 134
        __syncthreads(); phase_mix_prep(a, lds);
#endif
        PHASE_END(3); }
    if (PH_ON(4) && a.ph_lo <= 4 && 4 < a.ph_hi) { phase_scan_select(a, lds);
#if PROBE_DOUBLE == 134
        __syncthreads(); phase_scan_select(a, lds);
#endif
        PHASE_END(4); }
    if (PH_ON(5) && a.ph_lo <= 5 && 5 < a.ph_hi) { phase_mix_out(a, lds);
#if PROBE_DOUBLE == 5
        __syncthreads(); phase_mix_out(a, lds);
#endif
        PHASE_END(5); }
#if CHECK_MODE
    if (a.ph_lo <= 5 && 5 < a.ph_hi) { phase_check(a, lds); xcd_barrier(bar, []() { return false; }); phase_check2(a, lds); xcd_barrier(bar, []() { return false; }); }
#endif
    if (PH_ON(6) && a.ph_lo <= 6 && 6 < a.ph_hi) {
        pg8::Gemm g{(const bf16_t*)(a.ws + WS_OCAT), (const bf16_t*)(a.ws + WS_WOUT_T), DM, 0};
        pg8::StaticOrder S; S.init(NTOK, DM, G, blk);
        pg8::EpiOut E{a.x, (const float*)(a.ws + WS_MOD) + 4096, (float*)(a.ws + WS_X1)};
        pg8::gemm_phase<false>(lds, g, S, E);
#if PROBE_DOUBLE == 26
        __syncthreads(); pg8::gemm_phase<false>(lds, g, S, E);
#endif
        PHASE_END(6); }
    if (PH_ON(7) && a.ph_lo <= 7 && 7 < a.ph_hi) { phase_router(a, lds); PHASE_END(7); }
    if (PH_ON(8) && a.ph_lo <= 8 && 8 < a.ph_hi) { phase_gather(a, lds);
#if PROBE_DOUBLE == 811
        __syncthreads(); phase_gather(a, lds);
#endif
        PHASE_END(8); }
    if (PH_ON(9) && a.ph_lo <= 9 && 9 < a.ph_hi) {
        moe_build_tab(a, lds, 16);
        pg8::Gemm g{(const bf16_t*)(a.ws + WS_XG), (const bf16_t*)(a.ws + WS_WGU_T), DM / 2, (size_t)4096 * 1024};
        pg8::MoeOrder S{(const LAS int*)(lds + LDS_EXTRA), blk >> 3, G >> 3};
        pg8::EpiGU8 E{a.b_gate_up, (unsigned char*)(a.ws + WS_ACT)};
        pg8::gemm_phase<true>(lds, g, S, E);
#if PROBE_DOUBLE == 9
        __syncthreads(); pg8::gemm_phase<true>(lds, g, S, E);
#endif
        PHASE_END(9); }
    if (PH_ON(10) && a.ph_lo <= 10 && 10 < a.ph_hi) {
        moe_build_tab(a, lds, 8);
        pg8::Gemm g{(const bf16_t*)(a.ws + WS_ACT), (const bf16_t*)(a.ws + WS_WD_T), DM / 2, (size_t)2048 * 1024};
        pg8::MoeOrder S{(const LAS int*)(lds + LDS_EXTRA), blk >> 3, G >> 3};
        pg8::EpiDown8 E{a.b_down, (const float*)(a.ws + WS_WBUF), (bf16_t*)(a.ws + WS_Y)};
        pg8::gemm_phase<true>(lds, g, S, E);
        PHASE_END(10); }
    if (PH_ON(11) && a.ph_lo <= 11 && 11 < a.ph_hi) { phase_final(a, lds);
#if PROBE_DOUBLE == 811
        __syncthreads(); phase_final(a, lds);
#endif
    }
}

#ifndef N_LAUNCHES
#define N_LAUNCHES 1
#endif
extern "C" void kernel_launch(void* const* d_in, const int* in_sizes, int n_in, void* d_out, int out_size, void* d_ws, size_t ws_size, hipStream_t stream) {
    static int grid = 0;
    if (grid == 0) {
        if (n_in != 18 || out_size != NTOK * DM || ws_size < WS_END) { fprintf(stderr, "kernel_launch: unexpected shapes (n_in %d out %d ws %zu, need %zu)\n", n_in, out_size, ws_size, (size_t)WS_END); grid = -1; return; }
        int dev = 0, cus = 0, per_cu = 0;
        if (hipGetDevice(&dev) != hipSuccess || hipDeviceGetAttribute(&cus, hipDeviceAttributeMultiprocessorCount, dev) != hipSuccess) { grid = -1; return; }
        if (hipFuncSetAttribute((const void*)fwd, hipFuncAttributeMaxDynamicSharedMemorySize, LDS_BYTES) != hipSuccess) { fprintf(stderr, "kernel_launch: hipFuncSetAttribute failed\n"); grid = -1; return; }
        if (hipOccupancyMaxActiveBlocksPerMultiprocessor(&per_cu, (const void*)fwd, 512, LDS_BYTES) != hipSuccess || per_cu < 1) fprintf(stderr, "kernel_launch: occupancy query says %d\n", per_cu);
        (void)hipGetLastError();
        grid = cus;
    }
    if (grid < 0) return;
    (void)hipMemsetAsync(d_ws, 0, WS_ZERO_BYTES, stream);
    Args a{};
    a.x = (const float*)d_in[0]; a.c = (const float*)d_in[1]; a.w_ada = (const float*)d_in[2]; a.b_ada = (const float*)d_in[3]; a.norm1_w = (const float*)d_in[4];
    a.w_in = (const float*)d_in[5]; a.w_alpha2 = (const float*)d_in[6]; a.b_alpha = (const float*)d_in[7]; a.gla_norm_w = (const float*)d_in[8]; a.w_out = (const float*)d_in[9];
    a.norm2_w = (const float*)d_in[10]; a.w_router = (const float*)d_in[11]; a.b_router = (const float*)d_in[12]; a.w_gate_up = (const float*)d_in[13]; a.b_gate_up = (const float*)d_in[14];
    a.w_down = (const float*)d_in[15]; a.b_down = (const float*)d_in[16]; a.final_norm_w = (const float*)d_in[17];
    a.out = (float*)d_out; a.ws = (unsigned char*)d_ws;
    if (N_LAUNCHES == 1) { a.ph_lo = 0; a.ph_hi = NPHASE; hipLaunchKernelGGL(fwd, dim3(grid), dim3(512), LDS_BYTES, stream, a); }
    else for (int p = 0; p < NPHASE; ++p) { a.ph_lo = p; a.ph_hi = p + 1; hipLaunchKernelGGL(fwd, dim3(grid), dim3(512), LDS_BYTES, stream, a); }
}
```

```cpp
#include <hip/hip_runtime.h>
#include <stdint.h>
#include <stdio.h>

#define LAS __attribute__((address_space(3)))
typedef unsigned short bf16_t;
typedef short bf16x8 __attribute__((ext_vector_type(8)));
typedef float f32x4 __attribute__((ext_vector_type(4)));
typedef float f32x2 __attribute__((ext_vector_type(2)));
typedef unsigned u32x4 __attribute__((ext_vector_type(4)));
typedef unsigned u32x2 __attribute__((ext_vector_type(2)));

constexpr int DM = 2048, NBATCH = 2, SEQ = 4096, NTOK = 8192;
constexpr int DIN = 6160, NPROJ = 6144;
constexpr int NE = 32, TOPK = 4;
constexpr int C_QA = 0, C_KA = 512, C_VA = 1024, C_GA = 2048, C_QB = 3072, C_KB = 4096, C_VB = 5120;
constexpr int MAXROWS = 40960;
constexpr float EPS = 1e-6f;

constexpr size_t MB = 1024ull * 1024ull;
constexpr size_t WS_BAR = 0;
constexpr size_t WS_CNT = 16384;
constexpr size_t WS_ZERO_BYTES = 20480;
constexpr size_t WS_MOD = 32768;
constexpr size_t WS_ROPE = 1 * MB;
constexpr size_t WS_H1 = 3 * MB;
constexpr size_t WS_GK = WS_H1 + 32 * MB;
constexpr size_t WS_PROJ = WS_GK + 16 * MB;
constexpr size_t WS_WIN_T = WS_PROJ + 96 * MB;
constexpr size_t WS_WOUT_T = WS_WIN_T + 24 * MB;
constexpr size_t WS_WGU_T = WS_WOUT_T + 8 * MB;
constexpr size_t WS_WD_T = WS_WGU_T + 512 * MB;
constexpr size_t WS_BCUM = WS_WD_T + 256 * MB;
constexpr size_t WS_DST = WS_BCUM + 16 * MB;
constexpr size_t WS_DEC = WS_DST + 64 * MB;
constexpr size_t WS_ST = WS_DEC + 1 * MB;
constexpr size_t WS_QBR = WS_ST + 32 * MB;
constexpr size_t WS_KBR = WS_QBR + 16 * MB;
constexpr size_t WS_VBT = WS_KBR + 16 * MB;
constexpr size_t WS_KMEAN = WS_VBT + 16 * MB;
constexpr size_t WS_SEL = WS_KMEAN + 1 * MB;
constexpr size_t WS_OCAT = WS_SEL + 1 * MB;
constexpr size_t WS_X1 = WS_OCAT + 32 * MB;
constexpr size_t WS_PAIR_E = WS_X1 + 64 * MB;
constexpr size_t WS_PAIR_POS = WS_PAIR_E + 1 * MB;
constexpr size_t WS_PAIR_W = WS_PAIR_POS + 1 * MB;
constexpr size_t WS_SLOTROW = WS_PAIR_W + 1 * MB;
constexpr size_t WS_WBUF = WS_SLOTROW + 1 * MB;
constexpr size_t WS_XG = WS_WBUF + 1 * MB;
constexpr size_t WS_ACT = WS_XG + 160 * MB;
constexpr size_t WS_Y = WS_ACT + 160 * MB;
constexpr size_t WS_END = WS_Y + 160 * MB;

constexpr int LDS_BYTES = 163840;
constexpr int LDS_XB = 163840 - 16;
constexpr int LDS_EXTRA = 131072 + 1024;
constexpr int LDS_ROWTAB = 131072 + 1024 + 4096;
constexpr int MAX_UNITS_WG = 24;

struct Args {
    const float* x; const float* c; const float* w_ada; const float* b_ada; const float* norm1_w; const float* w_in; const float* w_alpha2; const float* b_alpha;
    const float* gla_norm_w; const float* w_out; const float* norm2_w; const float* w_router; const float* b_router; const float* w_gate_up; const float* b_gate_up;
    const float* w_down; const float* b_down; const float* final_norm_w;
    float* out; unsigned char* ws;
    int ph_lo, ph_hi;
};

__device__ __forceinline__ unsigned cvt_pk_bf16(float lo, float hi) { unsigned r; asm("v_cvt_pk_bf16_f32 %0, %1, %2" : "=v"(r) : "v"(lo), "v"(hi)); return r; }
__device__ __forceinline__ bf16_t f2bf(float f) { return (bf16_t)(cvt_pk_bf16(f, 0.f) & 0xffffu); }
__device__ __forceinline__ float bf2f(bf16_t b) { return __uint_as_float(((unsigned)b) << 16); }
__device__ __forceinline__ float bflo(unsigned w) { return __uint_as_float(w << 16); }
__device__ __forceinline__ float bfhi(unsigned w) { return __uint_as_float(w & 0xffff0000u); }
__device__ __forceinline__ float wave_sum(float v) {
#pragma unroll
    for (int o = 1; o < 64; o <<= 1) v += __shfl_xor(v, o);
    return v;
}
#ifndef FP8_EMU
#define FP8_EMU 0
#endif
__device__ __forceinline__ float q8(float x) { return __builtin_amdgcn_cvt_f32_fp8(__builtin_amdgcn_cvt_pk_fp8_f32(x, x, 0, false), 0); }
__device__ __forceinline__ float silu_f(float v) { return v / (1.f + expf(-v)); }
__device__ __forceinline__ f32x4 mfma16(bf16x8 a, bf16x8 b, f32x4 c) { return __builtin_amdgcn_mfma_f32_16x16x32_bf16(a, b, c, 0, 0, 0); }
__device__ __forceinline__ bf16x8 lds_frag(const LAS bf16_t* img, int ld, int r0, int k0, int lane) {
    return *(const LAS bf16x8*)(img + (r0 + (lane & 15)) * ld + k0 + 8 * (lane >> 4));
}

#define XB_TMO      128
#define XB_XCNT(j)  (256  + 64 * (j))
#define XB_XSUB(j)  (1280 + 64 * (j))
#define XB_XGEN(j)  (2304 + 64 * (j))
#define XB_TOP      3328
#define XB_TOPGEN   3392
#define XCD_BAR_WORDS 3456
#define XB_SPIN_CAP (1u << 18)
__device__ __forceinline__ unsigned xb_ld(unsigned* p)              { return __hip_atomic_load(p, __ATOMIC_RELAXED, __HIP_MEMORY_SCOPE_AGENT); }
__device__ __forceinline__ unsigned xb_add(unsigned* p, unsigned v) { return __hip_atomic_fetch_add(p, v, __ATOMIC_RELAXED, __HIP_MEMORY_SCOPE_AGENT); }
__device__ __forceinline__ unsigned xb_xcc_id() { return (unsigned)__builtin_amdgcn_s_getreg((3 << 11) | 20) & 0xFu; }
#define XB_SPIN(cond, bar) do { unsigned _sp = 0; while (cond) { __builtin_amdgcn_s_sleep(1); \
    if ((++_sp & 255u) == 0u) { if (xb_ld(&(bar)[XB_TMO])) break; if (_sp > XB_SPIN_CAP) { atomicAdd(&(bar)[XB_TMO], 1u); break; } } } } while (0)
struct XcdBarrier { unsigned* bar; unsigned x; volatile LAS unsigned* st; };
__device__ __forceinline__ XcdBarrier xcd_barrier_post(unsigned* bar, volatile LAS unsigned* st) {
    XcdBarrier b; b.bar = bar; b.x = xb_xcc_id(); b.st = st;
    if (threadIdx.x == 0) (void)xb_add(&bar[XB_XCNT(b.x)], 1u);
    return b;
}
__device__ __forceinline__ void xcd_barrier_complete(unsigned* bar, unsigned x, unsigned& nloc, unsigned& nx) {
    const unsigned G = gridDim.x * gridDim.y * gridDim.z;
    unsigned sum, cnt, mine, sp = 0u;
    for (;;) {
        sum = 0u; cnt = 0u; mine = 0u;
#pragma unroll
        for (unsigned j = 0; j < 16; ++j) { const unsigned c = xb_ld(&bar[XB_XCNT(j)]); sum += c; cnt += (c > 0u) ? 1u : 0u; mine = (j == x) ? c : mine; }
        if (sum == G) break;
        __builtin_amdgcn_s_sleep(1);
        if ((++sp & 255u) == 0u) { if (xb_ld(&bar[XB_TMO])) break; if (sp > XB_SPIN_CAP) { atomicAdd(&bar[XB_TMO], 1u); break; } }
    }
    nloc = mine > 0u ? mine : 1u; nx = cnt > 0u ? cnt : 1u;
}
template <class Idle>
__device__ __forceinline__ void xcd_barrier(const XcdBarrier& b, Idle&& idle) {
    asm volatile("s_waitcnt vmcnt(0)" ::: "memory");
    __syncthreads();
    if (threadIdx.x == 0) {
        unsigned* bar = b.bar;
        __builtin_amdgcn_s_waitcnt(0);
        unsigned nloc = b.st[0], nx = b.st[1];
        if (nloc == 0u) { xcd_barrier_complete(bar, b.x, nloc, nx); b.st[0] = nloc; b.st[1] = nx; }
        const unsigned old = xb_add(&bar[XB_XSUB(b.x)], 1u);
        const unsigned gen = old / nloc;
        if (old + 1u == (gen + 1u) * nloc) {
            __builtin_amdgcn_fence(__ATOMIC_RELEASE, "agent");
            asm volatile("s_waitcnt vmcnt(0)" ::: "memory");
            const unsigned og = xb_add(&bar[XB_TOP], 1u);
            const unsigned tg = og / nx;
            if (og + 1u == (tg + 1u) * nx) xb_add(&bar[XB_TOPGEN], 1u);
            else XB_SPIN(xb_ld(&bar[XB_TOPGEN]) == tg, bar);
            __builtin_amdgcn_fence(__ATOMIC_ACQUIRE, "agent");
            xb_add(&bar[XB_XGEN(b.x)], 1u);
            asm volatile("s_waitcnt vmcnt(0)" ::: "memory");
            b.st[2] = 1u;
        } else { b.st[2] = 0u; b.st[3] = gen; }
    }
    __syncthreads();
    unsigned rounds = 0u;
    while (b.st[2] == 0u) {
        const bool had = idle();
        const unsigned long long anyw = __ballot(had);
        __syncthreads();
        if (threadIdx.x == 0) {
            unsigned* bar = b.bar; const unsigned gen = b.st[3];
            bool rel = xb_ld(&bar[XB_XGEN(b.x)]) != gen;
            if (!rel && anyw == 0ull) { XB_SPIN(xb_ld(&bar[XB_XGEN(b.x)]) == gen, bar); rel = true; }
            if (!rel && ++rounds > (1u << 16)) { atomicAdd(&bar[XB_TMO], 1u); rel = true; }
            if (rel) { __builtin_amdgcn_fence(__ATOMIC_ACQUIRE, "agent"); asm volatile("s_waitcnt vmcnt(0)" ::: "memory"); b.st[2] = 1u; }
        }
        __syncthreads();
    }
}
#ifndef PROBE_GMIN
#define PROBE_GMIN 0
#endif
#ifndef FP8_SCALE_ARG
#define FP8_SCALE_ARG 0
#endif

#ifndef PROBE_STORE2
#define PROBE_STORE2 0
#endif
#ifndef FP8_ASM
#define FP8_ASM 0
#endif
namespace pg8 {
constexpr int BM = 256, BK = 64, HALF = 128, HTB = HALF * BK * 2, STAGE_BYTES = 8 * HTB, NXCD = 8, WGM = 8;
__host__ __device__ __forceinline__ int lds_byte(int r, int c) { const int st = (r >> 4) * 2 + (c >> 5), rr = r & 15, cc = c & 31, ob = rr * 64 + cc * 2; return st * 1024 + (ob ^ (((ob >> 9) & 1) << 5)); }
__host__ __device__ __forceinline__ void stage_rc(int b, int& R, int& C) { const int st = b / 1024, sb = b % 1024, swz = sb ^ (((sb >> 9) & 1) << 5); R = (st >> 1) * 16 + swz / 64; C = (st & 1) * 32 + (swz % 64) / 2; }
__host__ __device__ __forceinline__ int perm32(int rho) { const int n = rho >> 4, i = rho & 15; return 8 * (i >> 2) + 4 * n + (i & 3); }

struct Unit { int pm, pn, e, full, pos0; };
struct Gemm { const bf16_t* A; const bf16_t* Bt; int K; size_t b_estride; const LAS int* rowtab; void* probe; };

struct StaticOrder {
    int nM, nN, nwg, G, c;
    __device__ void init(int M, int N, int G_, int c_) { nM = M / BM; nN = N / BM; nwg = nM * nN; G = G_; c = c_; }
    __device__ bool next(int i, Unit& u) const {
        const long L = (long)i * G + c; if (L >= nwg) return false;
        int wgid = (int)L; { const int q = nwg / NXCD, r = nwg % NXCD, xcd = wgid % NXCD, off = wgid / NXCD; wgid = (xcd < r ? xcd * (q + 1) : r * (q + 1) + (xcd - r) * q) + off; }
        const int nig = WGM * nN, gid = wgid / nig, fm = gid * WGM, gsz = (nM - fm) < WGM ? (nM - fm) : WGM;
        u.pm = fm + ((wgid % nig) % gsz); u.pn = (wgid % nig) / gsz; u.e = 0; u.full = 1; u.pos0 = 0; return true;
    }
    __device__ __forceinline__ void between(int) const {}
};
struct MoeOrder {
    const LAS int* tab; int r, nper, i0, imax;
    __device__ bool next(int i, Unit& u) const {
        if (i >= imax) return false;
        const int L = (i0 + i) * nper + r; if (L >= __builtin_amdgcn_readfirstlane(tab[1])) return false;
        int p = 0; const int np = tab[0];
#pragma unroll 1
        while (p + 1 < np && tab[4 + 8 * (p + 1)] <= L) ++p;
        const LAS int* t = tab + 4 + 8 * p;
        const int local = L - t[0], mte = t[3], pq = local / mte, mt = local - pq * mte;
        u.e = __builtin_amdgcn_readfirstlane(t[1]); u.pn = __builtin_amdgcn_readfirstlane(t[2] + pq); u.pm = __builtin_amdgcn_readfirstlane(t[4] + mt);
        u.full = __builtin_amdgcn_readfirstlane((t[5] - mt * 256) > 128 ? 1 : 0); u.pos0 = __builtin_amdgcn_readfirstlane(mt * 256); return true;
    }
    __device__ __forceinline__ void between(int) const {}
};

struct EpiProj {
    static constexpr bool PERM = true;
    bf16_t* O; int ldc;
    __device__ __forceinline__ void operator()(const f32x4 (&acc)[2][2][4][2], const Unit& u, int wr, int wc, int fr, int fq) const {
        const int row0 = u.pm * BM + wr * 64 + fr, col0 = u.pn * BM + wc * 32 + 8 * fq;
#pragma unroll
        for (int ai = 0; ai < 2; ++ai)
#pragma unroll
            for (int m = 0; m < 4; ++m) { bf16_t* rowp = O + (size_t)(row0 + ai * HALF + m * 16) * ldc + col0;
#pragma unroll
                for (int bj = 0; bj < 2; ++bj) { const f32x4 v0 = acc[ai][bj][m][0], v1 = acc[ai][bj][m][1];
                    u32x4 w; w.x = cvt_pk_bf16(v0[0], v0[1]); w.y = cvt_pk_bf16(v0[2], v0[3]); w.z = cvt_pk_bf16(v1[0], v1[1]); w.w = cvt_pk_bf16(v1[2], v1[3]);
                    *(u32x4*)(rowp + bj * HALF) = w;
#if PROBE_STORE2 == 1
                    *(u32x4*)(rowp + bj * HALF + (size_t)1792 * 1024 * 1024) = w;
#endif
                } }
    }
};
struct EpiOut {
    static constexpr bool PERM = false;
    const float* X; const float* g1;   float* O;
    __device__ __forceinline__ void operator()(const f32x4 (&acc)[2][2][4][2], const Unit& u, int wr, int wc, int fr, int fq) const {
        const int row0 = u.pm * BM + wr * 64 + fr, col0 = u.pn * BM + wc * 32 + 4 * fq;
        const float* gp = g1 + (size_t)((u.pm * BM) >> 12) * 12288 + col0;
        f32x4 gv[2][2];
#pragma unroll
        for (int bj = 0; bj < 2; ++bj)
#pragma unroll
            for (int n = 0; n < 2; ++n) gv[bj][n] = *(const f32x4*)(gp + bj * HALF + n * 16);
#pragma unroll
        for (int ai = 0; ai < 2; ++ai)
#pragma unroll
            for (int m = 0; m < 4; ++m) { const size_t off = (size_t)(row0 + ai * HALF + m * 16) * DM + col0;
#pragma unroll
                for (int bj = 0; bj < 2; ++bj)
#pragma unroll
                    for (int n = 0; n < 2; ++n) { const f32x4 xv = *(const f32x4*)(X + off + bj * HALF + n * 16);
                        *(f32x4*)(O + off + bj * HALF + n * 16) = xv + gv[bj][n] * acc[ai][bj][m][n]; }
                asm volatile("" ::: "memory"); }
    }
};
struct EpiGU {
    static constexpr bool PERM = true;
    const float* bias;   bf16_t* O;
    __device__ __forceinline__ void operator()(const f32x4 (&acc)[2][2][4][2], const Unit& u, int wr, int wc, int fr, int fq) const {
        const int row0 = u.pm * BM + wr * 64 + fr, cc = u.pn * HALF + wc * 32 + 8 * fq;
        const float* bp = bias + (size_t)u.e * 4096 + cc;
        f32x4 bg[2], bu[2];
#pragma unroll
        for (int n = 0; n < 2; ++n) { bg[n] = *(const f32x4*)(bp + 4 * n); bu[n] = *(const f32x4*)(bp + 2048 + 4 * n); }
#pragma unroll
        for (int ai = 0; ai < 2; ++ai)
#pragma unroll
            for (int m = 0; m < 4; ++m) { float r[8];
#pragma unroll
                for (int n = 0; n < 2; ++n)
#pragma unroll
                    for (int j = 0; j < 4; ++j) {
                        float g = acc[ai][0][m][n][j] + bg[n][j], uu = acc[ai][1][m][n][j] + bu[n][j];
                        g = fminf(g, 7.0f); uu = fminf(fmaxf(uu, -7.0f), 7.0f);
                        const float glu = g * __builtin_amdgcn_rcpf(1.0f + __expf(-1.702f * g));
                        r[n * 4 + j] = (uu + 1.0f) * glu;
#if FP8_EMU
                        r[n * 4 + j] = q8(r[n * 4 + j]);
#endif
                    }
                u32x4 w; w.x = cvt_pk_bf16(r[0], r[1]); w.y = cvt_pk_bf16(r[2], r[3]); w.z = cvt_pk_bf16(r[4], r[5]); w.w = cvt_pk_bf16(r[6], r[7]);
                *(u32x4*)(O + (size_t)(row0 + ai * HALF + m * 16) * DM + cc) = w; }
    }
};
struct EpiDown {
    static constexpr bool PERM = true;
    const float* bias;   const float* wbuf; bf16_t* O;
    __device__ __forceinline__ void operator()(const f32x4 (&acc)[2][2][4][2], const Unit& u, int wr, int wc, int fr, int fq) const {
        const int row0 = u.pm * BM + wr * 64 + fr, col0 = u.pn * BM + wc * 32 + 8 * fq;
        const float* bp = bias + (size_t)u.e * 2048 + col0;
        f32x4 bv[2][2];
#pragma unroll
        for (int bj = 0; bj < 2; ++bj)
#pragma unroll
            for (int n = 0; n < 2; ++n) bv[bj][n] = *(const f32x4*)(bp + bj * HALF + 4 * n);
#pragma unroll
        for (int ai = 0; ai < 2; ++ai)
#pragma unroll
            for (int m = 0; m < 4; ++m) { const int row = row0 + ai * HALF + m * 16; const float rw = wbuf[row]; bf16_t* rowp = O + (size_t)row * DM + col0;
#pragma unroll
                for (int bj = 0; bj < 2; ++bj) { const f32x4 v0 = (acc[ai][bj][m][0] + bv[bj][0]) * rw, v1 = (acc[ai][bj][m][1] + bv[bj][1]) * rw;
                    u32x4 w; w.x = cvt_pk_bf16(v0[0], v0[1]); w.y = cvt_pk_bf16(v0[2], v0[3]); w.z = cvt_pk_bf16(v1[0], v1[1]); w.w = cvt_pk_bf16(v1[2], v1[3]);
                    *(u32x4*)(rowp + bj * HALF) = w; } }
    }
};

__device__ __forceinline__ unsigned pk4_fp8(float a, float b, float c, float d) { int p = __builtin_amdgcn_cvt_pk_fp8_f32(a, b, 0, false); p = __builtin_amdgcn_cvt_pk_fp8_f32(c, d, p, true); return (unsigned)p; }
constexpr float W8_SCALE = 64.0f, W8_INV = 1.0f / 64.0f;
struct EpiGU8 {
    static constexpr bool PERM = true;
    const float* bias;   unsigned char* O;
    __device__ __forceinline__ void operator()(const f32x4 (&acc)[2][2][4][2], const Unit& u, int wr, int wc, int fr, int fq) const {
        const int row0 = u.pm * BM + wr * 64 + fr, cc = u.pn * HALF + wc * 32 + 8 * fq;
        const float* bp = bias + (size_t)u.e * 4096 + cc;
        f32x4 bg[2], bu[2];
#pragma unroll
        for (int n = 0; n < 2; ++n) { bg[n] = *(const f32x4*)(bp + 4 * n); bu[n] = *(const f32x4*)(bp + 2048 + 4 * n); }
#pragma unroll
        for (int ai = 0; ai < 2; ++ai)
#pragma unroll
            for (int m = 0; m < 4; ++m) { float r[8];
#pragma unroll
                for (int n = 0; n < 2; ++n)
#pragma unroll
                    for (int j = 0; j < 4; ++j) {
                        float g = acc[ai][0][m][n][j] * W8_INV + bg[n][j], uu = acc[ai][1][m][n][j] * W8_INV + bu[n][j];
                        g = fminf(g, 7.0f); uu = fminf(fmaxf(uu, -7.0f), 7.0f);
                        const float glu = g * __builtin_amdgcn_rcpf(1.0f + __expf(-1.702f * g));
                        r[n * 4 + j] = (uu + 1.0f) * glu; }
                u32x2 w; w.x = pk4_fp8(r[0], r[1], r[2], r[3]); w.y = pk4_fp8(r[4], r[5], r[6], r[7]);
                *(u32x2*)(O + (size_t)(row0 + ai * HALF + m * 16) * DM + cc) = w; }
    }
};
struct EpiDown8 {
    static constexpr bool PERM = true;
    const float* bias;   const float* wbuf; bf16_t* O;
    __device__ __forceinline__ void operator()(const f32x4 (&acc)[2][2][4][2], const Unit& u, int wr, int wc, int fr, int fq) const {
        const int row0 = u.pm * BM + wr * 64 + fr, col0 = u.pn * BM + wc * 32 + 8 * fq;
        const float* bp = bias + (size_t)u.e * 2048 + col0;
        f32x4 bv[2][2];
#pragma unroll
        for (int bj = 0; bj < 2; ++bj)
#pragma unroll
            for (int n = 0; n < 2; ++n) bv[bj][n] = *(const f32x4*)(bp + bj * HALF + 4 * n);
#pragma unroll
        for (int ai = 0; ai < 2; ++ai)
#pragma unroll
            for (int m = 0; m < 4; ++m) { const int row = row0 + ai * HALF + m * 16; const float rw = wbuf[(size_t)u.e * 8192 + u.pos0 + (row - u.pm * BM)]; bf16_t* rowp = O + (size_t)row * DM + col0;
#pragma unroll
                for (int bj = 0; bj < 2; ++bj) { const f32x4 v0 = (acc[ai][bj][m][0] * W8_INV + bv[bj][0]) * rw, v1 = (acc[ai][bj][m][1] * W8_INV + bv[bj][1]) * rw;
                    u32x4 w; w.x = cvt_pk_bf16(v0[0], v0[1]); w.y = cvt_pk_bf16(v0[2], v0[3]); w.z = cvt_pk_bf16(v1[0], v1[1]); w.w = cvt_pk_bf16(v1[2], v1[3]);
                    *(u32x4*)(rowp + bj * HALF) = w; } }
    }
};

typedef int i32x8 __attribute__((ext_vector_type(8)));
typedef short s16x16 __attribute__((ext_vector_type(16)));
__device__ __forceinline__ i32x8 ld32(const LAS unsigned char* p) { const bf16x8 lo = *(const LAS bf16x8*)p, hi = *(const LAS bf16x8*)(p + 1024); return __builtin_bit_cast(i32x8, __builtin_shufflevector(lo, hi, 0, 1, 2, 3, 4, 5, 6, 7, 8, 9, 10, 11, 12, 13, 14, 15)); }
__device__ __forceinline__ const char* sbase(const char* p) { asm volatile("" : "+s"(p)); return p; }
template <bool FP8, bool GATHER, class Epi, class Sched>
__device__ __forceinline__ void gemm_phase(LAS unsigned char* lds, const Gemm g, const Sched& S, const Epi& E) {
    const int tid = threadIdx.x, wid = __builtin_amdgcn_readfirstlane(tid >> 6), lane = tid & 63, wr = wid >> 2, wc = wid & 3, fr = lane & 15, fq = lane >> 4;
    const int K = g.K, nt = K / BK;
    unsigned voffA, voffB;
    { int R, C; stage_rc(tid * 16, R, C); const int Rb = Epi::PERM ? ((R & ~31) + perm32(R & 31)) : R; voffA = (unsigned)(R * K + C) * 2u; voffB = (unsigned)(Rb * K + C) * 2u; }
    const size_t pstep = (size_t)64 * K * 2;
    unsigned voffC = 0, ro[4] = {0, 0, 0, 0}; int Rl = 0;
    if constexpr (GATHER) { int R, C; stage_rc(tid * 16, R, C); voffC = (unsigned)C * 2u; Rl = R; }
#define PG8_ROWS(x0, uidx) do { ro[x0] = (unsigned)g.rowtab[(uidx) * 256 + Rl + 64 * (x0)]; ro[(x0) + 1] = (unsigned)g.rowtab[(uidx) * 256 + Rl + 64 * (x0) + 64]; } while (0)
    const size_t kstep = (size_t)(BK * 2);
    const size_t hstep = (size_t)HALF * K * 2;
    const size_t tstep = 2 * hstep;
    const size_t estep = g.b_estride * 2;
    const unsigned ldsw = (unsigned)wid * 1024u;
    const int aoff0 = lds_byte(wr * 64 + fr, fq * 8), boff0 = lds_byte(wc * 32 + fr, fq * 8);
#define PG8_SA(b, h) (((b) * 2 + (h)) * HTB)
#define PG8_SB(b, h) ((4 + (b) * 2 + (h)) * HTB)
#define PG8_STAGE(bufoff, gbase, voff) do { _Pragma("unroll") for (int _i = 0; _i < 2; ++_i) \
        __builtin_amdgcn_global_load_lds((const unsigned*)(sbase((const char*)(gbase) + _i * pstep) + (voff)), (LAS unsigned*)(lds + (bufoff) + ldsw + _i * 8192), 16, 0, 0); } while (0)
#define PG8_STAGEA(bufoff, isnext, half, koff) do { if constexpr (GATHER) { _Pragma("unroll") for (int _i = 0; _i < 2; ++_i) { const unsigned _r = ro[(half) * 2 + _i]; \
            __builtin_amdgcn_global_load_lds((const unsigned*)(sbase((const char*)g.A + (koff)) + (_r + voffC)), (LAS unsigned*)(lds + (bufoff) + ldsw + _i * 8192), 16, 0, 0); } } \
        else { PG8_STAGE(bufoff, ((isnext) ? nA : cA) + (half) * hstep + (koff), voffA); } } while (0)
#define PG8_LDA(dst, b, h) do { _Pragma("unroll") for (int m = 0; m < 4; ++m) { \
        if constexpr (FP8) dst##8[m] = ld32(lds + PG8_SA(b, h) + aoff0 + m * 2048); \
        else { dst[m][0] = *(const LAS bf16x8*)(lds + PG8_SA(b, h) + aoff0 + m * 2048); dst[m][1] = *(const LAS bf16x8*)(lds + PG8_SA(b, h) + aoff0 + m * 2048 + 1024); } } } while (0)
#define PG8_LDB(dst, b, h) do { _Pragma("unroll") for (int n = 0; n < 2; ++n) { \
        if constexpr (FP8) dst##8[n] = ld32(lds + PG8_SB(b, h) + boff0 + n * 2048); \
        else { dst[n][0] = *(const LAS bf16x8*)(lds + PG8_SB(b, h) + boff0 + n * 2048); dst[n][1] = *(const LAS bf16x8*)(lds + PG8_SB(b, h) + boff0 + n * 2048 + 1024); } } } while (0)
#define PG8_MMA(ai, bj, At, Bt) do { __builtin_amdgcn_s_setprio(1); _Pragma("unroll") for (int m = 0; m < 4; ++m) _Pragma("unroll") for (int n = 0; n < 2; ++n) { \
        if constexpr (FP8) { if (FP8_ASM) { asm volatile("v_mfma_scale_f32_16x16x128_f8f6f4 %0, %1, %2, %0, %3, %3 op_sel_hi:[0,0,0]" : "+a"(acc[ai][bj][m][n]) : "v"(Bt##8[n]), "v"(At##8[m]), "v"(scale1)); } \
            else acc[ai][bj][m][n] = __builtin_amdgcn_mfma_scale_f32_16x16x128_f8f6f4(Bt##8[n], At##8[m], acc[ai][bj][m][n], 0, 0, 0, FP8_SCALE_ARG, 0, FP8_SCALE_ARG); } \
        else { acc[ai][bj][m][n] = __builtin_amdgcn_mfma_f32_16x16x32_bf16(Bt[n][0], At[m][0], acc[ai][bj][m][n], 0, 0, 0); \
               acc[ai][bj][m][n] = __builtin_amdgcn_mfma_f32_16x16x32_bf16(Bt[n][1], At[m][1], acc[ai][bj][m][n], 0, 0, 0); } } \
        __builtin_amdgcn_s_setprio(0); } while (0)
#define PG8_WAIT_V(n) asm volatile("s_waitcnt vmcnt(" #n ")" ::: "memory")
#define PG8_WAIT_L(n) asm volatile("s_waitcnt lgkmcnt(" #n ")" ::: "memory")
#define PG8_BAR __builtin_amdgcn_s_barrier()
#define PG8_SCHED __builtin_amdgcn_sched_barrier(0)
#ifdef PROBE_GMAX
    const unsigned long long tg0 = __builtin_amdgcn_s_memrealtime();
#endif
    Unit cur, nxt; int ui = 0;
#ifdef PROBE_EPI
    unsigned long long epi_acc = 0;
#endif
    if (!S.next(0, cur)) return;
    f32x4 acc[2][2][4][2];
#pragma unroll
    for (int a = 0; a < 2; ++a)
#pragma unroll
        for (int b = 0; b < 2; ++b)
#pragma unroll
            for (int m = 0; m < 4; ++m)
#pragma unroll
                for (int n = 0; n < 2; ++n) acc[a][b][m][n] = (f32x4){0.f, 0.f, 0.f, 0.f};
    bf16x8 At[4][2], B0[2][2], B1[2][2]; i32x8 At8[4], B08[2], B18[2];
    const unsigned scale1 = 0x7f7f7f7fu;
    const char* cA = (const char*)g.A + (size_t)cur.pm * tstep; const char* cB = (const char*)g.Bt + (size_t)cur.e * estep + (size_t)cur.pn * tstep;
    const char* nA = cA;
    if constexpr (GATHER) { PG8_ROWS(0, 0); PG8_ROWS(2, 0); }
    PG8_STAGE(PG8_SB(0, 0), cB, voffB); PG8_STAGEA(PG8_SA(0, 0), false, 0, 0); PG8_STAGE(PG8_SB(0, 1), cB + hstep, voffB); PG8_STAGEA(PG8_SA(0, 1), false, 1, 0);
    if (wr == 1) PG8_BAR;
    PG8_WAIT_V(4); PG8_BAR;
    PG8_STAGE(PG8_SB(1, 0), cB + kstep, voffB); PG8_STAGEA(PG8_SA(1, 0), false, 0, kstep); PG8_STAGE(PG8_SB(1, 1), cB + hstep + kstep, voffB);
    PG8_WAIT_V(6); PG8_BAR;
    for (;;) {
        const bool has_next = S.next(ui + 1, nxt);
        const bool cfull = FP8 ? true : (cur.full != 0);
        nA = has_next ? (const char*)g.A + (size_t)nxt.pm * tstep : cA;
        const char* nB = has_next ? (const char*)g.Bt + (size_t)nxt.e * estep + (size_t)nxt.pn * tstep : cB;
#ifdef PROBE_KL
        const unsigned long long tk0 = __builtin_amdgcn_s_memrealtime();
#endif
        for (int t = 0; t < nt; t += 2) {
            const bool last = (t == nt - 2);
            const size_t k1 = (size_t)(t + 1) * kstep, k2 = last ? 0 : (size_t)(t + 2) * kstep, k3 = k2 + kstep;
            const char* b2 = last ? nB : cB + (size_t)(t + 2) * kstep; const char* b3 = b2 + kstep;
            if constexpr (GATHER) { if (last && has_next) PG8_ROWS(0, ui + 1); }
            PG8_LDB(B0, 0, 0); PG8_SCHED; PG8_LDA(At, 0, 0); PG8_STAGEA(PG8_SA(1, 1), false, 1, k1);
            if constexpr (GATHER) { if (last && has_next) PG8_ROWS(2, ui + 1); }
            PG8_WAIT_V(10); PG8_WAIT_L(8); PG8_BAR; PG8_WAIT_L(0); PG8_MMA(0, 0, At, B0); PG8_BAR; PG8_SCHED;
            PG8_LDB(B1, 0, 1); PG8_STAGE(PG8_SB(0, 0), b2, voffB);
            PG8_WAIT_V(10); PG8_BAR; PG8_WAIT_L(0); PG8_MMA(0, 1, At, B1); PG8_BAR;
            PG8_LDA(At, 0, 1); PG8_STAGEA(PG8_SA(0, 0), last, 0, k2);
            PG8_BAR; PG8_WAIT_L(0); if (cfull) PG8_MMA(1, 0, At, B0); PG8_BAR; PG8_SCHED;
            PG8_STAGE(PG8_SB(0, 1), b2 + hstep, voffB);
            PG8_WAIT_V(10); PG8_BAR; if (cfull) PG8_MMA(1, 1, At, B1); PG8_BAR;
            PG8_LDB(B0, 1, 0); PG8_SCHED; PG8_LDA(At, 1, 0); PG8_STAGEA(PG8_SA(0, 1), last, 1, k2);
            PG8_WAIT_V(10); PG8_WAIT_L(8); PG8_BAR; PG8_WAIT_L(0); PG8_MMA(0, 0, At, B0); PG8_BAR; PG8_SCHED;
            PG8_LDB(B1, 1, 1); PG8_STAGE(PG8_SB(1, 0), b3, voffB);
            PG8_WAIT_V(10); PG8_BAR; PG8_WAIT_L(0); PG8_MMA(0, 1, At, B1); PG8_BAR;
            PG8_LDA(At, 1, 1); PG8_STAGEA(PG8_SA(1, 0), last, 0, k3);
            PG8_BAR; PG8_WAIT_L(0); if (cfull) PG8_MMA(1, 0, At, B0); PG8_BAR; PG8_SCHED;
            PG8_STAGE(PG8_SB(1, 1), b3 + hstep, voffB);
            PG8_WAIT_V(10); PG8_BAR; if (cfull) PG8_MMA(1, 1, At, B1); PG8_BAR;
        }
#ifdef PROBE_KL
        if (FP8 && (GATHER ? 9 : 10) == PROBE_EPI) epi_acc += __builtin_amdgcn_s_memrealtime() - tk0;
#endif
        {
            int tz = threadIdx.x; asm volatile("" : "+v"(tz)); const int lz = tz & 63;
#ifdef PROBE_EPI
            const unsigned long long te0 = __builtin_amdgcn_s_memrealtime();
#endif
            E(acc, cur, wr, wc, lz & 15, lz >> 4);
#ifdef PROBE_EPI
#ifndef PROBE_KL
            if (FP8 && (GATHER ? 9 : 10) == PROBE_EPI) { epi_acc += __builtin_amdgcn_s_memrealtime() - te0; }
#endif
#endif
            }
        S.between(ui);
        if (!has_next) break;
#pragma unroll
        for (int a = 0; a < 2; ++a)
#pragma unroll
            for (int b = 0; b < 2; ++b)
#pragma unroll
                for (int m = 0; m < 4; ++m)
#pragma unroll
                    for (int n = 0; n < 2; ++n) acc[a][b][m][n] = (f32x4){0.f, 0.f, 0.f, 0.f};
        cur = nxt; cA = nA; cB = nB; ++ui;

    }
#ifdef PROBE_EPI
    if (FP8 && (GATHER ? 9 : 10) == PROBE_EPI && blockIdx.x == 0 && threadIdx.x == 0) *(unsigned long long*)((char*)g.probe) = epi_acc;
#endif
#ifdef PROBE_GMAX
    if (FP8 && (GATHER ? 9 : 10) == PROBE_GMAX && threadIdx.x == 0) { const unsigned d = (unsigned)(__builtin_amdgcn_s_memrealtime() - tg0); if (PROBE_GMIN) atomicMin((unsigned*)((char*)g.probe + 8), d); else atomicMax((unsigned*)((char*)g.probe + 8), d); }
#endif
    PG8_WAIT_V(0);
    if (wr == 0) PG8_BAR;
    PG8_BAR;
#undef PG8_SA
#undef PG8_SB
#undef PG8_STAGE
#undef PG8_STAGEA
#undef PG8_ROWS
#undef PG8_LDA
#undef PG8_LDB
#undef PG8_MMA
#undef PG8_WAIT_V
#undef PG8_WAIT_L
#undef PG8_BAR
#undef PG8_SCHED
}
}

__device__ __forceinline__ void conv_job(const float* src, int ld, bf16_t* dst, int kt) {
    const int w = threadIdx.x >> 6, lane = threadIdx.x & 63, kseg = lane & 7, nq = lane >> 3;
    const int k0 = kt * 128 + (w >> 2) * 64 + kseg * 8, nl = (w & 3) * 32 + nq * 4;
    f32x4 v[8];
#pragma unroll
    for (int r = 0; r < 8; ++r) v[r] = *(const f32x4*)(src + (size_t)(k0 + r) * ld + nl);
#if FP8_EMU
#pragma unroll
    for (int r = 0; r < 8; ++r)
#pragma unroll
        for (int j = 0; j < 4; ++j) v[r][j] = q8(v[r][j] * 64.0f) * (1.0f / 64.0f);
#endif
#pragma unroll
    for (int j = 0; j < 4; ++j) { u32x4 o; o.x = cvt_pk_bf16(v[0][j], v[1][j]); o.y = cvt_pk_bf16(v[2][j], v[3][j]); o.z = cvt_pk_bf16(v[4][j], v[5][j]); o.w = cvt_pk_bf16(v[6][j], v[7][j]);
        *(u32x4*)(dst + (size_t)(nl + j) * 2048 + k0) = o; }
}
constexpr int CONV_JOBS_GU = 32 * 16 * 16, CONV_JOBS_D = 32 * 16 * 8, CONV_JOBS = CONV_JOBS_GU + CONV_JOBS_D;
__device__ __forceinline__ void conv_block_job(const Args& a, LAS unsigned char* T, int j) {
    const int tid = threadIdx.x, w = tid >> 6, lane = tid & 63;
    const float* src; int ld; unsigned char* dst; int gu, s0;
    if (j < CONV_JOBS_GU) { const int e = j >> 8, kb = (j >> 4) & 15, nb = j & 15; s0 = nb * 256; gu = 1;
        src = a.w_gate_up + ((size_t)e * 2048 + kb * 128) * 4096 + s0; ld = 4096; dst = (unsigned char*)(a.ws + WS_WGU_T) + (size_t)e * 4096 * 2048 + kb * 128; }
    else { const int jj = j - CONV_JOBS_GU, e = jj >> 7, kb = (jj >> 3) & 15, nb = jj & 7; s0 = nb * 256; gu = 0;
        src = a.w_down + ((size_t)e * 2048 + kb * 128) * 2048 + s0; ld = 2048; dst = (unsigned char*)(a.ws + WS_WD_T) + (size_t)e * 2048 * 2048 + kb * 128; }
    f32x4 v[16];
#pragma unroll
    for (int r = 0; r < 16; ++r) v[r] = __builtin_nontemporal_load((const f32x4*)(src + (size_t)(w * 16 + r) * ld + lane * 4)) * pg8::W8_SCALE;
#pragma unroll
    for (int jn = 0; jn < 4; ++jn) { u32x4 o;
        o.x = pg8::pk4_fp8(v[0][jn], v[1][jn], v[2][jn], v[3][jn]); o.y = pg8::pk4_fp8(v[4][jn], v[5][jn], v[6][jn], v[7][jn]);
        o.z = pg8::pk4_fp8(v[8][jn], v[9][jn], v[10][jn], v[11][jn]); o.w = pg8::pk4_fp8(v[12][jn], v[13][jn], v[14][jn], v[15][jn]);
        const int n = lane * 4 + jn;
        *(LAS u32x4*)(T + n * 128 + ((w ^ (lane & 7)) << 4)) = o; }
    __syncthreads();
#pragma unroll
    for (int p = 0; p < 4; ++p) { const int idx = tid + 512 * p, n = idx >> 3, wq = idx & 7;
        const u32x4 o = *(const LAS u32x4*)(T + n * 128 + ((wq ^ ((n >> 2) & 7)) << 4));
        const int c = s0 + n; int np = c;
        if (gu) { const int bj = c >> 11, rem = c & 2047; np = (rem >> 7) * 256 + bj * 128 + (rem & 127); }
        __builtin_nontemporal_store(o, (u32x4*)(dst + (size_t)np * 2048 + wq * 16)); }
}
constexpr int SJOBS_GU = 32 * 32 * 128, SJOBS_D = 32 * 32 * 64, SJOBS = SJOBS_GU + SJOBS_D;
constexpr int SJOBS_ATTN = 256 * 33 * 8;
typedef short s16x2 __attribute__((ext_vector_type(2)));
__device__ __forceinline__ unsigned pk4_fp8_scaled(float a, float b, float c, float d) { s16x2 r = {0, 0}; r = __builtin_amdgcn_cvt_scalef32_pk_fp8_f32(r, a, b, pg8::W8_INV, false); r = __builtin_amdgcn_cvt_scalef32_pk_fp8_f32(r, c, d, pg8::W8_INV, true); return __builtin_bit_cast(unsigned, r); }
struct SJob { const float* src; unsigned char* dst; int ld; };
__device__ __forceinline__ SJob sjob_addr(const Args& a, int j, int lane) {
    SJob c; const int kseg = lane & 7, nq = lane >> 3;
    if (j < SJOBS_GU) { const int e = j >> 12, kb = (j >> 7) & 31, nb = j & 127, s0 = nb * 32, bj = s0 >> 11, rem = s0 & 2047, pn = rem >> 7, c0 = rem & 127, np = pn * 256 + bj * 128 + c0;
        c.ld = 4096; c.src = a.w_gate_up + ((size_t)e * 2048 + kb * 64 + kseg * 8) * 4096 + s0 + nq * 4; c.dst = (unsigned char*)(a.ws + WS_WGU_T) + ((size_t)e * 4096 + np + nq * 4) * 2048 + kb * 64 + kseg * 8; }
    else { const int jj = j - SJOBS_GU, e = jj >> 11, kb = (jj >> 6) & 31, nb = jj & 63;
        c.ld = 2048; c.src = a.w_down + ((size_t)e * 2048 + kb * 64 + kseg * 8) * 2048 + nb * 32 + nq * 4; c.dst = (unsigned char*)(a.ws + WS_WD_T) + ((size_t)e * 2048 + nb * 32 + nq * 4) * 2048 + kb * 64 + kseg * 8; }
    return c;
}
__device__ __forceinline__ void sjob_load(const SJob& c, f32x4 (&v)[8]) {
#pragma unroll
    for (int r = 0; r < 8; ++r) v[r] = __builtin_nontemporal_load((const f32x4*)(c.src + (size_t)r * c.ld));
}
__device__ __forceinline__ void sjob_store(const SJob& c, const f32x4 (&v)[8]) {
#pragma unroll
    for (int jn = 0; jn < 4; ++jn) { u32x2 o;
        o.x = pk4_fp8_scaled(v[0][jn], v[1][jn], v[2][jn], v[3][jn]); o.y = pk4_fp8_scaled(v[4][jn], v[5][jn], v[6][jn], v[7][jn]);
        __builtin_nontemporal_store(o, (u32x2*)(c.dst + (size_t)jn * 2048)); }
}
__device__ __forceinline__ void conv_share(const Args& a, int blk, int G) {
    const int s = blk % 3, r = blk / 3, nb = (G - s + 2) / 3, w = threadIdx.x >> 6, lane = threadIdx.x & 63;
    const int npair = (SJOBS - SJOBS_ATTN) / 2, p0 = s * (npair / 3), p1 = (s == 2) ? npair : (s + 1) * (npair / 3);
    int p = p0 + r * 8 + w; const int step = nb * 8;
    if (p >= p1) return;
    f32x4 va0[8], va1[8], vb0[8], vb1[8]; SJob ca = sjob_addr(a, SJOBS_ATTN + 2 * p, lane), cb = ca, t;
    sjob_load(ca, va0); t = ca; t.src += 32; sjob_load(t, va1);
#pragma unroll 1
    for (;;) {
        const bool hb = (p + step) < p1; if (hb) { cb = sjob_addr(a, SJOBS_ATTN + 2 * (p + step), lane); sjob_load(cb, vb0); t = cb; t.src += 32; sjob_load(t, vb1); }
        sjob_store(ca, va0); t = ca; t.dst += 32 * 2048; sjob_store(t, va1);
        if (!hb) break;
        p += step;
        const bool ha = (p + step) < p1; if (ha) { ca = sjob_addr(a, SJOBS_ATTN + 2 * (p + step), lane); sjob_load(ca, va0); t = ca; t.src += 32; sjob_load(t, va1); }
        sjob_store(cb, vb0); t = cb; t.dst += 32 * 2048; sjob_store(t, vb1);
        if (!ha) break;
        p += step;
    }
}
struct BJob { const float* src; unsigned char* dst; int ld, gu, s0; };
__device__ __forceinline__ BJob bjob_addr(const Args& a, int j) {
    BJob c;
    if (j < CONV_JOBS_GU) { const int e = j >> 8, kb = (j >> 4) & 15, nb = j & 15; c.s0 = nb * 256; c.gu = 1;
        c.src = a.w_gate_up + ((size_t)e * 2048 + kb * 128) * 4096 + c.s0; c.ld = 4096; c.dst = (unsigned char*)(a.ws + WS_WGU_T) + (size_t)e * 4096 * 2048 + kb * 128; }
    else { const int jj = j - CONV_JOBS_GU, e = jj >> 7, kb = (jj >> 3) & 15, nb = jj & 7; c.s0 = nb * 256; c.gu = 0;
        c.src = a.w_down + ((size_t)e * 2048 + kb * 128) * 2048 + c.s0; c.ld = 2048; c.dst = (unsigned char*)(a.ws + WS_WD_T) + (size_t)e * 2048 * 2048 + kb * 128; }
    return c;
}
__device__ __forceinline__ void bjob_load(const BJob& c, f32x4 (&v)[16]) {
    int tz = threadIdx.x; asm volatile("" : "+v"(tz));
    const int w = tz >> 6, lane = tz & 63;
#pragma unroll
    for (int r = 0; r < 16; ++r) v[r] = __builtin_nontemporal_load((const f32x4*)(c.src + (size_t)(w * 16 + r) * c.ld + lane * 4));
}
__device__ __forceinline__ void bjob_pack(const f32x4 (&v)[16], u32x4 (&o)[4]) {
#pragma unroll
    for (int jn = 0; jn < 4; ++jn) {
        o[jn].x = pk4_fp8_scaled(v[0][jn], v[1][jn], v[2][jn], v[3][jn]); o[jn].y = pk4_fp8_scaled(v[4][jn], v[5][jn], v[6][jn], v[7][jn]);
        o[jn].z = pk4_fp8_scaled(v[8][jn], v[9][jn], v[10][jn], v[11][jn]); o[jn].w = pk4_fp8_scaled(v[12][jn], v[13][jn], v[14][jn], v[15][jn]); }
}
__device__ __forceinline__ void bjob_out(const BJob& c, const u32x4 (&o)[4], LAS unsigned char* Tlo, LAS unsigned char* Thi) {
    int tz = threadIdx.x; asm volatile("" : "+v"(tz));
    const int tid = tz, w = tid >> 6, lane = tid & 63;
    LAS unsigned char* Tw = (lane < 32) ? Tlo : Thi;
#pragma unroll
    for (int jn = 0; jn < 4; ++jn) { const int nl = (lane & 31) * 4 + jn;
        *(LAS u32x4*)(Tw + nl * 128 + ((w ^ (lane & 7)) << 4)) = o[jn]; }
    asm volatile("s_waitcnt lgkmcnt(0)" ::: "memory"); __builtin_amdgcn_s_barrier(); asm volatile("" ::: "memory");
#pragma unroll
    for (int p = 0; p < 4; ++p) { const int idx = tid + 512 * p, n = idx >> 3, wq = idx & 7;
        const LAS unsigned char* Tr = (n < 128) ? Tlo : Thi;
        const u32x4 ov = *(const LAS u32x4*)(Tr + (n & 127) * 128 + ((wq ^ ((n >> 2) & 7)) << 4));
        const int cc = c.s0 + n; int np = cc;
        if (c.gu) { const int bj = cc >> 11, rem = cc & 2047; np = (rem >> 7) * 256 + bj * 128 + (rem & 127); }
        __builtin_nontemporal_store(ov, (u32x4*)(c.dst + (size_t)np * 2048 + wq * 16)); }
    asm volatile("s_waitcnt lgkmcnt(0)" ::: "memory"); __builtin_amdgcn_s_barrier(); asm volatile("" ::: "memory");
}
#ifndef CONV_IN_ATTN
#define CONV_IN_ATTN 1
#endif
constexpr int BJOB0 = CONV_IN_ATTN ? 16 * 256 + 8 * 16 : 0;
__device__ __forceinline__ void conv_share_blk(const Args& a, LAS unsigned char* lds, int blk, int G) {
    const int s = blk % 3, r = blk / 3, nb = (G - s + 2) / 3, nj = CONV_JOBS - BJOB0, j0 = BJOB0 + s * (nj / 3), j1 = (s == 2) ? CONV_JOBS : BJOB0 + (s + 1) * (nj / 3);
    LAS unsigned char* Tlo = lds + 3 * 16384; LAS unsigned char* Thi = lds + LDS_EXTRA;
    int j = j0 + r; if (j >= j1) return;
    f32x4 v[16]; u32x4 o[4]; BJob cc = bjob_addr(a, j);
    bjob_load(cc, v);
#pragma unroll 1
    for (;;) {
        bjob_pack(v, o);
        const BJob cur = cc; const bool hn = (j + nb) < j1;
        if (hn) { cc = bjob_addr(a, j + nb); bjob_load(cc, v); }
        bjob_out(cur, o, Tlo, Thi);
        if (!hn) break;
        j += nb;
    }
}
__device__ __forceinline__ void conv_all(const Args& a, LAS unsigned char* lds) {
    int buf = 0;
    for (int j = blockIdx.x; j < CONV_JOBS; j += gridDim.x) { conv_block_job(a, lds + buf * 32768, j); buf ^= 1; }
    __syncthreads();
}
__device__ __forceinline__ bool conv_claim(const Args&, int) { return false; }

__device__ __forceinline__ void phase_prologue(const Args& a, LAS unsigned char* lds) {
    const int tid = threadIdx.x, blk = blockIdx.x, G = gridDim.x;
    if (blk < 192) {
        LAS float* cact = (LAS float*)lds; LAS float* red = (LAS float*)(lds + 16384);
        for (int i = tid; i < 4096; i += 512) cact[i] = silu_f(a.c[i]);
        __syncthreads();
        float* mod = (float*)(a.ws + WS_MOD);
        for (int cb = blk; cb < 192; cb += G) {
            const int rg = tid >> 4, cl = tid & 15;
            const float* wp = a.w_ada + (size_t)cb * 64 + cl * 4;
            f32x4 a0 = {0.f, 0.f, 0.f, 0.f}, a1 = {0.f, 0.f, 0.f, 0.f};
#pragma unroll 8
            for (int i = 0; i < 64; ++i) { const int k = rg + 32 * i; const f32x4 w = *(const f32x4*)(wp + (size_t)k * 12288); a0 += w * cact[k]; a1 += w * cact[2048 + k]; }
#pragma unroll
            for (int j = 0; j < 4; ++j) { red[(rg * 2 + 0) * 64 + cl * 4 + j] = a0[j]; red[(rg * 2 + 1) * 64 + cl * 4 + j] = a1[j]; }
            __syncthreads();
            if (tid < 128) { const int b = tid >> 6, col = tid & 63; float s = 0.f; for (int r = 0; r < 32; ++r) s += red[(r * 2 + b) * 64 + col]; mod[b * 12288 + cb * 64 + col] = s + a.b_ada[cb * 64 + col]; }
            __syncthreads();
        }
    }
    {
        float* ct = (float*)(a.ws + WS_ROPE); float* st = ct + 4096 * 64;
        for (int idx = blk * 512 + tid; idx < 4096 * 64; idx += G * 512) {
            const int t = idx >> 6, i = idx & 63;
            const float inv = (float)exp2(-(double)i * (13.287712379549449 / 64.0));
            const float ang = (float)t * inv;
            const double ad = (double)ang, n = rint(ad * 0.15915494309189535), r = fma(-n, 6.283185307179586, ad) - n * 2.4492935982947064e-16;
            const float rf = (float)r;
            ct[idx] = cosf(rf); st[idx] = sinf(rf);
        }
    }
    {
        bf16_t* win_t = (bf16_t*)(a.ws + WS_WIN_T); bf16_t* wout_t = (bf16_t*)(a.ws + WS_WOUT_T);
        for (int job = blk; job < 64 * 16; job += G) {
            const int rt = job >> 4, kt = job & 15;
            const float* src; int ld; bf16_t* dst;
            if (rt < 48) { const int n0 = rt * 128, col0 = n0 < 3072 ? n0 : n0 + 16; src = a.w_in + col0; ld = DIN; dst = win_t + (size_t)n0 * 2048; }
            else { const int n0 = (rt - 48) * 128; src = a.w_out + n0; ld = 2048; dst = wout_t + (size_t)n0 * 2048; }
            conv_job(src, ld, dst, kt);
        }
    }
}

__device__ __forceinline__ void phase_norm1(const Args& a, LAS unsigned char* lds) {
    const int tid = threadIdx.x, blk = blockIdx.x, G = gridDim.x, w = tid >> 6, lane = tid & 63;
    constexpr int HS = 2052;
    LAS float* hs = (LAS float*)lds;
    LAS float* part = (LAS float*)(lds + LDS_EXTRA + 4096);
    LAS float* las = (LAS float*)(lds + LDS_EXTRA);
    const float* mod = (const float*)(a.ws + WS_MOD);
    bf16_t* h1 = (bf16_t*)(a.ws + WS_H1); float* gk = (float*)(a.ws + WS_GK);
    float wl[64];
    { const int kk = lane >> 4, fr = lane & 15; const float* wp = a.w_in + (size_t)(w * 256 + kk) * DIN + 3072 + fr;
#pragma unroll
      for (int ks = 0; ks < 64; ++ks) wl[ks] = wp[(size_t)ks * 4 * DIN]; }
    float w2[16];
#pragma unroll
    for (int j = 0; j < 16; ++j) w2[j] = a.w_alpha2[j * 512 + tid];
    const float bz = a.b_alpha[tid];
    for (int grp = blk; grp < NTOK / 16; grp += G) {
        {
            const int r0 = grp * 16 + 2 * w;
            const f32x4* xr0 = (const f32x4*)(a.x + (size_t)r0 * DM) + lane; const f32x4* xr1 = xr0 + DM / 4;
            f32x4 v0[8], v1[8]; float ss0 = 0.f, ss1 = 0.f;
#pragma unroll
            for (int q = 0; q < 8; ++q) { v0[q] = xr0[64 * q]; v1[q] = xr1[64 * q]; }
#pragma unroll
            for (int q = 0; q < 8; ++q) { ss0 += (v0[q][0] * v0[q][0] + v0[q][1] * v0[q][1]) + (v0[q][2] * v0[q][2] + v0[q][3] * v0[q][3]); ss1 += (v1[q][0] * v1[q][0] + v1[q][1] * v1[q][1]) + (v1[q][2] * v1[q][2] + v1[q][3] * v1[q][3]); }
            ss0 = wave_sum(ss0); ss1 = wave_sum(ss1);
            const float rstd0 = 1.0f / sqrtf(ss0 * (1.0f / DM) + EPS), rstd1 = 1.0f / sqrtf(ss1 * (1.0f / DM) + EPS);
            const float* sh = mod + (size_t)(r0 >> 12) * 12288; const float* sc = sh + 2048;
#pragma unroll
            for (int q = 0; q < 8; ++q) { const int k = 4 * (lane + 64 * q);
                const f32x4 nw = *(const f32x4*)(a.norm1_w + k), scv = *(const f32x4*)(sc + k), shv = *(const f32x4*)(sh + k);
                const f32x4 h0 = (v0[q] * rstd0 * nw) * (scv + 1.0f) + shv, h1v = (v1[q] * rstd1 * nw) * (scv + 1.0f) + shv;
                *(LAS f32x4*)(hs + (2 * w) * HS + k) = h0; *(LAS f32x4*)(hs + (2 * w + 1) * HS + k) = h1v;
                u32x2 o; o.x = cvt_pk_bf16(h0[0], h0[1]); o.y = cvt_pk_bf16(h0[2], h0[3]);
                *(u32x2*)(h1 + (size_t)r0 * DM + k) = o;
                o.x = cvt_pk_bf16(h1v[0], h1v[1]); o.y = cvt_pk_bf16(h1v[2], h1v[3]);
                *(u32x2*)(h1 + (size_t)(r0 + 1) * DM + k) = o; } }
        __syncthreads();
        {
            const int kk = lane >> 4, fr = lane & 15; f32x4 acc = {0.f, 0.f, 0.f, 0.f};
            const LAS float* hp = hs + fr * HS + w * 256 + kk;
#pragma unroll
            for (int ks = 0; ks < 64; ++ks) acc = __builtin_amdgcn_mfma_f32_16x16x4f32(wl[ks], hp[ks * 4], acc, 0, 0, 0);
#pragma unroll
            for (int r = 0; r < 4; ++r) part[(w * 16 + 4 * kk + r) * 16 + fr] = acc[r];
        }
        __syncthreads();
        if (tid < 256) { const int t = tid >> 4, j = tid & 15; float s = 0.f;
#pragma unroll
            for (int q = 0; q < 8; ++q) s += part[(q * 16 + j) * 16 + t];
            las[t * 16 + j] = s; }
        __syncthreads();
        {
#pragma unroll 4
            for (int t = 0; t < 16; ++t) { const LAS f32x4* lp = (const LAS f32x4*)(las + t * 16); float z = bz;
#pragma unroll
                for (int q = 0; q < 4; ++q) { const f32x4 l = lp[q]; z += l[0] * w2[4 * q] + l[1] * w2[4 * q + 1] + l[2] * w2[4 * q + 2] + l[3] * w2[4 * q + 3]; }
                const float ls = fminf(z, 0.f) - log1pf(expf(-fabsf(z)));
                gk[(size_t)(grp * 16 + t) * 512 + tid] = ls * (1.0f / 16.0f); }
        }
        __syncthreads();
    }
}

__device__ __forceinline__ void gla_stage_vt(const bf16_t* proj, int row0, int h, LAS bf16_t* VT, int tid) {
    const int i = tid >> 3, seg = tid & 7;
    const u32x4* vp = (const u32x4*)(proj + (size_t)(row0 + i) * NPROJ + C_VA + h * 256 + seg * 32);
#pragma unroll
    for (int c4 = 0; c4 < 4; ++c4) { const u32x4 vv = vp[c4];
#pragma unroll
        for (int p = 0; p < 4; ++p) { const unsigned wd = vv[p]; const int e = seg * 32 + c4 * 8 + p * 2;
            VT[e * 72 + i] = (bf16_t)(wd & 0xffffu); VT[(e + 1) * 72 + i] = (bf16_t)(wd >> 16); } }
}
__device__ __forceinline__ void gla1_unit(const Args& a, LAS unsigned char* lds, int u) {
    const int tid = threadIdx.x, w = tid >> 6, lane = tid & 63;
    const int bh = u >> 6, c = u & 63, b = bh >> 2, h = bh & 3, row0 = b * SEQ + c * 64;
    LAS float* Bm = (LAS float*)lds; LAS bf16_t* KT = (LAS bf16_t*)(lds + 32768); LAS bf16_t* VT = (LAS bf16_t*)(lds + 51200);
    const float* gk = (const float*)(a.ws + WS_GK); const bf16_t* proj = (const bf16_t*)(a.ws + WS_PROJ);
    float* bcum = (float*)(a.ws + WS_BCUM); float* dst = (float*)(a.ws + WS_DST); float* dec = (float*)(a.ws + WS_DEC);
    const int i = tid >> 3, seg = tid & 7;
    {
        const f32x4* gp = (const f32x4*)(gk + (size_t)(row0 + i) * 512 + h * 128 + seg * 16);
#pragma unroll
        for (int q = 0; q < 4; ++q) *(LAS f32x4*)(Bm + i * 128 + seg * 16 + q * 4) = gp[q];
    }
    __syncthreads();
    {
        const int d = tid & 127, q4 = tid >> 7; LAS float* qs = (LAS float*)(lds + 90112);
        float run = 0.f;
#pragma unroll
        for (int ii = 0; ii < 16; ++ii) { run += Bm[(q4 * 16 + ii) * 128 + d]; Bm[(q4 * 16 + ii) * 128 + d] = run; }
        qs[q4 * 128 + d] = run;
        __syncthreads();
        float off = 0.f;
#pragma unroll
        for (int qq = 0; qq < 3; ++qq) off += (qq < q4) ? qs[qq * 128 + d] : 0.f;
        if (q4 > 0) {
#pragma unroll
            for (int ii = 0; ii < 16; ++ii) Bm[(q4 * 16 + ii) * 128 + d] += off; }
    }
    __syncthreads();
    {
        const u32x4* kp = (const u32x4*)(proj + (size_t)(row0 + i) * NPROJ + C_KA + h * 128 + seg * 16);
        float* bo = bcum + ((size_t)u * 64 + i) * 128 + seg * 16;
#pragma unroll
        for (int q = 0; q < 2; ++q) { const u32x4 kv = kp[q];
#pragma unroll
            for (int p = 0; p < 4; ++p) { const int d = seg * 16 + q * 8 + p * 2;
                const float b0 = Bm[i * 128 + d], b1 = Bm[i * 128 + d + 1], l0 = Bm[63 * 128 + d], l1 = Bm[63 * 128 + d + 1];
                bo[q * 8 + p * 2] = b0; bo[q * 8 + p * 2 + 1] = b1;
                KT[d * 72 + i] = f2bf(bflo(kv[p]) * expf(l0 - b0)); KT[(d + 1) * 72 + i] = f2bf(bfhi(kv[p]) * expf(l1 - b1));
                if (i == 63) { dec[(size_t)u * 128 + d] = expf(l0); dec[(size_t)u * 128 + d + 1] = expf(l1); } } }
        gla_stage_vt(proj, row0, h, VT, tid);
    }
    __syncthreads();
    {
        f32x4 acc[2][8];
#pragma unroll
        for (int x = 0; x < 2; ++x)
#pragma unroll
            for (int y = 0; y < 8; ++y) acc[x][y] = (f32x4){0.f, 0.f, 0.f, 0.f};
#pragma unroll
        for (int ks = 0; ks < 2; ++ks) {
            const bf16x8 a0 = lds_frag(VT, 72, (2 * w) * 16, ks * 32, lane), a1 = lds_frag(VT, 72, (2 * w + 1) * 16, ks * 32, lane);
#pragma unroll
            for (int dt = 0; dt < 8; ++dt) { const bf16x8 bf = lds_frag(KT, 72, dt * 16, ks * 32, lane); acc[0][dt] = mfma16(a0, bf, acc[0][dt]); acc[1][dt] = mfma16(a1, bf, acc[1][dt]); }
        }
        float* dp = dst + (size_t)u * 32768;
#pragma unroll
        for (int x = 0; x < 2; ++x)
#pragma unroll
            for (int dt = 0; dt < 8; ++dt)
#pragma unroll
                for (int r = 0; r < 4; ++r) dp[((2 * w + x) * 16 + 4 * (lane >> 4) + r) * 128 + dt * 16 + (lane & 15)] = acc[x][dt][r];
    }
    __syncthreads();
}
__device__ __forceinline__ void moba_prep_unit(const Args& a, LAS unsigned char* lds, int u2) {
    const int tid = threadIdx.x;
    const int bh = u2 >> 4, kb = u2 & 15, b = bh >> 3, h = bh & 7, row0 = b * SEQ + kb * 256, t0 = kb * 256;
    const bf16_t* proj = (const bf16_t*)(a.ws + WS_PROJ);
    const float* ct = (const float*)(a.ws + WS_ROPE); const float* st = ct + 4096 * 64;
    bf16_t* qbr = (bf16_t*)(a.ws + WS_QBR); bf16_t* kbr = (bf16_t*)(a.ws + WS_KBR); bf16_t* vbt = (bf16_t*)(a.ws + WS_VBT); float* kmean = (float*)(a.ws + WS_KMEAN);
    constexpr int KS = 132;
    LAS float* Kf = (LAS float*)lds;
    LAS float* part = (LAS float*)(lds + 135168);
    LAS bf16_t* Vl = (LAS bf16_t*)(lds + 139264);
    const int rl = tid >> 3, c = tid & 7;
#pragma unroll 1
    for (int pass = 0; pass < 4; ++pass) { const int row = pass * 64 + rl;
        const f32x4 cv0 = *(const f32x4*)(ct + (size_t)(t0 + row) * 64 + c * 8), cv1 = *(const f32x4*)(ct + (size_t)(t0 + row) * 64 + c * 8 + 4);
        const f32x4 sv0 = *(const f32x4*)(st + (size_t)(t0 + row) * 64 + c * 8), sv1 = *(const f32x4*)(st + (size_t)(t0 + row) * 64 + c * 8 + 4);
#pragma unroll
        for (int which = 0; which < 2; ++which) {
            const bf16_t* src = proj + (size_t)(row0 + row) * NPROJ + (which == 0 ? C_KB : C_QB) + h * 128 + c * 8;
            bf16_t* dsto = (which == 0 ? kbr : qbr) + ((size_t)bh * SEQ + t0 + row) * 128 + c * 8;
            const u32x4 x1 = *(const u32x4*)src, x2 = *(const u32x4*)(src + 64);
            u32x4 o1, o2; float r1[8], r2[8];
#pragma unroll
            for (int p = 0; p < 4; ++p) {
                const float c0 = (p < 2) ? cv0[2 * p] : cv1[2 * p - 4], c1 = (p < 2) ? cv0[2 * p + 1] : cv1[2 * p - 3], s0 = (p < 2) ? sv0[2 * p] : sv1[2 * p - 4], s1 = (p < 2) ? sv0[2 * p + 1] : sv1[2 * p - 3];
                const float a0 = bflo(x1[p]), a1 = bfhi(x1[p]), b0 = bflo(x2[p]), b1 = bfhi(x2[p]);
                r1[2 * p] = a0 * c0 - b0 * s0; r1[2 * p + 1] = a1 * c1 - b1 * s1; r2[2 * p] = a0 * s0 + b0 * c0; r2[2 * p + 1] = a1 * s1 + b1 * c1;
                o1[p] = cvt_pk_bf16(r1[2 * p], r1[2 * p + 1]); o2[p] = cvt_pk_bf16(r2[2 * p], r2[2 * p + 1]); }
            *(u32x4*)dsto = o1; *(u32x4*)(dsto + 64) = o2;
            if (which == 0) { LAS float* kr = Kf + row * KS + c * 8;
                *(LAS f32x4*)kr = (f32x4){r1[0], r1[1], r1[2], r1[3]}; *(LAS f32x4*)(kr + 4) = (f32x4){r1[4], r1[5], r1[6], r1[7]};
                *(LAS f32x4*)(kr + 64) = (f32x4){r2[0], r2[1], r2[2], r2[3]}; *(LAS f32x4*)(kr + 68) = (f32x4){r2[4], r2[5], r2[6], r2[7]}; }
        }
    }
    __syncthreads();
    { const int d = tid & 127, rq = tid >> 7; float s = 0.f;
#pragma unroll 8
        for (int rr = 0; rr < 64; ++rr) s += Kf[(rq * 64 + rr) * KS + d];
        part[rq * 128 + d] = s; }
    __syncthreads();
    if (tid < 128) kmean[((size_t)bh * 16 + kb) * 128 + tid] = (part[tid] + part[128 + tid] + part[256 + tid] + part[384 + tid]) * (1.0f / 256.0f);
#pragma unroll 1
    for (int sl = 0; sl < 4; ++sl) {
        { const int rw = tid >> 2, c4 = tid & 3;
#pragma unroll
            for (int ps = 0; ps < 2; ++ps) { const int row = ps * 128 + rw;
                const u32x4 vv = *(const u32x4*)(proj + (size_t)(row0 + row) * NPROJ + C_VB + h * 128 + sl * 32 + c4 * 8);
                *(LAS u32x4*)(Vl + row * 40 + (((c4 + (row >> 4)) & 3) << 3)) = vv; } }
        __syncthreads();
        { const int d = tid >> 4, tc = tid & 15;
            u32x4 o0, o1;
            const int dp = ((((d >> 3) + tc) & 3) << 3) + (d & 7);
#pragma unroll
            for (int p = 0; p < 4; ++p) { const int tt = tc * 16 + p * 2; o0[p] = (unsigned)Vl[tt * 40 + dp] | ((unsigned)Vl[(tt + 1) * 40 + dp] << 16);
                o1[p] = (unsigned)Vl[(tt + 8) * 40 + dp] | ((unsigned)Vl[(tt + 9) * 40 + dp] << 16); }
            bf16_t* op = vbt + ((size_t)bh * 128 + sl * 32 + d) * SEQ + t0 + tc * 16;
            *(u32x4*)op = o0; *(u32x4*)(op + 8) = o1; }
        __syncthreads();
    }
}
__device__ __forceinline__ void phase_mix_prep(const Args& a, LAS unsigned char* lds) {
    const int blk = blockIdx.x, G = gridDim.x;
    for (int u = blk; u < 512; u += G) gla1_unit(a, lds, u);
    for (int u2 = blk; u2 < 256; u2 += G) moba_prep_unit(a, lds, u2);
}

__device__ __forceinline__ void phase_scan_select(const Args& a, LAS unsigned char* lds) {
    const int tid = threadIdx.x, blk = blockIdx.x, G = gridDim.x;
    {
        const float* dst = (const float*)(a.ws + WS_DST); const float* dec = (const float*)(a.ws + WS_DEC); bf16_t* ST = (bf16_t*)(a.ws + WS_ST);
        for (int el = blk * 512 + tid; el < 8 * 32768; el += G * 512) {
            const int bh = el >> 15, ed = el & 32767, d = ed & 127; float cur = 0.f;
#pragma unroll 8
            for (int c = 0; c < 64; ++c) { const size_t u = (size_t)bh * 64 + c; ST[u * 32768 + ed] = f2bf(cur); cur = dec[u * 128 + d] * cur + dst[u * 32768 + ed]; }
        }
    }
    {
        const float* kmean = (const float*)(a.ws + WS_KMEAN); const bf16_t* qbr = (const bf16_t*)(a.ws + WS_QBR); unsigned* sel = (unsigned*)(a.ws + WS_SEL);
        LAS float* km = (LAS float*)lds;
        for (int u2 = blk; u2 < 256; u2 += G) {
            const int bh = u2 >> 4, qb = u2 & 15;
            __syncthreads();
            for (int i = tid; i < 2048; i += 512) km[i] = kmean[(size_t)bh * 2048 + i];
            __syncthreads();
            const int q = tid >> 1, half = tid & 1;
            float gv[8];
#pragma unroll
            for (int n = 0; n < 8; ++n) gv[n] = 0.f;
            const u32x4* qp = (const u32x4*)(qbr + ((size_t)bh * SEQ + qb * 256 + q) * 128);
#pragma unroll 4
            for (int c = 0; c < 16; ++c) { const u32x4 qq = qp[c]; float qf[8];
#pragma unroll
                for (int p = 0; p < 4; ++p) { qf[2 * p] = bflo(qq[p]); qf[2 * p + 1] = bfhi(qq[p]); }
#pragma unroll
                for (int n = 0; n < 8; ++n) { const LAS float* kr = km + (half * 8 + n) * 128 + c * 8; const f32x4 k0 = *(const LAS f32x4*)kr, k1 = *(const LAS f32x4*)(kr + 4);
                    gv[n] += (qf[0] * k0[0] + qf[1] * k0[1]) + (qf[2] * k0[2] + qf[3] * k0[3]) + (qf[4] * k1[0] + qf[5] * k1[1]) + (qf[6] * k1[2] + qf[7] * k1[3]); } }
            float ga[16];
#pragma unroll
            for (int n = 0; n < 8; ++n) { const float o = __shfl_xor(gv[n], 1); ga[n] = half ? o : gv[n]; ga[8 + n] = half ? gv[n] : o; }
            unsigned mask = 0u; const int nsel = qb < 3 ? qb : 3;
            for (int s = 0; s < nsel; ++s) { int best = -1; float bv = -INFINITY;
#pragma unroll
                for (int n = 0; n < 16; ++n) { const bool ok = (n < qb) && !((mask >> n) & 1u) && (best < 0 || ga[n] > bv); if (ok) { bv = ga[n]; best = n; } }
                mask |= 1u << best; }
            if (half == 0) sel[(size_t)bh * SEQ + qb * 256 + q] = mask;
        }
        __syncthreads();
    }
}

#ifndef CHECK_MODE
#define CHECK_MODE 0
#endif
constexpr size_t WS_CHK = 18432;
constexpr size_t WS_CHKO = WS_Y + 160 * MB;
#if CHECK_MODE
__device__ __forceinline__ void phase_check(const Args& a, LAS unsigned char* lds) {
    const int tid = threadIdx.x, blk = blockIdx.x, G = gridDim.x, w = tid >> 6, lane = tid & 63;
    const bf16_t* proj = (const bf16_t*)(a.ws + WS_PROJ); const bf16_t* ocat = (const bf16_t*)(a.ws + WS_OCAT);
    float* chk = (float*)(a.ws + WS_CHK);
#if CHECK_MODE == 1
    const float* ct = (const float*)(a.ws + WS_ROPE); const float* st = ct + 4096 * 64;
    for (int task = blk * 8 + w; task < 67 * 16; task += G * 8) {
        const int s = task >> 4, bh = task & 15, b = bh >> 3, h = bh & 7, t = 61 * s + 7, qblk = t >> 8;
        const bf16_t* qrow = proj + (size_t)(b * SEQ + t) * NPROJ + C_QB + h * 128;
        const float c = ct[t * 64 + lane], sn = st[t * 64 + lane];
        const float q1 = bf2f(qrow[lane]), q2 = bf2f(qrow[lane + 64]);
        const float qa = q1 * c - q2 * sn, qb2 = q1 * sn + q2 * c;
        float gate[16];
#pragma unroll 1
        for (int n = 0; n < 16; ++n) { float g = -INFINITY;
            if (n < qblk) { float m1 = 0.f, m2 = 0.f;
                for (int kk = 0; kk < 256; ++kk) { const int tk = n * 256 + kk; const bf16_t* krow = proj + (size_t)(b * SEQ + tk) * NPROJ + C_KB + h * 128;
                    const float k1 = bf2f(krow[lane]), k2 = bf2f(krow[lane + 64]), ck = ct[tk * 64 + lane], sk = st[tk * 64 + lane];
                    m1 += k1 * ck - k2 * sk; m2 += k1 * sk + k2 * ck; }
                g = wave_sum(qa * (m1 * (1.0f / 256.0f)) + qb2 * (m2 * (1.0f / 256.0f))); }
#pragma unroll
            for (int z = 0; z < 16; ++z) if (z == n) gate[z] = g; }
        unsigned mask = 0u; const int nsel = qblk < 3 ? qblk : 3;
        for (int it = 0; it < nsel; ++it) { int best = -1; float bv = -INFINITY;
#pragma unroll
            for (int n = 0; n < 16; ++n) { const bool ok = (n < qblk) && !((mask >> n) & 1u) && (best < 0 || gate[n] > bv); if (ok) { bv = gate[n]; best = n; } }
            mask |= 1u << best; }
        { const unsigned fastsel = ((const unsigned*)(a.ws + WS_SEL))[(size_t)bh * SEQ + t];
          if (fastsel != mask) { if (lane == 0) atomicAdd(&chk[2], 1.0f); continue; } }
        mask |= 1u << qblk;
        float m = -INFINITY, l = 0.f, o1 = 0.f, o2 = 0.f;
        for (int n = 0; n <= qblk; ++n) { if (!((mask >> n) & 1u)) continue;
            for (int kk = 0; kk < 256; ++kk) { const int tk = n * 256 + kk; if (tk > t) break;
                const bf16_t* krow = proj + (size_t)(b * SEQ + tk) * NPROJ + C_KB + h * 128; const bf16_t* vrow = proj + (size_t)(b * SEQ + tk) * NPROJ + C_VB + h * 128;
                const float k1 = bf2f(krow[lane]), k2 = bf2f(krow[lane + 64]), ck = ct[tk * 64 + lane], sk = st[tk * 64 + lane];
                const float sc = wave_sum(qa * (k1 * ck - k2 * sk) + qb2 * (k1 * sk + k2 * ck)) * 0.08838834764831845f;
                const float mn = fmaxf(m, sc), al = expf(m - mn), p = expf(sc - mn);
                l = l * al + p; o1 = o1 * al + p * bf2f(vrow[lane]); o2 = o2 * al + p * bf2f(vrow[lane + 64]); m = mn; } }
        o1 /= l; o2 /= l;
        const bf16_t* frow = ocat + (size_t)(b * SEQ + t) * DM + 1024 + h * 128;
        const float f1 = bf2f(frow[lane]), f2 = bf2f(frow[lane + 64]);
        const float num = wave_sum((f1 - o1) * (f1 - o1) + (f2 - o2) * (f2 - o2)), den = wave_sum(o1 * o1 + o2 * o2);
        if (lane == 0) { atomicAdd(&chk[0], num); atomicAdd(&chk[1], den); }
    }
#else
    const int cb = 1, ch = 2; const float* gk = (const float*)(a.ws + WS_GK); float* oref = (float*)(a.ws + WS_CHKO);
    for (int e = blk * 8 + w; e < 256; e += G * 8) {
        float s1 = 0.f, s2 = 0.f;
        for (int t = 0; t < SEQ; ++t) { const size_t row = (size_t)(cb * SEQ + t);
            const bf16_t* pr = proj + row * NPROJ;
            const float a1 = expf(gk[row * 512 + ch * 128 + lane]), a2 = expf(gk[row * 512 + ch * 128 + lane + 64]);
            const float k1 = bf2f(pr[C_KA + ch * 128 + lane]), k2 = bf2f(pr[C_KA + ch * 128 + lane + 64]), v = bf2f(pr[C_VA + ch * 256 + e]);
            const float q1 = bf2f(pr[C_QA + ch * 128 + lane]) * 0.08838834764831845f, q2 = bf2f(pr[C_QA + ch * 128 + lane + 64]) * 0.08838834764831845f;
            s1 = a1 * s1 + k1 * v; s2 = a2 * s2 + k2 * v;
            const float o = wave_sum(q1 * s1 + q2 * s2);
            if (lane == 0) oref[(size_t)t * 256 + e] = o; }
    }
#endif
}
__device__ __forceinline__ void phase_check2(const Args& a, LAS unsigned char* lds) {
#if CHECK_MODE == 2
    const int tid = threadIdx.x, blk = blockIdx.x, G = gridDim.x, w = tid >> 6, lane = tid & 63;
    const int cb = 1, ch = 2; const float* oref = (const float*)(a.ws + WS_CHKO); float* chk = (float*)(a.ws + WS_CHK);
    const bf16_t* proj = (const bf16_t*)(a.ws + WS_PROJ); const bf16_t* ocat = (const bf16_t*)(a.ws + WS_OCAT);
    for (int t = blk * 8 + w; t < SEQ; t += G * 8) { float o[4], ss = 0.f;
#pragma unroll
        for (int q = 0; q < 4; ++q) { o[q] = oref[(size_t)t * 256 + lane + 64 * q]; ss += o[q] * o[q]; }
        ss = wave_sum(ss); const float rstd = 1.0f / sqrtf(ss * (1.0f / 256.0f) + EPS); float num = 0.f, den = 0.f;
#pragma unroll
        for (int q = 0; q < 4; ++q) { const int e = lane + 64 * q; const size_t row = (size_t)(cb * SEQ + t);
            const float ga = bf2f(proj[row * NPROJ + C_GA + ch * 256 + e]), ref = o[q] * rstd * a.gla_norm_w[e] * silu_f(ga), f = bf2f(ocat[row * DM + ch * 256 + e]);
            num += (f - ref) * (f - ref); den += ref * ref; }
        num = wave_sum(num); den = wave_sum(den);
        if (lane == 0) { atomicAdd(&chk[0], num); atomicAdd(&chk[1], den); } }
#endif
}
#endif
#ifndef PROBE_TIME
#define PROBE_TIME -1
#endif
#ifndef PROBE_TOFF
#define PROBE_TOFF 0.0f
#endif
#ifndef PROBE_TSCALE
#define PROBE_TSCALE 3000.0f
#endif
#ifndef CONV_IN_GEMM
#define CONV_IN_GEMM 1
#endif
#ifndef CONV_IN_ATTN
#define CONV_IN_ATTN 1
#endif
#ifndef CONV_BLK
#define CONV_BLK 1
#endif

__device__ __forceinline__ void gla3_unit(const Args& a, LAS unsigned char* lds, int u) {
    const int tid = threadIdx.x, w = tid >> 6, lane = tid & 63, g = lane >> 4, fr = lane & 15;
    const int bh = u >> 6, c = u & 63, b = bh >> 2, h = bh & 3, row0 = b * SEQ + c * 64;
    LAS bf16_t* QP = (LAS bf16_t*)lds; LAS bf16_t* KP = (LAS bf16_t*)(lds + 17408); LAS bf16_t* VT = (LAS bf16_t*)(lds + 34816);
    LAS bf16_t* AM = (LAS bf16_t*)(lds + 71680); LAS float* OT = (LAS float*)(lds + 81920);
    const bf16_t* proj = (const bf16_t*)(a.ws + WS_PROJ); const float* bcum = (const float*)(a.ws + WS_BCUM); const bf16_t* ST = (const bf16_t*)(a.ws + WS_ST);
    bf16_t* ocat = (bf16_t*)(a.ws + WS_OCAT);
    {
        const int i = tid >> 3, seg = tid & 7;
        const f32x4* bp = (const f32x4*)(bcum + ((size_t)u * 64 + i) * 128 + seg * 16);
        const u32x4* qp = (const u32x4*)(proj + (size_t)(row0 + i) * NPROJ + C_QA + h * 128 + seg * 16);
        const u32x4* kp = (const u32x4*)(proj + (size_t)(row0 + i) * NPROJ + C_KA + h * 128 + seg * 16);
#pragma unroll
        for (int q = 0; q < 2; ++q) { const u32x4 qv = qp[q], kv = kp[q]; const f32x4 b0 = bp[2 * q], b1 = bp[2 * q + 1]; u32x4 qo, ko;
#pragma unroll
            for (int p = 0; p < 4; ++p) { const float bl = (p < 2) ? b0[2 * p] : b1[2 * p - 4], bhv = (p < 2) ? b0[2 * p + 1] : b1[2 * p - 3];
                const float el = expf(bl), eh = expf(bhv);
                qo[p] = cvt_pk_bf16(bflo(qv[p]) * el * 0.08838834764831845f, bfhi(qv[p]) * eh * 0.08838834764831845f);
                ko[p] = cvt_pk_bf16(bflo(kv[p]) / el, bfhi(kv[p]) / eh); }
            *(LAS u32x4*)(QP + i * 136 + seg * 16 + q * 8) = qo; *(LAS u32x4*)(KP + i * 136 + seg * 16 + q * 8) = ko; }
        gla_stage_vt(proj, row0, h, VT, tid);
    }
    __syncthreads();
    {
        const int it = w >> 1;
#pragma unroll
        for (int jj = 0; jj < 2; ++jj) { const int jt = (w & 1) * 2 + jj; f32x4 acc = {0.f, 0.f, 0.f, 0.f};
            if (jt <= it) {
#pragma unroll
                for (int ks = 0; ks < 4; ++ks) acc = mfma16(lds_frag(QP, 136, it * 16, ks * 32, lane), lds_frag(KP, 136, jt * 16, ks * 32, lane), acc);
            }
#pragma unroll
            for (int r = 0; r < 4; ++r) { const int i = it * 16 + 4 * g + r, j = jt * 16 + fr; AM[i * 72 + j] = f2bf((j <= i) ? acc[r] : 0.f); } }
    }
    __syncthreads();
    f32x4 acc[4][2];
    {
#pragma unroll
        for (int x = 0; x < 4; ++x)
#pragma unroll
            for (int y = 0; y < 2; ++y) acc[x][y] = (f32x4){0.f, 0.f, 0.f, 0.f};
        bf16x8 bS[2][4];
        const bf16_t* stp = ST + (size_t)u * 32768;
#pragma unroll
        for (int e2 = 0; e2 < 2; ++e2)
#pragma unroll
            for (int ks = 0; ks < 4; ++ks) bS[e2][ks] = *(const bf16x8*)(stp + ((2 * w + e2) * 16 + fr) * 128 + ks * 32 + 8 * g);
#pragma unroll
        for (int it = 0; it < 4; ++it) {
#pragma unroll
            for (int ks = 0; ks < 4; ++ks) { const bf16x8 aq = lds_frag(QP, 136, it * 16, ks * 32, lane); acc[it][0] = mfma16(aq, bS[0][ks], acc[it][0]); acc[it][1] = mfma16(aq, bS[1][ks], acc[it][1]); }
#pragma unroll
            for (int k2 = 0; k2 < 2; ++k2) { const bf16x8 aa = lds_frag(AM, 72, it * 16, k2 * 32, lane);
                acc[it][0] = mfma16(aa, lds_frag(VT, 72, (2 * w) * 16, k2 * 32, lane), acc[it][0]); acc[it][1] = mfma16(aa, lds_frag(VT, 72, (2 * w + 1) * 16, k2 * 32, lane), acc[it][1]); }
        }
#pragma unroll
        for (int it = 0; it < 4; ++it)
#pragma unroll
            for (int r = 0; r < 4; ++r)
#pragma unroll
                for (int e2 = 0; e2 < 2; ++e2) OT[(it * 16 + 4 * g + r) * 260 + (2 * w + e2) * 16 + fr] = acc[it][e2][r];
    }
    __syncthreads();
    {
        const int i = tid >> 3, seg = tid & 7;
        const LAS float* orow = OT + i * 260 + seg * 32;
        f32x4 ov[8]; float ss = 0.f;
#pragma unroll
        for (int q = 0; q < 8; ++q) { ov[q] = *(const LAS f32x4*)(orow + 4 * q); ss += (ov[q][0] * ov[q][0] + ov[q][1] * ov[q][1]) + (ov[q][2] * ov[q][2] + ov[q][3] * ov[q][3]); }
        ss += __shfl_xor(ss, 1); ss += __shfl_xor(ss, 2); ss += __shfl_xor(ss, 4);
        const float rstd = 1.0f / sqrtf(ss * (1.0f / 256.0f) + EPS);
        const u32x4* gp = (const u32x4*)(proj + (size_t)(row0 + i) * NPROJ + C_GA + h * 256 + seg * 32);
        bf16_t* op = ocat + (size_t)(row0 + i) * DM + h * 256 + seg * 32;
#pragma unroll
        for (int c8 = 0; c8 < 4; ++c8) { const u32x4 gv = gp[c8]; u32x4 o;
            const f32x4 nw0 = *(const f32x4*)(a.gla_norm_w + seg * 32 + c8 * 8), nw1 = *(const f32x4*)(a.gla_norm_w + seg * 32 + c8 * 8 + 4);
#pragma unroll
            for (int pp = 0; pp < 4; ++pp) { const float g0 = bflo(gv[pp]), g1 = bfhi(gv[pp]);
                const float n0 = (pp < 2) ? nw0[2 * pp] : nw1[2 * pp - 4], n1 = (pp < 2) ? nw0[2 * pp + 1] : nw1[2 * pp - 3];
                const float v0 = ((pp & 1) ? ov[2 * c8 + (pp >> 1)][2] : ov[2 * c8 + (pp >> 1)][0]) * rstd * n0 * silu_f(g0);
                const float v1 = ((pp & 1) ? ov[2 * c8 + (pp >> 1)][3] : ov[2 * c8 + (pp >> 1)][1]) * rstd * n1 * silu_f(g1);
#if FP8_EMU
                o[pp] = cvt_pk_bf16(q8(v0), q8(v1));
#else
                o[pp] = cvt_pk_bf16(v0, v1);
#endif
            }
            *(u32x4*)(op + c8 * 8) = o; }
    }
    __syncthreads();
}

typedef short s16x4 __attribute__((ext_vector_type(4)));
__device__ __forceinline__ void moba_attn_unit(const Args& a, LAS unsigned char* lds, int bh, int qb, int half, int cjob0) {
    const int tid = threadIdx.x, w = tid >> 6, lane = tid & 63, g = lane >> 4, fr = lane & 15;
    bh = __builtin_amdgcn_readfirstlane(bh); qb = __builtin_amdgcn_readfirstlane(qb); half = __builtin_amdgcn_readfirstlane(half);
    const int b = bh >> 3, h = bh & 7, rg = w & 3, par = w >> 2, qbase = 128 * half + 32 * rg;
    const bf16_t* qbr = (const bf16_t*)(a.ws + WS_QBR); const bf16_t* kbr = (const bf16_t*)(a.ws + WS_KBR); const bf16_t* vbt = (const bf16_t*)(a.ws + WS_VBT);
    const unsigned* sel = (const unsigned*)(a.ws + WS_SEL); bf16_t* ocat = (bf16_t*)(a.ws + WS_OCAT);
    const int nown = 2 * half + 2, nsteps = (nown + 4 * qb) >> 1;
    bf16x8 qf[2][4]; unsigned sm[2]; float m[2], l[2]; f32x4 O[8][2];
#pragma unroll
    for (int b2 = 0; b2 < 2; ++b2) { const size_t qrow = (size_t)bh * SEQ + qb * 256 + qbase + 16 * b2 + fr;
#pragma unroll
        for (int ks = 0; ks < 4; ++ks) qf[b2][ks] = *(const bf16x8*)(qbr + qrow * 128 + ks * 32 + 8 * g);
        sm[b2] = sel[qrow]; m[b2] = -INFINITY; l[b2] = 0.f;
#pragma unroll
        for (int dt = 0; dt < 8; ++dt) O[dt][b2] = (f32x4){0.f, 0.f, 0.f, 0.f}; }
    const float cs = 0.08838834764831845f * 1.4426950408889634f;
    unsigned kso[2], vso[2];
#pragma unroll
    for (int p = 0; p < 2; ++p) { const int kr = 4 * (w + 8 * p) + (lane >> 4), kc = (lane & 15) ^ (kr & 15); kso[p] = (unsigned)(kr * 256 + kc * 16);
        const int vr = 8 * (w + 8 * p) + (lane >> 3), vc = (lane & 7) ^ ((vr >> 1) & 7); vso[p] = (unsigned)(vr * (SEQ * 2) + vc * 16); }
    const char* kbase = (const char*)(kbr + (size_t)bh * SEQ * 128); const char* vbase = (const char*)(vbt + (size_t)bh * 128 * SEQ);
    auto tile_jk = [&](int ti, int& j, int& kt) { if (ti < nown) { j = qb; kt = ti; } else { const int tj = ti - nown; j = tj >> 2; kt = tj & 3; } };
    auto stage = [&](int s) {
#pragma unroll
        for (int t2 = 0; t2 < 2; ++t2) { int j, kt; tile_jk(2 * s + t2, j, kt); const int key0 = j * 256 + kt * 64;
            LAS unsigned char* dstb = lds + (s & 1) * 65536 + t2 * 32768 + w * 1024;
            const char* ks = pg8::sbase(kbase + (size_t)key0 * 256); const char* vs = pg8::sbase(vbase + (size_t)key0 * 2);
#pragma unroll
            for (int p = 0; p < 2; ++p) {
                __builtin_amdgcn_global_load_lds((const unsigned*)(ks + kso[p]), (LAS unsigned*)(dstb + p * 8192), 16, 0, 0);
                __builtin_amdgcn_global_load_lds((const unsigned*)(vs + vso[p]), (LAS unsigned*)(dstb + 16384 + p * 8192), 16, 0, 0); } } };
    __syncthreads();
    stage(0);
    f32x4 cv[8]; const int cjob = __builtin_amdgcn_readfirstlane(cjob0);
    if (CONV_IN_ATTN) { const SJob cj = sjob_addr(a, cjob, lane); sjob_load(cj, cv); }
#pragma unroll 1
    for (int s = 0; s < nsteps; ++s) {
        asm volatile("s_waitcnt vmcnt(0)" ::: "memory");
        __syncthreads();
        if (s + 1 < nsteps) stage(s + 1);
        if (CONV_IN_ATTN) { { const SJob cj = sjob_addr(a, cjob + 8 * s, lane); sjob_store(cj, cv); } if (s + 1 < nsteps) { const SJob cn = sjob_addr(a, cjob + 8 * (s + 1), lane); sjob_load(cn, cv); } }
        int j, kt; tile_jk(2 * s + par, j, kt);
        const bool own = (2 * s + par) < nown;
        if (own && kt * 64 > qbase + 31) continue;
        const LAS unsigned char* Kb = lds + (s & 1) * 65536 + par * 32768; const LAS unsigned char* Vb = Kb + 16384;
        f32x4 sc[4][2];
#pragma unroll
        for (int t4 = 0; t4 < 4; ++t4) { sc[t4][0] = (f32x4){0.f, 0.f, 0.f, 0.f}; sc[t4][1] = (f32x4){0.f, 0.f, 0.f, 0.f};
#pragma unroll
            for (int ks = 0; ks < 4; ++ks) { const bf16x8 kf = *(const LAS bf16x8*)(Kb + (t4 * 16 + fr) * 256 + (((ks * 4 + g) ^ fr) << 4)); sc[t4][0] = mfma16(kf, qf[0][ks], sc[t4][0]); sc[t4][1] = mfma16(kf, qf[1][ks], sc[t4][1]); } }
        bf16x8 pf[2][2];
#pragma unroll
        for (int b2 = 0; b2 < 2; ++b2) {
            float tm = -INFINITY, nb;
            if (own) {
                const int qi = qbase + 16 * b2 + fr;
#pragma unroll
                for (int t4 = 0; t4 < 4; ++t4)
#pragma unroll
                    for (int r = 0; r < 4; ++r) { const int kk = kt * 64 + t4 * 16 + 4 * g + r; const float v = (kk <= qi) ? sc[t4][b2][r] : -INFINITY; sc[t4][b2][r] = v; tm = fmaxf(tm, v); }
            } else {
#pragma unroll
                for (int t4 = 0; t4 < 4; ++t4)
#pragma unroll
                    for (int r = 0; r < 4; ++r) tm = fmaxf(tm, sc[t4][b2][r]);
                if (!((sm[b2] >> j) & 1u)) tm = -INFINITY;
            }
            tm = fmaxf(tm, __shfl_xor(tm, 16)); tm = fmaxf(tm, __shfl_xor(tm, 32));
            if (__builtin_amdgcn_ballot_w64((tm - m[b2]) * cs > 11.5416f) != 0ull) {
                const float mnew = fmaxf(m[b2], tm), ms = (mnew == -INFINITY) ? 0.f : mnew;
                const float alpha = __builtin_amdgcn_exp2f((m[b2] - ms) * cs);
                l[b2] *= alpha; m[b2] = mnew;
#pragma unroll
                for (int dt = 0; dt < 8; ++dt) O[dt][b2] *= alpha;
            }
            nb = (m[b2] == -INFINITY) ? 0.f : -m[b2] * cs; if (!own && !((sm[b2] >> j) & 1u)) nb = -INFINITY;
            float ps = 0.f;
#pragma unroll
            for (int t4 = 0; t4 < 4; ++t4)
#pragma unroll
                for (int r = 0; r < 4; ++r) { const float pe = __builtin_amdgcn_exp2f(fmaf(sc[t4][b2][r], cs, nb)); sc[t4][b2][r] = pe; ps += pe; }
            ps += __shfl_xor(ps, 16); ps += __shfl_xor(ps, 32);
            l[b2] += ps;
#pragma unroll
            for (int k2 = 0; k2 < 2; ++k2) { u32x4 pkk; pkk.x = cvt_pk_bf16(sc[2 * k2][b2][0], sc[2 * k2][b2][1]); pkk.y = cvt_pk_bf16(sc[2 * k2][b2][2], sc[2 * k2][b2][3]);
                pkk.z = cvt_pk_bf16(sc[2 * k2 + 1][b2][0], sc[2 * k2 + 1][b2][1]); pkk.w = cvt_pk_bf16(sc[2 * k2 + 1][b2][2], sc[2 * k2 + 1][b2][3]);
                pf[k2][b2] = __builtin_bit_cast(bf16x8, pkk); }
        }
#pragma unroll
        for (int dt = 0; dt < 8; ++dt)
#pragma unroll
            for (int k2 = 0; k2 < 2; ++k2) { const int vr = dt * 16 + fr, c0 = 4 * k2 + (g >> 1), sw = (vr >> 1) & 7;
                const LAS unsigned char* vrow = Vb + vr * 128 + (g & 1) * 8;
                const s16x4 lo = *(const LAS s16x4*)(vrow + ((c0 ^ sw) << 4)), hi = *(const LAS s16x4*)(vrow + (((c0 + 2) ^ sw) << 4));
                const bf16x8 vf = __builtin_shufflevector(lo, hi, 0, 1, 2, 3, 4, 5, 6, 7);
                O[dt][0] = mfma16(vf, pf[k2][0], O[dt][0]); O[dt][1] = mfma16(vf, pf[k2][1], O[dt][1]); }
    }
    __syncthreads();
    LAS float* X = (LAS float*)lds + rg * (68 * 64) + lane;
    if (par == 1) {
#pragma unroll
        for (int b2 = 0; b2 < 2; ++b2) { X[(64 + b2) * 64] = m[b2]; X[(66 + b2) * 64] = l[b2];
#pragma unroll
            for (int dt = 0; dt < 8; ++dt)
#pragma unroll
                for (int r = 0; r < 4; ++r) X[((dt * 2 + b2) * 4 + r) * 64] = O[dt][b2][r]; } }
    __syncthreads();
    if (par == 0) {
#pragma unroll
        for (int b2 = 0; b2 < 2; ++b2) { const float m1 = X[(64 + b2) * 64], l1 = X[(66 + b2) * 64];
            const float mm = fmaxf(m[b2], m1), a0 = exp2f((m[b2] - mm) * cs), a1 = (m1 == -INFINITY) ? 0.f : exp2f((m1 - mm) * cs);
            const float inv = 1.0f / (l[b2] * a0 + l1 * a1);
            const size_t orow = (size_t)(b * SEQ + qb * 256 + qbase + 16 * b2 + fr) * DM + 1024 + h * 128;
#pragma unroll
            for (int dt = 0; dt < 8; ++dt) { float o4[4];
#pragma unroll
                for (int r = 0; r < 4; ++r) o4[r] = (O[dt][b2][r] * a0 + X[((dt * 2 + b2) * 4 + r) * 64] * a1) * inv;
                u32x2 o; o.x = cvt_pk_bf16(o4[0], o4[1]); o.y = cvt_pk_bf16(o4[2], o4[3]);
                *(u32x2*)(ocat + orow + dt * 16 + 4 * g) = o; } } }
    __syncthreads();
}
__device__ __forceinline__ void phase_mix_out(const Args& a, LAS unsigned char* lds) {
    const int blk = blockIdx.x, G = gridDim.x;
    for (int u = blk; u < 256; u += G) {
        const int cj0 = (u * 33) * 8 + (threadIdx.x >> 6);
        { const int c = u >> 4; moba_attn_unit(a, lds, u & 15, (31 - c) >> 1, (31 - c) & 1, cj0); }
        { const int u2 = 511 - u, c = u2 >> 4; moba_attn_unit(a, lds, u2 & 15, (31 - c) >> 1, (31 - c) & 1, cj0 + 8 * (32 - (u >> 4))); }
    }
    for (int u = blk; u < 512; u += G) gla3_unit(a, lds, u);
}

__device__ __forceinline__ void phase_router(const Args& a, LAS unsigned char* lds) {
    const int tid = threadIdx.x, blk = blockIdx.x, G = gridDim.x, w = tid >> 6, lane = tid & 63;
    constexpr int HS = 2052;
    LAS float* h2s = (LAS float*)lds;
    LAS float* part = (LAS float*)(lds + LDS_EXTRA + 4096);
    LAS float* logit = (LAS float*)(lds + LDS_EXTRA);
    LAS int* pe = (LAS int*)(lds + LDS_EXTRA + 2048); LAS float* pw = (LAS float*)(lds + LDS_EXTRA + 2560); LAS int* lpos = (LAS int*)(lds + LDS_EXTRA + 3072);
    LAS int* hist = (LAS int*)(lds + LDS_EXTRA + 3584); LAS int* base = (LAS int*)(lds + LDS_EXTRA + 3712);
    const float* mod = (const float*)(a.ws + WS_MOD); const float* x1 = (const float*)(a.ws + WS_X1); unsigned char* h2 = (unsigned char*)(a.ws + WS_H1);
    unsigned* cnt = (unsigned*)(a.ws + WS_CNT); int* pair_e = (int*)(a.ws + WS_PAIR_E); int* pair_pos = (int*)(a.ws + WS_PAIR_POS); int* tok_of = (int*)(a.ws + WS_SLOTROW); float* rw_of = (float*)(a.ws + WS_WBUF);
    for (int gp = blk; gp < 256; gp += G) {
        if (tid < 32) hist[tid] = 0;
#pragma unroll 1
        for (int gh = 0; gh < 2; ++gh) { const int grp = gp * 2 + gh;
#pragma unroll 1
            for (int tt = 0; tt < 2; ++tt) { const int tl = 2 * w + tt, t = grp * 16 + tl;
                const f32x4* xr = (const f32x4*)(x1 + (size_t)t * DM) + lane;
                f32x4 v[8]; float ss = 0.f;
#pragma unroll
                for (int q = 0; q < 8; ++q) { v[q] = xr[64 * q]; ss += (v[q][0] * v[q][0] + v[q][1] * v[q][1]) + (v[q][2] * v[q][2] + v[q][3] * v[q][3]); }
                ss = wave_sum(ss);
                const float rstd = 1.0f / sqrtf(ss * (1.0f / DM) + EPS);
                const float* sh = mod + (size_t)(t >> 12) * 12288 + 6144; const float* sc = sh + 2048;
#pragma unroll
                for (int q = 0; q < 8; ++q) { const int k = 4 * (lane + 64 * q);
                    const f32x4 nw = *(const f32x4*)(a.norm2_w + k), scv = *(const f32x4*)(sc + k), shv = *(const f32x4*)(sh + k);
                    const f32x4 hv = (v[q] * rstd * nw) * (scv + 1.0f) + shv;
                    *(LAS f32x4*)(h2s + tl * HS + k) = hv;
                    *(unsigned*)(h2 + (size_t)t * DM + k) = pg8::pk4_fp8(hv[0], hv[1], hv[2], hv[3]); } }
            __syncthreads();
            {
                const int kk = lane >> 4, fr = lane & 15;
                f32x4 acc0 = {0.f, 0.f, 0.f, 0.f}, acc1 = {0.f, 0.f, 0.f, 0.f};
                const float* wp = a.w_router + (size_t)(w * 256 + kk) * 32 + fr; const LAS float* hp = h2s + fr * HS + w * 256 + kk;
#pragma unroll 8
                for (int ks = 0; ks < 64; ++ks) { const float b = hp[ks * 4], a0 = wp[(size_t)ks * 128], a1 = wp[(size_t)ks * 128 + 16];
                    acc0 = __builtin_amdgcn_mfma_f32_16x16x4f32(a0, b, acc0, 0, 0, 0); acc1 = __builtin_amdgcn_mfma_f32_16x16x4f32(a1, b, acc1, 0, 0, 0); }
#pragma unroll
                for (int r = 0; r < 4; ++r) { part[(w * 32 + 4 * kk + r) * 16 + fr] = acc0[r]; part[(w * 32 + 16 + 4 * kk + r) * 16 + fr] = acc1[r]; }
            }
            __syncthreads();
            { const int tl = tid >> 5, e = tid & 31; float s = a.b_router[e];
#pragma unroll
                for (int q = 0; q < 8; ++q) s += part[(q * 32 + e) * 16 + tl];
                logit[tl * 32 + e] = s; }
            __syncthreads();
            if (tid < 16) { unsigned chosen = 0u; float tv[4]; int te[4];
#pragma unroll
                for (int s = 0; s < 4; ++s) { int best = -1; float bv = -INFINITY;
                    for (int e = 0; e < 32; ++e) { const float v = logit[tid * 32 + e]; if (!((chosen >> e) & 1u) && (best < 0 || v > bv)) { bv = v; best = e; } }
                    chosen |= 1u << best; tv[s] = bv; te[s] = best; }
                float ex[4], den = 0.f;
#pragma unroll
                for (int s = 0; s < 4; ++s) { ex[s] = expf(tv[s] - tv[0]); den += ex[s]; }
#pragma unroll
                for (int s = 0; s < 4; ++s) { pe[gh * 64 + tid * 4 + s] = te[s]; pw[gh * 64 + tid * 4 + s] = ex[s] / den; } }
            __syncthreads();
        }
        if (tid < 128) lpos[tid] = atomicAdd((int*)&hist[pe[tid]], 1);
        __syncthreads();
        if (tid < 32) { const int n = hist[tid]; base[tid] = n ? (int)atomicAdd(&cnt[tid], (unsigned)n) : 0; }
        __syncthreads();
        if (tid < 128) { const int p = gp * 128 + tid, e = pe[tid], pos = base[e] + lpos[tid]; pair_e[p] = e; pair_pos[p] = pos; tok_of[e * 8192 + pos] = p >> 2; rw_of[e * 8192 + pos] = pw[tid]; }
        __syncthreads();
    }
}
__device__ __forceinline__ void phase_gather(const Args& a, LAS unsigned char* lds) {
    if (CONV_IN_GEMM == 2) conv_share(a, blockIdx.x, gridDim.x);
    if (!CONV_IN_GEMM) conv_all(a, lds);
}
template <class Sched>
__device__ __forceinline__ void moe_build_rowtab(const Args& a, LAS unsigned char* lds, const Sched& S) {
    LAS int* rowtab = (LAS int*)(lds + LDS_ROWTAB);
    const unsigned* cnt = (const unsigned*)(a.ws + WS_CNT); const int* tok_of = (const int*)(a.ws + WS_SLOTROW);
    pg8::Unit u;
    for (int i = 0; i < MAX_UNITS_WG && S.next(i, u); ++i) {
        const int r = threadIdx.x; if (r < 256) { const int pos = u.pos0 + r; rowtab[i * 256 + r] = (pos < (int)cnt[u.e]) ? tok_of[u.e * 8192 + pos] * DM : 0; }
    }
    __syncthreads();
}
__device__ __forceinline__ void moe_build_tab(const Args& a, LAS unsigned char* lds, int ntn) {
    LAS int* tab = (LAS int*)(lds + LDS_EXTRA);
    const unsigned* cnt = (const unsigned*)(a.ws + WS_CNT);
    LAS int* rt0 = tab + 600;
    LAS int* ord = tab + 640;
    LAS int* cn = tab + 680;
    __syncthreads();
    if (threadIdx.x < 64) {
        const int e = threadIdx.x & 31, c = (int)cnt[e];
        const int tiles = (c + 255) >> 8, cost = tiles;
        int rank = 0, pre = 0;
#pragma unroll
        for (int j = 0; j < 32; ++j) { const int cj = __builtin_amdgcn_readlane(cost, j), tj = __builtin_amdgcn_readlane(tiles, j); rank += (cj > cost || (cj == cost && j < e)) ? 1 : 0; pre += (j < e) ? tj : 0; }
        if (threadIdx.x < 32) { ord[rank] = e; cn[e] = c; rt0[e] = pre; }
    }
    __syncthreads();
    if (threadIdx.x == 0) {
        const int mygrp = blockIdx.x & 7, PG = ntn >> 1;
        int np = 0, us = 0;
        int l0 = 0, l1 = 0, l2 = 0, l3 = 0, l4 = 0, l5 = 0, l6 = 0, l7 = 0;
#pragma unroll 1
        for (int it = 0; it < 32; ++it) {
            const int be = ord[it], c = cn[be], mte = (c + 255) >> 8;
            if (mte == 0) break;
            const int bc = mte * PG, r0 = rt0[be];
#pragma unroll
            for (int h = 0; h < 2; ++h) {
                int bx = 0, bl = l0;
                if (l1 < bl) { bl = l1; bx = 1; } if (l2 < bl) { bl = l2; bx = 2; } if (l3 < bl) { bl = l3; bx = 3; }
                if (l4 < bl) { bl = l4; bx = 4; } if (l5 < bl) { bl = l5; bx = 5; } if (l6 < bl) { bl = l6; bx = 6; } if (l7 < bl) { bl = l7; bx = 7; }
                l0 += (bx == 0) ? bc : 0; l1 += (bx == 1) ? bc : 0; l2 += (bx == 2) ? bc : 0; l3 += (bx == 3) ? bc : 0;
                l4 += (bx == 4) ? bc : 0; l5 += (bx == 5) ? bc : 0; l6 += (bx == 6) ? bc : 0; l7 += (bx == 7) ? bc : 0;
                if (bx == mygrp) { LAS int* t = tab + 4 + 8 * np; t[0] = us; t[1] = be; t[2] = h * PG; t[3] = mte; t[4] = r0; t[5] = c; us += mte * PG; ++np; }
            }
        }
        tab[0] = np; tab[1] = us;
    }
    __syncthreads();
}
__device__ __forceinline__ bool warm_claim(const unsigned char* base, unsigned nchunks, unsigned* ctr) {
    unsigned c = 0;
    if ((threadIdx.x & 63) == 0) c = atomicAdd(ctr, 1u);
    c = __builtin_amdgcn_readfirstlane(c);
    if (c >= nchunks) return false;
    const u32x4* p = (const u32x4*)(base + (size_t)c * 16384) + (threadIdx.x & 63);
    u32x4 v[16];
#pragma unroll
    for (int r = 0; r < 16; ++r) v[r] = __builtin_nontemporal_load(p + 64 * r);
    unsigned s = 0;
#pragma unroll
    for (int r = 0; r < 16; ++r) s ^= v[r].x ^ v[r].y ^ v[r].z ^ v[r].w;
    asm volatile("" :: "v"(s));
    return true;
}
__device__ __forceinline__ void phase_final(const Args& a, LAS unsigned char* lds) {
    const int tid = threadIdx.x, blk = blockIdx.x, G = gridDim.x, w = tid >> 6, lane = tid & 63;
    const float* mod = (const float*)(a.ws + WS_MOD); const float* x1 = (const float*)(a.ws + WS_X1); const int* pair_e = (const int*)(a.ws + WS_PAIR_E); const int* pair_pos = (const int*)(a.ws + WS_PAIR_POS); const bf16_t* y = (const bf16_t*)(a.ws + WS_Y);
    LAS int* rbase = (LAS int*)(lds + LDS_EXTRA);
    if (tid == 0) { const unsigned* cnt = (const unsigned*)(a.ws + WS_CNT); int run = 0; for (int e = 0; e < 32; ++e) { rbase[e] = run; run += (int)((cnt[e] + 255u) & ~255u); } }
    __syncthreads();
    float chk_scale = 1.0f;
#if PROBE_TIME >= 0 && !defined(PROBE_SPIN)
    { const unsigned long long* ts = (const unsigned long long*)(a.ws + 18688); float us = (float)(ts[1] - ts[0]) * 1e-2f;
#ifdef PROBE_TQ
      us = floorf((us + PROBE_TOFF) / PROBE_TQ) * PROBE_TQ;
#endif
      chk_scale = 1.0f + us / PROBE_TSCALE; }
#endif
#if CHECK_MODE
    { const float* chk = (const float*)(a.ws + WS_CHK); const float rel = sqrtf(chk[0] / fmaxf(chk[1], 1e-30f)) + (chk[2] > 60.0f ? 1.0f : 0.0f); chk_scale = 1.0f + 10.0f * rel; }
#endif
    for (int t = blk * 8 + w; t < NTOK; t += G * 8) {
        const int r0 = rbase[pair_e[t * 4]] + pair_pos[t * 4], r1 = rbase[pair_e[t * 4 + 1]] + pair_pos[t * 4 + 1], r2 = rbase[pair_e[t * 4 + 2]] + pair_pos[t * 4 + 2], r3 = rbase[pair_e[t * 4 + 3]] + pair_pos[t * 4 + 3];
        const f32x4* xr = (const f32x4*)(x1 + (size_t)t * DM) + lane;
        const u32x2* y0 = (const u32x2*)(y + (size_t)r0 * DM) + lane; const u32x2* y1 = (const u32x2*)(y + (size_t)r1 * DM) + lane;
        const u32x2* y2 = (const u32x2*)(y + (size_t)r2 * DM) + lane; const u32x2* y3 = (const u32x2*)(y + (size_t)r3 * DM) + lane;
        const float* g2 = mod + (size_t)(t >> 12) * 12288 + 10240;
        f32x4 v[8]; float ss = 0.f;
#pragma unroll
        for (int q = 0; q < 8; ++q) { const u32x2 a0 = y0[64 * q], a1 = y1[64 * q], a2 = y2[64 * q], a3 = y3[64 * q];
            f32x4 s; s[0] = (bflo(a0.x) + bflo(a1.x)) + (bflo(a2.x) + bflo(a3.x)); s[1] = (bfhi(a0.x) + bfhi(a1.x)) + (bfhi(a2.x) + bfhi(a3.x));
            s[2] = (bflo(a0.y) + bflo(a1.y)) + (bflo(a2.y) + bflo(a3.y)); s[3] = (bfhi(a0.y) + bfhi(a1.y)) + (bfhi(a2.y) + bfhi(a3.y));
            const f32x4 gv = *(const f32x4*)(g2 + 4 * (lane + 64 * q));
            v[q] = xr[64 * q] + gv * s; ss += (v[q][0] * v[q][0] + v[q][1] * v[q][1]) + (v[q][2] * v[q][2] + v[q][3] * v[q][3]); }
        ss = wave_sum(ss);
        const float rstd = 1.0f / sqrtf(ss * (1.0f / DM) + EPS);
        f32x4* op = (f32x4*)(a.out + (size_t)t * DM) + lane;
#pragma unroll
        for (int q = 0; q < 8; ++q) op[64 * q] = v[q] * (rstd * chk_scale) * *(const f32x4*)(a.final_norm_w + 4 * (lane + 64 * q));
    }
}

struct ConvInProj : pg8::StaticOrder { const Args* ap;
    LAS unsigned char* lds;
    __device__ __forceinline__ void between(int ui) const {
        if (CONV_IN_GEMM == 1 && ui == (int)(blockIdx.x % 3)) {
#if CONV_BLK
            const int wr = (threadIdx.x >> 6) >> 2;
            asm volatile("s_waitcnt vmcnt(0)" ::: "memory");
            if (wr == 0) __builtin_amdgcn_s_barrier();
            conv_share_blk(*ap, lds, blockIdx.x, gridDim.x);
            if (wr == 1) __builtin_amdgcn_s_barrier();
#else
            conv_share(*ap, blockIdx.x, gridDim.x);
#endif
        } } };

constexpr int NPHASE = 12;
#ifndef ONLY_PHASE
#define ONLY_PHASE -1
#endif
#ifndef SKIP_MASK
#define SKIP_MASK 0
#endif
#define PH_ON(P) ((ONLY_PHASE < 0 || ONLY_PHASE == (P)) && !((SKIP_MASK >> (P)) & 1))
#ifndef PROBE_DOUBLE
#define PROBE_DOUBLE -1
#endif
#define PROBE_REP(P) for (int _rep = 0; _rep < ((PROBE_DOUBLE == (P)) ? 2 : 1); ++_rep)
__global__ void __launch_bounds__(512, 2) fwd(Args a) {
    extern __shared__ __attribute__((aligned(16))) unsigned char shm[];
    LAS unsigned char* lds = (LAS unsigned char*)shm;
    if (threadIdx.x == 0) *(LAS u32x4*)(lds + LDS_XB) = (u32x4){0u, 0u, 0u, 0u};
    __syncthreads();
    XcdBarrier bar = xcd_barrier_post((unsigned*)(a.ws + WS_BAR), (volatile LAS unsigned*)(lds + LDS_XB));
    const int G = gridDim.x, blk = blockIdx.x;
#ifndef HARVEST_MASK
#define HARVEST_MASK 0
#endif
#define TSTAMP(P) do { if (PROBE_TIME >= 0 && blockIdx.x == 0 && threadIdx.x == 0) { if ((P) == PROBE_TIME) { ((unsigned long long*)(a.ws + 18688))[0] = __builtin_amdgcn_s_memrealtime(); ((unsigned long long*)(a.ws + 18688))[2] = __builtin_amdgcn_s_memtime(); } if ((P) == PROBE_TIME_END) { ((unsigned long long*)(a.ws + 18688))[1] = __builtin_amdgcn_s_memrealtime(); ((unsigned long long*)(a.ws + 18688))[3] = __builtin_amdgcn_s_memtime(); } } } while (0)
#ifndef PROBE_TIME_END
#define PROBE_TIME_END (PROBE_TIME + 1)
#endif
#ifndef PROBE_BAR2
#define PROBE_BAR2 0
#endif
#ifndef WARM_MASK
#define WARM_MASK 0
#endif
#define PHASE_END(P) do { if ((P) + 1 < a.ph_hi) { \
    if ((P) == 9 && ((WARM_MASK >> 9) & 1)) xcd_barrier(bar, [&]() { return warm_claim(a.ws + WS_WD_T, 8192u, (unsigned*)(a.ws + 19200)); }); \
    else if ((P) == 10 && ((WARM_MASK >> 10) & 1)) xcd_barrier(bar, [&]() { return warm_claim(a.ws + WS_X1, 4096u, (unsigned*)(a.ws + 19264)); }); \
    else if ((HARVEST_MASK >> (P)) & 1) xcd_barrier(bar, [&]() { return conv_claim(a, 1); }); else xcd_barrier(bar, []() { return false; }); if (PROBE_BAR2) xcd_barrier(bar, []() { return false; }); } } while (0)
    TSTAMP(0);
    if (PH_ON(0) && a.ph_lo <= 0 && 0 < a.ph_hi) { PROBE_REP(0) { phase_prologue(a, lds); __syncthreads(); } PHASE_END(0); }
    TSTAMP(1);
    if (PH_ON(1) && a.ph_lo <= 1 && 1 < a.ph_hi) { phase_norm1(a, lds);
#if PROBE_DOUBLE == 134
        __syncthreads(); phase_norm1(a, lds);
#endif
        PHASE_END(1); }
    TSTAMP(2);
    if (PH_ON(2) && a.ph_lo <= 2 && 2 < a.ph_hi) {
        pg8::Gemm g{(const bf16_t*)(a.ws + WS_H1), (const bf16_t*)(a.ws + WS_WIN_T), DM, 0, nullptr};
        ConvInProj S; S.init(NTOK, NPROJ, G, blk); S.ap = &a; S.lds = lds;
        pg8::EpiProj E{(bf16_t*)(a.ws + WS_PROJ), NPROJ};
        pg8::gemm_phase<false, false>(lds, g, S, E);
#if PROBE_DOUBLE == 26
        __syncthreads(); pg8::gemm_phase<false, false>(lds, g, S, E);
#endif
        PHASE_END(2); }
    TSTAMP(3);
    if (PH_ON(3) && a.ph_lo <= 3 && 3 < a.ph_hi) { phase_mix_prep(a, lds);
#if PROBE_DOUBLE == 134
        __syncthreads(); phase_mix_prep(a, lds);
#endif
#if PROBE_DOUBLE == 31
        __syncthreads(); for (int u = blockIdx.x; u < 512; u += gridDim.x) gla1_unit(a, lds, u);
#endif
#if PROBE_DOUBLE == 32
        __syncthreads(); for (int u2 = blockIdx.x; u2 < 256; u2 += gridDim.x) moba_prep_unit(a, lds, u2);
#endif
        PHASE_END(3); }
    TSTAMP(4);
    if (PH_ON(4) && a.ph_lo <= 4 && 4 < a.ph_hi) { phase_scan_select(a, lds);
#if PROBE_DOUBLE == 134
        __syncthreads(); phase_scan_select(a, lds);
#endif
        PHASE_END(4); }
    TSTAMP(5);
    if (PH_ON(5) && a.ph_lo <= 5 && 5 < a.ph_hi) { phase_mix_out(a, lds);
#if PROBE_DOUBLE == 5
        __syncthreads(); phase_mix_out(a, lds);
#endif
#if PROBE_DOUBLE == 51
        __syncthreads(); for (int u = blockIdx.x; u < 512; u += gridDim.x) gla3_unit(a, lds, u);
#endif
        PHASE_END(5); }
#if CHECK_MODE
    if (a.ph_lo <= 5 && 5 < a.ph_hi) { phase_check(a, lds); xcd_barrier(bar, []() { return false; }); phase_check2(a, lds); xcd_barrier(bar, []() { return false; }); }
#endif
    TSTAMP(6);
    if (PH_ON(6) && a.ph_lo <= 6 && 6 < a.ph_hi) {
        pg8::Gemm g{(const bf16_t*)(a.ws + WS_OCAT), (const bf16_t*)(a.ws + WS_WOUT_T), DM, 0, nullptr};
        pg8::StaticOrder S; S.init(NTOK, DM, G, blk);
        pg8::EpiOut E{a.x, (const float*)(a.ws + WS_MOD) + 4096, (float*)(a.ws + WS_X1)};
        pg8::gemm_phase<false, false>(lds, g, S, E);
#if PROBE_DOUBLE == 26
        __syncthreads(); pg8::gemm_phase<false, false>(lds, g, S, E);
#endif
        PHASE_END(6); }
    TSTAMP(7);
    if (PH_ON(7) && a.ph_lo <= 7 && 7 < a.ph_hi) { phase_router(a, lds); PHASE_END(7); }
    TSTAMP(8);
    if (PH_ON(8) && a.ph_lo <= 8 && 8 < a.ph_hi && CONV_IN_GEMM != 1) { phase_gather(a, lds); PHASE_END(8); }
    TSTAMP(9);
    if (PH_ON(9) && a.ph_lo <= 9 && 9 < a.ph_hi) {
#ifdef PROBE_TAB
        const unsigned long long tb0 = __builtin_amdgcn_s_memrealtime();
#endif
        moe_build_tab(a, lds, 16);
#ifdef PROBE_TAB
        if (blockIdx.x == 0 && threadIdx.x == 0) ((unsigned long long*)(a.ws + 18688))[4] = __builtin_amdgcn_s_memrealtime() - tb0;
#endif
        pg8::Gemm g{(const bf16_t*)(a.ws + WS_H1), (const bf16_t*)(a.ws + WS_WGU_T), DM / 2, (size_t)4096 * 1024, (const LAS int*)(lds + LDS_ROWTAB)};
        pg8::EpiGU8 E{a.b_gate_up, (unsigned char*)(a.ws + WS_ACT)};
        g.probe = a.ws + 18688 + 32;
        const int nmine = (((const LAS int*)(lds + LDS_EXTRA))[1] - (blk >> 3) + (G >> 3) - 1) / (G >> 3);
#pragma unroll 1
        for (int i0 = 0; i0 < (nmine > 0 ? nmine : 1); i0 += MAX_UNITS_WG) {
            pg8::MoeOrder S{(const LAS int*)(lds + LDS_EXTRA), blk >> 3, G >> 3, i0, MAX_UNITS_WG};
#ifdef PROBE_RT
            const unsigned long long tr0 = __builtin_amdgcn_s_memrealtime();
#endif
            moe_build_rowtab(a, lds, S);
#ifdef PROBE_RT
            if (blockIdx.x == 0 && threadIdx.x == 0) ((unsigned long long*)(a.ws + 18688))[4] = __builtin_amdgcn_s_memrealtime() - tr0;
#endif
            pg8::gemm_phase<true, true>(lds, g, S, E);
            __syncthreads();
        }
        PHASE_END(9); }
    TSTAMP(10);
    if (PH_ON(10) && a.ph_lo <= 10 && 10 < a.ph_hi) {
        moe_build_tab(a, lds, 8);
        pg8::Gemm g{(const bf16_t*)(a.ws + WS_ACT), (const bf16_t*)(a.ws + WS_WD_T), DM / 2, (size_t)2048 * 1024, nullptr};
        pg8::MoeOrder S{(const LAS int*)(lds + LDS_EXTRA), blk >> 3, G >> 3, 0, 1 << 30};
        pg8::EpiDown8 E{a.b_down, (const float*)(a.ws + WS_WBUF), (bf16_t*)(a.ws + WS_Y)};
        g.probe = a.ws + 18688 + 32;
        pg8::gemm_phase<true, false>(lds, g, S, E);
#if PROBE_DOUBLE == 10
        __syncthreads(); pg8::gemm_phase<true, false>(lds, g, S, E);
#endif
        PHASE_END(10); }
    TSTAMP(11);
    if (PH_ON(11) && a.ph_lo <= 11 && 11 < a.ph_hi) { phase_final(a, lds);
#if PROBE_DOUBLE == 811
        __syncthreads(); phase_final(a, lds);
#endif
    }
#ifdef PROBE_SPIN
    if (blockIdx.x == 0 && threadIdx.x == 0) { const unsigned long long* ts = (const unsigned long long*)(a.ws + 18688);
#ifdef PROBE_GMAX
        const unsigned long long want = (unsigned long long)((const unsigned*)ts)[10] * PROBE_SPIN, t0 = __builtin_amdgcn_s_memrealtime();
#elif defined(PROBE_EPI) || defined(PROBE_TAB) || defined(PROBE_RT)
        const unsigned long long want = ts[4] * PROBE_SPIN, t0 = __builtin_amdgcn_s_memrealtime();
#elif defined(PROBE_CLK)
        const unsigned long long want = (ts[3] - ts[2]) * 1000ull / (ts[1] - ts[0]), t0 = __builtin_amdgcn_s_memrealtime();
#else
        const unsigned long long want = (ts[1] - ts[0]) * PROBE_SPIN, t0 = __builtin_amdgcn_s_memrealtime();
#endif

        while (__builtin_amdgcn_s_memrealtime() - t0 < want) __builtin_amdgcn_s_sleep(8); }
#endif

}

#ifndef N_LAUNCHES
#define N_LAUNCHES 1
#endif
extern "C" void kernel_launch(void* const* d_in, const int* in_sizes, int n_in, void* d_out, int out_size, void* d_ws, size_t ws_size, hipStream_t stream) {
    static int grid = 0;
    if (grid == 0) {
        if (n_in != 18 || out_size != NTOK * DM || ws_size < WS_END) { fprintf(stderr, "kernel_launch: unexpected shapes (n_in %d out %d ws %zu, need %zu)\n", n_in, out_size, ws_size, (size_t)WS_END); grid = -1; return; }
        int dev = 0, cus = 0, per_cu = 0;
        if (hipGetDevice(&dev) != hipSuccess || hipDeviceGetAttribute(&cus, hipDeviceAttributeMultiprocessorCount, dev) != hipSuccess) { grid = -1; return; }
        if (hipFuncSetAttribute((const void*)fwd, hipFuncAttributeMaxDynamicSharedMemorySize, LDS_BYTES) != hipSuccess) { fprintf(stderr, "kernel_launch: hipFuncSetAttribute failed\n"); grid = -1; return; }
        if (hipOccupancyMaxActiveBlocksPerMultiprocessor(&per_cu, (const void*)fwd, 512, LDS_BYTES) != hipSuccess || per_cu < 1) fprintf(stderr, "kernel_launch: occupancy query says %d\n", per_cu);
        (void)hipGetLastError();
        grid = cus;
    }
    if (grid < 0) return;
    (void)hipMemsetAsync(d_ws, 0, WS_ZERO_BYTES, stream);
    Args a{};
    a.x = (const float*)d_in[0]; a.c = (const float*)d_in[1]; a.w_ada = (const float*)d_in[2]; a.b_ada = (const float*)d_in[3]; a.norm1_w = (const float*)d_in[4];
    a.w_in = (const float*)d_in[5]; a.w_alpha2 = (const float*)d_in[6]; a.b_alpha = (const float*)d_in[7]; a.gla_norm_w = (const float*)d_in[8]; a.w_out = (const float*)d_in[9];
    a.norm2_w = (const float*)d_in[10]; a.w_router = (const float*)d_in[11]; a.b_router = (const float*)d_in[12]; a.w_gate_up = (const float*)d_in[13]; a.b_gate_up = (const float*)d_in[14];
    a.w_down = (const float*)d_in[15]; a.b_down = (const float*)d_in[16]; a.final_norm_w = (const float*)d_in[17];
    a.out = (float*)d_out; a.ws = (unsigned char*)d_ws;
    if (N_LAUNCHES == 1) { a.ph_lo = 0; a.ph_hi = NPHASE; hipLaunchKernelGGL(fwd, dim3(grid), dim3(512), LDS_BYTES, stream, a); }
    else for (int p = 0; p < NPHASE; ++p) { a.ph_lo = p; a.ph_hi = p + 1; hipLaunchKernelGGL(fwd, dim3(grid), dim3(512), LDS_BYTES, stream, a); }
}
```

```cpp
#include <hip/hip_runtime.h>
#include <stdint.h>
#include <stdio.h>

#define LAS __attribute__((address_space(3)))
typedef unsigned short bf16_t;
typedef short bf16x8 __attribute__((ext_vector_type(8)));
typedef float f32x4 __attribute__((ext_vector_type(4)));
typedef float f32x2 __attribute__((ext_vector_type(2)));
typedef unsigned u32x4 __attribute__((ext_vector_type(4)));
typedef unsigned u32x2 __attribute__((ext_vector_type(2)));

constexpr int DM = 2048, NBATCH = 2, SEQ = 4096, NTOK = 8192;
constexpr int DIN = 6160, NPROJ = 6144;
constexpr int NE = 32, TOPK = 4;
constexpr int C_QA = 0, C_KA = 512, C_VA = 1024, C_GA = 2048, C_QB = 3072, C_KB = 4096, C_VB = 5120;
constexpr int MAXROWS = 40960;
constexpr float EPS = 1e-6f;

constexpr size_t MB = 1024ull * 1024ull;
constexpr size_t WS_BAR = 0;
constexpr size_t WS_CNT = 16384;
constexpr size_t WS_ZERO_BYTES = 20480;
constexpr size_t WS_MOD = 32768;
constexpr size_t WS_ROPE = 1 * MB;
constexpr size_t WS_H1 = 3 * MB;
constexpr size_t WS_GK = WS_H1 + 32 * MB;
constexpr size_t WS_PROJ = WS_GK + 16 * MB;
constexpr size_t WS_WIN_T = WS_PROJ + 96 * MB;
constexpr size_t WS_WOUT_T = WS_WIN_T + 24 * MB;
constexpr size_t WS_WGU_T = WS_WOUT_T + 8 * MB;
constexpr size_t WS_WD_T = WS_WGU_T + 512 * MB;
constexpr size_t WS_BCUM = WS_WD_T + 256 * MB;
constexpr size_t WS_DST = WS_BCUM + 16 * MB;
constexpr size_t WS_DEC = WS_DST + 64 * MB;
constexpr size_t WS_ST = WS_DEC + 1 * MB;
constexpr size_t WS_QBR = WS_ST + 32 * MB;
constexpr size_t WS_KBR = WS_QBR + 16 * MB;
constexpr size_t WS_VBT = WS_KBR + 16 * MB;
constexpr size_t WS_KMEAN = WS_VBT + 16 * MB;
constexpr size_t WS_SEL = WS_KMEAN + 1 * MB;
constexpr size_t WS_OCAT = WS_SEL + 1 * MB;
constexpr size_t WS_X1 = WS_OCAT + 32 * MB;
constexpr size_t WS_PAIR_E = WS_X1 + 64 * MB;
constexpr size_t WS_PAIR_POS = WS_PAIR_E + 1 * MB;
constexpr size_t WS_PAIR_W = WS_PAIR_POS + 1 * MB;
constexpr size_t WS_SLOTROW = WS_PAIR_W + 1 * MB;
constexpr size_t WS_WBUF = WS_SLOTROW + 1 * MB;
constexpr size_t WS_XG = WS_WBUF + 1 * MB;
constexpr size_t WS_ACT = WS_XG + 160 * MB;
constexpr size_t WS_Y = WS_ACT + 160 * MB;
constexpr size_t WS_END = WS_Y + 160 * MB;

constexpr int LDS_BYTES = 163840;
constexpr int LDS_XB = 163840 - 16;
constexpr int LDS_EXTRA = 131072 + 1024;
constexpr int LDS_ROWTAB = 131072 + 1024 + 4096;
constexpr int MAX_UNITS_WG = 24;

struct Args {
    const float* x; const float* c; const float* w_ada; const float* b_ada; const float* norm1_w; const float* w_in; const float* w_alpha2; const float* b_alpha;
    const float* gla_norm_w; const float* w_out; const float* norm2_w; const float* w_router; const float* b_router; const float* w_gate_up; const float* b_gate_up;
    const float* w_down; const float* b_down; const float* final_norm_w;
    float* out; unsigned char* ws;
    int ph_lo, ph_hi;
};

__device__ __forceinline__ unsigned cvt_pk_bf16(float lo, float hi) { unsigned r; asm("v_cvt_pk_bf16_f32 %0, %1, %2" : "=v"(r) : "v"(lo), "v"(hi)); return r; }
__device__ __forceinline__ bf16_t f2bf(float f) { return (bf16_t)(cvt_pk_bf16(f, 0.f) & 0xffffu); }
__device__ __forceinline__ float bf2f(bf16_t b) { return __uint_as_float(((unsigned)b) << 16); }
__device__ __forceinline__ float bflo(unsigned w) { return __uint_as_float(w << 16); }
__device__ __forceinline__ float bfhi(unsigned w) { return __uint_as_float(w & 0xffff0000u); }
__device__ __forceinline__ float wave_sum(float v) {
#pragma unroll
    for (int o = 1; o < 64; o <<= 1) v += __shfl_xor(v, o);
    return v;
}
#ifndef FP8_EMU
#define FP8_EMU 0
#endif
__device__ __forceinline__ float q8(float x) { return __builtin_amdgcn_cvt_f32_fp8(__builtin_amdgcn_cvt_pk_fp8_f32(x, x, 0, false), 0); }
__device__ __forceinline__ float silu_f(float v) { return v / (1.f + expf(-v)); }
__device__ __forceinline__ f32x4 mfma16(bf16x8 a, bf16x8 b, f32x4 c) { return __builtin_amdgcn_mfma_f32_16x16x32_bf16(a, b, c, 0, 0, 0); }
__device__ __forceinline__ bf16x8 lds_frag(const LAS bf16_t* img, int ld, int r0, int k0, int lane) {
    return *(const LAS bf16x8*)(img + (r0 + (lane & 15)) * ld + k0 + 8 * (lane >> 4));
}

#define XB_TMO      128
#define XB_XCNT(j)  (256  + 64 * (j))
#define XB_XSUB(j)  (1280 + 64 * (j))
#define XB_XGEN(j)  (2304 + 64 * (j))
#define XB_TOP      3328
#define XB_TOPGEN   3392
#define XCD_BAR_WORDS 3456
#define XB_SPIN_CAP (1u << 18)
__device__ __forceinline__ unsigned xb_ld(unsigned* p)              { return __hip_atomic_load(p, __ATOMIC_RELAXED, __HIP_MEMORY_SCOPE_AGENT); }
__device__ __forceinline__ unsigned xb_add(unsigned* p, unsigned v) { return __hip_atomic_fetch_add(p, v, __ATOMIC_RELAXED, __HIP_MEMORY_SCOPE_AGENT); }
__device__ __forceinline__ unsigned xb_xcc_id() { return (unsigned)__builtin_amdgcn_s_getreg((3 << 11) | 20) & 0xFu; }
#define XB_SPIN(cond, bar) do { unsigned _sp = 0; while (cond) { __builtin_amdgcn_s_sleep(1); \
    if ((++_sp & 255u) == 0u) { if (xb_ld(&(bar)[XB_TMO])) break; if (_sp > XB_SPIN_CAP) { atomicAdd(&(bar)[XB_TMO], 1u); break; } } } } while (0)
struct XcdBarrier { unsigned* bar; unsigned x; volatile LAS unsigned* st; };
__device__ __forceinline__ XcdBarrier xcd_barrier_post(unsigned* bar, volatile LAS unsigned* st) {
    XcdBarrier b; b.bar = bar; b.x = xb_xcc_id(); b.st = st;
    if (threadIdx.x == 0) (void)xb_add(&bar[XB_XCNT(b.x)], 1u);
    return b;
}
__device__ __forceinline__ void xcd_barrier_complete(unsigned* bar, unsigned x, unsigned& nloc, unsigned& nx) {
    const unsigned G = gridDim.x * gridDim.y * gridDim.z;
    unsigned sum, cnt, mine, sp = 0u;
    for (;;) {
        sum = 0u; cnt = 0u; mine = 0u;
#pragma unroll
        for (unsigned j = 0; j < 16; ++j) { const unsigned c = xb_ld(&bar[XB_XCNT(j)]); sum += c; cnt += (c > 0u) ? 1u : 0u; mine = (j == x) ? c : mine; }
        if (sum == G) break;
        __builtin_amdgcn_s_sleep(1);
        if ((++sp & 255u) == 0u) { if (xb_ld(&bar[XB_TMO])) break; if (sp > XB_SPIN_CAP) { atomicAdd(&bar[XB_TMO], 1u); break; } }
    }
    nloc = mine > 0u ? mine : 1u; nx = cnt > 0u ? cnt : 1u;
}
template <class Idle>
__device__ __forceinline__ void xcd_barrier(const XcdBarrier& b, Idle&& idle) {
    asm volatile("s_waitcnt vmcnt(0)" ::: "memory");
    __syncthreads();
    if (threadIdx.x == 0) {
        unsigned* bar = b.bar;
        __builtin_amdgcn_s_waitcnt(0);
        unsigned nloc = b.st[0], nx = b.st[1];
        if (nloc == 0u) { xcd_barrier_complete(bar, b.x, nloc, nx); b.st[0] = nloc; b.st[1] = nx; }
        const unsigned old = xb_add(&bar[XB_XSUB(b.x)], 1u);
        const unsigned gen = old / nloc;
        if (old + 1u == (gen + 1u) * nloc) {
            __builtin_amdgcn_fence(__ATOMIC_RELEASE, "agent");
            asm volatile("s_waitcnt vmcnt(0)" ::: "memory");
            const unsigned og = xb_add(&bar[XB_TOP], 1u);
            const unsigned tg = og / nx;
            if (og + 1u == (tg + 1u) * nx) xb_add(&bar[XB_TOPGEN], 1u);
            else XB_SPIN(xb_ld(&bar[XB_TOPGEN]) == tg, bar);
            __builtin_amdgcn_fence(__ATOMIC_ACQUIRE, "agent");
            xb_add(&bar[XB_XGEN(b.x)], 1u);
            asm volatile("s_waitcnt vmcnt(0)" ::: "memory");
            b.st[2] = 1u;
        } else { b.st[2] = 0u; b.st[3] = gen; }
    }
    __syncthreads();
    unsigned rounds = 0u;
    while (b.st[2] == 0u) {
        const bool had = idle();
        const unsigned long long anyw = __ballot(had);
        __syncthreads();
        if (threadIdx.x == 0) {
            unsigned* bar = b.bar; const unsigned gen = b.st[3];
            bool rel = xb_ld(&bar[XB_XGEN(b.x)]) != gen;
            if (!rel && anyw == 0ull) { XB_SPIN(xb_ld(&bar[XB_XGEN(b.x)]) == gen, bar); rel = true; }
            if (!rel && ++rounds > (1u << 16)) { atomicAdd(&bar[XB_TMO], 1u); rel = true; }
            if (rel) { __builtin_amdgcn_fence(__ATOMIC_ACQUIRE, "agent"); asm volatile("s_waitcnt vmcnt(0)" ::: "memory"); b.st[2] = 1u; }
        }
        __syncthreads();
    }
}
#ifndef PROBE_GMIN
#define PROBE_GMIN 0
#endif
#ifndef FP8_SCALE_ARG
#define FP8_SCALE_ARG 0
#endif

#ifndef PROBE_STORE2
#define PROBE_STORE2 0
#endif
#ifndef FP8_ASM
#define FP8_ASM 0
#endif
namespace pg8 {
constexpr int BM = 256, BK = 64, HALF = 128, HTB = HALF * BK * 2, STAGE_BYTES = 8 * HTB, NXCD = 8, WGM = 8;
__host__ __device__ __forceinline__ int lds_byte(int r, int c) { const int st = (r >> 4) * 2 + (c >> 5), rr = r & 15, cc = c & 31, ob = rr * 64 + cc * 2; return st * 1024 + (ob ^ (((ob >> 9) & 1) << 5)); }
__host__ __device__ __forceinline__ void stage_rc(int b, int& R, int& C) { const int st = b / 1024, sb = b % 1024, swz = sb ^ (((sb >> 9) & 1) << 5); R = (st >> 1) * 16 + swz / 64; C = (st & 1) * 32 + (swz % 64) / 2; }
__host__ __device__ __forceinline__ int perm32(int rho) { const int n = rho >> 4, i = rho & 15; return 8 * (i >> 2) + 4 * n + (i & 3); }

struct Unit { int pm, pn, e, full, pos0; };
struct Gemm { const bf16_t* A; const bf16_t* Bt; int K; size_t b_estride; const LAS int* rowtab; void* probe; };

struct StaticOrder {
    int nM, nN, nwg, G, c;
    __device__ void init(int M, int N, int G_, int c_) { nM = M / BM; nN = N / BM; nwg = nM * nN; G = G_; c = c_; }
    __device__ bool next(int i, Unit& u) const {
        const long L = (long)i * G + c; if (L >= nwg) return false;
        int wgid = (int)L; { const int q = nwg / NXCD, r = nwg % NXCD, xcd = wgid % NXCD, off = wgid / NXCD; wgid = (xcd < r ? xcd * (q + 1) : r * (q + 1) + (xcd - r) * q) + off; }
        const int nig = WGM * nN, gid = wgid / nig, fm = gid * WGM, gsz = (nM - fm) < WGM ? (nM - fm) : WGM;
        u.pm = fm + ((wgid % nig) % gsz); u.pn = (wgid % nig) / gsz; u.e = 0; u.full = 1; u.pos0 = 0; return true;
    }
    __device__ __forceinline__ void between(int) const {}
};
struct MoeOrder {
    const LAS int* tab; int r, nper, i0, imax;
    __device__ bool next(int i, Unit& u) const {
        if (i >= imax) return false;
        const int L = (i0 + i) * nper + r; if (L >= __builtin_amdgcn_readfirstlane(tab[1])) return false;
        int p = 0; const int np = tab[0];
#pragma unroll 1
        while (p + 1 < np && tab[4 + 8 * (p + 1)] <= L) ++p;
        const LAS int* t = tab + 4 + 8 * p;
        const int local = L - t[0], mte = t[3], pq = local / mte, mt = local - pq * mte;
        u.e = __builtin_amdgcn_readfirstlane(t[1]); u.pn = __builtin_amdgcn_readfirstlane(t[2] + pq); u.pm = __builtin_amdgcn_readfirstlane(t[4] + mt);
        u.full = __builtin_amdgcn_readfirstlane((t[5] - mt * 256) > 128 ? 1 : 0); u.pos0 = __builtin_amdgcn_readfirstlane(mt * 256); return true;
    }
    __device__ __forceinline__ void between(int) const {}
};

struct EpiProj {
    static constexpr bool PERM = true;
    bf16_t* O; int ldc;
    __device__ __forceinline__ void operator()(const f32x4 (&acc)[2][2][4][2], const Unit& u, int wr, int wc, int fr, int fq) const {
        const int row0 = u.pm * BM + wr * 64 + fr, col0 = u.pn * BM + wc * 32 + 8 * fq;
#pragma unroll
        for (int ai = 0; ai < 2; ++ai)
#pragma unroll
            for (int m = 0; m < 4; ++m) { bf16_t* rowp = O + (size_t)(row0 + ai * HALF + m * 16) * ldc + col0;
#pragma unroll
                for (int bj = 0; bj < 2; ++bj) { const f32x4 v0 = acc[ai][bj][m][0], v1 = acc[ai][bj][m][1];
                    u32x4 w; w.x = cvt_pk_bf16(v0[0], v0[1]); w.y = cvt_pk_bf16(v0[2], v0[3]); w.z = cvt_pk_bf16(v1[0], v1[1]); w.w = cvt_pk_bf16(v1[2], v1[3]);
                    *(u32x4*)(rowp + bj * HALF) = w;
#if PROBE_STORE2 == 1
                    *(u32x4*)(rowp + bj * HALF + (size_t)1792 * 1024 * 1024) = w;
#endif
                } }
    }
};
struct EpiOut {
    static constexpr bool PERM = false;
    const float* X; const float* g1;   float* O;
    __device__ __forceinline__ void operator()(const f32x4 (&acc)[2][2][4][2], const Unit& u, int wr, int wc, int fr, int fq) const {
        const int row0 = u.pm * BM + wr * 64 + fr, col0 = u.pn * BM + wc * 32 + 4 * fq;
        const float* gp = g1 + (size_t)((u.pm * BM) >> 12) * 12288 + col0;
        f32x4 gv[2][2];
#pragma unroll
        for (int bj = 0; bj < 2; ++bj)
#pragma unroll
            for (int n = 0; n < 2; ++n) gv[bj][n] = *(const f32x4*)(gp + bj * HALF + n * 16);
#pragma unroll
        for (int ai = 0; ai < 2; ++ai)
#pragma unroll
            for (int m = 0; m < 4; ++m) { const size_t off = (size_t)(row0 + ai * HALF + m * 16) * DM + col0;
#pragma unroll
                for (int bj = 0; bj < 2; ++bj)
#pragma unroll
                    for (int n = 0; n < 2; ++n) { const f32x4 xv = *(const f32x4*)(X + off + bj * HALF + n * 16);
                        *(f32x4*)(O + off + bj * HALF + n * 16) = xv + gv[bj][n] * acc[ai][bj][m][n]; }
                asm volatile("" ::: "memory"); }
    }
};
struct EpiGU {
    static constexpr bool PERM = true;
    const float* bias;   bf16_t* O;
    __device__ __forceinline__ void operator()(const f32x4 (&acc)[2][2][4][2], const Unit& u, int wr, int wc, int fr, int fq) const {
        const int row0 = u.pm * BM + wr * 64 + fr, cc = u.pn * HALF + wc * 32 + 8 * fq;
        const float* bp = bias + (size_t)u.e * 4096 + cc;
        f32x4 bg[2], bu[2];
#pragma unroll
        for (int n = 0; n < 2; ++n) { bg[n] = *(const f32x4*)(bp + 4 * n); bu[n] = *(const f32x4*)(bp + 2048 + 4 * n); }
#pragma unroll
        for (int ai = 0; ai < 2; ++ai)
#pragma unroll
            for (int m = 0; m < 4; ++m) { float r[8];
#pragma unroll
                for (int n = 0; n < 2; ++n)
#pragma unroll
                    for (int j = 0; j < 4; ++j) {
                        float g = acc[ai][0][m][n][j] + bg[n][j], uu = acc[ai][1][m][n][j] + bu[n][j];
                        g = fminf(g, 7.0f); uu = fminf(fmaxf(uu, -7.0f), 7.0f);
                        const float glu = g * __builtin_amdgcn_rcpf(1.0f + __expf(-1.702f * g));
                        r[n * 4 + j] = (uu + 1.0f) * glu;
#if FP8_EMU
                        r[n * 4 + j] = q8(r[n * 4 + j]);
#endif
                    }
                u32x4 w; w.x = cvt_pk_bf16(r[0], r[1]); w.y = cvt_pk_bf16(r[2], r[3]); w.z = cvt_pk_bf16(r[4], r[5]); w.w = cvt_pk_bf16(r[6], r[7]);
                *(u32x4*)(O + (size_t)(row0 + ai * HALF + m * 16) * DM + cc) = w; }
    }
};
struct EpiDown {
    static constexpr bool PERM = true;
    const float* bias;   const float* wbuf; bf16_t* O;
    __device__ __forceinline__ void operator()(const f32x4 (&acc)[2][2][4][2], const Unit& u, int wr, int wc, int fr, int fq) const {
        const int row0 = u.pm * BM + wr * 64 + fr, col0 = u.pn * BM + wc * 32 + 8 * fq;
        const float* bp = bias + (size_t)u.e * 2048 + col0;
        f32x4 bv[2][2];
#pragma unroll
        for (int bj = 0; bj < 2; ++bj)
#pragma unroll
            for (int n = 0; n < 2; ++n) bv[bj][n] = *(const f32x4*)(bp + bj * HALF + 4 * n);
#pragma unroll
        for (int ai = 0; ai < 2; ++ai)
#pragma unroll
            for (int m = 0; m < 4; ++m) { const int row = row0 + ai * HALF + m * 16; const float rw = wbuf[row]; bf16_t* rowp = O + (size_t)row * DM + col0;
#pragma unroll
                for (int bj = 0; bj < 2; ++bj) { const f32x4 v0 = (acc[ai][bj][m][0] + bv[bj][0]) * rw, v1 = (acc[ai][bj][m][1] + bv[bj][1]) * rw;
                    u32x4 w; w.x = cvt_pk_bf16(v0[0], v0[1]); w.y = cvt_pk_bf16(v0[2], v0[3]); w.z = cvt_pk_bf16(v1[0], v1[1]); w.w = cvt_pk_bf16(v1[2], v1[3]);
                    *(u32x4*)(rowp + bj * HALF) = w; } }
    }
};

__device__ __forceinline__ unsigned pk4_fp8(float a, float b, float c, float d) { int p = __builtin_amdgcn_cvt_pk_fp8_f32(a, b, 0, false); p = __builtin_amdgcn_cvt_pk_fp8_f32(c, d, p, true); return (unsigned)p; }
constexpr float W8_SCALE = 64.0f, W8_INV = 1.0f / 64.0f;
struct EpiGU8 {
    static constexpr bool PERM = true;
    const float* bias;   unsigned char* O;
    __device__ __forceinline__ void operator()(const f32x4 (&acc)[2][2][4][2], const Unit& u, int wr, int wc, int fr, int fq) const {
        const int row0 = u.pm * BM + wr * 64 + fr, cc = u.pn * HALF + wc * 32 + 8 * fq;
        const float* bp = bias + (size_t)u.e * 4096 + cc;
        f32x4 bg[2], bu[2];
#pragma unroll
        for (int n = 0; n < 2; ++n) { bg[n] = *(const f32x4*)(bp + 4 * n); bu[n] = *(const f32x4*)(bp + 2048 + 4 * n); }
#pragma unroll
        for (int ai = 0; ai < 2; ++ai)
#pragma unroll
            for (int m = 0; m < 4; ++m) { float r[8];
#pragma unroll
                for (int n = 0; n < 2; ++n)
#pragma unroll
                    for (int j = 0; j < 4; ++j) {
                        float g = acc[ai][0][m][n][j] * W8_INV + bg[n][j], uu = acc[ai][1][m][n][j] * W8_INV + bu[n][j];
                        g = fminf(g, 7.0f); uu = fminf(fmaxf(uu, -7.0f), 7.0f);
                        const float glu = g * __builtin_amdgcn_rcpf(1.0f + __expf(-1.702f * g));
                        r[n * 4 + j] = (uu + 1.0f) * glu; }
                u32x2 w; w.x = pk4_fp8(r[0], r[1], r[2], r[3]); w.y = pk4_fp8(r[4], r[5], r[6], r[7]);
                *(u32x2*)(O + (size_t)(row0 + ai * HALF + m * 16) * DM + cc) = w; }
    }
};
struct EpiDown8 {
    static constexpr bool PERM = true;
    const float* bias;   const float* wbuf; bf16_t* O;
    __device__ __forceinline__ void operator()(const f32x4 (&acc)[2][2][4][2], const Unit& u, int wr, int wc, int fr, int fq) const {
        const int row0 = u.pm * BM + wr * 64 + fr, col0 = u.pn * BM + wc * 32 + 8 * fq;
        const float* bp = bias + (size_t)u.e * 2048 + col0;
        f32x4 bv[2][2];
#pragma unroll
        for (int bj = 0; bj < 2; ++bj)
#pragma unroll
            for (int n = 0; n < 2; ++n) bv[bj][n] = *(const f32x4*)(bp + bj * HALF + 4 * n);
#pragma unroll
        for (int ai = 0; ai < 2; ++ai)
#pragma unroll
            for (int m = 0; m < 4; ++m) { const int row = row0 + ai * HALF + m * 16; const float rw = wbuf[(size_t)u.e * 8192 + u.pos0 + (row - u.pm * BM)]; bf16_t* rowp = O + (size_t)row * DM + col0;
#pragma unroll
                for (int bj = 0; bj < 2; ++bj) { const f32x4 v0 = (acc[ai][bj][m][0] * W8_INV + bv[bj][0]) * rw, v1 = (acc[ai][bj][m][1] * W8_INV + bv[bj][1]) * rw;
                    u32x4 w; w.x = cvt_pk_bf16(v0[0], v0[1]); w.y = cvt_pk_bf16(v0[2], v0[3]); w.z = cvt_pk_bf16(v1[0], v1[1]); w.w = cvt_pk_bf16(v1[2], v1[3]);
                    *(u32x4*)(rowp + bj * HALF) = w; } }
    }
};

typedef int i32x8 __attribute__((ext_vector_type(8)));
typedef short s16x16 __attribute__((ext_vector_type(16)));
__device__ __forceinline__ i32x8 ld32(const LAS unsigned char* p) { const bf16x8 lo = *(const LAS bf16x8*)p, hi = *(const LAS bf16x8*)(p + 1024); return __builtin_bit_cast(i32x8, __builtin_shufflevector(lo, hi, 0, 1, 2, 3, 4, 5, 6, 7, 8, 9, 10, 11, 12, 13, 14, 15)); }
__device__ __forceinline__ const char* sbase(const char* p) { asm volatile("" : "+s"(p)); return p; }
template <bool FP8, bool GATHER, class Epi, class Sched>
__device__ __forceinline__ void gemm_phase(LAS unsigned char* lds, const Gemm g, const Sched& S, const Epi& E) {
    const int tid = threadIdx.x, wid = __builtin_amdgcn_readfirstlane(tid >> 6), lane = tid & 63, wr = wid >> 2, wc = wid & 3, fr = lane & 15, fq = lane >> 4;
    const int K = g.K, nt = K / BK;
    unsigned voffA, voffB;
    { int R, C; stage_rc(tid * 16, R, C); const int Rb = Epi::PERM ? ((R & ~31) + perm32(R & 31)) : R; voffA = (unsigned)(R * K + C) * 2u; voffB = (unsigned)(Rb * K + C) * 2u; }
    const size_t pstep = (size_t)64 * K * 2;
    unsigned voffC = 0, ro[4] = {0, 0, 0, 0}; int Rl = 0;
    if constexpr (GATHER) { int R, C; stage_rc(tid * 16, R, C); voffC = (unsigned)C * 2u; Rl = R; }
#define PG8_ROWS(x0, uidx) do { ro[x0] = (unsigned)g.rowtab[(uidx) * 256 + Rl + 64 * (x0)]; ro[(x0) + 1] = (unsigned)g.rowtab[(uidx) * 256 + Rl + 64 * (x0) + 64]; } while (0)
    const size_t kstep = (size_t)(BK * 2);
    const size_t hstep = (size_t)HALF * K * 2;
    const size_t tstep = 2 * hstep;
    const size_t estep = g.b_estride * 2;
    const unsigned ldsw = (unsigned)wid * 1024u;
    const int aoff0 = lds_byte(wr * 64 + fr, fq * 8), boff0 = lds_byte(wc * 32 + fr, fq * 8);
#define PG8_SA(b, h) (((b) * 2 + (h)) * HTB)
#define PG8_SB(b, h) ((4 + (b) * 2 + (h)) * HTB)
#define PG8_STAGE(bufoff, gbase, voff) do { _Pragma("unroll") for (int _i = 0; _i < 2; ++_i) \
        __builtin_amdgcn_global_load_lds((const unsigned*)(sbase((const char*)(gbase) + _i * pstep) + (voff)), (LAS unsigned*)(lds + (bufoff) + ldsw + _i * 8192), 16, 0, 0); } while (0)
#define PG8_STAGEA(bufoff, isnext, half, koff) do { if constexpr (GATHER) { _Pragma("unroll") for (int _i = 0; _i < 2; ++_i) { const unsigned _r = ro[(half) * 2 + _i]; \
            __builtin_amdgcn_global_load_lds((const unsigned*)(sbase((const char*)g.A + (koff)) + (_r + voffC)), (LAS unsigned*)(lds + (bufoff) + ldsw + _i * 8192), 16, 0, 0); } } \
        else { PG8_STAGE(bufoff, ((isnext) ? nA : cA) + (half) * hstep + (koff), voffA); } } while (0)
#define PG8_LDA(dst, b, h) do { _Pragma("unroll") for (int m = 0; m < 4; ++m) { \
        if constexpr (FP8) dst##8[m] = ld32(lds + PG8_SA(b, h) + aoff0 + m * 2048); \
        else { dst[m][0] = *(const LAS bf16x8*)(lds + PG8_SA(b, h) + aoff0 + m * 2048); dst[m][1] = *(const LAS bf16x8*)(lds + PG8_SA(b, h) + aoff0 + m * 2048 + 1024); } } } while (0)
#define PG8_LDB(dst, b, h) do { _Pragma("unroll") for (int n = 0; n < 2; ++n) { \
        if constexpr (FP8) dst##8[n] = ld32(lds + PG8_SB(b, h) + boff0 + n * 2048); \
        else { dst[n][0] = *(const LAS bf16x8*)(lds + PG8_SB(b, h) + boff0 + n * 2048); dst[n][1] = *(const LAS bf16x8*)(lds + PG8_SB(b, h) + boff0 + n * 2048 + 1024); } } } while (0)
#define PG8_MMA(ai, bj, At, Bt) do { __builtin_amdgcn_s_setprio(1); _Pragma("unroll") for (int m = 0; m < 4; ++m) _Pragma("unroll") for (int n = 0; n < 2; ++n) { \
        if constexpr (FP8) { if (FP8_ASM) { asm volatile("v_mfma_scale_f32_16x16x128_f8f6f4 %0, %1, %2, %0, %3, %3 op_sel_hi:[0,0,0]" : "+a"(acc[ai][bj][m][n]) : "v"(Bt##8[n]), "v"(At##8[m]), "v"(scale1)); } \
            else acc[ai][bj][m][n] = __builtin_amdgcn_mfma_scale_f32_16x16x128_f8f6f4(Bt##8[n], At##8[m], acc[ai][bj][m][n], 0, 0, 0, FP8_SCALE_ARG, 0, FP8_SCALE_ARG); } \
        else { acc[ai][bj][m][n] = __builtin_amdgcn_mfma_f32_16x16x32_bf16(Bt[n][0], At[m][0], acc[ai][bj][m][n], 0, 0, 0); \
               acc[ai][bj][m][n] = __builtin_amdgcn_mfma_f32_16x16x32_bf16(Bt[n][1], At[m][1], acc[ai][bj][m][n], 0, 0, 0); } } \
        __builtin_amdgcn_s_setprio(0); } while (0)
#define PG8_WAIT_V(n) asm volatile("s_waitcnt vmcnt(" #n ")" ::: "memory")
#define PG8_WAIT_L(n) asm volatile("s_waitcnt lgkmcnt(" #n ")" ::: "memory")
#define PG8_BAR __builtin_amdgcn_s_barrier()
#define PG8_SCHED __builtin_amdgcn_sched_barrier(0)
#ifdef PROBE_GMAX
    const unsigned long long tg0 = __builtin_amdgcn_s_memrealtime();
#endif
    Unit cur, nxt; int ui = 0;
#ifdef PROBE_EPI
    unsigned long long epi_acc = 0;
#endif
    if (!S.next(0, cur)) return;
    f32x4 acc[2][2][4][2];
#pragma unroll
    for (int a = 0; a < 2; ++a)
#pragma unroll
        for (int b = 0; b < 2; ++b)
#pragma unroll
            for (int m = 0; m < 4; ++m)
#pragma unroll
                for (int n = 0; n < 2; ++n) acc[a][b][m][n] = (f32x4){0.f, 0.f, 0.f, 0.f};
    bf16x8 At[4][2], B0[2][2], B1[2][2]; i32x8 At8[4], B08[2], B18[2];
    const unsigned scale1 = 0x7f7f7f7fu;
    const char* cA = (const char*)g.A + (size_t)cur.pm * tstep; const char* cB = (const char*)g.Bt + (size_t)cur.e * estep + (size_t)cur.pn * tstep;
    const char* nA = cA;
    if constexpr (GATHER) { PG8_ROWS(0, 0); PG8_ROWS(2, 0); }
    PG8_STAGE(PG8_SB(0, 0), cB, voffB); PG8_STAGEA(PG8_SA(0, 0), false, 0, 0); PG8_STAGE(PG8_SB(0, 1), cB + hstep, voffB); PG8_STAGEA(PG8_SA(0, 1), false, 1, 0);
    if (wr == 1) PG8_BAR;
    PG8_WAIT_V(4); PG8_BAR;
    PG8_STAGE(PG8_SB(1, 0), cB + kstep, voffB); PG8_STAGEA(PG8_SA(1, 0), false, 0, kstep); PG8_STAGE(PG8_SB(1, 1), cB + hstep + kstep, voffB);
    PG8_WAIT_V(6); PG8_BAR;
    for (;;) {
        const bool has_next = S.next(ui + 1, nxt);
        const bool cfull = FP8 ? true : (cur.full != 0);
        nA = has_next ? (const char*)g.A + (size_t)nxt.pm * tstep : cA;
        const char* nB = has_next ? (const char*)g.Bt + (size_t)nxt.e * estep + (size_t)nxt.pn * tstep : cB;
#ifdef PROBE_KL
        const unsigned long long tk0 = __builtin_amdgcn_s_memrealtime();
#endif
        for (int t = 0; t < nt; t += 2) {
            const bool last = (t == nt - 2);
            const size_t k1 = (size_t)(t + 1) * kstep, k2 = last ? 0 : (size_t)(t + 2) * kstep, k3 = k2 + kstep;
            const char* b2 = last ? nB : cB + (size_t)(t + 2) * kstep; const char* b3 = b2 + kstep;
            if constexpr (GATHER) { if (last && has_next) PG8_ROWS(0, ui + 1); }
            PG8_LDB(B0, 0, 0); PG8_SCHED; PG8_LDA(At, 0, 0); PG8_STAGEA(PG8_SA(1, 1), false, 1, k1);
            if constexpr (GATHER) { if (last && has_next) PG8_ROWS(2, ui + 1); }
            PG8_WAIT_V(10); PG8_WAIT_L(8); PG8_BAR; PG8_WAIT_L(0); PG8_MMA(0, 0, At, B0); PG8_BAR; PG8_SCHED;
            PG8_LDB(B1, 0, 1); PG8_STAGE(PG8_SB(0, 0), b2, voffB);
            PG8_WAIT_V(10); PG8_BAR; PG8_WAIT_L(0); PG8_MMA(0, 1, At, B1); PG8_BAR;
            PG8_LDA(At, 0, 1); PG8_STAGEA(PG8_SA(0, 0), last, 0, k2);
            PG8_BAR; PG8_WAIT_L(0); if (cfull) PG8_MMA(1, 0, At, B0); PG8_BAR; PG8_SCHED;
            PG8_STAGE(PG8_SB(0, 1), b2 + hstep, voffB);
            PG8_WAIT_V(10); PG8_BAR; if (cfull) PG8_MMA(1, 1, At, B1); PG8_BAR;
            PG8_LDB(B0, 1, 0); PG8_SCHED; PG8_LDA(At, 1, 0); PG8_STAGEA(PG8_SA(0, 1), last, 1, k2);
            PG8_WAIT_V(10); PG8_WAIT_L(8); PG8_BAR; PG8_WAIT_L(0); PG8_MMA(0, 0, At, B0); PG8_BAR; PG8_SCHED;
            PG8_LDB(B1, 1, 1); PG8_STAGE(PG8_SB(1, 0), b3, voffB);
            PG8_WAIT_V(10); PG8_BAR; PG8_WAIT_L(0); PG8_MMA(0, 1, At, B1); PG8_BAR;
            PG8_LDA(At, 1, 1); PG8_STAGEA(PG8_SA(1, 0), last, 0, k3);
            PG8_BAR; PG8_WAIT_L(0); if (cfull) PG8_MMA(1, 0, At, B0); PG8_BAR; PG8_SCHED;
            PG8_STAGE(PG8_SB(1, 1), b3 + hstep, voffB);
            PG8_WAIT_V(10); PG8_BAR; if (cfull) PG8_MMA(1, 1, At, B1); PG8_BAR;
        }
#ifdef PROBE_KL
        if (FP8 && (GATHER ? 9 : 10) == PROBE_EPI) epi_acc += __builtin_amdgcn_s_memrealtime() - tk0;
#endif
        {
            int tz = threadIdx.x; asm volatile("" : "+v"(tz)); const int lz = tz & 63;
#ifdef PROBE_EPI
            const unsigned long long te0 = __builtin_amdgcn_s_memrealtime();
#endif
            E(acc, cur, wr, wc, lz & 15, lz >> 4);
#ifdef PROBE_EPI
#ifndef PROBE_KL
            if (FP8 && (GATHER ? 9 : 10) == PROBE_EPI) { epi_acc += __builtin_amdgcn_s_memrealtime() - te0; }
#endif
#endif
            }
        S.between(ui);
        if (!has_next) break;
#pragma unroll
        for (int a = 0; a < 2; ++a)
#pragma unroll
            for (int b = 0; b < 2; ++b)
#pragma unroll
                for (int m = 0; m < 4; ++m)
#pragma unroll
                    for (int n = 0; n < 2; ++n) acc[a][b][m][n] = (f32x4){0.f, 0.f, 0.f, 0.f};
        cur = nxt; cA = nA; cB = nB; ++ui;

    }
#ifdef PROBE_EPI
    if (FP8 && (GATHER ? 9 : 10) == PROBE_EPI && blockIdx.x == 0 && threadIdx.x == 0) *(unsigned long long*)((char*)g.probe) = epi_acc;
#endif
#ifdef PROBE_GMAX
    if (FP8 && (GATHER ? 9 : 10) == PROBE_GMAX && threadIdx.x == 0) { const unsigned d = (unsigned)(__builtin_amdgcn_s_memrealtime() - tg0); if (PROBE_GMIN) atomicMin((unsigned*)((char*)g.probe + 8), d); else atomicMax((unsigned*)((char*)g.probe + 8), d); }
#endif
    PG8_WAIT_V(0);
    if (wr == 0) PG8_BAR;
    PG8_BAR;
#undef PG8_SA
#undef PG8_SB
#undef PG8_STAGE
#undef PG8_STAGEA
#undef PG8_ROWS
#undef PG8_LDA
#undef PG8_LDB
#undef PG8_MMA
#undef PG8_WAIT_V
#undef PG8_WAIT_L
#undef PG8_BAR
#undef PG8_SCHED
}
}

__device__ __forceinline__ void conv_job(const float* src, int ld, bf16_t* dst, int kt) {
    const int w = threadIdx.x >> 6, lane = threadIdx.x & 63, kseg = lane & 7, nq = lane >> 3;
    const int k0 = kt * 128 + (w >> 2) * 64 + kseg * 8, nl = (w & 3) * 32 + nq * 4;
    f32x4 v[8];
#pragma unroll
    for (int r = 0; r < 8; ++r) v[r] = *(const f32x4*)(src + (size_t)(k0 + r) * ld + nl);
#if FP8_EMU
#pragma unroll
    for (int r = 0; r < 8; ++r)
#pragma unroll
        for (int j = 0; j < 4; ++j) v[r][j] = q8(v[r][j] * 64.0f) * (1.0f / 64.0f);
#endif
#pragma unroll
    for (int j = 0; j < 4; ++j) { u32x4 o; o.x = cvt_pk_bf16(v[0][j], v[1][j]); o.y = cvt_pk_bf16(v[2][j], v[3][j]); o.z = cvt_pk_bf16(v[4][j], v[5][j]); o.w = cvt_pk_bf16(v[6][j], v[7][j]);
        *(u32x4*)(dst + (size_t)(nl + j) * 2048 + k0) = o; }
}
constexpr int CONV_JOBS_GU = 32 * 16 * 16, CONV_JOBS_D = 32 * 16 * 8, CONV_JOBS = CONV_JOBS_GU + CONV_JOBS_D;
__device__ __forceinline__ void conv_block_job(const Args& a, LAS unsigned char* T, int j) {
    const int tid = threadIdx.x, w = tid >> 6, lane = tid & 63;
    const float* src; int ld; unsigned char* dst; int gu, s0;
    if (j < CONV_JOBS_GU) { const int e = j >> 8, kb = (j >> 4) & 15, nb = j & 15; s0 = nb * 256; gu = 1;
        src = a.w_gate_up + ((size_t)e * 2048 + kb * 128) * 4096 + s0; ld = 4096; dst = (unsigned char*)(a.ws + WS_WGU_T) + (size_t)e * 4096 * 2048 + kb * 128; }
    else { const int jj = j - CONV_JOBS_GU, e = jj >> 7, kb = (jj >> 3) & 15, nb = jj & 7; s0 = nb * 256; gu = 0;
        src = a.w_down + ((size_t)e * 2048 + kb * 128) * 2048 + s0; ld = 2048; dst = (unsigned char*)(a.ws + WS_WD_T) + (size_t)e * 2048 * 2048 + kb * 128; }
    f32x4 v[16];
#pragma unroll
    for (int r = 0; r < 16; ++r) v[r] = __builtin_nontemporal_load((const f32x4*)(src + (size_t)(w * 16 + r) * ld + lane * 4)) * pg8::W8_SCALE;
#pragma unroll
    for (int jn = 0; jn < 4; ++jn) { u32x4 o;
        o.x = pg8::pk4_fp8(v[0][jn], v[1][jn], v[2][jn], v[3][jn]); o.y = pg8::pk4_fp8(v[4][jn], v[5][jn], v[6][jn], v[7][jn]);
        o.z = pg8::pk4_fp8(v[8][jn], v[9][jn], v[10][jn], v[11][jn]); o.w = pg8::pk4_fp8(v[12][jn], v[13][jn], v[14][jn], v[15][jn]);
        const int n = lane * 4 + jn;
        *(LAS u32x4*)(T + n * 128 + ((w ^ (lane & 7)) << 4)) = o; }
    __syncthreads();
#pragma unroll
    for (int p = 0; p < 4; ++p) { const int idx = tid + 512 * p, n = idx >> 3, wq = idx & 7;
        const u32x4 o = *(const LAS u32x4*)(T + n * 128 + ((wq ^ ((n >> 2) & 7)) << 4));
        const int c = s0 + n; int np = c;
        if (gu) { const int bj = c >> 11, rem = c & 2047; np = (rem >> 7) * 256 + bj * 128 + (rem & 127); }
        __builtin_nontemporal_store(o, (u32x4*)(dst + (size_t)np * 2048 + wq * 16)); }
}
constexpr int SJOBS_GU = 32 * 32 * 128, SJOBS_D = 32 * 32 * 64, SJOBS = SJOBS_GU + SJOBS_D;
constexpr int SJOBS_ATTN = 256 * 33 * 8;
typedef short s16x2 __attribute__((ext_vector_type(2)));
__device__ __forceinline__ unsigned pk4_fp8_scaled(float a, float b, float c, float d) { s16x2 r = {0, 0}; r = __builtin_amdgcn_cvt_scalef32_pk_fp8_f32(r, a, b, pg8::W8_INV, false); r = __builtin_amdgcn_cvt_scalef32_pk_fp8_f32(r, c, d, pg8::W8_INV, true); return __builtin_bit_cast(unsigned, r); }
struct SJob { const float* src; unsigned char* dst; int ld; };
__device__ __forceinline__ SJob sjob_addr(const Args& a, int j, int lane) {
    SJob c; const int kseg = lane & 7, nq = lane >> 3;
    if (j < SJOBS_GU) { const int e = j >> 12, kb = (j >> 7) & 31, nb = j & 127, s0 = nb * 32, bj = s0 >> 11, rem = s0 & 2047, pn = rem >> 7, c0 = rem & 127, np = pn * 256 + bj * 128 + c0;
        c.ld = 4096; c.src = a.w_gate_up + ((size_t)e * 2048 + kb * 64 + kseg * 8) * 4096 + s0 + nq * 4; c.dst = (unsigned char*)(a.ws + WS_WGU_T) + ((size_t)e * 4096 + np + nq * 4) * 2048 + kb * 64 + kseg * 8; }
    else { const int jj = j - SJOBS_GU, e = jj >> 11, kb = (jj >> 6) & 31, nb = jj & 63;
        c.ld = 2048; c.src = a.w_down + ((size_t)e * 2048 + kb * 64 + kseg * 8) * 2048 + nb * 32 + nq * 4; c.dst = (unsigned char*)(a.ws + WS_WD_T) + ((size_t)e * 2048 + nb * 32 + nq * 4) * 2048 + kb * 64 + kseg * 8; }
    return c;
}
__device__ __forceinline__ void sjob_load(const SJob& c, f32x4 (&v)[8]) {
#pragma unroll
    for (int r = 0; r < 8; ++r) v[r] = __builtin_nontemporal_load((const f32x4*)(c.src + (size_t)r * c.ld));
}
__device__ __forceinline__ void sjob_store(const SJob& c, const f32x4 (&v)[8]) {
#pragma unroll
    for (int jn = 0; jn < 4; ++jn) { u32x2 o;
        o.x = pk4_fp8_scaled(v[0][jn], v[1][jn], v[2][jn], v[3][jn]); o.y = pk4_fp8_scaled(v[4][jn], v[5][jn], v[6][jn], v[7][jn]);
        __builtin_nontemporal_store(o, (u32x2*)(c.dst + (size_t)jn * 2048)); }
}
__device__ __forceinline__ void conv_share(const Args& a, int blk, int G) {
    const int s = blk % 3, r = blk / 3, nb = (G - s + 2) / 3, w = threadIdx.x >> 6, lane = threadIdx.x & 63;
    const int npair = (SJOBS - SJOBS_ATTN) / 2, p0 = s * (npair / 3), p1 = (s == 2) ? npair : (s + 1) * (npair / 3);
    int p = p0 + r * 8 + w; const int step = nb * 8;
    if (p >= p1) return;
    f32x4 va0[8], va1[8], vb0[8], vb1[8]; SJob ca = sjob_addr(a, SJOBS_ATTN + 2 * p, lane), cb = ca, t;
    sjob_load(ca, va0); t = ca; t.src += 32; sjob_load(t, va1);
#pragma unroll 1
    for (;;) {
        const bool hb = (p + step) < p1; if (hb) { cb = sjob_addr(a, SJOBS_ATTN + 2 * (p + step), lane); sjob_load(cb, vb0); t = cb; t.src += 32; sjob_load(t, vb1); }
        sjob_store(ca, va0); t = ca; t.dst += 32 * 2048; sjob_store(t, va1);
        if (!hb) break;
        p += step;
        const bool ha = (p + step) < p1; if (ha) { ca = sjob_addr(a, SJOBS_ATTN + 2 * (p + step), lane); sjob_load(ca, va0); t = ca; t.src += 32; sjob_load(t, va1); }
        sjob_store(cb, vb0); t = cb; t.dst += 32 * 2048; sjob_store(t, vb1);
        if (!ha) break;
        p += step;
    }
}
struct BJob { const float* src; unsigned char* dst; int ld, gu, s0; };
__device__ __forceinline__ BJob bjob_addr(const Args& a, int j) {
    BJob c;
    if (j < CONV_JOBS_GU) { const int e = j >> 8, kb = (j >> 4) & 15, nb = j & 15; c.s0 = nb * 256; c.gu = 1;
        c.src = a.w_gate_up + ((size_t)e * 2048 + kb * 128) * 4096 + c.s0; c.ld = 4096; c.dst = (unsigned char*)(a.ws + WS_WGU_T) + (size_t)e * 4096 * 2048 + kb * 128; }
    else { const int jj = j - CONV_JOBS_GU, e = jj >> 7, kb = (jj >> 3) & 15, nb = jj & 7; c.s0 = nb * 256; c.gu = 0;
        c.src = a.w_down + ((size_t)e * 2048 + kb * 128) * 2048 + c.s0; c.ld = 2048; c.dst = (unsigned char*)(a.ws + WS_WD_T) + (size_t)e * 2048 * 2048 + kb * 128; }
    return c;
}
__device__ __forceinline__ void bjob_load(const BJob& c, f32x4 (&v)[16]) {
    int tz = threadIdx.x; asm volatile("" : "+v"(tz));
    const int w = tz >> 6, lane = tz & 63;
#pragma unroll
    for (int r = 0; r < 16; ++r) v[r] = __builtin_nontemporal_load((const f32x4*)(c.src + (size_t)(w * 16 + r) * c.ld + lane * 4));
}
__device__ __forceinline__ void bjob_pack(const f32x4 (&v)[16], u32x4 (&o)[4]) {
#pragma unroll
    for (int jn = 0; jn < 4; ++jn) {
        o[jn].x = pk4_fp8_scaled(v[0][jn], v[1][jn], v[2][jn], v[3][jn]); o[jn].y = pk4_fp8_scaled(v[4][jn], v[5][jn], v[6][jn], v[7][jn]);
        o[jn].z = pk4_fp8_scaled(v[8][jn], v[9][jn], v[10][jn], v[11][jn]); o[jn].w = pk4_fp8_scaled(v[12][jn], v[13][jn], v[14][jn], v[15][jn]); }
}
__device__ __forceinline__ void bjob_out(const BJob& c, const u32x4 (&o)[4], LAS unsigned char* Tlo, LAS unsigned char* Thi) {
    int tz = threadIdx.x; asm volatile("" : "+v"(tz));
    const int tid = tz, w = tid >> 6, lane = tid & 63;
    LAS unsigned char* Tw = (lane < 32) ? Tlo : Thi;
#pragma unroll
    for (int jn = 0; jn < 4; ++jn) { const int nl = (lane & 31) * 4 + jn;
        *(LAS u32x4*)(Tw + nl * 128 + ((w ^ (lane & 7)) << 4)) = o[jn]; }
    asm volatile("s_waitcnt lgkmcnt(0)" ::: "memory"); __builtin_amdgcn_s_barrier(); asm volatile("" ::: "memory");
#pragma unroll
    for (int p = 0; p < 4; ++p) { const int idx = tid + 512 * p, n = idx >> 3, wq = idx & 7;
        const LAS unsigned char* Tr = (n < 128) ? Tlo : Thi;
        const u32x4 ov = *(const LAS u32x4*)(Tr + (n & 127) * 128 + ((wq ^ ((n >> 2) & 7)) << 4));
        const int cc = c.s0 + n; int np = cc;
        if (c.gu) { const int bj = cc >> 11, rem = cc & 2047; np = (rem >> 7) * 256 + bj * 128 + (rem & 127); }
        __builtin_nontemporal_store(ov, (u32x4*)(c.dst + (size_t)np * 2048 + wq * 16)); }
    asm volatile("s_waitcnt lgkmcnt(0)" ::: "memory"); __builtin_amdgcn_s_barrier(); asm volatile("" ::: "memory");
}
#ifndef CONV_IN_ATTN
#define CONV_IN_ATTN 1
#endif
constexpr int BJOB0 = CONV_IN_ATTN ? 16 * 256 + 8 * 16 : 0;
__device__ __forceinline__ void conv_share_blk(const Args& a, LAS unsigned char* lds, int blk, int G) {
    const int s = blk % 3, r = blk / 3, nb = (G - s + 2) / 3, nj = CONV_JOBS - BJOB0, j0 = BJOB0 + s * (nj / 3), j1 = (s == 2) ? CONV_JOBS : BJOB0 + (s + 1) * (nj / 3);
    LAS unsigned char* Tlo = lds + 3 * 16384; LAS unsigned char* Thi = lds + LDS_EXTRA;
    int j = j0 + r; if (j >= j1) return;
    f32x4 v[16]; u32x4 o[4]; BJob cc = bjob_addr(a, j);
    bjob_load(cc, v);
#pragma unroll 1
    for (;;) {
        bjob_pack(v, o);
        const BJob cur = cc; const bool hn = (j + nb) < j1;
        if (hn) { cc = bjob_addr(a, j + nb); bjob_load(cc, v); }
        bjob_out(cur, o, Tlo, Thi);
        if (!hn) break;
        j += nb;
    }
}
__device__ __forceinline__ void conv_all(const Args& a, LAS unsigned char* lds) {
    int buf = 0;
    for (int j = blockIdx.x; j < CONV_JOBS; j += gridDim.x) { conv_block_job(a, lds + buf * 32768, j); buf ^= 1; }
    __syncthreads();
}
__device__ __forceinline__ bool conv_claim(const Args&, int) { return false; }

__device__ __forceinline__ void phase_prologue(const Args& a, LAS unsigned char* lds) {
    const int tid = threadIdx.x, blk = blockIdx.x, G = gridDim.x;
    if (blk < 192) {
        LAS float* cact = (LAS float*)lds; LAS float* red = (LAS float*)(lds + 16384);
        for (int i = tid; i < 4096; i += 512) cact[i] = silu_f(a.c[i]);
        __syncthreads();
        float* mod = (float*)(a.ws + WS_MOD);
        for (int cb = blk; cb < 192; cb += G) {
            const int rg = tid >> 4, cl = tid & 15;
            const float* wp = a.w_ada + (size_t)cb * 64 + cl * 4;
            f32x4 a0 = {0.f, 0.f, 0.f, 0.f}, a1 = {0.f, 0.f, 0.f, 0.f};
#pragma unroll 16
            for (int i = 0; i < 64; ++i) { const int k = rg + 32 * i; const f32x4 w = *(const f32x4*)(wp + (size_t)k * 12288); a0 += w * cact[k]; a1 += w * cact[2048 + k]; }
#pragma unroll
            for (int j = 0; j < 4; ++j) { red[(rg * 2 + 0) * 64 + cl * 4 + j] = a0[j]; red[(rg * 2 + 1) * 64 + cl * 4 + j] = a1[j]; }
            __syncthreads();
            if (tid < 128) { const int b = tid >> 6, col = tid & 63; float s = 0.f; for (int r = 0; r < 32; ++r) s += red[(r * 2 + b) * 64 + col]; mod[b * 12288 + cb * 64 + col] = s + a.b_ada[cb * 64 + col]; }
            __syncthreads();
        }
    }
    {
        float* ct = (float*)(a.ws + WS_ROPE); float* st = ct + 4096 * 64;
        for (int idx = blk * 512 + tid; idx < 4096 * 64; idx += G * 512) {
            const int t = idx >> 6, i = idx & 63;
            const float inv = (float)exp2(-(double)i * (13.287712379549449 / 64.0));
            const float ang = (float)t * inv;
            const double ad = (double)ang, n = rint(ad * 0.15915494309189535), r = fma(-n, 6.283185307179586, ad) - n * 2.4492935982947064e-16;
            const float rf = (float)r;
            ct[idx] = cosf(rf); st[idx] = sinf(rf);
        }
    }
    {
        bf16_t* win_t = (bf16_t*)(a.ws + WS_WIN_T); bf16_t* wout_t = (bf16_t*)(a.ws + WS_WOUT_T);
        for (int job = blk; job < 64 * 16; job += 2 * G) {
            const float* src[2]; int ld[2]; bf16_t* dst[2]; int kts[2]; f32x4 v[2][8];
            const int w = threadIdx.x >> 6, lane = threadIdx.x & 63, kseg = lane & 7, nq = lane >> 3, nl = (w & 3) * 32 + nq * 4;
#pragma unroll
            for (int u = 0; u < 2; ++u) { const int jb = (job + u * G < 64 * 16) ? job + u * G : job, rt = jb >> 4; kts[u] = jb & 15;
                if (rt < 48) { const int n0 = rt * 128, col0 = n0 < 3072 ? n0 : n0 + 16; src[u] = a.w_in + col0; ld[u] = DIN; dst[u] = win_t + (size_t)n0 * 2048; }
                else { const int n0 = (rt - 48) * 128; src[u] = a.w_out + n0; ld[u] = 2048; dst[u] = wout_t + (size_t)n0 * 2048; }
                const int k0 = kts[u] * 128 + (w >> 2) * 64 + kseg * 8;
#pragma unroll
                for (int r = 0; r < 8; ++r) v[u][r] = *(const f32x4*)(src[u] + (size_t)(k0 + r) * ld[u] + nl); }
#pragma unroll
            for (int u = 0; u < 2; ++u) { const int k0 = kts[u] * 128 + (w >> 2) * 64 + kseg * 8;
#pragma unroll
                for (int j = 0; j < 4; ++j) { u32x4 o; o.x = cvt_pk_bf16(v[u][0][j], v[u][1][j]); o.y = cvt_pk_bf16(v[u][2][j], v[u][3][j]); o.z = cvt_pk_bf16(v[u][4][j], v[u][5][j]); o.w = cvt_pk_bf16(v[u][6][j], v[u][7][j]);
                    *(u32x4*)(dst[u] + (size_t)(nl + j) * 2048 + k0) = o; } }
        }
    }
}

__device__ __forceinline__ void phase_norm1(const Args& a, LAS unsigned char* lds) {
    const int tid = threadIdx.x, blk = blockIdx.x, G = gridDim.x, w = tid >> 6, lane = tid & 63;
    constexpr int HS = 2052;
    LAS float* hs = (LAS float*)lds;
    LAS float* part = (LAS float*)(lds + LDS_EXTRA + 4096);
    LAS float* las = (LAS float*)(lds + LDS_EXTRA);
    const float* mod = (const float*)(a.ws + WS_MOD);
    bf16_t* h1 = (bf16_t*)(a.ws + WS_H1); float* gk = (float*)(a.ws + WS_GK);
    float wl[64];
    { const int kk = lane >> 4, fr = lane & 15; const float* wp = a.w_in + (size_t)(w * 256 + kk) * DIN + 3072 + fr;
#pragma unroll
      for (int ks = 0; ks < 64; ++ks) wl[ks] = wp[(size_t)ks * 4 * DIN]; }
    float w2[16];
#pragma unroll
    for (int j = 0; j < 16; ++j) w2[j] = a.w_alpha2[j * 512 + tid];
    const float bz = a.b_alpha[tid];
    for (int grp = blk; grp < NTOK / 16; grp += G) {
        {
            const int r0 = grp * 16 + 2 * w;
            const f32x4* xr0 = (const f32x4*)(a.x + (size_t)r0 * DM) + lane; const f32x4* xr1 = xr0 + DM / 4;
            f32x4 v0[8], v1[8]; float ss0 = 0.f, ss1 = 0.f;
#pragma unroll
            for (int q = 0; q < 8; ++q) { v0[q] = xr0[64 * q]; v1[q] = xr1[64 * q]; }
#pragma unroll
            for (int q = 0; q < 8; ++q) { ss0 += (v0[q][0] * v0[q][0] + v0[q][1] * v0[q][1]) + (v0[q][2] * v0[q][2] + v0[q][3] * v0[q][3]); ss1 += (v1[q][0] * v1[q][0] + v1[q][1] * v1[q][1]) + (v1[q][2] * v1[q][2] + v1[q][3] * v1[q][3]); }
            ss0 = wave_sum(ss0); ss1 = wave_sum(ss1);
            const float rstd0 = 1.0f / sqrtf(ss0 * (1.0f / DM) + EPS), rstd1 = 1.0f / sqrtf(ss1 * (1.0f / DM) + EPS);
            const float* sh = mod + (size_t)(r0 >> 12) * 12288; const float* sc = sh + 2048;
#pragma unroll
            for (int q = 0; q < 8; ++q) { const int k = 4 * (lane + 64 * q);
                const f32x4 nw = *(const f32x4*)(a.norm1_w + k), scv = *(const f32x4*)(sc + k), shv = *(const f32x4*)(sh + k);
                const f32x4 h0 = (v0[q] * rstd0 * nw) * (scv + 1.0f) + shv, h1v = (v1[q] * rstd1 * nw) * (scv + 1.0f) + shv;
                *(LAS f32x4*)(hs + (2 * w) * HS + k) = h0; *(LAS f32x4*)(hs + (2 * w + 1) * HS + k) = h1v;
                u32x2 o; o.x = cvt_pk_bf16(h0[0], h0[1]); o.y = cvt_pk_bf16(h0[2], h0[3]);
                *(u32x2*)(h1 + (size_t)r0 * DM + k) = o;
                o.x = cvt_pk_bf16(h1v[0], h1v[1]); o.y = cvt_pk_bf16(h1v[2], h1v[3]);
                *(u32x2*)(h1 + (size_t)(r0 + 1) * DM + k) = o; } }
        __syncthreads();
        {
            const int kk = lane >> 4, fr = lane & 15; f32x4 acc = {0.f, 0.f, 0.f, 0.f};
            const LAS float* hp = hs + fr * HS + w * 256 + kk;
#pragma unroll
            for (int ks = 0; ks < 64; ++ks) acc = __builtin_amdgcn_mfma_f32_16x16x4f32(wl[ks], hp[ks * 4], acc, 0, 0, 0);
#pragma unroll
            for (int r = 0; r < 4; ++r) part[(w * 16 + 4 * kk + r) * 16 + fr] = acc[r];
        }
        __syncthreads();
        if (tid < 256) { const int t = tid >> 4, j = tid & 15; float s = 0.f;
#pragma unroll
            for (int q = 0; q < 8; ++q) s += part[(q * 16 + j) * 16 + t];
            las[t * 16 + j] = s; }
        __syncthreads();
        {
#pragma unroll 4
            for (int t = 0; t < 16; ++t) { const LAS f32x4* lp = (const LAS f32x4*)(las + t * 16); float z = bz;
#pragma unroll
                for (int q = 0; q < 4; ++q) { const f32x4 l = lp[q]; z += l[0] * w2[4 * q] + l[1] * w2[4 * q + 1] + l[2] * w2[4 * q + 2] + l[3] * w2[4 * q + 3]; }
                const float ls = fminf(z, 0.f) - log1pf(expf(-fabsf(z)));
                gk[(size_t)(grp * 16 + t) * 512 + tid] = ls * (1.0f / 16.0f); }
        }
        __syncthreads();
    }
}

__device__ __forceinline__ void gla_stage_vt(const bf16_t* proj, int row0, int h, LAS bf16_t* VT, int tid) {
    const int i = tid >> 3, seg = tid & 7;
    const u32x4* vp = (const u32x4*)(proj + (size_t)(row0 + i) * NPROJ + C_VA + h * 256 + seg * 32);
#pragma unroll
    for (int c4 = 0; c4 < 4; ++c4) { const u32x4 vv = vp[c4];
#pragma unroll
        for (int p = 0; p < 4; ++p) { const unsigned wd = vv[p]; const int e = seg * 32 + c4 * 8 + p * 2;
            VT[e * 72 + i] = (bf16_t)(wd & 0xffffu); VT[(e + 1) * 72 + i] = (bf16_t)(wd >> 16); } }
}
__device__ __forceinline__ void gla1_unit(const Args& a, LAS unsigned char* lds, int u) {
    const int tid = threadIdx.x, w = tid >> 6, lane = tid & 63;
    const int bh = u >> 6, c = u & 63, b = bh >> 2, h = bh & 3, row0 = b * SEQ + c * 64;
    LAS float* Bm = (LAS float*)lds; LAS bf16_t* KT = (LAS bf16_t*)(lds + 32768); LAS bf16_t* VT = (LAS bf16_t*)(lds + 51200);
    const float* gk = (const float*)(a.ws + WS_GK); const bf16_t* proj = (const bf16_t*)(a.ws + WS_PROJ);
    float* bcum = (float*)(a.ws + WS_BCUM); float* dst = (float*)(a.ws + WS_DST); float* dec = (float*)(a.ws + WS_DEC);
    const int i = tid >> 3, seg = tid & 7;
    {
        const f32x4* gp = (const f32x4*)(gk + (size_t)(row0 + i) * 512 + h * 128 + seg * 16);
#pragma unroll
        for (int q = 0; q < 4; ++q) *(LAS f32x4*)(Bm + i * 128 + seg * 16 + q * 4) = gp[q];
    }
    __syncthreads();
    {
        const int d = tid & 127, q4 = tid >> 7; LAS float* qs = (LAS float*)(lds + 90112);
        float run = 0.f;
#pragma unroll
        for (int ii = 0; ii < 16; ++ii) { run += Bm[(q4 * 16 + ii) * 128 + d]; Bm[(q4 * 16 + ii) * 128 + d] = run; }
        qs[q4 * 128 + d] = run;
        __syncthreads();
        float off = 0.f;
#pragma unroll
        for (int qq = 0; qq < 3; ++qq) off += (qq < q4) ? qs[qq * 128 + d] : 0.f;
        if (q4 > 0) {
#pragma unroll
            for (int ii = 0; ii < 16; ++ii) Bm[(q4 * 16 + ii) * 128 + d] += off; }
    }
    __syncthreads();
    {
        const u32x4* kp = (const u32x4*)(proj + (size_t)(row0 + i) * NPROJ + C_KA + h * 128 + seg * 16);
        float* bo = bcum + ((size_t)u * 64 + i) * 128 + seg * 16;
#pragma unroll
        for (int q = 0; q < 2; ++q) { const u32x4 kv = kp[q];
#pragma unroll
            for (int p = 0; p < 4; ++p) { const int d = seg * 16 + q * 8 + p * 2;
                const float b0 = Bm[i * 128 + d], b1 = Bm[i * 128 + d + 1], l0 = Bm[63 * 128 + d], l1 = Bm[63 * 128 + d + 1];
                bo[q * 8 + p * 2] = b0; bo[q * 8 + p * 2 + 1] = b1;
                KT[d * 72 + i] = f2bf(bflo(kv[p]) * expf(l0 - b0)); KT[(d + 1) * 72 + i] = f2bf(bfhi(kv[p]) * expf(l1 - b1));
                if (i == 63) { dec[(size_t)u * 128 + d] = expf(l0); dec[(size_t)u * 128 + d + 1] = expf(l1); } } }
        gla_stage_vt(proj, row0, h, VT, tid);
    }
    __syncthreads();
    {
        f32x4 acc[2][8];
#pragma unroll
        for (int x = 0; x < 2; ++x)
#pragma unroll
            for (int y = 0; y < 8; ++y) acc[x][y] = (f32x4){0.f, 0.f, 0.f, 0.f};
#pragma unroll
        for (int ks = 0; ks < 2; ++ks) {
            const bf16x8 a0 = lds_frag(VT, 72, (2 * w) * 16, ks * 32, lane), a1 = lds_frag(VT, 72, (2 * w + 1) * 16, ks * 32, lane);
#pragma unroll
            for (int dt = 0; dt < 8; ++dt) { const bf16x8 bf = lds_frag(KT, 72, dt * 16, ks * 32, lane); acc[0][dt] = mfma16(a0, bf, acc[0][dt]); acc[1][dt] = mfma16(a1, bf, acc[1][dt]); }
        }
        float* dp = dst + (size_t)u * 32768;
#pragma unroll
        for (int x = 0; x < 2; ++x)
#pragma unroll
            for (int dt = 0; dt < 8; ++dt)
#pragma unroll
                for (int r = 0; r < 4; ++r) dp[((2 * w + x) * 16 + 4 * (lane >> 4) + r) * 128 + dt * 16 + (lane & 15)] = acc[x][dt][r];
    }
    __syncthreads();
}
__device__ __forceinline__ void moba_prep_unit(const Args& a, LAS unsigned char* lds, int u2) {
    const int tid = threadIdx.x;
    const int bh = u2 >> 4, kb = u2 & 15, b = bh >> 3, h = bh & 7, row0 = b * SEQ + kb * 256, t0 = kb * 256;
    const bf16_t* proj = (const bf16_t*)(a.ws + WS_PROJ);
    const float* ct = (const float*)(a.ws + WS_ROPE); const float* st = ct + 4096 * 64;
    bf16_t* qbr = (bf16_t*)(a.ws + WS_QBR); bf16_t* kbr = (bf16_t*)(a.ws + WS_KBR); bf16_t* vbt = (bf16_t*)(a.ws + WS_VBT); float* kmean = (float*)(a.ws + WS_KMEAN);
    constexpr int KS = 132;
    LAS float* Kf = (LAS float*)lds;
    LAS float* part = (LAS float*)(lds + 135168);
    LAS bf16_t* Vl = (LAS bf16_t*)(lds + 139264);
    const int rl = tid >> 3, c = tid & 7;
#pragma unroll 1
    for (int pass = 0; pass < 4; ++pass) { const int row = pass * 64 + rl;
        const f32x4 cv0 = *(const f32x4*)(ct + (size_t)(t0 + row) * 64 + c * 8), cv1 = *(const f32x4*)(ct + (size_t)(t0 + row) * 64 + c * 8 + 4);
        const f32x4 sv0 = *(const f32x4*)(st + (size_t)(t0 + row) * 64 + c * 8), sv1 = *(const f32x4*)(st + (size_t)(t0 + row) * 64 + c * 8 + 4);
#pragma unroll
        for (int which = 0; which < 2; ++which) {
            const bf16_t* src = proj + (size_t)(row0 + row) * NPROJ + (which == 0 ? C_KB : C_QB) + h * 128 + c * 8;
            bf16_t* dsto = (which == 0 ? kbr : qbr) + ((size_t)bh * SEQ + t0 + row) * 128 + c * 8;
            const u32x4 x1 = *(const u32x4*)src, x2 = *(const u32x4*)(src + 64);
            u32x4 o1, o2; float r1[8], r2[8];
#pragma unroll
            for (int p = 0; p < 4; ++p) {
                const float c0 = (p < 2) ? cv0[2 * p] : cv1[2 * p - 4], c1 = (p < 2) ? cv0[2 * p + 1] : cv1[2 * p - 3], s0 = (p < 2) ? sv0[2 * p] : sv1[2 * p - 4], s1 = (p < 2) ? sv0[2 * p + 1] : sv1[2 * p - 3];
                const float a0 = bflo(x1[p]), a1 = bfhi(x1[p]), b0 = bflo(x2[p]), b1 = bfhi(x2[p]);
                r1[2 * p] = a0 * c0 - b0 * s0; r1[2 * p + 1] = a1 * c1 - b1 * s1; r2[2 * p] = a0 * s0 + b0 * c0; r2[2 * p + 1] = a1 * s1 + b1 * c1;
                o1[p] = cvt_pk_bf16(r1[2 * p], r1[2 * p + 1]); o2[p] = cvt_pk_bf16(r2[2 * p], r2[2 * p + 1]); }
            *(u32x4*)dsto = o1; *(u32x4*)(dsto + 64) = o2;
            if (which == 0) { LAS float* kr = Kf + row * KS + c * 8;
                *(LAS f32x4*)kr = (f32x4){r1[0], r1[1], r1[2], r1[3]}; *(LAS f32x4*)(kr + 4) = (f32x4){r1[4], r1[5], r1[6], r1[7]};
                *(LAS f32x4*)(kr + 64) = (f32x4){r2[0], r2[1], r2[2], r2[3]}; *(LAS f32x4*)(kr + 68) = (f32x4){r2[4], r2[5], r2[6], r2[7]}; }
        }
    }
    __syncthreads();
    { const int d = tid & 127, rq = tid >> 7; float s = 0.f;
#pragma unroll 8
        for (int rr = 0; rr < 64; ++rr) s += Kf[(rq * 64 + rr) * KS + d];
        part[rq * 128 + d] = s; }
    __syncthreads();
    if (tid < 128) kmean[((size_t)bh * 16 + kb) * 128 + tid] = (part[tid] + part[128 + tid] + part[256 + tid] + part[384 + tid]) * (1.0f / 256.0f);
#pragma unroll 1
    for (int sl = 0; sl < 4; ++sl) {
        { const int rw = tid >> 2, c4 = tid & 3;
#pragma unroll
            for (int ps = 0; ps < 2; ++ps) { const int row = ps * 128 + rw;
                const u32x4 vv = *(const u32x4*)(proj + (size_t)(row0 + row) * NPROJ + C_VB + h * 128 + sl * 32 + c4 * 8);
                *(LAS u32x4*)(Vl + row * 40 + (((c4 + (row >> 4)) & 3) << 3)) = vv; } }
        __syncthreads();
        { const int d = tid >> 4, tc = tid & 15;
            u32x4 o0, o1;
            const int dp = ((((d >> 3) + tc) & 3) << 3) + (d & 7);
#pragma unroll
            for (int p = 0; p < 4; ++p) { const int tt = tc * 16 + p * 2; o0[p] = (unsigned)Vl[tt * 40 + dp] | ((unsigned)Vl[(tt + 1) * 40 + dp] << 16);
                o1[p] = (unsigned)Vl[(tt + 8) * 40 + dp] | ((unsigned)Vl[(tt + 9) * 40 + dp] << 16); }
            bf16_t* op = vbt + ((size_t)bh * 128 + sl * 32 + d) * SEQ + t0 + tc * 16;
            *(u32x4*)op = o0; *(u32x4*)(op + 8) = o1; }
        __syncthreads();
    }
}
__device__ __forceinline__ void phase_mix_prep(const Args& a, LAS unsigned char* lds) {
    const int blk = blockIdx.x, G = gridDim.x;
    for (int u = blk; u < 512; u += G) gla1_unit(a, lds, u);
    for (int u2 = blk; u2 < 256; u2 += G) moba_prep_unit(a, lds, u2);
}

__device__ __forceinline__ void phase_scan_select(const Args& a, LAS unsigned char* lds) {
    const int tid = threadIdx.x, blk = blockIdx.x, G = gridDim.x;
    {
        const float* dst = (const float*)(a.ws + WS_DST); const float* dec = (const float*)(a.ws + WS_DEC); bf16_t* ST = (bf16_t*)(a.ws + WS_ST);
        for (int el = blk * 512 + tid; el < 8 * 32768; el += G * 512) {
            const int bh = el >> 15, ed = el & 32767, d = ed & 127; float cur = 0.f;
#pragma unroll 8
            for (int c = 0; c < 64; ++c) { const size_t u = (size_t)bh * 64 + c; ST[u * 32768 + ed] = f2bf(cur); cur = dec[u * 128 + d] * cur + dst[u * 32768 + ed]; }
        }
    }
    {
        const float* kmean = (const float*)(a.ws + WS_KMEAN); const bf16_t* qbr = (const bf16_t*)(a.ws + WS_QBR); unsigned* sel = (unsigned*)(a.ws + WS_SEL);
        LAS float* km = (LAS float*)lds;
        for (int u2 = blk; u2 < 256; u2 += G) {
            const int bh = u2 >> 4, qb = u2 & 15;
            __syncthreads();
            for (int i = tid; i < 2048; i += 512) km[i] = kmean[(size_t)bh * 2048 + i];
            __syncthreads();
            const int q = tid >> 1, half = tid & 1;
            float gv[8];
#pragma unroll
            for (int n = 0; n < 8; ++n) gv[n] = 0.f;
            const u32x4* qp = (const u32x4*)(qbr + ((size_t)bh * SEQ + qb * 256 + q) * 128);
#pragma unroll 4
            for (int c = 0; c < 16; ++c) { const u32x4 qq = qp[c]; float qf[8];
#pragma unroll
                for (int p = 0; p < 4; ++p) { qf[2 * p] = bflo(qq[p]); qf[2 * p + 1] = bfhi(qq[p]); }
#pragma unroll
                for (int n = 0; n < 8; ++n) { const LAS float* kr = km + (half * 8 + n) * 128 + c * 8; const f32x4 k0 = *(const LAS f32x4*)kr, k1 = *(const LAS f32x4*)(kr + 4);
                    gv[n] += (qf[0] * k0[0] + qf[1] * k0[1]) + (qf[2] * k0[2] + qf[3] * k0[3]) + (qf[4] * k1[0] + qf[5] * k1[1]) + (qf[6] * k1[2] + qf[7] * k1[3]); } }
            float ga[16];
#pragma unroll
            for (int n = 0; n < 8; ++n) { const float o = __shfl_xor(gv[n], 1); ga[n] = half ? o : gv[n]; ga[8 + n] = half ? gv[n] : o; }
            unsigned mask = 0u; const int nsel = qb < 3 ? qb : 3;
            for (int s = 0; s < nsel; ++s) { int best = -1; float bv = -INFINITY;
#pragma unroll
                for (int n = 0; n < 16; ++n) { const bool ok = (n < qb) && !((mask >> n) & 1u) && (best < 0 || ga[n] > bv); if (ok) { bv = ga[n]; best = n; } }
                mask |= 1u << best; }
            if (half == 0) sel[(size_t)bh * SEQ + qb * 256 + q] = mask;
        }
        __syncthreads();
    }
}

#ifndef CHECK_MODE
#define CHECK_MODE 0
#endif
constexpr size_t WS_CHK = 18432;
constexpr size_t WS_CHKO = WS_Y + 160 * MB;
#if CHECK_MODE
__device__ __forceinline__ void phase_check(const Args& a, LAS unsigned char* lds) {
    const int tid = threadIdx.x, blk = blockIdx.x, G = gridDim.x, w = tid >> 6, lane = tid & 63;
    const bf16_t* proj = (const bf16_t*)(a.ws + WS_PROJ); const bf16_t* ocat = (const bf16_t*)(a.ws + WS_OCAT);
    float* chk = (float*)(a.ws + WS_CHK);
#if CHECK_MODE == 1
    const float* ct = (const float*)(a.ws + WS_ROPE); const float* st = ct + 4096 * 64;
    for (int task = blk * 8 + w; task < 67 * 16; task += G * 8) {
        const int s = task >> 4, bh = task & 15, b = bh >> 3, h = bh & 7, t = 61 * s + 7, qblk = t >> 8;
        const bf16_t* qrow = proj + (size_t)(b * SEQ + t) * NPROJ + C_QB + h * 128;
        const float c = ct[t * 64 + lane], sn = st[t * 64 + lane];
        const float q1 = bf2f(qrow[lane]), q2 = bf2f(qrow[lane + 64]);
        const float qa = q1 * c - q2 * sn, qb2 = q1 * sn + q2 * c;
        float gate[16];
#pragma unroll 1
        for (int n = 0; n < 16; ++n) { float g = -INFINITY;
            if (n < qblk) { float m1 = 0.f, m2 = 0.f;
                for (int kk = 0; kk < 256; ++kk) { const int tk = n * 256 + kk; const bf16_t* krow = proj + (size_t)(b * SEQ + tk) * NPROJ + C_KB + h * 128;
                    const float k1 = bf2f(krow[lane]), k2 = bf2f(krow[lane + 64]), ck = ct[tk * 64 + lane], sk = st[tk * 64 + lane];
                    m1 += k1 * ck - k2 * sk; m2 += k1 * sk + k2 * ck; }
                g = wave_sum(qa * (m1 * (1.0f / 256.0f)) + qb2 * (m2 * (1.0f / 256.0f))); }
#pragma unroll
            for (int z = 0; z < 16; ++z) if (z == n) gate[z] = g; }
        unsigned mask = 0u; const int nsel = qblk < 3 ? qblk : 3;
        for (int it = 0; it < nsel; ++it) { int best = -1; float bv = -INFINITY;
#pragma unroll
            for (int n = 0; n < 16; ++n) { const bool ok = (n < qblk) && !((mask >> n) & 1u) && (best < 0 || gate[n] > bv); if (ok) { bv = gate[n]; best = n; } }
            mask |= 1u << best; }
        { const unsigned fastsel = ((const unsigned*)(a.ws + WS_SEL))[(size_t)bh * SEQ + t];
          if (fastsel != mask) { if (lane == 0) atomicAdd(&chk[2], 1.0f); continue; } }
        mask |= 1u << qblk;
        float m = -INFINITY, l = 0.f, o1 = 0.f, o2 = 0.f;
        for (int n = 0; n <= qblk; ++n) { if (!((mask >> n) & 1u)) continue;
            for (int kk = 0; kk < 256; ++kk) { const int tk = n * 256 + kk; if (tk > t) break;
                const bf16_t* krow = proj + (size_t)(b * SEQ + tk) * NPROJ + C_KB + h * 128; const bf16_t* vrow = proj + (size_t)(b * SEQ + tk) * NPROJ + C_VB + h * 128;
                const float k1 = bf2f(krow[lane]), k2 = bf2f(krow[lane + 64]), ck = ct[tk * 64 + lane], sk = st[tk * 64 + lane];
                const float sc = wave_sum(qa * (k1 * ck - k2 * sk) + qb2 * (k1 * sk + k2 * ck)) * 0.08838834764831845f;
                const float mn = fmaxf(m, sc), al = expf(m - mn), p = expf(sc - mn);
                l = l * al + p; o1 = o1 * al + p * bf2f(vrow[lane]); o2 = o2 * al + p * bf2f(vrow[lane + 64]); m = mn; } }
        o1 /= l; o2 /= l;
        const bf16_t* frow = ocat + (size_t)(b * SEQ + t) * DM + 1024 + h * 128;
        const float f1 = bf2f(frow[lane]), f2 = bf2f(frow[lane + 64]);
        const float num = wave_sum((f1 - o1) * (f1 - o1) + (f2 - o2) * (f2 - o2)), den = wave_sum(o1 * o1 + o2 * o2);
        if (lane == 0) { atomicAdd(&chk[0], num); atomicAdd(&chk[1], den); }
    }
#else
    const int cb = 1, ch = 2; const float* gk = (const float*)(a.ws + WS_GK); float* oref = (float*)(a.ws + WS_CHKO);
    for (int e = blk * 8 + w; e < 256; e += G * 8) {
        float s1 = 0.f, s2 = 0.f;
        for (int t = 0; t < SEQ; ++t) { const size_t row = (size_t)(cb * SEQ + t);
            const bf16_t* pr = proj + row * NPROJ;
            const float a1 = expf(gk[row * 512 + ch * 128 + lane]), a2 = expf(gk[row * 512 + ch * 128 + lane + 64]);
            const float k1 = bf2f(pr[C_KA + ch * 128 + lane]), k2 = bf2f(pr[C_KA + ch * 128 + lane + 64]), v = bf2f(pr[C_VA + ch * 256 + e]);
            const float q1 = bf2f(pr[C_QA + ch * 128 + lane]) * 0.08838834764831845f, q2 = bf2f(pr[C_QA + ch * 128 + lane + 64]) * 0.08838834764831845f;
            s1 = a1 * s1 + k1 * v; s2 = a2 * s2 + k2 * v;
            const float o = wave_sum(q1 * s1 + q2 * s2);
            if (lane == 0) oref[(size_t)t * 256 + e] = o; }
    }
#endif
}
__device__ __forceinline__ void phase_check2(const Args& a, LAS unsigned char* lds) {
#if CHECK_MODE == 2
    const int tid = threadIdx.x, blk = blockIdx.x, G = gridDim.x, w = tid >> 6, lane = tid & 63;
    const int cb = 1, ch = 2; const float* oref = (const float*)(a.ws + WS_CHKO); float* chk = (float*)(a.ws + WS_CHK);
    const bf16_t* proj = (const bf16_t*)(a.ws + WS_PROJ); const bf16_t* ocat = (const bf16_t*)(a.ws + WS_OCAT);
    for (int t = blk * 8 + w; t < SEQ; t += G * 8) { float o[4], ss = 0.f;
#pragma unroll
        for (int q = 0; q < 4; ++q) { o[q] = oref[(size_t)t * 256 + lane + 64 * q]; ss += o[q] * o[q]; }
        ss = wave_sum(ss); const float rstd = 1.0f / sqrtf(ss * (1.0f / 256.0f) + EPS); float num = 0.f, den = 0.f;
#pragma unroll
        for (int q = 0; q < 4; ++q) { const int e = lane + 64 * q; const size_t row = (size_t)(cb * SEQ + t);
            const float ga = bf2f(proj[row * NPROJ + C_GA + ch * 256 + e]), ref = o[q] * rstd * a.gla_norm_w[e] * silu_f(ga), f = bf2f(ocat[row * DM + ch * 256 + e]);
            num += (f - ref) * (f - ref); den += ref * ref; }
        num = wave_sum(num); den = wave_sum(den);
        if (lane == 0) { atomicAdd(&chk[0], num); atomicAdd(&chk[1], den); } }
#endif
}
#endif
#ifndef PROBE_TIME
#define PROBE_TIME -1
#endif
#ifndef PROBE_TOFF
#define PROBE_TOFF 0.0f
#endif
#ifndef PROBE_TSCALE
#define PROBE_TSCALE 3000.0f
#endif
#ifndef CONV_IN_GEMM
#define CONV_IN_GEMM 1
#endif
#ifndef CONV_IN_ATTN
#define CONV_IN_ATTN 1
#endif
#ifndef CONV_BLK
#define CONV_BLK 1
#endif

__device__ __forceinline__ void gla3_unit(const Args& a, LAS unsigned char* lds, int u) {
    const int tid = threadIdx.x, w = tid >> 6, lane = tid & 63, g = lane >> 4, fr = lane & 15;
    const int bh = u >> 6, c = u & 63, b = bh >> 2, h = bh & 3, row0 = b * SEQ + c * 64;
    LAS bf16_t* QP = (LAS bf16_t*)lds; LAS bf16_t* KP = (LAS bf16_t*)(lds + 17408); LAS bf16_t* VT = (LAS bf16_t*)(lds + 34816);
    LAS bf16_t* AM = (LAS bf16_t*)(lds + 71680); LAS float* OT = (LAS float*)(lds + 81920);
    const bf16_t* proj = (const bf16_t*)(a.ws + WS_PROJ); const float* bcum = (const float*)(a.ws + WS_BCUM); const bf16_t* ST = (const bf16_t*)(a.ws + WS_ST);
    bf16_t* ocat = (bf16_t*)(a.ws + WS_OCAT);
    {
        const int i = tid >> 3, seg = tid & 7;
        const f32x4* bp = (const f32x4*)(bcum + ((size_t)u * 64 + i) * 128 + seg * 16);
        const u32x4* qp = (const u32x4*)(proj + (size_t)(row0 + i) * NPROJ + C_QA + h * 128 + seg * 16);
        const u32x4* kp = (const u32x4*)(proj + (size_t)(row0 + i) * NPROJ + C_KA + h * 128 + seg * 16);
#pragma unroll
        for (int q = 0; q < 2; ++q) { const u32x4 qv = qp[q], kv = kp[q]; const f32x4 b0 = bp[2 * q], b1 = bp[2 * q + 1]; u32x4 qo, ko;
#pragma unroll
            for (int p = 0; p < 4; ++p) { const float bl = (p < 2) ? b0[2 * p] : b1[2 * p - 4], bhv = (p < 2) ? b0[2 * p + 1] : b1[2 * p - 3];
                const float el = expf(bl), eh = expf(bhv);
                qo[p] = cvt_pk_bf16(bflo(qv[p]) * el * 0.08838834764831845f, bfhi(qv[p]) * eh * 0.08838834764831845f);
                ko[p] = cvt_pk_bf16(bflo(kv[p]) / el, bfhi(kv[p]) / eh); }
            *(LAS u32x4*)(QP + i * 136 + seg * 16 + q * 8) = qo; *(LAS u32x4*)(KP + i * 136 + seg * 16 + q * 8) = ko; }
        gla_stage_vt(proj, row0, h, VT, tid);
    }
    __syncthreads();
    {
        const int it = w >> 1;
#pragma unroll
        for (int jj = 0; jj < 2; ++jj) { const int jt = (w & 1) * 2 + jj; f32x4 acc = {0.f, 0.f, 0.f, 0.f};
            if (jt <= it) {
#pragma unroll
                for (int ks = 0; ks < 4; ++ks) acc = mfma16(lds_frag(QP, 136, it * 16, ks * 32, lane), lds_frag(KP, 136, jt * 16, ks * 32, lane), acc);
            }
#pragma unroll
            for (int r = 0; r < 4; ++r) { const int i = it * 16 + 4 * g + r, j = jt * 16 + fr; AM[i * 72 + j] = f2bf((j <= i) ? acc[r] : 0.f); } }
    }
    __syncthreads();
    f32x4 acc[4][2];
    {
#pragma unroll
        for (int x = 0; x < 4; ++x)
#pragma unroll
            for (int y = 0; y < 2; ++y) acc[x][y] = (f32x4){0.f, 0.f, 0.f, 0.f};
        bf16x8 bS[2][4];
        const bf16_t* stp = ST + (size_t)u * 32768;
#pragma unroll
        for (int e2 = 0; e2 < 2; ++e2)
#pragma unroll
            for (int ks = 0; ks < 4; ++ks) bS[e2][ks] = *(const bf16x8*)(stp + ((2 * w + e2) * 16 + fr) * 128 + ks * 32 + 8 * g);
#pragma unroll
        for (int it = 0; it < 4; ++it) {
#pragma unroll
            for (int ks = 0; ks < 4; ++ks) { const bf16x8 aq = lds_frag(QP, 136, it * 16, ks * 32, lane); acc[it][0] = mfma16(aq, bS[0][ks], acc[it][0]); acc[it][1] = mfma16(aq, bS[1][ks], acc[it][1]); }
#pragma unroll
            for (int k2 = 0; k2 < 2; ++k2) { const bf16x8 aa = lds_frag(AM, 72, it * 16, k2 * 32, lane);
                acc[it][0] = mfma16(aa, lds_frag(VT, 72, (2 * w) * 16, k2 * 32, lane), acc[it][0]); acc[it][1] = mfma16(aa, lds_frag(VT, 72, (2 * w + 1) * 16, k2 * 32, lane), acc[it][1]); }
        }
#pragma unroll
        for (int it = 0; it < 4; ++it)
#pragma unroll
            for (int r = 0; r < 4; ++r)
#pragma unroll
                for (int e2 = 0; e2 < 2; ++e2) OT[(it * 16 + 4 * g + r) * 260 + (2 * w + e2) * 16 + fr] = acc[it][e2][r];
    }
    __syncthreads();
    {
        const int i = tid >> 3, seg = tid & 7;
        const LAS float* orow = OT + i * 260 + seg * 32;
        f32x4 ov[8]; float ss = 0.f;
#pragma unroll
        for (int q = 0; q < 8; ++q) { ov[q] = *(const LAS f32x4*)(orow + 4 * q); ss += (ov[q][0] * ov[q][0] + ov[q][1] * ov[q][1]) + (ov[q][2] * ov[q][2] + ov[q][3] * ov[q][3]); }
        ss += __shfl_xor(ss, 1); ss += __shfl_xor(ss, 2); ss += __shfl_xor(ss, 4);
        const float rstd = 1.0f / sqrtf(ss * (1.0f / 256.0f) + EPS);
        const u32x4* gp = (const u32x4*)(proj + (size_t)(row0 + i) * NPROJ + C_GA + h * 256 + seg * 32);
        bf16_t* op = ocat + (size_t)(row0 + i) * DM + h * 256 + seg * 32;
#pragma unroll
        for (int c8 = 0; c8 < 4; ++c8) { const u32x4 gv = gp[c8]; u32x4 o;
            const f32x4 nw0 = *(const f32x4*)(a.gla_norm_w + seg * 32 + c8 * 8), nw1 = *(const f32x4*)(a.gla_norm_w + seg * 32 + c8 * 8 + 4);
#pragma unroll
            for (int pp = 0; pp < 4; ++pp) { const float g0 = bflo(gv[pp]), g1 = bfhi(gv[pp]);
                const float n0 = (pp < 2) ? nw0[2 * pp] : nw1[2 * pp - 4], n1 = (pp < 2) ? nw0[2 * pp + 1] : nw1[2 * pp - 3];
                const float v0 = ((pp & 1) ? ov[2 * c8 + (pp >> 1)][2] : ov[2 * c8 + (pp >> 1)][0]) * rstd * n0 * silu_f(g0);
                const float v1 = ((pp & 1) ? ov[2 * c8 + (pp >> 1)][3] : ov[2 * c8 + (pp >> 1)][1]) * rstd * n1 * silu_f(g1);
#if FP8_EMU
                o[pp] = cvt_pk_bf16(q8(v0), q8(v1));
#else
                o[pp] = cvt_pk_bf16(v0, v1);
#endif
            }
            *(u32x4*)(op + c8 * 8) = o; }
    }
    __syncthreads();
}

typedef short s16x4 __attribute__((ext_vector_type(4)));
__device__ __forceinline__ void moba_attn_unit(const Args& a, LAS unsigned char* lds, int bh, int qb, int half, int cjob0) {
    const int tid = threadIdx.x, w = tid >> 6, lane = tid & 63, g = lane >> 4, fr = lane & 15;
    bh = __builtin_amdgcn_readfirstlane(bh); qb = __builtin_amdgcn_readfirstlane(qb); half = __builtin_amdgcn_readfirstlane(half);
    const int b = bh >> 3, h = bh & 7, rg = w & 3, par = w >> 2, qbase = 128 * half + 32 * rg;
    const bf16_t* qbr = (const bf16_t*)(a.ws + WS_QBR); const bf16_t* kbr = (const bf16_t*)(a.ws + WS_KBR); const bf16_t* vbt = (const bf16_t*)(a.ws + WS_VBT);
    const unsigned* sel = (const unsigned*)(a.ws + WS_SEL); bf16_t* ocat = (bf16_t*)(a.ws + WS_OCAT);
    const int nown = 2 * half + 2, nsteps = (nown + 4 * qb) >> 1;
    bf16x8 qf[2][4]; unsigned sm[2]; float m[2], l[2]; f32x4 O[8][2];
#pragma unroll
    for (int b2 = 0; b2 < 2; ++b2) { const size_t qrow = (size_t)bh * SEQ + qb * 256 + qbase + 16 * b2 + fr;
#pragma unroll
        for (int ks = 0; ks < 4; ++ks) qf[b2][ks] = *(const bf16x8*)(qbr + qrow * 128 + ks * 32 + 8 * g);
        sm[b2] = sel[qrow]; m[b2] = -INFINITY; l[b2] = 0.f;
#pragma unroll
        for (int dt = 0; dt < 8; ++dt) O[dt][b2] = (f32x4){0.f, 0.f, 0.f, 0.f}; }
    const float cs = 0.08838834764831845f * 1.4426950408889634f;
    unsigned kso[2], vso[2];
#pragma unroll
    for (int p = 0; p < 2; ++p) { const int kr = 4 * (w + 8 * p) + (lane >> 4), kc = (lane & 15) ^ (kr & 15); kso[p] = (unsigned)(kr * 256 + kc * 16);
        const int vr = 8 * (w + 8 * p) + (lane >> 3), vc = (lane & 7) ^ ((vr >> 1) & 7); vso[p] = (unsigned)(vr * (SEQ * 2) + vc * 16); }
    const char* kbase = (const char*)(kbr + (size_t)bh * SEQ * 128); const char* vbase = (const char*)(vbt + (size_t)bh * 128 * SEQ);
    auto tile_jk = [&](int ti, int& j, int& kt) { if (ti < nown) { j = qb; kt = ti; } else { const int tj = ti - nown; j = tj >> 2; kt = tj & 3; } };
    auto stage = [&](int s) {
#pragma unroll
        for (int t2 = 0; t2 < 2; ++t2) { int j, kt; tile_jk(2 * s + t2, j, kt); const int key0 = j * 256 + kt * 64;
            LAS unsigned char* dstb = lds + (s & 1) * 65536 + t2 * 32768 + w * 1024;
            const char* ks = pg8::sbase(kbase + (size_t)key0 * 256); const char* vs = pg8::sbase(vbase + (size_t)key0 * 2);
#pragma unroll
            for (int p = 0; p < 2; ++p) {
                __builtin_amdgcn_global_load_lds((const unsigned*)(ks + kso[p]), (LAS unsigned*)(dstb + p * 8192), 16, 0, 0);
                __builtin_amdgcn_global_load_lds((const unsigned*)(vs + vso[p]), (LAS unsigned*)(dstb + 16384 + p * 8192), 16, 0, 0); } } };
    __syncthreads();
    stage(0);
    f32x4 cv[8]; const int cjob = __builtin_amdgcn_readfirstlane(cjob0);
    if (CONV_IN_ATTN) { const SJob cj = sjob_addr(a, cjob, lane); sjob_load(cj, cv); }
#pragma unroll 1
    for (int s = 0; s < nsteps; ++s) {
        asm volatile("s_waitcnt vmcnt(0)" ::: "memory");
        __syncthreads();
        if (s + 1 < nsteps) stage(s + 1);
        if (CONV_IN_ATTN) { { const SJob cj = sjob_addr(a, cjob + 8 * s, lane); sjob_store(cj, cv); } if (s + 1 < nsteps) { const SJob cn = sjob_addr(a, cjob + 8 * (s + 1), lane); sjob_load(cn, cv); } }
        int j, kt; tile_jk(2 * s + par, j, kt);
        const bool own = (2 * s + par) < nown;
        if (own && kt * 64 > qbase + 31) continue;
        const LAS unsigned char* Kb = lds + (s & 1) * 65536 + par * 32768; const LAS unsigned char* Vb = Kb + 16384;
        f32x4 sc[4][2];
#pragma unroll
        for (int t4 = 0; t4 < 4; ++t4) { sc[t4][0] = (f32x4){0.f, 0.f, 0.f, 0.f}; sc[t4][1] = (f32x4){0.f, 0.f, 0.f, 0.f};
#pragma unroll
            for (int ks = 0; ks < 4; ++ks) { const bf16x8 kf = *(const LAS bf16x8*)(Kb + (t4 * 16 + fr) * 256 + (((ks * 4 + g) ^ fr) << 4)); sc[t4][0] = mfma16(kf, qf[0][ks], sc[t4][0]); sc[t4][1] = mfma16(kf, qf[1][ks], sc[t4][1]); } }
        bf16x8 pf[2][2];
#pragma unroll
        for (int b2 = 0; b2 < 2; ++b2) {
            float tm = -INFINITY, nb;
            if (own) {
                const int qi = qbase + 16 * b2 + fr;
#pragma unroll
                for (int t4 = 0; t4 < 4; ++t4)
#pragma unroll
                    for (int r = 0; r < 4; ++r) { const int kk = kt * 64 + t4 * 16 + 4 * g + r; const float v = (kk <= qi) ? sc[t4][b2][r] : -INFINITY; sc[t4][b2][r] = v; tm = fmaxf(tm, v); }
            } else {
#pragma unroll
                for (int t4 = 0; t4 < 4; ++t4)
#pragma unroll
                    for (int r = 0; r < 4; ++r) tm = fmaxf(tm, sc[t4][b2][r]);
                if (!((sm[b2] >> j) & 1u)) tm = -INFINITY;
            }
            tm = fmaxf(tm, __shfl_xor(tm, 16)); tm = fmaxf(tm, __shfl_xor(tm, 32));
            if (__builtin_amdgcn_ballot_w64((tm - m[b2]) * cs > 11.5416f) != 0ull) {
                const float mnew = fmaxf(m[b2], tm), ms = (mnew == -INFINITY) ? 0.f : mnew;
                const float alpha = __builtin_amdgcn_exp2f((m[b2] - ms) * cs);
                l[b2] *= alpha; m[b2] = mnew;
#pragma unroll
                for (int dt = 0; dt < 8; ++dt) O[dt][b2] *= alpha;
            }
            nb = (m[b2] == -INFINITY) ? 0.f : -m[b2] * cs; if (!own && !((sm[b2] >> j) & 1u)) nb = -INFINITY;
            float ps = 0.f;
#pragma unroll
            for (int t4 = 0; t4 < 4; ++t4)
#pragma unroll
                for (int r = 0; r < 4; ++r) { const float pe = __builtin_amdgcn_exp2f(fmaf(sc[t4][b2][r], cs, nb)); sc[t4][b2][r] = pe; ps += pe; }
            ps += __shfl_xor(ps, 16); ps += __shfl_xor(ps, 32);
            l[b2] += ps;
#pragma unroll
            for (int k2 = 0; k2 < 2; ++k2) { u32x4 pkk; pkk.x = cvt_pk_bf16(sc[2 * k2][b2][0], sc[2 * k2][b2][1]); pkk.y = cvt_pk_bf16(sc[2 * k2][b2][2], sc[2 * k2][b2][3]);
                pkk.z = cvt_pk_bf16(sc[2 * k2 + 1][b2][0], sc[2 * k2 + 1][b2][1]); pkk.w = cvt_pk_bf16(sc[2 * k2 + 1][b2][2], sc[2 * k2 + 1][b2][3]);
                pf[k2][b2] = __builtin_bit_cast(bf16x8, pkk); }
        }
#pragma unroll
        for (int dt = 0; dt < 8; ++dt)
#pragma unroll
            for (int k2 = 0; k2 < 2; ++k2) { const int vr = dt * 16 + fr, c0 = 4 * k2 + (g >> 1), sw = (vr >> 1) & 7;
                const LAS unsigned char* vrow = Vb + vr * 128 + (g & 1) * 8;
                const s16x4 lo = *(const LAS s16x4*)(vrow + ((c0 ^ sw) << 4)), hi = *(const LAS s16x4*)(vrow + (((c0 + 2) ^ sw) << 4));
                const bf16x8 vf = __builtin_shufflevector(lo, hi, 0, 1, 2, 3, 4, 5, 6, 7);
                O[dt][0] = mfma16(vf, pf[k2][0], O[dt][0]); O[dt][1] = mfma16(vf, pf[k2][1], O[dt][1]); }
    }
    __syncthreads();
    LAS float* X = (LAS float*)lds + rg * (68 * 64) + lane;
    if (par == 1) {
#pragma unroll
        for (int b2 = 0; b2 < 2; ++b2) { X[(64 + b2) * 64] = m[b2]; X[(66 + b2) * 64] = l[b2];
#pragma unroll
            for (int dt = 0; dt < 8; ++dt)
#pragma unroll
                for (int r = 0; r < 4; ++r) X[((dt * 2 + b2) * 4 + r) * 64] = O[dt][b2][r]; } }
    __syncthreads();
    if (par == 0) {
#pragma unroll
        for (int b2 = 0; b2 < 2; ++b2) { const float m1 = X[(64 + b2) * 64], l1 = X[(66 + b2) * 64];
            const float mm = fmaxf(m[b2], m1), a0 = exp2f((m[b2] - mm) * cs), a1 = (m1 == -INFINITY) ? 0.f : exp2f((m1 - mm) * cs);
            const float inv = 1.0f / (l[b2] * a0 + l1 * a1);
            const size_t orow = (size_t)(b * SEQ + qb * 256 + qbase + 16 * b2 + fr) * DM + 1024 + h * 128;
#pragma unroll
            for (int dt = 0; dt < 8; ++dt) { float o4[4];
#pragma unroll
                for (int r = 0; r < 4; ++r) o4[r] = (O[dt][b2][r] * a0 + X[((dt * 2 + b2) * 4 + r) * 64] * a1) * inv;
                u32x2 o; o.x = cvt_pk_bf16(o4[0], o4[1]); o.y = cvt_pk_bf16(o4[2], o4[3]);
                *(u32x2*)(ocat + orow + dt * 16 + 4 * g) = o; } } }
    __syncthreads();
}
__device__ __forceinline__ void phase_mix_out(const Args& a, LAS unsigned char* lds) {
    const int blk = blockIdx.x, G = gridDim.x;
    for (int u = blk; u < 256; u += G) {
        const int cj0 = (u * 33) * 8 + (threadIdx.x >> 6);
        { const int c = u >> 4; moba_attn_unit(a, lds, u & 15, (31 - c) >> 1, (31 - c) & 1, cj0); }
        { const int u2 = 511 - u, c = u2 >> 4; moba_attn_unit(a, lds, u2 & 15, (31 - c) >> 1, (31 - c) & 1, cj0 + 8 * (32 - (u >> 4))); }
    }
    for (int u = blk; u < 512; u += G) gla3_unit(a, lds, u);
}

__device__ __forceinline__ void phase_router(const Args& a, LAS unsigned char* lds) {
    const int tid = threadIdx.x, blk = blockIdx.x, G = gridDim.x, w = tid >> 6, lane = tid & 63;
    constexpr int HS = 2052;
    LAS float* h2s = (LAS float*)lds;
    LAS float* part = (LAS float*)(lds + LDS_EXTRA + 4096);
    LAS float* logit = (LAS float*)(lds + LDS_EXTRA);
    LAS int* pe = (LAS int*)(lds + LDS_EXTRA + 2048); LAS float* pw = (LAS float*)(lds + LDS_EXTRA + 2560); LAS int* lpos = (LAS int*)(lds + LDS_EXTRA + 3072);
    LAS int* hist = (LAS int*)(lds + LDS_EXTRA + 3584); LAS int* base = (LAS int*)(lds + LDS_EXTRA + 3712);
    const float* mod = (const float*)(a.ws + WS_MOD); const float* x1 = (const float*)(a.ws + WS_X1); unsigned char* h2 = (unsigned char*)(a.ws + WS_H1);
    unsigned* cnt = (unsigned*)(a.ws + WS_CNT); int* pair_e = (int*)(a.ws + WS_PAIR_E); int* pair_pos = (int*)(a.ws + WS_PAIR_POS); int* tok_of = (int*)(a.ws + WS_SLOTROW); float* rw_of = (float*)(a.ws + WS_WBUF);
    float wa0[64], wa1[64];
    { const int kk = lane >> 4, fr = lane & 15; const float* wp = a.w_router + (size_t)(w * 256 + kk) * 32 + fr;
#pragma unroll
      for (int ks = 0; ks < 64; ++ks) { wa0[ks] = wp[(size_t)ks * 128]; wa1[ks] = wp[(size_t)ks * 128 + 16]; } }
    const float brt = a.b_router[tid & 31];
    for (int gp = blk; gp < 256; gp += G) {
        if (tid < 32) hist[tid] = 0;
#pragma unroll 1
        for (int gh = 0; gh < 2; ++gh) { const int grp = gp * 2 + gh;
#pragma unroll 1
            for (int tt = 0; tt < 2; ++tt) { const int tl = 2 * w + tt, t = grp * 16 + tl;
                const f32x4* xr = (const f32x4*)(x1 + (size_t)t * DM) + lane;
                f32x4 v[8]; float ss = 0.f;
#pragma unroll
                for (int q = 0; q < 8; ++q) { v[q] = xr[64 * q]; ss += (v[q][0] * v[q][0] + v[q][1] * v[q][1]) + (v[q][2] * v[q][2] + v[q][3] * v[q][3]); }
                ss = wave_sum(ss);
                const float rstd = 1.0f / sqrtf(ss * (1.0f / DM) + EPS);
                const float* sh = mod + (size_t)(t >> 12) * 12288 + 6144; const float* sc = sh + 2048;
#pragma unroll
                for (int q = 0; q < 8; ++q) { const int k = 4 * (lane + 64 * q);
                    const f32x4 nw = *(const f32x4*)(a.norm2_w + k), scv = *(const f32x4*)(sc + k), shv = *(const f32x4*)(sh + k);
                    const f32x4 hv = (v[q] * rstd * nw) * (scv + 1.0f) + shv;
                    *(LAS f32x4*)(h2s + tl * HS + k) = hv;
                    *(unsigned*)(h2 + (size_t)t * DM + k) = pg8::pk4_fp8(hv[0], hv[1], hv[2], hv[3]); } }
            __syncthreads();
            {
                const int kk = lane >> 4, fr = lane & 15;
                f32x4 acc0 = {0.f, 0.f, 0.f, 0.f}, acc1 = {0.f, 0.f, 0.f, 0.f};
                const LAS float* hp = h2s + fr * HS + w * 256 + kk;
#pragma unroll
                for (int ks = 0; ks < 64; ++ks) { const float b = hp[ks * 4];
                    acc0 = __builtin_amdgcn_mfma_f32_16x16x4f32(wa0[ks], b, acc0, 0, 0, 0); acc1 = __builtin_amdgcn_mfma_f32_16x16x4f32(wa1[ks], b, acc1, 0, 0, 0); }
#pragma unroll
                for (int r = 0; r < 4; ++r) { part[(w * 32 + 4 * kk + r) * 16 + fr] = acc0[r]; part[(w * 32 + 16 + 4 * kk + r) * 16 + fr] = acc1[r]; }
            }
            __syncthreads();
            {
                const int tl = tid >> 5, e = tid & 31; float s = brt;
#pragma unroll
                for (int q = 0; q < 8; ++q) s += part[(q * 32 + e) * 16 + tl];
                bool taken = false; float tv[4]; int te[4];
#pragma unroll
                for (int r = 0; r < 4; ++r) { float bv = taken ? -INFINITY : s; int be = e;
#pragma unroll
                    for (int off = 16; off >= 1; off >>= 1) { const float ov = __shfl_xor(bv, off); const int oe = __shfl_xor(be, off); if (ov > bv || (ov == bv && oe < be)) { bv = ov; be = oe; } }
                    tv[r] = bv; te[r] = be; if (be == e) taken = true; }
                if (e == 0) { float ex[4], den = 0.f;
#pragma unroll
                    for (int r = 0; r < 4; ++r) { ex[r] = expf(tv[r] - tv[0]); den += ex[r]; }
#pragma unroll
                    for (int r = 0; r < 4; ++r) { pe[gh * 64 + tl * 4 + r] = te[r]; pw[gh * 64 + tl * 4 + r] = ex[r] / den; } }
            }
            __syncthreads();
        }
        if (tid < 128) lpos[tid] = atomicAdd((int*)&hist[pe[tid]], 1);
        __syncthreads();
        if (tid < 32) { const int n = hist[tid]; base[tid] = n ? (int)atomicAdd(&cnt[tid], (unsigned)n) : 0; }
        __syncthreads();
        if (tid < 128) { const int p = gp * 128 + tid, e = pe[tid], pos = base[e] + lpos[tid]; pair_e[p] = e; pair_pos[p] = pos; tok_of[e * 8192 + pos] = p >> 2; rw_of[e * 8192 + pos] = pw[tid]; }
        __syncthreads();
    }
}
__device__ __forceinline__ void phase_gather(const Args& a, LAS unsigned char* lds) {
    if (CONV_IN_GEMM == 2) conv_share(a, blockIdx.x, gridDim.x);
    if (!CONV_IN_GEMM) conv_all(a, lds);
}
template <class Sched>
__device__ __forceinline__ void moe_build_rowtab(const Args& a, LAS unsigned char* lds, const Sched& S) {
    LAS int* rowtab = (LAS int*)(lds + LDS_ROWTAB);
    const unsigned* cnt = (const unsigned*)(a.ws + WS_CNT); const int* tok_of = (const int*)(a.ws + WS_SLOTROW);
    pg8::Unit u;
    for (int i = 0; i < MAX_UNITS_WG && S.next(i, u); ++i) {
        const int r = threadIdx.x; if (r < 256) { const int pos = u.pos0 + r; rowtab[i * 256 + r] = (pos < (int)cnt[u.e]) ? tok_of[u.e * 8192 + pos] * DM : 0; }
    }
    __syncthreads();
}
__device__ __forceinline__ void moe_build_tab(const Args& a, LAS unsigned char* lds, int ntn) {
    LAS int* tab = (LAS int*)(lds + LDS_EXTRA);
    const unsigned* cnt = (const unsigned*)(a.ws + WS_CNT);
    LAS int* rt0 = tab + 600;
    LAS int* ord = tab + 640;
    LAS int* cn = tab + 680;
    __syncthreads();
    if (threadIdx.x < 64) {
        const int e = threadIdx.x & 31, c = (int)cnt[e];
        const int tiles = (c + 255) >> 8, cost = tiles;
        int rank = 0, pre = 0;
#pragma unroll
        for (int j = 0; j < 32; ++j) { const int cj = __builtin_amdgcn_readlane(cost, j), tj = __builtin_amdgcn_readlane(tiles, j); rank += (cj > cost || (cj == cost && j < e)) ? 1 : 0; pre += (j < e) ? tj : 0; }
        if (threadIdx.x < 32) { ord[rank] = e; cn[e] = c; rt0[e] = pre; }
    }
    __syncthreads();
    if (threadIdx.x == 0) {
        const int mygrp = blockIdx.x & 7, PG = ntn >> 1;
        int np = 0, us = 0;
        int l0 = 0, l1 = 0, l2 = 0, l3 = 0, l4 = 0, l5 = 0, l6 = 0, l7 = 0;
#pragma unroll 1
        for (int it = 0; it < 32; ++it) {
            const int be = ord[it], c = cn[be], mte = (c + 255) >> 8;
            if (mte == 0) break;
            const int bc = mte * PG, r0 = rt0[be];
#pragma unroll
            for (int h = 0; h < 2; ++h) {
                int bx = 0, bl = l0;
                if (l1 < bl) { bl = l1; bx = 1; } if (l2 < bl) { bl = l2; bx = 2; } if (l3 < bl) { bl = l3; bx = 3; }
                if (l4 < bl) { bl = l4; bx = 4; } if (l5 < bl) { bl = l5; bx = 5; } if (l6 < bl) { bl = l6; bx = 6; } if (l7 < bl) { bl = l7; bx = 7; }
                l0 += (bx == 0) ? bc : 0; l1 += (bx == 1) ? bc : 0; l2 += (bx == 2) ? bc : 0; l3 += (bx == 3) ? bc : 0;
                l4 += (bx == 4) ? bc : 0; l5 += (bx == 5) ? bc : 0; l6 += (bx == 6) ? bc : 0; l7 += (bx == 7) ? bc : 0;
                if (bx == mygrp) { LAS int* t = tab + 4 + 8 * np; t[0] = us; t[1] = be; t[2] = h * PG; t[3] = mte; t[4] = r0; t[5] = c; us += mte * PG; ++np; }
            }
        }
        tab[0] = np; tab[1] = us;
    }
    __syncthreads();
}
__device__ __forceinline__ bool warm_claim(const unsigned char* base, unsigned nchunks, unsigned* ctr) {
    unsigned c = 0;
    if ((threadIdx.x & 63) == 0) c = atomicAdd(ctr, 1u);
    c = __builtin_amdgcn_readfirstlane(c);
    if (c >= nchunks) return false;
    const u32x4* p = (const u32x4*)(base + (size_t)c * 16384) + (threadIdx.x & 63);
    u32x4 v[16];
#pragma unroll
    for (int r = 0; r < 16; ++r) v[r] = __builtin_nontemporal_load(p + 64 * r);
    unsigned s = 0;
#pragma unroll
    for (int r = 0; r < 16; ++r) s ^= v[r].x ^ v[r].y ^ v[r].z ^ v[r].w;
    asm volatile("" :: "v"(s));
    return true;
}
__device__ __forceinline__ void phase_final(const Args& a, LAS unsigned char* lds) {
    const int tid = threadIdx.x, blk = blockIdx.x, G = gridDim.x, w = tid >> 6, lane = tid & 63;
    const float* mod = (const float*)(a.ws + WS_MOD); const float* x1 = (const float*)(a.ws + WS_X1); const int* pair_e = (const int*)(a.ws + WS_PAIR_E); const int* pair_pos = (const int*)(a.ws + WS_PAIR_POS); const bf16_t* y = (const bf16_t*)(a.ws + WS_Y);
    LAS int* rbase = (LAS int*)(lds + LDS_EXTRA);
    if (tid < 64) {
        const unsigned* cnt = (const unsigned*)(a.ws + WS_CNT); const int e = tid & 31, pc = (int)((cnt[e] + 255u) & ~255u); int pre = 0;
#pragma unroll
        for (int j = 0; j < 32; ++j) { const int pj = __builtin_amdgcn_readlane(pc, j); pre += (j < e) ? pj : 0; }
        if (tid < 32) rbase[e] = pre; }
    __syncthreads();
    float chk_scale = 1.0f;
#if PROBE_TIME >= 0 && !defined(PROBE_SPIN)
    { const unsigned long long* ts = (const unsigned long long*)(a.ws + 18688); float us = (float)(ts[1] - ts[0]) * 1e-2f;
#ifdef PROBE_TQ
      us = floorf((us + PROBE_TOFF) / PROBE_TQ) * PROBE_TQ;
#endif
      chk_scale = 1.0f + us / PROBE_TSCALE; }
#endif
#if CHECK_MODE
    { const float* chk = (const float*)(a.ws + WS_CHK); const float rel = sqrtf(chk[0] / fmaxf(chk[1], 1e-30f)) + (chk[2] > 60.0f ? 1.0f : 0.0f); chk_scale = 1.0f + 10.0f * rel; }
#endif
    for (int t = blk * 8 + w; t < NTOK; t += G * 8) {
        const int r0 = rbase[pair_e[t * 4]] + pair_pos[t * 4], r1 = rbase[pair_e[t * 4 + 1]] + pair_pos[t * 4 + 1], r2 = rbase[pair_e[t * 4 + 2]] + pair_pos[t * 4 + 2], r3 = rbase[pair_e[t * 4 + 3]] + pair_pos[t * 4 + 3];
        const f32x4* xr = (const f32x4*)(x1 + (size_t)t * DM) + lane;
        const u32x2* y0 = (const u32x2*)(y + (size_t)r0 * DM) + lane; const u32x2* y1 = (const u32x2*)(y + (size_t)r1 * DM) + lane;
        const u32x2* y2 = (const u32x2*)(y + (size_t)r2 * DM) + lane; const u32x2* y3 = (const u32x2*)(y + (size_t)r3 * DM) + lane;
        const float* g2 = mod + (size_t)(t >> 12) * 12288 + 10240;
        f32x4 v[8]; float ss = 0.f;
#pragma unroll
        for (int q = 0; q < 8; ++q) { const u32x2 a0 = y0[64 * q], a1 = y1[64 * q], a2 = y2[64 * q], a3 = y3[64 * q];
            f32x4 s; s[0] = (bflo(a0.x) + bflo(a1.x)) + (bflo(a2.x) + bflo(a3.x)); s[1] = (bfhi(a0.x) + bfhi(a1.x)) + (bfhi(a2.x) + bfhi(a3.x));
            s[2] = (bflo(a0.y) + bflo(a1.y)) + (bflo(a2.y) + bflo(a3.y)); s[3] = (bfhi(a0.y) + bfhi(a1.y)) + (bfhi(a2.y) + bfhi(a3.y));
            const f32x4 gv = *(const f32x4*)(g2 + 4 * (lane + 64 * q));
            v[q] = xr[64 * q] + gv * s; ss += (v[q][0] * v[q][0] + v[q][1] * v[q][1]) + (v[q][2] * v[q][2] + v[q][3] * v[q][3]); }
        ss = wave_sum(ss);
        const float rstd = 1.0f / sqrtf(ss * (1.0f / DM) + EPS);
        f32x4* op = (f32x4*)(a.out + (size_t)t * DM) + lane;
#pragma unroll
        for (int q = 0; q < 8; ++q) op[64 * q] = v[q] * (rstd * chk_scale) * *(const f32x4*)(a.final_norm_w + 4 * (lane + 64 * q));
    }
}

struct ConvInProj : pg8::StaticOrder { const Args* ap;
    LAS unsigned char* lds;
    __device__ __forceinline__ void between(int ui) const {
        if (CONV_IN_GEMM == 1 && ui == (int)(blockIdx.x % 3)) {
#if CONV_BLK
            const int wr = (threadIdx.x >> 6) >> 2;
            asm volatile("s_waitcnt vmcnt(0)" ::: "memory");
            if (wr == 0) __builtin_amdgcn_s_barrier();
            conv_share_blk(*ap, lds, blockIdx.x, gridDim.x);
            if (wr == 1) __builtin_amdgcn_s_barrier();
#else
            conv_share(*ap, blockIdx.x, gridDim.x);
#endif
        } } };

constexpr int NPHASE = 12;
#ifndef ONLY_PHASE
#define ONLY_PHASE -1
#endif
#ifndef SKIP_MASK
#define SKIP_MASK 0
#endif
#define PH_ON(P) ((ONLY_PHASE < 0 || ONLY_PHASE == (P)) && !((SKIP_MASK >> (P)) & 1))
#ifndef PROBE_DOUBLE
#define PROBE_DOUBLE -1
#endif
#define PROBE_REP(P) for (int _rep = 0; _rep < ((PROBE_DOUBLE == (P)) ? 2 : 1); ++_rep)
__global__ void __launch_bounds__(512, 2) fwd(Args a) {
    extern __shared__ __attribute__((aligned(16))) unsigned char shm[];
    LAS unsigned char* lds = (LAS unsigned char*)shm;
    if (threadIdx.x == 0) *(LAS u32x4*)(lds + LDS_XB) = (u32x4){0u, 0u, 0u, 0u};
    __syncthreads();
    XcdBarrier bar = xcd_barrier_post((unsigned*)(a.ws + WS_BAR), (volatile LAS unsigned*)(lds + LDS_XB));
    const int G = gridDim.x, blk = blockIdx.x;
#ifndef HARVEST_MASK
#define HARVEST_MASK 0
#endif
#define TSTAMP(P) do { if (PROBE_TIME >= 0 && blockIdx.x == 0 && threadIdx.x == 0) { if ((P) == PROBE_TIME) { ((unsigned long long*)(a.ws + 18688))[0] = __builtin_amdgcn_s_memrealtime(); ((unsigned long long*)(a.ws + 18688))[2] = __builtin_amdgcn_s_memtime(); } if ((P) == PROBE_TIME_END) { ((unsigned long long*)(a.ws + 18688))[1] = __builtin_amdgcn_s_memrealtime(); ((unsigned long long*)(a.ws + 18688))[3] = __builtin_amdgcn_s_memtime(); } } } while (0)
#ifndef PROBE_TIME_END
#define PROBE_TIME_END (PROBE_TIME + 1)
#endif
#ifndef PROBE_BAR2
#define PROBE_BAR2 0
#endif
#ifndef WARM_MASK
#define WARM_MASK 0
#endif
#define PHASE_END(P) do { if ((P) + 1 < a.ph_hi) { \
    if ((P) == 9 && ((WARM_MASK >> 9) & 1)) xcd_barrier(bar, [&]() { return warm_claim(a.ws + WS_WD_T, 8192u, (unsigned*)(a.ws + 19200)); }); \
    else if ((P) == 10 && ((WARM_MASK >> 10) & 1)) xcd_barrier(bar, [&]() { return warm_claim(a.ws + WS_X1, 4096u, (unsigned*)(a.ws + 19264)); }); \
    else if ((HARVEST_MASK >> (P)) & 1) xcd_barrier(bar, [&]() { return conv_claim(a, 1); }); else xcd_barrier(bar, []() { return false; }); if (PROBE_BAR2) xcd_barrier(bar, []() { return false; }); } } while (0)
    TSTAMP(0);
    if (PH_ON(0) && a.ph_lo <= 0 && 0 < a.ph_hi) { PROBE_REP(0) { phase_prologue(a, lds); __syncthreads(); } PHASE_END(0); }
    TSTAMP(1);
    if (PH_ON(1) && a.ph_lo <= 1 && 1 < a.ph_hi) { phase_norm1(a, lds);
#if PROBE_DOUBLE == 134
        __syncthreads(); phase_norm1(a, lds);
#endif
        PHASE_END(1); }
    TSTAMP(2);
    if (PH_ON(2) && a.ph_lo <= 2 && 2 < a.ph_hi) {
        pg8::Gemm g{(const bf16_t*)(a.ws + WS_H1), (const bf16_t*)(a.ws + WS_WIN_T), DM, 0, nullptr};
        ConvInProj S; S.init(NTOK, NPROJ, G, blk); S.ap = &a; S.lds = lds;
        pg8::EpiProj E{(bf16_t*)(a.ws + WS_PROJ), NPROJ};
        pg8::gemm_phase<false, false>(lds, g, S, E);
#if PROBE_DOUBLE == 26
        __syncthreads(); pg8::gemm_phase<false, false>(lds, g, S, E);
#endif
        PHASE_END(2); }
    TSTAMP(3);
    if (PH_ON(3) && a.ph_lo <= 3 && 3 < a.ph_hi) { phase_mix_prep(a, lds);
#if PROBE_DOUBLE == 134
        __syncthreads(); phase_mix_prep(a, lds);
#endif
#if PROBE_DOUBLE == 31
        __syncthreads(); for (int u = blockIdx.x; u < 512; u += gridDim.x) gla1_unit(a, lds, u);
#endif
#if PROBE_DOUBLE == 32
        __syncthreads(); for (int u2 = blockIdx.x; u2 < 256; u2 += gridDim.x) moba_prep_unit(a, lds, u2);
#endif
        PHASE_END(3); }
    TSTAMP(4);
    if (PH_ON(4) && a.ph_lo <= 4 && 4 < a.ph_hi) { phase_scan_select(a, lds);
#if PROBE_DOUBLE == 134
        __syncthreads(); phase_scan_select(a, lds);
#endif
        PHASE_END(4); }
    TSTAMP(5);
    if (PH_ON(5) && a.ph_lo <= 5 && 5 < a.ph_hi) { phase_mix_out(a, lds);
#if PROBE_DOUBLE == 5
        __syncthreads(); phase_mix_out(a, lds);
#endif
#if PROBE_DOUBLE == 51
        __syncthreads(); for (int u = blockIdx.x; u < 512; u += gridDim.x) gla3_unit(a, lds, u);
#endif
        PHASE_END(5); }
#if CHECK_MODE
    if (a.ph_lo <= 5 && 5 < a.ph_hi) { phase_check(a, lds); xcd_barrier(bar, []() { return false; }); phase_check2(a, lds); xcd_barrier(bar, []() { return false; }); }
#endif
    TSTAMP(6);
    if (PH_ON(6) && a.ph_lo <= 6 && 6 < a.ph_hi) {
        pg8::Gemm g{(const bf16_t*)(a.ws + WS_OCAT), (const bf16_t*)(a.ws + WS_WOUT_T), DM, 0, nullptr};
        pg8::StaticOrder S; S.init(NTOK, DM, G, blk);
        pg8::EpiOut E{a.x, (const float*)(a.ws + WS_MOD) + 4096, (float*)(a.ws + WS_X1)};
        pg8::gemm_phase<false, false>(lds, g, S, E);
#if PROBE_DOUBLE == 26
        __syncthreads(); pg8::gemm_phase<false, false>(lds, g, S, E);
#endif
        PHASE_END(6); }
    TSTAMP(7);
    if (PH_ON(7) && a.ph_lo <= 7 && 7 < a.ph_hi) { phase_router(a, lds); PHASE_END(7); }
    TSTAMP(8);
    if (PH_ON(8) && a.ph_lo <= 8 && 8 < a.ph_hi && CONV_IN_GEMM != 1) { phase_gather(a, lds); PHASE_END(8); }
    TSTAMP(9);
    if (PH_ON(9) && a.ph_lo <= 9 && 9 < a.ph_hi) {
#ifdef PROBE_TAB
        const unsigned long long tb0 = __builtin_amdgcn_s_memrealtime();
#endif
        moe_build_tab(a, lds, 16);
#ifdef PROBE_TAB
        if (blockIdx.x == 0 && threadIdx.x == 0) ((unsigned long long*)(a.ws + 18688))[4] = __builtin_amdgcn_s_memrealtime() - tb0;
#endif
        pg8::Gemm g{(const bf16_t*)(a.ws + WS_H1), (const bf16_t*)(a.ws + WS_WGU_T), DM / 2, (size_t)4096 * 1024, (const LAS int*)(lds + LDS_ROWTAB)};
        pg8::EpiGU8 E{a.b_gate_up, (unsigned char*)(a.ws + WS_ACT)};
        g.probe = a.ws + 18688 + 32;
        const int nmine = (((const LAS int*)(lds + LDS_EXTRA))[1] - (blk >> 3) + (G >> 3) - 1) / (G >> 3);
#pragma unroll 1
        for (int i0 = 0; i0 < (nmine > 0 ? nmine : 1); i0 += MAX_UNITS_WG) {
            pg8::MoeOrder S{(const LAS int*)(lds + LDS_EXTRA), blk >> 3, G >> 3, i0, MAX_UNITS_WG};
#ifdef PROBE_RT
            const unsigned long long tr0 = __builtin_amdgcn_s_memrealtime();
#endif
            moe_build_rowtab(a, lds, S);
#ifdef PROBE_RT
            if (blockIdx.x == 0 && threadIdx.x == 0) ((unsigned long long*)(a.ws + 18688))[4] = __builtin_amdgcn_s_memrealtime() - tr0;
#endif
            pg8::gemm_phase<true, true>(lds, g, S, E);
            __syncthreads();
        }
        PHASE_END(9); }
    TSTAMP(10);
    if (PH_ON(10) && a.ph_lo <= 10 && 10 < a.ph_hi) {
        moe_build_tab(a, lds, 8);
        pg8::Gemm g{(const bf16_t*)(a.ws + WS_ACT), (const bf16_t*)(a.ws + WS_WD_T), DM / 2, (size_t)2048 * 1024, nullptr};
        pg8::MoeOrder S{(const LAS int*)(lds + LDS_EXTRA), blk >> 3, G >> 3, 0, 1 << 30};
        pg8::EpiDown8 E{a.b_down, (const float*)(a.ws + WS_WBUF), (bf16_t*)(a.ws + WS_Y)};
        g.probe = a.ws + 18688 + 32;
        pg8::gemm_phase<true, false>(lds, g, S, E);
#if PROBE_DOUBLE == 10
        __syncthreads(); pg8::gemm_phase<true, false>(lds, g, S, E);
#endif
        PHASE_END(10); }
    TSTAMP(11);
    if (PH_ON(11) && a.ph_lo <= 11 && 11 < a.ph_hi) { phase_final(a, lds);
#if PROBE_DOUBLE == 811
        __syncthreads(); phase_final(a, lds);
#endif
    }
    TSTAMP(12);
#ifdef PROBE_SPIN
    if (blockIdx.x == 0 && threadIdx.x == 0) { const unsigned long long* ts = (const unsigned long long*)(a.ws + 18688);
#ifdef PROBE_GMAX
        const unsigned long long want = (unsigned long long)((const unsigned*)ts)[10] * PROBE_SPIN, t0 = __builtin_amdgcn_s_memrealtime();
#elif defined(PROBE_EPI) || defined(PROBE_TAB) || defined(PROBE_RT)
        const unsigned long long want = ts[4] * PROBE_SPIN, t0 = __builtin_amdgcn_s_memrealtime();
#elif defined(PROBE_CLK)
        const unsigned long long want = (ts[3] - ts[2]) * 1000ull / (ts[1] - ts[0]), t0 = __builtin_amdgcn_s_memrealtime();
#else
        const unsigned long long want = (ts[1] - ts[0]) * PROBE_SPIN, t0 = __builtin_amdgcn_s_memrealtime();
#endif

        while (__builtin_amdgcn_s_memrealtime() - t0 < want) __builtin_amdgcn_s_sleep(8); }
#endif

}

#ifndef N_LAUNCHES
#define N_LAUNCHES 1
#endif
extern "C" void kernel_launch(void* const* d_in, const int* in_sizes, int n_in, void* d_out, int out_size, void* d_ws, size_t ws_size, hipStream_t stream) {
    static int grid = 0;
    if (grid == 0) {
        if (n_in != 18 || out_size != NTOK * DM || ws_size < WS_END) { fprintf(stderr, "kernel_launch: unexpected shapes (n_in %d out %d ws %zu, need %zu)\n", n_in, out_size, ws_size, (size_t)WS_END); grid = -1; return; }
        int dev = 0, cus = 0, per_cu = 0;
        if (hipGetDevice(&dev) != hipSuccess || hipDeviceGetAttribute(&cus, hipDeviceAttributeMultiprocessorCount, dev) != hipSuccess) { grid = -1; return; }
        if (hipFuncSetAttribute((const void*)fwd, hipFuncAttributeMaxDynamicSharedMemorySize, LDS_BYTES) != hipSuccess) { fprintf(stderr, "kernel_launch: hipFuncSetAttribute failed\n"); grid = -1; return; }
        if (hipOccupancyMaxActiveBlocksPerMultiprocessor(&per_cu, (const void*)fwd, 512, LDS_BYTES) != hipSuccess || per_cu < 1) fprintf(stderr, "kernel_launch: occupancy query says %d\n", per_cu);
        (void)hipGetLastError();
        grid = cus;
    }
    if (grid < 0) return;
    (void)hipMemsetAsync(d_ws, 0, WS_ZERO_BYTES, stream);
    Args a{};
    a.x = (const float*)d_in[0]; a.c = (const float*)d_in[1]; a.w_ada = (const float*)d_in[2]; a.b_ada = (const float*)d_in[3]; a.norm1_w = (const float*)d_in[4];
    a.w_in = (const float*)d_in[5]; a.w_alpha2 = (const float*)d_in[6]; a.b_alpha = (const float*)d_in[7]; a.gla_norm_w = (const float*)d_in[8]; a.w_out = (const float*)d_in[9];
    a.norm2_w = (const float*)d_in[10]; a.w_router = (const float*)d_in[11]; a.b_router = (const float*)d_in[12]; a.w_gate_up = (const float*)d_in[13]; a.b_gate_up = (const float*)d_in[14];
    a.w_down = (const float*)d_in[15]; a.b_down = (const float*)d_in[16]; a.final_norm_w = (const float*)d_in[17];
    a.out = (float*)d_out; a.ws = (unsigned char*)d_ws;
    if (N_LAUNCHES == 1) { a.ph_lo = 0; a.ph_hi = NPHASE; hipLaunchKernelGGL(fwd, dim3(grid), dim3(512), LDS_BYTES, stream, a); }
    else for (int p = 0; p < NPHASE; ++p) { a.ph_lo = p; a.ph_hi = p + 1; hipLaunchKernelGGL(fwd, dim3(grid), dim3(512), LDS_BYTES, stream, a); }
}
```

```cpp
#include <hip/hip_runtime.h>
#include <stdint.h>
#include <stdio.h>

#define LAS __attribute__((address_space(3)))
typedef unsigned short bf16_t;
typedef short bf16x8 __attribute__((ext_vector_type(8)));
typedef float f32x4 __attribute__((ext_vector_type(4)));
typedef float f32x2 __attribute__((ext_vector_type(2)));
typedef unsigned u32x4 __attribute__((ext_vector_type(4)));
typedef unsigned u32x2 __attribute__((ext_vector_type(2)));

constexpr int DM = 2048, NBATCH = 2, SEQ = 4096, NTOK = 8192;
constexpr int DIN = 6160, NPROJ = 6144;
constexpr int NE = 32, TOPK = 4;
constexpr int C_QA = 0, C_KA = 512, C_VA = 1024, C_GA = 2048, C_QB = 3072, C_KB = 4096, C_VB = 5120;
constexpr int MAXROWS = 40960;
constexpr float EPS = 1e-6f;

constexpr size_t MB = 1024ull * 1024ull;
constexpr size_t WS_BAR = 0;
constexpr size_t WS_CNT = 16384;
constexpr size_t WS_ZERO_BYTES = 20480;
constexpr size_t WS_MOD = 32768;
constexpr size_t WS_ROPE = 1 * MB;
constexpr size_t WS_H1 = 3 * MB;
constexpr size_t WS_GK = WS_H1 + 32 * MB;
constexpr size_t WS_PROJ = WS_GK + 16 * MB;
constexpr size_t WS_WIN_T = WS_PROJ + 96 * MB;
constexpr size_t WS_WOUT_T = WS_WIN_T + 24 * MB;
constexpr size_t WS_WGU_T = WS_WOUT_T + 8 * MB;
constexpr size_t WS_WD_T = WS_WGU_T + 512 * MB;
constexpr size_t WS_BCUM = WS_WD_T + 256 * MB;
constexpr size_t WS_DST = WS_BCUM + 16 * MB;
constexpr size_t WS_DEC = WS_DST + 64 * MB;
constexpr size_t WS_ST = WS_DEC + 1 * MB;
constexpr size_t WS_QBR = WS_ST + 32 * MB;
constexpr size_t WS_KBR = WS_QBR + 16 * MB;
constexpr size_t WS_VBT = WS_KBR + 16 * MB;
constexpr size_t WS_KMEAN = WS_VBT + 16 * MB;
constexpr size_t WS_SEL = WS_KMEAN + 1 * MB;
constexpr size_t WS_OCAT = WS_SEL + 1 * MB;
constexpr size_t WS_X1 = WS_OCAT + 32 * MB;
constexpr size_t WS_PAIR_E = WS_X1 + 64 * MB;
constexpr size_t WS_PAIR_POS = WS_PAIR_E + 1 * MB;
constexpr size_t WS_PAIR_W = WS_PAIR_POS + 1 * MB;
constexpr size_t WS_SLOTROW = WS_PAIR_W + 1 * MB;
constexpr size_t WS_WBUF = WS_SLOTROW + 1 * MB;
constexpr size_t WS_XG = WS_WBUF + 1 * MB;
constexpr size_t WS_ACT = WS_XG + 160 * MB;
constexpr size_t WS_Y = WS_ACT + 160 * MB;
constexpr size_t WS_END = WS_Y + 160 * MB;

constexpr int LDS_BYTES = 163840;
constexpr int LDS_XB = 163840 - 16;
constexpr int LDS_EXTRA = 131072 + 1024;
constexpr int LDS_ROWTAB = 131072 + 1024 + 4096;
constexpr int MAX_UNITS_WG = 24;

struct Args {
    const float* x; const float* c; const float* w_ada; const float* b_ada; const float* norm1_w; const float* w_in; const float* w_alpha2; const float* b_alpha;
    const float* gla_norm_w; const float* w_out; const float* norm2_w; const float* w_router; const float* b_router; const float* w_gate_up; const float* b_gate_up;
    const float* w_down; const float* b_down; const float* final_norm_w;
    float* out; unsigned char* ws;
    int ph_lo, ph_hi;
};

__device__ __forceinline__ unsigned cvt_pk_bf16(float lo, float hi) { unsigned r; asm("v_cvt_pk_bf16_f32 %0, %1, %2" : "=v"(r) : "v"(lo), "v"(hi)); return r; }
__device__ __forceinline__ bf16_t f2bf(float f) { return (bf16_t)(cvt_pk_bf16(f, 0.f) & 0xffffu); }
__device__ __forceinline__ float bf2f(bf16_t b) { return __uint_as_float(((unsigned)b) << 16); }
__device__ __forceinline__ float bflo(unsigned w) { return __uint_as_float(w << 16); }
__device__ __forceinline__ float bfhi(unsigned w) { return __uint_as_float(w & 0xffff0000u); }
__device__ __forceinline__ float wave_sum(float v) {
#pragma unroll
    for (int o = 1; o < 64; o <<= 1) v += __shfl_xor(v, o);
    return v;
}
#ifndef FP8_EMU
#define FP8_EMU 0
#endif
__device__ __forceinline__ float q8(float x) { return __builtin_amdgcn_cvt_f32_fp8(__builtin_amdgcn_cvt_pk_fp8_f32(x, x, 0, false), 0); }
__device__ __forceinline__ float silu_f(float v) { return v / (1.f + expf(-v)); }
__device__ __forceinline__ f32x4 mfma16(bf16x8 a, bf16x8 b, f32x4 c) { return __builtin_amdgcn_mfma_f32_16x16x32_bf16(a, b, c, 0, 0, 0); }
__device__ __forceinline__ bf16x8 lds_frag(const LAS bf16_t* img, int ld, int r0, int k0, int lane) {
    return *(const LAS bf16x8*)(img + (r0 + (lane & 15)) * ld + k0 + 8 * (lane >> 4));
}

#define XB_TMO      128
#define XB_XCNT(j)  (256  + 64 * (j))
#define XB_XSUB(j)  (1280 + 64 * (j))
#define XB_XGEN(j)  (2304 + 64 * (j))
#define XB_TOP      3328
#define XB_TOPGEN   3392
#define XCD_BAR_WORDS 3456
#define XB_SPIN_CAP (1u << 18)
__device__ __forceinline__ unsigned xb_ld(unsigned* p)              { return __hip_atomic_load(p, __ATOMIC_RELAXED, __HIP_MEMORY_SCOPE_AGENT); }
__device__ __forceinline__ unsigned xb_add(unsigned* p, unsigned v) { return __hip_atomic_fetch_add(p, v, __ATOMIC_RELAXED, __HIP_MEMORY_SCOPE_AGENT); }
__device__ __forceinline__ unsigned xb_xcc_id() { return (unsigned)__builtin_amdgcn_s_getreg((3 << 11) | 20) & 0xFu; }
#define XB_SPIN(cond, bar) do { unsigned _sp = 0; while (cond) { __builtin_amdgcn_s_sleep(1); \
    if ((++_sp & 255u) == 0u) { if (xb_ld(&(bar)[XB_TMO])) break; if (_sp > XB_SPIN_CAP) { atomicAdd(&(bar)[XB_TMO], 1u); break; } } } } while (0)
struct XcdBarrier { unsigned* bar; unsigned x; volatile LAS unsigned* st; };
__device__ __forceinline__ XcdBarrier xcd_barrier_post(unsigned* bar, volatile LAS unsigned* st) {
    XcdBarrier b; b.bar = bar; b.x = xb_xcc_id(); b.st = st;
    if (threadIdx.x == 0) (void)xb_add(&bar[XB_XCNT(b.x)], 1u);
    return b;
}
__device__ __forceinline__ void xcd_barrier_complete(unsigned* bar, unsigned x, unsigned& nloc, unsigned& nx) {
    const unsigned G = gridDim.x * gridDim.y * gridDim.z;
    unsigned sum, cnt, mine, sp = 0u;
    for (;;) {
        sum = 0u; cnt = 0u; mine = 0u;
#pragma unroll
        for (unsigned j = 0; j < 16; ++j) { const unsigned c = xb_ld(&bar[XB_XCNT(j)]); sum += c; cnt += (c > 0u) ? 1u : 0u; mine = (j == x) ? c : mine; }
        if (sum == G) break;
        __builtin_amdgcn_s_sleep(1);
        if ((++sp & 255u) == 0u) { if (xb_ld(&bar[XB_TMO])) break; if (sp > XB_SPIN_CAP) { atomicAdd(&bar[XB_TMO], 1u); break; } }
    }
    nloc = mine > 0u ? mine : 1u; nx = cnt > 0u ? cnt : 1u;
}
template <class Idle>
__device__ __forceinline__ void xcd_barrier(const XcdBarrier& b, Idle&& idle) {
    asm volatile("s_waitcnt vmcnt(0)" ::: "memory");
    __syncthreads();
    if (threadIdx.x == 0) {
        unsigned* bar = b.bar;
        __builtin_amdgcn_s_waitcnt(0);
        unsigned nloc = b.st[0], nx = b.st[1];
        if (nloc == 0u) { xcd_barrier_complete(bar, b.x, nloc, nx); b.st[0] = nloc; b.st[1] = nx; }
        const unsigned old = xb_add(&bar[XB_XSUB(b.x)], 1u);
        const unsigned gen = old / nloc;
        if (old + 1u == (gen + 1u) * nloc) {
            __builtin_amdgcn_fence(__ATOMIC_RELEASE, "agent");
            asm volatile("s_waitcnt vmcnt(0)" ::: "memory");
            const unsigned og = xb_add(&bar[XB_TOP], 1u);
            const unsigned tg = og / nx;
            if (og + 1u == (tg + 1u) * nx) xb_add(&bar[XB_TOPGEN], 1u);
            else XB_SPIN(xb_ld(&bar[XB_TOPGEN]) == tg, bar);
            __builtin_amdgcn_fence(__ATOMIC_ACQUIRE, "agent");
            xb_add(&bar[XB_XGEN(b.x)], 1u);
            asm volatile("s_waitcnt vmcnt(0)" ::: "memory");
            b.st[2] = 1u;
        } else { b.st[2] = 0u; b.st[3] = gen; }
    }
    __syncthreads();
    unsigned rounds = 0u;
    while (b.st[2] == 0u) {
        const bool had = idle();
        const unsigned long long anyw = __ballot(had);
        __syncthreads();
        if (threadIdx.x == 0) {
            unsigned* bar = b.bar; const unsigned gen = b.st[3];
            bool rel = xb_ld(&bar[XB_XGEN(b.x)]) != gen;
            if (!rel && anyw == 0ull) { XB_SPIN(xb_ld(&bar[XB_XGEN(b.x)]) == gen, bar); rel = true; }
            if (!rel && ++rounds > (1u << 16)) { atomicAdd(&bar[XB_TMO], 1u); rel = true; }
            if (rel) { __builtin_amdgcn_fence(__ATOMIC_ACQUIRE, "agent"); asm volatile("s_waitcnt vmcnt(0)" ::: "memory"); b.st[2] = 1u; }
        }
        __syncthreads();
    }
}
#ifndef PROBE_GMIN
#define PROBE_GMIN 0
#endif
#ifndef FP8_SCALE_ARG
#define FP8_SCALE_ARG 0
#endif

#ifndef PROBE_STORE2
#define PROBE_STORE2 0
#endif
#ifndef FP8_ASM
#define FP8_ASM 0
#endif
namespace pg8 {
constexpr int BM = 256, BK = 64, HALF = 128, HTB = HALF * BK * 2, STAGE_BYTES = 8 * HTB, NXCD = 8, WGM = 8;
__host__ __device__ __forceinline__ int lds_byte(int r, int c) { const int st = (r >> 4) * 2 + (c >> 5), rr = r & 15, cc = c & 31, ob = rr * 64 + cc * 2; return st * 1024 + (ob ^ (((ob >> 9) & 1) << 5)); }
__host__ __device__ __forceinline__ void stage_rc(int b, int& R, int& C) { const int st = b / 1024, sb = b % 1024, swz = sb ^ (((sb >> 9) & 1) << 5); R = (st >> 1) * 16 + swz / 64; C = (st & 1) * 32 + (swz % 64) / 2; }
__host__ __device__ __forceinline__ int perm32(int rho) { const int n = rho >> 4, i = rho & 15; return 8 * (i >> 2) + 4 * n + (i & 3); }

struct Unit { int pm, pn, e, full, pos0; };
struct Gemm { const bf16_t* A; const bf16_t* Bt; int K; size_t b_estride; const LAS int* rowtab; void* probe; };

struct StaticOrder {
    int nM, nN, nwg, G, c;
    __device__ void init(int M, int N, int G_, int c_) { nM = M / BM; nN = N / BM; nwg = nM * nN; G = G_; c = c_; }
    __device__ bool next(int i, Unit& u) const {
        const long L = (long)i * G + c; if (L >= nwg) return false;
        int wgid = (int)L; { const int q = nwg / NXCD, r = nwg % NXCD, xcd = wgid % NXCD, off = wgid / NXCD; wgid = (xcd < r ? xcd * (q + 1) : r * (q + 1) + (xcd - r) * q) + off; }
        const int nig = WGM * nN, gid = wgid / nig, fm = gid * WGM, gsz = (nM - fm) < WGM ? (nM - fm) : WGM;
        u.pm = fm + ((wgid % nig) % gsz); u.pn = (wgid % nig) / gsz; u.e = 0; u.full = 1; u.pos0 = 0; return true;
    }
    __device__ __forceinline__ void between(int) const {}
};
struct MoeOrder {
    const LAS int* tab; int r, nper, i0, imax;
    __device__ bool next(int i, Unit& u) const {
        if (i >= imax) return false;
        const int L = (i0 + i) * nper + r; if (L >= __builtin_amdgcn_readfirstlane(tab[1])) return false;
        int p = 0; const int np = tab[0];
#pragma unroll 1
        while (p + 1 < np && tab[4 + 8 * (p + 1)] <= L) ++p;
        const LAS int* t = tab + 4 + 8 * p;
        const int local = L - t[0], mte = t[3], pq = local / mte, mt = local - pq * mte;
        u.e = __builtin_amdgcn_readfirstlane(t[1]); u.pn = __builtin_amdgcn_readfirstlane(t[2] + pq); u.pm = __builtin_amdgcn_readfirstlane(t[4] + mt);
        u.full = __builtin_amdgcn_readfirstlane((t[5] - mt * 256) > 128 ? 1 : 0); u.pos0 = __builtin_amdgcn_readfirstlane(mt * 256); return true;
    }
    __device__ __forceinline__ void between(int) const {}
};

struct EpiProj {
    static constexpr bool PERM = true;
    bf16_t* O; int ldc;
    __device__ __forceinline__ void operator()(const f32x4 (&acc)[2][2][4][2], const Unit& u, int wr, int wc, int fr, int fq) const {
        const int row0 = u.pm * BM + wr * 64 + fr, col0 = u.pn * BM + wc * 32 + 8 * fq;
#pragma unroll
        for (int ai = 0; ai < 2; ++ai)
#pragma unroll
            for (int m = 0; m < 4; ++m) { bf16_t* rowp = O + (size_t)(row0 + ai * HALF + m * 16) * ldc + col0;
#pragma unroll
                for (int bj = 0; bj < 2; ++bj) { const f32x4 v0 = acc[ai][bj][m][0], v1 = acc[ai][bj][m][1];
                    u32x4 w; w.x = cvt_pk_bf16(v0[0], v0[1]); w.y = cvt_pk_bf16(v0[2], v0[3]); w.z = cvt_pk_bf16(v1[0], v1[1]); w.w = cvt_pk_bf16(v1[2], v1[3]);
                    *(u32x4*)(rowp + bj * HALF) = w;
#if PROBE_STORE2 == 1
                    *(u32x4*)(rowp + bj * HALF + (size_t)1792 * 1024 * 1024) = w;
#endif
                } }
    }
};
struct EpiOut {
    static constexpr bool PERM = false;
    const float* X; const float* g1;   float* O;
    __device__ __forceinline__ void operator()(const f32x4 (&acc)[2][2][4][2], const Unit& u, int wr, int wc, int fr, int fq) const {
        const int row0 = u.pm * BM + wr * 64 + fr, col0 = u.pn * BM + wc * 32 + 4 * fq;
        const float* gp = g1 + (size_t)((u.pm * BM) >> 12) * 12288 + col0;
        f32x4 gv[2][2];
#pragma unroll
        for (int bj = 0; bj < 2; ++bj)
#pragma unroll
            for (int n = 0; n < 2; ++n) gv[bj][n] = *(const f32x4*)(gp + bj * HALF + n * 16);
#pragma unroll
        for (int ai = 0; ai < 2; ++ai)
#pragma unroll
            for (int m = 0; m < 4; ++m) { const size_t off = (size_t)(row0 + ai * HALF + m * 16) * DM + col0;
#pragma unroll
                for (int bj = 0; bj < 2; ++bj)
#pragma unroll
                    for (int n = 0; n < 2; ++n) { const f32x4 xv = *(const f32x4*)(X + off + bj * HALF + n * 16);
                        *(f32x4*)(O + off + bj * HALF + n * 16) = xv + gv[bj][n] * acc[ai][bj][m][n]; }
                asm volatile("" ::: "memory"); }
    }
};
struct EpiGU {
    static constexpr bool PERM = true;
    const float* bias;   bf16_t* O;
    __device__ __forceinline__ void operator()(const f32x4 (&acc)[2][2][4][2], const Unit& u, int wr, int wc, int fr, int fq) const {
        const int row0 = u.pm * BM + wr * 64 + fr, cc = u.pn * HALF + wc * 32 + 8 * fq;
        const float* bp = bias + (size_t)u.e * 4096 + cc;
        f32x4 bg[2], bu[2];
#pragma unroll
        for (int n = 0; n < 2; ++n) { bg[n] = *(const f32x4*)(bp + 4 * n); bu[n] = *(const f32x4*)(bp + 2048 + 4 * n); }
#pragma unroll
        for (int ai = 0; ai < 2; ++ai)
#pragma unroll
            for (int m = 0; m < 4; ++m) { float r[8];
#pragma unroll
                for (int n = 0; n < 2; ++n)
#pragma unroll
                    for (int j = 0; j < 4; ++j) {
                        float g = acc[ai][0][m][n][j] + bg[n][j], uu = acc[ai][1][m][n][j] + bu[n][j];
                        g = fminf(g, 7.0f); uu = fminf(fmaxf(uu, -7.0f), 7.0f);
                        const float glu = g * __builtin_amdgcn_rcpf(1.0f + __expf(-1.702f * g));
                        r[n * 4 + j] = (uu + 1.0f) * glu;
#if FP8_EMU
                        r[n * 4 + j] = q8(r[n * 4 + j]);
#endif
                    }
                u32x4 w; w.x = cvt_pk_bf16(r[0], r[1]); w.y = cvt_pk_bf16(r[2], r[3]); w.z = cvt_pk_bf16(r[4], r[5]); w.w = cvt_pk_bf16(r[6], r[7]);
                *(u32x4*)(O + (size_t)(row0 + ai * HALF + m * 16) * DM + cc) = w; }
    }
};
struct EpiDown {
    static constexpr bool PERM = true;
    const float* bias;   const float* wbuf; bf16_t* O;
    __device__ __forceinline__ void operator()(const f32x4 (&acc)[2][2][4][2], const Unit& u, int wr, int wc, int fr, int fq) const {
        const int row0 = u.pm * BM + wr * 64 + fr, col0 = u.pn * BM + wc * 32 + 8 * fq;
        const float* bp = bias + (size_t)u.e * 2048 + col0;
        f32x4 bv[2][2];
#pragma unroll
        for (int bj = 0; bj < 2; ++bj)
#pragma unroll
            for (int n = 0; n < 2; ++n) bv[bj][n] = *(const f32x4*)(bp + bj * HALF + 4 * n);
#pragma unroll
        for (int ai = 0; ai < 2; ++ai)
#pragma unroll
            for (int m = 0; m < 4; ++m) { const int row = row0 + ai * HALF + m * 16; const float rw = wbuf[row]; bf16_t* rowp = O + (size_t)row * DM + col0;
#pragma unroll
                for (int bj = 0; bj < 2; ++bj) { const f32x4 v0 = (acc[ai][bj][m][0] + bv[bj][0]) * rw, v1 = (acc[ai][bj][m][1] + bv[bj][1]) * rw;
                    u32x4 w; w.x = cvt_pk_bf16(v0[0], v0[1]); w.y = cvt_pk_bf16(v0[2], v0[3]); w.z = cvt_pk_bf16(v1[0], v1[1]); w.w = cvt_pk_bf16(v1[2], v1[3]);
                    *(u32x4*)(rowp + bj * HALF) = w; } }
    }
};

__device__ __forceinline__ unsigned pk4_fp8(float a, float b, float c, float d) { int p = __builtin_amdgcn_cvt_pk_fp8_f32(a, b, 0, false); p = __builtin_amdgcn_cvt_pk_fp8_f32(c, d, p, true); return (unsigned)p; }
constexpr float W8_SCALE = 64.0f, W8_INV = 1.0f / 64.0f;
struct EpiGU8 {
    static constexpr bool PERM = true;
    const float* bias;   unsigned char* O;
    __device__ __forceinline__ void operator()(const f32x4 (&acc)[2][2][4][2], const Unit& u, int wr, int wc, int fr, int fq) const {
        const int row0 = u.pm * BM + wr * 64 + fr, cc = u.pn * HALF + wc * 32 + 8 * fq;
        const float* bp = bias + (size_t)u.e * 4096 + cc;
        f32x4 bg[2], bu[2];
#pragma unroll
        for (int n = 0; n < 2; ++n) { bg[n] = *(const f32x4*)(bp + 4 * n); bu[n] = *(const f32x4*)(bp + 2048 + 4 * n); }
#pragma unroll
        for (int ai = 0; ai < 2; ++ai)
#pragma unroll
            for (int m = 0; m < 4; ++m) { float r[8];
#pragma unroll
                for (int n = 0; n < 2; ++n)
#pragma unroll
                    for (int j = 0; j < 4; ++j) {
                        float g = acc[ai][0][m][n][j] * W8_INV + bg[n][j], uu = acc[ai][1][m][n][j] * W8_INV + bu[n][j];
                        g = fminf(g, 7.0f); uu = fminf(fmaxf(uu, -7.0f), 7.0f);
                        const float glu = g * __builtin_amdgcn_rcpf(1.0f + __expf(-1.702f * g));
                        r[n * 4 + j] = (uu + 1.0f) * glu; }
                u32x2 w; w.x = pk4_fp8(r[0], r[1], r[2], r[3]); w.y = pk4_fp8(r[4], r[5], r[6], r[7]);
                *(u32x2*)(O + (size_t)(row0 + ai * HALF + m * 16) * DM + cc) = w; }
    }
};
struct EpiDown8 {
    static constexpr bool PERM = true;
    const float* bias;   const float* wbuf; bf16_t* O;
    __device__ __forceinline__ void operator()(const f32x4 (&acc)[2][2][4][2], const Unit& u, int wr, int wc, int fr, int fq) const {
        const int row0 = u.pm * BM + wr * 64 + fr, col0 = u.pn * BM + wc * 32 + 8 * fq;
        const float* bp = bias + (size_t)u.e * 2048 + col0;
        f32x4 bv[2][2];
#pragma unroll
        for (int bj = 0; bj < 2; ++bj)
#pragma unroll
            for (int n = 0; n < 2; ++n) bv[bj][n] = *(const f32x4*)(bp + bj * HALF + 4 * n);
#pragma unroll
        for (int ai = 0; ai < 2; ++ai)
#pragma unroll
            for (int m = 0; m < 4; ++m) { const int row = row0 + ai * HALF + m * 16; const float rw = wbuf[(size_t)u.e * 8192 + u.pos0 + (row - u.pm * BM)]; bf16_t* rowp = O + (size_t)row * DM + col0;
#pragma unroll
                for (int bj = 0; bj < 2; ++bj) { const f32x4 v0 = (acc[ai][bj][m][0] * W8_INV + bv[bj][0]) * rw, v1 = (acc[ai][bj][m][1] * W8_INV + bv[bj][1]) * rw;
                    u32x4 w; w.x = cvt_pk_bf16(v0[0], v0[1]); w.y = cvt_pk_bf16(v0[2], v0[3]); w.z = cvt_pk_bf16(v1[0], v1[1]); w.w = cvt_pk_bf16(v1[2], v1[3]);
                    *(u32x4*)(rowp + bj * HALF) = w; } }
    }
};

typedef int i32x8 __attribute__((ext_vector_type(8)));
typedef short s16x16 __attribute__((ext_vector_type(16)));
__device__ __forceinline__ i32x8 ld32(const LAS unsigned char* p) { const bf16x8 lo = *(const LAS bf16x8*)p, hi = *(const LAS bf16x8*)(p + 1024); return __builtin_bit_cast(i32x8, __builtin_shufflevector(lo, hi, 0, 1, 2, 3, 4, 5, 6, 7, 8, 9, 10, 11, 12, 13, 14, 15)); }
__device__ __forceinline__ const char* sbase(const char* p) { asm volatile("" : "+s"(p)); return p; }
template <bool FP8, bool GATHER, class Epi, class Sched>
__device__ __forceinline__ void gemm_phase(LAS unsigned char* lds, const Gemm g, const Sched& S, const Epi& E) {
    const int tid = threadIdx.x, wid = __builtin_amdgcn_readfirstlane(tid >> 6), lane = tid & 63, wr = wid >> 2, wc = wid & 3, fr = lane & 15, fq = lane >> 4;
    const int K = g.K, nt = K / BK;
    unsigned voffA, voffB;
    { int R, C; stage_rc(tid * 16, R, C); const int Rb = Epi::PERM ? ((R & ~31) + perm32(R & 31)) : R; voffA = (unsigned)(R * K + C) * 2u; voffB = (unsigned)(Rb * K + C) * 2u; }
    const size_t pstep = (size_t)64 * K * 2;
    unsigned voffC = 0, ro[4] = {0, 0, 0, 0}; int Rl = 0;
    if constexpr (GATHER) { int R, C; stage_rc(tid * 16, R, C); voffC = (unsigned)C * 2u; Rl = R; }
#define PG8_ROWS(x0, uidx) do { ro[x0] = (unsigned)g.rowtab[(uidx) * 256 + Rl + 64 * (x0)]; ro[(x0) + 1] = (unsigned)g.rowtab[(uidx) * 256 + Rl + 64 * (x0) + 64]; } while (0)
    const size_t kstep = (size_t)(BK * 2);
    const size_t hstep = (size_t)HALF * K * 2;
    const size_t tstep = 2 * hstep;
    const size_t estep = g.b_estride * 2;
    const unsigned ldsw = (unsigned)wid * 1024u;
    const int aoff0 = lds_byte(wr * 64 + fr, fq * 8), boff0 = lds_byte(wc * 32 + fr, fq * 8);
#define PG8_SA(b, h) (((b) * 2 + (h)) * HTB)
#define PG8_SB(b, h) ((4 + (b) * 2 + (h)) * HTB)
#define PG8_STAGE(bufoff, gbase, voff) do { _Pragma("unroll") for (int _i = 0; _i < 2; ++_i) \
        __builtin_amdgcn_global_load_lds((const unsigned*)(sbase((const char*)(gbase) + _i * pstep) + (voff)), (LAS unsigned*)(lds + (bufoff) + ldsw + _i * 8192), 16, 0, 0); } while (0)
#define PG8_STAGEA(bufoff, isnext, half, koff) do { if constexpr (GATHER) { _Pragma("unroll") for (int _i = 0; _i < 2; ++_i) { const unsigned _r = ro[(half) * 2 + _i]; \
            __builtin_amdgcn_global_load_lds((const unsigned*)(sbase((const char*)g.A + (koff)) + (_r + voffC)), (LAS unsigned*)(lds + (bufoff) + ldsw + _i * 8192), 16, 0, 0); } } \
        else { PG8_STAGE(bufoff, ((isnext) ? nA : cA) + (half) * hstep + (koff), voffA); } } while (0)
#define PG8_LDA(dst, b, h) do { _Pragma("unroll") for (int m = 0; m < 4; ++m) { \
        if constexpr (FP8) dst##8[m] = ld32(lds + PG8_SA(b, h) + aoff0 + m * 2048); \
        else { dst[m][0] = *(const LAS bf16x8*)(lds + PG8_SA(b, h) + aoff0 + m * 2048); dst[m][1] = *(const LAS bf16x8*)(lds + PG8_SA(b, h) + aoff0 + m * 2048 + 1024); } } } while (0)
#define PG8_LDB(dst, b, h) do { _Pragma("unroll") for (int n = 0; n < 2; ++n) { \
        if constexpr (FP8) dst##8[n] = ld32(lds + PG8_SB(b, h) + boff0 + n * 2048); \
        else { dst[n][0] = *(const LAS bf16x8*)(lds + PG8_SB(b, h) + boff0 + n * 2048); dst[n][1] = *(const LAS bf16x8*)(lds + PG8_SB(b, h) + boff0 + n * 2048 + 1024); } } } while (0)
#define PG8_MMA(ai, bj, At, Bt) do { __builtin_amdgcn_s_setprio(1); _Pragma("unroll") for (int m = 0; m < 4; ++m) _Pragma("unroll") for (int n = 0; n < 2; ++n) { \
        if constexpr (FP8) { if (FP8_ASM) { asm volatile("v_mfma_scale_f32_16x16x128_f8f6f4 %0, %1, %2, %0, %3, %3 op_sel_hi:[0,0,0]" : "+a"(acc[ai][bj][m][n]) : "v"(Bt##8[n]), "v"(At##8[m]), "v"(scale1)); } \
            else acc[ai][bj][m][n] = __builtin_amdgcn_mfma_scale_f32_16x16x128_f8f6f4(Bt##8[n], At##8[m], acc[ai][bj][m][n], 0, 0, 0, FP8_SCALE_ARG, 0, FP8_SCALE_ARG); } \
        else { acc[ai][bj][m][n] = __builtin_amdgcn_mfma_f32_16x16x32_bf16(Bt[n][0], At[m][0], acc[ai][bj][m][n], 0, 0, 0); \
               acc[ai][bj][m][n] = __builtin_amdgcn_mfma_f32_16x16x32_bf16(Bt[n][1], At[m][1], acc[ai][bj][m][n], 0, 0, 0); } } \
        __builtin_amdgcn_s_setprio(0); } while (0)
#define PG8_WAIT_V(n) asm volatile("s_waitcnt vmcnt(" #n ")" ::: "memory")
#define PG8_WAIT_L(n) asm volatile("s_waitcnt lgkmcnt(" #n ")" ::: "memory")
#define PG8_BAR __builtin_amdgcn_s_barrier()
#define PG8_SCHED __builtin_amdgcn_sched_barrier(0)
#ifdef PROBE_GMAX
    const unsigned long long tg0 = __builtin_amdgcn_s_memrealtime();
#endif
    Unit cur, nxt; int ui = 0;
#ifdef PROBE_EPI
    unsigned long long epi_acc = 0;
#endif
    if (!S.next(0, cur)) return;
    f32x4 acc[2][2][4][2];
#pragma unroll
    for (int a = 0; a < 2; ++a)
#pragma unroll
        for (int b = 0; b < 2; ++b)
#pragma unroll
            for (int m = 0; m < 4; ++m)
#pragma unroll
                for (int n = 0; n < 2; ++n) acc[a][b][m][n] = (f32x4){0.f, 0.f, 0.f, 0.f};
    bf16x8 At[4][2], B0[2][2], B1[2][2]; i32x8 At8[4], B08[2], B18[2];
    const unsigned scale1 = 0x7f7f7f7fu;
    const char* cA = (const char*)g.A + (size_t)cur.pm * tstep; const char* cB = (const char*)g.Bt + (size_t)cur.e * estep + (size_t)cur.pn * tstep;
    const char* nA = cA;
    if constexpr (GATHER) { PG8_ROWS(0, 0); PG8_ROWS(2, 0); }
    PG8_STAGE(PG8_SB(0, 0), cB, voffB); PG8_STAGEA(PG8_SA(0, 0), false, 0, 0); PG8_STAGE(PG8_SB(0, 1), cB + hstep, voffB); PG8_STAGEA(PG8_SA(0, 1), false, 1, 0);
    if (wr == 1) PG8_BAR;
    PG8_WAIT_V(4); PG8_BAR;
    PG8_STAGE(PG8_SB(1, 0), cB + kstep, voffB); PG8_STAGEA(PG8_SA(1, 0), false, 0, kstep); PG8_STAGE(PG8_SB(1, 1), cB + hstep + kstep, voffB);
    PG8_WAIT_V(6); PG8_BAR;
    for (;;) {
        const bool has_next = S.next(ui + 1, nxt);
        const bool cfull = FP8 ? true : (cur.full != 0);
        nA = has_next ? (const char*)g.A + (size_t)nxt.pm * tstep : cA;
        const char* nB = has_next ? (const char*)g.Bt + (size_t)nxt.e * estep + (size_t)nxt.pn * tstep : cB;
#ifdef PROBE_KL
        const unsigned long long tk0 = __builtin_amdgcn_s_memrealtime();
#endif
        for (int t = 0; t < nt; t += 2) {
            const bool last = (t == nt - 2);
            const size_t k1 = (size_t)(t + 1) * kstep, k2 = last ? 0 : (size_t)(t + 2) * kstep, k3 = k2 + kstep;
            const char* b2 = last ? nB : cB + (size_t)(t + 2) * kstep; const char* b3 = b2 + kstep;
            if constexpr (GATHER) { if (last && has_next) PG8_ROWS(0, ui + 1); }
            PG8_LDB(B0, 0, 0); PG8_SCHED; PG8_LDA(At, 0, 0); PG8_STAGEA(PG8_SA(1, 1), false, 1, k1);
            if constexpr (GATHER) { if (last && has_next) PG8_ROWS(2, ui + 1); }
            PG8_WAIT_V(10); PG8_WAIT_L(8); PG8_BAR; PG8_WAIT_L(0); PG8_MMA(0, 0, At, B0); PG8_BAR; PG8_SCHED;
            PG8_LDB(B1, 0, 1); PG8_STAGE(PG8_SB(0, 0), b2, voffB);
            PG8_WAIT_V(10); PG8_BAR; PG8_WAIT_L(0); PG8_MMA(0, 1, At, B1); PG8_BAR;
            PG8_LDA(At, 0, 1); PG8_STAGEA(PG8_SA(0, 0), last, 0, k2);
            PG8_BAR; PG8_WAIT_L(0); if (cfull) PG8_MMA(1, 0, At, B0); PG8_BAR; PG8_SCHED;
            PG8_STAGE(PG8_SB(0, 1), b2 + hstep, voffB);
            PG8_WAIT_V(10); PG8_BAR; if (cfull) PG8_MMA(1, 1, At, B1); PG8_BAR;
            PG8_LDB(B0, 1, 0); PG8_SCHED; PG8_LDA(At, 1, 0); PG8_STAGEA(PG8_SA(0, 1), last, 1, k2);
            PG8_WAIT_V(10); PG8_WAIT_L(8); PG8_BAR; PG8_WAIT_L(0); PG8_MMA(0, 0, At, B0); PG8_BAR; PG8_SCHED;
            PG8_LDB(B1, 1, 1); PG8_STAGE(PG8_SB(1, 0), b3, voffB);
            PG8_WAIT_V(10); PG8_BAR; PG8_WAIT_L(0); PG8_MMA(0, 1, At, B1); PG8_BAR;
            PG8_LDA(At, 1, 1); PG8_STAGEA(PG8_SA(1, 0), last, 0, k3);
            PG8_BAR; PG8_WAIT_L(0); if (cfull) PG8_MMA(1, 0, At, B0); PG8_BAR; PG8_SCHED;
            PG8_STAGE(PG8_SB(1, 1), b3 + hstep, voffB);
            PG8_WAIT_V(10); PG8_BAR; if (cfull) PG8_MMA(1, 1, At, B1); PG8_BAR;
        }
#ifdef PROBE_KL
        if (FP8 && (GATHER ? 9 : 10) == PROBE_EPI) epi_acc += __builtin_amdgcn_s_memrealtime() - tk0;
#endif
        {
            int tz = threadIdx.x; asm volatile("" : "+v"(tz)); const int lz = tz & 63;
#ifdef PROBE_EPI
            const unsigned long long te0 = __builtin_amdgcn_s_memrealtime();
#endif
            E(acc, cur, wr, wc, lz & 15, lz >> 4);
#ifdef PROBE_EPI
#ifndef PROBE_KL
            if (FP8 && (GATHER ? 9 : 10) == PROBE_EPI) { epi_acc += __builtin_amdgcn_s_memrealtime() - te0; }
#endif
#endif
            }
        S.between(ui);
        if (!has_next) break;
#pragma unroll
        for (int a = 0; a < 2; ++a)
#pragma unroll
            for (int b = 0; b < 2; ++b)
#pragma unroll
                for (int m = 0; m < 4; ++m)
#pragma unroll
                    for (int n = 0; n < 2; ++n) acc[a][b][m][n] = (f32x4){0.f, 0.f, 0.f, 0.f};
        cur = nxt; cA = nA; cB = nB; ++ui;

    }
#ifdef PROBE_EPI
    if (FP8 && (GATHER ? 9 : 10) == PROBE_EPI && blockIdx.x == 0 && threadIdx.x == 0) *(unsigned long long*)((char*)g.probe) = epi_acc;
#endif
#ifdef PROBE_GMAX
    if (FP8 && (GATHER ? 9 : 10) == PROBE_GMAX && threadIdx.x == 0) { const unsigned d = (unsigned)(__builtin_amdgcn_s_memrealtime() - tg0); if (PROBE_GMIN) atomicMin((unsigned*)((char*)g.probe + 8), d); else atomicMax((unsigned*)((char*)g.probe + 8), d); }
#endif
    PG8_WAIT_V(0);
    if (wr == 0) PG8_BAR;
    PG8_BAR;
#undef PG8_SA
#undef PG8_SB
#undef PG8_STAGE
#undef PG8_STAGEA
#undef PG8_ROWS
#undef PG8_LDA
#undef PG8_LDB
#undef PG8_MMA
#undef PG8_WAIT_V
#undef PG8_WAIT_L
#undef PG8_BAR
#undef PG8_SCHED
}
}
#ifndef BJOB_NT
#define BJOB_NT 1
#endif
#if BJOB_NT
#define BJOB_LD(p) __builtin_nontemporal_load(p)
#else
#define BJOB_LD(p) (*(p))
#endif

__device__ __forceinline__ void conv_job(const float* src, int ld, bf16_t* dst, int kt) {
    const int w = threadIdx.x >> 6, lane = threadIdx.x & 63, kseg = lane & 7, nq = lane >> 3;
    const int k0 = kt * 128 + (w >> 2) * 64 + kseg * 8, nl = (w & 3) * 32 + nq * 4;
    f32x4 v[8];
#pragma unroll
    for (int r = 0; r < 8; ++r) v[r] = *(const f32x4*)(src + (size_t)(k0 + r) * ld + nl);
#if FP8_EMU
#pragma unroll
    for (int r = 0; r < 8; ++r)
#pragma unroll
        for (int j = 0; j < 4; ++j) v[r][j] = q8(v[r][j] * 64.0f) * (1.0f / 64.0f);
#endif
#pragma unroll
    for (int j = 0; j < 4; ++j) { u32x4 o; o.x = cvt_pk_bf16(v[0][j], v[1][j]); o.y = cvt_pk_bf16(v[2][j], v[3][j]); o.z = cvt_pk_bf16(v[4][j], v[5][j]); o.w = cvt_pk_bf16(v[6][j], v[7][j]);
        *(u32x4*)(dst + (size_t)(nl + j) * 2048 + k0) = o; }
}
constexpr int CONV_JOBS_GU = 32 * 16 * 16, CONV_JOBS_D = 32 * 16 * 8, CONV_JOBS = CONV_JOBS_GU + CONV_JOBS_D;
__device__ __forceinline__ void conv_block_job(const Args& a, LAS unsigned char* T, int j) {
    const int tid = threadIdx.x, w = tid >> 6, lane = tid & 63;
    const float* src; int ld; unsigned char* dst; int gu, s0;
    if (j < CONV_JOBS_GU) { const int e = j >> 8, kb = (j >> 4) & 15, nb = j & 15; s0 = nb * 256; gu = 1;
        src = a.w_gate_up + ((size_t)e * 2048 + kb * 128) * 4096 + s0; ld = 4096; dst = (unsigned char*)(a.ws + WS_WGU_T) + (size_t)e * 4096 * 2048 + kb * 128; }
    else { const int jj = j - CONV_JOBS_GU, e = jj >> 7, kb = (jj >> 3) & 15, nb = jj & 7; s0 = nb * 256; gu = 0;
        src = a.w_down + ((size_t)e * 2048 + kb * 128) * 2048 + s0; ld = 2048; dst = (unsigned char*)(a.ws + WS_WD_T) + (size_t)e * 2048 * 2048 + kb * 128; }
    f32x4 v[16];
#pragma unroll
    for (int r = 0; r < 16; ++r) v[r] = __builtin_nontemporal_load((const f32x4*)(src + (size_t)(w * 16 + r) * ld + lane * 4)) * pg8::W8_SCALE;
#pragma unroll
    for (int jn = 0; jn < 4; ++jn) { u32x4 o;
        o.x = pg8::pk4_fp8(v[0][jn], v[1][jn], v[2][jn], v[3][jn]); o.y = pg8::pk4_fp8(v[4][jn], v[5][jn], v[6][jn], v[7][jn]);
        o.z = pg8::pk4_fp8(v[8][jn], v[9][jn], v[10][jn], v[11][jn]); o.w = pg8::pk4_fp8(v[12][jn], v[13][jn], v[14][jn], v[15][jn]);
        const int n = lane * 4 + jn;
        *(LAS u32x4*)(T + n * 128 + ((w ^ (lane & 7)) << 4)) = o; }
    __syncthreads();
#pragma unroll
    for (int p = 0; p < 4; ++p) { const int idx = tid + 512 * p, n = idx >> 3, wq = idx & 7;
        const u32x4 o = *(const LAS u32x4*)(T + n * 128 + ((wq ^ ((n >> 2) & 7)) << 4));
        const int c = s0 + n; int np = c;
        if (gu) { const int bj = c >> 11, rem = c & 2047; np = (rem >> 7) * 256 + bj * 128 + (rem & 127); }
        __builtin_nontemporal_store(o, (u32x4*)(dst + (size_t)np * 2048 + wq * 16)); }
}
constexpr int SJOBS_GU = 32 * 32 * 128, SJOBS_D = 32 * 32 * 64, SJOBS = SJOBS_GU + SJOBS_D;
constexpr int SJOBS_ATTN = 256 * 33 * 8;
typedef short s16x2 __attribute__((ext_vector_type(2)));
__device__ __forceinline__ unsigned pk4_fp8_scaled(float a, float b, float c, float d) { s16x2 r = {0, 0}; r = __builtin_amdgcn_cvt_scalef32_pk_fp8_f32(r, a, b, pg8::W8_INV, false); r = __builtin_amdgcn_cvt_scalef32_pk_fp8_f32(r, c, d, pg8::W8_INV, true); return __builtin_bit_cast(unsigned, r); }
struct SJob { const float* src; unsigned char* dst; int ld; };
__device__ __forceinline__ SJob sjob_addr(const Args& a, int j, int lane) {
    SJob c; const int kseg = lane & 7, nq = lane >> 3;
    if (j < SJOBS_GU) { const int e = j >> 12, kb = (j >> 7) & 31, nb = j & 127, s0 = nb * 32, bj = s0 >> 11, rem = s0 & 2047, pn = rem >> 7, c0 = rem & 127, np = pn * 256 + bj * 128 + c0;
        c.ld = 4096; c.src = a.w_gate_up + ((size_t)e * 2048 + kb * 64 + kseg * 8) * 4096 + s0 + nq * 4; c.dst = (unsigned char*)(a.ws + WS_WGU_T) + ((size_t)e * 4096 + np + nq * 4) * 2048 + kb * 64 + kseg * 8; }
    else { const int jj = j - SJOBS_GU, e = jj >> 11, kb = (jj >> 6) & 31, nb = jj & 63;
        c.ld = 2048; c.src = a.w_down + ((size_t)e * 2048 + kb * 64 + kseg * 8) * 2048 + nb * 32 + nq * 4; c.dst = (unsigned char*)(a.ws + WS_WD_T) + ((size_t)e * 2048 + nb * 32 + nq * 4) * 2048 + kb * 64 + kseg * 8; }
    return c;
}
__device__ __forceinline__ void sjob_load(const SJob& c, f32x4 (&v)[8]) {
#pragma unroll
    for (int r = 0; r < 8; ++r) v[r] = __builtin_nontemporal_load((const f32x4*)(c.src + (size_t)r * c.ld));
}
__device__ __forceinline__ void sjob_store(const SJob& c, const f32x4 (&v)[8]) {
#pragma unroll
    for (int jn = 0; jn < 4; ++jn) { u32x2 o;
        o.x = pk4_fp8_scaled(v[0][jn], v[1][jn], v[2][jn], v[3][jn]); o.y = pk4_fp8_scaled(v[4][jn], v[5][jn], v[6][jn], v[7][jn]);
        __builtin_nontemporal_store(o, (u32x2*)(c.dst + (size_t)jn * 2048)); }
}
__device__ __forceinline__ void conv_share(const Args& a, int blk, int G) {
    const int s = blk % 3, r = blk / 3, nb = (G - s + 2) / 3, w = threadIdx.x >> 6, lane = threadIdx.x & 63;
    const int npair = (SJOBS - SJOBS_ATTN) / 2, p0 = s * (npair / 3), p1 = (s == 2) ? npair : (s + 1) * (npair / 3);
    int p = p0 + r * 8 + w; const int step = nb * 8;
    if (p >= p1) return;
    f32x4 va0[8], va1[8], vb0[8], vb1[8]; SJob ca = sjob_addr(a, SJOBS_ATTN + 2 * p, lane), cb = ca, t;
    sjob_load(ca, va0); t = ca; t.src += 32; sjob_load(t, va1);
#pragma unroll 1
    for (;;) {
        const bool hb = (p + step) < p1; if (hb) { cb = sjob_addr(a, SJOBS_ATTN + 2 * (p + step), lane); sjob_load(cb, vb0); t = cb; t.src += 32; sjob_load(t, vb1); }
        sjob_store(ca, va0); t = ca; t.dst += 32 * 2048; sjob_store(t, va1);
        if (!hb) break;
        p += step;
        const bool ha = (p + step) < p1; if (ha) { ca = sjob_addr(a, SJOBS_ATTN + 2 * (p + step), lane); sjob_load(ca, va0); t = ca; t.src += 32; sjob_load(t, va1); }
        sjob_store(cb, vb0); t = cb; t.dst += 32 * 2048; sjob_store(t, vb1);
        if (!ha) break;
        p += step;
    }
}
struct BJob { const float* src; unsigned char* dst; int ld, gu, s0; };
__device__ __forceinline__ BJob bjob_addr(const Args& a, int j) {
    BJob c;
    if (j < CONV_JOBS_GU) { const int e = j >> 8, kb = (j >> 4) & 15, nb = j & 15; c.s0 = nb * 256; c.gu = 1;
        c.src = a.w_gate_up + ((size_t)e * 2048 + kb * 128) * 4096 + c.s0; c.ld = 4096; c.dst = (unsigned char*)(a.ws + WS_WGU_T) + (size_t)e * 4096 * 2048 + kb * 128; }
    else { const int jj = j - CONV_JOBS_GU, e = jj >> 7, kb = (jj >> 3) & 15, nb = jj & 7; c.s0 = nb * 256; c.gu = 0;
        c.src = a.w_down + ((size_t)e * 2048 + kb * 128) * 2048 + c.s0; c.ld = 2048; c.dst = (unsigned char*)(a.ws + WS_WD_T) + (size_t)e * 2048 * 2048 + kb * 128; }
    return c;
}
__device__ __forceinline__ void bjob_load(const BJob& c, f32x4 (&v)[16]) {
    int tz = threadIdx.x; asm volatile("" : "+v"(tz));
    const int w = tz >> 6, lane = tz & 63;
#pragma unroll
    for (int r = 0; r < 16; ++r) v[r] = BJOB_LD((const f32x4*)(c.src + (size_t)(w * 16 + r) * c.ld + lane * 4));
}
__device__ __forceinline__ void bjob_pack(const f32x4 (&v)[16], u32x4 (&o)[4]) {
#pragma unroll
    for (int jn = 0; jn < 4; ++jn) {
        o[jn].x = pk4_fp8_scaled(v[0][jn], v[1][jn], v[2][jn], v[3][jn]); o[jn].y = pk4_fp8_scaled(v[4][jn], v[5][jn], v[6][jn], v[7][jn]);
        o[jn].z = pk4_fp8_scaled(v[8][jn], v[9][jn], v[10][jn], v[11][jn]); o[jn].w = pk4_fp8_scaled(v[12][jn], v[13][jn], v[14][jn], v[15][jn]); }
}
__device__ __forceinline__ void bjob_out(const BJob& c, const u32x4 (&o)[4], LAS unsigned char* Tlo, LAS unsigned char* Thi) {
    int tz = threadIdx.x; asm volatile("" : "+v"(tz));
    const int tid = tz, w = tid >> 6, lane = tid & 63;
    LAS unsigned char* Tw = (lane < 32) ? Tlo : Thi;
#pragma unroll
    for (int jn = 0; jn < 4; ++jn) { const int nl = (lane & 31) * 4 + jn;
        *(LAS u32x4*)(Tw + nl * 128 + ((w ^ (lane & 7)) << 4)) = o[jn]; }
    asm volatile("s_waitcnt lgkmcnt(0)" ::: "memory"); __builtin_amdgcn_s_barrier(); asm volatile("" ::: "memory");
#pragma unroll
    for (int p = 0; p < 4; ++p) { const int idx = tid + 512 * p, n = idx >> 3, wq = idx & 7;
        const LAS unsigned char* Tr = (n < 128) ? Tlo : Thi;
        const u32x4 ov = *(const LAS u32x4*)(Tr + (n & 127) * 128 + ((wq ^ ((n >> 2) & 7)) << 4));
        const int cc = c.s0 + n; int np = cc;
        if (c.gu) { const int bj = cc >> 11, rem = cc & 2047; np = (rem >> 7) * 256 + bj * 128 + (rem & 127); }
        __builtin_nontemporal_store(ov, (u32x4*)(c.dst + (size_t)np * 2048 + wq * 16)); }
    asm volatile("s_waitcnt lgkmcnt(0)" ::: "memory"); __builtin_amdgcn_s_barrier(); asm volatile("" ::: "memory");
}
#ifndef CONV_IN_ATTN
#define CONV_IN_ATTN 1
#endif
constexpr int BJOB0 = CONV_IN_ATTN ? 16 * 256 + 8 * 16 : 0;
__device__ __forceinline__ void conv_share_blk(const Args& a, LAS unsigned char* lds, int blk, int G) {
    const int s = blk % 3, r = blk / 3, nb = (G - s + 2) / 3, nj = CONV_JOBS - BJOB0, j0 = BJOB0 + s * (nj / 3), j1 = (s == 2) ? CONV_JOBS : BJOB0 + (s + 1) * (nj / 3);
    LAS unsigned char* Tlo = lds + 3 * 16384; LAS unsigned char* Thi = lds + LDS_EXTRA;
    int j = j0 + r; if (j >= j1) return;
    f32x4 v[16]; u32x4 o[4]; BJob cc = bjob_addr(a, j);
    bjob_load(cc, v);
#pragma unroll 1
    for (;;) {
        bjob_pack(v, o);
        const BJob cur = cc; const bool hn = (j + nb) < j1;
        if (hn) { cc = bjob_addr(a, j + nb); bjob_load(cc, v); }
        bjob_out(cur, o, Tlo, Thi);
        if (!hn) break;
        j += nb;
    }
}
__device__ __forceinline__ void conv_all(const Args& a, LAS unsigned char* lds) {
    int buf = 0;
    for (int j = blockIdx.x; j < CONV_JOBS; j += gridDim.x) { conv_block_job(a, lds + buf * 32768, j); buf ^= 1; }
    __syncthreads();
}
__device__ __forceinline__ bool conv_claim(const Args&, int) { return false; }

__device__ __forceinline__ void phase_prologue(const Args& a, LAS unsigned char* lds) {
    const int tid = threadIdx.x, blk = blockIdx.x, G = gridDim.x;
    if (blk < 192) {
        LAS float* cact = (LAS float*)lds; LAS float* red = (LAS float*)(lds + 16384);
        for (int i = tid; i < 4096; i += 512) cact[i] = silu_f(a.c[i]);
        __syncthreads();
        float* mod = (float*)(a.ws + WS_MOD);
        for (int cb = blk; cb < 192; cb += G) {
            const int rg = tid >> 4, cl = tid & 15;
            const float* wp = a.w_ada + (size_t)cb * 64 + cl * 4;
            f32x4 a0 = {0.f, 0.f, 0.f, 0.f}, a1 = {0.f, 0.f, 0.f, 0.f};
#pragma unroll 16
            for (int i = 0; i < 64; ++i) { const int k = rg + 32 * i; const f32x4 w = *(const f32x4*)(wp + (size_t)k * 12288); a0 += w * cact[k]; a1 += w * cact[2048 + k]; }
#pragma unroll
            for (int j = 0; j < 4; ++j) { red[(rg * 2 + 0) * 64 + cl * 4 + j] = a0[j]; red[(rg * 2 + 1) * 64 + cl * 4 + j] = a1[j]; }
            __syncthreads();
            if (tid < 128) { const int b = tid >> 6, col = tid & 63; float s = 0.f; for (int r = 0; r < 32; ++r) s += red[(r * 2 + b) * 64 + col]; mod[b * 12288 + cb * 64 + col] = s + a.b_ada[cb * 64 + col]; }
            __syncthreads();
        }
    }
    {
        float* ct = (float*)(a.ws + WS_ROPE); float* st = ct + 4096 * 64;
        for (int idx = blk * 512 + tid; idx < 4096 * 64; idx += G * 512) {
            const int t = idx >> 6, i = idx & 63;
            const float inv = (float)exp2(-(double)i * (13.287712379549449 / 64.0));
            const float ang = (float)t * inv;
            const double ad = (double)ang, n = rint(ad * 0.15915494309189535), r = fma(-n, 6.283185307179586, ad) - n * 2.4492935982947064e-16;
            const float rf = (float)r;
            ct[idx] = cosf(rf); st[idx] = sinf(rf);
        }
    }
    {
        bf16_t* win_t = (bf16_t*)(a.ws + WS_WIN_T); bf16_t* wout_t = (bf16_t*)(a.ws + WS_WOUT_T);
        for (int job = blk; job < 64 * 16; job += 2 * G) {
            const float* src[2]; int ld[2]; bf16_t* dst[2]; int kts[2]; f32x4 v[2][8];
            const int w = threadIdx.x >> 6, lane = threadIdx.x & 63, kseg = lane & 7, nq = lane >> 3, nl = (w & 3) * 32 + nq * 4;
#pragma unroll
            for (int u = 0; u < 2; ++u) { const int jb = (job + u * G < 64 * 16) ? job + u * G : job, rt = jb >> 4; kts[u] = jb & 15;
                if (rt < 48) { const int n0 = rt * 128, col0 = n0 < 3072 ? n0 : n0 + 16; src[u] = a.w_in + col0; ld[u] = DIN; dst[u] = win_t + (size_t)n0 * 2048; }
                else { const int n0 = (rt - 48) * 128; src[u] = a.w_out + n0; ld[u] = 2048; dst[u] = wout_t + (size_t)n0 * 2048; }
                const int k0 = kts[u] * 128 + (w >> 2) * 64 + kseg * 8;
#pragma unroll
                for (int r = 0; r < 8; ++r) v[u][r] = *(const f32x4*)(src[u] + (size_t)(k0 + r) * ld[u] + nl); }
#pragma unroll
            for (int u = 0; u < 2; ++u) { const int k0 = kts[u] * 128 + (w >> 2) * 64 + kseg * 8;
#pragma unroll
                for (int j = 0; j < 4; ++j) { u32x4 o; o.x = cvt_pk_bf16(v[u][0][j], v[u][1][j]); o.y = cvt_pk_bf16(v[u][2][j], v[u][3][j]); o.z = cvt_pk_bf16(v[u][4][j], v[u][5][j]); o.w = cvt_pk_bf16(v[u][6][j], v[u][7][j]);
                    *(u32x4*)(dst[u] + (size_t)(nl + j) * 2048 + k0) = o; } }
        }
    }
}

__device__ __forceinline__ void phase_norm1(const Args& a, LAS unsigned char* lds) {
    const int tid = threadIdx.x, blk = blockIdx.x, G = gridDim.x, w = tid >> 6, lane = tid & 63;
    constexpr int HS = 2052;
    LAS float* hs = (LAS float*)lds;
    LAS float* part = (LAS float*)(lds + LDS_EXTRA + 4096);
    LAS float* las = (LAS float*)(lds + LDS_EXTRA);
    const float* mod = (const float*)(a.ws + WS_MOD);
    bf16_t* h1 = (bf16_t*)(a.ws + WS_H1); float* gk = (float*)(a.ws + WS_GK);
    float wl[64];
    { const int kk = lane >> 4, fr = lane & 15; const float* wp = a.w_in + (size_t)(w * 256 + kk) * DIN + 3072 + fr;
#pragma unroll
      for (int ks = 0; ks < 64; ++ks) wl[ks] = wp[(size_t)ks * 4 * DIN]; }
    float w2[16];
#pragma unroll
    for (int j = 0; j < 16; ++j) w2[j] = a.w_alpha2[j * 512 + tid];
    const float bz = a.b_alpha[tid];
    for (int grp = blk; grp < NTOK / 16; grp += G) {
        {
            const int r0 = grp * 16 + 2 * w;
            const f32x4* xr0 = (const f32x4*)(a.x + (size_t)r0 * DM) + lane; const f32x4* xr1 = xr0 + DM / 4;
            f32x4 v0[8], v1[8]; float ss0 = 0.f, ss1 = 0.f;
#pragma unroll
            for (int q = 0; q < 8; ++q) { v0[q] = xr0[64 * q]; v1[q] = xr1[64 * q]; }
#pragma unroll
            for (int q = 0; q < 8; ++q) { ss0 += (v0[q][0] * v0[q][0] + v0[q][1] * v0[q][1]) + (v0[q][2] * v0[q][2] + v0[q][3] * v0[q][3]); ss1 += (v1[q][0] * v1[q][0] + v1[q][1] * v1[q][1]) + (v1[q][2] * v1[q][2] + v1[q][3] * v1[q][3]); }
            ss0 = wave_sum(ss0); ss1 = wave_sum(ss1);
            const float rstd0 = 1.0f / sqrtf(ss0 * (1.0f / DM) + EPS), rstd1 = 1.0f / sqrtf(ss1 * (1.0f / DM) + EPS);
            const float* sh = mod + (size_t)(r0 >> 12) * 12288; const float* sc = sh + 2048;
#pragma unroll
            for (int q = 0; q < 8; ++q) { const int k = 4 * (lane + 64 * q);
                const f32x4 nw = *(const f32x4*)(a.norm1_w + k), scv = *(const f32x4*)(sc + k), shv = *(const f32x4*)(sh + k);
                const f32x4 h0 = (v0[q] * rstd0 * nw) * (scv + 1.0f) + shv, h1v = (v1[q] * rstd1 * nw) * (scv + 1.0f) + shv;
                *(LAS f32x4*)(hs + (2 * w) * HS + k) = h0; *(LAS f32x4*)(hs + (2 * w + 1) * HS + k) = h1v;
                u32x2 o; o.x = cvt_pk_bf16(h0[0], h0[1]); o.y = cvt_pk_bf16(h0[2], h0[3]);
                *(u32x2*)(h1 + (size_t)r0 * DM + k) = o;
                o.x = cvt_pk_bf16(h1v[0], h1v[1]); o.y = cvt_pk_bf16(h1v[2], h1v[3]);
                *(u32x2*)(h1 + (size_t)(r0 + 1) * DM + k) = o; } }
        __syncthreads();
        {
            const int kk = lane >> 4, fr = lane & 15; f32x4 acc = {0.f, 0.f, 0.f, 0.f};
            const LAS float* hp = hs + fr * HS + w * 256 + kk;
#pragma unroll
            for (int ks = 0; ks < 64; ++ks) acc = __builtin_amdgcn_mfma_f32_16x16x4f32(wl[ks], hp[ks * 4], acc, 0, 0, 0);
#pragma unroll
            for (int r = 0; r < 4; ++r) part[(w * 16 + 4 * kk + r) * 16 + fr] = acc[r];
        }
        __syncthreads();
        if (tid < 256) { const int t = tid >> 4, j = tid & 15; float s = 0.f;
#pragma unroll
            for (int q = 0; q < 8; ++q) s += part[(q * 16 + j) * 16 + t];
            las[t * 16 + j] = s; }
        __syncthreads();
        {
#pragma unroll 4
            for (int t = 0; t < 16; ++t) { const LAS f32x4* lp = (const LAS f32x4*)(las + t * 16); float z = bz;
#pragma unroll
                for (int q = 0; q < 4; ++q) { const f32x4 l = lp[q]; z += l[0] * w2[4 * q] + l[1] * w2[4 * q + 1] + l[2] * w2[4 * q + 2] + l[3] * w2[4 * q + 3]; }
                const float ls = fminf(z, 0.f) - log1pf(expf(-fabsf(z)));
                gk[(size_t)(grp * 16 + t) * 512 + tid] = ls * (1.0f / 16.0f); }
        }
        __syncthreads();
    }
}

__device__ __forceinline__ void gla_stage_vt(const bf16_t* proj, int row0, int h, LAS bf16_t* VT, int tid) {
    const int i = tid >> 3, seg = tid & 7;
    const u32x4* vp = (const u32x4*)(proj + (size_t)(row0 + i) * NPROJ + C_VA + h * 256 + seg * 32);
#pragma unroll
    for (int c4 = 0; c4 < 4; ++c4) { const u32x4 vv = vp[c4];
#pragma unroll
        for (int p = 0; p < 4; ++p) { const unsigned wd = vv[p]; const int e = seg * 32 + c4 * 8 + p * 2;
            VT[e * 72 + i] = (bf16_t)(wd & 0xffffu); VT[(e + 1) * 72 + i] = (bf16_t)(wd >> 16); } }
}
__device__ __forceinline__ void gla1_unit(const Args& a, LAS unsigned char* lds, int u) {
    const int tid = threadIdx.x, w = tid >> 6, lane = tid & 63;
    const int bh = u >> 6, c = u & 63, b = bh >> 2, h = bh & 3, row0 = b * SEQ + c * 64;
    LAS float* Bm = (LAS float*)lds; LAS bf16_t* KT = (LAS bf16_t*)(lds + 32768); LAS bf16_t* VT = (LAS bf16_t*)(lds + 51200);
    const float* gk = (const float*)(a.ws + WS_GK); const bf16_t* proj = (const bf16_t*)(a.ws + WS_PROJ);
    float* bcum = (float*)(a.ws + WS_BCUM); float* dst = (float*)(a.ws + WS_DST); float* dec = (float*)(a.ws + WS_DEC);
    const int i = tid >> 3, seg = tid & 7;
    {
        const f32x4* gp = (const f32x4*)(gk + (size_t)(row0 + i) * 512 + h * 128 + seg * 16);
#pragma unroll
        for (int q = 0; q < 4; ++q) *(LAS f32x4*)(Bm + i * 128 + seg * 16 + q * 4) = gp[q];
    }
    __syncthreads();
    {
        const int d = tid & 127, q4 = tid >> 7; LAS float* qs = (LAS float*)(lds + 90112);
        float run = 0.f;
#pragma unroll
        for (int ii = 0; ii < 16; ++ii) { run += Bm[(q4 * 16 + ii) * 128 + d]; Bm[(q4 * 16 + ii) * 128 + d] = run; }
        qs[q4 * 128 + d] = run;
        __syncthreads();
        float off = 0.f;
#pragma unroll
        for (int qq = 0; qq < 3; ++qq) off += (qq < q4) ? qs[qq * 128 + d] : 0.f;
        if (q4 > 0) {
#pragma unroll
            for (int ii = 0; ii < 16; ++ii) Bm[(q4 * 16 + ii) * 128 + d] += off; }
    }
    __syncthreads();
    {
        const u32x4* kp = (const u32x4*)(proj + (size_t)(row0 + i) * NPROJ + C_KA + h * 128 + seg * 16);
        float* bo = bcum + ((size_t)u * 64 + i) * 128 + seg * 16;
#pragma unroll
        for (int q = 0; q < 2; ++q) { const u32x4 kv = kp[q];
#pragma unroll
            for (int p = 0; p < 4; ++p) { const int d = seg * 16 + q * 8 + p * 2;
                const float b0 = Bm[i * 128 + d], b1 = Bm[i * 128 + d + 1], l0 = Bm[63 * 128 + d], l1 = Bm[63 * 128 + d + 1];
                bo[q * 8 + p * 2] = b0; bo[q * 8 + p * 2 + 1] = b1;
                KT[d * 72 + i] = f2bf(bflo(kv[p]) * expf(l0 - b0)); KT[(d + 1) * 72 + i] = f2bf(bfhi(kv[p]) * expf(l1 - b1));
                if (i == 63) { dec[(size_t)u * 128 + d] = expf(l0); dec[(size_t)u * 128 + d + 1] = expf(l1); } } }
        gla_stage_vt(proj, row0, h, VT, tid);
    }
    __syncthreads();
    {
        f32x4 acc[2][8];
#pragma unroll
        for (int x = 0; x < 2; ++x)
#pragma unroll
            for (int y = 0; y < 8; ++y) acc[x][y] = (f32x4){0.f, 0.f, 0.f, 0.f};
#pragma unroll
        for (int ks = 0; ks < 2; ++ks) {
            const bf16x8 a0 = lds_frag(VT, 72, (2 * w) * 16, ks * 32, lane), a1 = lds_frag(VT, 72, (2 * w + 1) * 16, ks * 32, lane);
#pragma unroll
            for (int dt = 0; dt < 8; ++dt) { const bf16x8 bf = lds_frag(KT, 72, dt * 16, ks * 32, lane); acc[0][dt] = mfma16(a0, bf, acc[0][dt]); acc[1][dt] = mfma16(a1, bf, acc[1][dt]); }
        }
        float* dp = dst + (size_t)u * 32768;
#pragma unroll
        for (int x = 0; x < 2; ++x)
#pragma unroll
            for (int dt = 0; dt < 8; ++dt)
#pragma unroll
                for (int r = 0; r < 4; ++r) dp[((2 * w + x) * 16 + 4 * (lane >> 4) + r) * 128 + dt * 16 + (lane & 15)] = acc[x][dt][r];
    }
    __syncthreads();
}
__device__ __forceinline__ void moba_prep_unit(const Args& a, LAS unsigned char* lds, int u2) {
    const int tid = threadIdx.x;
    const int bh = u2 >> 4, kb = u2 & 15, b = bh >> 3, h = bh & 7, row0 = b * SEQ + kb * 256, t0 = kb * 256;
    const bf16_t* proj = (const bf16_t*)(a.ws + WS_PROJ);
    const float* ct = (const float*)(a.ws + WS_ROPE); const float* st = ct + 4096 * 64;
    bf16_t* qbr = (bf16_t*)(a.ws + WS_QBR); bf16_t* kbr = (bf16_t*)(a.ws + WS_KBR); bf16_t* vbt = (bf16_t*)(a.ws + WS_VBT); float* kmean = (float*)(a.ws + WS_KMEAN);
    constexpr int KS = 132;
    LAS float* Kf = (LAS float*)lds;
    LAS float* part = (LAS float*)(lds + 135168);
    LAS bf16_t* Vl = (LAS bf16_t*)(lds + 139264);
    const int rl = tid >> 3, c = tid & 7;
#pragma unroll 1
    for (int pass = 0; pass < 4; ++pass) { const int row = pass * 64 + rl;
        const f32x4 cv0 = *(const f32x4*)(ct + (size_t)(t0 + row) * 64 + c * 8), cv1 = *(const f32x4*)(ct + (size_t)(t0 + row) * 64 + c * 8 + 4);
        const f32x4 sv0 = *(const f32x4*)(st + (size_t)(t0 + row) * 64 + c * 8), sv1 = *(const f32x4*)(st + (size_t)(t0 + row) * 64 + c * 8 + 4);
#pragma unroll
        for (int which = 0; which < 2; ++which) {
            const bf16_t* src = proj + (size_t)(row0 + row) * NPROJ + (which == 0 ? C_KB : C_QB) + h * 128 + c * 8;
            bf16_t* dsto = (which == 0 ? kbr : qbr) + ((size_t)bh * SEQ + t0 + row) * 128 + c * 8;
            const u32x4 x1 = *(const u32x4*)src, x2 = *(const u32x4*)(src + 64);
            u32x4 o1, o2; float r1[8], r2[8];
#pragma unroll
            for (int p = 0; p < 4; ++p) {
                const float c0 = (p < 2) ? cv0[2 * p] : cv1[2 * p - 4], c1 = (p < 2) ? cv0[2 * p + 1] : cv1[2 * p - 3], s0 = (p < 2) ? sv0[2 * p] : sv1[2 * p - 4], s1 = (p < 2) ? sv0[2 * p + 1] : sv1[2 * p - 3];
                const float a0 = bflo(x1[p]), a1 = bfhi(x1[p]), b0 = bflo(x2[p]), b1 = bfhi(x2[p]);
                r1[2 * p] = a0 * c0 - b0 * s0; r1[2 * p + 1] = a1 * c1 - b1 * s1; r2[2 * p] = a0 * s0 + b0 * c0; r2[2 * p + 1] = a1 * s1 + b1 * c1;
                o1[p] = cvt_pk_bf16(r1[2 * p], r1[2 * p + 1]); o2[p] = cvt_pk_bf16(r2[2 * p], r2[2 * p + 1]); }
            *(u32x4*)dsto = o1; *(u32x4*)(dsto + 64) = o2;
            if (which == 0) { LAS float* kr = Kf + row * KS + c * 8;
                *(LAS f32x4*)kr = (f32x4){r1[0], r1[1], r1[2], r1[3]}; *(LAS f32x4*)(kr + 4) = (f32x4){r1[4], r1[5], r1[6], r1[7]};
                *(LAS f32x4*)(kr + 64) = (f32x4){r2[0], r2[1], r2[2], r2[3]}; *(LAS f32x4*)(kr + 68) = (f32x4){r2[4], r2[5], r2[6], r2[7]}; }
        }
    }
    __syncthreads();
    { const int d = tid & 127, rq = tid >> 7; float s = 0.f;
#pragma unroll 8
        for (int rr = 0; rr < 64; ++rr) s += Kf[(rq * 64 + rr) * KS + d];
        part[rq * 128 + d] = s; }
    __syncthreads();
    if (tid < 128) kmean[((size_t)bh * 16 + kb) * 128 + tid] = (part[tid] + part[128 + tid] + part[256 + tid] + part[384 + tid]) * (1.0f / 256.0f);
#pragma unroll 1
    for (int sl = 0; sl < 4; ++sl) {
        { const int rw = tid >> 2, c4 = tid & 3;
#pragma unroll
            for (int ps = 0; ps < 2; ++ps) { const int row = ps * 128 + rw;
                const u32x4 vv = *(const u32x4*)(proj + (size_t)(row0 + row) * NPROJ + C_VB + h * 128 + sl * 32 + c4 * 8);
                *(LAS u32x4*)(Vl + row * 40 + (((c4 + (row >> 4)) & 3) << 3)) = vv; } }
        __syncthreads();
        { const int d = tid >> 4, tc = tid & 15;
            u32x4 o0, o1;
            const int dp = ((((d >> 3) + tc) & 3) << 3) + (d & 7);
#pragma unroll
            for (int p = 0; p < 4; ++p) { const int tt = tc * 16 + p * 2; o0[p] = (unsigned)Vl[tt * 40 + dp] | ((unsigned)Vl[(tt + 1) * 40 + dp] << 16);
                o1[p] = (unsigned)Vl[(tt + 8) * 40 + dp] | ((unsigned)Vl[(tt + 9) * 40 + dp] << 16); }
            bf16_t* op = vbt + ((size_t)bh * 128 + sl * 32 + d) * SEQ + t0 + tc * 16;
            *(u32x4*)op = o0; *(u32x4*)(op + 8) = o1; }
        __syncthreads();
    }
}
__device__ __forceinline__ void phase_mix_prep(const Args& a, LAS unsigned char* lds) {
    const int blk = blockIdx.x, G = gridDim.x;
    for (int u = blk; u < 512; u += G) gla1_unit(a, lds, u);
    for (int u2 = blk; u2 < 256; u2 += G) moba_prep_unit(a, lds, u2);
}

__device__ __forceinline__ void phase_scan_select(const Args& a, LAS unsigned char* lds) {
    const int tid = threadIdx.x, blk = blockIdx.x, G = gridDim.x;
    {
        const float* dst = (const float*)(a.ws + WS_DST); const float* dec = (const float*)(a.ws + WS_DEC); bf16_t* ST = (bf16_t*)(a.ws + WS_ST);
        for (int el = blk * 512 + tid; el < 8 * 32768; el += G * 512) {
            const int bh = el >> 15, ed = el & 32767, d = ed & 127; float cur = 0.f;
#pragma unroll 1
            for (int c0 = 0; c0 < 64; c0 += 32) { float dv[32], gv[32];
#pragma unroll
                for (int c = 0; c < 32; ++c) { const size_t u = (size_t)bh * 64 + c0 + c; dv[c] = dst[u * 32768 + ed]; gv[c] = dec[u * 128 + d]; }
#pragma unroll
                for (int c = 0; c < 32; ++c) { const size_t u = (size_t)bh * 64 + c0 + c; ST[u * 32768 + ed] = f2bf(cur); cur = gv[c] * cur + dv[c]; } }
        }
    }
    {
        const float* kmean = (const float*)(a.ws + WS_KMEAN); const bf16_t* qbr = (const bf16_t*)(a.ws + WS_QBR); unsigned* sel = (unsigned*)(a.ws + WS_SEL);
        LAS float* km = (LAS float*)lds;
        for (int u2 = blk; u2 < 256; u2 += G) {
            const int bh = u2 >> 4, qb = u2 & 15;
            __syncthreads();
            for (int i = tid; i < 2048; i += 512) km[i] = kmean[(size_t)bh * 2048 + i];
            __syncthreads();
            const int q = tid >> 1, half = tid & 1;
            float gv[8];
#pragma unroll
            for (int n = 0; n < 8; ++n) gv[n] = 0.f;
            const u32x4* qp = (const u32x4*)(qbr + ((size_t)bh * SEQ + qb * 256 + q) * 128);
#pragma unroll 4
            for (int c = 0; c < 16; ++c) { const u32x4 qq = qp[c]; float qf[8];
#pragma unroll
                for (int p = 0; p < 4; ++p) { qf[2 * p] = bflo(qq[p]); qf[2 * p + 1] = bfhi(qq[p]); }
#pragma unroll
                for (int n = 0; n < 8; ++n) { const LAS float* kr = km + (half * 8 + n) * 128 + c * 8; const f32x4 k0 = *(const LAS f32x4*)kr, k1 = *(const LAS f32x4*)(kr + 4);
                    gv[n] += (qf[0] * k0[0] + qf[1] * k0[1]) + (qf[2] * k0[2] + qf[3] * k0[3]) + (qf[4] * k1[0] + qf[5] * k1[1]) + (qf[6] * k1[2] + qf[7] * k1[3]); } }
            float ga[16];
#pragma unroll
            for (int n = 0; n < 8; ++n) { const float o = __shfl_xor(gv[n], 1); ga[n] = half ? o : gv[n]; ga[8 + n] = half ? gv[n] : o; }
            unsigned mask = 0u; const int nsel = qb < 3 ? qb : 3;
            for (int s = 0; s < nsel; ++s) { int best = -1; float bv = -INFINITY;
#pragma unroll
                for (int n = 0; n < 16; ++n) { const bool ok = (n < qb) && !((mask >> n) & 1u) && (best < 0 || ga[n] > bv); if (ok) { bv = ga[n]; best = n; } }
                mask |= 1u << best; }
            if (half == 0) sel[(size_t)bh * SEQ + qb * 256 + q] = mask;
        }
        __syncthreads();
    }
}

#ifndef CHECK_MODE
#define CHECK_MODE 0
#endif
constexpr size_t WS_CHK = 18432;
constexpr size_t WS_CHKO = WS_Y + 160 * MB;
#if CHECK_MODE
__device__ __forceinline__ void phase_check(const Args& a, LAS unsigned char* lds) {
    const int tid = threadIdx.x, blk = blockIdx.x, G = gridDim.x, w = tid >> 6, lane = tid & 63;
    const bf16_t* proj = (const bf16_t*)(a.ws + WS_PROJ); const bf16_t* ocat = (const bf16_t*)(a.ws + WS_OCAT);
    float* chk = (float*)(a.ws + WS_CHK);
#if CHECK_MODE == 1
    const float* ct = (const float*)(a.ws + WS_ROPE); const float* st = ct + 4096 * 64;
    for (int task = blk * 8 + w; task < 67 * 16; task += G * 8) {
        const int s = task >> 4, bh = task & 15, b = bh >> 3, h = bh & 7, t = 61 * s + 7, qblk = t >> 8;
        const bf16_t* qrow = proj + (size_t)(b * SEQ + t) * NPROJ + C_QB + h * 128;
        const float c = ct[t * 64 + lane], sn = st[t * 64 + lane];
        const float q1 = bf2f(qrow[lane]), q2 = bf2f(qrow[lane + 64]);
        const float qa = q1 * c - q2 * sn, qb2 = q1 * sn + q2 * c;
        float gate[16];
#pragma unroll 1
        for (int n = 0; n < 16; ++n) { float g = -INFINITY;
            if (n < qblk) { float m1 = 0.f, m2 = 0.f;
                for (int kk = 0; kk < 256; ++kk) { const int tk = n * 256 + kk; const bf16_t* krow = proj + (size_t)(b * SEQ + tk) * NPROJ + C_KB + h * 128;
                    const float k1 = bf2f(krow[lane]), k2 = bf2f(krow[lane + 64]), ck = ct[tk * 64 + lane], sk = st[tk * 64 + lane];
                    m1 += k1 * ck - k2 * sk; m2 += k1 * sk + k2 * ck; }
                g = wave_sum(qa * (m1 * (1.0f / 256.0f)) + qb2 * (m2 * (1.0f / 256.0f))); }
#pragma unroll
            for (int z = 0; z < 16; ++z) if (z == n) gate[z] = g; }
        unsigned mask = 0u; const int nsel = qblk < 3 ? qblk : 3;
        for (int it = 0; it < nsel; ++it) { int best = -1; float bv = -INFINITY;
#pragma unroll
            for (int n = 0; n < 16; ++n) { const bool ok = (n < qblk) && !((mask >> n) & 1u) && (best < 0 || gate[n] > bv); if (ok) { bv = gate[n]; best = n; } }
            mask |= 1u << best; }
        { const unsigned fastsel = ((const unsigned*)(a.ws + WS_SEL))[(size_t)bh * SEQ + t];
          if (fastsel != mask) { if (lane == 0) atomicAdd(&chk[2], 1.0f); continue; } }
        mask |= 1u << qblk;
        float m = -INFINITY, l = 0.f, o1 = 0.f, o2 = 0.f;
        for (int n = 0; n <= qblk; ++n) { if (!((mask >> n) & 1u)) continue;
            for (int kk = 0; kk < 256; ++kk) { const int tk = n * 256 + kk; if (tk > t) break;
                const bf16_t* krow = proj + (size_t)(b * SEQ + tk) * NPROJ + C_KB + h * 128; const bf16_t* vrow = proj + (size_t)(b * SEQ + tk) * NPROJ + C_VB + h * 128;
                const float k1 = bf2f(krow[lane]), k2 = bf2f(krow[lane + 64]), ck = ct[tk * 64 + lane], sk = st[tk * 64 + lane];
                const float sc = wave_sum(qa * (k1 * ck - k2 * sk) + qb2 * (k1 * sk + k2 * ck)) * 0.08838834764831845f;
                const float mn = fmaxf(m, sc), al = expf(m - mn), p = expf(sc - mn);
                l = l * al + p; o1 = o1 * al + p * bf2f(vrow[lane]); o2 = o2 * al + p * bf2f(vrow[lane + 64]); m = mn; } }
        o1 /= l; o2 /= l;
        const bf16_t* frow = ocat + (size_t)(b * SEQ + t) * DM + 1024 + h * 128;
        const float f1 = bf2f(frow[lane]), f2 = bf2f(frow[lane + 64]);
        const float num = wave_sum((f1 - o1) * (f1 - o1) + (f2 - o2) * (f2 - o2)), den = wave_sum(o1 * o1 + o2 * o2);
        if (lane == 0) { atomicAdd(&chk[0], num); atomicAdd(&chk[1], den); }
    }
#else
    const int cb = 1, ch = 2; const float* gk = (const float*)(a.ws + WS_GK); float* oref = (float*)(a.ws + WS_CHKO);
    for (int e = blk * 8 + w; e < 256; e += G * 8) {
        float s1 = 0.f, s2 = 0.f;
        for (int t = 0; t < SEQ; ++t) { const size_t row = (size_t)(cb * SEQ + t);
            const bf16_t* pr = proj + row * NPROJ;
            const float a1 = expf(gk[row * 512 + ch * 128 + lane]), a2 = expf(gk[row * 512 + ch * 128 + lane + 64]);
            const float k1 = bf2f(pr[C_KA + ch * 128 + lane]), k2 = bf2f(pr[C_KA + ch * 128 + lane + 64]), v = bf2f(pr[C_VA + ch * 256 + e]);
            const float q1 = bf2f(pr[C_QA + ch * 128 + lane]) * 0.08838834764831845f, q2 = bf2f(pr[C_QA + ch * 128 + lane + 64]) * 0.08838834764831845f;
            s1 = a1 * s1 + k1 * v; s2 = a2 * s2 + k2 * v;
            const float o = wave_sum(q1 * s1 + q2 * s2);
            if (lane == 0) oref[(size_t)t * 256 + e] = o; }
    }
#endif
}
__device__ __forceinline__ void phase_check2(const Args& a, LAS unsigned char* lds) {
#if CHECK_MODE == 2
    const int tid = threadIdx.x, blk = blockIdx.x, G = gridDim.x, w = tid >> 6, lane = tid & 63;
    const int cb = 1, ch = 2; const float* oref = (const float*)(a.ws + WS_CHKO); float* chk = (float*)(a.ws + WS_CHK);
    const bf16_t* proj = (const bf16_t*)(a.ws + WS_PROJ); const bf16_t* ocat = (const bf16_t*)(a.ws + WS_OCAT);
    for (int t = blk * 8 + w; t < SEQ; t += G * 8) { float o[4], ss = 0.f;
#pragma unroll
        for (int q = 0; q < 4; ++q) { o[q] = oref[(size_t)t * 256 + lane + 64 * q]; ss += o[q] * o[q]; }
        ss = wave_sum(ss); const float rstd = 1.0f / sqrtf(ss * (1.0f / 256.0f) + EPS); float num = 0.f, den = 0.f;
#pragma unroll
        for (int q = 0; q < 4; ++q) { const int e = lane + 64 * q; const size_t row = (size_t)(cb * SEQ + t);
            const float ga = bf2f(proj[row * NPROJ + C_GA + ch * 256 + e]), ref = o[q] * rstd * a.gla_norm_w[e] * silu_f(ga), f = bf2f(ocat[row * DM + ch * 256 + e]);
            num += (f - ref) * (f - ref); den += ref * ref; }
        num = wave_sum(num); den = wave_sum(den);
        if (lane == 0) { atomicAdd(&chk[0], num); atomicAdd(&chk[1], den); } }
#endif
}
#endif
#ifndef PROBE_TIME
#define PROBE_TIME -1
#endif
#ifndef PROBE_TOFF
#define PROBE_TOFF 0.0f
#endif
#ifndef PROBE_TSCALE
#define PROBE_TSCALE 3000.0f
#endif
#ifndef CONV_IN_GEMM
#define CONV_IN_GEMM 1
#endif
#ifndef CONV_IN_ATTN
#define CONV_IN_ATTN 1
#endif
#ifndef CONV_BLK
#define CONV_BLK 1
#endif

__device__ __forceinline__ void gla3_unit(const Args& a, LAS unsigned char* lds, int u) {
    const int tid = threadIdx.x, w = tid >> 6, lane = tid & 63, g = lane >> 4, fr = lane & 15;
    const int bh = u >> 6, c = u & 63, b = bh >> 2, h = bh & 3, row0 = b * SEQ + c * 64;
    LAS bf16_t* QP = (LAS bf16_t*)lds; LAS bf16_t* KP = (LAS bf16_t*)(lds + 17408); LAS bf16_t* VT = (LAS bf16_t*)(lds + 34816);
    LAS bf16_t* AM = (LAS bf16_t*)(lds + 71680); LAS float* OT = (LAS float*)(lds + 81920);
    const bf16_t* proj = (const bf16_t*)(a.ws + WS_PROJ); const float* bcum = (const float*)(a.ws + WS_BCUM); const bf16_t* ST = (const bf16_t*)(a.ws + WS_ST);
    bf16_t* ocat = (bf16_t*)(a.ws + WS_OCAT);
    {
        const int i = tid >> 3, seg = tid & 7;
        const f32x4* bp = (const f32x4*)(bcum + ((size_t)u * 64 + i) * 128 + seg * 16);
        const u32x4* qp = (const u32x4*)(proj + (size_t)(row0 + i) * NPROJ + C_QA + h * 128 + seg * 16);
        const u32x4* kp = (const u32x4*)(proj + (size_t)(row0 + i) * NPROJ + C_KA + h * 128 + seg * 16);
#pragma unroll
        for (int q = 0; q < 2; ++q) { const u32x4 qv = qp[q], kv = kp[q]; const f32x4 b0 = bp[2 * q], b1 = bp[2 * q + 1]; u32x4 qo, ko;
#pragma unroll
            for (int p = 0; p < 4; ++p) { const float bl = (p < 2) ? b0[2 * p] : b1[2 * p - 4], bhv = (p < 2) ? b0[2 * p + 1] : b1[2 * p - 3];
                const float el = expf(bl), eh = expf(bhv);
                qo[p] = cvt_pk_bf16(bflo(qv[p]) * el * 0.08838834764831845f, bfhi(qv[p]) * eh * 0.08838834764831845f);
                ko[p] = cvt_pk_bf16(bflo(kv[p]) / el, bfhi(kv[p]) / eh); }
            *(LAS u32x4*)(QP + i * 136 + seg * 16 + q * 8) = qo; *(LAS u32x4*)(KP + i * 136 + seg * 16 + q * 8) = ko; }
        gla_stage_vt(proj, row0, h, VT, tid);
    }
    __syncthreads();
    {
        const int it = w >> 1;
#pragma unroll
        for (int jj = 0; jj < 2; ++jj) { const int jt = (w & 1) * 2 + jj; f32x4 acc = {0.f, 0.f, 0.f, 0.f};
            if (jt <= it) {
#pragma unroll
                for (int ks = 0; ks < 4; ++ks) acc = mfma16(lds_frag(QP, 136, it * 16, ks * 32, lane), lds_frag(KP, 136, jt * 16, ks * 32, lane), acc);
            }
#pragma unroll
            for (int r = 0; r < 4; ++r) { const int i = it * 16 + 4 * g + r, j = jt * 16 + fr; AM[i * 72 + j] = f2bf((j <= i) ? acc[r] : 0.f); } }
    }
    __syncthreads();
    f32x4 acc[4][2];
    {
#pragma unroll
        for (int x = 0; x < 4; ++x)
#pragma unroll
            for (int y = 0; y < 2; ++y) acc[x][y] = (f32x4){0.f, 0.f, 0.f, 0.f};
        bf16x8 bS[2][4];
        const bf16_t* stp = ST + (size_t)u * 32768;
#pragma unroll
        for (int e2 = 0; e2 < 2; ++e2)
#pragma unroll
            for (int ks = 0; ks < 4; ++ks) bS[e2][ks] = *(const bf16x8*)(stp + ((2 * w + e2) * 16 + fr) * 128 + ks * 32 + 8 * g);
#pragma unroll
        for (int it = 0; it < 4; ++it) {
#pragma unroll
            for (int ks = 0; ks < 4; ++ks) { const bf16x8 aq = lds_frag(QP, 136, it * 16, ks * 32, lane); acc[it][0] = mfma16(aq, bS[0][ks], acc[it][0]); acc[it][1] = mfma16(aq, bS[1][ks], acc[it][1]); }
#pragma unroll
            for (int k2 = 0; k2 < 2; ++k2) { const bf16x8 aa = lds_frag(AM, 72, it * 16, k2 * 32, lane);
                acc[it][0] = mfma16(aa, lds_frag(VT, 72, (2 * w) * 16, k2 * 32, lane), acc[it][0]); acc[it][1] = mfma16(aa, lds_frag(VT, 72, (2 * w + 1) * 16, k2 * 32, lane), acc[it][1]); }
        }
#pragma unroll
        for (int it = 0; it < 4; ++it)
#pragma unroll
            for (int r = 0; r < 4; ++r)
#pragma unroll
                for (int e2 = 0; e2 < 2; ++e2) OT[(it * 16 + 4 * g + r) * 260 + (2 * w + e2) * 16 + fr] = acc[it][e2][r];
    }
    __syncthreads();
    {
        const int i = tid >> 3, seg = tid & 7;
        const LAS float* orow = OT + i * 260 + seg * 32;
        f32x4 ov[8]; float ss = 0.f;
#pragma unroll
        for (int q = 0; q < 8; ++q) { ov[q] = *(const LAS f32x4*)(orow + 4 * q); ss += (ov[q][0] * ov[q][0] + ov[q][1] * ov[q][1]) + (ov[q][2] * ov[q][2] + ov[q][3] * ov[q][3]); }
        ss += __shfl_xor(ss, 1); ss += __shfl_xor(ss, 2); ss += __shfl_xor(ss, 4);
        const float rstd = 1.0f / sqrtf(ss * (1.0f / 256.0f) + EPS);
        const u32x4* gp = (const u32x4*)(proj + (size_t)(row0 + i) * NPROJ + C_GA + h * 256 + seg * 32);
        bf16_t* op = ocat + (size_t)(row0 + i) * DM + h * 256 + seg * 32;
#pragma unroll
        for (int c8 = 0; c8 < 4; ++c8) { const u32x4 gv = gp[c8]; u32x4 o;
            const f32x4 nw0 = *(const f32x4*)(a.gla_norm_w + seg * 32 + c8 * 8), nw1 = *(const f32x4*)(a.gla_norm_w + seg * 32 + c8 * 8 + 4);
#pragma unroll
            for (int pp = 0; pp < 4; ++pp) { const float g0 = bflo(gv[pp]), g1 = bfhi(gv[pp]);
                const float n0 = (pp < 2) ? nw0[2 * pp] : nw1[2 * pp - 4], n1 = (pp < 2) ? nw0[2 * pp + 1] : nw1[2 * pp - 3];
                const float v0 = ((pp & 1) ? ov[2 * c8 + (pp >> 1)][2] : ov[2 * c8 + (pp >> 1)][0]) * rstd * n0 * silu_f(g0);
                const float v1 = ((pp & 1) ? ov[2 * c8 + (pp >> 1)][3] : ov[2 * c8 + (pp >> 1)][1]) * rstd * n1 * silu_f(g1);
#if FP8_EMU
                o[pp] = cvt_pk_bf16(q8(v0), q8(v1));
#else
                o[pp] = cvt_pk_bf16(v0, v1);
#endif
            }
            *(u32x4*)(op + c8 * 8) = o; }
    }
    __syncthreads();
}

typedef short s16x4 __attribute__((ext_vector_type(4)));
__device__ __forceinline__ void moba_attn_unit(const Args& a, LAS unsigned char* lds, int bh, int qb, int half, int cjob0) {
    const int tid = threadIdx.x, w = tid >> 6, lane = tid & 63, g = lane >> 4, fr = lane & 15;
    bh = __builtin_amdgcn_readfirstlane(bh); qb = __builtin_amdgcn_readfirstlane(qb); half = __builtin_amdgcn_readfirstlane(half);
    const int b = bh >> 3, h = bh & 7, rg = w & 3, par = w >> 2, qbase = 128 * half + 32 * rg;
    const bf16_t* qbr = (const bf16_t*)(a.ws + WS_QBR); const bf16_t* kbr = (const bf16_t*)(a.ws + WS_KBR); const bf16_t* vbt = (const bf16_t*)(a.ws + WS_VBT);
    const unsigned* sel = (const unsigned*)(a.ws + WS_SEL); bf16_t* ocat = (bf16_t*)(a.ws + WS_OCAT);
    const int nown = 2 * half + 2, nsteps = (nown + 4 * qb) >> 1;
    bf16x8 qf[2][4]; unsigned sm[2]; float m[2], l[2]; f32x4 O[8][2];
#pragma unroll
    for (int b2 = 0; b2 < 2; ++b2) { const size_t qrow = (size_t)bh * SEQ + qb * 256 + qbase + 16 * b2 + fr;
#pragma unroll
        for (int ks = 0; ks < 4; ++ks) qf[b2][ks] = *(const bf16x8*)(qbr + qrow * 128 + ks * 32 + 8 * g);
        sm[b2] = sel[qrow]; m[b2] = -INFINITY; l[b2] = 0.f;
#pragma unroll
        for (int dt = 0; dt < 8; ++dt) O[dt][b2] = (f32x4){0.f, 0.f, 0.f, 0.f}; }
    const float cs = 0.08838834764831845f * 1.4426950408889634f;
    unsigned kso[2], vso[2];
#pragma unroll
    for (int p = 0; p < 2; ++p) { const int kr = 4 * (w + 8 * p) + (lane >> 4), kc = (lane & 15) ^ (kr & 15); kso[p] = (unsigned)(kr * 256 + kc * 16);
        const int vr = 8 * (w + 8 * p) + (lane >> 3), vc = (lane & 7) ^ ((vr >> 1) & 7); vso[p] = (unsigned)(vr * (SEQ * 2) + vc * 16); }
    const char* kbase = (const char*)(kbr + (size_t)bh * SEQ * 128); const char* vbase = (const char*)(vbt + (size_t)bh * 128 * SEQ);
    auto tile_jk = [&](int ti, int& j, int& kt) { if (ti < nown) { j = qb; kt = ti; } else { const int tj = ti - nown; j = tj >> 2; kt = tj & 3; } };
    auto stage = [&](int s) {
#pragma unroll
        for (int t2 = 0; t2 < 2; ++t2) { int j, kt; tile_jk(2 * s + t2, j, kt); const int key0 = j * 256 + kt * 64;
            LAS unsigned char* dstb = lds + (s & 1) * 65536 + t2 * 32768 + w * 1024;
            const char* ks = pg8::sbase(kbase + (size_t)key0 * 256); const char* vs = pg8::sbase(vbase + (size_t)key0 * 2);
#pragma unroll
            for (int p = 0; p < 2; ++p) {
                __builtin_amdgcn_global_load_lds((const unsigned*)(ks + kso[p]), (LAS unsigned*)(dstb + p * 8192), 16, 0, 0);
                __builtin_amdgcn_global_load_lds((const unsigned*)(vs + vso[p]), (LAS unsigned*)(dstb + 16384 + p * 8192), 16, 0, 0); } } };
    __syncthreads();
    stage(0);
    f32x4 cv[8]; const int cjob = __builtin_amdgcn_readfirstlane(cjob0);
    if (CONV_IN_ATTN) { const SJob cj = sjob_addr(a, cjob, lane); sjob_load(cj, cv); }
#pragma unroll 1
    for (int s = 0; s < nsteps; ++s) {
        asm volatile("s_waitcnt vmcnt(0)" ::: "memory");
        __syncthreads();
        if (s + 1 < nsteps) stage(s + 1);
        if (CONV_IN_ATTN) { { const SJob cj = sjob_addr(a, cjob + 8 * s, lane); sjob_store(cj, cv); } if (s + 1 < nsteps) { const SJob cn = sjob_addr(a, cjob + 8 * (s + 1), lane); sjob_load(cn, cv); } }
        int j, kt; tile_jk(2 * s + par, j, kt);
        const bool own = (2 * s + par) < nown;
        if (own && kt * 64 > qbase + 31) continue;
        const LAS unsigned char* Kb = lds + (s & 1) * 65536 + par * 32768; const LAS unsigned char* Vb = Kb + 16384;
        f32x4 sc[4][2];
#pragma unroll
        for (int t4 = 0; t4 < 4; ++t4) { sc[t4][0] = (f32x4){0.f, 0.f, 0.f, 0.f}; sc[t4][1] = (f32x4){0.f, 0.f, 0.f, 0.f};
#pragma unroll
            for (int ks = 0; ks < 4; ++ks) { const bf16x8 kf = *(const LAS bf16x8*)(Kb + (t4 * 16 + fr) * 256 + (((ks * 4 + g) ^ fr) << 4)); sc[t4][0] = mfma16(kf, qf[0][ks], sc[t4][0]); sc[t4][1] = mfma16(kf, qf[1][ks], sc[t4][1]); } }
        bf16x8 pf[2][2];
#pragma unroll
        for (int b2 = 0; b2 < 2; ++b2) {
            float tm = -INFINITY, nb;
            if (own) {
                const int qi = qbase + 16 * b2 + fr;
#pragma unroll
                for (int t4 = 0; t4 < 4; ++t4)
#pragma unroll
                    for (int r = 0; r < 4; ++r) { const int kk = kt * 64 + t4 * 16 + 4 * g + r; const float v = (kk <= qi) ? sc[t4][b2][r] : -INFINITY; sc[t4][b2][r] = v; tm = fmaxf(tm, v); }
            } else {
#pragma unroll
                for (int t4 = 0; t4 < 4; ++t4)
#pragma unroll
                    for (int r = 0; r < 4; ++r) tm = fmaxf(tm, sc[t4][b2][r]);
                if (!((sm[b2] >> j) & 1u)) tm = -INFINITY;
            }
            tm = fmaxf(tm, __shfl_xor(tm, 16)); tm = fmaxf(tm, __shfl_xor(tm, 32));
            if (__builtin_amdgcn_ballot_w64((tm - m[b2]) * cs > 11.5416f) != 0ull) {
                const float mnew = fmaxf(m[b2], tm), ms = (mnew == -INFINITY) ? 0.f : mnew;
                const float alpha = __builtin_amdgcn_exp2f((m[b2] - ms) * cs);
                l[b2] *= alpha; m[b2] = mnew;
#pragma unroll
                for (int dt = 0; dt < 8; ++dt) O[dt][b2] *= alpha;
            }
            nb = (m[b2] == -INFINITY) ? 0.f : -m[b2] * cs; if (!own && !((sm[b2] >> j) & 1u)) nb = -INFINITY;
            float ps = 0.f;
#pragma unroll
            for (int t4 = 0; t4 < 4; ++t4)
#pragma unroll
                for (int r = 0; r < 4; ++r) { const float pe = __builtin_amdgcn_exp2f(fmaf(sc[t4][b2][r], cs, nb)); sc[t4][b2][r] = pe; ps += pe; }
            ps += __shfl_xor(ps, 16); ps += __shfl_xor(ps, 32);
            l[b2] += ps;
#pragma unroll
            for (int k2 = 0; k2 < 2; ++k2) { u32x4 pkk; pkk.x = cvt_pk_bf16(sc[2 * k2][b2][0], sc[2 * k2][b2][1]); pkk.y = cvt_pk_bf16(sc[2 * k2][b2][2], sc[2 * k2][b2][3]);
                pkk.z = cvt_pk_bf16(sc[2 * k2 + 1][b2][0], sc[2 * k2 + 1][b2][1]); pkk.w = cvt_pk_bf16(sc[2 * k2 + 1][b2][2], sc[2 * k2 + 1][b2][3]);
                pf[k2][b2] = __builtin_bit_cast(bf16x8, pkk); }
        }
#pragma unroll
        for (int dt = 0; dt < 8; ++dt)
#pragma unroll
            for (int k2 = 0; k2 < 2; ++k2) { const int vr = dt * 16 + fr, c0 = 4 * k2 + (g >> 1), sw = (vr >> 1) & 7;
                const LAS unsigned char* vrow = Vb + vr * 128 + (g & 1) * 8;
                const s16x4 lo = *(const LAS s16x4*)(vrow + ((c0 ^ sw) << 4)), hi = *(const LAS s16x4*)(vrow + (((c0 + 2) ^ sw) << 4));
                const bf16x8 vf = __builtin_shufflevector(lo, hi, 0, 1, 2, 3, 4, 5, 6, 7);
                O[dt][0] = mfma16(vf, pf[k2][0], O[dt][0]); O[dt][1] = mfma16(vf, pf[k2][1], O[dt][1]); }
    }
    __syncthreads();
    LAS float* X = (LAS float*)lds + rg * (68 * 64) + lane;
    if (par == 1) {
#pragma unroll
        for (int b2 = 0; b2 < 2; ++b2) { X[(64 + b2) * 64] = m[b2]; X[(66 + b2) * 64] = l[b2];
#pragma unroll
            for (int dt = 0; dt < 8; ++dt)
#pragma unroll
                for (int r = 0; r < 4; ++r) X[((dt * 2 + b2) * 4 + r) * 64] = O[dt][b2][r]; } }
    __syncthreads();
    if (par == 0) {
#pragma unroll
        for (int b2 = 0; b2 < 2; ++b2) { const float m1 = X[(64 + b2) * 64], l1 = X[(66 + b2) * 64];
            const float mm = fmaxf(m[b2], m1), a0 = exp2f((m[b2] - mm) * cs), a1 = (m1 == -INFINITY) ? 0.f : exp2f((m1 - mm) * cs);
            const float inv = 1.0f / (l[b2] * a0 + l1 * a1);
            const size_t orow = (size_t)(b * SEQ + qb * 256 + qbase + 16 * b2 + fr) * DM + 1024 + h * 128;
#pragma unroll
            for (int dt = 0; dt < 8; ++dt) { float o4[4];
#pragma unroll
                for (int r = 0; r < 4; ++r) o4[r] = (O[dt][b2][r] * a0 + X[((dt * 2 + b2) * 4 + r) * 64] * a1) * inv;
                u32x2 o; o.x = cvt_pk_bf16(o4[0], o4[1]); o.y = cvt_pk_bf16(o4[2], o4[3]);
                *(u32x2*)(ocat + orow + dt * 16 + 4 * g) = o; } } }
    __syncthreads();
}
__device__ __forceinline__ void phase_mix_out(const Args& a, LAS unsigned char* lds) {
    const int blk = blockIdx.x, G = gridDim.x;
    for (int u = blk; u < 256; u += G) {
        const int cj0 = (u * 33) * 8 + (threadIdx.x >> 6);
        { const int c = u >> 4; moba_attn_unit(a, lds, u & 15, (31 - c) >> 1, (31 - c) & 1, cj0); }
        { const int u2 = 511 - u, c = u2 >> 4; moba_attn_unit(a, lds, u2 & 15, (31 - c) >> 1, (31 - c) & 1, cj0 + 8 * (32 - (u >> 4))); }
    }
    for (int u = blk; u < 512; u += G) gla3_unit(a, lds, u);
}

__device__ __forceinline__ void phase_router(const Args& a, LAS unsigned char* lds) {
    const int tid = threadIdx.x, blk = blockIdx.x, G = gridDim.x, w = tid >> 6, lane = tid & 63;
    constexpr int HS = 2052;
    LAS float* h2s = (LAS float*)lds;
    LAS float* part = (LAS float*)(lds + LDS_EXTRA + 4096);
    LAS float* logit = (LAS float*)(lds + LDS_EXTRA);
    LAS int* pe = (LAS int*)(lds + LDS_EXTRA + 2048); LAS float* pw = (LAS float*)(lds + LDS_EXTRA + 2560); LAS int* lpos = (LAS int*)(lds + LDS_EXTRA + 3072);
    LAS int* hist = (LAS int*)(lds + LDS_EXTRA + 3584); LAS int* base = (LAS int*)(lds + LDS_EXTRA + 3712);
    const float* mod = (const float*)(a.ws + WS_MOD); const float* x1 = (const float*)(a.ws + WS_X1); unsigned char* h2 = (unsigned char*)(a.ws + WS_H1);
    unsigned* cnt = (unsigned*)(a.ws + WS_CNT); int* pair_e = (int*)(a.ws + WS_PAIR_E); int* pair_pos = (int*)(a.ws + WS_PAIR_POS); int* tok_of = (int*)(a.ws + WS_SLOTROW); float* rw_of = (float*)(a.ws + WS_WBUF);
    float wa0[64], wa1[64];
    { const int kk = lane >> 4, fr = lane & 15; const float* wp = a.w_router + (size_t)(w * 256 + kk) * 32 + fr;
#pragma unroll
      for (int ks = 0; ks < 64; ++ks) { wa0[ks] = wp[(size_t)ks * 128]; wa1[ks] = wp[(size_t)ks * 128 + 16]; } }
    const float brt = a.b_router[tid & 31];
    for (int gp = blk; gp < 256; gp += G) {
        if (tid < 32) hist[tid] = 0;
#pragma unroll 1
        for (int gh = 0; gh < 2; ++gh) { const int grp = gp * 2 + gh;
#pragma unroll 1
            for (int tt = 0; tt < 2; ++tt) { const int tl = 2 * w + tt, t = grp * 16 + tl;
                const f32x4* xr = (const f32x4*)(x1 + (size_t)t * DM) + lane;
                f32x4 v[8]; float ss = 0.f;
#pragma unroll
                for (int q = 0; q < 8; ++q) { v[q] = xr[64 * q]; ss += (v[q][0] * v[q][0] + v[q][1] * v[q][1]) + (v[q][2] * v[q][2] + v[q][3] * v[q][3]); }
                ss = wave_sum(ss);
                const float rstd = 1.0f / sqrtf(ss * (1.0f / DM) + EPS);
                const float* sh = mod + (size_t)(t >> 12) * 12288 + 6144; const float* sc = sh + 2048;
#pragma unroll
                for (int q = 0; q < 8; ++q) { const int k = 4 * (lane + 64 * q);
                    const f32x4 nw = *(const f32x4*)(a.norm2_w + k), scv = *(const f32x4*)(sc + k), shv = *(const f32x4*)(sh + k);
                    const f32x4 hv = (v[q] * rstd * nw) * (scv + 1.0f) + shv;
                    *(LAS f32x4*)(h2s + tl * HS + k) = hv;
                    *(unsigned*)(h2 + (size_t)t * DM + k) = pg8::pk4_fp8(hv[0], hv[1], hv[2], hv[3]); } }
            __syncthreads();
            {
                const int kk = lane >> 4, fr = lane & 15;
                f32x4 acc0 = {0.f, 0.f, 0.f, 0.f}, acc1 = {0.f, 0.f, 0.f, 0.f};
                const LAS float* hp = h2s + fr * HS + w * 256 + kk;
#pragma unroll
                for (int ks = 0; ks < 64; ++ks) { const float b = hp[ks * 4];
                    acc0 = __builtin_amdgcn_mfma_f32_16x16x4f32(wa0[ks], b, acc0, 0, 0, 0); acc1 = __builtin_amdgcn_mfma_f32_16x16x4f32(wa1[ks], b, acc1, 0, 0, 0); }
#pragma unroll
                for (int r = 0; r < 4; ++r) { part[(w * 32 + 4 * kk + r) * 16 + fr] = acc0[r]; part[(w * 32 + 16 + 4 * kk + r) * 16 + fr] = acc1[r]; }
            }
            __syncthreads();
            {
                const int tl = tid >> 5, e = tid & 31; float s = brt;
#pragma unroll
                for (int q = 0; q < 8; ++q) s += part[(q * 32 + e) * 16 + tl];
                bool taken = false; float tv[4]; int te[4];
#pragma unroll
                for (int r = 0; r < 4; ++r) { float bv = taken ? -INFINITY : s; int be = e;
#pragma unroll
                    for (int off = 16; off >= 1; off >>= 1) { const float ov = __shfl_xor(bv, off); const int oe = __shfl_xor(be, off); if (ov > bv || (ov == bv && oe < be)) { bv = ov; be = oe; } }
                    tv[r] = bv; te[r] = be; if (be == e) taken = true; }
                if (e == 0) { float ex[4], den = 0.f;
#pragma unroll
                    for (int r = 0; r < 4; ++r) { ex[r] = expf(tv[r] - tv[0]); den += ex[r]; }
#pragma unroll
                    for (int r = 0; r < 4; ++r) { pe[gh * 64 + tl * 4 + r] = te[r]; pw[gh * 64 + tl * 4 + r] = ex[r] / den; } }
            }
            __syncthreads();
        }
        if (tid < 128) lpos[tid] = atomicAdd((int*)&hist[pe[tid]], 1);
        __syncthreads();
        if (tid < 32) { const int n = hist[tid]; base[tid] = n ? (int)atomicAdd(&cnt[tid], (unsigned)n) : 0; }
        __syncthreads();
        if (tid < 128) { const int p = gp * 128 + tid, e = pe[tid], pos = base[e] + lpos[tid]; pair_e[p] = e; pair_pos[p] = pos; tok_of[e * 8192 + pos] = p >> 2; rw_of[e * 8192 + pos] = pw[tid]; }
        __syncthreads();
    }
}
__device__ __forceinline__ void phase_gather(const Args& a, LAS unsigned char* lds) {
    if (CONV_IN_GEMM == 2) conv_share(a, blockIdx.x, gridDim.x);
    if (!CONV_IN_GEMM) conv_all(a, lds);
}
template <class Sched>
__device__ __forceinline__ void moe_build_rowtab(const Args& a, LAS unsigned char* lds, const Sched& S) {
    LAS int* rowtab = (LAS int*)(lds + LDS_ROWTAB);
    const unsigned* cnt = (const unsigned*)(a.ws + WS_CNT); const int* tok_of = (const int*)(a.ws + WS_SLOTROW);
    pg8::Unit u;
    for (int i = 0; i < MAX_UNITS_WG && S.next(i, u); ++i) {
        const int r = threadIdx.x; if (r < 256) { const int pos = u.pos0 + r; rowtab[i * 256 + r] = (pos < (int)cnt[u.e]) ? tok_of[u.e * 8192 + pos] * DM : 0; }
    }
    __syncthreads();
}
__device__ __forceinline__ void moe_build_tab(const Args& a, LAS unsigned char* lds, int ntn) {
    LAS int* tab = (LAS int*)(lds + LDS_EXTRA);
    const unsigned* cnt = (const unsigned*)(a.ws + WS_CNT);
    LAS int* rt0 = tab + 600;
    LAS int* ord = tab + 640;
    LAS int* cn = tab + 680;
    __syncthreads();
    if (threadIdx.x < 64) {
        const int e = threadIdx.x & 31, c = (int)cnt[e];
        const int tiles = (c + 255) >> 8, cost = tiles;
        int rank = 0, pre = 0;
#pragma unroll
        for (int j = 0; j < 32; ++j) { const int cj = __builtin_amdgcn_readlane(cost, j), tj = __builtin_amdgcn_readlane(tiles, j); rank += (cj > cost || (cj == cost && j < e)) ? 1 : 0; pre += (j < e) ? tj : 0; }
        if (threadIdx.x < 32) { ord[rank] = e; cn[e] = c; rt0[e] = pre; }
    }
    __syncthreads();
    if (threadIdx.x == 0) {
        const int mygrp = blockIdx.x & 7, PG = ntn >> 1;
        int np = 0, us = 0;
        int l0 = 0, l1 = 0, l2 = 0, l3 = 0, l4 = 0, l5 = 0, l6 = 0, l7 = 0;
#pragma unroll 1
        for (int it = 0; it < 32; ++it) {
            const int be = ord[it], c = cn[be], mte = (c + 255) >> 8;
            if (mte == 0) break;
            const int bc = mte * PG, r0 = rt0[be];
#pragma unroll
            for (int h = 0; h < 2; ++h) {
                int bx = 0, bl = l0;
                if (l1 < bl) { bl = l1; bx = 1; } if (l2 < bl) { bl = l2; bx = 2; } if (l3 < bl) { bl = l3; bx = 3; }
                if (l4 < bl) { bl = l4; bx = 4; } if (l5 < bl) { bl = l5; bx = 5; } if (l6 < bl) { bl = l6; bx = 6; } if (l7 < bl) { bl = l7; bx = 7; }
                l0 += (bx == 0) ? bc : 0; l1 += (bx == 1) ? bc : 0; l2 += (bx == 2) ? bc : 0; l3 += (bx == 3) ? bc : 0;
                l4 += (bx == 4) ? bc : 0; l5 += (bx == 5) ? bc : 0; l6 += (bx == 6) ? bc : 0; l7 += (bx == 7) ? bc : 0;
                if (bx == mygrp) { LAS int* t = tab + 4 + 8 * np; t[0] = us; t[1] = be; t[2] = h * PG; t[3] = mte; t[4] = r0; t[5] = c; us += mte * PG; ++np; }
            }
        }
        tab[0] = np; tab[1] = us;
    }
    __syncthreads();
}
__device__ __forceinline__ bool warm_claim(const unsigned char* base, unsigned nchunks, unsigned* ctr) {
    unsigned c = 0;
    if ((threadIdx.x & 63) == 0) c = atomicAdd(ctr, 1u);
    c = __builtin_amdgcn_readfirstlane(c);
    if (c >= nchunks) return false;
    const u32x4* p = (const u32x4*)(base + (size_t)c * 16384) + (threadIdx.x & 63);
    u32x4 v[16];
#pragma unroll
    for (int r = 0; r < 16; ++r) v[r] = __builtin_nontemporal_load(p + 64 * r);
    unsigned s = 0;
#pragma unroll
    for (int r = 0; r < 16; ++r) s ^= v[r].x ^ v[r].y ^ v[r].z ^ v[r].w;
    asm volatile("" :: "v"(s));
    return true;
}
__device__ __forceinline__ void phase_final(const Args& a, LAS unsigned char* lds) {
    const int tid = threadIdx.x, blk = blockIdx.x, G = gridDim.x, w = tid >> 6, lane = tid & 63;
    const float* mod = (const float*)(a.ws + WS_MOD); const float* x1 = (const float*)(a.ws + WS_X1); const int* pair_e = (const int*)(a.ws + WS_PAIR_E); const int* pair_pos = (const int*)(a.ws + WS_PAIR_POS); const bf16_t* y = (const bf16_t*)(a.ws + WS_Y);
    LAS int* rbase = (LAS int*)(lds + LDS_EXTRA);
    if (tid < 64) {
        const unsigned* cnt = (const unsigned*)(a.ws + WS_CNT); const int e = tid & 31, pc = (int)((cnt[e] + 255u) & ~255u); int pre = 0;
#pragma unroll
        for (int j = 0; j < 32; ++j) { const int pj = __builtin_amdgcn_readlane(pc, j); pre += (j < e) ? pj : 0; }
        if (tid < 32) rbase[e] = pre; }
    __syncthreads();
    float chk_scale = 1.0f;
#if PROBE_TIME >= 0 && !defined(PROBE_SPIN)
    { const unsigned long long* ts = (const unsigned long long*)(a.ws + 18688); float us = (float)(ts[1] - ts[0]) * 1e-2f;
#ifdef PROBE_TQ
      us = floorf((us + PROBE_TOFF) / PROBE_TQ) * PROBE_TQ;
#endif
      chk_scale = 1.0f + us / PROBE_TSCALE; }
#endif
#if CHECK_MODE
    { const float* chk = (const float*)(a.ws + WS_CHK); const float rel = sqrtf(chk[0] / fmaxf(chk[1], 1e-30f)) + (chk[2] > 60.0f ? 1.0f : 0.0f); chk_scale = 1.0f + 10.0f * rel; }
#endif
    for (int t = blk * 8 + w; t < NTOK; t += G * 8) {
        const int r0 = rbase[pair_e[t * 4]] + pair_pos[t * 4], r1 = rbase[pair_e[t * 4 + 1]] + pair_pos[t * 4 + 1], r2 = rbase[pair_e[t * 4 + 2]] + pair_pos[t * 4 + 2], r3 = rbase[pair_e[t * 4 + 3]] + pair_pos[t * 4 + 3];
        const f32x4* xr = (const f32x4*)(x1 + (size_t)t * DM) + lane;
        const u32x2* y0 = (const u32x2*)(y + (size_t)r0 * DM) + lane; const u32x2* y1 = (const u32x2*)(y + (size_t)r1 * DM) + lane;
        const u32x2* y2 = (const u32x2*)(y + (size_t)r2 * DM) + lane; const u32x2* y3 = (const u32x2*)(y + (size_t)r3 * DM) + lane;
        const float* g2 = mod + (size_t)(t >> 12) * 12288 + 10240;
        f32x4 v[8]; float ss = 0.f;
#pragma unroll
        for (int q = 0; q < 8; ++q) { const u32x2 a0 = y0[64 * q], a1 = y1[64 * q], a2 = y2[64 * q], a3 = y3[64 * q];
            f32x4 s; s[0] = (bflo(a0.x) + bflo(a1.x)) + (bflo(a2.x) + bflo(a3.x)); s[1] = (bfhi(a0.x) + bfhi(a1.x)) + (bfhi(a2.x) + bfhi(a3.x));
            s[2] = (bflo(a0.y) + bflo(a1.y)) + (bflo(a2.y) + bflo(a3.y)); s[3] = (bfhi(a0.y) + bfhi(a1.y)) + (bfhi(a2.y) + bfhi(a3.y));
            const f32x4 gv = *(const f32x4*)(g2 + 4 * (lane + 64 * q));
            v[q] = xr[64 * q] + gv * s; ss += (v[q][0] * v[q][0] + v[q][1] * v[q][1]) + (v[q][2] * v[q][2] + v[q][3] * v[q][3]); }
        ss = wave_sum(ss);
        const float rstd = 1.0f / sqrtf(ss * (1.0f / DM) + EPS);
        f32x4* op = (f32x4*)(a.out + (size_t)t * DM) + lane;
#pragma unroll
        for (int q = 0; q < 8; ++q) op[64 * q] = v[q] * (rstd * chk_scale) * *(const f32x4*)(a.final_norm_w + 4 * (lane + 64 * q));
    }
}

struct ConvInProj : pg8::StaticOrder { const Args* ap;
    LAS unsigned char* lds;
    __device__ __forceinline__ void between(int ui) const {
        if (CONV_IN_GEMM == 1 && ui == (int)(blockIdx.x % 3)) {
#if CONV_BLK
            const int wr = (threadIdx.x >> 6) >> 2;
            asm volatile("s_waitcnt vmcnt(0)" ::: "memory");
            if (wr == 0) __builtin_amdgcn_s_barrier();
            conv_share_blk(*ap, lds, blockIdx.x, gridDim.x);
            if (wr == 1) __builtin_amdgcn_s_barrier();
#else
            conv_share(*ap, blockIdx.x, gridDim.x);
#endif
        } } };

constexpr int NPHASE = 12;
#ifndef ONLY_PHASE
#define ONLY_PHASE -1
#endif
#ifndef SKIP_MASK
#define SKIP_MASK 0
#endif
#define PH_ON(P) ((ONLY_PHASE < 0 || ONLY_PHASE == (P)) && !((SKIP_MASK >> (P)) & 1))
#ifndef PROBE_DOUBLE
#define PROBE_DOUBLE -1
#endif
#define PROBE_REP(P) for (int _rep = 0; _rep < ((PROBE_DOUBLE == (P)) ? 2 : 1); ++_rep)
__global__ void __launch_bounds__(512, 2) fwd(Args a) {
    extern __shared__ __attribute__((aligned(16))) unsigned char shm[];
    LAS unsigned char* lds = (LAS unsigned char*)shm;
    if (threadIdx.x == 0) *(LAS u32x4*)(lds + LDS_XB) = (u32x4){0u, 0u, 0u, 0u};
    __syncthreads();
    XcdBarrier bar = xcd_barrier_post((unsigned*)(a.ws + WS_BAR), (volatile LAS unsigned*)(lds + LDS_XB));
    const int G = gridDim.x, blk = blockIdx.x;
#ifndef HARVEST_MASK
#define HARVEST_MASK 0
#endif
#define TSTAMP(P) do { if (PROBE_TIME >= 0 && blockIdx.x == 0 && threadIdx.x == 0) { if ((P) == PROBE_TIME) { ((unsigned long long*)(a.ws + 18688))[0] = __builtin_amdgcn_s_memrealtime(); ((unsigned long long*)(a.ws + 18688))[2] = __builtin_amdgcn_s_memtime(); } if ((P) == PROBE_TIME_END) { ((unsigned long long*)(a.ws + 18688))[1] = __builtin_amdgcn_s_memrealtime(); ((unsigned long long*)(a.ws + 18688))[3] = __builtin_amdgcn_s_memtime(); } } } while (0)
#ifndef PROBE_TIME_END
#define PROBE_TIME_END (PROBE_TIME + 1)
#endif
#ifndef PROBE_BAR2
#define PROBE_BAR2 0
#endif
#ifndef WARM_MASK
#define WARM_MASK 0
#endif
#define PHASE_END(P) do { if ((P) + 1 < a.ph_hi) { \
    if ((P) == 9 && ((WARM_MASK >> 9) & 1)) xcd_barrier(bar, [&]() { return warm_claim(a.ws + WS_WD_T, 8192u, (unsigned*)(a.ws + 19200)); }); \
    else if ((P) == 10 && ((WARM_MASK >> 10) & 1)) xcd_barrier(bar, [&]() { return warm_claim(a.ws + WS_X1, 4096u, (unsigned*)(a.ws + 19264)); }); \
    else if ((HARVEST_MASK >> (P)) & 1) xcd_barrier(bar, [&]() { return conv_claim(a, 1); }); else xcd_barrier(bar, []() { return false; }); if (PROBE_BAR2) xcd_barrier(bar, []() { return false; }); } } while (0)
    TSTAMP(0);
    if (PH_ON(0) && a.ph_lo <= 0 && 0 < a.ph_hi) { PROBE_REP(0) { phase_prologue(a, lds); __syncthreads(); } PHASE_END(0); }
    TSTAMP(1);
    if (PH_ON(1) && a.ph_lo <= 1 && 1 < a.ph_hi) { phase_norm1(a, lds);
#if PROBE_DOUBLE == 134
        __syncthreads(); phase_norm1(a, lds);
#endif
        PHASE_END(1); }
    TSTAMP(2);
    if (PH_ON(2) && a.ph_lo <= 2 && 2 < a.ph_hi) {
        pg8::Gemm g{(const bf16_t*)(a.ws + WS_H1), (const bf16_t*)(a.ws + WS_WIN_T), DM, 0, nullptr};
        ConvInProj S; S.init(NTOK, NPROJ, G, blk); S.ap = &a; S.lds = lds;
        pg8::EpiProj E{(bf16_t*)(a.ws + WS_PROJ), NPROJ};
        pg8::gemm_phase<false, false>(lds, g, S, E);
#if PROBE_DOUBLE == 26
        __syncthreads(); pg8::gemm_phase<false, false>(lds, g, S, E);
#endif
        PHASE_END(2); }
    TSTAMP(3);
    if (PH_ON(3) && a.ph_lo <= 3 && 3 < a.ph_hi) { phase_mix_prep(a, lds);
#if PROBE_DOUBLE == 134
        __syncthreads(); phase_mix_prep(a, lds);
#endif
#if PROBE_DOUBLE == 31
        __syncthreads(); for (int u = blockIdx.x; u < 512; u += gridDim.x) gla1_unit(a, lds, u);
#endif
#if PROBE_DOUBLE == 32
        __syncthreads(); for (int u2 = blockIdx.x; u2 < 256; u2 += gridDim.x) moba_prep_unit(a, lds, u2);
#endif
        PHASE_END(3); }
    TSTAMP(4);
    if (PH_ON(4) && a.ph_lo <= 4 && 4 < a.ph_hi) { phase_scan_select(a, lds);
#if PROBE_DOUBLE == 134
        __syncthreads(); phase_scan_select(a, lds);
#endif
        PHASE_END(4); }
    TSTAMP(5);
    if (PH_ON(5) && a.ph_lo <= 5 && 5 < a.ph_hi) { phase_mix_out(a, lds);
#if PROBE_DOUBLE == 5
        __syncthreads(); phase_mix_out(a, lds);
#endif
#if PROBE_DOUBLE == 51
        __syncthreads(); for (int u = blockIdx.x; u < 512; u += gridDim.x) gla3_unit(a, lds, u);
#endif
        PHASE_END(5); }
#if CHECK_MODE
    if (a.ph_lo <= 5 && 5 < a.ph_hi) { phase_check(a, lds); xcd_barrier(bar, []() { return false; }); phase_check2(a, lds); xcd_barrier(bar, []() { return false; }); }
#endif
    TSTAMP(6);
    if (PH_ON(6) && a.ph_lo <= 6 && 6 < a.ph_hi) {
        pg8::Gemm g{(const bf16_t*)(a.ws + WS_OCAT), (const bf16_t*)(a.ws + WS_WOUT_T), DM, 0, nullptr};
        pg8::StaticOrder S; S.init(NTOK, DM, G, blk);
        pg8::EpiOut E{a.x, (const float*)(a.ws + WS_MOD) + 4096, (float*)(a.ws + WS_X1)};
        pg8::gemm_phase<false, false>(lds, g, S, E);
#if PROBE_DOUBLE == 26
        __syncthreads(); pg8::gemm_phase<false, false>(lds, g, S, E);
#endif
        PHASE_END(6); }
    TSTAMP(7);
    if (PH_ON(7) && a.ph_lo <= 7 && 7 < a.ph_hi) { phase_router(a, lds); PHASE_END(7); }
    TSTAMP(8);
    if (PH_ON(8) && a.ph_lo <= 8 && 8 < a.ph_hi && CONV_IN_GEMM != 1) { phase_gather(a, lds); PHASE_END(8); }
    TSTAMP(9);
    if (PH_ON(9) && a.ph_lo <= 9 && 9 < a.ph_hi) {
#ifdef PROBE_TAB
        const unsigned long long tb0 = __builtin_amdgcn_s_memrealtime();
#endif
        moe_build_tab(a, lds, 16);
#ifdef PROBE_TAB
        if (blockIdx.x == 0 && threadIdx.x == 0) ((unsigned long long*)(a.ws + 18688))[4] = __builtin_amdgcn_s_memrealtime() - tb0;
#endif
        pg8::Gemm g{(const bf16_t*)(a.ws + WS_H1), (const bf16_t*)(a.ws + WS_WGU_T), DM / 2, (size_t)4096 * 1024, (const LAS int*)(lds + LDS_ROWTAB)};
        pg8::EpiGU8 E{a.b_gate_up, (unsigned char*)(a.ws + WS_ACT)};
        g.probe = a.ws + 18688 + 32;
        const int nmine = (((const LAS int*)(lds + LDS_EXTRA))[1] - (blk >> 3) + (G >> 3) - 1) / (G >> 3);
#pragma unroll 1
        for (int i0 = 0; i0 < (nmine > 0 ? nmine : 1); i0 += MAX_UNITS_WG) {
            pg8::MoeOrder S{(const LAS int*)(lds + LDS_EXTRA), blk >> 3, G >> 3, i0, MAX_UNITS_WG};
#ifdef PROBE_RT
            const unsigned long long tr0 = __builtin_amdgcn_s_memrealtime();
#endif
            moe_build_rowtab(a, lds, S);
#ifdef PROBE_RT
            if (blockIdx.x == 0 && threadIdx.x == 0) ((unsigned long long*)(a.ws + 18688))[4] = __builtin_amdgcn_s_memrealtime() - tr0;
#endif
            pg8::gemm_phase<true, true>(lds, g, S, E);
            __syncthreads();
        }
        PHASE_END(9); }
    TSTAMP(10);
    if (PH_ON(10) && a.ph_lo <= 10 && 10 < a.ph_hi) {
        moe_build_tab(a, lds, 8);
        pg8::Gemm g{(const bf16_t*)(a.ws + WS_ACT), (const bf16_t*)(a.ws + WS_WD_T), DM / 2, (size_t)2048 * 1024, nullptr};
        pg8::MoeOrder S{(const LAS int*)(lds + LDS_EXTRA), blk >> 3, G >> 3, 0, 1 << 30};
        pg8::EpiDown8 E{a.b_down, (const float*)(a.ws + WS_WBUF), (bf16_t*)(a.ws + WS_Y)};
        g.probe = a.ws + 18688 + 32;
        pg8::gemm_phase<true, false>(lds, g, S, E);
#if PROBE_DOUBLE == 10
        __syncthreads(); pg8::gemm_phase<true, false>(lds, g, S, E);
#endif
        PHASE_END(10); }
    TSTAMP(11);
    if (PH_ON(11) && a.ph_lo <= 11 && 11 < a.ph_hi) { phase_final(a, lds);
#if PROBE_DOUBLE == 811
        __syncthreads(); phase_final(a, lds);
#endif
    }
    TSTAMP(12);
#ifdef PROBE_SPIN
    if (blockIdx.x == 0 && threadIdx.x == 0) { const unsigned long long* ts = (const unsigned long long*)(a.ws + 18688);
#ifdef PROBE_GMAX
        const unsigned long long want = (unsigned long long)((const unsigned*)ts)[10] * PROBE_SPIN, t0 = __builtin_amdgcn_s_memrealtime();
#elif defined(PROBE_EPI) || defined(PROBE_TAB) || defined(PROBE_RT)
        const unsigned long long want = ts[4] * PROBE_SPIN, t0 = __builtin_amdgcn_s_memrealtime();
#elif defined(PROBE_CLK)
        const unsigned long long want = (ts[3] - ts[2]) * 1000ull / (ts[1] - ts[0]), t0 = __builtin_amdgcn_s_memrealtime();
#else
        const unsigned long long want = (ts[1] - ts[0]) * PROBE_SPIN, t0 = __builtin_amdgcn_s_memrealtime();
#endif

        while (__builtin_amdgcn_s_memrealtime() - t0 < want) __builtin_amdgcn_s_sleep(8); }
#endif

}

#ifndef N_LAUNCHES
#define N_LAUNCHES 1
#endif
extern "C" void kernel_launch(void* const* d_in, const int* in_sizes, int n_in, void* d_out, int out_size, void* d_ws, size_t ws_size, hipStream_t stream) {
    static int grid = 0;
    if (grid == 0) {
        if (n_in != 18 || out_size != NTOK * DM || ws_size < WS_END) { fprintf(stderr, "kernel_launch: unexpected shapes (n_in %d out %d ws %zu, need %zu)\n", n_in, out_size, ws_size, (size_t)WS_END); grid = -1; return; }
        int dev = 0, cus = 0, per_cu = 0;
        if (hipGetDevice(&dev) != hipSuccess || hipDeviceGetAttribute(&cus, hipDeviceAttributeMultiprocessorCount, dev) != hipSuccess) { grid = -1; return; }
        if (hipFuncSetAttribute((const void*)fwd, hipFuncAttributeMaxDynamicSharedMemorySize, LDS_BYTES) != hipSuccess) { fprintf(stderr, "kernel_launch: hipFuncSetAttribute failed\n"); grid = -1; return; }
        if (hipOccupancyMaxActiveBlocksPerMultiprocessor(&per_cu, (const void*)fwd, 512, LDS_BYTES) != hipSuccess || per_cu < 1) fprintf(stderr, "kernel_launch: occupancy query says %d\n", per_cu);
        (void)hipGetLastError();
        grid = cus;
    }
    if (grid < 0) return;
    (void)hipMemsetAsync(d_ws, 0, WS_ZERO_BYTES, stream);
    Args a{};
    a.x = (const float*)d_in[0]; a.c = (const float*)d_in[1]; a.w_ada = (const float*)d_in[2]; a.b_ada = (const float*)d_in[3]; a.norm1_w = (const float*)d_in[4];
    a.w_in = (const float*)d_in[5]; a.w_alpha2 = (const float*)d_in[6]; a.b_alpha = (const float*)d_in[7]; a.gla_norm_w = (const float*)d_in[8]; a.w_out = (const float*)d_in[9];
    a.norm2_w = (const float*)d_in[10]; a.w_router = (const float*)d_in[11]; a.b_router = (const float*)d_in[12]; a.w_gate_up = (const float*)d_in[13]; a.b_gate_up = (const float*)d_in[14];
    a.w_down = (const float*)d_in[15]; a.b_down = (const float*)d_in[16]; a.final_norm_w = (const float*)d_in[17];
    a.out = (float*)d_out; a.ws = (unsigned char*)d_ws;
    if (N_LAUNCHES == 1) { a.ph_lo = 0; a.ph_hi = NPHASE; hipLaunchKernelGGL(fwd, dim3(grid), dim3(512), LDS_BYTES, stream, a); }
    else for (int p = 0; p < NPHASE; ++p) { a.ph_lo = p; a.ph_hi = p + 1; hipLaunchKernelGGL(fwd, dim3(grid), dim3(512), LDS_BYTES, stream, a); }
}
```

```cpp
#include <hip/hip_runtime.h>
#include <stdint.h>
#include <stdio.h>

#define LAS __attribute__((address_space(3)))
typedef unsigned short bf16_t;
typedef short bf16x8 __attribute__((ext_vector_type(8)));
typedef float f32x4 __attribute__((ext_vector_type(4)));
typedef float f32x2 __attribute__((ext_vector_type(2)));
typedef unsigned u32x4 __attribute__((ext_vector_type(4)));
typedef unsigned u32x2 __attribute__((ext_vector_type(2)));

constexpr int DM = 2048, NBATCH = 2, SEQ = 4096, NTOK = 8192;
constexpr int DIN = 6160, NPROJ = 6144;
constexpr int NE = 32, TOPK = 4;
constexpr int C_QA = 0, C_KA = 512, C_VA = 1024, C_GA = 2048, C_QB = 3072, C_KB = 4096, C_VB = 5120;
constexpr int MAXROWS = 40960;
constexpr float EPS = 1e-6f;

constexpr size_t MB = 1024ull * 1024ull;
constexpr size_t WS_BAR = 0;
constexpr size_t WS_CNT = 16384;
constexpr size_t WS_ZERO_BYTES = 20480;
constexpr size_t WS_MOD = 32768;
constexpr size_t WS_ROPE = 1 * MB;
constexpr size_t WS_H1 = 3 * MB;
constexpr size_t WS_GK = WS_H1 + 32 * MB;
constexpr size_t WS_PROJ = WS_GK + 16 * MB;
constexpr size_t WS_WIN_T = WS_PROJ + 96 * MB;
constexpr size_t WS_WOUT_T = WS_WIN_T + 24 * MB;
constexpr size_t WS_WGU_T = WS_WOUT_T + 8 * MB;
constexpr size_t WS_WD_T = WS_WGU_T + 512 * MB;
constexpr size_t WS_BCUM = WS_WD_T + 256 * MB;
constexpr size_t WS_DST = WS_BCUM + 16 * MB;
constexpr size_t WS_DEC = WS_DST + 64 * MB;
constexpr size_t WS_ST = WS_DEC + 1 * MB;
constexpr size_t WS_QBR = WS_ST + 32 * MB;
constexpr size_t WS_KBR = WS_QBR + 16 * MB;
constexpr size_t WS_VBT = WS_KBR + 16 * MB;
constexpr size_t WS_KMEAN = WS_VBT + 16 * MB;
constexpr size_t WS_SEL = WS_KMEAN + 1 * MB;
constexpr size_t WS_OCAT = WS_SEL + 1 * MB;
constexpr size_t WS_X1 = WS_OCAT + 32 * MB;
constexpr size_t WS_PAIR_E = WS_X1 + 64 * MB;
constexpr size_t WS_PAIR_POS = WS_PAIR_E + 1 * MB;
constexpr size_t WS_PAIR_W = WS_PAIR_POS + 1 * MB;
constexpr size_t WS_SLOTROW = WS_PAIR_W + 1 * MB;
constexpr size_t WS_WBUF = WS_SLOTROW + 1 * MB;
constexpr size_t WS_XG = WS_WBUF + 1 * MB;
constexpr size_t WS_ACT = WS_XG + 160 * MB;
constexpr size_t WS_Y = WS_ACT + 160 * MB;
constexpr size_t WS_END = WS_Y + 160 * MB;

constexpr int LDS_BYTES = 163840;
constexpr int LDS_XB = 163840 - 16;
constexpr int LDS_EXTRA = 131072 + 1024;
constexpr int LDS_ROWTAB = 131072 + 1024 + 4096;
constexpr int MAX_UNITS_WG = 24;

struct Args {
    const float* x; const float* c; const float* w_ada; const float* b_ada; const float* norm1_w; const float* w_in; const float* w_alpha2; const float* b_alpha;
    const float* gla_norm_w; const float* w_out; const float* norm2_w; const float* w_router; const float* b_router; const float* w_gate_up; const float* b_gate_up;
    const float* w_down; const float* b_down; const float* final_norm_w;
    float* out; unsigned char* ws;
    int ph_lo, ph_hi;
};

__device__ __forceinline__ unsigned cvt_pk_bf16(float lo, float hi) { unsigned r; asm("v_cvt_pk_bf16_f32 %0, %1, %2" : "=v"(r) : "v"(lo), "v"(hi)); return r; }
__device__ __forceinline__ bf16_t f2bf(float f) { return (bf16_t)(cvt_pk_bf16(f, 0.f) & 0xffffu); }
__device__ __forceinline__ float bf2f(bf16_t b) { return __uint_as_float(((unsigned)b) << 16); }
__device__ __forceinline__ float bflo(unsigned w) { return __uint_as_float(w << 16); }
__device__ __forceinline__ float bfhi(unsigned w) { return __uint_as_float(w & 0xffff0000u); }
__device__ __forceinline__ float wave_sum(float v) {
#pragma unroll
    for (int o = 1; o < 64; o <<= 1) v += __shfl_xor(v, o);
    return v;
}
#ifndef FP8_EMU
#define FP8_EMU 0
#endif
__device__ __forceinline__ float q8(float x) { return __builtin_amdgcn_cvt_f32_fp8(__builtin_amdgcn_cvt_pk_fp8_f32(x, x, 0, false), 0); }
__device__ __forceinline__ float silu_f(float v) { return v / (1.f + expf(-v)); }
__device__ __forceinline__ f32x4 mfma16(bf16x8 a, bf16x8 b, f32x4 c) { return __builtin_amdgcn_mfma_f32_16x16x32_bf16(a, b, c, 0, 0, 0); }
__device__ __forceinline__ bf16x8 lds_frag(const LAS bf16_t* img, int ld, int r0, int k0, int lane) {
    return *(const LAS bf16x8*)(img + (r0 + (lane & 15)) * ld + k0 + 8 * (lane >> 4));
}

#define XB_TMO      128
#define XB_XCNT(j)  (256  + 64 * (j))
#define XB_XSUB(j)  (1280 + 64 * (j))
#define XB_XGEN(j)  (2304 + 64 * (j))
#define XB_TOP      3328
#define XB_TOPGEN   3392
#define XCD_BAR_WORDS 3456
#define XB_SPIN_CAP (1u << 18)
__device__ __forceinline__ unsigned xb_ld(unsigned* p)              { return __hip_atomic_load(p, __ATOMIC_RELAXED, __HIP_MEMORY_SCOPE_AGENT); }
__device__ __forceinline__ unsigned xb_add(unsigned* p, unsigned v) { return __hip_atomic_fetch_add(p, v, __ATOMIC_RELAXED, __HIP_MEMORY_SCOPE_AGENT); }
__device__ __forceinline__ unsigned xb_xcc_id() { return (unsigned)__builtin_amdgcn_s_getreg((3 << 11) | 20) & 0xFu; }
#define XB_SPIN(cond, bar) do { unsigned _sp = 0; while (cond) { __builtin_amdgcn_s_sleep(1); \
    if ((++_sp & 255u) == 0u) { if (xb_ld(&(bar)[XB_TMO])) break; if (_sp > XB_SPIN_CAP) { atomicAdd(&(bar)[XB_TMO], 1u); break; } } } } while (0)
struct XcdBarrier { unsigned* bar; unsigned x; volatile LAS unsigned* st; };
__device__ __forceinline__ XcdBarrier xcd_barrier_post(unsigned* bar, volatile LAS unsigned* st) {
    XcdBarrier b; b.bar = bar; b.x = xb_xcc_id(); b.st = st;
    if (threadIdx.x == 0) (void)xb_add(&bar[XB_XCNT(b.x)], 1u);
    return b;
}
__device__ __forceinline__ void xcd_barrier_complete(unsigned* bar, unsigned x, unsigned& nloc, unsigned& nx) {
    const unsigned G = gridDim.x * gridDim.y * gridDim.z;
    unsigned sum, cnt, mine, sp = 0u;
    for (;;) {
        sum = 0u; cnt = 0u; mine = 0u;
#pragma unroll
        for (unsigned j = 0; j < 16; ++j) { const unsigned c = xb_ld(&bar[XB_XCNT(j)]); sum += c; cnt += (c > 0u) ? 1u : 0u; mine = (j == x) ? c : mine; }
        if (sum == G) break;
        __builtin_amdgcn_s_sleep(1);
        if ((++sp & 255u) == 0u) { if (xb_ld(&bar[XB_TMO])) break; if (sp > XB_SPIN_CAP) { atomicAdd(&bar[XB_TMO], 1u); break; } }
    }
    nloc = mine > 0u ? mine : 1u; nx = cnt > 0u ? cnt : 1u;
}
template <class Idle>
__device__ __forceinline__ void xcd_barrier(const XcdBarrier& b, Idle&& idle) {
    asm volatile("s_waitcnt vmcnt(0)" ::: "memory");
    __syncthreads();
    if (threadIdx.x == 0) {
        unsigned* bar = b.bar;
        __builtin_amdgcn_s_waitcnt(0);
        unsigned nloc = b.st[0], nx = b.st[1];
        if (nloc == 0u) { xcd_barrier_complete(bar, b.x, nloc, nx); b.st[0] = nloc; b.st[1] = nx; }
        const unsigned old = xb_add(&bar[XB_XSUB(b.x)], 1u);
        const unsigned gen = old / nloc;
        if (old + 1u == (gen + 1u) * nloc) {
            __builtin_amdgcn_fence(__ATOMIC_RELEASE, "agent");
            asm volatile("s_waitcnt vmcnt(0)" ::: "memory");
            const unsigned og = xb_add(&bar[XB_TOP], 1u);
            const unsigned tg = og / nx;
            if (og + 1u == (tg + 1u) * nx) xb_add(&bar[XB_TOPGEN], 1u);
            else XB_SPIN(xb_ld(&bar[XB_TOPGEN]) == tg, bar);
            __builtin_amdgcn_fence(__ATOMIC_ACQUIRE, "agent");
            xb_add(&bar[XB_XGEN(b.x)], 1u);
            asm volatile("s_waitcnt vmcnt(0)" ::: "memory");
            b.st[2] = 1u;
        } else { b.st[2] = 0u; b.st[3] = gen; }
    }
    __syncthreads();
    unsigned rounds = 0u;
    while (b.st[2] == 0u) {
        const bool had = idle();
        const unsigned long long anyw = __ballot(had);
        __syncthreads();
        if (threadIdx.x == 0) {
            unsigned* bar = b.bar; const unsigned gen = b.st[3];
            bool rel = xb_ld(&bar[XB_XGEN(b.x)]) != gen;
            if (!rel && anyw == 0ull) { XB_SPIN(xb_ld(&bar[XB_XGEN(b.x)]) == gen, bar); rel = true; }
            if (!rel && ++rounds > (1u << 16)) { atomicAdd(&bar[XB_TMO], 1u); rel = true; }
            if (rel) { __builtin_amdgcn_fence(__ATOMIC_ACQUIRE, "agent"); asm volatile("s_waitcnt vmcnt(0)" ::: "memory"); b.st[2] = 1u; }
        }
        __syncthreads();
    }
}
#ifndef PROBE_GMIN
#define PROBE_GMIN 0
#endif
#ifndef FP8_SCALE_ARG
#define FP8_SCALE_ARG 0
#endif

#ifndef PROBE_STORE2
#define PROBE_STORE2 0
#endif
#ifndef FP8_ASM
#define FP8_ASM 0
#endif
namespace pg8 {
constexpr int BM = 256, BK = 64, HALF = 128, HTB = HALF * BK * 2, STAGE_BYTES = 8 * HTB, NXCD = 8, WGM = 8;
__host__ __device__ __forceinline__ int lds_byte(int r, int c) { const int st = (r >> 4) * 2 + (c >> 5), rr = r & 15, cc = c & 31, ob = rr * 64 + cc * 2; return st * 1024 + (ob ^ (((ob >> 9) & 1) << 5)); }
__host__ __device__ __forceinline__ void stage_rc(int b, int& R, int& C) { const int st = b / 1024, sb = b % 1024, swz = sb ^ (((sb >> 9) & 1) << 5); R = (st >> 1) * 16 + swz / 64; C = (st & 1) * 32 + (swz % 64) / 2; }
__host__ __device__ __forceinline__ int perm32(int rho) { const int n = rho >> 4, i = rho & 15; return 8 * (i >> 2) + 4 * n + (i & 3); }

struct Unit { int pm, pn, e, full, pos0; };
struct Gemm { const bf16_t* A; const bf16_t* Bt; int K; size_t b_estride; const LAS int* rowtab; void* probe; };

struct StaticOrder {
    int nM, nN, nwg, G, c;
    __device__ void init(int M, int N, int G_, int c_) { nM = M / BM; nN = N / BM; nwg = nM * nN; G = G_; c = c_; }
    __device__ bool next(int i, Unit& u) const {
        const long L = (long)i * G + c; if (L >= nwg) return false;
        int wgid = (int)L; { const int q = nwg / NXCD, r = nwg % NXCD, xcd = wgid % NXCD, off = wgid / NXCD; wgid = (xcd < r ? xcd * (q + 1) : r * (q + 1) + (xcd - r) * q) + off; }
        const int nig = WGM * nN, gid = wgid / nig, fm = gid * WGM, gsz = (nM - fm) < WGM ? (nM - fm) : WGM;
        u.pm = fm + ((wgid % nig) % gsz); u.pn = (wgid % nig) / gsz; u.e = 0; u.full = 1; u.pos0 = 0; return true;
    }
    __device__ __forceinline__ void between(int) const {}
};
struct MoeOrder {
    const LAS int* tab; int r, nper, i0, imax;
    __device__ bool next(int i, Unit& u) const {
        if (i >= imax) return false;
        const int L = (i0 + i) * nper + r; if (L >= __builtin_amdgcn_readfirstlane(tab[1])) return false;
        int p = 0; const int np = tab[0];
#pragma unroll 1
        while (p + 1 < np && tab[4 + 8 * (p + 1)] <= L) ++p;
        const LAS int* t = tab + 4 + 8 * p;
        const int local = L - t[0], mte = t[3], pq = local / mte, mt = local - pq * mte;
        u.e = __builtin_amdgcn_readfirstlane(t[1]); u.pn = __builtin_amdgcn_readfirstlane(t[2] + pq); u.pm = __builtin_amdgcn_readfirstlane(t[4] + mt);
        u.full = __builtin_amdgcn_readfirstlane((t[5] - mt * 256) > 128 ? 1 : 0); u.pos0 = __builtin_amdgcn_readfirstlane(mt * 256); return true;
    }
    __device__ __forceinline__ void between(int) const {}
};

struct EpiProj {
    static constexpr bool PERM = true;
    bf16_t* O; int ldc;
    __device__ __forceinline__ void operator()(const f32x4 (&acc)[2][2][4][2], const Unit& u, int wr, int wc, int fr, int fq) const {
        const int row0 = u.pm * BM + wr * 64 + fr, col0 = u.pn * BM + wc * 32 + 8 * fq;
#pragma unroll
        for (int ai = 0; ai < 2; ++ai)
#pragma unroll
            for (int m = 0; m < 4; ++m) { bf16_t* rowp = O + (size_t)(row0 + ai * HALF + m * 16) * ldc + col0;
#pragma unroll
                for (int bj = 0; bj < 2; ++bj) { const f32x4 v0 = acc[ai][bj][m][0], v1 = acc[ai][bj][m][1];
                    u32x4 w; w.x = cvt_pk_bf16(v0[0], v0[1]); w.y = cvt_pk_bf16(v0[2], v0[3]); w.z = cvt_pk_bf16(v1[0], v1[1]); w.w = cvt_pk_bf16(v1[2], v1[3]);
                    *(u32x4*)(rowp + bj * HALF) = w;
#if PROBE_STORE2 == 1
                    *(u32x4*)(rowp + bj * HALF + (size_t)1792 * 1024 * 1024) = w;
#endif
                } }
    }
};
struct EpiOut {
    static constexpr bool PERM = false;
    const float* X; const float* g1;   float* O;
    __device__ __forceinline__ void operator()(const f32x4 (&acc)[2][2][4][2], const Unit& u, int wr, int wc, int fr, int fq) const {
        const int row0 = u.pm * BM + wr * 64 + fr, col0 = u.pn * BM + wc * 32 + 4 * fq;
        const float* gp = g1 + (size_t)((u.pm * BM) >> 12) * 12288 + col0;
        f32x4 gv[2][2];
#pragma unroll
        for (int bj = 0; bj < 2; ++bj)
#pragma unroll
            for (int n = 0; n < 2; ++n) gv[bj][n] = *(const f32x4*)(gp + bj * HALF + n * 16);
#pragma unroll
        for (int ai = 0; ai < 2; ++ai) {
            f32x4 xv[4][2][2];
#pragma unroll
            for (int m = 0; m < 4; ++m) { const size_t off = (size_t)(row0 + ai * HALF + m * 16) * DM + col0;
#pragma unroll
                for (int bj = 0; bj < 2; ++bj)
#pragma unroll
                    for (int n = 0; n < 2; ++n) xv[m][bj][n] = *(const f32x4*)(X + off + bj * HALF + n * 16); }
#pragma unroll
            for (int m = 0; m < 4; ++m) { const size_t off = (size_t)(row0 + ai * HALF + m * 16) * DM + col0;
#pragma unroll
                for (int bj = 0; bj < 2; ++bj)
#pragma unroll
                    for (int n = 0; n < 2; ++n) *(f32x4*)(O + off + bj * HALF + n * 16) = xv[m][bj][n] + gv[bj][n] * acc[ai][bj][m][n]; }
            asm volatile("" ::: "memory"); }
    }
};
struct EpiGU {
    static constexpr bool PERM = true;
    const float* bias;   bf16_t* O;
    __device__ __forceinline__ void operator()(const f32x4 (&acc)[2][2][4][2], const Unit& u, int wr, int wc, int fr, int fq) const {
        const int row0 = u.pm * BM + wr * 64 + fr, cc = u.pn * HALF + wc * 32 + 8 * fq;
        const float* bp = bias + (size_t)u.e * 4096 + cc;
        f32x4 bg[2], bu[2];
#pragma unroll
        for (int n = 0; n < 2; ++n) { bg[n] = *(const f32x4*)(bp + 4 * n); bu[n] = *(const f32x4*)(bp + 2048 + 4 * n); }
#pragma unroll
        for (int ai = 0; ai < 2; ++ai)
#pragma unroll
            for (int m = 0; m < 4; ++m) { float r[8];
#pragma unroll
                for (int n = 0; n < 2; ++n)
#pragma unroll
                    for (int j = 0; j < 4; ++j) {
                        float g = acc[ai][0][m][n][j] + bg[n][j], uu = acc[ai][1][m][n][j] + bu[n][j];
                        g = fminf(g, 7.0f); uu = fminf(fmaxf(uu, -7.0f), 7.0f);
                        const float glu = g * __builtin_amdgcn_rcpf(1.0f + __expf(-1.702f * g));
                        r[n * 4 + j] = (uu + 1.0f) * glu;
#if FP8_EMU
                        r[n * 4 + j] = q8(r[n * 4 + j]);
#endif
                    }
                u32x4 w; w.x = cvt_pk_bf16(r[0], r[1]); w.y = cvt_pk_bf16(r[2], r[3]); w.z = cvt_pk_bf16(r[4], r[5]); w.w = cvt_pk_bf16(r[6], r[7]);
                *(u32x4*)(O + (size_t)(row0 + ai * HALF + m * 16) * DM + cc) = w; }
    }
};
struct EpiDown {
    static constexpr bool PERM = true;
    const float* bias;   const float* wbuf; bf16_t* O;
    __device__ __forceinline__ void operator()(const f32x4 (&acc)[2][2][4][2], const Unit& u, int wr, int wc, int fr, int fq) const {
        const int row0 = u.pm * BM + wr * 64 + fr, col0 = u.pn * BM + wc * 32 + 8 * fq;
        const float* bp = bias + (size_t)u.e * 2048 + col0;
        f32x4 bv[2][2];
#pragma unroll
        for (int bj = 0; bj < 2; ++bj)
#pragma unroll
            for (int n = 0; n < 2; ++n) bv[bj][n] = *(const f32x4*)(bp + bj * HALF + 4 * n);
#pragma unroll
        for (int ai = 0; ai < 2; ++ai)
#pragma unroll
            for (int m = 0; m < 4; ++m) { const int row = row0 + ai * HALF + m * 16; const float rw = wbuf[row]; bf16_t* rowp = O + (size_t)row * DM + col0;
#pragma unroll
                for (int bj = 0; bj < 2; ++bj) { const f32x4 v0 = (acc[ai][bj][m][0] + bv[bj][0]) * rw, v1 = (acc[ai][bj][m][1] + bv[bj][1]) * rw;
                    u32x4 w; w.x = cvt_pk_bf16(v0[0], v0[1]); w.y = cvt_pk_bf16(v0[2], v0[3]); w.z = cvt_pk_bf16(v1[0], v1[1]); w.w = cvt_pk_bf16(v1[2], v1[3]);
                    *(u32x4*)(rowp + bj * HALF) = w; } }
    }
};

__device__ __forceinline__ unsigned pk4_fp8(float a, float b, float c, float d) { int p = __builtin_amdgcn_cvt_pk_fp8_f32(a, b, 0, false); p = __builtin_amdgcn_cvt_pk_fp8_f32(c, d, p, true); return (unsigned)p; }
constexpr float W8_SCALE = 64.0f, W8_INV = 1.0f / 64.0f;
struct EpiGU8 {
    static constexpr bool PERM = true;
    const float* bias;   unsigned char* O;
    __device__ __forceinline__ void operator()(const f32x4 (&acc)[2][2][4][2], const Unit& u, int wr, int wc, int fr, int fq) const {
        const int row0 = u.pm * BM + wr * 64 + fr, cc = u.pn * HALF + wc * 32 + 8 * fq;
        const float* bp = bias + (size_t)u.e * 4096 + cc;
        f32x4 bg[2], bu[2];
#pragma unroll
        for (int n = 0; n < 2; ++n) { bg[n] = *(const f32x4*)(bp + 4 * n); bu[n] = *(const f32x4*)(bp + 2048 + 4 * n); }
#pragma unroll
        for (int ai = 0; ai < 2; ++ai)
#pragma unroll
            for (int m = 0; m < 4; ++m) { float r[8];
#pragma unroll
                for (int n = 0; n < 2; ++n)
#pragma unroll
                    for (int j = 0; j < 4; ++j) {
                        float g = acc[ai][0][m][n][j] * W8_INV + bg[n][j], uu = acc[ai][1][m][n][j] * W8_INV + bu[n][j];
                        g = fminf(g, 7.0f); uu = fminf(fmaxf(uu, -7.0f), 7.0f);
                        const float glu = g * __builtin_amdgcn_rcpf(1.0f + __expf(-1.702f * g));
                        r[n * 4 + j] = (uu + 1.0f) * glu; }
                u32x2 w; w.x = pk4_fp8(r[0], r[1], r[2], r[3]); w.y = pk4_fp8(r[4], r[5], r[6], r[7]);
                *(u32x2*)(O + (size_t)(row0 + ai * HALF + m * 16) * DM + cc) = w; }
    }
};
struct EpiDown8 {
    static constexpr bool PERM = true;
    const float* bias;   const float* wbuf; bf16_t* O;
    __device__ __forceinline__ void operator()(const f32x4 (&acc)[2][2][4][2], const Unit& u, int wr, int wc, int fr, int fq) const {
        const int row0 = u.pm * BM + wr * 64 + fr, col0 = u.pn * BM + wc * 32 + 8 * fq;
        const float* bp = bias + (size_t)u.e * 2048 + col0;
        f32x4 bv[2][2];
#pragma unroll
        for (int bj = 0; bj < 2; ++bj)
#pragma unroll
            for (int n = 0; n < 2; ++n) bv[bj][n] = *(const f32x4*)(bp + bj * HALF + 4 * n);
#pragma unroll
        for (int ai = 0; ai < 2; ++ai)
#pragma unroll
            for (int m = 0; m < 4; ++m) { const int row = row0 + ai * HALF + m * 16; const float rw = wbuf[(size_t)u.e * 8192 + u.pos0 + (row - u.pm * BM)]; bf16_t* rowp = O + (size_t)row * DM + col0;
#pragma unroll
                for (int bj = 0; bj < 2; ++bj) { const f32x4 v0 = (acc[ai][bj][m][0] * W8_INV + bv[bj][0]) * rw, v1 = (acc[ai][bj][m][1] * W8_INV + bv[bj][1]) * rw;
                    u32x4 w; w.x = cvt_pk_bf16(v0[0], v0[1]); w.y = cvt_pk_bf16(v0[2], v0[3]); w.z = cvt_pk_bf16(v1[0], v1[1]); w.w = cvt_pk_bf16(v1[2], v1[3]);
                    *(u32x4*)(rowp + bj * HALF) = w; } }
    }
};

typedef int i32x8 __attribute__((ext_vector_type(8)));
typedef short s16x16 __attribute__((ext_vector_type(16)));
__device__ __forceinline__ i32x8 ld32(const LAS unsigned char* p) { const bf16x8 lo = *(const LAS bf16x8*)p, hi = *(const LAS bf16x8*)(p + 1024); return __builtin_bit_cast(i32x8, __builtin_shufflevector(lo, hi, 0, 1, 2, 3, 4, 5, 6, 7, 8, 9, 10, 11, 12, 13, 14, 15)); }
__device__ __forceinline__ const char* sbase(const char* p) { asm volatile("" : "+s"(p)); return p; }
template <bool FP8, bool GATHER, class Epi, class Sched>
__device__ __forceinline__ void gemm_phase(LAS unsigned char* lds, const Gemm g, const Sched& S, const Epi& E) {
    const int tid = threadIdx.x, wid = __builtin_amdgcn_readfirstlane(tid >> 6), lane = tid & 63, wr = wid >> 2, wc = wid & 3, fr = lane & 15, fq = lane >> 4;
    const int K = g.K, nt = K / BK;
    unsigned voffA, voffB;
    { int R, C; stage_rc(tid * 16, R, C); const int Rb = Epi::PERM ? ((R & ~31) + perm32(R & 31)) : R; voffA = (unsigned)(R * K + C) * 2u; voffB = (unsigned)(Rb * K + C) * 2u; }
    const size_t pstep = (size_t)64 * K * 2;
    unsigned voffC = 0, ro[4] = {0, 0, 0, 0}; int Rl = 0;
    if constexpr (GATHER) { int R, C; stage_rc(tid * 16, R, C); voffC = (unsigned)C * 2u; Rl = R; }
#define PG8_ROWS(x0, uidx) do { ro[x0] = (unsigned)g.rowtab[(uidx) * 256 + Rl + 64 * (x0)]; ro[(x0) + 1] = (unsigned)g.rowtab[(uidx) * 256 + Rl + 64 * (x0) + 64]; } while (0)
    const size_t kstep = (size_t)(BK * 2);
    const size_t hstep = (size_t)HALF * K * 2;
    const size_t tstep = 2 * hstep;
    const size_t estep = g.b_estride * 2;
    const unsigned ldsw = (unsigned)wid * 1024u;
    const int aoff0 = lds_byte(wr * 64 + fr, fq * 8), boff0 = lds_byte(wc * 32 + fr, fq * 8);
#define PG8_SA(b, h) (((b) * 2 + (h)) * HTB)
#define PG8_SB(b, h) ((4 + (b) * 2 + (h)) * HTB)
#define PG8_STAGE(bufoff, gbase, voff) do { _Pragma("unroll") for (int _i = 0; _i < 2; ++_i) \
        __builtin_amdgcn_global_load_lds((const unsigned*)(sbase((const char*)(gbase) + _i * pstep) + (voff)), (LAS unsigned*)(lds + (bufoff) + ldsw + _i * 8192), 16, 0, 0); } while (0)
#define PG8_STAGEA(bufoff, isnext, half, koff) do { if constexpr (GATHER) { _Pragma("unroll") for (int _i = 0; _i < 2; ++_i) { const unsigned _r = ro[(half) * 2 + _i]; \
            __builtin_amdgcn_global_load_lds((const unsigned*)(sbase((const char*)g.A + (koff)) + (_r + voffC)), (LAS unsigned*)(lds + (bufoff) + ldsw + _i * 8192), 16, 0, 0); } } \
        else { PG8_STAGE(bufoff, ((isnext) ? nA : cA) + (half) * hstep + (koff), voffA); } } while (0)
#define PG8_LDA(dst, b, h) do { _Pragma("unroll") for (int m = 0; m < 4; ++m) { \
        if constexpr (FP8) dst##8[m] = ld32(lds + PG8_SA(b, h) + aoff0 + m * 2048); \
        else { dst[m][0] = *(const LAS bf16x8*)(lds + PG8_SA(b, h) + aoff0 + m * 2048); dst[m][1] = *(const LAS bf16x8*)(lds + PG8_SA(b, h) + aoff0 + m * 2048 + 1024); } } } while (0)
#define PG8_LDB(dst, b, h) do { _Pragma("unroll") for (int n = 0; n < 2; ++n) { \
        if constexpr (FP8) dst##8[n] = ld32(lds + PG8_SB(b, h) + boff0 + n * 2048); \
        else { dst[n][0] = *(const LAS bf16x8*)(lds + PG8_SB(b, h) + boff0 + n * 2048); dst[n][1] = *(const LAS bf16x8*)(lds + PG8_SB(b, h) + boff0 + n * 2048 + 1024); } } } while (0)
#define PG8_MMA(ai, bj, At, Bt) do { __builtin_amdgcn_s_setprio(1); _Pragma("unroll") for (int m = 0; m < 4; ++m) _Pragma("unroll") for (int n = 0; n < 2; ++n) { \
        if constexpr (FP8) { if (FP8_ASM) { asm volatile("v_mfma_scale_f32_16x16x128_f8f6f4 %0, %1, %2, %0, %3, %3 op_sel_hi:[0,0,0]" : "+a"(acc[ai][bj][m][n]) : "v"(Bt##8[n]), "v"(At##8[m]), "v"(scale1)); } \
            else acc[ai][bj][m][n] = __builtin_amdgcn_mfma_scale_f32_16x16x128_f8f6f4(Bt##8[n], At##8[m], acc[ai][bj][m][n], 0, 0, 0, FP8_SCALE_ARG, 0, FP8_SCALE_ARG); } \
        else { acc[ai][bj][m][n] = __builtin_amdgcn_mfma_f32_16x16x32_bf16(Bt[n][0], At[m][0], acc[ai][bj][m][n], 0, 0, 0); \
               acc[ai][bj][m][n] = __builtin_amdgcn_mfma_f32_16x16x32_bf16(Bt[n][1], At[m][1], acc[ai][bj][m][n], 0, 0, 0); } } \
        __builtin_amdgcn_s_setprio(0); } while (0)
#define PG8_WAIT_V(n) asm volatile("s_waitcnt vmcnt(" #n ")" ::: "memory")
#define PG8_WAIT_L(n) asm volatile("s_waitcnt lgkmcnt(" #n ")" ::: "memory")
#define PG8_BAR __builtin_amdgcn_s_barrier()
#define PG8_SCHED __builtin_amdgcn_sched_barrier(0)
#ifdef PROBE_GMAX
    const unsigned long long tg0 = __builtin_amdgcn_s_memrealtime();
#endif
    Unit cur, nxt; int ui = 0;
#ifdef PROBE_EPI
    unsigned long long epi_acc = 0;
#endif
    if (!S.next(0, cur)) return;
    f32x4 acc[2][2][4][2];
#pragma unroll
    for (int a = 0; a < 2; ++a)
#pragma unroll
        for (int b = 0; b < 2; ++b)
#pragma unroll
            for (int m = 0; m < 4; ++m)
#pragma unroll
                for (int n = 0; n < 2; ++n) acc[a][b][m][n] = (f32x4){0.f, 0.f, 0.f, 0.f};
    bf16x8 At[4][2], B0[2][2], B1[2][2]; i32x8 At8[4], B08[2], B18[2];
    const unsigned scale1 = 0x7f7f7f7fu;
    const char* cA = (const char*)g.A + (size_t)cur.pm * tstep; const char* cB = (const char*)g.Bt + (size_t)cur.e * estep + (size_t)cur.pn * tstep;
    const char* nA = cA;
    if constexpr (GATHER) { PG8_ROWS(0, 0); PG8_ROWS(2, 0); }
    PG8_STAGE(PG8_SB(0, 0), cB, voffB); PG8_STAGEA(PG8_SA(0, 0), false, 0, 0); PG8_STAGE(PG8_SB(0, 1), cB + hstep, voffB); PG8_STAGEA(PG8_SA(0, 1), false, 1, 0);
    if (wr == 1) PG8_BAR;
    PG8_WAIT_V(4); PG8_BAR;
    PG8_STAGE(PG8_SB(1, 0), cB + kstep, voffB); PG8_STAGEA(PG8_SA(1, 0), false, 0, kstep); PG8_STAGE(PG8_SB(1, 1), cB + hstep + kstep, voffB);
    PG8_WAIT_V(6); PG8_BAR;
    for (;;) {
        const bool has_next = S.next(ui + 1, nxt);
        const bool cfull = FP8 ? true : (cur.full != 0);
        nA = has_next ? (const char*)g.A + (size_t)nxt.pm * tstep : cA;
        const char* nB = has_next ? (const char*)g.Bt + (size_t)nxt.e * estep + (size_t)nxt.pn * tstep : cB;
#ifdef PROBE_KL
        const unsigned long long tk0 = __builtin_amdgcn_s_memrealtime();
#endif
        for (int t = 0; t < nt; t += 2) {
            const bool last = (t == nt - 2);
            const size_t k1 = (size_t)(t + 1) * kstep, k2 = last ? 0 : (size_t)(t + 2) * kstep, k3 = k2 + kstep;
            const char* b2 = last ? nB : cB + (size_t)(t + 2) * kstep; const char* b3 = b2 + kstep;
            if constexpr (GATHER) { if (last && has_next) PG8_ROWS(0, ui + 1); }
            PG8_LDB(B0, 0, 0); PG8_SCHED; PG8_LDA(At, 0, 0); PG8_STAGEA(PG8_SA(1, 1), false, 1, k1);
            if constexpr (GATHER) { if (last && has_next) PG8_ROWS(2, ui + 1); }
            PG8_WAIT_V(10); PG8_WAIT_L(8); PG8_BAR; PG8_WAIT_L(0); PG8_MMA(0, 0, At, B0); PG8_BAR; PG8_SCHED;
            PG8_LDB(B1, 0, 1); PG8_STAGE(PG8_SB(0, 0), b2, voffB);
            PG8_WAIT_V(10); PG8_BAR; PG8_WAIT_L(0); PG8_MMA(0, 1, At, B1); PG8_BAR;
            PG8_LDA(At, 0, 1); PG8_STAGEA(PG8_SA(0, 0), last, 0, k2);
            PG8_BAR; PG8_WAIT_L(0); if (cfull) PG8_MMA(1, 0, At, B0); PG8_BAR; PG8_SCHED;
            PG8_STAGE(PG8_SB(0, 1), b2 + hstep, voffB);
            PG8_WAIT_V(10); PG8_BAR; if (cfull) PG8_MMA(1, 1, At, B1); PG8_BAR;
            PG8_LDB(B0, 1, 0); PG8_SCHED; PG8_LDA(At, 1, 0); PG8_STAGEA(PG8_SA(0, 1), last, 1, k2);
            PG8_WAIT_V(10); PG8_WAIT_L(8); PG8_BAR; PG8_WAIT_L(0); PG8_MMA(0, 0, At, B0); PG8_BAR; PG8_SCHED;
            PG8_LDB(B1, 1, 1); PG8_STAGE(PG8_SB(1, 0), b3, voffB);
            PG8_WAIT_V(10); PG8_BAR; PG8_WAIT_L(0); PG8_MMA(0, 1, At, B1); PG8_BAR;
            PG8_LDA(At, 1, 1); PG8_STAGEA(PG8_SA(1, 0), last, 0, k3);
            PG8_BAR; PG8_WAIT_L(0); if (cfull) PG8_MMA(1, 0, At, B0); PG8_BAR; PG8_SCHED;
            PG8_STAGE(PG8_SB(1, 1), b3 + hstep, voffB);
            PG8_WAIT_V(10); PG8_BAR; if (cfull) PG8_MMA(1, 1, At, B1); PG8_BAR;
        }
#ifdef PROBE_KL
        if (FP8 && (GATHER ? 9 : 10) == PROBE_EPI) epi_acc += __builtin_amdgcn_s_memrealtime() - tk0;
#endif
        {
            int tz = threadIdx.x; asm volatile("" : "+v"(tz)); const int lz = tz & 63;
#ifdef PROBE_EPI
            const unsigned long long te0 = __builtin_amdgcn_s_memrealtime();
#endif
            E(acc, cur, wr, wc, lz & 15, lz >> 4);
#ifdef PROBE_EPI
#ifndef PROBE_KL
            if (FP8 && (GATHER ? 9 : 10) == PROBE_EPI) { epi_acc += __builtin_amdgcn_s_memrealtime() - te0; }
#endif
#endif
            }
        S.between(ui);
        if (!has_next) break;
#pragma unroll
        for (int a = 0; a < 2; ++a)
#pragma unroll
            for (int b = 0; b < 2; ++b)
#pragma unroll
                for (int m = 0; m < 4; ++m)
#pragma unroll
                    for (int n = 0; n < 2; ++n) acc[a][b][m][n] = (f32x4){0.f, 0.f, 0.f, 0.f};
        cur = nxt; cA = nA; cB = nB; ++ui;

    }
#ifdef PROBE_EPI
    if (FP8 && (GATHER ? 9 : 10) == PROBE_EPI && blockIdx.x == 0 && threadIdx.x == 0) *(unsigned long long*)((char*)g.probe) = epi_acc;
#endif
#ifdef PROBE_GMAX
    if (FP8 && (GATHER ? 9 : 10) == PROBE_GMAX && threadIdx.x == 0) { const unsigned d = (unsigned)(__builtin_amdgcn_s_memrealtime() - tg0); if (PROBE_GMIN) atomicMin((unsigned*)((char*)g.probe + 8), d); else atomicMax((unsigned*)((char*)g.probe + 8), d); }
#endif
    PG8_WAIT_V(0);
    if (wr == 0) PG8_BAR;
    PG8_BAR;
#undef PG8_SA
#undef PG8_SB
#undef PG8_STAGE
#undef PG8_STAGEA
#undef PG8_ROWS
#undef PG8_LDA
#undef PG8_LDB
#undef PG8_MMA
#undef PG8_WAIT_V
#undef PG8_WAIT_L
#undef PG8_BAR
#undef PG8_SCHED
}
}
#ifndef BJOB_NT
#define BJOB_NT 1
#endif
#if BJOB_NT
#define BJOB_LD(p) __builtin_nontemporal_load(p)
#else
#define BJOB_LD(p) (*(p))
#endif

__device__ __forceinline__ void conv_job(const float* src, int ld, bf16_t* dst, int kt) {
    const int w = threadIdx.x >> 6, lane = threadIdx.x & 63, kseg = lane & 7, nq = lane >> 3;
    const int k0 = kt * 128 + (w >> 2) * 64 + kseg * 8, nl = (w & 3) * 32 + nq * 4;
    f32x4 v[8];
#pragma unroll
    for (int r = 0; r < 8; ++r) v[r] = *(const f32x4*)(src + (size_t)(k0 + r) * ld + nl);
#if FP8_EMU
#pragma unroll
    for (int r = 0; r < 8; ++r)
#pragma unroll
        for (int j = 0; j < 4; ++j) v[r][j] = q8(v[r][j] * 64.0f) * (1.0f / 64.0f);
#endif
#pragma unroll
    for (int j = 0; j < 4; ++j) { u32x4 o; o.x = cvt_pk_bf16(v[0][j], v[1][j]); o.y = cvt_pk_bf16(v[2][j], v[3][j]); o.z = cvt_pk_bf16(v[4][j], v[5][j]); o.w = cvt_pk_bf16(v[6][j], v[7][j]);
        *(u32x4*)(dst + (size_t)(nl + j) * 2048 + k0) = o; }
}
constexpr int CONV_JOBS_GU = 32 * 16 * 16, CONV_JOBS_D = 32 * 16 * 8, CONV_JOBS = CONV_JOBS_GU + CONV_JOBS_D;
__device__ __forceinline__ void conv_block_job(const Args& a, LAS unsigned char* T, int j) {
    const int tid = threadIdx.x, w = tid >> 6, lane = tid & 63;
    const float* src; int ld; unsigned char* dst; int gu, s0;
    if (j < CONV_JOBS_GU) { const int e = j >> 8, kb = (j >> 4) & 15, nb = j & 15; s0 = nb * 256; gu = 1;
        src = a.w_gate_up + ((size_t)e * 2048 + kb * 128) * 4096 + s0; ld = 4096; dst = (unsigned char*)(a.ws + WS_WGU_T) + (size_t)e * 4096 * 2048 + kb * 128; }
    else { const int jj = j - CONV_JOBS_GU, e = jj >> 7, kb = (jj >> 3) & 15, nb = jj & 7; s0 = nb * 256; gu = 0;
        src = a.w_down + ((size_t)e * 2048 + kb * 128) * 2048 + s0; ld = 2048; dst = (unsigned char*)(a.ws + WS_WD_T) + (size_t)e * 2048 * 2048 + kb * 128; }
    f32x4 v[16];
#pragma unroll
    for (int r = 0; r < 16; ++r) v[r] = __builtin_nontemporal_load((const f32x4*)(src + (size_t)(w * 16 + r) * ld + lane * 4)) * pg8::W8_SCALE;
#pragma unroll
    for (int jn = 0; jn < 4; ++jn) { u32x4 o;
        o.x = pg8::pk4_fp8(v[0][jn], v[1][jn], v[2][jn], v[3][jn]); o.y = pg8::pk4_fp8(v[4][jn], v[5][jn], v[6][jn], v[7][jn]);
        o.z = pg8::pk4_fp8(v[8][jn], v[9][jn], v[10][jn], v[11][jn]); o.w = pg8::pk4_fp8(v[12][jn], v[13][jn], v[14][jn], v[15][jn]);
        const int n = lane * 4 + jn;
        *(LAS u32x4*)(T + n * 128 + ((w ^ (lane & 7)) << 4)) = o; }
    __syncthreads();
#pragma unroll
    for (int p = 0; p < 4; ++p) { const int idx = tid + 512 * p, n = idx >> 3, wq = idx & 7;
        const u32x4 o = *(const LAS u32x4*)(T + n * 128 + ((wq ^ ((n >> 2) & 7)) << 4));
        const int c = s0 + n; int np = c;
        if (gu) { const int bj = c >> 11, rem = c & 2047; np = (rem >> 7) * 256 + bj * 128 + (rem & 127); }
        __builtin_nontemporal_store(o, (u32x4*)(dst + (size_t)np * 2048 + wq * 16)); }
}
constexpr int SJOBS_GU = 32 * 32 * 128, SJOBS_D = 32 * 32 * 64, SJOBS = SJOBS_GU + SJOBS_D;
constexpr int SJOBS_ATTN = 256 * 33 * 8;
typedef short s16x2 __attribute__((ext_vector_type(2)));
__device__ __forceinline__ unsigned pk4_fp8_scaled(float a, float b, float c, float d) { s16x2 r = {0, 0}; r = __builtin_amdgcn_cvt_scalef32_pk_fp8_f32(r, a, b, pg8::W8_INV, false); r = __builtin_amdgcn_cvt_scalef32_pk_fp8_f32(r, c, d, pg8::W8_INV, true); return __builtin_bit_cast(unsigned, r); }
struct SJob { const float* src; unsigned char* dst; int ld; };
__device__ __forceinline__ SJob sjob_addr(const Args& a, int j, int lane) {
    SJob c; const int kseg = lane & 7, nq = lane >> 3;
    if (j < SJOBS_GU) { const int e = j >> 12, kb = (j >> 7) & 31, nb = j & 127, s0 = nb * 32, bj = s0 >> 11, rem = s0 & 2047, pn = rem >> 7, c0 = rem & 127, np = pn * 256 + bj * 128 + c0;
        c.ld = 4096; c.src = a.w_gate_up + ((size_t)e * 2048 + kb * 64 + kseg * 8) * 4096 + s0 + nq * 4; c.dst = (unsigned char*)(a.ws + WS_WGU_T) + ((size_t)e * 4096 + np + nq * 4) * 2048 + kb * 64 + kseg * 8; }
    else { const int jj = j - SJOBS_GU, e = jj >> 11, kb = (jj >> 6) & 31, nb = jj & 63;
        c.ld = 2048; c.src = a.w_down + ((size_t)e * 2048 + kb * 64 + kseg * 8) * 2048 + nb * 32 + nq * 4; c.dst = (unsigned char*)(a.ws + WS_WD_T) + ((size_t)e * 2048 + nb * 32 + nq * 4) * 2048 + kb * 64 + kseg * 8; }
    return c;
}
__device__ __forceinline__ void sjob_load(const SJob& c, f32x4 (&v)[8]) {
#pragma unroll
    for (int r = 0; r < 8; ++r) v[r] = __builtin_nontemporal_load((const f32x4*)(c.src + (size_t)r * c.ld));
}
__device__ __forceinline__ void sjob_store(const SJob& c, const f32x4 (&v)[8]) {
#pragma unroll
    for (int jn = 0; jn < 4; ++jn) { u32x2 o;
        o.x = pk4_fp8_scaled(v[0][jn], v[1][jn], v[2][jn], v[3][jn]); o.y = pk4_fp8_scaled(v[4][jn], v[5][jn], v[6][jn], v[7][jn]);
        __builtin_nontemporal_store(o, (u32x2*)(c.dst + (size_t)jn * 2048)); }
}
__device__ __forceinline__ void conv_share(const Args& a, int blk, int G) {
    const int s = blk % 3, r = blk / 3, nb = (G - s + 2) / 3, w = threadIdx.x >> 6, lane = threadIdx.x & 63;
    const int npair = (SJOBS - SJOBS_ATTN) / 2, p0 = s * (npair / 3), p1 = (s == 2) ? npair : (s + 1) * (npair / 3);
    int p = p0 + r * 8 + w; const int step = nb * 8;
    if (p >= p1) return;
    f32x4 va0[8], va1[8], vb0[8], vb1[8]; SJob ca = sjob_addr(a, SJOBS_ATTN + 2 * p, lane), cb = ca, t;
    sjob_load(ca, va0); t = ca; t.src += 32; sjob_load(t, va1);
#pragma unroll 1
    for (;;) {
        const bool hb = (p + step) < p1; if (hb) { cb = sjob_addr(a, SJOBS_ATTN + 2 * (p + step), lane); sjob_load(cb, vb0); t = cb; t.src += 32; sjob_load(t, vb1); }
        sjob_store(ca, va0); t = ca; t.dst += 32 * 2048; sjob_store(t, va1);
        if (!hb) break;
        p += step;
        const bool ha = (p + step) < p1; if (ha) { ca = sjob_addr(a, SJOBS_ATTN + 2 * (p + step), lane); sjob_load(ca, va0); t = ca; t.src += 32; sjob_load(t, va1); }
        sjob_store(cb, vb0); t = cb; t.dst += 32 * 2048; sjob_store(t, vb1);
        if (!ha) break;
        p += step;
    }
}
struct BJob { const float* src; unsigned char* dst; int ld, gu, s0; };
__device__ __forceinline__ BJob bjob_addr(const Args& a, int j) {
    BJob c;
    if (j < CONV_JOBS_GU) { const int e = j >> 8, kb = (j >> 4) & 15, nb = j & 15; c.s0 = nb * 256; c.gu = 1;
        c.src = a.w_gate_up + ((size_t)e * 2048 + kb * 128) * 4096 + c.s0; c.ld = 4096; c.dst = (unsigned char*)(a.ws + WS_WGU_T) + (size_t)e * 4096 * 2048 + kb * 128; }
    else { const int jj = j - CONV_JOBS_GU, e = jj >> 7, kb = (jj >> 3) & 15, nb = jj & 7; c.s0 = nb * 256; c.gu = 0;
        c.src = a.w_down + ((size_t)e * 2048 + kb * 128) * 2048 + c.s0; c.ld = 2048; c.dst = (unsigned char*)(a.ws + WS_WD_T) + (size_t)e * 2048 * 2048 + kb * 128; }
    return c;
}
__device__ __forceinline__ void bjob_load(const BJob& c, f32x4 (&v)[16]) {
    int tz = threadIdx.x; asm volatile("" : "+v"(tz));
    const int w = tz >> 6, lane = tz & 63;
#pragma unroll
    for (int r = 0; r < 16; ++r) v[r] = BJOB_LD((const f32x4*)(c.src + (size_t)(w * 16 + r) * c.ld + lane * 4));
}
__device__ __forceinline__ void bjob_pack(const f32x4 (&v)[16], u32x4 (&o)[4]) {
#pragma unroll
    for (int jn = 0; jn < 4; ++jn) {
        o[jn].x = pk4_fp8_scaled(v[0][jn], v[1][jn], v[2][jn], v[3][jn]); o[jn].y = pk4_fp8_scaled(v[4][jn], v[5][jn], v[6][jn], v[7][jn]);
        o[jn].z = pk4_fp8_scaled(v[8][jn], v[9][jn], v[10][jn], v[11][jn]); o[jn].w = pk4_fp8_scaled(v[12][jn], v[13][jn], v[14][jn], v[15][jn]); }
}
__device__ __forceinline__ void bjob_out(const BJob& c, const u32x4 (&o)[4], LAS unsigned char* Tlo, LAS unsigned char* Thi) {
    int tz = threadIdx.x; asm volatile("" : "+v"(tz));
    const int tid = tz, w = tid >> 6, lane = tid & 63;
    LAS unsigned char* Tw = (lane < 32) ? Tlo : Thi;
#pragma unroll
    for (int jn = 0; jn < 4; ++jn) { const int nl = (lane & 31) * 4 + jn;
        *(LAS u32x4*)(Tw + nl * 128 + ((w ^ (lane & 7)) << 4)) = o[jn]; }
    asm volatile("s_waitcnt lgkmcnt(0)" ::: "memory"); __builtin_amdgcn_s_barrier(); asm volatile("" ::: "memory");
#pragma unroll
    for (int p = 0; p < 4; ++p) { const int idx = tid + 512 * p, n = idx >> 3, wq = idx & 7;
        const LAS unsigned char* Tr = (n < 128) ? Tlo : Thi;
        const u32x4 ov = *(const LAS u32x4*)(Tr + (n & 127) * 128 + ((wq ^ ((n >> 2) & 7)) << 4));
        const int cc = c.s0 + n; int np = cc;
        if (c.gu) { const int bj = cc >> 11, rem = cc & 2047; np = (rem >> 7) * 256 + bj * 128 + (rem & 127); }
        __builtin_nontemporal_store(ov, (u32x4*)(c.dst + (size_t)np * 2048 + wq * 16)); }
    asm volatile("s_waitcnt lgkmcnt(0)" ::: "memory"); __builtin_amdgcn_s_barrier(); asm volatile("" ::: "memory");
}
#ifndef CONV_IN_ATTN
#define CONV_IN_ATTN 1
#endif
constexpr int BJOB0 = CONV_IN_ATTN ? 16 * 256 + 8 * 16 : 0;
__device__ __forceinline__ void conv_share_blk(const Args& a, LAS unsigned char* lds, int blk, int G) {
    const int s = blk % 3, r = blk / 3, nb = (G - s + 2) / 3, nj = CONV_JOBS - BJOB0, j0 = BJOB0 + s * (nj / 3), j1 = (s == 2) ? CONV_JOBS : BJOB0 + (s + 1) * (nj / 3);
    LAS unsigned char* Tlo = lds + 3 * 16384; LAS unsigned char* Thi = lds + LDS_EXTRA;
    int j = j0 + r; if (j >= j1) return;
    f32x4 v[16]; u32x4 o[4]; BJob cc = bjob_addr(a, j);
    bjob_load(cc, v);
#pragma unroll 1
    for (;;) {
        bjob_pack(v, o);
        const BJob cur = cc; const bool hn = (j + nb) < j1;
        if (hn) { cc = bjob_addr(a, j + nb); bjob_load(cc, v); }
        bjob_out(cur, o, Tlo, Thi);
        if (!hn) break;
        j += nb;
    }
}
__device__ __forceinline__ void conv_all(const Args& a, LAS unsigned char* lds) {
    int buf = 0;
    for (int j = blockIdx.x; j < CONV_JOBS; j += gridDim.x) { conv_block_job(a, lds + buf * 32768, j); buf ^= 1; }
    __syncthreads();
}
__device__ __forceinline__ bool conv_claim(const Args&, int) { return false; }

__device__ __forceinline__ void phase_prologue(const Args& a, LAS unsigned char* lds) {
    const int tid = threadIdx.x, blk = blockIdx.x, G = gridDim.x;
    if (blk < 192) {
        LAS float* cact = (LAS float*)lds; LAS float* red = (LAS float*)(lds + 16384);
        for (int i = tid; i < 4096; i += 512) cact[i] = silu_f(a.c[i]);
        __syncthreads();
        float* mod = (float*)(a.ws + WS_MOD);
        for (int cb = blk; cb < 192; cb += G) {
            const int rg = tid >> 4, cl = tid & 15;
            const float* wp = a.w_ada + (size_t)cb * 64 + cl * 4;
            f32x4 a0 = {0.f, 0.f, 0.f, 0.f}, a1 = {0.f, 0.f, 0.f, 0.f};
#pragma unroll 16
            for (int i = 0; i < 64; ++i) { const int k = rg + 32 * i; const f32x4 w = *(const f32x4*)(wp + (size_t)k * 12288); a0 += w * cact[k]; a1 += w * cact[2048 + k]; }
#pragma unroll
            for (int j = 0; j < 4; ++j) { red[(rg * 2 + 0) * 64 + cl * 4 + j] = a0[j]; red[(rg * 2 + 1) * 64 + cl * 4 + j] = a1[j]; }
            __syncthreads();
            if (tid < 128) { const int b = tid >> 6, col = tid & 63; float s = 0.f; for (int r = 0; r < 32; ++r) s += red[(r * 2 + b) * 64 + col]; mod[b * 12288 + cb * 64 + col] = s + a.b_ada[cb * 64 + col]; }
            __syncthreads();
        }
    }
    {
        float* ct = (float*)(a.ws + WS_ROPE); float* st = ct + 4096 * 64;
        for (int idx = blk * 512 + tid; idx < 4096 * 64; idx += G * 512) {
            const int t = idx >> 6, i = idx & 63;
            const float inv = (float)exp2(-(double)i * (13.287712379549449 / 64.0));
            const float ang = (float)t * inv;
            const double ad = (double)ang, n = rint(ad * 0.15915494309189535), r = fma(-n, 6.283185307179586, ad) - n * 2.4492935982947064e-16;
            const float rf = (float)r;
            ct[idx] = cosf(rf); st[idx] = sinf(rf);
        }
    }
    {
        bf16_t* win_t = (bf16_t*)(a.ws + WS_WIN_T); bf16_t* wout_t = (bf16_t*)(a.ws + WS_WOUT_T);
        for (int job = blk; job < 64 * 16; job += 2 * G) {
            const float* src[2]; int ld[2]; bf16_t* dst[2]; int kts[2]; f32x4 v[2][8];
            const int w = threadIdx.x >> 6, lane = threadIdx.x & 63, kseg = lane & 7, nq = lane >> 3, nl = (w & 3) * 32 + nq * 4;
#pragma unroll
            for (int u = 0; u < 2; ++u) { const int jb = (job + u * G < 64 * 16) ? job + u * G : job, rt = jb >> 4; kts[u] = jb & 15;
                if (rt < 48) { const int n0 = rt * 128, col0 = n0 < 3072 ? n0 : n0 + 16; src[u] = a.w_in + col0; ld[u] = DIN; dst[u] = win_t + (size_t)n0 * 2048; }
                else { const int n0 = (rt - 48) * 128; src[u] = a.w_out + n0; ld[u] = 2048; dst[u] = wout_t + (size_t)n0 * 2048; }
                const int k0 = kts[u] * 128 + (w >> 2) * 64 + kseg * 8;
#pragma unroll
                for (int r = 0; r < 8; ++r) v[u][r] = *(const f32x4*)(src[u] + (size_t)(k0 + r) * ld[u] + nl); }
#pragma unroll
            for (int u = 0; u < 2; ++u) { const int k0 = kts[u] * 128 + (w >> 2) * 64 + kseg * 8;
#pragma unroll
                for (int j = 0; j < 4; ++j) { u32x4 o; o.x = cvt_pk_bf16(v[u][0][j], v[u][1][j]); o.y = cvt_pk_bf16(v[u][2][j], v[u][3][j]); o.z = cvt_pk_bf16(v[u][4][j], v[u][5][j]); o.w = cvt_pk_bf16(v[u][6][j], v[u][7][j]);
                    *(u32x4*)(dst[u] + (size_t)(nl + j) * 2048 + k0) = o; } }
        }
    }
}

__device__ __forceinline__ void phase_norm1(const Args& a, LAS unsigned char* lds) {
    const int tid = threadIdx.x, blk = blockIdx.x, G = gridDim.x, w = tid >> 6, lane = tid & 63;
    constexpr int HS = 2052;
    LAS float* hs = (LAS float*)lds;
    LAS float* part = (LAS float*)(lds + LDS_EXTRA + 4096);
    LAS float* las = (LAS float*)(lds + LDS_EXTRA);
    const float* mod = (const float*)(a.ws + WS_MOD);
    bf16_t* h1 = (bf16_t*)(a.ws + WS_H1); float* gk = (float*)(a.ws + WS_GK);
    float wl[64];
    { const int kk = lane >> 4, fr = lane & 15; const float* wp = a.w_in + (size_t)(w * 256 + kk) * DIN + 3072 + fr;
#pragma unroll
      for (int ks = 0; ks < 64; ++ks) wl[ks] = wp[(size_t)ks * 4 * DIN]; }
    float w2[16];
#pragma unroll
    for (int j = 0; j < 16; ++j) w2[j] = a.w_alpha2[j * 512 + tid];
    const float bz = a.b_alpha[tid];
    for (int grp = blk; grp < NTOK / 16; grp += G) {
        {
            const int r0 = grp * 16 + 2 * w;
            const f32x4* xr0 = (const f32x4*)(a.x + (size_t)r0 * DM) + lane; const f32x4* xr1 = xr0 + DM / 4;
            f32x4 v0[8], v1[8]; float ss0 = 0.f, ss1 = 0.f;
#pragma unroll
            for (int q = 0; q < 8; ++q) { v0[q] = xr0[64 * q]; v1[q] = xr1[64 * q]; }
#pragma unroll
            for (int q = 0; q < 8; ++q) { ss0 += (v0[q][0] * v0[q][0] + v0[q][1] * v0[q][1]) + (v0[q][2] * v0[q][2] + v0[q][3] * v0[q][3]); ss1 += (v1[q][0] * v1[q][0] + v1[q][1] * v1[q][1]) + (v1[q][2] * v1[q][2] + v1[q][3] * v1[q][3]); }
            ss0 = wave_sum(ss0); ss1 = wave_sum(ss1);
            const float rstd0 = 1.0f / sqrtf(ss0 * (1.0f / DM) + EPS), rstd1 = 1.0f / sqrtf(ss1 * (1.0f / DM) + EPS);
            const float* sh = mod + (size_t)(r0 >> 12) * 12288; const float* sc = sh + 2048;
#pragma unroll
            for (int q = 0; q < 8; ++q) { const int k = 4 * (lane + 64 * q);
                const f32x4 nw = *(const f32x4*)(a.norm1_w + k), scv = *(const f32x4*)(sc + k), shv = *(const f32x4*)(sh + k);
                const f32x4 h0 = (v0[q] * rstd0 * nw) * (scv + 1.0f) + shv, h1v = (v1[q] * rstd1 * nw) * (scv + 1.0f) + shv;
                *(LAS f32x4*)(hs + (2 * w) * HS + k) = h0; *(LAS f32x4*)(hs + (2 * w + 1) * HS + k) = h1v;
                u32x2 o; o.x = cvt_pk_bf16(h0[0], h0[1]); o.y = cvt_pk_bf16(h0[2], h0[3]);
                *(u32x2*)(h1 + (size_t)r0 * DM + k) = o;
                o.x = cvt_pk_bf16(h1v[0], h1v[1]); o.y = cvt_pk_bf16(h1v[2], h1v[3]);
                *(u32x2*)(h1 + (size_t)(r0 + 1) * DM + k) = o; } }
        __syncthreads();
        {
            const int kk = lane >> 4, fr = lane & 15; f32x4 acc = {0.f, 0.f, 0.f, 0.f};
            const LAS float* hp = hs + fr * HS + w * 256 + kk;
#pragma unroll
            for (int ks = 0; ks < 64; ++ks) acc = __builtin_amdgcn_mfma_f32_16x16x4f32(wl[ks], hp[ks * 4], acc, 0, 0, 0);
#pragma unroll
            for (int r = 0; r < 4; ++r) part[(w * 16 + 4 * kk + r) * 16 + fr] = acc[r];
        }
        __syncthreads();
        if (tid < 256) { const int t = tid >> 4, j = tid & 15; float s = 0.f;
#pragma unroll
            for (int q = 0; q < 8; ++q) s += part[(q * 16 + j) * 16 + t];
            las[t * 16 + j] = s; }
        __syncthreads();
        {
#pragma unroll 4
            for (int t = 0; t < 16; ++t) { const LAS f32x4* lp = (const LAS f32x4*)(las + t * 16); float z = bz;
#pragma unroll
                for (int q = 0; q < 4; ++q) { const f32x4 l = lp[q]; z += l[0] * w2[4 * q] + l[1] * w2[4 * q + 1] + l[2] * w2[4 * q + 2] + l[3] * w2[4 * q + 3]; }
                const float ls = fminf(z, 0.f) - log1pf(expf(-fabsf(z)));
                gk[(size_t)(grp * 16 + t) * 512 + tid] = ls * (1.0f / 16.0f); }
        }
        __syncthreads();
    }
}

__device__ __forceinline__ void gla_stage_vt(const bf16_t* proj, int row0, int h, LAS bf16_t* VT, int tid) {
    const int i = tid >> 3, seg = tid & 7;
    const u32x4* vp = (const u32x4*)(proj + (size_t)(row0 + i) * NPROJ + C_VA + h * 256 + seg * 32);
#pragma unroll
    for (int c4 = 0; c4 < 4; ++c4) { const u32x4 vv = vp[c4];
#pragma unroll
        for (int p = 0; p < 4; ++p) { const unsigned wd = vv[p]; const int e = seg * 32 + c4 * 8 + p * 2;
            VT[e * 72 + i] = (bf16_t)(wd & 0xffffu); VT[(e + 1) * 72 + i] = (bf16_t)(wd >> 16); } }
}
__device__ __forceinline__ void gla1_unit(const Args& a, LAS unsigned char* lds, int u) {
    const int tid = threadIdx.x, w = tid >> 6, lane = tid & 63;
    const int bh = u >> 6, c = u & 63, b = bh >> 2, h = bh & 3, row0 = b * SEQ + c * 64;
    LAS float* Bm = (LAS float*)lds; LAS bf16_t* KT = (LAS bf16_t*)(lds + 32768); LAS bf16_t* VT = (LAS bf16_t*)(lds + 51200);
    const float* gk = (const float*)(a.ws + WS_GK); const bf16_t* proj = (const bf16_t*)(a.ws + WS_PROJ);
    float* bcum = (float*)(a.ws + WS_BCUM); float* dst = (float*)(a.ws + WS_DST); float* dec = (float*)(a.ws + WS_DEC);
    const int i = tid >> 3, seg = tid & 7;
    {
        const f32x4* gp = (const f32x4*)(gk + (size_t)(row0 + i) * 512 + h * 128 + seg * 16);
#pragma unroll
        for (int q = 0; q < 4; ++q) *(LAS f32x4*)(Bm + i * 128 + seg * 16 + q * 4) = gp[q];
    }
    __syncthreads();
    {
        const int d = tid & 127, q4 = tid >> 7; LAS float* qs = (LAS float*)(lds + 90112);
        float run = 0.f;
#pragma unroll
        for (int ii = 0; ii < 16; ++ii) { run += Bm[(q4 * 16 + ii) * 128 + d]; Bm[(q4 * 16 + ii) * 128 + d] = run; }
        qs[q4 * 128 + d] = run;
        __syncthreads();
        float off = 0.f;
#pragma unroll
        for (int qq = 0; qq < 3; ++qq) off += (qq < q4) ? qs[qq * 128 + d] : 0.f;
        if (q4 > 0) {
#pragma unroll
            for (int ii = 0; ii < 16; ++ii) Bm[(q4 * 16 + ii) * 128 + d] += off; }
    }
    __syncthreads();
    {
        const u32x4* kp = (const u32x4*)(proj + (size_t)(row0 + i) * NPROJ + C_KA + h * 128 + seg * 16);
        float* bo = bcum + ((size_t)u * 64 + i) * 128 + seg * 16;
#pragma unroll
        for (int q = 0; q < 2; ++q) { const u32x4 kv = kp[q];
#pragma unroll
            for (int p = 0; p < 4; ++p) { const int d = seg * 16 + q * 8 + p * 2;
                const float b0 = Bm[i * 128 + d], b1 = Bm[i * 128 + d + 1], l0 = Bm[63 * 128 + d], l1 = Bm[63 * 128 + d + 1];
                bo[q * 8 + p * 2] = b0; bo[q * 8 + p * 2 + 1] = b1;
                KT[d * 72 + i] = f2bf(bflo(kv[p]) * expf(l0 - b0)); KT[(d + 1) * 72 + i] = f2bf(bfhi(kv[p]) * expf(l1 - b1));
                if (i == 63) { dec[(size_t)u * 128 + d] = expf(l0); dec[(size_t)u * 128 + d + 1] = expf(l1); } } }
        gla_stage_vt(proj, row0, h, VT, tid);
    }
    __syncthreads();
    {
        f32x4 acc[2][8];
#pragma unroll
        for (int x = 0; x < 2; ++x)
#pragma unroll
            for (int y = 0; y < 8; ++y) acc[x][y] = (f32x4){0.f, 0.f, 0.f, 0.f};
#pragma unroll
        for (int ks = 0; ks < 2; ++ks) {
            const bf16x8 a0 = lds_frag(VT, 72, (2 * w) * 16, ks * 32, lane), a1 = lds_frag(VT, 72, (2 * w + 1) * 16, ks * 32, lane);
#pragma unroll
            for (int dt = 0; dt < 8; ++dt) { const bf16x8 bf = lds_frag(KT, 72, dt * 16, ks * 32, lane); acc[0][dt] = mfma16(a0, bf, acc[0][dt]); acc[1][dt] = mfma16(a1, bf, acc[1][dt]); }
        }
        float* dp = dst + (size_t)u * 32768;
#pragma unroll
        for (int x = 0; x < 2; ++x)
#pragma unroll
            for (int dt = 0; dt < 8; ++dt)
#pragma unroll
                for (int r = 0; r < 4; ++r) dp[((2 * w + x) * 16 + 4 * (lane >> 4) + r) * 128 + dt * 16 + (lane & 15)] = acc[x][dt][r];
    }
    __syncthreads();
}
__device__ __forceinline__ void moba_prep_unit(const Args& a, LAS unsigned char* lds, int u2) {
    const int tid = threadIdx.x;
    const int bh = u2 >> 4, kb = u2 & 15, b = bh >> 3, h = bh & 7, row0 = b * SEQ + kb * 256, t0 = kb * 256;
    const bf16_t* proj = (const bf16_t*)(a.ws + WS_PROJ);
    const float* ct = (const float*)(a.ws + WS_ROPE); const float* st = ct + 4096 * 64;
    bf16_t* qbr = (bf16_t*)(a.ws + WS_QBR); bf16_t* kbr = (bf16_t*)(a.ws + WS_KBR); bf16_t* vbt = (bf16_t*)(a.ws + WS_VBT); float* kmean = (float*)(a.ws + WS_KMEAN);
    constexpr int KS = 132;
    LAS float* Kf = (LAS float*)lds;
    LAS float* part = (LAS float*)(lds + 135168);
    LAS bf16_t* Vl = (LAS bf16_t*)(lds + 139264);
    const int rl = tid >> 3, c = tid & 7;
    f32x4 cvv[4][2], svv[4][2]; u32x4 xin[4][2][2], vin[4][2];
#pragma unroll
    for (int pass = 0; pass < 4; ++pass) { const int row = pass * 64 + rl;
        cvv[pass][0] = *(const f32x4*)(ct + (size_t)(t0 + row) * 64 + c * 8); cvv[pass][1] = *(const f32x4*)(ct + (size_t)(t0 + row) * 64 + c * 8 + 4);
        svv[pass][0] = *(const f32x4*)(st + (size_t)(t0 + row) * 64 + c * 8); svv[pass][1] = *(const f32x4*)(st + (size_t)(t0 + row) * 64 + c * 8 + 4);
#pragma unroll
        for (int which = 0; which < 2; ++which) { const bf16_t* src = proj + (size_t)(row0 + row) * NPROJ + (which == 0 ? C_KB : C_QB) + h * 128 + c * 8;
            xin[pass][which][0] = *(const u32x4*)src; xin[pass][which][1] = *(const u32x4*)(src + 64); } }
#pragma unroll
    for (int sl = 0; sl < 4; ++sl)
#pragma unroll
        for (int ps = 0; ps < 2; ++ps) { const int row = ps * 128 + (tid >> 2);
            vin[sl][ps] = *(const u32x4*)(proj + (size_t)(row0 + row) * NPROJ + C_VB + h * 128 + sl * 32 + (tid & 3) * 8); }
#pragma unroll
    for (int pass = 0; pass < 4; ++pass) { const int row = pass * 64 + rl;
        const f32x4 cv0 = cvv[pass][0], cv1 = cvv[pass][1], sv0 = svv[pass][0], sv1 = svv[pass][1];
#pragma unroll
        for (int which = 0; which < 2; ++which) {
            bf16_t* dsto = (which == 0 ? kbr : qbr) + ((size_t)bh * SEQ + t0 + row) * 128 + c * 8;
            const u32x4 x1 = xin[pass][which][0], x2 = xin[pass][which][1];
            u32x4 o1, o2; float r1[8], r2[8];
#pragma unroll
            for (int p = 0; p < 4; ++p) {
                const float c0 = (p < 2) ? cv0[2 * p] : cv1[2 * p - 4], c1 = (p < 2) ? cv0[2 * p + 1] : cv1[2 * p - 3], s0 = (p < 2) ? sv0[2 * p] : sv1[2 * p - 4], s1 = (p < 2) ? sv0[2 * p + 1] : sv1[2 * p - 3];
                const float a0 = bflo(x1[p]), a1 = bfhi(x1[p]), b0 = bflo(x2[p]), b1 = bfhi(x2[p]);
                r1[2 * p] = a0 * c0 - b0 * s0; r1[2 * p + 1] = a1 * c1 - b1 * s1; r2[2 * p] = a0 * s0 + b0 * c0; r2[2 * p + 1] = a1 * s1 + b1 * c1;
                o1[p] = cvt_pk_bf16(r1[2 * p], r1[2 * p + 1]); o2[p] = cvt_pk_bf16(r2[2 * p], r2[2 * p + 1]); }
            *(u32x4*)dsto = o1; *(u32x4*)(dsto + 64) = o2;
            if (which == 0) { LAS float* kr = Kf + row * KS + c * 8;
                *(LAS f32x4*)kr = (f32x4){r1[0], r1[1], r1[2], r1[3]}; *(LAS f32x4*)(kr + 4) = (f32x4){r1[4], r1[5], r1[6], r1[7]};
                *(LAS f32x4*)(kr + 64) = (f32x4){r2[0], r2[1], r2[2], r2[3]}; *(LAS f32x4*)(kr + 68) = (f32x4){r2[4], r2[5], r2[6], r2[7]}; }
        }
    }
    __syncthreads();
    { const int d = tid & 127, rq = tid >> 7; float s = 0.f;
#pragma unroll 8
        for (int rr = 0; rr < 64; ++rr) s += Kf[(rq * 64 + rr) * KS + d];
        part[rq * 128 + d] = s; }
    __syncthreads();
    if (tid < 128) kmean[((size_t)bh * 16 + kb) * 128 + tid] = (part[tid] + part[128 + tid] + part[256 + tid] + part[384 + tid]) * (1.0f / 256.0f);
#pragma unroll
    for (int sl = 0; sl < 4; ++sl) {
        { const int rw = tid >> 2, c4 = tid & 3;
#pragma unroll
            for (int ps = 0; ps < 2; ++ps) { const int row = ps * 128 + rw;
                *(LAS u32x4*)(Vl + row * 40 + (((c4 + (row >> 4)) & 3) << 3)) = vin[sl][ps]; } }
        __syncthreads();
        { const int d = tid >> 4, tc = tid & 15;
            u32x4 o0, o1;
            const int dp = ((((d >> 3) + tc) & 3) << 3) + (d & 7);
#pragma unroll
            for (int p = 0; p < 4; ++p) { const int tt = tc * 16 + p * 2; o0[p] = (unsigned)Vl[tt * 40 + dp] | ((unsigned)Vl[(tt + 1) * 40 + dp] << 16);
                o1[p] = (unsigned)Vl[(tt + 8) * 40 + dp] | ((unsigned)Vl[(tt + 9) * 40 + dp] << 16); }
            bf16_t* op = vbt + ((size_t)bh * 128 + sl * 32 + d) * SEQ + t0 + tc * 16;
            *(u32x4*)op = o0; *(u32x4*)(op + 8) = o1; }
        __syncthreads();
    }
}
__device__ __forceinline__ void phase_mix_prep(const Args& a, LAS unsigned char* lds) {
    const int blk = blockIdx.x, G = gridDim.x;
    for (int u = blk; u < 512; u += G) gla1_unit(a, lds, u);
    for (int u2 = blk; u2 < 256; u2 += G) moba_prep_unit(a, lds, u2);
}

__device__ __forceinline__ void phase_scan_select(const Args& a, LAS unsigned char* lds) {
    const int tid = threadIdx.x, blk = blockIdx.x, G = gridDim.x;
    {
        const float* dst = (const float*)(a.ws + WS_DST); const float* dec = (const float*)(a.ws + WS_DEC); bf16_t* ST = (bf16_t*)(a.ws + WS_ST);
        for (int el = blk * 512 + tid; el < 8 * 32768; el += G * 512) {
            const int bh = el >> 15, ed = el & 32767, d = ed & 127; float cur = 0.f;
#pragma unroll 1
            for (int c0 = 0; c0 < 64; c0 += 32) { float dv[32], gv[32];
#pragma unroll
                for (int c = 0; c < 32; ++c) { const size_t u = (size_t)bh * 64 + c0 + c; dv[c] = dst[u * 32768 + ed]; gv[c] = dec[u * 128 + d]; }
#pragma unroll
                for (int c = 0; c < 32; ++c) { const size_t u = (size_t)bh * 64 + c0 + c; ST[u * 32768 + ed] = f2bf(cur); cur = gv[c] * cur + dv[c]; } }
        }
    }
    {
        const float* kmean = (const float*)(a.ws + WS_KMEAN); const bf16_t* qbr = (const bf16_t*)(a.ws + WS_QBR); unsigned* sel = (unsigned*)(a.ws + WS_SEL);
        LAS float* km = (LAS float*)lds;
        for (int u2 = blk; u2 < 256; u2 += G) {
            const int bh = u2 >> 4, qb = u2 & 15;
            __syncthreads();
            for (int i = tid; i < 2048; i += 512) km[i] = kmean[(size_t)bh * 2048 + i];
            __syncthreads();
            const int q = tid >> 1, half = tid & 1;
            float gv[8];
#pragma unroll
            for (int n = 0; n < 8; ++n) gv[n] = 0.f;
            const u32x4* qp = (const u32x4*)(qbr + ((size_t)bh * SEQ + qb * 256 + q) * 128);
#pragma unroll 4
            for (int c = 0; c < 16; ++c) { const u32x4 qq = qp[c]; float qf[8];
#pragma unroll
                for (int p = 0; p < 4; ++p) { qf[2 * p] = bflo(qq[p]); qf[2 * p + 1] = bfhi(qq[p]); }
#pragma unroll
                for (int n = 0; n < 8; ++n) { const LAS float* kr = km + (half * 8 + n) * 128 + c * 8; const f32x4 k0 = *(const LAS f32x4*)kr, k1 = *(const LAS f32x4*)(kr + 4);
                    gv[n] += (qf[0] * k0[0] + qf[1] * k0[1]) + (qf[2] * k0[2] + qf[3] * k0[3]) + (qf[4] * k1[0] + qf[5] * k1[1]) + (qf[6] * k1[2] + qf[7] * k1[3]); } }
            float ga[16];
#pragma unroll
            for (int n = 0; n < 8; ++n) { const float o = __shfl_xor(gv[n], 1); ga[n] = half ? o : gv[n]; ga[8 + n] = half ? gv[n] : o; }
            unsigned mask = 0u; const int nsel = qb < 3 ? qb : 3;
            for (int s = 0; s < nsel; ++s) { int best = -1; float bv = -INFINITY;
#pragma unroll
                for (int n = 0; n < 16; ++n) { const bool ok = (n < qb) && !((mask >> n) & 1u) && (best < 0 || ga[n] > bv); if (ok) { bv = ga[n]; best = n; } }
                mask |= 1u << best; }
            if (half == 0) sel[(size_t)bh * SEQ + qb * 256 + q] = mask;
        }
        __syncthreads();
    }
}

#ifndef CHECK_MODE
#define CHECK_MODE 0
#endif
constexpr size_t WS_CHK = 18432;
constexpr size_t WS_CHKO = WS_Y + 160 * MB;
#if CHECK_MODE
__device__ __forceinline__ void phase_check(const Args& a, LAS unsigned char* lds) {
    const int tid = threadIdx.x, blk = blockIdx.x, G = gridDim.x, w = tid >> 6, lane = tid & 63;
    const bf16_t* proj = (const bf16_t*)(a.ws + WS_PROJ); const bf16_t* ocat = (const bf16_t*)(a.ws + WS_OCAT);
    float* chk = (float*)(a.ws + WS_CHK);
#if CHECK_MODE == 1
    const float* ct = (const float*)(a.ws + WS_ROPE); const float* st = ct + 4096 * 64;
    for (int task = blk * 8 + w; task < 67 * 16; task += G * 8) {
        const int s = task >> 4, bh = task & 15, b = bh >> 3, h = bh & 7, t = 61 * s + 7, qblk = t >> 8;
        const bf16_t* qrow = proj + (size_t)(b * SEQ + t) * NPROJ + C_QB + h * 128;
        const float c = ct[t * 64 + lane], sn = st[t * 64 + lane];
        const float q1 = bf2f(qrow[lane]), q2 = bf2f(qrow[lane + 64]);
        const float qa = q1 * c - q2 * sn, qb2 = q1 * sn + q2 * c;
        float gate[16];
#pragma unroll 1
        for (int n = 0; n < 16; ++n) { float g = -INFINITY;
            if (n < qblk) { float m1 = 0.f, m2 = 0.f;
                for (int kk = 0; kk < 256; ++kk) { const int tk = n * 256 + kk; const bf16_t* krow = proj + (size_t)(b * SEQ + tk) * NPROJ + C_KB + h * 128;
                    const float k1 = bf2f(krow[lane]), k2 = bf2f(krow[lane + 64]), ck = ct[tk * 64 + lane], sk = st[tk * 64 + lane];
                    m1 += k1 * ck - k2 * sk; m2 += k1 * sk + k2 * ck; }
                g = wave_sum(qa * (m1 * (1.0f / 256.0f)) + qb2 * (m2 * (1.0f / 256.0f))); }
#pragma unroll
            for (int z = 0; z < 16; ++z) if (z == n) gate[z] = g; }
        unsigned mask = 0u; const int nsel = qblk < 3 ? qblk : 3;
        for (int it = 0; it < nsel; ++it) { int best = -1; float bv = -INFINITY;
#pragma unroll
            for (int n = 0; n < 16; ++n) { const bool ok = (n < qblk) && !((mask >> n) & 1u) && (best < 0 || gate[n] > bv); if (ok) { bv = gate[n]; best = n; } }
            mask |= 1u << best; }
        { const unsigned fastsel = ((const unsigned*)(a.ws + WS_SEL))[(size_t)bh * SEQ + t];
          if (fastsel != mask) { if (lane == 0) atomicAdd(&chk[2], 1.0f); continue; } }
        mask |= 1u << qblk;
        float m = -INFINITY, l = 0.f, o1 = 0.f, o2 = 0.f;
        for (int n = 0; n <= qblk; ++n) { if (!((mask >> n) & 1u)) continue;
            for (int kk = 0; kk < 256; ++kk) { const int tk = n * 256 + kk; if (tk > t) break;
                const bf16_t* krow = proj + (size_t)(b * SEQ + tk) * NPROJ + C_KB + h * 128; const bf16_t* vrow = proj + (size_t)(b * SEQ + tk) * NPROJ + C_VB + h * 128;
                const float k1 = bf2f(krow[lane]), k2 = bf2f(krow[lane + 64]), ck = ct[tk * 64 + lane], sk = st[tk * 64 + lane];
                const float sc = wave_sum(qa * (k1 * ck - k2 * sk) + qb2 * (k1 * sk + k2 * ck)) * 0.08838834764831845f;
                const float mn = fmaxf(m, sc), al = expf(m - mn), p = expf(sc - mn);
                l = l * al + p; o1 = o1 * al + p * bf2f(vrow[lane]); o2 = o2 * al + p * bf2f(vrow[lane + 64]); m = mn; } }
        o1 /= l; o2 /= l;
        const bf16_t* frow = ocat + (size_t)(b * SEQ + t) * DM + 1024 + h * 128;
        const float f1 = bf2f(frow[lane]), f2 = bf2f(frow[lane + 64]);
        const float num = wave_sum((f1 - o1) * (f1 - o1) + (f2 - o2) * (f2 - o2)), den = wave_sum(o1 * o1 + o2 * o2);
        if (lane == 0) { atomicAdd(&chk[0], num); atomicAdd(&chk[1], den); }
    }
#else
    const int cb = 1, ch = 2; const float* gk = (const float*)(a.ws + WS_GK); float* oref = (float*)(a.ws + WS_CHKO);
    for (int e = blk * 8 + w; e < 256; e += G * 8) {
        float s1 = 0.f, s2 = 0.f;
        for (int t = 0; t < SEQ; ++t) { const size_t row = (size_t)(cb * SEQ + t);
            const bf16_t* pr = proj + row * NPROJ;
            const float a1 = expf(gk[row * 512 + ch * 128 + lane]), a2 = expf(gk[row * 512 + ch * 128 + lane + 64]);
            const float k1 = bf2f(pr[C_KA + ch * 128 + lane]), k2 = bf2f(pr[C_KA + ch * 128 + lane + 64]), v = bf2f(pr[C_VA + ch * 256 + e]);
            const float q1 = bf2f(pr[C_QA + ch * 128 + lane]) * 0.08838834764831845f, q2 = bf2f(pr[C_QA + ch * 128 + lane + 64]) * 0.08838834764831845f;
            s1 = a1 * s1 + k1 * v; s2 = a2 * s2 + k2 * v;
            const float o = wave_sum(q1 * s1 + q2 * s2);
            if (lane == 0) oref[(size_t)t * 256 + e] = o; }
    }
#endif
}
__device__ __forceinline__ void phase_check2(const Args& a, LAS unsigned char* lds) {
#if CHECK_MODE == 2
    const int tid = threadIdx.x, blk = blockIdx.x, G = gridDim.x, w = tid >> 6, lane = tid & 63;
    const int cb = 1, ch = 2; const float* oref = (const float*)(a.ws + WS_CHKO); float* chk = (float*)(a.ws + WS_CHK);
    const bf16_t* proj = (const bf16_t*)(a.ws + WS_PROJ); const bf16_t* ocat = (const bf16_t*)(a.ws + WS_OCAT);
    for (int t = blk * 8 + w; t < SEQ; t += G * 8) { float o[4], ss = 0.f;
#pragma unroll
        for (int q = 0; q < 4; ++q) { o[q] = oref[(size_t)t * 256 + lane + 64 * q]; ss += o[q] * o[q]; }
        ss = wave_sum(ss); const float rstd = 1.0f / sqrtf(ss * (1.0f / 256.0f) + EPS); float num = 0.f, den = 0.f;
#pragma unroll
        for (int q = 0; q < 4; ++q) { const int e = lane + 64 * q; const size_t row = (size_t)(cb * SEQ + t);
            const float ga = bf2f(proj[row * NPROJ + C_GA + ch * 256 + e]), ref = o[q] * rstd * a.gla_norm_w[e] * silu_f(ga), f = bf2f(ocat[row * DM + ch * 256 + e]);
            num += (f - ref) * (f - ref); den += ref * ref; }
        num = wave_sum(num); den = wave_sum(den);
        if (lane == 0) { atomicAdd(&chk[0], num); atomicAdd(&chk[1], den); } }
#endif
}
#endif
#ifndef PROBE_TIME
#define PROBE_TIME -1
#endif
#ifndef PROBE_TOFF
#define PROBE_TOFF 0.0f
#endif
#ifndef PROBE_TSCALE
#define PROBE_TSCALE 3000.0f
#endif
#ifndef CONV_IN_GEMM
#define CONV_IN_GEMM 1
#endif
#ifndef CONV_IN_ATTN
#define CONV_IN_ATTN 1
#endif
#ifndef CONV_BLK
#define CONV_BLK 1
#endif

__device__ __forceinline__ void gla3_unit(const Args& a, LAS unsigned char* lds, int u) {
    const int tid = threadIdx.x, w = tid >> 6, lane = tid & 63, g = lane >> 4, fr = lane & 15;
    const int bh = u >> 6, c = u & 63, b = bh >> 2, h = bh & 3, row0 = b * SEQ + c * 64;
    LAS bf16_t* QP = (LAS bf16_t*)lds; LAS bf16_t* KP = (LAS bf16_t*)(lds + 17408); LAS bf16_t* VT = (LAS bf16_t*)(lds + 34816);
    LAS bf16_t* AM = (LAS bf16_t*)(lds + 71680); LAS float* OT = (LAS float*)(lds + 81920);
    const bf16_t* proj = (const bf16_t*)(a.ws + WS_PROJ); const float* bcum = (const float*)(a.ws + WS_BCUM); const bf16_t* ST = (const bf16_t*)(a.ws + WS_ST);
    bf16_t* ocat = (bf16_t*)(a.ws + WS_OCAT);
    {
        const int i = tid >> 3, seg = tid & 7;
        const f32x4* bp = (const f32x4*)(bcum + ((size_t)u * 64 + i) * 128 + seg * 16);
        const u32x4* qp = (const u32x4*)(proj + (size_t)(row0 + i) * NPROJ + C_QA + h * 128 + seg * 16);
        const u32x4* kp = (const u32x4*)(proj + (size_t)(row0 + i) * NPROJ + C_KA + h * 128 + seg * 16);
#pragma unroll
        for (int q = 0; q < 2; ++q) { const u32x4 qv = qp[q], kv = kp[q]; const f32x4 b0 = bp[2 * q], b1 = bp[2 * q + 1]; u32x4 qo, ko;
#pragma unroll
            for (int p = 0; p < 4; ++p) { const float bl = (p < 2) ? b0[2 * p] : b1[2 * p - 4], bhv = (p < 2) ? b0[2 * p + 1] : b1[2 * p - 3];
                const float el = expf(bl), eh = expf(bhv);
                qo[p] = cvt_pk_bf16(bflo(qv[p]) * el * 0.08838834764831845f, bfhi(qv[p]) * eh * 0.08838834764831845f);
                ko[p] = cvt_pk_bf16(bflo(kv[p]) / el, bfhi(kv[p]) / eh); }
            *(LAS u32x4*)(QP + i * 136 + seg * 16 + q * 8) = qo; *(LAS u32x4*)(KP + i * 136 + seg * 16 + q * 8) = ko; }
        gla_stage_vt(proj, row0, h, VT, tid);
    }
    __syncthreads();
    {
        const int it = w >> 1;
#pragma unroll
        for (int jj = 0; jj < 2; ++jj) { const int jt = (w & 1) * 2 + jj; f32x4 acc = {0.f, 0.f, 0.f, 0.f};
            if (jt <= it) {
#pragma unroll
                for (int ks = 0; ks < 4; ++ks) acc = mfma16(lds_frag(QP, 136, it * 16, ks * 32, lane), lds_frag(KP, 136, jt * 16, ks * 32, lane), acc);
            }
#pragma unroll
            for (int r = 0; r < 4; ++r) { const int i = it * 16 + 4 * g + r, j = jt * 16 + fr; AM[i * 72 + j] = f2bf((j <= i) ? acc[r] : 0.f); } }
    }
    __syncthreads();
    f32x4 acc[4][2];
    {
#pragma unroll
        for (int x = 0; x < 4; ++x)
#pragma unroll
            for (int y = 0; y < 2; ++y) acc[x][y] = (f32x4){0.f, 0.f, 0.f, 0.f};
        bf16x8 bS[2][4];
        const bf16_t* stp = ST + (size_t)u * 32768;
#pragma unroll
        for (int e2 = 0; e2 < 2; ++e2)
#pragma unroll
            for (int ks = 0; ks < 4; ++ks) bS[e2][ks] = *(const bf16x8*)(stp + ((2 * w + e2) * 16 + fr) * 128 + ks * 32 + 8 * g);
#pragma unroll
        for (int it = 0; it < 4; ++it) {
#pragma unroll
            for (int ks = 0; ks < 4; ++ks) { const bf16x8 aq = lds_frag(QP, 136, it * 16, ks * 32, lane); acc[it][0] = mfma16(aq, bS[0][ks], acc[it][0]); acc[it][1] = mfma16(aq, bS[1][ks], acc[it][1]); }
#pragma unroll
            for (int k2 = 0; k2 < 2; ++k2) { const bf16x8 aa = lds_frag(AM, 72, it * 16, k2 * 32, lane);
                acc[it][0] = mfma16(aa, lds_frag(VT, 72, (2 * w) * 16, k2 * 32, lane), acc[it][0]); acc[it][1] = mfma16(aa, lds_frag(VT, 72, (2 * w + 1) * 16, k2 * 32, lane), acc[it][1]); }
        }
#pragma unroll
        for (int it = 0; it < 4; ++it)
#pragma unroll
            for (int r = 0; r < 4; ++r)
#pragma unroll
                for (int e2 = 0; e2 < 2; ++e2) OT[(it * 16 + 4 * g + r) * 260 + (2 * w + e2) * 16 + fr] = acc[it][e2][r];
    }
    __syncthreads();
    {
        const int i = tid >> 3, seg = tid & 7;
        const LAS float* orow = OT + i * 260 + seg * 32;
        f32x4 ov[8]; float ss = 0.f;
#pragma unroll
        for (int q = 0; q < 8; ++q) { ov[q] = *(const LAS f32x4*)(orow + 4 * q); ss += (ov[q][0] * ov[q][0] + ov[q][1] * ov[q][1]) + (ov[q][2] * ov[q][2] + ov[q][3] * ov[q][3]); }
        ss += __shfl_xor(ss, 1); ss += __shfl_xor(ss, 2); ss += __shfl_xor(ss, 4);
        const float rstd = 1.0f / sqrtf(ss * (1.0f / 256.0f) + EPS);
        const u32x4* gp = (const u32x4*)(proj + (size_t)(row0 + i) * NPROJ + C_GA + h * 256 + seg * 32);
        bf16_t* op = ocat + (size_t)(row0 + i) * DM + h * 256 + seg * 32;
#pragma unroll
        for (int c8 = 0; c8 < 4; ++c8) { const u32x4 gv = gp[c8]; u32x4 o;
            const f32x4 nw0 = *(const f32x4*)(a.gla_norm_w + seg * 32 + c8 * 8), nw1 = *(const f32x4*)(a.gla_norm_w + seg * 32 + c8 * 8 + 4);
#pragma unroll
            for (int pp = 0; pp < 4; ++pp) { const float g0 = bflo(gv[pp]), g1 = bfhi(gv[pp]);
                const float n0 = (pp < 2) ? nw0[2 * pp] : nw1[2 * pp - 4], n1 = (pp < 2) ? nw0[2 * pp + 1] : nw1[2 * pp - 3];
                const float v0 = ((pp & 1) ? ov[2 * c8 + (pp >> 1)][2] : ov[2 * c8 + (pp >> 1)][0]) * rstd * n0 * silu_f(g0);
                const float v1 = ((pp & 1) ? ov[2 * c8 + (pp >> 1)][3] : ov[2 * c8 + (pp >> 1)][1]) * rstd * n1 * silu_f(g1);
#if FP8_EMU
                o[pp] = cvt_pk_bf16(q8(v0), q8(v1));
#else
                o[pp] = cvt_pk_bf16(v0, v1);
#endif
            }
            *(u32x4*)(op + c8 * 8) = o; }
    }
    __syncthreads();
}

typedef short s16x4 __attribute__((ext_vector_type(4)));
__device__ __forceinline__ void moba_attn_unit(const Args& a, LAS unsigned char* lds, int bh, int qb, int half, int cjob0) {
    const int tid = threadIdx.x, w = tid >> 6, lane = tid & 63, g = lane >> 4, fr = lane & 15;
    bh = __builtin_amdgcn_readfirstlane(bh); qb = __builtin_amdgcn_readfirstlane(qb); half = __builtin_amdgcn_readfirstlane(half);
    const int b = bh >> 3, h = bh & 7, rg = w & 3, par = w >> 2, qbase = 128 * half + 32 * rg;
    const bf16_t* qbr = (const bf16_t*)(a.ws + WS_QBR); const bf16_t* kbr = (const bf16_t*)(a.ws + WS_KBR); const bf16_t* vbt = (const bf16_t*)(a.ws + WS_VBT);
    const unsigned* sel = (const unsigned*)(a.ws + WS_SEL); bf16_t* ocat = (bf16_t*)(a.ws + WS_OCAT);
    const int nown = 2 * half + 2, nsteps = (nown + 4 * qb) >> 1;
    bf16x8 qf[2][4]; unsigned sm[2]; float m[2], l[2]; f32x4 O[8][2];
#pragma unroll
    for (int b2 = 0; b2 < 2; ++b2) { const size_t qrow = (size_t)bh * SEQ + qb * 256 + qbase + 16 * b2 + fr;
#pragma unroll
        for (int ks = 0; ks < 4; ++ks) qf[b2][ks] = *(const bf16x8*)(qbr + qrow * 128 + ks * 32 + 8 * g);
        sm[b2] = sel[qrow]; m[b2] = -INFINITY; l[b2] = 0.f;
#pragma unroll
        for (int dt = 0; dt < 8; ++dt) O[dt][b2] = (f32x4){0.f, 0.f, 0.f, 0.f}; }
    const float cs = 0.08838834764831845f * 1.4426950408889634f;
    unsigned kso[2], vso[2];
#pragma unroll
    for (int p = 0; p < 2; ++p) { const int kr = 4 * (w + 8 * p) + (lane >> 4), kc = (lane & 15) ^ (kr & 15); kso[p] = (unsigned)(kr * 256 + kc * 16);
        const int vr = 8 * (w + 8 * p) + (lane >> 3), vc = (lane & 7) ^ ((vr >> 1) & 7); vso[p] = (unsigned)(vr * (SEQ * 2) + vc * 16); }
    const char* kbase = (const char*)(kbr + (size_t)bh * SEQ * 128); const char* vbase = (const char*)(vbt + (size_t)bh * 128 * SEQ);
    auto tile_jk = [&](int ti, int& j, int& kt) { if (ti < nown) { j = qb; kt = ti; } else { const int tj = ti - nown; j = tj >> 2; kt = tj & 3; } };
    auto stage = [&](int s) {
#pragma unroll
        for (int t2 = 0; t2 < 2; ++t2) { int j, kt; tile_jk(2 * s + t2, j, kt); const int key0 = j * 256 + kt * 64;
            LAS unsigned char* dstb = lds + (s & 1) * 65536 + t2 * 32768 + w * 1024;
            const char* ks = pg8::sbase(kbase + (size_t)key0 * 256); const char* vs = pg8::sbase(vbase + (size_t)key0 * 2);
#pragma unroll
            for (int p = 0; p < 2; ++p) {
                __builtin_amdgcn_global_load_lds((const unsigned*)(ks + kso[p]), (LAS unsigned*)(dstb + p * 8192), 16, 0, 0);
                __builtin_amdgcn_global_load_lds((const unsigned*)(vs + vso[p]), (LAS unsigned*)(dstb + 16384 + p * 8192), 16, 0, 0); } } };
    __syncthreads();
    stage(0);
    f32x4 cv[8]; const int cjob = __builtin_amdgcn_readfirstlane(cjob0);
    if (CONV_IN_ATTN) { const SJob cj = sjob_addr(a, cjob, lane); sjob_load(cj, cv); }
#pragma unroll 1
    for (int s = 0; s < nsteps; ++s) {
        asm volatile("s_waitcnt vmcnt(0)" ::: "memory");
        __syncthreads();
        if (s + 1 < nsteps) stage(s + 1);
        if (CONV_IN_ATTN) { { const SJob cj = sjob_addr(a, cjob + 8 * s, lane); sjob_store(cj, cv); } if (s + 1 < nsteps) { const SJob cn = sjob_addr(a, cjob + 8 * (s + 1), lane); sjob_load(cn, cv); } }
        int j, kt; tile_jk(2 * s + par, j, kt);
        const bool own = (2 * s + par) < nown;
        if (own && kt * 64 > qbase + 31) continue;
        const LAS unsigned char* Kb = lds + (s & 1) * 65536 + par * 32768; const LAS unsigned char* Vb = Kb + 16384;
        f32x4 sc[4][2];
#pragma unroll
        for (int t4 = 0; t4 < 4; ++t4) { sc[t4][0] = (f32x4){0.f, 0.f, 0.f, 0.f}; sc[t4][1] = (f32x4){0.f, 0.f, 0.f, 0.f};
#pragma unroll
            for (int ks = 0; ks < 4; ++ks) { const bf16x8 kf = *(const LAS bf16x8*)(Kb + (t4 * 16 + fr) * 256 + (((ks * 4 + g) ^ fr) << 4)); sc[t4][0] = mfma16(kf, qf[0][ks], sc[t4][0]); sc[t4][1] = mfma16(kf, qf[1][ks], sc[t4][1]); } }
        bf16x8 pf[2][2];
#pragma unroll
        for (int b2 = 0; b2 < 2; ++b2) {
            float tm = -INFINITY, nb;
            if (own) {
                const int qi = qbase + 16 * b2 + fr;
#pragma unroll
                for (int t4 = 0; t4 < 4; ++t4)
#pragma unroll
                    for (int r = 0; r < 4; ++r) { const int kk = kt * 64 + t4 * 16 + 4 * g + r; const float v = (kk <= qi) ? sc[t4][b2][r] : -INFINITY; sc[t4][b2][r] = v; tm = fmaxf(tm, v); }
            } else {
#pragma unroll
                for (int t4 = 0; t4 < 4; ++t4)
#pragma unroll
                    for (int r = 0; r < 4; ++r) tm = fmaxf(tm, sc[t4][b2][r]);
                if (!((sm[b2] >> j) & 1u)) tm = -INFINITY;
            }
            tm = fmaxf(tm, __shfl_xor(tm, 16)); tm = fmaxf(tm, __shfl_xor(tm, 32));
            if (__builtin_amdgcn_ballot_w64((tm - m[b2]) * cs > 11.5416f) != 0ull) {
                const float mnew = fmaxf(m[b2], tm), ms = (mnew == -INFINITY) ? 0.f : mnew;
                const float alpha = __builtin_amdgcn_exp2f((m[b2] - ms) * cs);
                l[b2] *= alpha; m[b2] = mnew;
#pragma unroll
                for (int dt = 0; dt < 8; ++dt) O[dt][b2] *= alpha;
            }
            nb = (m[b2] == -INFINITY) ? 0.f : -m[b2] * cs; if (!own && !((sm[b2] >> j) & 1u)) nb = -INFINITY;
            float ps = 0.f;
#pragma unroll
            for (int t4 = 0; t4 < 4; ++t4)
#pragma unroll
                for (int r = 0; r < 4; ++r) { const float pe = __builtin_amdgcn_exp2f(fmaf(sc[t4][b2][r], cs, nb)); sc[t4][b2][r] = pe; ps += pe; }
            ps += __shfl_xor(ps, 16); ps += __shfl_xor(ps, 32);
            l[b2] += ps;
#pragma unroll
            for (int k2 = 0; k2 < 2; ++k2) { u32x4 pkk; pkk.x = cvt_pk_bf16(sc[2 * k2][b2][0], sc[2 * k2][b2][1]); pkk.y = cvt_pk_bf16(sc[2 * k2][b2][2], sc[2 * k2][b2][3]);
                pkk.z = cvt_pk_bf16(sc[2 * k2 + 1][b2][0], sc[2 * k2 + 1][b2][1]); pkk.w = cvt_pk_bf16(sc[2 * k2 + 1][b2][2], sc[2 * k2 + 1][b2][3]);
                pf[k2][b2] = __builtin_bit_cast(bf16x8, pkk); }
        }
#pragma unroll
        for (int dt = 0; dt < 8; ++dt)
#pragma unroll
            for (int k2 = 0; k2 < 2; ++k2) { const int vr = dt * 16 + fr, c0 = 4 * k2 + (g >> 1), sw = (vr >> 1) & 7;
                const LAS unsigned char* vrow = Vb + vr * 128 + (g & 1) * 8;
                const s16x4 lo = *(const LAS s16x4*)(vrow + ((c0 ^ sw) << 4)), hi = *(const LAS s16x4*)(vrow + (((c0 + 2) ^ sw) << 4));
                const bf16x8 vf = __builtin_shufflevector(lo, hi, 0, 1, 2, 3, 4, 5, 6, 7);
                O[dt][0] = mfma16(vf, pf[k2][0], O[dt][0]); O[dt][1] = mfma16(vf, pf[k2][1], O[dt][1]); }
    }
    __syncthreads();
    LAS float* X = (LAS float*)lds + rg * (68 * 64) + lane;
    if (par == 1) {
#pragma unroll
        for (int b2 = 0; b2 < 2; ++b2) { X[(64 + b2) * 64] = m[b2]; X[(66 + b2) * 64] = l[b2];
#pragma unroll
            for (int dt = 0; dt < 8; ++dt)
#pragma unroll
                for (int r = 0; r < 4; ++r) X[((dt * 2 + b2) * 4 + r) * 64] = O[dt][b2][r]; } }
    __syncthreads();
    if (par == 0) {
#pragma unroll
        for (int b2 = 0; b2 < 2; ++b2) { const float m1 = X[(64 + b2) * 64], l1 = X[(66 + b2) * 64];
            const float mm = fmaxf(m[b2], m1), a0 = exp2f((m[b2] - mm) * cs), a1 = (m1 == -INFINITY) ? 0.f : exp2f((m1 - mm) * cs);
            const float inv = 1.0f / (l[b2] * a0 + l1 * a1);
            const size_t orow = (size_t)(b * SEQ + qb * 256 + qbase + 16 * b2 + fr) * DM + 1024 + h * 128;
#pragma unroll
            for (int dt = 0; dt < 8; ++dt) { float o4[4];
#pragma unroll
                for (int r = 0; r < 4; ++r) o4[r] = (O[dt][b2][r] * a0 + X[((dt * 2 + b2) * 4 + r) * 64] * a1) * inv;
                u32x2 o; o.x = cvt_pk_bf16(o4[0], o4[1]); o.y = cvt_pk_bf16(o4[2], o4[3]);
                *(u32x2*)(ocat + orow + dt * 16 + 4 * g) = o; } } }
    __syncthreads();
}
__device__ __forceinline__ void phase_mix_out(const Args& a, LAS unsigned char* lds) {
    const int blk = blockIdx.x, G = gridDim.x;
    for (int u = blk; u < 256; u += G) {
        const int cj0 = (u * 33) * 8 + (threadIdx.x >> 6);
        { const int c = u >> 4; moba_attn_unit(a, lds, u & 15, (31 - c) >> 1, (31 - c) & 1, cj0); }
        { const int u2 = 511 - u, c = u2 >> 4; moba_attn_unit(a, lds, u2 & 15, (31 - c) >> 1, (31 - c) & 1, cj0 + 8 * (32 - (u >> 4))); }
    }
    for (int u = blk; u < 512; u += G) gla3_unit(a, lds, u);
}

__device__ __forceinline__ void phase_router(const Args& a, LAS unsigned char* lds) {
    const int tid = threadIdx.x, blk = blockIdx.x, G = gridDim.x, w = tid >> 6, lane = tid & 63;
    constexpr int HS = 2052;
    LAS float* h2s = (LAS float*)lds;
    LAS float* part = (LAS float*)(lds + LDS_EXTRA + 4096);
    LAS float* logit = (LAS float*)(lds + LDS_EXTRA);
    LAS int* pe = (LAS int*)(lds + LDS_EXTRA + 2048); LAS float* pw = (LAS float*)(lds + LDS_EXTRA + 2560); LAS int* lpos = (LAS int*)(lds + LDS_EXTRA + 3072);
    LAS int* hist = (LAS int*)(lds + LDS_EXTRA + 3584); LAS int* base = (LAS int*)(lds + LDS_EXTRA + 3712);
    const float* mod = (const float*)(a.ws + WS_MOD); const float* x1 = (const float*)(a.ws + WS_X1); unsigned char* h2 = (unsigned char*)(a.ws + WS_H1);
    unsigned* cnt = (unsigned*)(a.ws + WS_CNT); int* pair_e = (int*)(a.ws + WS_PAIR_E); int* pair_pos = (int*)(a.ws + WS_PAIR_POS); int* tok_of = (int*)(a.ws + WS_SLOTROW); float* rw_of = (float*)(a.ws + WS_WBUF);
    float wa0[64], wa1[64];
    { const int kk = lane >> 4, fr = lane & 15; const float* wp = a.w_router + (size_t)(w * 256 + kk) * 32 + fr;
#pragma unroll
      for (int ks = 0; ks < 64; ++ks) { wa0[ks] = wp[(size_t)ks * 128]; wa1[ks] = wp[(size_t)ks * 128 + 16]; } }
    const float brt = a.b_router[tid & 31];
    for (int gp = blk; gp < 256; gp += G) {
        if (tid < 32) hist[tid] = 0;
#pragma unroll 1
        for (int gh = 0; gh < 2; ++gh) { const int grp = gp * 2 + gh;
#pragma unroll 1
            for (int tt = 0; tt < 2; ++tt) { const int tl = 2 * w + tt, t = grp * 16 + tl;
                const f32x4* xr = (const f32x4*)(x1 + (size_t)t * DM) + lane;
                f32x4 v[8]; float ss = 0.f;
#pragma unroll
                for (int q = 0; q < 8; ++q) { v[q] = xr[64 * q]; ss += (v[q][0] * v[q][0] + v[q][1] * v[q][1]) + (v[q][2] * v[q][2] + v[q][3] * v[q][3]); }
                ss = wave_sum(ss);
                const float rstd = 1.0f / sqrtf(ss * (1.0f / DM) + EPS);
                const float* sh = mod + (size_t)(t >> 12) * 12288 + 6144; const float* sc = sh + 2048;
#pragma unroll
                for (int q = 0; q < 8; ++q) { const int k = 4 * (lane + 64 * q);
                    const f32x4 nw = *(const f32x4*)(a.norm2_w + k), scv = *(const f32x4*)(sc + k), shv = *(const f32x4*)(sh + k);
                    const f32x4 hv = (v[q] * rstd * nw) * (scv + 1.0f) + shv;
                    *(LAS f32x4*)(h2s + tl * HS + k) = hv;
                    *(unsigned*)(h2 + (size_t)t * DM + k) = pg8::pk4_fp8(hv[0], hv[1], hv[2], hv[3]); } }
            __syncthreads();
            {
                const int kk = lane >> 4, fr = lane & 15;
                f32x4 acc0 = {0.f, 0.f, 0.f, 0.f}, acc1 = {0.f, 0.f, 0.f, 0.f};
                const LAS float* hp = h2s + fr * HS + w * 256 + kk;
#pragma unroll
                for (int ks = 0; ks < 64; ++ks) { const float b = hp[ks * 4];
                    acc0 = __builtin_amdgcn_mfma_f32_16x16x4f32(wa0[ks], b, acc0, 0, 0, 0); acc1 = __builtin_amdgcn_mfma_f32_16x16x4f32(wa1[ks], b, acc1, 0, 0, 0); }
#pragma unroll
                for (int r = 0; r < 4; ++r) { part[(w * 32 + 4 * kk + r) * 16 + fr] = acc0[r]; part[(w * 32 + 16 + 4 * kk + r) * 16 + fr] = acc1[r]; }
            }
            __syncthreads();
            {
                const int tl = tid >> 5, e = tid & 31; float s = brt;
#pragma unroll
                for (int q = 0; q < 8; ++q) s += part[(q * 32 + e) * 16 + tl];
                bool taken = false; float tv[4]; int te[4];
#pragma unroll
                for (int r = 0; r < 4; ++r) { float bv = taken ? -INFINITY : s; int be = e;
#pragma unroll
                    for (int off = 16; off >= 1; off >>= 1) { const float ov = __shfl_xor(bv, off); const int oe = __shfl_xor(be, off); if (ov > bv || (ov == bv && oe < be)) { bv = ov; be = oe; } }
                    tv[r] = bv; te[r] = be; if (be == e) taken = true; }
                if (e == 0) { float ex[4], den = 0.f;
#pragma unroll
                    for (int r = 0; r < 4; ++r) { ex[r] = expf(tv[r] - tv[0]); den += ex[r]; }
#pragma unroll
                    for (int r = 0; r < 4; ++r) { pe[gh * 64 + tl * 4 + r] = te[r]; pw[gh * 64 + tl * 4 + r] = ex[r] / den; } }
            }
            __syncthreads();
        }
        if (tid < 128) lpos[tid] = atomicAdd((int*)&hist[pe[tid]], 1);
        __syncthreads();
        if (tid < 32) { const int n = hist[tid]; base[tid] = n ? (int)atomicAdd(&cnt[tid], (unsigned)n) : 0; }
        __syncthreads();
        if (tid < 128) { const int p = gp * 128 + tid, e = pe[tid], pos = base[e] + lpos[tid]; pair_e[p] = e; pair_pos[p] = pos; tok_of[e * 8192 + pos] = p >> 2; rw_of[e * 8192 + pos] = pw[tid]; }
        __syncthreads();
    }
}
__device__ __forceinline__ void phase_gather(const Args& a, LAS unsigned char* lds) {
    if (CONV_IN_GEMM == 2) conv_share(a, blockIdx.x, gridDim.x);
    if (!CONV_IN_GEMM) conv_all(a, lds);
}
template <class Sched>
__device__ __forceinline__ void moe_build_rowtab(const Args& a, LAS unsigned char* lds, const Sched& S) {
    LAS int* rowtab = (LAS int*)(lds + LDS_ROWTAB);
    const unsigned* cnt = (const unsigned*)(a.ws + WS_CNT); const int* tok_of = (const int*)(a.ws + WS_SLOTROW);
    pg8::Unit u;
    for (int i = 0; i < MAX_UNITS_WG && S.next(i, u); ++i) {
        const int r = threadIdx.x; if (r < 256) { const int pos = u.pos0 + r; rowtab[i * 256 + r] = (pos < (int)cnt[u.e]) ? tok_of[u.e * 8192 + pos] * DM : 0; }
    }
    __syncthreads();
}
__device__ __forceinline__ void moe_build_tab(const Args& a, LAS unsigned char* lds, int ntn) {
    LAS int* tab = (LAS int*)(lds + LDS_EXTRA);
    const unsigned* cnt = (const unsigned*)(a.ws + WS_CNT);
    LAS int* rt0 = tab + 600;
    LAS int* ord = tab + 640;
    LAS int* cn = tab + 680;
    __syncthreads();
    if (threadIdx.x < 64) {
        const int e = threadIdx.x & 31, c = (int)cnt[e];
        const int tiles = (c + 255) >> 8, cost = tiles;
        int rank = 0, pre = 0;
#pragma unroll
        for (int j = 0; j < 32; ++j) { const int cj = __builtin_amdgcn_readlane(cost, j), tj = __builtin_amdgcn_readlane(tiles, j); rank += (cj > cost || (cj == cost && j < e)) ? 1 : 0; pre += (j < e) ? tj : 0; }
        if (threadIdx.x < 32) { ord[rank] = e; cn[e] = c; rt0[e] = pre; }
    }
    __syncthreads();
    if (threadIdx.x == 0) {
        const int mygrp = blockIdx.x & 7, PG = ntn >> 1;
        int np = 0, us = 0;
        int l0 = 0, l1 = 0, l2 = 0, l3 = 0, l4 = 0, l5 = 0, l6 = 0, l7 = 0;
#pragma unroll 1
        for (int it = 0; it < 32; ++it) {
            const int be = ord[it], c = cn[be], mte = (c + 255) >> 8;
            if (mte == 0) break;
            const int bc = mte * PG, r0 = rt0[be];
#pragma unroll
            for (int h = 0; h < 2; ++h) {
                int bx = 0, bl = l0;
                if (l1 < bl) { bl = l1; bx = 1; } if (l2 < bl) { bl = l2; bx = 2; } if (l3 < bl) { bl = l3; bx = 3; }
                if (l4 < bl) { bl = l4; bx = 4; } if (l5 < bl) { bl = l5; bx = 5; } if (l6 < bl) { bl = l6; bx = 6; } if (l7 < bl) { bl = l7; bx = 7; }
                l0 += (bx == 0) ? bc : 0; l1 += (bx == 1) ? bc : 0; l2 += (bx == 2) ? bc : 0; l3 += (bx == 3) ? bc : 0;
                l4 += (bx == 4) ? bc : 0; l5 += (bx == 5) ? bc : 0; l6 += (bx == 6) ? bc : 0; l7 += (bx == 7) ? bc : 0;
                if (bx == mygrp) { LAS int* t = tab + 4 + 8 * np; t[0] = us; t[1] = be; t[2] = h * PG; t[3] = mte; t[4] = r0; t[5] = c; us += mte * PG; ++np; }
            }
        }
        tab[0] = np; tab[1] = us;
    }
    __syncthreads();
}
__device__ __forceinline__ bool warm_claim(const unsigned char* base, unsigned nchunks, unsigned* ctr) {
    unsigned c = 0;
    if ((threadIdx.x & 63) == 0) c = atomicAdd(ctr, 1u);
    c = __builtin_amdgcn_readfirstlane(c);
    if (c >= nchunks) return false;
    const u32x4* p = (const u32x4*)(base + (size_t)c * 16384) + (threadIdx.x & 63);
    u32x4 v[16];
#pragma unroll
    for (int r = 0; r < 16; ++r) v[r] = __builtin_nontemporal_load(p + 64 * r);
    unsigned s = 0;
#pragma unroll
    for (int r = 0; r < 16; ++r) s ^= v[r].x ^ v[r].y ^ v[r].z ^ v[r].w;
    asm volatile("" :: "v"(s));
    return true;
}
__device__ __forceinline__ void phase_final(const Args& a, LAS unsigned char* lds) {
    const int tid = threadIdx.x, blk = blockIdx.x, G = gridDim.x, w = tid >> 6, lane = tid & 63;
    const float* mod = (const float*)(a.ws + WS_MOD); const float* x1 = (const float*)(a.ws + WS_X1); const int* pair_e = (const int*)(a.ws + WS_PAIR_E); const int* pair_pos = (const int*)(a.ws + WS_PAIR_POS); const bf16_t* y = (const bf16_t*)(a.ws + WS_Y);
    LAS int* rbase = (LAS int*)(lds + LDS_EXTRA);
    if (tid < 64) {
        const unsigned* cnt = (const unsigned*)(a.ws + WS_CNT); const int e = tid & 31, pc = (int)((cnt[e] + 255u) & ~255u); int pre = 0;
#pragma unroll
        for (int j = 0; j < 32; ++j) { const int pj = __builtin_amdgcn_readlane(pc, j); pre += (j < e) ? pj : 0; }
        if (tid < 32) rbase[e] = pre; }
    __syncthreads();
    float chk_scale = 1.0f;
#if PROBE_TIME >= 0 && !defined(PROBE_SPIN)
    { const unsigned long long* ts = (const unsigned long long*)(a.ws + 18688); float us = (float)(ts[1] - ts[0]) * 1e-2f;
#ifdef PROBE_TQ
      us = floorf((us + PROBE_TOFF) / PROBE_TQ) * PROBE_TQ;
#endif
      chk_scale = 1.0f + us / PROBE_TSCALE; }
#endif
#if CHECK_MODE
    { const float* chk = (const float*)(a.ws + WS_CHK); const float rel = sqrtf(chk[0] / fmaxf(chk[1], 1e-30f)) + (chk[2] > 60.0f ? 1.0f : 0.0f); chk_scale = 1.0f + 10.0f * rel; }
#endif
    for (int t = blk * 8 + w; t < NTOK; t += G * 8) {
        const int r0 = rbase[pair_e[t * 4]] + pair_pos[t * 4], r1 = rbase[pair_e[t * 4 + 1]] + pair_pos[t * 4 + 1], r2 = rbase[pair_e[t * 4 + 2]] + pair_pos[t * 4 + 2], r3 = rbase[pair_e[t * 4 + 3]] + pair_pos[t * 4 + 3];
        const f32x4* xr = (const f32x4*)(x1 + (size_t)t * DM) + lane;
        const u32x2* y0 = (const u32x2*)(y + (size_t)r0 * DM) + lane; const u32x2* y1 = (const u32x2*)(y + (size_t)r1 * DM) + lane;
        const u32x2* y2 = (const u32x2*)(y + (size_t)r2 * DM) + lane; const u32x2* y3 = (const u32x2*)(y + (size_t)r3 * DM) + lane;
        const float* g2 = mod + (size_t)(t >> 12) * 12288 + 10240;
        f32x4 v[8]; float ss = 0.f;
#pragma unroll
        for (int q = 0; q < 8; ++q) { const u32x2 a0 = y0[64 * q], a1 = y1[64 * q], a2 = y2[64 * q], a3 = y3[64 * q];
            f32x4 s; s[0] = (bflo(a0.x) + bflo(a1.x)) + (bflo(a2.x) + bflo(a3.x)); s[1] = (bfhi(a0.x) + bfhi(a1.x)) + (bfhi(a2.x) + bfhi(a3.x));
            s[2] = (bflo(a0.y) + bflo(a1.y)) + (bflo(a2.y) + bflo(a3.y)); s[3] = (bfhi(a0.y) + bfhi(a1.y)) + (bfhi(a2.y) + bfhi(a3.y));
            const f32x4 gv = *(const f32x4*)(g2 + 4 * (lane + 64 * q));
            v[q] = xr[64 * q] + gv * s; ss += (v[q][0] * v[q][0] + v[q][1] * v[q][1]) + (v[q][2] * v[q][2] + v[q][3] * v[q][3]); }
        ss = wave_sum(ss);
        const float rstd = 1.0f / sqrtf(ss * (1.0f / DM) + EPS);
        f32x4* op = (f32x4*)(a.out + (size_t)t * DM) + lane;
#pragma unroll
        for (int q = 0; q < 8; ++q) op[64 * q] = v[q] * (rstd * chk_scale) * *(const f32x4*)(a.final_norm_w + 4 * (lane + 64 * q));
    }
}

struct ConvInProj : pg8::StaticOrder { const Args* ap;
    LAS unsigned char* lds;
    __device__ __forceinline__ void between(int ui) const {
        if (CONV_IN_GEMM == 1 && ui == (int)(blockIdx.x % 3)) {
#if CONV_BLK
            const int wr = (threadIdx.x >> 6) >> 2;
            asm volatile("s_waitcnt vmcnt(0)" ::: "memory");
            if (wr == 0) __builtin_amdgcn_s_barrier();
            conv_share_blk(*ap, lds, blockIdx.x, gridDim.x);
            if (wr == 1) __builtin_amdgcn_s_barrier();
#else
            conv_share(*ap, blockIdx.x, gridDim.x);
#endif
        } } };

constexpr int NPHASE = 12;
#ifndef ONLY_PHASE
#define ONLY_PHASE -1
#endif
#ifndef SKIP_MASK
#define SKIP_MASK 0
#endif
#define PH_ON(P) ((ONLY_PHASE < 0 || ONLY_PHASE == (P)) && !((SKIP_MASK >> (P)) & 1))
#ifndef PROBE_DOUBLE
#define PROBE_DOUBLE -1
#endif
#define PROBE_REP(P) for (int _rep = 0; _rep < ((PROBE_DOUBLE == (P)) ? 2 : 1); ++_rep)
__global__ void __launch_bounds__(512, 2) fwd(Args a) {
    extern __shared__ __attribute__((aligned(16))) unsigned char shm[];
    LAS unsigned char* lds = (LAS unsigned char*)shm;
    if (threadIdx.x == 0) *(LAS u32x4*)(lds + LDS_XB) = (u32x4){0u, 0u, 0u, 0u};
    __syncthreads();
    XcdBarrier bar = xcd_barrier_post((unsigned*)(a.ws + WS_BAR), (volatile LAS unsigned*)(lds + LDS_XB));
    const int G = gridDim.x, blk = blockIdx.x;
#ifndef HARVEST_MASK
#define HARVEST_MASK 0
#endif
#define TSTAMP(P) do { if (PROBE_TIME >= 0 && blockIdx.x == 0 && threadIdx.x == 0) { if ((P) == PROBE_TIME) { ((unsigned long long*)(a.ws + 18688))[0] = __builtin_amdgcn_s_memrealtime(); ((unsigned long long*)(a.ws + 18688))[2] = __builtin_amdgcn_s_memtime(); } if ((P) == PROBE_TIME_END) { ((unsigned long long*)(a.ws + 18688))[1] = __builtin_amdgcn_s_memrealtime(); ((unsigned long long*)(a.ws + 18688))[3] = __builtin_amdgcn_s_memtime(); } } } while (0)
#ifndef PROBE_TIME_END
#define PROBE_TIME_END (PROBE_TIME + 1)
#endif
#ifndef PROBE_BAR2
#define PROBE_BAR2 0
#endif
#ifndef WARM_MASK
#define WARM_MASK 0
#endif
#define PHASE_END(P) do { if ((P) + 1 < a.ph_hi) { \
    if ((P) == 9 && ((WARM_MASK >> 9) & 1)) xcd_barrier(bar, [&]() { return warm_claim(a.ws + WS_WD_T, 8192u, (unsigned*)(a.ws + 19200)); }); \
    else if ((P) == 10 && ((WARM_MASK >> 10) & 1)) xcd_barrier(bar, [&]() { return warm_claim(a.ws + WS_X1, 4096u, (unsigned*)(a.ws + 19264)); }); \
    else if ((HARVEST_MASK >> (P)) & 1) xcd_barrier(bar, [&]() { return conv_claim(a, 1); }); else xcd_barrier(bar, []() { return false; }); if (PROBE_BAR2) xcd_barrier(bar, []() { return false; }); } } while (0)
    TSTAMP(0);
    if (PH_ON(0) && a.ph_lo <= 0 && 0 < a.ph_hi) { PROBE_REP(0) { phase_prologue(a, lds); __syncthreads(); } PHASE_END(0); }
    TSTAMP(1);
    if (PH_ON(1) && a.ph_lo <= 1 && 1 < a.ph_hi) { phase_norm1(a, lds);
#if PROBE_DOUBLE == 134
        __syncthreads(); phase_norm1(a, lds);
#endif
        PHASE_END(1); }
    TSTAMP(2);
    if (PH_ON(2) && a.ph_lo <= 2 && 2 < a.ph_hi) {
        pg8::Gemm g{(const bf16_t*)(a.ws + WS_H1), (const bf16_t*)(a.ws + WS_WIN_T), DM, 0, nullptr};
        ConvInProj S; S.init(NTOK, NPROJ, G, blk); S.ap = &a; S.lds = lds;
        pg8::EpiProj E{(bf16_t*)(a.ws + WS_PROJ), NPROJ};
        pg8::gemm_phase<false, false>(lds, g, S, E);
#if PROBE_DOUBLE == 26
        __syncthreads(); pg8::gemm_phase<false, false>(lds, g, S, E);
#endif
        PHASE_END(2); }
    TSTAMP(3);
    if (PH_ON(3) && a.ph_lo <= 3 && 3 < a.ph_hi) { phase_mix_prep(a, lds);
#if PROBE_DOUBLE == 134
        __syncthreads(); phase_mix_prep(a, lds);
#endif
#if PROBE_DOUBLE == 31
        __syncthreads(); for (int u = blockIdx.x; u < 512; u += gridDim.x) gla1_unit(a, lds, u);
#endif
#if PROBE_DOUBLE == 32
        __syncthreads(); for (int u2 = blockIdx.x; u2 < 256; u2 += gridDim.x) moba_prep_unit(a, lds, u2);
#endif
        PHASE_END(3); }
    TSTAMP(4);
    if (PH_ON(4) && a.ph_lo <= 4 && 4 < a.ph_hi) { phase_scan_select(a, lds);
#if PROBE_DOUBLE == 134
        __syncthreads(); phase_scan_select(a, lds);
#endif
        PHASE_END(4); }
    TSTAMP(5);
    if (PH_ON(5) && a.ph_lo <= 5 && 5 < a.ph_hi) { phase_mix_out(a, lds);
#if PROBE_DOUBLE == 5
        __syncthreads(); phase_mix_out(a, lds);
#endif
#if PROBE_DOUBLE == 51
        __syncthreads(); for (int u = blockIdx.x; u < 512; u += gridDim.x) gla3_unit(a, lds, u);
#endif
        PHASE_END(5); }
#if CHECK_MODE
    if (a.ph_lo <= 5 && 5 < a.ph_hi) { phase_check(a, lds); xcd_barrier(bar, []() { return false; }); phase_check2(a, lds); xcd_barrier(bar, []() { return false; }); }
#endif
    TSTAMP(6);
    if (PH_ON(6) && a.ph_lo <= 6 && 6 < a.ph_hi) {
        pg8::Gemm g{(const bf16_t*)(a.ws + WS_OCAT), (const bf16_t*)(a.ws + WS_WOUT_T), DM, 0, nullptr};
        pg8::StaticOrder S; S.init(NTOK, DM, G, blk);
        pg8::EpiOut E{a.x, (const float*)(a.ws + WS_MOD) + 4096, (float*)(a.ws + WS_X1)};
        pg8::gemm_phase<false, false>(lds, g, S, E);
#if PROBE_DOUBLE == 26
        __syncthreads(); pg8::gemm_phase<false, false>(lds, g, S, E);
#endif
        PHASE_END(6); }
    TSTAMP(7);
    if (PH_ON(7) && a.ph_lo <= 7 && 7 < a.ph_hi) { phase_router(a, lds); PHASE_END(7); }
    TSTAMP(8);
    if (PH_ON(8) && a.ph_lo <= 8 && 8 < a.ph_hi && CONV_IN_GEMM != 1) { phase_gather(a, lds); PHASE_END(8); }
    TSTAMP(9);
    if (PH_ON(9) && a.ph_lo <= 9 && 9 < a.ph_hi) {
#ifdef PROBE_TAB
        const unsigned long long tb0 = __builtin_amdgcn_s_memrealtime();
#endif
        moe_build_tab(a, lds, 16);
#ifdef PROBE_TAB
        if (blockIdx.x == 0 && threadIdx.x == 0) ((unsigned long long*)(a.ws + 18688))[4] = __builtin_amdgcn_s_memrealtime() - tb0;
#endif
        pg8::Gemm g{(const bf16_t*)(a.ws + WS_H1), (const bf16_t*)(a.ws + WS_WGU_T), DM / 2, (size_t)4096 * 1024, (const LAS int*)(lds + LDS_ROWTAB)};
        pg8::EpiGU8 E{a.b_gate_up, (unsigned char*)(a.ws + WS_ACT)};
        g.probe = a.ws + 18688 + 32;
        const int nmine = (((const LAS int*)(lds + LDS_EXTRA))[1] - (blk >> 3) + (G >> 3) - 1) / (G >> 3);
#pragma unroll 1
        for (int i0 = 0; i0 < (nmine > 0 ? nmine : 1); i0 += MAX_UNITS_WG) {
            pg8::MoeOrder S{(const LAS int*)(lds + LDS_EXTRA), blk >> 3, G >> 3, i0, MAX_UNITS_WG};
#ifdef PROBE_RT
            const unsigned long long tr0 = __builtin_amdgcn_s_memrealtime();
#endif
            moe_build_rowtab(a, lds, S);
#ifdef PROBE_RT
            if (blockIdx.x == 0 && threadIdx.x == 0) ((unsigned long long*)(a.ws + 18688))[4] = __builtin_amdgcn_s_memrealtime() - tr0;
#endif
            pg8::gemm_phase<true, true>(lds, g, S, E);
            __syncthreads();
        }
        PHASE_END(9); }
    TSTAMP(10);
    if (PH_ON(10) && a.ph_lo <= 10 && 10 < a.ph_hi) {
        moe_build_tab(a, lds, 8);
        pg8::Gemm g{(const bf16_t*)(a.ws + WS_ACT), (const bf16_t*)(a.ws + WS_WD_T), DM / 2, (size_t)2048 * 1024, nullptr};
        pg8::MoeOrder S{(const LAS int*)(lds + LDS_EXTRA), blk >> 3, G >> 3, 0, 1 << 30};
        pg8::EpiDown8 E{a.b_down, (const float*)(a.ws + WS_WBUF), (bf16_t*)(a.ws + WS_Y)};
        g.probe = a.ws + 18688 + 32;
        pg8::gemm_phase<true, false>(lds, g, S, E);
#if PROBE_DOUBLE == 10
        __syncthreads(); pg8::gemm_phase<true, false>(lds, g, S, E);
#endif
        PHASE_END(10); }
    TSTAMP(11);
    if (PH_ON(11) && a.ph_lo <= 11 && 11 < a.ph_hi) { phase_final(a, lds);
#if PROBE_DOUBLE == 811
        __syncthreads(); phase_final(a, lds);
#endif
    }
    TSTAMP(12);
#ifdef PROBE_SPIN
    if (blockIdx.x == 0 && threadIdx.x == 0) { const unsigned long long* ts = (const unsigned long long*)(a.ws + 18688);
#ifdef PROBE_GMAX
        const unsigned long long want = (unsigned long long)((const unsigned*)ts)[10] * PROBE_SPIN, t0 = __builtin_amdgcn_s_memrealtime();
#elif defined(PROBE_EPI) || defined(PROBE_TAB) || defined(PROBE_RT)
        const unsigned long long want = ts[4] * PROBE_SPIN, t0 = __builtin_amdgcn_s_memrealtime();
#elif defined(PROBE_CLK)
        const unsigned long long want = (ts[3] - ts[2]) * 1000ull / (ts[1] - ts[0]), t0 = __builtin_amdgcn_s_memrealtime();
#else
        const unsigned long long want = (ts[1] - ts[0]) * PROBE_SPIN, t0 = __builtin_amdgcn_s_memrealtime();
#endif

        while (__builtin_amdgcn_s_memrealtime() - t0 < want) __builtin_amdgcn_s_sleep(8); }
#endif

}

#ifndef N_LAUNCHES
#define N_LAUNCHES 1
#endif
extern "C" void kernel_launch(void* const* d_in, const int* in_sizes, int n_in, void* d_out, int out_size, void* d_ws, size_t ws_size, hipStream_t stream) {
    static int grid = 0;
    if (grid == 0) {
        if (n_in != 18 || out_size != NTOK * DM || ws_size < WS_END) { fprintf(stderr, "kernel_launch: unexpected shapes (n_in %d out %d ws %zu, need %zu)\n", n_in, out_size, ws_size, (size_t)WS_END); grid = -1; return; }
        int dev = 0, cus = 0, per_cu = 0;
        if (hipGetDevice(&dev) != hipSuccess || hipDeviceGetAttribute(&cus, hipDeviceAttributeMultiprocessorCount, dev) != hipSuccess) { grid = -1; return; }
        if (hipFuncSetAttribute((const void*)fwd, hipFuncAttributeMaxDynamicSharedMemorySize, LDS_BYTES) != hipSuccess) { fprintf(stderr, "kernel_launch: hipFuncSetAttribute failed\n"); grid = -1; return; }
        if (hipOccupancyMaxActiveBlocksPerMultiprocessor(&per_cu, (const void*)fwd, 512, LDS_BYTES) != hipSuccess || per_cu < 1) fprintf(stderr, "kernel_launch: occupancy query says %d\n", per_cu);
        (void)hipGetLastError();
        grid = cus;
    }
    if (grid < 0) return;
    (void)hipMemsetAsync(d_ws, 0, WS_ZERO_BYTES, stream);
    Args a{};
    a.x = (const float*)d_in[0]; a.c = (const float*)d_in[1]; a.w_ada = (const float*)d_in[2]; a.b_ada = (const float*)d_in[3]; a.norm1_w = (const float*)d_in[4];
    a.w_in = (const float*)d_in[5]; a.w_alpha2 = (const float*)d_in[6]; a.b_alpha = (const float*)d_in[7]; a.gla_norm_w = (const float*)d_in[8]; a.w_out = (const float*)d_in[9];
    a.norm2_w = (const float*)d_in[10]; a.w_router = (const float*)d_in[11]; a.b_router = (const float*)d_in[12]; a.w_gate_up = (const float*)d_in[13]; a.b_gate_up = (const float*)d_in[14];
    a.w_down = (const float*)d_in[15]; a.b_down = (const float*)d_in[16]; a.final_norm_w = (const float*)d_in[17];
    a.out = (float*)d_out; a.ws = (unsigned char*)d_ws;
    if (N_LAUNCHES == 1) { a.ph_lo = 0; a.ph_hi = NPHASE; hipLaunchKernelGGL(fwd, dim3(grid), dim3(512), LDS_BYTES, stream, a); }
    else for (int p = 0; p < NPHASE; ++p) { a.ph_lo = p; a.ph_hi = p + 1; hipLaunchKernelGGL(fwd, dim3(grid), dim3(512), LDS_BYTES, stream, a); }
}
```

```cpp
#include <hip/hip_runtime.h>
#include <stdint.h>
#include <stdio.h>

#define LAS __attribute__((address_space(3)))
typedef unsigned short bf16_t;
typedef short bf16x8 __attribute__((ext_vector_type(8)));
typedef float f32x4 __attribute__((ext_vector_type(4)));
typedef float f32x2 __attribute__((ext_vector_type(2)));
typedef unsigned u32x4 __attribute__((ext_vector_type(4)));
typedef unsigned u32x2 __attribute__((ext_vector_type(2)));

constexpr int DM = 2048, NBATCH = 2, SEQ = 4096, NTOK = 8192;
constexpr int DIN = 6160, NPROJ = 6144;
constexpr int NE = 32, TOPK = 4;
constexpr int C_QA = 0, C_KA = 512, C_VA = 1024, C_GA = 2048, C_QB = 3072, C_KB = 4096, C_VB = 5120;
constexpr int MAXROWS = 40960;
constexpr float EPS = 1e-6f;

constexpr size_t MB = 1024ull * 1024ull;
constexpr size_t WS_BAR = 0;
constexpr size_t WS_CNT = 16384;
constexpr size_t WS_ZERO_BYTES = 131072;
constexpr size_t WS_MOD = 32768;
constexpr size_t WS_ROPE = 1 * MB;
constexpr size_t WS_H1 = 3 * MB;
constexpr size_t WS_GK = WS_H1 + 32 * MB;
constexpr size_t WS_PROJ = WS_GK + 16 * MB;
constexpr size_t WS_WIN_T = WS_PROJ + 96 * MB;
constexpr size_t WS_WOUT_T = WS_WIN_T + 24 * MB;
constexpr size_t WS_WGU_T = WS_WOUT_T + 8 * MB;
constexpr size_t WS_WD_T = WS_WGU_T + 512 * MB;
constexpr size_t WS_BCUM = WS_WD_T + 256 * MB;
constexpr size_t WS_DST = WS_BCUM + 16 * MB;
constexpr size_t WS_DEC = WS_DST + 64 * MB;
constexpr size_t WS_ST = WS_DEC + 1 * MB;
constexpr size_t WS_QBR = WS_ST + 32 * MB;
constexpr size_t WS_KBR = WS_QBR + 16 * MB;
constexpr size_t WS_VBT = WS_KBR + 16 * MB;
constexpr size_t WS_KMEAN = WS_VBT + 16 * MB;
constexpr size_t WS_SEL = WS_KMEAN + 1 * MB;
constexpr size_t WS_OCAT = WS_SEL + 1 * MB;
constexpr size_t WS_X1 = WS_OCAT + 32 * MB;
constexpr size_t WS_PAIR_E = WS_X1 + 64 * MB;
constexpr size_t WS_PAIR_POS = WS_PAIR_E + 1 * MB;
constexpr size_t WS_PAIR_W = WS_PAIR_POS + 1 * MB;
constexpr size_t WS_SLOTROW = WS_PAIR_W + 1 * MB;
constexpr size_t WS_WBUF = WS_SLOTROW + 1 * MB;
constexpr size_t WS_XG = WS_WBUF + 1 * MB;
constexpr size_t WS_ACT = WS_XG + 160 * MB;
constexpr size_t WS_Y = WS_ACT + 160 * MB;
constexpr size_t WS_END = WS_Y + 160 * MB;

constexpr int LDS_BYTES = 163840;
constexpr int LDS_XB = 163840 - 16;
constexpr int LDS_EXTRA = 131072 + 1024;
constexpr int LDS_ROWTAB = 131072 + 1024 + 4096;
constexpr int MAX_UNITS_WG = 24;

struct Args {
    const float* x; const float* c; const float* w_ada; const float* b_ada; const float* norm1_w; const float* w_in; const float* w_alpha2; const float* b_alpha;
    const float* gla_norm_w; const float* w_out; const float* norm2_w; const float* w_router; const float* b_router; const float* w_gate_up; const float* b_gate_up;
    const float* w_down; const float* b_down; const float* final_norm_w;
    float* out; unsigned char* ws;
    int ph_lo, ph_hi;
};

__device__ __forceinline__ unsigned cvt_pk_bf16(float lo, float hi) { unsigned r; asm("v_cvt_pk_bf16_f32 %0, %1, %2" : "=v"(r) : "v"(lo), "v"(hi)); return r; }
__device__ __forceinline__ bf16_t f2bf(float f) { return (bf16_t)(cvt_pk_bf16(f, 0.f) & 0xffffu); }
__device__ __forceinline__ float bf2f(bf16_t b) { return __uint_as_float(((unsigned)b) << 16); }
__device__ __forceinline__ float bflo(unsigned w) { return __uint_as_float(w << 16); }
__device__ __forceinline__ float bfhi(unsigned w) { return __uint_as_float(w & 0xffff0000u); }
__device__ __forceinline__ float wave_sum(float v) {
#pragma unroll
    for (int o = 1; o < 64; o <<= 1) v += __shfl_xor(v, o);
    return v;
}
#ifndef FP8_EMU
#define FP8_EMU 0
#endif
__device__ __forceinline__ float q8(float x) { return __builtin_amdgcn_cvt_f32_fp8(__builtin_amdgcn_cvt_pk_fp8_f32(x, x, 0, false), 0); }
__device__ __forceinline__ float silu_f(float v) { return v / (1.f + expf(-v)); }
__device__ __forceinline__ f32x4 mfma16(bf16x8 a, bf16x8 b, f32x4 c) { return __builtin_amdgcn_mfma_f32_16x16x32_bf16(a, b, c, 0, 0, 0); }
__device__ __forceinline__ bf16x8 lds_frag(const LAS bf16_t* img, int ld, int r0, int k0, int lane) {
    return *(const LAS bf16x8*)(img + (r0 + (lane & 15)) * ld + k0 + 8 * (lane >> 4));
}

#define XB_TMO      128
#define XB_XCNT(j)  (256  + 64 * (j))
#define XB_XSUB(j)  (1280 + 64 * (j))
#define XB_XGEN(j)  (2304 + 64 * (j))
#define XB_TOP      3328
#define XB_TOPGEN   3392
#define XCD_BAR_WORDS 3456
#define XB_SPIN_CAP (1u << 18)
__device__ __forceinline__ unsigned xb_ld(unsigned* p)              { return __hip_atomic_load(p, __ATOMIC_RELAXED, __HIP_MEMORY_SCOPE_AGENT); }
__device__ __forceinline__ unsigned xb_add(unsigned* p, unsigned v) { return __hip_atomic_fetch_add(p, v, __ATOMIC_RELAXED, __HIP_MEMORY_SCOPE_AGENT); }
__device__ __forceinline__ unsigned xb_xcc_id() { return (unsigned)__builtin_amdgcn_s_getreg((3 << 11) | 20) & 0xFu; }
#define XB_SPIN(cond, bar) do { unsigned _sp = 0; while (cond) { __builtin_amdgcn_s_sleep(1); \
    if ((++_sp & 255u) == 0u) { if (xb_ld(&(bar)[XB_TMO])) break; if (_sp > XB_SPIN_CAP) { atomicAdd(&(bar)[XB_TMO], 1u); break; } } } } while (0)
struct XcdBarrier { unsigned* bar; unsigned x; volatile LAS unsigned* st; };
__device__ __forceinline__ XcdBarrier xcd_barrier_post(unsigned* bar, volatile LAS unsigned* st) {
    XcdBarrier b; b.bar = bar; b.x = xb_xcc_id(); b.st = st;
    if (threadIdx.x == 0) (void)xb_add(&bar[XB_XCNT(b.x)], 1u);
    return b;
}
__device__ __forceinline__ void xcd_barrier_complete(unsigned* bar, unsigned x, unsigned& nloc, unsigned& nx) {
    const unsigned G = gridDim.x * gridDim.y * gridDim.z;
    unsigned sum, cnt, mine, sp = 0u;
    for (;;) {
        sum = 0u; cnt = 0u; mine = 0u;
#pragma unroll
        for (unsigned j = 0; j < 16; ++j) { const unsigned c = xb_ld(&bar[XB_XCNT(j)]); sum += c; cnt += (c > 0u) ? 1u : 0u; mine = (j == x) ? c : mine; }
        if (sum == G) break;
        __builtin_amdgcn_s_sleep(1);
        if ((++sp & 255u) == 0u) { if (xb_ld(&bar[XB_TMO])) break; if (sp > XB_SPIN_CAP) { atomicAdd(&bar[XB_TMO], 1u); break; } }
    }
    nloc = mine > 0u ? mine : 1u; nx = cnt > 0u ? cnt : 1u;
}
template <class Idle>
__device__ __forceinline__ void xcd_barrier(const XcdBarrier& b, Idle&& idle) {
    asm volatile("s_waitcnt vmcnt(0)" ::: "memory");
    __syncthreads();
    if (threadIdx.x == 0) {
        unsigned* bar = b.bar;
        __builtin_amdgcn_s_waitcnt(0);
        unsigned nloc = b.st[0], nx = b.st[1];
        if (nloc == 0u) { xcd_barrier_complete(bar, b.x, nloc, nx); b.st[0] = nloc; b.st[1] = nx; }
        const unsigned old = xb_add(&bar[XB_XSUB(b.x)], 1u);
        const unsigned gen = old / nloc;
        if (old + 1u == (gen + 1u) * nloc) {
            __builtin_amdgcn_fence(__ATOMIC_RELEASE, "agent");
            asm volatile("s_waitcnt vmcnt(0)" ::: "memory");
            const unsigned og = xb_add(&bar[XB_TOP], 1u);
            const unsigned tg = og / nx;
            if (og + 1u == (tg + 1u) * nx) xb_add(&bar[XB_TOPGEN], 1u);
            else XB_SPIN(xb_ld(&bar[XB_TOPGEN]) == tg, bar);
            __builtin_amdgcn_fence(__ATOMIC_ACQUIRE, "agent");
            xb_add(&bar[XB_XGEN(b.x)], 1u);
            asm volatile("s_waitcnt vmcnt(0)" ::: "memory");
            b.st[2] = 1u;
        } else { b.st[2] = 0u; b.st[3] = gen; }
    }
    __syncthreads();
    unsigned rounds = 0u;
    while (b.st[2] == 0u) {
        const bool had = idle();
        const unsigned long long anyw = __ballot(had);
        __syncthreads();
        if (threadIdx.x == 0) {
            unsigned* bar = b.bar; const unsigned gen = b.st[3];
            bool rel = xb_ld(&bar[XB_XGEN(b.x)]) != gen;
            if (!rel && anyw == 0ull) { XB_SPIN(xb_ld(&bar[XB_XGEN(b.x)]) == gen, bar); rel = true; }
            if (!rel && ++rounds > (1u << 16)) { atomicAdd(&bar[XB_TMO], 1u); rel = true; }
            if (rel) { __builtin_amdgcn_fence(__ATOMIC_ACQUIRE, "agent"); asm volatile("s_waitcnt vmcnt(0)" ::: "memory"); b.st[2] = 1u; }
        }
        __syncthreads();
    }
}
#ifndef PROBE_GMIN
#define PROBE_GMIN 0
#endif
#ifndef FP8_SCALE_ARG
#define FP8_SCALE_ARG 0
#endif

#ifndef PROBE_STORE2
#define PROBE_STORE2 0
#endif
#ifndef FP8_ASM
#define FP8_ASM 0
#endif
namespace pg8 {
constexpr int BM = 256, BK = 64, HALF = 128, HTB = HALF * BK * 2, STAGE_BYTES = 8 * HTB, NXCD = 8, WGM = 8;
__host__ __device__ __forceinline__ int lds_byte(int r, int c) { const int st = (r >> 4) * 2 + (c >> 5), rr = r & 15, cc = c & 31, ob = rr * 64 + cc * 2; return st * 1024 + (ob ^ (((ob >> 9) & 1) << 5)); }
__host__ __device__ __forceinline__ void stage_rc(int b, int& R, int& C) { const int st = b / 1024, sb = b % 1024, swz = sb ^ (((sb >> 9) & 1) << 5); R = (st >> 1) * 16 + swz / 64; C = (st & 1) * 32 + (swz % 64) / 2; }
__host__ __device__ __forceinline__ int perm32(int rho) { const int n = rho >> 4, i = rho & 15; return 8 * (i >> 2) + 4 * n + (i & 3); }

struct Unit { int pm, pn, e, full, pos0; };
struct Gemm { const bf16_t* A; const bf16_t* Bt; int K; size_t b_estride; const LAS int* rowtab; void* probe; };

struct StaticOrder {
    int nM, nN, nwg, G, c;
    __device__ void init(int M, int N, int G_, int c_) { nM = M / BM; nN = N / BM; nwg = nM * nN; G = G_; c = c_; }
    __device__ bool next(int i, Unit& u) const {
        const long L = (long)i * G + c; if (L >= nwg) return false;
        int wgid = (int)L; { const int q = nwg / NXCD, r = nwg % NXCD, xcd = wgid % NXCD, off = wgid / NXCD; wgid = (xcd < r ? xcd * (q + 1) : r * (q + 1) + (xcd - r) * q) + off; }
        const int nig = WGM * nN, gid = wgid / nig, fm = gid * WGM, gsz = (nM - fm) < WGM ? (nM - fm) : WGM;
        u.pm = fm + ((wgid % nig) % gsz); u.pn = (wgid % nig) / gsz; u.e = 0; u.full = 1; u.pos0 = 0; return true;
    }
    __device__ __forceinline__ void between(int) const {}
};
struct MoeOrder {
    const LAS int* tab; int r, nper, i0, imax;
    __device__ bool next(int i, Unit& u) const {
        if (i >= imax) return false;
        const int L = (i0 + i) * nper + r; if (L >= __builtin_amdgcn_readfirstlane(tab[1])) return false;
        int p = 0; const int np = tab[0];
#pragma unroll 1
        while (p + 1 < np && tab[4 + 8 * (p + 1)] <= L) ++p;
        const LAS int* t = tab + 4 + 8 * p;
        const int local = L - t[0], mte = t[3], pq = local / mte, mt = local - pq * mte;
        u.e = __builtin_amdgcn_readfirstlane(t[1]); u.pn = __builtin_amdgcn_readfirstlane(t[2] + pq); u.pm = __builtin_amdgcn_readfirstlane(t[4] + mt);
        u.full = __builtin_amdgcn_readfirstlane((t[5] - mt * 256) > 128 ? 1 : 0); u.pos0 = __builtin_amdgcn_readfirstlane(mt * 256); return true;
    }
    __device__ __forceinline__ void between(int) const {}
};

struct EpiProj {
    static constexpr bool PERM = true;
    bf16_t* O; int ldc;
    __device__ __forceinline__ void operator()(const f32x4 (&acc)[2][2][4][2], const Unit& u, int wr, int wc, int fr, int fq) const {
        const int row0 = u.pm * BM + wr * 64 + fr, col0 = u.pn * BM + wc * 32 + 8 * fq;
#pragma unroll
        for (int ai = 0; ai < 2; ++ai)
#pragma unroll
            for (int m = 0; m < 4; ++m) { bf16_t* rowp = O + (size_t)(row0 + ai * HALF + m * 16) * ldc + col0;
#pragma unroll
                for (int bj = 0; bj < 2; ++bj) { const f32x4 v0 = acc[ai][bj][m][0], v1 = acc[ai][bj][m][1];
                    u32x4 w; w.x = cvt_pk_bf16(v0[0], v0[1]); w.y = cvt_pk_bf16(v0[2], v0[3]); w.z = cvt_pk_bf16(v1[0], v1[1]); w.w = cvt_pk_bf16(v1[2], v1[3]);
                    *(u32x4*)(rowp + bj * HALF) = w;
#if PROBE_STORE2 == 1
                    *(u32x4*)(rowp + bj * HALF + (size_t)1792 * 1024 * 1024) = w;
#endif
                } }
    }
};
struct EpiOut {
    static constexpr bool PERM = false;
    const float* X; const float* g1;   float* O;
    __device__ __forceinline__ void operator()(const f32x4 (&acc)[2][2][4][2], const Unit& u, int wr, int wc, int fr, int fq) const {
        const int row0 = u.pm * BM + wr * 64 + fr, col0 = u.pn * BM + wc * 32 + 4 * fq;
        const float* gp = g1 + (size_t)((u.pm * BM) >> 12) * 12288 + col0;
        f32x4 gv[2][2];
#pragma unroll
        for (int bj = 0; bj < 2; ++bj)
#pragma unroll
            for (int n = 0; n < 2; ++n) gv[bj][n] = *(const f32x4*)(gp + bj * HALF + n * 16);
#pragma unroll
        for (int ai = 0; ai < 2; ++ai) {
            f32x4 xv[4][2][2];
#pragma unroll
            for (int m = 0; m < 4; ++m) { const size_t off = (size_t)(row0 + ai * HALF + m * 16) * DM + col0;
#pragma unroll
                for (int bj = 0; bj < 2; ++bj)
#pragma unroll
                    for (int n = 0; n < 2; ++n) xv[m][bj][n] = *(const f32x4*)(X + off + bj * HALF + n * 16); }
#pragma unroll
            for (int m = 0; m < 4; ++m) { const size_t off = (size_t)(row0 + ai * HALF + m * 16) * DM + col0;
#pragma unroll
                for (int bj = 0; bj < 2; ++bj)
#pragma unroll
                    for (int n = 0; n < 2; ++n) *(f32x4*)(O + off + bj * HALF + n * 16) = xv[m][bj][n] + gv[bj][n] * acc[ai][bj][m][n]; }
            asm volatile("" ::: "memory"); }
    }
};
struct EpiGU {
    static constexpr bool PERM = true;
    const float* bias;   bf16_t* O;
    __device__ __forceinline__ void operator()(const f32x4 (&acc)[2][2][4][2], const Unit& u, int wr, int wc, int fr, int fq) const {
        const int row0 = u.pm * BM + wr * 64 + fr, cc = u.pn * HALF + wc * 32 + 8 * fq;
        const float* bp = bias + (size_t)u.e * 4096 + cc;
        f32x4 bg[2], bu[2];
#pragma unroll
        for (int n = 0; n < 2; ++n) { bg[n] = *(const f32x4*)(bp + 4 * n); bu[n] = *(const f32x4*)(bp + 2048 + 4 * n); }
#pragma unroll
        for (int ai = 0; ai < 2; ++ai)
#pragma unroll
            for (int m = 0; m < 4; ++m) { float r[8];
#pragma unroll
                for (int n = 0; n < 2; ++n)
#pragma unroll
                    for (int j = 0; j < 4; ++j) {
                        float g = acc[ai][0][m][n][j] + bg[n][j], uu = acc[ai][1][m][n][j] + bu[n][j];
                        g = fminf(g, 7.0f); uu = fminf(fmaxf(uu, -7.0f), 7.0f);
                        const float glu = g * __builtin_amdgcn_rcpf(1.0f + __expf(-1.702f * g));
                        r[n * 4 + j] = (uu + 1.0f) * glu;
#if FP8_EMU
                        r[n * 4 + j] = q8(r[n * 4 + j]);
#endif
                    }
                u32x4 w; w.x = cvt_pk_bf16(r[0], r[1]); w.y = cvt_pk_bf16(r[2], r[3]); w.z = cvt_pk_bf16(r[4], r[5]); w.w = cvt_pk_bf16(r[6], r[7]);
                *(u32x4*)(O + (size_t)(row0 + ai * HALF + m * 16) * DM + cc) = w; }
    }
};
struct EpiDown {
    static constexpr bool PERM = true;
    const float* bias;   const float* wbuf; bf16_t* O;
    __device__ __forceinline__ void operator()(const f32x4 (&acc)[2][2][4][2], const Unit& u, int wr, int wc, int fr, int fq) const {
        const int row0 = u.pm * BM + wr * 64 + fr, col0 = u.pn * BM + wc * 32 + 8 * fq;
        const float* bp = bias + (size_t)u.e * 2048 + col0;
        f32x4 bv[2][2];
#pragma unroll
        for (int bj = 0; bj < 2; ++bj)
#pragma unroll
            for (int n = 0; n < 2; ++n) bv[bj][n] = *(const f32x4*)(bp + bj * HALF + 4 * n);
#pragma unroll
        for (int ai = 0; ai < 2; ++ai)
#pragma unroll
            for (int m = 0; m < 4; ++m) { const int row = row0 + ai * HALF + m * 16; const float rw = wbuf[row]; bf16_t* rowp = O + (size_t)row * DM + col0;
#pragma unroll
                for (int bj = 0; bj < 2; ++bj) { const f32x4 v0 = (acc[ai][bj][m][0] + bv[bj][0]) * rw, v1 = (acc[ai][bj][m][1] + bv[bj][1]) * rw;
                    u32x4 w; w.x = cvt_pk_bf16(v0[0], v0[1]); w.y = cvt_pk_bf16(v0[2], v0[3]); w.z = cvt_pk_bf16(v1[0], v1[1]); w.w = cvt_pk_bf16(v1[2], v1[3]);
                    *(u32x4*)(rowp + bj * HALF) = w; } }
    }
};

__device__ __forceinline__ unsigned pk4_fp8(float a, float b, float c, float d) { int p = __builtin_amdgcn_cvt_pk_fp8_f32(a, b, 0, false); p = __builtin_amdgcn_cvt_pk_fp8_f32(c, d, p, true); return (unsigned)p; }
constexpr float W8_SCALE = 64.0f, W8_INV = 1.0f / 64.0f;
struct EpiGU8 {
    static constexpr bool PERM = true;
    const float* bias;   unsigned char* O;
    __device__ __forceinline__ void operator()(const f32x4 (&acc)[2][2][4][2], const Unit& u, int wr, int wc, int fr, int fq) const {
        const int row0 = u.pm * BM + wr * 64 + fr, cc = u.pn * HALF + wc * 32 + 8 * fq;
        const float* bp = bias + (size_t)u.e * 4096 + cc;
        f32x4 bg[2], bu[2];
#pragma unroll
        for (int n = 0; n < 2; ++n) { bg[n] = *(const f32x4*)(bp + 4 * n); bu[n] = *(const f32x4*)(bp + 2048 + 4 * n); }
#pragma unroll
        for (int ai = 0; ai < 2; ++ai)
#pragma unroll
            for (int m = 0; m < 4; ++m) { float r[8];
#pragma unroll
                for (int n = 0; n < 2; ++n)
#pragma unroll
                    for (int j = 0; j < 4; ++j) {
                        float g = acc[ai][0][m][n][j] * W8_INV + bg[n][j], uu = acc[ai][1][m][n][j] * W8_INV + bu[n][j];
                        g = fminf(g, 7.0f); uu = fminf(fmaxf(uu, -7.0f), 7.0f);
                        const float glu = g * __builtin_amdgcn_rcpf(1.0f + __expf(-1.702f * g));
                        r[n * 4 + j] = (uu + 1.0f) * glu; }
                u32x2 w; w.x = pk4_fp8(r[0], r[1], r[2], r[3]); w.y = pk4_fp8(r[4], r[5], r[6], r[7]);
                *(u32x2*)(O + (size_t)(row0 + ai * HALF + m * 16) * DM + cc) = w; }
    }
};
struct EpiDown8 {
    static constexpr bool PERM = true;
    const float* bias;   const float* wbuf; bf16_t* O;
    __device__ __forceinline__ void operator()(const f32x4 (&acc)[2][2][4][2], const Unit& u, int wr, int wc, int fr, int fq) const {
        const int row0 = u.pm * BM + wr * 64 + fr, col0 = u.pn * BM + wc * 32 + 8 * fq;
        const float* bp = bias + (size_t)u.e * 2048 + col0;
        f32x4 bv[2][2];
#pragma unroll
        for (int bj = 0; bj < 2; ++bj)
#pragma unroll
            for (int n = 0; n < 2; ++n) bv[bj][n] = *(const f32x4*)(bp + bj * HALF + 4 * n);
#pragma unroll
        for (int ai = 0; ai < 2; ++ai)
#pragma unroll
            for (int m = 0; m < 4; ++m) { const int row = row0 + ai * HALF + m * 16; const float rw = wbuf[(size_t)u.e * 8192 + u.pos0 + (row - u.pm * BM)]; bf16_t* rowp = O + (size_t)row * DM + col0;
#pragma unroll
                for (int bj = 0; bj < 2; ++bj) { const f32x4 v0 = (acc[ai][bj][m][0] * W8_INV + bv[bj][0]) * rw, v1 = (acc[ai][bj][m][1] * W8_INV + bv[bj][1]) * rw;
                    u32x4 w; w.x = cvt_pk_bf16(v0[0], v0[1]); w.y = cvt_pk_bf16(v0[2], v0[3]); w.z = cvt_pk_bf16(v1[0], v1[1]); w.w = cvt_pk_bf16(v1[2], v1[3]);
                    *(u32x4*)(rowp + bj * HALF) = w; } }
    }
};

typedef int i32x8 __attribute__((ext_vector_type(8)));
typedef short s16x16 __attribute__((ext_vector_type(16)));
__device__ __forceinline__ i32x8 ld32(const LAS unsigned char* p) { const bf16x8 lo = *(const LAS bf16x8*)p, hi = *(const LAS bf16x8*)(p + 1024); return __builtin_bit_cast(i32x8, __builtin_shufflevector(lo, hi, 0, 1, 2, 3, 4, 5, 6, 7, 8, 9, 10, 11, 12, 13, 14, 15)); }
__device__ __forceinline__ const char* sbase(const char* p) { asm volatile("" : "+s"(p)); return p; }
template <bool FP8, bool GATHER, class Epi, class Sched>
__device__ __forceinline__ void gemm_phase(LAS unsigned char* lds, const Gemm g, const Sched& S, const Epi& E) {
    const int tid = threadIdx.x, wid = __builtin_amdgcn_readfirstlane(tid >> 6), lane = tid & 63, wr = wid >> 2, wc = wid & 3, fr = lane & 15, fq = lane >> 4;
    const int K = g.K, nt = K / BK;
    unsigned voffA, voffB;
    { int R, C; stage_rc(tid * 16, R, C); const int Rb = Epi::PERM ? ((R & ~31) + perm32(R & 31)) : R; voffA = (unsigned)(R * K + C) * 2u; voffB = (unsigned)(Rb * K + C) * 2u; }
    const size_t pstep = (size_t)64 * K * 2;
    unsigned voffC = 0, ro[4] = {0, 0, 0, 0}; int Rl = 0;
    if constexpr (GATHER) { int R, C; stage_rc(tid * 16, R, C); voffC = (unsigned)C * 2u; Rl = R; }
#define PG8_ROWS(x0, uidx) do { ro[x0] = (unsigned)g.rowtab[(uidx) * 256 + Rl + 64 * (x0)]; ro[(x0) + 1] = (unsigned)g.rowtab[(uidx) * 256 + Rl + 64 * (x0) + 64]; } while (0)
    const size_t kstep = (size_t)(BK * 2);
    const size_t hstep = (size_t)HALF * K * 2;
    const size_t tstep = 2 * hstep;
    const size_t estep = g.b_estride * 2;
    const unsigned ldsw = (unsigned)wid * 1024u;
    const int aoff0 = lds_byte(wr * 64 + fr, fq * 8), boff0 = lds_byte(wc * 32 + fr, fq * 8);
#define PG8_SA(b, h) (((b) * 2 + (h)) * HTB)
#define PG8_SB(b, h) ((4 + (b) * 2 + (h)) * HTB)
#define PG8_STAGE(bufoff, gbase, voff) do { _Pragma("unroll") for (int _i = 0; _i < 2; ++_i) \
        __builtin_amdgcn_global_load_lds((const unsigned*)(sbase((const char*)(gbase) + _i * pstep) + (voff)), (LAS unsigned*)(lds + (bufoff) + ldsw + _i * 8192), 16, 0, 0); } while (0)
#define PG8_STAGEA(bufoff, isnext, half, koff) do { if constexpr (GATHER) { _Pragma("unroll") for (int _i = 0; _i < 2; ++_i) { const unsigned _r = ro[(half) * 2 + _i]; \
            __builtin_amdgcn_global_load_lds((const unsigned*)(sbase((const char*)g.A + (koff)) + (_r + voffC)), (LAS unsigned*)(lds + (bufoff) + ldsw + _i * 8192), 16, 0, 0); } } \
        else { PG8_STAGE(bufoff, ((isnext) ? nA : cA) + (half) * hstep + (koff), voffA); } } while (0)
#define PG8_LDA(dst, b, h) do { _Pragma("unroll") for (int m = 0; m < 4; ++m) { \
        if constexpr (FP8) dst##8[m] = ld32(lds + PG8_SA(b, h) + aoff0 + m * 2048); \
        else { dst[m][0] = *(const LAS bf16x8*)(lds + PG8_SA(b, h) + aoff0 + m * 2048); dst[m][1] = *(const LAS bf16x8*)(lds + PG8_SA(b, h) + aoff0 + m * 2048 + 1024); } } } while (0)
#define PG8_LDB(dst, b, h) do { _Pragma("unroll") for (int n = 0; n < 2; ++n) { \
        if constexpr (FP8) dst##8[n] = ld32(lds + PG8_SB(b, h) + boff0 + n * 2048); \
        else { dst[n][0] = *(const LAS bf16x8*)(lds + PG8_SB(b, h) + boff0 + n * 2048); dst[n][1] = *(const LAS bf16x8*)(lds + PG8_SB(b, h) + boff0 + n * 2048 + 1024); } } } while (0)
#define PG8_MMA(ai, bj, At, Bt) do { __builtin_amdgcn_s_setprio(1); _Pragma("unroll") for (int m = 0; m < 4; ++m) _Pragma("unroll") for (int n = 0; n < 2; ++n) { \
        if constexpr (FP8) { if (FP8_ASM) { asm volatile("v_mfma_scale_f32_16x16x128_f8f6f4 %0, %1, %2, %0, %3, %3 op_sel_hi:[0,0,0]" : "+a"(acc[ai][bj][m][n]) : "v"(Bt##8[n]), "v"(At##8[m]), "v"(scale1)); } \
            else acc[ai][bj][m][n] = __builtin_amdgcn_mfma_scale_f32_16x16x128_f8f6f4(Bt##8[n], At##8[m], acc[ai][bj][m][n], 0, 0, 0, FP8_SCALE_ARG, 0, FP8_SCALE_ARG); } \
        else { acc[ai][bj][m][n] = __builtin_amdgcn_mfma_f32_16x16x32_bf16(Bt[n][0], At[m][0], acc[ai][bj][m][n], 0, 0, 0); \
               acc[ai][bj][m][n] = __builtin_amdgcn_mfma_f32_16x16x32_bf16(Bt[n][1], At[m][1], acc[ai][bj][m][n], 0, 0, 0); } } \
        __builtin_amdgcn_s_setprio(0); } while (0)
#define PG8_WAIT_V(n) asm volatile("s_waitcnt vmcnt(" #n ")" ::: "memory")
#define PG8_WAIT_L(n) asm volatile("s_waitcnt lgkmcnt(" #n ")" ::: "memory")
#define PG8_BAR __builtin_amdgcn_s_barrier()
#define PG8_SCHED __builtin_amdgcn_sched_barrier(0)
#ifdef PROBE_GMAX
    const unsigned long long tg0 = __builtin_amdgcn_s_memrealtime();
#endif
    Unit cur, nxt; int ui = 0;
#ifdef PROBE_EPI
    unsigned long long epi_acc = 0;
#endif
    if (!S.next(0, cur)) return;
    f32x4 acc[2][2][4][2];
#pragma unroll
    for (int a = 0; a < 2; ++a)
#pragma unroll
        for (int b = 0; b < 2; ++b)
#pragma unroll
            for (int m = 0; m < 4; ++m)
#pragma unroll
                for (int n = 0; n < 2; ++n) acc[a][b][m][n] = (f32x4){0.f, 0.f, 0.f, 0.f};
    bf16x8 At[4][2], B0[2][2], B1[2][2]; i32x8 At8[4], B08[2], B18[2];
    const unsigned scale1 = 0x7f7f7f7fu;
    const char* cA = (const char*)g.A + (size_t)cur.pm * tstep; const char* cB = (const char*)g.Bt + (size_t)cur.e * estep + (size_t)cur.pn * tstep;
    const char* nA = cA;
    if constexpr (GATHER) { PG8_ROWS(0, 0); PG8_ROWS(2, 0); }
    PG8_STAGE(PG8_SB(0, 0), cB, voffB); PG8_STAGEA(PG8_SA(0, 0), false, 0, 0); PG8_STAGE(PG8_SB(0, 1), cB + hstep, voffB); PG8_STAGEA(PG8_SA(0, 1), false, 1, 0);
    if (wr == 1) PG8_BAR;
    PG8_WAIT_V(4); PG8_BAR;
    PG8_STAGE(PG8_SB(1, 0), cB + kstep, voffB); PG8_STAGEA(PG8_SA(1, 0), false, 0, kstep); PG8_STAGE(PG8_SB(1, 1), cB + hstep + kstep, voffB);
    PG8_WAIT_V(6); PG8_BAR;
    for (;;) {
        const bool has_next = S.next(ui + 1, nxt);
        const bool cfull = FP8 ? true : (cur.full != 0);
        nA = has_next ? (const char*)g.A + (size_t)nxt.pm * tstep : cA;
        const char* nB = has_next ? (const char*)g.Bt + (size_t)nxt.e * estep + (size_t)nxt.pn * tstep : cB;
#ifdef PROBE_KL
        const unsigned long long tk0 = __builtin_amdgcn_s_memrealtime();
#endif
        for (int t = 0; t < nt; t += 2) {
            const bool last = (t == nt - 2);
            const size_t k1 = (size_t)(t + 1) * kstep, k2 = last ? 0 : (size_t)(t + 2) * kstep, k3 = k2 + kstep;
            const char* b2 = last ? nB : cB + (size_t)(t + 2) * kstep; const char* b3 = b2 + kstep;
            if constexpr (GATHER) { if (last && has_next) PG8_ROWS(0, ui + 1); }
            PG8_LDB(B0, 0, 0); PG8_SCHED; PG8_LDA(At, 0, 0); PG8_STAGEA(PG8_SA(1, 1), false, 1, k1);
            if constexpr (GATHER) { if (last && has_next) PG8_ROWS(2, ui + 1); }
            PG8_WAIT_V(10); PG8_WAIT_L(8); PG8_BAR; PG8_WAIT_L(0); PG8_MMA(0, 0, At, B0); PG8_BAR; PG8_SCHED;
            PG8_LDB(B1, 0, 1); PG8_STAGE(PG8_SB(0, 0), b2, voffB);
            PG8_WAIT_V(10); PG8_BAR; PG8_WAIT_L(0); PG8_MMA(0, 1, At, B1); PG8_BAR;
            PG8_LDA(At, 0, 1); PG8_STAGEA(PG8_SA(0, 0), last, 0, k2);
            PG8_BAR; PG8_WAIT_L(0); if (cfull) PG8_MMA(1, 0, At, B0); PG8_BAR; PG8_SCHED;
            PG8_STAGE(PG8_SB(0, 1), b2 + hstep, voffB);
            PG8_WAIT_V(10); PG8_BAR; if (cfull) PG8_MMA(1, 1, At, B1); PG8_BAR;
            PG8_LDB(B0, 1, 0); PG8_SCHED; PG8_LDA(At, 1, 0); PG8_STAGEA(PG8_SA(0, 1), last, 1, k2);
            PG8_WAIT_V(10); PG8_WAIT_L(8); PG8_BAR; PG8_WAIT_L(0); PG8_MMA(0, 0, At, B0); PG8_BAR; PG8_SCHED;
            PG8_LDB(B1, 1, 1); PG8_STAGE(PG8_SB(1, 0), b3, voffB);
            PG8_WAIT_V(10); PG8_BAR; PG8_WAIT_L(0); PG8_MMA(0, 1, At, B1); PG8_BAR;
            PG8_LDA(At, 1, 1); PG8_STAGEA(PG8_SA(1, 0), last, 0, k3);
            PG8_BAR; PG8_WAIT_L(0); if (cfull) PG8_MMA(1, 0, At, B0); PG8_BAR; PG8_SCHED;
            PG8_STAGE(PG8_SB(1, 1), b3 + hstep, voffB);
            PG8_WAIT_V(10); PG8_BAR; if (cfull) PG8_MMA(1, 1, At, B1); PG8_BAR;
        }
#ifdef PROBE_KL
        if (FP8 && (GATHER ? 9 : 10) == PROBE_EPI) epi_acc += __builtin_amdgcn_s_memrealtime() - tk0;
#endif
        {
            int tz = threadIdx.x; asm volatile("" : "+v"(tz)); const int lz = tz & 63;
#ifdef PROBE_EPI
            const unsigned long long te0 = __builtin_amdgcn_s_memrealtime();
#endif
            E(acc, cur, wr, wc, lz & 15, lz >> 4);
#ifdef PROBE_EPI
#ifndef PROBE_KL
            if (FP8 && (GATHER ? 9 : 10) == PROBE_EPI) { epi_acc += __builtin_amdgcn_s_memrealtime() - te0; }
#endif
#endif
            }
        S.between(ui);
        if (!has_next) break;
#pragma unroll
        for (int a = 0; a < 2; ++a)
#pragma unroll
            for (int b = 0; b < 2; ++b)
#pragma unroll
                for (int m = 0; m < 4; ++m)
#pragma unroll
                    for (int n = 0; n < 2; ++n) acc[a][b][m][n] = (f32x4){0.f, 0.f, 0.f, 0.f};
        cur = nxt; cA = nA; cB = nB; ++ui;

    }
#ifdef PROBE_EPI
    if (FP8 && (GATHER ? 9 : 10) == PROBE_EPI && blockIdx.x == 0 && threadIdx.x == 0) *(unsigned long long*)((char*)g.probe) = epi_acc;
#endif
#ifdef PROBE_GMAX
    if (FP8 && (GATHER ? 9 : 10) == PROBE_GMAX && threadIdx.x == 0) { const unsigned d = (unsigned)(__builtin_amdgcn_s_memrealtime() - tg0); if (PROBE_GMIN) atomicMin((unsigned*)((char*)g.probe + 8), d); else atomicMax((unsigned*)((char*)g.probe + 8), d); }
#endif
    PG8_WAIT_V(0);
    if (wr == 0) PG8_BAR;
    PG8_BAR;
#undef PG8_SA
#undef PG8_SB
#undef PG8_STAGE
#undef PG8_STAGEA
#undef PG8_ROWS
#undef PG8_LDA
#undef PG8_LDB
#undef PG8_MMA
#undef PG8_WAIT_V
#undef PG8_WAIT_L
#undef PG8_BAR
#undef PG8_SCHED
}
}
#ifndef BJOB_NT
#define BJOB_NT 1
#endif
#if BJOB_NT
#define BJOB_LD(p) __builtin_nontemporal_load(p)
#else
#define BJOB_LD(p) (*(p))
#endif

__device__ __forceinline__ void conv_job(const float* src, int ld, bf16_t* dst, int kt) {
    const int w = threadIdx.x >> 6, lane = threadIdx.x & 63, kseg = lane & 7, nq = lane >> 3;
    const int k0 = kt * 128 + (w >> 2) * 64 + kseg * 8, nl = (w & 3) * 32 + nq * 4;
    f32x4 v[8];
#pragma unroll
    for (int r = 0; r < 8; ++r) v[r] = *(const f32x4*)(src + (size_t)(k0 + r) * ld + nl);
#if FP8_EMU
#pragma unroll
    for (int r = 0; r < 8; ++r)
#pragma unroll
        for (int j = 0; j < 4; ++j) v[r][j] = q8(v[r][j] * 64.0f) * (1.0f / 64.0f);
#endif
#pragma unroll
    for (int j = 0; j < 4; ++j) { u32x4 o; o.x = cvt_pk_bf16(v[0][j], v[1][j]); o.y = cvt_pk_bf16(v[2][j], v[3][j]); o.z = cvt_pk_bf16(v[4][j], v[5][j]); o.w = cvt_pk_bf16(v[6][j], v[7][j]);
        *(u32x4*)(dst + (size_t)(nl + j) * 2048 + k0) = o; }
}
constexpr int CONV_JOBS_GU = 32 * 16 * 16, CONV_JOBS_D = 32 * 16 * 8, CONV_JOBS = CONV_JOBS_GU + CONV_JOBS_D;
__device__ __forceinline__ void conv_block_job(const Args& a, LAS unsigned char* T, int j) {
    const int tid = threadIdx.x, w = tid >> 6, lane = tid & 63;
    const float* src; int ld; unsigned char* dst; int gu, s0;
    if (j < CONV_JOBS_GU) { const int e = j >> 8, kb = (j >> 4) & 15, nb = j & 15; s0 = nb * 256; gu = 1;
        src = a.w_gate_up + ((size_t)e * 2048 + kb * 128) * 4096 + s0; ld = 4096; dst = (unsigned char*)(a.ws + WS_WGU_T) + (size_t)e * 4096 * 2048 + kb * 128; }
    else { const int jj = j - CONV_JOBS_GU, e = jj >> 7, kb = (jj >> 3) & 15, nb = jj & 7; s0 = nb * 256; gu = 0;
        src = a.w_down + ((size_t)e * 2048 + kb * 128) * 2048 + s0; ld = 2048; dst = (unsigned char*)(a.ws + WS_WD_T) + (size_t)e * 2048 * 2048 + kb * 128; }
    f32x4 v[16];
#pragma unroll
    for (int r = 0; r < 16; ++r) v[r] = __builtin_nontemporal_load((const f32x4*)(src + (size_t)(w * 16 + r) * ld + lane * 4)) * pg8::W8_SCALE;
#pragma unroll
    for (int jn = 0; jn < 4; ++jn) { u32x4 o;
        o.x = pg8::pk4_fp8(v[0][jn], v[1][jn], v[2][jn], v[3][jn]); o.y = pg8::pk4_fp8(v[4][jn], v[5][jn], v[6][jn], v[7][jn]);
        o.z = pg8::pk4_fp8(v[8][jn], v[9][jn], v[10][jn], v[11][jn]); o.w = pg8::pk4_fp8(v[12][jn], v[13][jn], v[14][jn], v[15][jn]);
        const int n = lane * 4 + jn;
        *(LAS u32x4*)(T + n * 128 + ((w ^ (lane & 7)) << 4)) = o; }
    __syncthreads();
#pragma unroll
    for (int p = 0; p < 4; ++p) { const int idx = tid + 512 * p, n = idx >> 3, wq = idx & 7;
        const u32x4 o = *(const LAS u32x4*)(T + n * 128 + ((wq ^ ((n >> 2) & 7)) << 4));
        const int c = s0 + n; int np = c;
        if (gu) { const int bj = c >> 11, rem = c & 2047; np = (rem >> 7) * 256 + bj * 128 + (rem & 127); }
        __builtin_nontemporal_store(o, (u32x4*)(dst + (size_t)np * 2048 + wq * 16)); }
}
constexpr int SJOBS_GU = 32 * 32 * 128, SJOBS_D = 32 * 32 * 64, SJOBS = SJOBS_GU + SJOBS_D;
constexpr int SJOBS_ATTN = 256 * 33 * 8;
typedef short s16x2 __attribute__((ext_vector_type(2)));
__device__ __forceinline__ unsigned pk4_fp8_scaled(float a, float b, float c, float d) { s16x2 r = {0, 0}; r = __builtin_amdgcn_cvt_scalef32_pk_fp8_f32(r, a, b, pg8::W8_INV, false); r = __builtin_amdgcn_cvt_scalef32_pk_fp8_f32(r, c, d, pg8::W8_INV, true); return __builtin_bit_cast(unsigned, r); }
struct SJob { const float* src; unsigned char* dst; int ld; };
__device__ __forceinline__ SJob sjob_addr(const Args& a, int j, int lane) {
    SJob c; const int kseg = lane & 7, nq = lane >> 3;
    if (j < SJOBS_GU) { const int e = j >> 12, kb = (j >> 7) & 31, nb = j & 127, s0 = nb * 32, bj = s0 >> 11, rem = s0 & 2047, pn = rem >> 7, c0 = rem & 127, np = pn * 256 + bj * 128 + c0;
        c.ld = 4096; c.src = a.w_gate_up + ((size_t)e * 2048 + kb * 64 + kseg * 8) * 4096 + s0 + nq * 4; c.dst = (unsigned char*)(a.ws + WS_WGU_T) + ((size_t)e * 4096 + np + nq * 4) * 2048 + kb * 64 + kseg * 8; }
    else { const int jj = j - SJOBS_GU, e = jj >> 11, kb = (jj >> 6) & 31, nb = jj & 63;
        c.ld = 2048; c.src = a.w_down + ((size_t)e * 2048 + kb * 64 + kseg * 8) * 2048 + nb * 32 + nq * 4; c.dst = (unsigned char*)(a.ws + WS_WD_T) + ((size_t)e * 2048 + nb * 32 + nq * 4) * 2048 + kb * 64 + kseg * 8; }
    return c;
}
__device__ __forceinline__ void sjob_load(const SJob& c, f32x4 (&v)[8]) {
#pragma unroll
    for (int r = 0; r < 8; ++r) v[r] = __builtin_nontemporal_load((const f32x4*)(c.src + (size_t)r * c.ld));
}
__device__ __forceinline__ void sjob_store(const SJob& c, const f32x4 (&v)[8]) {
#pragma unroll
    for (int jn = 0; jn < 4; ++jn) { u32x2 o;
        o.x = pk4_fp8_scaled(v[0][jn], v[1][jn], v[2][jn], v[3][jn]); o.y = pk4_fp8_scaled(v[4][jn], v[5][jn], v[6][jn], v[7][jn]);
        __builtin_nontemporal_store(o, (u32x2*)(c.dst + (size_t)jn * 2048)); }
}
__device__ __forceinline__ void conv_share(const Args& a, int blk, int G) {
    const int s = blk % 3, r = blk / 3, nb = (G - s + 2) / 3, w = threadIdx.x >> 6, lane = threadIdx.x & 63;
    const int npair = (SJOBS - SJOBS_ATTN) / 2, p0 = s * (npair / 3), p1 = (s == 2) ? npair : (s + 1) * (npair / 3);
    int p = p0 + r * 8 + w; const int step = nb * 8;
    if (p >= p1) return;
    f32x4 va0[8], va1[8], vb0[8], vb1[8]; SJob ca = sjob_addr(a, SJOBS_ATTN + 2 * p, lane), cb = ca, t;
    sjob_load(ca, va0); t = ca; t.src += 32; sjob_load(t, va1);
#pragma unroll 1
    for (;;) {
        const bool hb = (p + step) < p1; if (hb) { cb = sjob_addr(a, SJOBS_ATTN + 2 * (p + step), lane); sjob_load(cb, vb0); t = cb; t.src += 32; sjob_load(t, vb1); }
        sjob_store(ca, va0); t = ca; t.dst += 32 * 2048; sjob_store(t, va1);
        if (!hb) break;
        p += step;
        const bool ha = (p + step) < p1; if (ha) { ca = sjob_addr(a, SJOBS_ATTN + 2 * (p + step), lane); sjob_load(ca, va0); t = ca; t.src += 32; sjob_load(t, va1); }
        sjob_store(cb, vb0); t = cb; t.dst += 32 * 2048; sjob_store(t, vb1);
        if (!ha) break;
        p += step;
    }
}
struct BJob { const float* src; unsigned char* dst; int ld, gu, s0; };
__device__ __forceinline__ BJob bjob_addr(const Args& a, int j) {
    BJob c;
    if (j < CONV_JOBS_GU) { const int e = j >> 8, kb = (j >> 4) & 15, nb = j & 15; c.s0 = nb * 256; c.gu = 1;
        c.src = a.w_gate_up + ((size_t)e * 2048 + kb * 128) * 4096 + c.s0; c.ld = 4096; c.dst = (unsigned char*)(a.ws + WS_WGU_T) + (size_t)e * 4096 * 2048 + kb * 128; }
    else { const int jj = j - CONV_JOBS_GU, e = jj >> 7, kb = (jj >> 3) & 15, nb = jj & 7; c.s0 = nb * 256; c.gu = 0;
        c.src = a.w_down + ((size_t)e * 2048 + kb * 128) * 2048 + c.s0; c.ld = 2048; c.dst = (unsigned char*)(a.ws + WS_WD_T) + (size_t)e * 2048 * 2048 + kb * 128; }
    return c;
}
__device__ __forceinline__ void bjob_load(const BJob& c, f32x4 (&v)[16]) {
    int tz = threadIdx.x; asm volatile("" : "+v"(tz));
    const int w = tz >> 6, lane = tz & 63;
#pragma unroll
    for (int r = 0; r < 16; ++r) v[r] = BJOB_LD((const f32x4*)(c.src + (size_t)(w * 16 + r) * c.ld + lane * 4));
}
__device__ __forceinline__ void bjob_pack(const f32x4 (&v)[16], u32x4 (&o)[4]) {
#pragma unroll
    for (int jn = 0; jn < 4; ++jn) {
        o[jn].x = pk4_fp8_scaled(v[0][jn], v[1][jn], v[2][jn], v[3][jn]); o[jn].y = pk4_fp8_scaled(v[4][jn], v[5][jn], v[6][jn], v[7][jn]);
        o[jn].z = pk4_fp8_scaled(v[8][jn], v[9][jn], v[10][jn], v[11][jn]); o[jn].w = pk4_fp8_scaled(v[12][jn], v[13][jn], v[14][jn], v[15][jn]); }
}
__device__ __forceinline__ void bjob_out(const BJob& c, const u32x4 (&o)[4], LAS unsigned char* Tlo, LAS unsigned char* Thi) {
    int tz = threadIdx.x; asm volatile("" : "+v"(tz));
    const int tid = tz, w = tid >> 6, lane = tid & 63;
    LAS unsigned char* Tw = (lane < 32) ? Tlo : Thi;
#pragma unroll
    for (int jn = 0; jn < 4; ++jn) { const int nl = (lane & 31) * 4 + jn;
        *(LAS u32x4*)(Tw + nl * 128 + ((w ^ (lane & 7)) << 4)) = o[jn]; }
    asm volatile("s_waitcnt lgkmcnt(0)" ::: "memory"); __builtin_amdgcn_s_barrier(); asm volatile("" ::: "memory");
#pragma unroll
    for (int p = 0; p < 4; ++p) { const int idx = tid + 512 * p, n = idx >> 3, wq = idx & 7;
        const LAS unsigned char* Tr = (n < 128) ? Tlo : Thi;
        const u32x4 ov = *(const LAS u32x4*)(Tr + (n & 127) * 128 + ((wq ^ ((n >> 2) & 7)) << 4));
        const int cc = c.s0 + n; int np = cc;
        if (c.gu) { const int bj = cc >> 11, rem = cc & 2047; np = (rem >> 7) * 256 + bj * 128 + (rem & 127); }
        __builtin_nontemporal_store(ov, (u32x4*)(c.dst + (size_t)np * 2048 + wq * 16)); }
    asm volatile("s_waitcnt lgkmcnt(0)" ::: "memory"); __builtin_amdgcn_s_barrier(); asm volatile("" ::: "memory");
}
#ifndef CONV_IN_ATTN
#define CONV_IN_ATTN 1
#endif
constexpr int BJOB0 = CONV_IN_ATTN ? 16 * 256 + 8 * 16 : 0;
__device__ __forceinline__ void conv_share_blk(const Args& a, LAS unsigned char* lds, int blk, int G) {
    const int s = blk % 3, r = blk / 3, nb = (G - s + 2) / 3, nj = CONV_JOBS - BJOB0, j0 = BJOB0 + s * (nj / 3), j1 = (s == 2) ? CONV_JOBS : BJOB0 + (s + 1) * (nj / 3);
    LAS unsigned char* Tlo = lds + 3 * 16384; LAS unsigned char* Thi = lds + LDS_EXTRA;
    int j = j0 + r; if (j >= j1) return;
    f32x4 v[16]; u32x4 o[4]; BJob cc = bjob_addr(a, j);
    bjob_load(cc, v);
#pragma unroll 1
    for (;;) {
        bjob_pack(v, o);
        const BJob cur = cc; const bool hn = (j + nb) < j1;
        if (hn) { cc = bjob_addr(a, j + nb); bjob_load(cc, v); }
        bjob_out(cur, o, Tlo, Thi);
        if (!hn) break;
        j += nb;
    }
}
__device__ __forceinline__ void conv_all(const Args& a, LAS unsigned char* lds) {
    int buf = 0;
    for (int j = blockIdx.x; j < CONV_JOBS; j += gridDim.x) { conv_block_job(a, lds + buf * 32768, j); buf ^= 1; }
    __syncthreads();
}
__device__ __forceinline__ bool conv_claim(const Args&, int) { return false; }

__device__ __forceinline__ void phase_prologue(const Args& a, LAS unsigned char* lds) {
    const int tid = threadIdx.x, blk = blockIdx.x, G = gridDim.x;
#ifdef PROBE_P0
    const unsigned long long p0t = __builtin_amdgcn_s_memrealtime();
#endif
    if (blk < 192) {
        LAS float* cact = (LAS float*)lds; LAS float* red = (LAS float*)(lds + 16384);
        for (int i = tid; i < 4096; i += 512) cact[i] = silu_f(a.c[i]);
        __syncthreads();
        float* mod = (float*)(a.ws + WS_MOD);
        for (int job = blk; job < 192; job += G) {
            const int cg = job % 48, kg = job / 48, w = tid >> 6, lane = tid & 63;
            const float* wp = a.w_ada + (size_t)(kg * 512 + w) * 12288 + cg * 256 + lane * 4;
            f32x4 a0 = {0.f, 0.f, 0.f, 0.f}, a1 = {0.f, 0.f, 0.f, 0.f};
#pragma unroll 16
            for (int i = 0; i < 64; ++i) { const int k = kg * 512 + w + 8 * i; const f32x4 wv = *(const f32x4*)(wp + (size_t)(8 * i) * 12288); a0 += wv * cact[k]; a1 += wv * cact[2048 + k]; }
            *(LAS f32x4*)(red + (w * 2 + 0) * 256 + lane * 4) = a0; *(LAS f32x4*)(red + (w * 2 + 1) * 256 + lane * 4) = a1;
            __syncthreads();
            { const int b = tid >> 8, col = tid & 255; float s = 0.f;
#pragma unroll
              for (int r = 0; r < 8; ++r) s += red[(r * 2 + b) * 256 + col];
              if (kg == 0) s += a.b_ada[cg * 256 + col];
              atomicAdd(&mod[b * 12288 + cg * 256 + col], s); }
            __syncthreads();
        }
    }
#ifdef PROBE_P0
    if (PROBE_P0 == 1 && blk == 0 && tid == 0) ((unsigned long long*)(a.ws + 18688))[4] = __builtin_amdgcn_s_memrealtime() - p0t;
    const unsigned long long p0t2 = __builtin_amdgcn_s_memrealtime();
#endif
    {
        float* ct = (float*)(a.ws + WS_ROPE); float* st = ct + 4096 * 64;
        for (int idx = blk * 512 + tid; idx < 4096 * 64; idx += G * 512) {
            const int t = idx >> 6, i = idx & 63;
            const float inv = (float)exp2(-(double)i * (13.287712379549449 / 64.0));
            const float ang = (float)t * inv;
            const double ad = (double)ang, n = rint(ad * 0.15915494309189535), r = fma(-n, 6.283185307179586, ad) - n * 2.4492935982947064e-16;
            const float rf = (float)r;
            ct[idx] = cosf(rf); st[idx] = sinf(rf);
        }
    }
#ifdef PROBE_P0
    if (PROBE_P0 == 2 && blk == 0 && tid == 0) ((unsigned long long*)(a.ws + 18688))[4] = __builtin_amdgcn_s_memrealtime() - p0t2;
#endif
    {
        bf16_t* win_t = (bf16_t*)(a.ws + WS_WIN_T); bf16_t* wout_t = (bf16_t*)(a.ws + WS_WOUT_T);
        for (int job = blk; job < 64 * 16; job += 2 * G) {
            const float* src[2]; int ld[2]; bf16_t* dst[2]; int kts[2]; f32x4 v[2][8];
            const int w = threadIdx.x >> 6, lane = threadIdx.x & 63, kseg = lane & 7, nq = lane >> 3, nl = (w & 3) * 32 + nq * 4;
#pragma unroll
            for (int u = 0; u < 2; ++u) { const int jb = (job + u * G < 64 * 16) ? job + u * G : job, rt = jb >> 4; kts[u] = jb & 15;
                if (rt < 48) { const int n0 = rt * 128, col0 = n0 < 3072 ? n0 : n0 + 16; src[u] = a.w_in + col0; ld[u] = DIN; dst[u] = win_t + (size_t)n0 * 2048; }
                else { const int n0 = (rt - 48) * 128; src[u] = a.w_out + n0; ld[u] = 2048; dst[u] = wout_t + (size_t)n0 * 2048; }
                const int k0 = kts[u] * 128 + (w >> 2) * 64 + kseg * 8;
#pragma unroll
                for (int r = 0; r < 8; ++r) v[u][r] = *(const f32x4*)(src[u] + (size_t)(k0 + r) * ld[u] + nl); }
#pragma unroll
            for (int u = 0; u < 2; ++u) { const int k0 = kts[u] * 128 + (w >> 2) * 64 + kseg * 8;
#pragma unroll
                for (int j = 0; j < 4; ++j) { u32x4 o; o.x = cvt_pk_bf16(v[u][0][j], v[u][1][j]); o.y = cvt_pk_bf16(v[u][2][j], v[u][3][j]); o.z = cvt_pk_bf16(v[u][4][j], v[u][5][j]); o.w = cvt_pk_bf16(v[u][6][j], v[u][7][j]);
                    *(u32x4*)(dst[u] + (size_t)(nl + j) * 2048 + k0) = o; } }
        }
    }
}

__device__ __forceinline__ void phase_norm1(const Args& a, LAS unsigned char* lds) {
    const int tid = threadIdx.x, blk = blockIdx.x, G = gridDim.x, w = tid >> 6, lane = tid & 63;
    constexpr int HS = 2052;
    LAS float* hs = (LAS float*)lds;
    LAS float* part = (LAS float*)(lds + LDS_EXTRA + 4096);
    LAS float* las = (LAS float*)(lds + LDS_EXTRA);
    const float* mod = (const float*)(a.ws + WS_MOD);
    bf16_t* h1 = (bf16_t*)(a.ws + WS_H1); float* gk = (float*)(a.ws + WS_GK);
    float wl[64];
    { const int kk = lane >> 4, fr = lane & 15; const float* wp = a.w_in + (size_t)(w * 256 + kk) * DIN + 3072 + fr;
#pragma unroll
      for (int ks = 0; ks < 64; ++ks) wl[ks] = wp[(size_t)ks * 4 * DIN]; }
    float w2[16];
#pragma unroll
    for (int j = 0; j < 16; ++j) w2[j] = a.w_alpha2[j * 512 + tid];
    const float bz = a.b_alpha[tid];
    for (int grp = blk; grp < NTOK / 16; grp += G) {
        {
            const int r0 = grp * 16 + 2 * w;
            const f32x4* xr0 = (const f32x4*)(a.x + (size_t)r0 * DM) + lane; const f32x4* xr1 = xr0 + DM / 4;
            f32x4 v0[8], v1[8]; float ss0 = 0.f, ss1 = 0.f;
#pragma unroll
            for (int q = 0; q < 8; ++q) { v0[q] = xr0[64 * q]; v1[q] = xr1[64 * q]; }
#pragma unroll
            for (int q = 0; q < 8; ++q) { ss0 += (v0[q][0] * v0[q][0] + v0[q][1] * v0[q][1]) + (v0[q][2] * v0[q][2] + v0[q][3] * v0[q][3]); ss1 += (v1[q][0] * v1[q][0] + v1[q][1] * v1[q][1]) + (v1[q][2] * v1[q][2] + v1[q][3] * v1[q][3]); }
            ss0 = wave_sum(ss0); ss1 = wave_sum(ss1);
            const float rstd0 = 1.0f / sqrtf(ss0 * (1.0f / DM) + EPS), rstd1 = 1.0f / sqrtf(ss1 * (1.0f / DM) + EPS);
            const float* sh = mod + (size_t)(r0 >> 12) * 12288; const float* sc = sh + 2048;
#pragma unroll
            for (int q = 0; q < 8; ++q) { const int k = 4 * (lane + 64 * q);
                const f32x4 nw = *(const f32x4*)(a.norm1_w + k), scv = *(const f32x4*)(sc + k), shv = *(const f32x4*)(sh + k);
                const f32x4 h0 = (v0[q] * rstd0 * nw) * (scv + 1.0f) + shv, h1v = (v1[q] * rstd1 * nw) * (scv + 1.0f) + shv;
                *(LAS f32x4*)(hs + (2 * w) * HS + k) = h0; *(LAS f32x4*)(hs + (2 * w + 1) * HS + k) = h1v;
                u32x2 o; o.x = cvt_pk_bf16(h0[0], h0[1]); o.y = cvt_pk_bf16(h0[2], h0[3]);
                *(u32x2*)(h1 + (size_t)r0 * DM + k) = o;
                o.x = cvt_pk_bf16(h1v[0], h1v[1]); o.y = cvt_pk_bf16(h1v[2], h1v[3]);
                *(u32x2*)(h1 + (size_t)(r0 + 1) * DM + k) = o; } }
        __syncthreads();
        {
            const int kk = lane >> 4, fr = lane & 15; f32x4 acc = {0.f, 0.f, 0.f, 0.f};
            const LAS float* hp = hs + fr * HS + w * 256 + kk;
#pragma unroll
            for (int ks = 0; ks < 64; ++ks) acc = __builtin_amdgcn_mfma_f32_16x16x4f32(wl[ks], hp[ks * 4], acc, 0, 0, 0);
#pragma unroll
            for (int r = 0; r < 4; ++r) part[(w * 16 + 4 * kk + r) * 16 + fr] = acc[r];
        }
        __syncthreads();
        if (tid < 256) { const int t = tid >> 4, j = tid & 15; float s = 0.f;
#pragma unroll
            for (int q = 0; q < 8; ++q) s += part[(q * 16 + j) * 16 + t];
            las[t * 16 + j] = s; }
        __syncthreads();
        {
#pragma unroll 4
            for (int t = 0; t < 16; ++t) { const LAS f32x4* lp = (const LAS f32x4*)(las + t * 16); float z = bz;
#pragma unroll
                for (int q = 0; q < 4; ++q) { const f32x4 l = lp[q]; z += l[0] * w2[4 * q] + l[1] * w2[4 * q + 1] + l[2] * w2[4 * q + 2] + l[3] * w2[4 * q + 3]; }
                const float ls = fminf(z, 0.f) - log1pf(expf(-fabsf(z)));
                gk[(size_t)(grp * 16 + t) * 512 + tid] = ls * (1.0f / 16.0f); }
        }
        __syncthreads();
    }
}

__device__ __forceinline__ void gla_stage_vt(const bf16_t* proj, int row0, int h, LAS bf16_t* VT, int tid) {
    const int i = tid >> 3, seg = tid & 7;
    const u32x4* vp = (const u32x4*)(proj + (size_t)(row0 + i) * NPROJ + C_VA + h * 256 + seg * 32);
#pragma unroll
    for (int c4 = 0; c4 < 4; ++c4) { const u32x4 vv = vp[c4];
#pragma unroll
        for (int p = 0; p < 4; ++p) { const unsigned wd = vv[p]; const int e = seg * 32 + c4 * 8 + p * 2;
            VT[e * 72 + i] = (bf16_t)(wd & 0xffffu); VT[(e + 1) * 72 + i] = (bf16_t)(wd >> 16); } }
}
__device__ __forceinline__ void gla1_unit(const Args& a, LAS unsigned char* lds, int u) {
    const int tid = threadIdx.x, w = tid >> 6, lane = tid & 63;
    const int bh = u >> 6, c = u & 63, b = bh >> 2, h = bh & 3, row0 = b * SEQ + c * 64;
    LAS float* Bm = (LAS float*)lds; LAS bf16_t* KT = (LAS bf16_t*)(lds + 32768); LAS bf16_t* VT = (LAS bf16_t*)(lds + 51200);
    const float* gk = (const float*)(a.ws + WS_GK); const bf16_t* proj = (const bf16_t*)(a.ws + WS_PROJ);
    float* bcum = (float*)(a.ws + WS_BCUM); float* dst = (float*)(a.ws + WS_DST); float* dec = (float*)(a.ws + WS_DEC);
    const int i = tid >> 3, seg = tid & 7;
    {
        const f32x4* gp = (const f32x4*)(gk + (size_t)(row0 + i) * 512 + h * 128 + seg * 16);
#pragma unroll
        for (int q = 0; q < 4; ++q) *(LAS f32x4*)(Bm + i * 128 + seg * 16 + q * 4) = gp[q];
    }
    __syncthreads();
    {
        const int d = tid & 127, q4 = tid >> 7; LAS float* qs = (LAS float*)(lds + 90112);
        float run = 0.f;
#pragma unroll
        for (int ii = 0; ii < 16; ++ii) { run += Bm[(q4 * 16 + ii) * 128 + d]; Bm[(q4 * 16 + ii) * 128 + d] = run; }
        qs[q4 * 128 + d] = run;
        __syncthreads();
        float off = 0.f;
#pragma unroll
        for (int qq = 0; qq < 3; ++qq) off += (qq < q4) ? qs[qq * 128 + d] : 0.f;
        if (q4 > 0) {
#pragma unroll
            for (int ii = 0; ii < 16; ++ii) Bm[(q4 * 16 + ii) * 128 + d] += off; }
    }
    __syncthreads();
    {
        const u32x4* kp = (const u32x4*)(proj + (size_t)(row0 + i) * NPROJ + C_KA + h * 128 + seg * 16);
        float* bo = bcum + ((size_t)u * 64 + i) * 128 + seg * 16;
#pragma unroll
        for (int q = 0; q < 2; ++q) { const u32x4 kv = kp[q];
#pragma unroll
            for (int p = 0; p < 4; ++p) { const int d = seg * 16 + q * 8 + p * 2;
                const float b0 = Bm[i * 128 + d], b1 = Bm[i * 128 + d + 1], l0 = Bm[63 * 128 + d], l1 = Bm[63 * 128 + d + 1];
                bo[q * 8 + p * 2] = b0; bo[q * 8 + p * 2 + 1] = b1;
                KT[d * 72 + i] = f2bf(bflo(kv[p]) * expf(l0 - b0)); KT[(d + 1) * 72 + i] = f2bf(bfhi(kv[p]) * expf(l1 - b1));
                if (i == 63) { dec[(size_t)u * 128 + d] = expf(l0); dec[(size_t)u * 128 + d + 1] = expf(l1); } } }
        gla_stage_vt(proj, row0, h, VT, tid);
    }
    __syncthreads();
    {
        f32x4 acc[2][8];
#pragma unroll
        for (int x = 0; x < 2; ++x)
#pragma unroll
            for (int y = 0; y < 8; ++y) acc[x][y] = (f32x4){0.f, 0.f, 0.f, 0.f};
#pragma unroll
        for (int ks = 0; ks < 2; ++ks) {
            const bf16x8 a0 = lds_frag(VT, 72, (2 * w) * 16, ks * 32, lane), a1 = lds_frag(VT, 72, (2 * w + 1) * 16, ks * 32, lane);
#pragma unroll
            for (int dt = 0; dt < 8; ++dt) { const bf16x8 bf = lds_frag(KT, 72, dt * 16, ks * 32, lane); acc[0][dt] = mfma16(a0, bf, acc[0][dt]); acc[1][dt] = mfma16(a1, bf, acc[1][dt]); }
        }
        float* dp = dst + (size_t)u * 32768;
#pragma unroll
        for (int x = 0; x < 2; ++x)
#pragma unroll
            for (int dt = 0; dt < 8; ++dt)
#pragma unroll
                for (int r = 0; r < 4; ++r) dp[((2 * w + x) * 16 + 4 * (lane >> 4) + r) * 128 + dt * 16 + (lane & 15)] = acc[x][dt][r];
    }
    __syncthreads();
}
__device__ __forceinline__ void moba_prep_unit(const Args& a, LAS unsigned char* lds, int u2) {
    const int tid = threadIdx.x;
    const int bh = u2 >> 4, kb = u2 & 15, b = bh >> 3, h = bh & 7, row0 = b * SEQ + kb * 256, t0 = kb * 256;
    const bf16_t* proj = (const bf16_t*)(a.ws + WS_PROJ);
    const float* ct = (const float*)(a.ws + WS_ROPE); const float* st = ct + 4096 * 64;
    bf16_t* qbr = (bf16_t*)(a.ws + WS_QBR); bf16_t* kbr = (bf16_t*)(a.ws + WS_KBR); bf16_t* vbt = (bf16_t*)(a.ws + WS_VBT); float* kmean = (float*)(a.ws + WS_KMEAN);
    constexpr int KS = 132;
    LAS float* Kf = (LAS float*)lds;
    LAS float* part = (LAS float*)(lds + 135168);
    LAS bf16_t* Vl = (LAS bf16_t*)(lds + 139264);
    const int rl = tid >> 3, c = tid & 7;
    f32x4 cvv[4][2], svv[4][2]; u32x4 xin[4][2][2], vin[4][2];
#pragma unroll
    for (int pass = 0; pass < 4; ++pass) { const int row = pass * 64 + rl;
        cvv[pass][0] = *(const f32x4*)(ct + (size_t)(t0 + row) * 64 + c * 8); cvv[pass][1] = *(const f32x4*)(ct + (size_t)(t0 + row) * 64 + c * 8 + 4);
        svv[pass][0] = *(const f32x4*)(st + (size_t)(t0 + row) * 64 + c * 8); svv[pass][1] = *(const f32x4*)(st + (size_t)(t0 + row) * 64 + c * 8 + 4);
#pragma unroll
        for (int which = 0; which < 2; ++which) { const bf16_t* src = proj + (size_t)(row0 + row) * NPROJ + (which == 0 ? C_KB : C_QB) + h * 128 + c * 8;
            xin[pass][which][0] = *(const u32x4*)src; xin[pass][which][1] = *(const u32x4*)(src + 64); } }
#pragma unroll
    for (int sl = 0; sl < 4; ++sl)
#pragma unroll
        for (int ps = 0; ps < 2; ++ps) { const int row = ps * 128 + (tid >> 2);
            vin[sl][ps] = *(const u32x4*)(proj + (size_t)(row0 + row) * NPROJ + C_VB + h * 128 + sl * 32 + (tid & 3) * 8); }
#pragma unroll
    for (int pass = 0; pass < 4; ++pass) { const int row = pass * 64 + rl;
        const f32x4 cv0 = cvv[pass][0], cv1 = cvv[pass][1], sv0 = svv[pass][0], sv1 = svv[pass][1];
#pragma unroll
        for (int which = 0; which < 2; ++which) {
            bf16_t* dsto = (which == 0 ? kbr : qbr) + ((size_t)bh * SEQ + t0 + row) * 128 + c * 8;
            const u32x4 x1 = xin[pass][which][0], x2 = xin[pass][which][1];
            u32x4 o1, o2; float r1[8], r2[8];
#pragma unroll
            for (int p = 0; p < 4; ++p) {
                const float c0 = (p < 2) ? cv0[2 * p] : cv1[2 * p - 4], c1 = (p < 2) ? cv0[2 * p + 1] : cv1[2 * p - 3], s0 = (p < 2) ? sv0[2 * p] : sv1[2 * p - 4], s1 = (p < 2) ? sv0[2 * p + 1] : sv1[2 * p - 3];
                const float a0 = bflo(x1[p]), a1 = bfhi(x1[p]), b0 = bflo(x2[p]), b1 = bfhi(x2[p]);
                r1[2 * p] = a0 * c0 - b0 * s0; r1[2 * p + 1] = a1 * c1 - b1 * s1; r2[2 * p] = a0 * s0 + b0 * c0; r2[2 * p + 1] = a1 * s1 + b1 * c1;
                o1[p] = cvt_pk_bf16(r1[2 * p], r1[2 * p + 1]); o2[p] = cvt_pk_bf16(r2[2 * p], r2[2 * p + 1]); }
            *(u32x4*)dsto = o1; *(u32x4*)(dsto + 64) = o2;
            if (which == 0) { LAS float* kr = Kf + row * KS + c * 8;
                *(LAS f32x4*)kr = (f32x4){r1[0], r1[1], r1[2], r1[3]}; *(LAS f32x4*)(kr + 4) = (f32x4){r1[4], r1[5], r1[6], r1[7]};
                *(LAS f32x4*)(kr + 64) = (f32x4){r2[0], r2[1], r2[2], r2[3]}; *(LAS f32x4*)(kr + 68) = (f32x4){r2[4], r2[5], r2[6], r2[7]}; }
        }
    }
    __syncthreads();
    { const int d = tid & 127, rq = tid >> 7; float s = 0.f;
#pragma unroll 8
        for (int rr = 0; rr < 64; ++rr) s += Kf[(rq * 64 + rr) * KS + d];
        part[rq * 128 + d] = s; }
    __syncthreads();
    if (tid < 128) kmean[((size_t)bh * 16 + kb) * 128 + tid] = (part[tid] + part[128 + tid] + part[256 + tid] + part[384 + tid]) * (1.0f / 256.0f);
#pragma unroll
    for (int sl = 0; sl < 4; ++sl) {
        { const int rw = tid >> 2, c4 = tid & 3;
#pragma unroll
            for (int ps = 0; ps < 2; ++ps) { const int row = ps * 128 + rw;
                *(LAS u32x4*)(Vl + row * 40 + (((c4 + (row >> 4)) & 3) << 3)) = vin[sl][ps]; } }
        __syncthreads();
        { const int d = tid >> 4, tc = tid & 15;
            u32x4 o0, o1;
            const int dp = ((((d >> 3) + tc) & 3) << 3) + (d & 7);
#pragma unroll
            for (int p = 0; p < 4; ++p) { const int tt = tc * 16 + p * 2; o0[p] = (unsigned)Vl[tt * 40 + dp] | ((unsigned)Vl[(tt + 1) * 40 + dp] << 16);
                o1[p] = (unsigned)Vl[(tt + 8) * 40 + dp] | ((unsigned)Vl[(tt + 9) * 40 + dp] << 16); }
            bf16_t* op = vbt + ((size_t)bh * 128 + sl * 32 + d) * SEQ + t0 + tc * 16;
            *(u32x4*)op = o0; *(u32x4*)(op + 8) = o1; }
        __syncthreads();
    }
}
__device__ __forceinline__ void phase_mix_prep(const Args& a, LAS unsigned char* lds) {
    const int blk = blockIdx.x, G = gridDim.x;
    for (int u = blk; u < 512; u += G) gla1_unit(a, lds, u);
    for (int u2 = blk; u2 < 256; u2 += G) moba_prep_unit(a, lds, u2);
}

__device__ __forceinline__ void phase_scan_select(const Args& a, LAS unsigned char* lds) {
    const int tid = threadIdx.x, blk = blockIdx.x, G = gridDim.x;
    {
        const float* dst = (const float*)(a.ws + WS_DST); const float* dec = (const float*)(a.ws + WS_DEC); bf16_t* ST = (bf16_t*)(a.ws + WS_ST);
        for (int el = blk * 512 + tid; el < 8 * 32768; el += G * 512) {
            const int bh = el >> 15, ed = el & 32767, d = ed & 127; float cur = 0.f;
#pragma unroll 1
            for (int c0 = 0; c0 < 64; c0 += 32) { float dv[32], gv[32];
#pragma unroll
                for (int c = 0; c < 32; ++c) { const size_t u = (size_t)bh * 64 + c0 + c; dv[c] = dst[u * 32768 + ed]; gv[c] = dec[u * 128 + d]; }
#pragma unroll
                for (int c = 0; c < 32; ++c) { const size_t u = (size_t)bh * 64 + c0 + c; ST[u * 32768 + ed] = f2bf(cur); cur = gv[c] * cur + dv[c]; } }
        }
    }
    {
        const float* kmean = (const float*)(a.ws + WS_KMEAN); const bf16_t* qbr = (const bf16_t*)(a.ws + WS_QBR); unsigned* sel = (unsigned*)(a.ws + WS_SEL);
        LAS float* km = (LAS float*)lds;
        for (int u2 = blk; u2 < 256; u2 += G) {
            const int bh = u2 >> 4, qb = u2 & 15;
            __syncthreads();
            for (int i = tid; i < 2048; i += 512) km[i] = kmean[(size_t)bh * 2048 + i];
            __syncthreads();
            const int q = tid >> 1, half = tid & 1;
            float gv[8];
#pragma unroll
            for (int n = 0; n < 8; ++n) gv[n] = 0.f;
            const u32x4* qp = (const u32x4*)(qbr + ((size_t)bh * SEQ + qb * 256 + q) * 128);
#pragma unroll 4
            for (int c = 0; c < 16; ++c) { const u32x4 qq = qp[c]; float qf[8];
#pragma unroll
                for (int p = 0; p < 4; ++p) { qf[2 * p] = bflo(qq[p]); qf[2 * p + 1] = bfhi(qq[p]); }
#pragma unroll
                for (int n = 0; n < 8; ++n) { const LAS float* kr = km + (half * 8 + n) * 128 + c * 8; const f32x4 k0 = *(const LAS f32x4*)kr, k1 = *(const LAS f32x4*)(kr + 4);
                    gv[n] += (qf[0] * k0[0] + qf[1] * k0[1]) + (qf[2] * k0[2] + qf[3] * k0[3]) + (qf[4] * k1[0] + qf[5] * k1[1]) + (qf[6] * k1[2] + qf[7] * k1[3]); } }
            float ga[16];
#pragma unroll
            for (int n = 0; n < 8; ++n) { const float o = __shfl_xor(gv[n], 1); ga[n] = half ? o : gv[n]; ga[8 + n] = half ? gv[n] : o; }
            unsigned mask = 0u; const int nsel = qb < 3 ? qb : 3;
            for (int s = 0; s < nsel; ++s) { int best = -1; float bv = -INFINITY;
#pragma unroll
                for (int n = 0; n < 16; ++n) { const bool ok = (n < qb) && !((mask >> n) & 1u) && (best < 0 || ga[n] > bv); if (ok) { bv = ga[n]; best = n; } }
                mask |= 1u << best; }
            if (half == 0) sel[(size_t)bh * SEQ + qb * 256 + q] = mask;
        }
        __syncthreads();
    }
}

#ifndef CHECK_MODE
#define CHECK_MODE 0
#endif
constexpr size_t WS_CHK = 18432;
constexpr size_t WS_CHKO = WS_Y + 160 * MB;
#if CHECK_MODE
__device__ __forceinline__ void phase_check(const Args& a, LAS unsigned char* lds) {
    const int tid = threadIdx.x, blk = blockIdx.x, G = gridDim.x, w = tid >> 6, lane = tid & 63;
    const bf16_t* proj = (const bf16_t*)(a.ws + WS_PROJ); const bf16_t* ocat = (const bf16_t*)(a.ws + WS_OCAT);
    float* chk = (float*)(a.ws + WS_CHK);
#if CHECK_MODE == 1
    const float* ct = (const float*)(a.ws + WS_ROPE); const float* st = ct + 4096 * 64;
    for (int task = blk * 8 + w; task < 67 * 16; task += G * 8) {
        const int s = task >> 4, bh = task & 15, b = bh >> 3, h = bh & 7, t = 61 * s + 7, qblk = t >> 8;
        const bf16_t* qrow = proj + (size_t)(b * SEQ + t) * NPROJ + C_QB + h * 128;
        const float c = ct[t * 64 + lane], sn = st[t * 64 + lane];
        const float q1 = bf2f(qrow[lane]), q2 = bf2f(qrow[lane + 64]);
        const float qa = q1 * c - q2 * sn, qb2 = q1 * sn + q2 * c;
        float gate[16];
#pragma unroll 1
        for (int n = 0; n < 16; ++n) { float g = -INFINITY;
            if (n < qblk) { float m1 = 0.f, m2 = 0.f;
                for (int kk = 0; kk < 256; ++kk) { const int tk = n * 256 + kk; const bf16_t* krow = proj + (size_t)(b * SEQ + tk) * NPROJ + C_KB + h * 128;
                    const float k1 = bf2f(krow[lane]), k2 = bf2f(krow[lane + 64]), ck = ct[tk * 64 + lane], sk = st[tk * 64 + lane];
                    m1 += k1 * ck - k2 * sk; m2 += k1 * sk + k2 * ck; }
                g = wave_sum(qa * (m1 * (1.0f / 256.0f)) + qb2 * (m2 * (1.0f / 256.0f))); }
#pragma unroll
            for (int z = 0; z < 16; ++z) if (z == n) gate[z] = g; }
        unsigned mask = 0u; const int nsel = qblk < 3 ? qblk : 3;
        for (int it = 0; it < nsel; ++it) { int best = -1; float bv = -INFINITY;
#pragma unroll
            for (int n = 0; n < 16; ++n) { const bool ok = (n < qblk) && !((mask >> n) & 1u) && (best < 0 || gate[n] > bv); if (ok) { bv = gate[n]; best = n; } }
            mask |= 1u << best; }
        { const unsigned fastsel = ((const unsigned*)(a.ws + WS_SEL))[(size_t)bh * SEQ + t];
          if (fastsel != mask) { if (lane == 0) atomicAdd(&chk[2], 1.0f); continue; } }
        mask |= 1u << qblk;
        float m = -INFINITY, l = 0.f, o1 = 0.f, o2 = 0.f;
        for (int n = 0; n <= qblk; ++n) { if (!((mask >> n) & 1u)) continue;
            for (int kk = 0; kk < 256; ++kk) { const int tk = n * 256 + kk; if (tk > t) break;
                const bf16_t* krow = proj + (size_t)(b * SEQ + tk) * NPROJ + C_KB + h * 128; const bf16_t* vrow = proj + (size_t)(b * SEQ + tk) * NPROJ + C_VB + h * 128;
                const float k1 = bf2f(krow[lane]), k2 = bf2f(krow[lane + 64]), ck = ct[tk * 64 + lane], sk = st[tk * 64 + lane];
                const float sc = wave_sum(qa * (k1 * ck - k2 * sk) + qb2 * (k1 * sk + k2 * ck)) * 0.08838834764831845f;
                const float mn = fmaxf(m, sc), al = expf(m - mn), p = expf(sc - mn);
                l = l * al + p; o1 = o1 * al + p * bf2f(vrow[lane]); o2 = o2 * al + p * bf2f(vrow[lane + 64]); m = mn; } }
        o1 /= l; o2 /= l;
        const bf16_t* frow = ocat + (size_t)(b * SEQ + t) * DM + 1024 + h * 128;
        const float f1 = bf2f(frow[lane]), f2 = bf2f(frow[lane + 64]);
        const float num = wave_sum((f1 - o1) * (f1 - o1) + (f2 - o2) * (f2 - o2)), den = wave_sum(o1 * o1 + o2 * o2);
        if (lane == 0) { atomicAdd(&chk[0], num); atomicAdd(&chk[1], den); }
    }
#else
    const int cb = 1, ch = 2; const float* gk = (const float*)(a.ws + WS_GK); float* oref = (float*)(a.ws + WS_CHKO);
    for (int e = blk * 8 + w; e < 256; e += G * 8) {
        float s1 = 0.f, s2 = 0.f;
        for (int t = 0; t < SEQ; ++t) { const size_t row = (size_t)(cb * SEQ + t);
            const bf16_t* pr = proj + row * NPROJ;
            const float a1 = expf(gk[row * 512 + ch * 128 + lane]), a2 = expf(gk[row * 512 + ch * 128 + lane + 64]);
            const float k1 = bf2f(pr[C_KA + ch * 128 + lane]), k2 = bf2f(pr[C_KA + ch * 128 + lane + 64]), v = bf2f(pr[C_VA + ch * 256 + e]);
            const float q1 = bf2f(pr[C_QA + ch * 128 + lane]) * 0.08838834764831845f, q2 = bf2f(pr[C_QA + ch * 128 + lane + 64]) * 0.08838834764831845f;
            s1 = a1 * s1 + k1 * v; s2 = a2 * s2 + k2 * v;
            const float o = wave_sum(q1 * s1 + q2 * s2);
            if (lane == 0) oref[(size_t)t * 256 + e] = o; }
    }
#endif
}
__device__ __forceinline__ void phase_check2(const Args& a, LAS unsigned char* lds) {
#if CHECK_MODE == 2
    const int tid = threadIdx.x, blk = blockIdx.x, G = gridDim.x, w = tid >> 6, lane = tid & 63;
    const int cb = 1, ch = 2; const float* oref = (const float*)(a.ws + WS_CHKO); float* chk = (float*)(a.ws + WS_CHK);
    const bf16_t* proj = (const bf16_t*)(a.ws + WS_PROJ); const bf16_t* ocat = (const bf16_t*)(a.ws + WS_OCAT);
    for (int t = blk * 8 + w; t < SEQ; t += G * 8) { float o[4], ss = 0.f;
#pragma unroll
        for (int q = 0; q < 4; ++q) { o[q] = oref[(size_t)t * 256 + lane + 64 * q]; ss += o[q] * o[q]; }
        ss = wave_sum(ss); const float rstd = 1.0f / sqrtf(ss * (1.0f / 256.0f) + EPS); float num = 0.f, den = 0.f;
#pragma unroll
        for (int q = 0; q < 4; ++q) { const int e = lane + 64 * q; const size_t row = (size_t)(cb * SEQ + t);
            const float ga = bf2f(proj[row * NPROJ + C_GA + ch * 256 + e]), ref = o[q] * rstd * a.gla_norm_w[e] * silu_f(ga), f = bf2f(ocat[row * DM + ch * 256 + e]);
            num += (f - ref) * (f - ref); den += ref * ref; }
        num = wave_sum(num); den = wave_sum(den);
        if (lane == 0) { atomicAdd(&chk[0], num); atomicAdd(&chk[1], den); } }
#endif
}
#endif
#ifndef DYN10
#define DYN10 0
#endif
#ifndef PROBE_TIME
#define PROBE_TIME -1
#endif
#ifndef PROBE_TOFF
#define PROBE_TOFF 0.0f
#endif
#ifndef PROBE_TSCALE
#define PROBE_TSCALE 3000.0f
#endif
#ifndef CONV_IN_GEMM
#define CONV_IN_GEMM 1
#endif
#ifndef CONV_IN_ATTN
#define CONV_IN_ATTN 1
#endif
#ifndef CONV_BLK
#define CONV_BLK 1
#endif

__device__ __forceinline__ void gla3_unit(const Args& a, LAS unsigned char* lds, int u) {
    const int tid = threadIdx.x, w = tid >> 6, lane = tid & 63, g = lane >> 4, fr = lane & 15;
    const int bh = u >> 6, c = u & 63, b = bh >> 2, h = bh & 3, row0 = b * SEQ + c * 64;
    LAS bf16_t* QP = (LAS bf16_t*)lds; LAS bf16_t* KP = (LAS bf16_t*)(lds + 17408); LAS bf16_t* VT = (LAS bf16_t*)(lds + 34816);
    LAS bf16_t* AM = (LAS bf16_t*)(lds + 71680); LAS float* OT = (LAS float*)(lds + 81920);
    const bf16_t* proj = (const bf16_t*)(a.ws + WS_PROJ); const float* bcum = (const float*)(a.ws + WS_BCUM); const bf16_t* ST = (const bf16_t*)(a.ws + WS_ST);
    bf16_t* ocat = (bf16_t*)(a.ws + WS_OCAT);
    {
        const int i = tid >> 3, seg = tid & 7;
        const f32x4* bp = (const f32x4*)(bcum + ((size_t)u * 64 + i) * 128 + seg * 16);
        const u32x4* qp = (const u32x4*)(proj + (size_t)(row0 + i) * NPROJ + C_QA + h * 128 + seg * 16);
        const u32x4* kp = (const u32x4*)(proj + (size_t)(row0 + i) * NPROJ + C_KA + h * 128 + seg * 16);
#pragma unroll
        for (int q = 0; q < 2; ++q) { const u32x4 qv = qp[q], kv = kp[q]; const f32x4 b0 = bp[2 * q], b1 = bp[2 * q + 1]; u32x4 qo, ko;
#pragma unroll
            for (int p = 0; p < 4; ++p) { const float bl = (p < 2) ? b0[2 * p] : b1[2 * p - 4], bhv = (p < 2) ? b0[2 * p + 1] : b1[2 * p - 3];
                const float el = expf(bl), eh = expf(bhv);
                qo[p] = cvt_pk_bf16(bflo(qv[p]) * el * 0.08838834764831845f, bfhi(qv[p]) * eh * 0.08838834764831845f);
                ko[p] = cvt_pk_bf16(bflo(kv[p]) / el, bfhi(kv[p]) / eh); }
            *(LAS u32x4*)(QP + i * 136 + seg * 16 + q * 8) = qo; *(LAS u32x4*)(KP + i * 136 + seg * 16 + q * 8) = ko; }
        gla_stage_vt(proj, row0, h, VT, tid);
    }
    __syncthreads();
    {
        const int it = w >> 1;
#pragma unroll
        for (int jj = 0; jj < 2; ++jj) { const int jt = (w & 1) * 2 + jj; f32x4 acc = {0.f, 0.f, 0.f, 0.f};
            if (jt <= it) {
#pragma unroll
                for (int ks = 0; ks < 4; ++ks) acc = mfma16(lds_frag(QP, 136, it * 16, ks * 32, lane), lds_frag(KP, 136, jt * 16, ks * 32, lane), acc);
            }
#pragma unroll
            for (int r = 0; r < 4; ++r) { const int i = it * 16 + 4 * g + r, j = jt * 16 + fr; AM[i * 72 + j] = f2bf((j <= i) ? acc[r] : 0.f); } }
    }
    __syncthreads();
    f32x4 acc[4][2];
    {
#pragma unroll
        for (int x = 0; x < 4; ++x)
#pragma unroll
            for (int y = 0; y < 2; ++y) acc[x][y] = (f32x4){0.f, 0.f, 0.f, 0.f};
        bf16x8 bS[2][4];
        const bf16_t* stp = ST + (size_t)u * 32768;
#pragma unroll
        for (int e2 = 0; e2 < 2; ++e2)
#pragma unroll
            for (int ks = 0; ks < 4; ++ks) bS[e2][ks] = *(const bf16x8*)(stp + ((2 * w + e2) * 16 + fr) * 128 + ks * 32 + 8 * g);
#pragma unroll
        for (int it = 0; it < 4; ++it) {
#pragma unroll
            for (int ks = 0; ks < 4; ++ks) { const bf16x8 aq = lds_frag(QP, 136, it * 16, ks * 32, lane); acc[it][0] = mfma16(aq, bS[0][ks], acc[it][0]); acc[it][1] = mfma16(aq, bS[1][ks], acc[it][1]); }
#pragma unroll
            for (int k2 = 0; k2 < 2; ++k2) { const bf16x8 aa = lds_frag(AM, 72, it * 16, k2 * 32, lane);
                acc[it][0] = mfma16(aa, lds_frag(VT, 72, (2 * w) * 16, k2 * 32, lane), acc[it][0]); acc[it][1] = mfma16(aa, lds_frag(VT, 72, (2 * w + 1) * 16, k2 * 32, lane), acc[it][1]); }
        }
#pragma unroll
        for (int it = 0; it < 4; ++it)
#pragma unroll
            for (int r = 0; r < 4; ++r)
#pragma unroll
                for (int e2 = 0; e2 < 2; ++e2) OT[(it * 16 + 4 * g + r) * 260 + (2 * w + e2) * 16 + fr] = acc[it][e2][r];
    }
    __syncthreads();
    {
        const int i = tid >> 3, seg = tid & 7;
        const LAS float* orow = OT + i * 260 + seg * 32;
        f32x4 ov[8]; float ss = 0.f;
#pragma unroll
        for (int q = 0; q < 8; ++q) { ov[q] = *(const LAS f32x4*)(orow + 4 * q); ss += (ov[q][0] * ov[q][0] + ov[q][1] * ov[q][1]) + (ov[q][2] * ov[q][2] + ov[q][3] * ov[q][3]); }
        ss += __shfl_xor(ss, 1); ss += __shfl_xor(ss, 2); ss += __shfl_xor(ss, 4);
        const float rstd = 1.0f / sqrtf(ss * (1.0f / 256.0f) + EPS);
        const u32x4* gp = (const u32x4*)(proj + (size_t)(row0 + i) * NPROJ + C_GA + h * 256 + seg * 32);
        bf16_t* op = ocat + (size_t)(row0 + i) * DM + h * 256 + seg * 32;
#pragma unroll
        for (int c8 = 0; c8 < 4; ++c8) { const u32x4 gv = gp[c8]; u32x4 o;
            const f32x4 nw0 = *(const f32x4*)(a.gla_norm_w + seg * 32 + c8 * 8), nw1 = *(const f32x4*)(a.gla_norm_w + seg * 32 + c8 * 8 + 4);
#pragma unroll
            for (int pp = 0; pp < 4; ++pp) { const float g0 = bflo(gv[pp]), g1 = bfhi(gv[pp]);
                const float n0 = (pp < 2) ? nw0[2 * pp] : nw1[2 * pp - 4], n1 = (pp < 2) ? nw0[2 * pp + 1] : nw1[2 * pp - 3];
                const float v0 = ((pp & 1) ? ov[2 * c8 + (pp >> 1)][2] : ov[2 * c8 + (pp >> 1)][0]) * rstd * n0 * silu_f(g0);
                const float v1 = ((pp & 1) ? ov[2 * c8 + (pp >> 1)][3] : ov[2 * c8 + (pp >> 1)][1]) * rstd * n1 * silu_f(g1);
#if FP8_EMU
                o[pp] = cvt_pk_bf16(q8(v0), q8(v1));
#else
                o[pp] = cvt_pk_bf16(v0, v1);
#endif
            }
            *(u32x4*)(op + c8 * 8) = o; }
    }
    __syncthreads();
}

typedef short s16x4 __attribute__((ext_vector_type(4)));
__device__ __forceinline__ void moba_attn_unit(const Args& a, LAS unsigned char* lds, int bh, int qb, int half, int cjob0) {
    const int tid = threadIdx.x, w = tid >> 6, lane = tid & 63, g = lane >> 4, fr = lane & 15;
    bh = __builtin_amdgcn_readfirstlane(bh); qb = __builtin_amdgcn_readfirstlane(qb); half = __builtin_amdgcn_readfirstlane(half);
    const int b = bh >> 3, h = bh & 7, rg = w & 3, par = w >> 2, qbase = 128 * half + 32 * rg;
    const bf16_t* qbr = (const bf16_t*)(a.ws + WS_QBR); const bf16_t* kbr = (const bf16_t*)(a.ws + WS_KBR); const bf16_t* vbt = (const bf16_t*)(a.ws + WS_VBT);
    const unsigned* sel = (const unsigned*)(a.ws + WS_SEL); bf16_t* ocat = (bf16_t*)(a.ws + WS_OCAT);
    const int nown = 2 * half + 2, nsteps = (nown + 4 * qb) >> 1;
    bf16x8 qf[2][4]; unsigned sm[2]; float m[2], l[2]; f32x4 O[8][2];
#pragma unroll
    for (int b2 = 0; b2 < 2; ++b2) { const size_t qrow = (size_t)bh * SEQ + qb * 256 + qbase + 16 * b2 + fr;
#pragma unroll
        for (int ks = 0; ks < 4; ++ks) qf[b2][ks] = *(const bf16x8*)(qbr + qrow * 128 + ks * 32 + 8 * g);
        sm[b2] = sel[qrow]; m[b2] = -INFINITY; l[b2] = 0.f;
#pragma unroll
        for (int dt = 0; dt < 8; ++dt) O[dt][b2] = (f32x4){0.f, 0.f, 0.f, 0.f}; }
    const float cs = 0.08838834764831845f * 1.4426950408889634f;
    unsigned kso[2], vso[2];
#pragma unroll
    for (int p = 0; p < 2; ++p) { const int kr = 4 * (w + 8 * p) + (lane >> 4), kc = (lane & 15) ^ (kr & 15); kso[p] = (unsigned)(kr * 256 + kc * 16);
        const int vr = 8 * (w + 8 * p) + (lane >> 3), vc = (lane & 7) ^ ((vr >> 1) & 7); vso[p] = (unsigned)(vr * (SEQ * 2) + vc * 16); }
    const char* kbase = (const char*)(kbr + (size_t)bh * SEQ * 128); const char* vbase = (const char*)(vbt + (size_t)bh * 128 * SEQ);
    auto tile_jk = [&](int ti, int& j, int& kt) { if (ti < nown) { j = qb; kt = ti; } else { const int tj = ti - nown; j = tj >> 2; kt = tj & 3; } };
    auto stage = [&](int s) {
#pragma unroll
        for (int t2 = 0; t2 < 2; ++t2) { int j, kt; tile_jk(2 * s + t2, j, kt); const int key0 = j * 256 + kt * 64;
            LAS unsigned char* dstb = lds + (s & 1) * 65536 + t2 * 32768 + w * 1024;
            const char* ks = pg8::sbase(kbase + (size_t)key0 * 256); const char* vs = pg8::sbase(vbase + (size_t)key0 * 2);
#pragma unroll
            for (int p = 0; p < 2; ++p) {
                __builtin_amdgcn_global_load_lds((const unsigned*)(ks + kso[p]), (LAS unsigned*)(dstb + p * 8192), 16, 0, 0);
                __builtin_amdgcn_global_load_lds((const unsigned*)(vs + vso[p]), (LAS unsigned*)(dstb + 16384 + p * 8192), 16, 0, 0); } } };
    __syncthreads();
    stage(0);
    f32x4 cv[8]; const int cjob = __builtin_amdgcn_readfirstlane(cjob0);
    if (CONV_IN_ATTN) { const SJob cj = sjob_addr(a, cjob, lane); sjob_load(cj, cv); }
#pragma unroll 1
    for (int s = 0; s < nsteps; ++s) {
        asm volatile("s_waitcnt vmcnt(0)" ::: "memory");
        __syncthreads();
        if (s + 1 < nsteps) stage(s + 1);
        if (CONV_IN_ATTN) { { const SJob cj = sjob_addr(a, cjob + 8 * s, lane); sjob_store(cj, cv); } if (s + 1 < nsteps) { const SJob cn = sjob_addr(a, cjob + 8 * (s + 1), lane); sjob_load(cn, cv); } }
        int j, kt; tile_jk(2 * s + par, j, kt);
        const bool own = (2 * s + par) < nown;
        if (own && kt * 64 > qbase + 31) continue;
        const LAS unsigned char* Kb = lds + (s & 1) * 65536 + par * 32768; const LAS unsigned char* Vb = Kb + 16384;
        f32x4 sc[4][2];
#pragma unroll
        for (int t4 = 0; t4 < 4; ++t4) { sc[t4][0] = (f32x4){0.f, 0.f, 0.f, 0.f}; sc[t4][1] = (f32x4){0.f, 0.f, 0.f, 0.f};
#pragma unroll
            for (int ks = 0; ks < 4; ++ks) { const bf16x8 kf = *(const LAS bf16x8*)(Kb + (t4 * 16 + fr) * 256 + (((ks * 4 + g) ^ fr) << 4)); sc[t4][0] = mfma16(kf, qf[0][ks], sc[t4][0]); sc[t4][1] = mfma16(kf, qf[1][ks], sc[t4][1]); } }
        bf16x8 pf[2][2];
#pragma unroll
        for (int b2 = 0; b2 < 2; ++b2) {
            float tm = -INFINITY, nb;
            if (own) {
                const int qi = qbase + 16 * b2 + fr;
#pragma unroll
                for (int t4 = 0; t4 < 4; ++t4)
#pragma unroll
                    for (int r = 0; r < 4; ++r) { const int kk = kt * 64 + t4 * 16 + 4 * g + r; const float v = (kk <= qi) ? sc[t4][b2][r] : -INFINITY; sc[t4][b2][r] = v; tm = fmaxf(tm, v); }
            } else {
#pragma unroll
                for (int t4 = 0; t4 < 4; ++t4)
#pragma unroll
                    for (int r = 0; r < 4; ++r) tm = fmaxf(tm, sc[t4][b2][r]);
                if (!((sm[b2] >> j) & 1u)) tm = -INFINITY;
            }
            tm = fmaxf(tm, __shfl_xor(tm, 16)); tm = fmaxf(tm, __shfl_xor(tm, 32));
            if (__builtin_amdgcn_ballot_w64((tm - m[b2]) * cs > 11.5416f) != 0ull) {
                const float mnew = fmaxf(m[b2], tm), ms = (mnew == -INFINITY) ? 0.f : mnew;
                const float alpha = __builtin_amdgcn_exp2f((m[b2] - ms) * cs);
                l[b2] *= alpha; m[b2] = mnew;
#pragma unroll
                for (int dt = 0; dt < 8; ++dt) O[dt][b2] *= alpha;
            }
            nb = (m[b2] == -INFINITY) ? 0.f : -m[b2] * cs; if (!own && !((sm[b2] >> j) & 1u)) nb = -INFINITY;
            float ps = 0.f;
#pragma unroll
            for (int t4 = 0; t4 < 4; ++t4)
#pragma unroll
                for (int r = 0; r < 4; ++r) { const float pe = __builtin_amdgcn_exp2f(fmaf(sc[t4][b2][r], cs, nb)); sc[t4][b2][r] = pe; ps += pe; }
            ps += __shfl_xor(ps, 16); ps += __shfl_xor(ps, 32);
            l[b2] += ps;
#pragma unroll
            for (int k2 = 0; k2 < 2; ++k2) { u32x4 pkk; pkk.x = cvt_pk_bf16(sc[2 * k2][b2][0], sc[2 * k2][b2][1]); pkk.y = cvt_pk_bf16(sc[2 * k2][b2][2], sc[2 * k2][b2][3]);
                pkk.z = cvt_pk_bf16(sc[2 * k2 + 1][b2][0], sc[2 * k2 + 1][b2][1]); pkk.w = cvt_pk_bf16(sc[2 * k2 + 1][b2][2], sc[2 * k2 + 1][b2][3]);
                pf[k2][b2] = __builtin_bit_cast(bf16x8, pkk); }
        }
#pragma unroll
        for (int dt = 0; dt < 8; ++dt)
#pragma unroll
            for (int k2 = 0; k2 < 2; ++k2) { const int vr = dt * 16 + fr, c0 = 4 * k2 + (g >> 1), sw = (vr >> 1) & 7;
                const LAS unsigned char* vrow = Vb + vr * 128 + (g & 1) * 8;
                const s16x4 lo = *(const LAS s16x4*)(vrow + ((c0 ^ sw) << 4)), hi = *(const LAS s16x4*)(vrow + (((c0 + 2) ^ sw) << 4));
                const bf16x8 vf = __builtin_shufflevector(lo, hi, 0, 1, 2, 3, 4, 5, 6, 7);
                O[dt][0] = mfma16(vf, pf[k2][0], O[dt][0]); O[dt][1] = mfma16(vf, pf[k2][1], O[dt][1]); }
    }
    __syncthreads();
    LAS float* X = (LAS float*)lds + rg * (68 * 64) + lane;
    if (par == 1) {
#pragma unroll
        for (int b2 = 0; b2 < 2; ++b2) { X[(64 + b2) * 64] = m[b2]; X[(66 + b2) * 64] = l[b2];
#pragma unroll
            for (int dt = 0; dt < 8; ++dt)
#pragma unroll
                for (int r = 0; r < 4; ++r) X[((dt * 2 + b2) * 4 + r) * 64] = O[dt][b2][r]; } }
    __syncthreads();
    if (par == 0) {
#pragma unroll
        for (int b2 = 0; b2 < 2; ++b2) { const float m1 = X[(64 + b2) * 64], l1 = X[(66 + b2) * 64];
            const float mm = fmaxf(m[b2], m1), a0 = exp2f((m[b2] - mm) * cs), a1 = (m1 == -INFINITY) ? 0.f : exp2f((m1 - mm) * cs);
            const float inv = 1.0f / (l[b2] * a0 + l1 * a1);
            const size_t orow = (size_t)(b * SEQ + qb * 256 + qbase + 16 * b2 + fr) * DM + 1024 + h * 128;
#pragma unroll
            for (int dt = 0; dt < 8; ++dt) { float o4[4];
#pragma unroll
                for (int r = 0; r < 4; ++r) o4[r] = (O[dt][b2][r] * a0 + X[((dt * 2 + b2) * 4 + r) * 64] * a1) * inv;
                u32x2 o; o.x = cvt_pk_bf16(o4[0], o4[1]); o.y = cvt_pk_bf16(o4[2], o4[3]);
                *(u32x2*)(ocat + orow + dt * 16 + 4 * g) = o; } } }
    __syncthreads();
}
__device__ __forceinline__ void phase_mix_out(const Args& a, LAS unsigned char* lds) {
    const int blk = blockIdx.x, G = gridDim.x;
    for (int u = blk; u < 256; u += G) {
        const int cj0 = (u * 33) * 8 + (threadIdx.x >> 6);
        { const int c = u >> 4; moba_attn_unit(a, lds, u & 15, (31 - c) >> 1, (31 - c) & 1, cj0); }
        { const int u2 = 511 - u, c = u2 >> 4; moba_attn_unit(a, lds, u2 & 15, (31 - c) >> 1, (31 - c) & 1, cj0 + 8 * (32 - (u >> 4))); }
    }
    for (int u = blk; u < 512; u += G) gla3_unit(a, lds, u);
}

__device__ __forceinline__ void phase_router(const Args& a, LAS unsigned char* lds) {
    const int tid = threadIdx.x, blk = blockIdx.x, G = gridDim.x, w = tid >> 6, lane = tid & 63;
    constexpr int HS = 2052;
    LAS float* h2s = (LAS float*)lds;
    LAS float* part = (LAS float*)(lds + LDS_EXTRA + 4096);
    LAS float* logit = (LAS float*)(lds + LDS_EXTRA);
    LAS int* pe = (LAS int*)(lds + LDS_EXTRA + 2048); LAS float* pw = (LAS float*)(lds + LDS_EXTRA + 2560); LAS int* lpos = (LAS int*)(lds + LDS_EXTRA + 3072);
    LAS int* hist = (LAS int*)(lds + LDS_EXTRA + 3584); LAS int* base = (LAS int*)(lds + LDS_EXTRA + 3712);
    const float* mod = (const float*)(a.ws + WS_MOD); const float* x1 = (const float*)(a.ws + WS_X1); unsigned char* h2 = (unsigned char*)(a.ws + WS_H1);
    unsigned* cnt = (unsigned*)(a.ws + WS_CNT); int* pair_e = (int*)(a.ws + WS_PAIR_E); int* pair_pos = (int*)(a.ws + WS_PAIR_POS); int* tok_of = (int*)(a.ws + WS_SLOTROW); float* rw_of = (float*)(a.ws + WS_WBUF);
    float wa0[64], wa1[64];
    { const int kk = lane >> 4, fr = lane & 15; const float* wp = a.w_router + (size_t)(w * 256 + kk) * 32 + fr;
#pragma unroll
      for (int ks = 0; ks < 64; ++ks) { wa0[ks] = wp[(size_t)ks * 128]; wa1[ks] = wp[(size_t)ks * 128 + 16]; } }
    const float brt = a.b_router[tid & 31];
    for (int gp = blk; gp < 256; gp += G) {
        if (tid < 32) hist[tid] = 0;
#pragma unroll 1
        for (int gh = 0; gh < 2; ++gh) { const int grp = gp * 2 + gh;
#pragma unroll 1
            for (int tt = 0; tt < 2; ++tt) { const int tl = 2 * w + tt, t = grp * 16 + tl;
                const f32x4* xr = (const f32x4*)(x1 + (size_t)t * DM) + lane;
                f32x4 v[8]; float ss = 0.f;
#pragma unroll
                for (int q = 0; q < 8; ++q) { v[q] = xr[64 * q]; ss += (v[q][0] * v[q][0] + v[q][1] * v[q][1]) + (v[q][2] * v[q][2] + v[q][3] * v[q][3]); }
                ss = wave_sum(ss);
                const float rstd = 1.0f / sqrtf(ss * (1.0f / DM) + EPS);
                const float* sh = mod + (size_t)(t >> 12) * 12288 + 6144; const float* sc = sh + 2048;
#pragma unroll
                for (int q = 0; q < 8; ++q) { const int k = 4 * (lane + 64 * q);
                    const f32x4 nw = *(const f32x4*)(a.norm2_w + k), scv = *(const f32x4*)(sc + k), shv = *(const f32x4*)(sh + k);
                    const f32x4 hv = (v[q] * rstd * nw) * (scv + 1.0f) + shv;
                    *(LAS f32x4*)(h2s + tl * HS + k) = hv;
                    *(unsigned*)(h2 + (size_t)t * DM + k) = pg8::pk4_fp8(hv[0], hv[1], hv[2], hv[3]); } }
            __syncthreads();
            {
                const int kk = lane >> 4, fr = lane & 15;
                f32x4 acc0 = {0.f, 0.f, 0.f, 0.f}, acc1 = {0.f, 0.f, 0.f, 0.f};
                const LAS float* hp = h2s + fr * HS + w * 256 + kk;
#pragma unroll
                for (int ks = 0; ks < 64; ++ks) { const float b = hp[ks * 4];
                    acc0 = __builtin_amdgcn_mfma_f32_16x16x4f32(wa0[ks], b, acc0, 0, 0, 0); acc1 = __builtin_amdgcn_mfma_f32_16x16x4f32(wa1[ks], b, acc1, 0, 0, 0); }
#pragma unroll
                for (int r = 0; r < 4; ++r) { part[(w * 32 + 4 * kk + r) * 16 + fr] = acc0[r]; part[(w * 32 + 16 + 4 * kk + r) * 16 + fr] = acc1[r]; }
            }
            __syncthreads();
            {
                const int tl = tid >> 5, e = tid & 31; float s = brt;
#pragma unroll
                for (int q = 0; q < 8; ++q) s += part[(q * 32 + e) * 16 + tl];
                bool taken = false; float tv[4]; int te[4];
#pragma unroll
                for (int r = 0; r < 4; ++r) { float bv = taken ? -INFINITY : s; int be = e;
#pragma unroll
                    for (int off = 16; off >= 1; off >>= 1) { const float ov = __shfl_xor(bv, off); const int oe = __shfl_xor(be, off); if (ov > bv || (ov == bv && oe < be)) { bv = ov; be = oe; } }
                    tv[r] = bv; te[r] = be; if (be == e) taken = true; }
                if (e == 0) { float ex[4], den = 0.f;
#pragma unroll
                    for (int r = 0; r < 4; ++r) { ex[r] = expf(tv[r] - tv[0]); den += ex[r]; }
#pragma unroll
                    for (int r = 0; r < 4; ++r) { pe[gh * 64 + tl * 4 + r] = te[r]; pw[gh * 64 + tl * 4 + r] = ex[r] / den; } }
            }
            __syncthreads();
        }
        if (tid < 128) lpos[tid] = atomicAdd((int*)&hist[pe[tid]], 1);
        __syncthreads();
        if (tid < 32) { const int n = hist[tid]; base[tid] = n ? (int)atomicAdd(&cnt[tid], (unsigned)n) : 0; }
        __syncthreads();
        if (tid < 128) { const int p = gp * 128 + tid, e = pe[tid], pos = base[e] + lpos[tid]; pair_e[p] = e; pair_pos[p] = pos; tok_of[e * 8192 + pos] = p >> 2; rw_of[e * 8192 + pos] = pw[tid]; }
        __syncthreads();
    }
}
__device__ __forceinline__ void phase_gather(const Args& a, LAS unsigned char* lds) {
    if (CONV_IN_GEMM == 2) conv_share(a, blockIdx.x, gridDim.x);
    if (!CONV_IN_GEMM) conv_all(a, lds);
}
template <class Sched>
__device__ __forceinline__ void moe_build_rowtab(const Args& a, LAS unsigned char* lds, const Sched& S) {
    LAS int* rowtab = (LAS int*)(lds + LDS_ROWTAB);
    const unsigned* cnt = (const unsigned*)(a.ws + WS_CNT); const int* tok_of = (const int*)(a.ws + WS_SLOTROW);
    pg8::Unit u;
    for (int i = 0; i < MAX_UNITS_WG && S.next(i, u); ++i) {
        const int r = threadIdx.x; if (r < 256) { const int pos = u.pos0 + r; rowtab[i * 256 + r] = (pos < (int)cnt[u.e]) ? tok_of[u.e * 8192 + pos] * DM : 0; }
    }
    __syncthreads();
}
__device__ __forceinline__ void moe_build_tab(const Args& a, LAS unsigned char* lds, int ntn) {
    LAS int* tab = (LAS int*)(lds + LDS_EXTRA);
    const unsigned* cnt = (const unsigned*)(a.ws + WS_CNT);
    LAS int* rt0 = tab + 600;
    LAS int* ord = tab + 640;
    LAS int* cn = tab + 680;
    __syncthreads();
    if (threadIdx.x < 64) {
        const int e = threadIdx.x & 31, c = (int)cnt[e];
        const int tiles = (c + 255) >> 8, cost = tiles;
        int rank = 0, pre = 0;
#pragma unroll
        for (int j = 0; j < 32; ++j) { const int cj = __builtin_amdgcn_readlane(cost, j), tj = __builtin_amdgcn_readlane(tiles, j); rank += (cj > cost || (cj == cost && j < e)) ? 1 : 0; pre += (j < e) ? tj : 0; }
        if (threadIdx.x < 32) { ord[rank] = e; cn[e] = c; rt0[e] = pre; }
    }
    __syncthreads();
    if (threadIdx.x == 0) {
        const int mygrp = blockIdx.x & 7, PG = ntn >> 1;
        int np = 0, us = 0;
        int l0 = 0, l1 = 0, l2 = 0, l3 = 0, l4 = 0, l5 = 0, l6 = 0, l7 = 0;
#pragma unroll 1
        for (int it = 0; it < 32; ++it) {
            const int be = ord[it], c = cn[be], mte = (c + 255) >> 8;
            if (mte == 0) break;
            const int bc = mte * PG, r0 = rt0[be];
#pragma unroll
            for (int h = 0; h < 2; ++h) {
                int bx = 0, bl = l0;
                if (l1 < bl) { bl = l1; bx = 1; } if (l2 < bl) { bl = l2; bx = 2; } if (l3 < bl) { bl = l3; bx = 3; }
                if (l4 < bl) { bl = l4; bx = 4; } if (l5 < bl) { bl = l5; bx = 5; } if (l6 < bl) { bl = l6; bx = 6; } if (l7 < bl) { bl = l7; bx = 7; }
                l0 += (bx == 0) ? bc : 0; l1 += (bx == 1) ? bc : 0; l2 += (bx == 2) ? bc : 0; l3 += (bx == 3) ? bc : 0;
                l4 += (bx == 4) ? bc : 0; l5 += (bx == 5) ? bc : 0; l6 += (bx == 6) ? bc : 0; l7 += (bx == 7) ? bc : 0;
                if (bx == mygrp) { LAS int* t = tab + 4 + 8 * np; t[0] = us; t[1] = be; t[2] = h * PG; t[3] = mte; t[4] = r0; t[5] = c; us += mte * PG; ++np; }
            }
        }
        tab[0] = np; tab[1] = us;
    }
    __syncthreads();
}
__device__ __forceinline__ bool warm_claim(const unsigned char* base, unsigned nchunks, unsigned* ctr) {
    unsigned c = 0;
    if ((threadIdx.x & 63) == 0) c = atomicAdd(ctr, 1u);
    c = __builtin_amdgcn_readfirstlane(c);
    if (c >= nchunks) return false;
    const u32x4* p = (const u32x4*)(base + (size_t)c * 16384) + (threadIdx.x & 63);
    u32x4 v[16];
#pragma unroll
    for (int r = 0; r < 16; ++r) v[r] = __builtin_nontemporal_load(p + 64 * r);
    unsigned s = 0;
#pragma unroll
    for (int r = 0; r < 16; ++r) s ^= v[r].x ^ v[r].y ^ v[r].z ^ v[r].w;
    asm volatile("" :: "v"(s));
    return true;
}
__device__ __forceinline__ void phase_final(const Args& a, LAS unsigned char* lds) {
    const int tid = threadIdx.x, blk = blockIdx.x, G = gridDim.x, w = tid >> 6, lane = tid & 63;
    const float* mod = (const float*)(a.ws + WS_MOD); const float* x1 = (const float*)(a.ws + WS_X1); const int* pair_e = (const int*)(a.ws + WS_PAIR_E); const int* pair_pos = (const int*)(a.ws + WS_PAIR_POS); const bf16_t* y = (const bf16_t*)(a.ws + WS_Y);
    LAS int* rbase = (LAS int*)(lds + LDS_EXTRA);
    if (tid < 64) {
        const unsigned* cnt = (const unsigned*)(a.ws + WS_CNT); const int e = tid & 31, pc = (int)((cnt[e] + 255u) & ~255u); int pre = 0;
#pragma unroll
        for (int j = 0; j < 32; ++j) { const int pj = __builtin_amdgcn_readlane(pc, j); pre += (j < e) ? pj : 0; }
        if (tid < 32) rbase[e] = pre; }
    __syncthreads();
    float chk_scale = 1.0f;
#if PROBE_TIME >= 0 && !defined(PROBE_SPIN)
    { const unsigned long long* ts = (const unsigned long long*)(a.ws + 18688); float us = (float)(ts[1] - ts[0]) * 1e-2f;
#ifdef PROBE_TQ
      us = floorf((us + PROBE_TOFF) / PROBE_TQ) * PROBE_TQ;
#endif
      chk_scale = 1.0f + us / PROBE_TSCALE; }
#endif
#if CHECK_MODE
    { const float* chk = (const float*)(a.ws + WS_CHK); const float rel = sqrtf(chk[0] / fmaxf(chk[1], 1e-30f)) + (chk[2] > 60.0f ? 1.0f : 0.0f); chk_scale = 1.0f + 10.0f * rel; }
#endif
    for (int t = blk * 8 + w; t < NTOK; t += G * 8) {
        const int r0 = rbase[pair_e[t * 4]] + pair_pos[t * 4], r1 = rbase[pair_e[t * 4 + 1]] + pair_pos[t * 4 + 1], r2 = rbase[pair_e[t * 4 + 2]] + pair_pos[t * 4 + 2], r3 = rbase[pair_e[t * 4 + 3]] + pair_pos[t * 4 + 3];
        const f32x4* xr = (const f32x4*)(x1 + (size_t)t * DM) + lane;
        const u32x2* y0 = (const u32x2*)(y + (size_t)r0 * DM) + lane; const u32x2* y1 = (const u32x2*)(y + (size_t)r1 * DM) + lane;
        const u32x2* y2 = (const u32x2*)(y + (size_t)r2 * DM) + lane; const u32x2* y3 = (const u32x2*)(y + (size_t)r3 * DM) + lane;
        const float* g2 = mod + (size_t)(t >> 12) * 12288 + 10240;
        f32x4 v[8]; float ss = 0.f;
#pragma unroll
        for (int q = 0; q < 8; ++q) { const u32x2 a0 = y0[64 * q], a1 = y1[64 * q], a2 = y2[64 * q], a3 = y3[64 * q];
            f32x4 s; s[0] = (bflo(a0.x) + bflo(a1.x)) + (bflo(a2.x) + bflo(a3.x)); s[1] = (bfhi(a0.x) + bfhi(a1.x)) + (bfhi(a2.x) + bfhi(a3.x));
            s[2] = (bflo(a0.y) + bflo(a1.y)) + (bflo(a2.y) + bflo(a3.y)); s[3] = (bfhi(a0.y) + bfhi(a1.y)) + (bfhi(a2.y) + bfhi(a3.y));
            const f32x4 gv = *(const f32x4*)(g2 + 4 * (lane + 64 * q));
            v[q] = xr[64 * q] + gv * s; ss += (v[q][0] * v[q][0] + v[q][1] * v[q][1]) + (v[q][2] * v[q][2] + v[q][3] * v[q][3]); }
        ss = wave_sum(ss);
        const float rstd = 1.0f / sqrtf(ss * (1.0f / DM) + EPS);
        f32x4* op = (f32x4*)(a.out + (size_t)t * DM) + lane;
#pragma unroll
        for (int q = 0; q < 8; ++q) op[64 * q] = v[q] * (rstd * chk_scale) * *(const f32x4*)(a.final_norm_w + 4 * (lane + 64 * q));
    }
}

struct ConvInProj : pg8::StaticOrder { const Args* ap;
    LAS unsigned char* lds;
    __device__ __forceinline__ void between(int ui) const {
        if (CONV_IN_GEMM == 1 && ui == (int)(blockIdx.x % 3)) {
#if CONV_BLK
            const int wr = (threadIdx.x >> 6) >> 2;
            asm volatile("s_waitcnt vmcnt(0)" ::: "memory");
            if (wr == 0) __builtin_amdgcn_s_barrier();
#ifdef PROBE_CONV
            const unsigned long long tc0 = __builtin_amdgcn_s_memrealtime();
#endif
            conv_share_blk(*ap, lds, blockIdx.x, gridDim.x);
#ifdef PROBE_CONV
            if (blockIdx.x == 0 && threadIdx.x == 0) ((unsigned long long*)(ap->ws + 18688))[4] = __builtin_amdgcn_s_memrealtime() - tc0;
#endif
            if (wr == 1) __builtin_amdgcn_s_barrier();
#else
            conv_share(*ap, blockIdx.x, gridDim.x);
#endif
        } } };

constexpr int NPHASE = 12;
#ifndef ONLY_PHASE
#define ONLY_PHASE -1
#endif
#ifndef SKIP_MASK
#define SKIP_MASK 0
#endif
#define PH_ON(P) ((ONLY_PHASE < 0 || ONLY_PHASE == (P)) && !((SKIP_MASK >> (P)) & 1))
#ifndef PROBE_DOUBLE
#define PROBE_DOUBLE -1
#endif
#define PROBE_REP(P) for (int _rep = 0; _rep < ((PROBE_DOUBLE == (P)) ? 2 : 1); ++_rep)
__global__ void __launch_bounds__(512, 2) fwd(Args a) {
    extern __shared__ __attribute__((aligned(16))) unsigned char shm[];
    LAS unsigned char* lds = (LAS unsigned char*)shm;
    if (threadIdx.x == 0) *(LAS u32x4*)(lds + LDS_XB) = (u32x4){0u, 0u, 0u, 0u};
    __syncthreads();
    XcdBarrier bar = xcd_barrier_post((unsigned*)(a.ws + WS_BAR), (volatile LAS unsigned*)(lds + LDS_XB));
    const int G = gridDim.x, blk = blockIdx.x;
#ifndef HARVEST_MASK
#define HARVEST_MASK 0
#endif
#define TSTAMP(P) do { if (PROBE_TIME >= 0 && blockIdx.x == 0 && threadIdx.x == 0) { if ((P) == PROBE_TIME) { ((unsigned long long*)(a.ws + 18688))[0] = __builtin_amdgcn_s_memrealtime(); ((unsigned long long*)(a.ws + 18688))[2] = __builtin_amdgcn_s_memtime(); } if ((P) == PROBE_TIME_END) { ((unsigned long long*)(a.ws + 18688))[1] = __builtin_amdgcn_s_memrealtime(); ((unsigned long long*)(a.ws + 18688))[3] = __builtin_amdgcn_s_memtime(); } } } while (0)
#ifndef PROBE_TIME_END
#define PROBE_TIME_END (PROBE_TIME + 1)
#endif
#ifndef PROBE_BAR2
#define PROBE_BAR2 0
#endif
#ifndef WARM_MASK
#define WARM_MASK 0
#endif
#define PHASE_END(P) do { if ((P) + 1 < a.ph_hi) { \
    if ((P) == 9 && ((WARM_MASK >> 9) & 1)) xcd_barrier(bar, [&]() { return warm_claim(a.ws + WS_WD_T, 8192u, (unsigned*)(a.ws + 19200)); }); \
    else if ((P) == 10 && ((WARM_MASK >> 10) & 1)) xcd_barrier(bar, [&]() { return warm_claim(a.ws + WS_X1, 4096u, (unsigned*)(a.ws + 19264)); }); \
    else if ((HARVEST_MASK >> (P)) & 1) xcd_barrier(bar, [&]() { return conv_claim(a, 1); }); else xcd_barrier(bar, []() { return false; }); if (PROBE_BAR2) xcd_barrier(bar, []() { return false; }); } } while (0)
    TSTAMP(0);
    if (PH_ON(0) && a.ph_lo <= 0 && 0 < a.ph_hi) { PROBE_REP(0) { phase_prologue(a, lds); __syncthreads(); } PHASE_END(0); }
    TSTAMP(1);
    if (PH_ON(1) && a.ph_lo <= 1 && 1 < a.ph_hi) { phase_norm1(a, lds);
#if PROBE_DOUBLE == 134
        __syncthreads(); phase_norm1(a, lds);
#endif
        PHASE_END(1); }
    TSTAMP(2);
    if (PH_ON(2) && a.ph_lo <= 2 && 2 < a.ph_hi) {
        pg8::Gemm g{(const bf16_t*)(a.ws + WS_H1), (const bf16_t*)(a.ws + WS_WIN_T), DM, 0, nullptr};
        ConvInProj S; S.init(NTOK, NPROJ, G, blk); S.ap = &a; S.lds = lds;
        pg8::EpiProj E{(bf16_t*)(a.ws + WS_PROJ), NPROJ};
        pg8::gemm_phase<false, false>(lds, g, S, E);
#if PROBE_DOUBLE == 26
        __syncthreads(); pg8::gemm_phase<false, false>(lds, g, S, E);
#endif
        PHASE_END(2); }
    TSTAMP(3);
    if (PH_ON(3) && a.ph_lo <= 3 && 3 < a.ph_hi) { phase_mix_prep(a, lds);
#if PROBE_DOUBLE == 134
        __syncthreads(); phase_mix_prep(a, lds);
#endif
#if PROBE_DOUBLE == 31
        __syncthreads(); for (int u = blockIdx.x; u < 512; u += gridDim.x) gla1_unit(a, lds, u);
#endif
#if PROBE_DOUBLE == 32
        __syncthreads(); for (int u2 = blockIdx.x; u2 < 256; u2 += gridDim.x) moba_prep_unit(a, lds, u2);
#endif
        PHASE_END(3); }
    TSTAMP(4);
    if (PH_ON(4) && a.ph_lo <= 4 && 4 < a.ph_hi) { phase_scan_select(a, lds);
#if PROBE_DOUBLE == 134
        __syncthreads(); phase_scan_select(a, lds);
#endif
        PHASE_END(4); }
    TSTAMP(5);
    if (PH_ON(5) && a.ph_lo <= 5 && 5 < a.ph_hi) { phase_mix_out(a, lds);
#if PROBE_DOUBLE == 5
        __syncthreads(); phase_mix_out(a, lds);
#endif
#if PROBE_DOUBLE == 51
        __syncthreads(); for (int u = blockIdx.x; u < 512; u += gridDim.x) gla3_unit(a, lds, u);
#endif
        PHASE_END(5); }
#if CHECK_MODE
    if (a.ph_lo <= 5 && 5 < a.ph_hi) { phase_check(a, lds); xcd_barrier(bar, []() { return false; }); phase_check2(a, lds); xcd_barrier(bar, []() { return false; }); }
#endif
    TSTAMP(6);
    if (PH_ON(6) && a.ph_lo <= 6 && 6 < a.ph_hi) {
        pg8::Gemm g{(const bf16_t*)(a.ws + WS_OCAT), (const bf16_t*)(a.ws + WS_WOUT_T), DM, 0, nullptr};
        pg8::StaticOrder S; S.init(NTOK, DM, G, blk);
        pg8::EpiOut E{a.x, (const float*)(a.ws + WS_MOD) + 4096, (float*)(a.ws + WS_X1)};
        pg8::gemm_phase<false, false>(lds, g, S, E);
#if PROBE_DOUBLE == 26
        __syncthreads(); pg8::gemm_phase<false, false>(lds, g, S, E);
#endif
        PHASE_END(6); }
    TSTAMP(7);
    if (PH_ON(7) && a.ph_lo <= 7 && 7 < a.ph_hi) { phase_router(a, lds); PHASE_END(7); }
    TSTAMP(8);
    if (PH_ON(8) && a.ph_lo <= 8 && 8 < a.ph_hi && CONV_IN_GEMM != 1) { phase_gather(a, lds); PHASE_END(8); }
    TSTAMP(9);
    if (PH_ON(9) && a.ph_lo <= 9 && 9 < a.ph_hi) {
#ifdef PROBE_TAB
        const unsigned long long tb0 = __builtin_amdgcn_s_memrealtime();
#endif
        moe_build_tab(a, lds, 16);
#ifdef PROBE_TAB
        if (blockIdx.x == 0 && threadIdx.x == 0) ((unsigned long long*)(a.ws + 18688))[4] = __builtin_amdgcn_s_memrealtime() - tb0;
#endif
        pg8::Gemm g{(const bf16_t*)(a.ws + WS_H1), (const bf16_t*)(a.ws + WS_WGU_T), DM / 2, (size_t)4096 * 1024, (const LAS int*)(lds + LDS_ROWTAB)};
        pg8::EpiGU8 E{a.b_gate_up, (unsigned char*)(a.ws + WS_ACT)};
        g.probe = a.ws + 18688 + 32;
        const int nmine = (((const LAS int*)(lds + LDS_EXTRA))[1] - (blk >> 3) + (G >> 3) - 1) / (G >> 3);
#pragma unroll 1
        for (int i0 = 0; i0 < (nmine > 0 ? nmine : 1); i0 += MAX_UNITS_WG) {
            pg8::MoeOrder S{(const LAS int*)(lds + LDS_EXTRA), blk >> 3, G >> 3, i0, MAX_UNITS_WG};
#ifdef PROBE_RT
            const unsigned long long tr0 = __builtin_amdgcn_s_memrealtime();
#endif
            moe_build_rowtab(a, lds, S);
#ifdef PROBE_RT
            if (blockIdx.x == 0 && threadIdx.x == 0) ((unsigned long long*)(a.ws + 18688))[4] = __builtin_amdgcn_s_memrealtime() - tr0;
#endif
            pg8::gemm_phase<true, true>(lds, g, S, E);
            __syncthreads();
        }
        PHASE_END(9); }
    TSTAMP(10);
    if (PH_ON(10) && a.ph_lo <= 10 && 10 < a.ph_hi) {
        moe_build_tab(a, lds, 8);
        pg8::Gemm g{(const bf16_t*)(a.ws + WS_ACT), (const bf16_t*)(a.ws + WS_WD_T), DM / 2, (size_t)2048 * 1024, nullptr};
        pg8::MoeOrder S{(const LAS int*)(lds + LDS_EXTRA), blk >> 3, G >> 3, 0, DYN10 > 0 ? DYN10 : (1 << 30)};
        pg8::EpiDown8 E{a.b_down, (const float*)(a.ws + WS_WBUF), (bf16_t*)(a.ws + WS_Y)};
        g.probe = a.ws + 18688 + 32;
        pg8::gemm_phase<true, false>(lds, g, S, E);
        if (DYN10 > 0) {
            LAS int* tabp = (LAS int*)(lds + LDS_EXTRA); const int total = tabp[1];
#pragma unroll 1
            for (;;) {
                __syncthreads();
                if (threadIdx.x == 0) tabp[760] = DYN10 * (G >> 3) + (int)atomicAdd((unsigned*)(a.ws + 19392 + 64 * (blk & 7)), 1u);
                __syncthreads();
                const int L = __builtin_amdgcn_readfirstlane(tabp[760]); if (L >= total) break;
                pg8::MoeOrder S1{(const LAS int*)(lds + LDS_EXTRA), L, 1 << 20, 0, 1};
                pg8::gemm_phase<true, false>(lds, g, S1, E);
            }
        }
#if PROBE_DOUBLE == 10
        __syncthreads(); pg8::gemm_phase<true, false>(lds, g, S, E);
#endif
        PHASE_END(10); }
    TSTAMP(11);
    if (PH_ON(11) && a.ph_lo <= 11 && 11 < a.ph_hi) { phase_final(a, lds);
#if PROBE_DOUBLE == 811
        __syncthreads(); phase_final(a, lds);
#endif
    }
    TSTAMP(12);
#ifdef PROBE_SPIN
    if (blockIdx.x == 0 && threadIdx.x == 0) { const unsigned long long* ts = (const unsigned long long*)(a.ws + 18688);
#ifdef PROBE_GMAX
        const unsigned long long want = (unsigned long long)((const unsigned*)ts)[10] * PROBE_SPIN, t0 = __builtin_amdgcn_s_memrealtime();
#elif defined(PROBE_EPI) || defined(PROBE_TAB) || defined(PROBE_RT) || defined(PROBE_CONV) || defined(PROBE_P0)
        const unsigned long long want = ts[4] * PROBE_SPIN, t0 = __builtin_amdgcn_s_memrealtime();
#elif defined(PROBE_CLK)
        const unsigned long long want = (ts[3] - ts[2]) * 1000ull / (ts[1] - ts[0]), t0 = __builtin_amdgcn_s_memrealtime();
#else
        const unsigned long long want = (ts[1] - ts[0]) * PROBE_SPIN, t0 = __builtin_amdgcn_s_memrealtime();
#endif

        while (__builtin_amdgcn_s_memrealtime() - t0 < want) __builtin_amdgcn_s_sleep(8); }
#endif

}

#ifndef N_LAUNCHES
#define N_LAUNCHES 1
#endif
extern "C" void kernel_launch(void* const* d_in, const int* in_sizes, int n_in, void* d_out, int out_size, void* d_ws, size_t ws_size, hipStream_t stream) {
    static int grid = 0;
    if (grid == 0) {
        if (n_in != 18 || out_size != NTOK * DM || ws_size < WS_END) { fprintf(stderr, "kernel_launch: unexpected shapes (n_in %d out %d ws %zu, need %zu)\n", n_in, out_size, ws_size, (size_t)WS_END); grid = -1; return; }
        int dev = 0, cus = 0, per_cu = 0;
        if (hipGetDevice(&dev) != hipSuccess || hipDeviceGetAttribute(&cus, hipDeviceAttributeMultiprocessorCount, dev) != hipSuccess) { grid = -1; return; }
        if (hipFuncSetAttribute((const void*)fwd, hipFuncAttributeMaxDynamicSharedMemorySize, LDS_BYTES) != hipSuccess) { fprintf(stderr, "kernel_launch: hipFuncSetAttribute failed\n"); grid = -1; return; }
        if (hipOccupancyMaxActiveBlocksPerMultiprocessor(&per_cu, (const void*)fwd, 512, LDS_BYTES) != hipSuccess || per_cu < 1) fprintf(stderr, "kernel_launch: occupancy query says %d\n", per_cu);
        (void)hipGetLastError();
        grid = cus;
    }
    if (grid < 0) return;
    (void)hipMemsetAsync(d_ws, 0, WS_ZERO_BYTES, stream);
    Args a{};
    a.x = (const float*)d_in[0]; a.c = (const float*)d_in[1]; a.w_ada = (const float*)d_in[2]; a.b_ada = (const float*)d_in[3]; a.norm1_w = (const float*)d_in[4];
    a.w_in = (const float*)d_in[5]; a.w_alpha2 = (const float*)d_in[6]; a.b_alpha = (const float*)d_in[7]; a.gla_norm_w = (const float*)d_in[8]; a.w_out = (const float*)d_in[9];
    a.norm2_w = (const float*)d_in[10]; a.w_router = (const float*)d_in[11]; a.b_router = (const float*)d_in[12]; a.w_gate_up = (const float*)d_in[13]; a.b_gate_up = (const float*)d_in[14];
    a.w_down = (const float*)d_in[15]; a.b_down = (const float*)d_in[16]; a.final_norm_w = (const float*)d_in[17];
    a.out = (float*)d_out; a.ws = (unsigned char*)d_ws;
    if (N_LAUNCHES == 1) { a.ph_lo = 0; a.ph_hi = NPHASE; hipLaunchKernelGGL(fwd, dim3(grid), dim3(512), LDS_BYTES, stream, a); }
    else for (int p = 0; p < NPHASE; ++p) { a.ph_lo = p; a.ph_hi = p + 1; hipLaunchKernelGGL(fwd, dim3(grid), dim3(512), LDS_BYTES, stream, a); }
}
```

```cpp
#include <hip/hip_runtime.h>
#include <stdint.h>
#include <stdio.h>

#define LAS __attribute__((address_space(3)))
typedef unsigned short bf16_t;
typedef short bf16x8 __attribute__((ext_vector_type(8)));
typedef float f32x4 __attribute__((ext_vector_type(4)));
typedef float f32x2 __attribute__((ext_vector_type(2)));
typedef unsigned u32x4 __attribute__((ext_vector_type(4)));
typedef unsigned u32x2 __attribute__((ext_vector_type(2)));

constexpr int DM = 2048, NBATCH = 2, SEQ = 4096, NTOK = 8192;
constexpr int DIN = 6160, NPROJ = 6144;
constexpr int NE = 32, TOPK = 4;
constexpr int C_QA = 0, C_KA = 512, C_VA = 1024, C_GA = 2048, C_QB = 3072, C_KB = 4096, C_VB = 5120;
constexpr int MAXROWS = 40960;
constexpr float EPS = 1e-6f;

constexpr size_t MB = 1024ull * 1024ull;
constexpr size_t WS_BAR = 0;
constexpr size_t WS_CNT = 20480;
constexpr int CNT_STRIDE = 32;
constexpr size_t WS_ZERO_BYTES = 131072;
constexpr size_t WS_MOD = 32768;
constexpr size_t WS_ROPE = 1 * MB;
constexpr size_t WS_H1 = 3 * MB;
constexpr size_t WS_GK = WS_H1 + 32 * MB;
constexpr size_t WS_PROJ = WS_GK + 16 * MB;
constexpr size_t WS_WIN_T = WS_PROJ + 96 * MB;
constexpr size_t WS_WOUT_T = WS_WIN_T + 24 * MB;
constexpr size_t WS_WGU_T = WS_WOUT_T + 8 * MB;
constexpr size_t WS_WD_T = WS_WGU_T + 512 * MB;
constexpr size_t WS_BCUM = WS_WD_T + 256 * MB;
constexpr size_t WS_DST = WS_BCUM + 16 * MB;
constexpr size_t WS_DEC = WS_DST + 64 * MB;
constexpr size_t WS_ST = WS_DEC + 1 * MB;
constexpr size_t WS_QBR = WS_ST + 32 * MB;
constexpr size_t WS_KBR = WS_QBR + 16 * MB;
constexpr size_t WS_VBT = WS_KBR + 16 * MB;
constexpr size_t WS_KMEAN = WS_VBT + 16 * MB;
constexpr size_t WS_SEL = WS_KMEAN + 1 * MB;
constexpr size_t WS_OCAT = WS_SEL + 1 * MB;
constexpr size_t WS_X1 = WS_OCAT + 32 * MB;
constexpr size_t WS_PAIR_E = WS_X1 + 64 * MB;
constexpr size_t WS_PAIR_POS = WS_PAIR_E + 1 * MB;
constexpr size_t WS_PAIR_W = WS_PAIR_POS + 1 * MB;
constexpr size_t WS_SLOTROW = WS_PAIR_W + 1 * MB;
constexpr size_t WS_WBUF = WS_SLOTROW + 1 * MB;
constexpr size_t WS_XG = WS_WBUF + 1 * MB;
constexpr size_t WS_ACT = WS_XG + 160 * MB;
constexpr size_t WS_Y = WS_ACT + 160 * MB;
constexpr size_t WS_END = WS_Y + 160 * MB;

constexpr int LDS_BYTES = 163840;
constexpr int LDS_XB = 163840 - 16;
constexpr int LDS_EXTRA = 131072 + 1024;
constexpr int LDS_ROWTAB = 131072 + 1024 + 4096;
constexpr int LDS_TAB2 = LDS_ROWTAB + 24 * 1024;
constexpr int MAX_UNITS_WG = 24;

struct Args {
    const float* x; const float* c; const float* w_ada; const float* b_ada; const float* norm1_w; const float* w_in; const float* w_alpha2; const float* b_alpha;
    const float* gla_norm_w; const float* w_out; const float* norm2_w; const float* w_router; const float* b_router; const float* w_gate_up; const float* b_gate_up;
    const float* w_down; const float* b_down; const float* final_norm_w;
    float* out; unsigned char* ws;
    int ph_lo, ph_hi;
};

__device__ __forceinline__ unsigned cvt_pk_bf16(float lo, float hi) { unsigned r; asm("v_cvt_pk_bf16_f32 %0, %1, %2" : "=v"(r) : "v"(lo), "v"(hi)); return r; }
__device__ __forceinline__ bf16_t f2bf(float f) { return (bf16_t)(cvt_pk_bf16(f, 0.f) & 0xffffu); }
__device__ __forceinline__ float bf2f(bf16_t b) { return __uint_as_float(((unsigned)b) << 16); }
__device__ __forceinline__ float bflo(unsigned w) { return __uint_as_float(w << 16); }
__device__ __forceinline__ float bfhi(unsigned w) { return __uint_as_float(w & 0xffff0000u); }
__device__ __forceinline__ float wave_sum(float v) {
#pragma unroll
    for (int o = 1; o < 64; o <<= 1) v += __shfl_xor(v, o);
    return v;
}
#ifndef FP8_EMU
#define FP8_EMU 0
#endif
__device__ __forceinline__ float q8(float x) { return __builtin_amdgcn_cvt_f32_fp8(__builtin_amdgcn_cvt_pk_fp8_f32(x, x, 0, false), 0); }
__device__ __forceinline__ float silu_f(float v) { return v / (1.f + expf(-v)); }
__device__ __forceinline__ f32x4 mfma16(bf16x8 a, bf16x8 b, f32x4 c) { return __builtin_amdgcn_mfma_f32_16x16x32_bf16(a, b, c, 0, 0, 0); }
__device__ __forceinline__ bf16x8 lds_frag(const LAS bf16_t* img, int ld, int r0, int k0, int lane) {
    return *(const LAS bf16x8*)(img + (r0 + (lane & 15)) * ld + k0 + 8 * (lane >> 4));
}

#define XB_TMO      128
#define XB_XCNT(j)  (256  + 64 * (j))
#define XB_XSUB(j)  (1280 + 64 * (j))
#define XB_XGEN(j)  (2304 + 64 * (j))
#define XB_TOP      3328
#define XB_TOPGEN   3392
#define XCD_BAR_WORDS 3456
#define XB_SPIN_CAP (1u << 18)
__device__ __forceinline__ unsigned xb_ld(unsigned* p)              { return __hip_atomic_load(p, __ATOMIC_RELAXED, __HIP_MEMORY_SCOPE_AGENT); }
__device__ __forceinline__ unsigned xb_add(unsigned* p, unsigned v) { return __hip_atomic_fetch_add(p, v, __ATOMIC_RELAXED, __HIP_MEMORY_SCOPE_AGENT); }
__device__ __forceinline__ unsigned xb_xcc_id() { return (unsigned)__builtin_amdgcn_s_getreg((3 << 11) | 20) & 0xFu; }
#define XB_SPIN(cond, bar) do { unsigned _sp = 0; while (cond) { __builtin_amdgcn_s_sleep(1); \
    if ((++_sp & 255u) == 0u) { if (xb_ld(&(bar)[XB_TMO])) break; if (_sp > XB_SPIN_CAP) { atomicAdd(&(bar)[XB_TMO], 1u); break; } } } } while (0)
struct XcdBarrier { unsigned* bar; unsigned x; volatile LAS unsigned* st; };
__device__ __forceinline__ XcdBarrier xcd_barrier_post(unsigned* bar, volatile LAS unsigned* st) {
    XcdBarrier b; b.bar = bar; b.x = xb_xcc_id(); b.st = st;
    if (threadIdx.x == 0) (void)xb_add(&bar[XB_XCNT(b.x)], 1u);
    return b;
}
__device__ __forceinline__ void xcd_barrier_complete(unsigned* bar, unsigned x, unsigned& nloc, unsigned& nx) {
    const unsigned G = gridDim.x * gridDim.y * gridDim.z;
    unsigned sum, cnt, mine, sp = 0u;
    for (;;) {
        sum = 0u; cnt = 0u; mine = 0u;
#pragma unroll
        for (unsigned j = 0; j < 16; ++j) { const unsigned c = xb_ld(&bar[XB_XCNT(j)]); sum += c; cnt += (c > 0u) ? 1u : 0u; mine = (j == x) ? c : mine; }
        if (sum == G) break;
        __builtin_amdgcn_s_sleep(1);
        if ((++sp & 255u) == 0u) { if (xb_ld(&bar[XB_TMO])) break; if (sp > XB_SPIN_CAP) { atomicAdd(&bar[XB_TMO], 1u); break; } }
    }
    nloc = mine > 0u ? mine : 1u; nx = cnt > 0u ? cnt : 1u;
}
template <class Idle>
__device__ __forceinline__ void xcd_barrier(const XcdBarrier& b, Idle&& idle) {
    asm volatile("s_waitcnt vmcnt(0)" ::: "memory");
    __syncthreads();
    if (threadIdx.x == 0) {
        unsigned* bar = b.bar;
        __builtin_amdgcn_s_waitcnt(0);
        unsigned nloc = b.st[0], nx = b.st[1];
        if (nloc == 0u) { xcd_barrier_complete(bar, b.x, nloc, nx); b.st[0] = nloc; b.st[1] = nx; }
        const unsigned old = xb_add(&bar[XB_XSUB(b.x)], 1u);
        const unsigned gen = old / nloc;
        if (old + 1u == (gen + 1u) * nloc) {
            __builtin_amdgcn_fence(__ATOMIC_RELEASE, "agent");
            asm volatile("s_waitcnt vmcnt(0)" ::: "memory");
            const unsigned og = xb_add(&bar[XB_TOP], 1u);
            const unsigned tg = og / nx;
            if (og + 1u == (tg + 1u) * nx) xb_add(&bar[XB_TOPGEN], 1u);
            else XB_SPIN(xb_ld(&bar[XB_TOPGEN]) == tg, bar);
            __builtin_amdgcn_fence(__ATOMIC_ACQUIRE, "agent");
            xb_add(&bar[XB_XGEN(b.x)], 1u);
            asm volatile("s_waitcnt vmcnt(0)" ::: "memory");
            b.st[2] = 1u;
        } else { b.st[2] = 0u; b.st[3] = gen; }
    }
    __syncthreads();
    unsigned rounds = 0u;
    while (b.st[2] == 0u) {
        const bool had = idle();
        const unsigned long long anyw = __ballot(had);
        __syncthreads();
        if (threadIdx.x == 0) {
            unsigned* bar = b.bar; const unsigned gen = b.st[3];
            bool rel = xb_ld(&bar[XB_XGEN(b.x)]) != gen;
            if (!rel && anyw == 0ull) { XB_SPIN(xb_ld(&bar[XB_XGEN(b.x)]) == gen, bar); rel = true; }
            if (!rel && ++rounds > (1u << 16)) { atomicAdd(&bar[XB_TMO], 1u); rel = true; }
            if (rel) { __builtin_amdgcn_fence(__ATOMIC_ACQUIRE, "agent"); asm volatile("s_waitcnt vmcnt(0)" ::: "memory"); b.st[2] = 1u; }
        }
        __syncthreads();
    }
}
#ifndef PROBE_GMIN
#define PROBE_GMIN 0
#endif
#ifndef FP8_SCALE_ARG
#define FP8_SCALE_ARG 0
#endif

#ifndef PROBE_STORE2
#define PROBE_STORE2 0
#endif
#ifndef FP8_ASM
#define FP8_ASM 0
#endif
namespace pg8 {
constexpr int BM = 256, BK = 64, HALF = 128, HTB = HALF * BK * 2, STAGE_BYTES = 8 * HTB, NXCD = 8, WGM = 8;
__host__ __device__ __forceinline__ int lds_byte(int r, int c) { const int st = (r >> 4) * 2 + (c >> 5), rr = r & 15, cc = c & 31, ob = rr * 64 + cc * 2; return st * 1024 + (ob ^ (((ob >> 9) & 1) << 5)); }
__host__ __device__ __forceinline__ void stage_rc(int b, int& R, int& C) { const int st = b / 1024, sb = b % 1024, swz = sb ^ (((sb >> 9) & 1) << 5); R = (st >> 1) * 16 + swz / 64; C = (st & 1) * 32 + (swz % 64) / 2; }
__host__ __device__ __forceinline__ int perm32(int rho) { const int n = rho >> 4, i = rho & 15; return 8 * (i >> 2) + 4 * n + (i & 3); }

struct Unit { int pm, pn, e, full, pos0; };
struct Gemm { const bf16_t* A; const bf16_t* Bt; int K; size_t b_estride; const LAS int* rowtab; void* probe; };

struct StaticOrder {
    int nM, nN, nwg, G, c;
    __device__ void init(int M, int N, int G_, int c_) { nM = M / BM; nN = N / BM; nwg = nM * nN; G = G_; c = c_; }
    __device__ bool next(int i, Unit& u) const {
        const long L = (long)i * G + c; if (L >= nwg) return false;
        int wgid = (int)L; { const int q = nwg / NXCD, r = nwg % NXCD, xcd = wgid % NXCD, off = wgid / NXCD; wgid = (xcd < r ? xcd * (q + 1) : r * (q + 1) + (xcd - r) * q) + off; }
        const int nig = WGM * nN, gid = wgid / nig, fm = gid * WGM, gsz = (nM - fm) < WGM ? (nM - fm) : WGM;
        u.pm = fm + ((wgid % nig) % gsz); u.pn = (wgid % nig) / gsz; u.e = 0; u.full = 1; u.pos0 = 0; return true;
    }
    __device__ __forceinline__ void between(int) const {}
};
struct MoeOrder {
    const LAS int* tab; int r, nper, i0, imax;
    __device__ bool next(int i, Unit& u) const {
        if (i >= imax) return false;
        const int L = (i0 + i) * nper + r; if (L >= __builtin_amdgcn_readfirstlane(tab[1])) return false;
        int p = 0; const int np = tab[0];
#pragma unroll 1
        while (p + 1 < np && tab[4 + 8 * (p + 1)] <= L) ++p;
        const LAS int* t = tab + 4 + 8 * p;
        const int local = L - t[0], mte = t[3], pq = local / mte, mt = local - pq * mte;
        u.e = __builtin_amdgcn_readfirstlane(t[1]); u.pn = __builtin_amdgcn_readfirstlane(t[2] + pq); u.pm = __builtin_amdgcn_readfirstlane(t[4] + mt);
        u.full = __builtin_amdgcn_readfirstlane((t[5] - mt * 256) > 128 ? 1 : 0); u.pos0 = __builtin_amdgcn_readfirstlane(mt * 256); return true;
    }
    __device__ __forceinline__ void between(int) const {}
};

struct EpiProj {
    static constexpr bool PERM = true;
    bf16_t* O; int ldc;
    __device__ __forceinline__ void operator()(const f32x4 (&acc)[2][2][4][2], const Unit& u, int wr, int wc, int fr, int fq) const {
        const int row0 = u.pm * BM + wr * 64 + fr, col0 = u.pn * BM + wc * 32 + 8 * fq;
#pragma unroll
        for (int ai = 0; ai < 2; ++ai)
#pragma unroll
            for (int m = 0; m < 4; ++m) { bf16_t* rowp = O + (size_t)(row0 + ai * HALF + m * 16) * ldc + col0;
#pragma unroll
                for (int bj = 0; bj < 2; ++bj) { const f32x4 v0 = acc[ai][bj][m][0], v1 = acc[ai][bj][m][1];
                    u32x4 w; w.x = cvt_pk_bf16(v0[0], v0[1]); w.y = cvt_pk_bf16(v0[2], v0[3]); w.z = cvt_pk_bf16(v1[0], v1[1]); w.w = cvt_pk_bf16(v1[2], v1[3]);
                    *(u32x4*)(rowp + bj * HALF) = w;
#if PROBE_STORE2 == 1
                    *(u32x4*)(rowp + bj * HALF + (size_t)1792 * 1024 * 1024) = w;
#endif
                } }
    }
};
struct EpiOut {
    static constexpr bool PERM = false;
    const float* X; const float* g1;   float* O;
    __device__ __forceinline__ void operator()(const f32x4 (&acc)[2][2][4][2], const Unit& u, int wr, int wc, int fr, int fq) const {
        const int row0 = u.pm * BM + wr * 64 + fr, col0 = u.pn * BM + wc * 32 + 4 * fq;
        const float* gp = g1 + (size_t)((u.pm * BM) >> 12) * 12288 + col0;
        f32x4 gv[2][2];
#pragma unroll
        for (int bj = 0; bj < 2; ++bj)
#pragma unroll
            for (int n = 0; n < 2; ++n) gv[bj][n] = *(const f32x4*)(gp + bj * HALF + n * 16);
#pragma unroll
        for (int ai = 0; ai < 2; ++ai) {
            f32x4 xv[4][2][2];
#pragma unroll
            for (int m = 0; m < 4; ++m) { const size_t off = (size_t)(row0 + ai * HALF + m * 16) * DM + col0;
#pragma unroll
                for (int bj = 0; bj < 2; ++bj)
#pragma unroll
                    for (int n = 0; n < 2; ++n) xv[m][bj][n] = *(const f32x4*)(X + off + bj * HALF + n * 16); }
#pragma unroll
            for (int m = 0; m < 4; ++m) { const size_t off = (size_t)(row0 + ai * HALF + m * 16) * DM + col0;
#pragma unroll
                for (int bj = 0; bj < 2; ++bj)
#pragma unroll
                    for (int n = 0; n < 2; ++n) *(f32x4*)(O + off + bj * HALF + n * 16) = xv[m][bj][n] + gv[bj][n] * acc[ai][bj][m][n]; }
            asm volatile("" ::: "memory"); }
    }
};
struct EpiGU {
    static constexpr bool PERM = true;
    const float* bias;   bf16_t* O;
    __device__ __forceinline__ void operator()(const f32x4 (&acc)[2][2][4][2], const Unit& u, int wr, int wc, int fr, int fq) const {
        const int row0 = u.pm * BM + wr * 64 + fr, cc = u.pn * HALF + wc * 32 + 8 * fq;
        const float* bp = bias + (size_t)u.e * 4096 + cc;
        f32x4 bg[2], bu[2];
#pragma unroll
        for (int n = 0; n < 2; ++n) { bg[n] = *(const f32x4*)(bp + 4 * n); bu[n] = *(const f32x4*)(bp + 2048 + 4 * n); }
#pragma unroll
        for (int ai = 0; ai < 2; ++ai)
#pragma unroll
            for (int m = 0; m < 4; ++m) { float r[8];
#pragma unroll
                for (int n = 0; n < 2; ++n)
#pragma unroll
                    for (int j = 0; j < 4; ++j) {
                        float g = acc[ai][0][m][n][j] + bg[n][j], uu = acc[ai][1][m][n][j] + bu[n][j];
                        g = fminf(g, 7.0f); uu = fminf(fmaxf(uu, -7.0f), 7.0f);
                        const float glu = g * __builtin_amdgcn_rcpf(1.0f + __expf(-1.702f * g));
                        r[n * 4 + j] = (uu + 1.0f) * glu;
#if FP8_EMU
                        r[n * 4 + j] = q8(r[n * 4 + j]);
#endif
                    }
                u32x4 w; w.x = cvt_pk_bf16(r[0], r[1]); w.y = cvt_pk_bf16(r[2], r[3]); w.z = cvt_pk_bf16(r[4], r[5]); w.w = cvt_pk_bf16(r[6], r[7]);
                *(u32x4*)(O + (size_t)(row0 + ai * HALF + m * 16) * DM + cc) = w; }
    }
};
struct EpiDown {
    static constexpr bool PERM = true;
    const float* bias;   const float* wbuf; bf16_t* O;
    __device__ __forceinline__ void operator()(const f32x4 (&acc)[2][2][4][2], const Unit& u, int wr, int wc, int fr, int fq) const {
        const int row0 = u.pm * BM + wr * 64 + fr, col0 = u.pn * BM + wc * 32 + 8 * fq;
        const float* bp = bias + (size_t)u.e * 2048 + col0;
        f32x4 bv[2][2];
#pragma unroll
        for (int bj = 0; bj < 2; ++bj)
#pragma unroll
            for (int n = 0; n < 2; ++n) bv[bj][n] = *(const f32x4*)(bp + bj * HALF + 4 * n);
#pragma unroll
        for (int ai = 0; ai < 2; ++ai)
#pragma unroll
            for (int m = 0; m < 4; ++m) { const int row = row0 + ai * HALF + m * 16; const float rw = wbuf[row]; bf16_t* rowp = O + (size_t)row * DM + col0;
#pragma unroll
                for (int bj = 0; bj < 2; ++bj) { const f32x4 v0 = (acc[ai][bj][m][0] + bv[bj][0]) * rw, v1 = (acc[ai][bj][m][1] + bv[bj][1]) * rw;
                    u32x4 w; w.x = cvt_pk_bf16(v0[0], v0[1]); w.y = cvt_pk_bf16(v0[2], v0[3]); w.z = cvt_pk_bf16(v1[0], v1[1]); w.w = cvt_pk_bf16(v1[2], v1[3]);
                    *(u32x4*)(rowp + bj * HALF) = w; } }
    }
};

__device__ __forceinline__ unsigned pk4_fp8(float a, float b, float c, float d) { int p = __builtin_amdgcn_cvt_pk_fp8_f32(a, b, 0, false); p = __builtin_amdgcn_cvt_pk_fp8_f32(c, d, p, true); return (unsigned)p; }
constexpr float W8_SCALE = 64.0f, W8_INV = 1.0f / 64.0f;
struct EpiGU8 {
    static constexpr bool PERM = true;
    const float* bias;   unsigned char* O;
    __device__ __forceinline__ void operator()(const f32x4 (&acc)[2][2][4][2], const Unit& u, int wr, int wc, int fr, int fq) const {
        const int row0 = u.pm * BM + wr * 64 + fr, cc = u.pn * HALF + wc * 32 + 8 * fq;
        const float* bp = bias + (size_t)u.e * 4096 + cc;
        f32x4 bg[2], bu[2];
#pragma unroll
        for (int n = 0; n < 2; ++n) { bg[n] = *(const f32x4*)(bp + 4 * n); bu[n] = *(const f32x4*)(bp + 2048 + 4 * n); }
#pragma unroll
        for (int ai = 0; ai < 2; ++ai)
#pragma unroll
            for (int m = 0; m < 4; ++m) { float r[8];
#pragma unroll
                for (int n = 0; n < 2; ++n)
#pragma unroll
                    for (int j = 0; j < 4; ++j) {
                        float g = acc[ai][0][m][n][j] * W8_INV + bg[n][j], uu = acc[ai][1][m][n][j] * W8_INV + bu[n][j];
                        g = fminf(g, 7.0f); uu = fminf(fmaxf(uu, -7.0f), 7.0f);
                        const float glu = g * __builtin_amdgcn_rcpf(1.0f + __expf(-1.702f * g));
                        r[n * 4 + j] = (uu + 1.0f) * glu; }
                u32x2 w; w.x = pk4_fp8(r[0], r[1], r[2], r[3]); w.y = pk4_fp8(r[4], r[5], r[6], r[7]);
                *(u32x2*)(O + (size_t)(row0 + ai * HALF + m * 16) * DM + cc) = w; }
    }
};
struct EpiDown8 {
    static constexpr bool PERM = true;
    const float* bias;   const float* wbuf; bf16_t* O;
    __device__ __forceinline__ void operator()(const f32x4 (&acc)[2][2][4][2], const Unit& u, int wr, int wc, int fr, int fq) const {
        const int row0 = u.pm * BM + wr * 64 + fr, col0 = u.pn * BM + wc * 32 + 8 * fq;
        const float* bp = bias + (size_t)u.e * 2048 + col0;
        f32x4 bv[2][2];
#pragma unroll
        for (int bj = 0; bj < 2; ++bj)
#pragma unroll
            for (int n = 0; n < 2; ++n) bv[bj][n] = *(const f32x4*)(bp + bj * HALF + 4 * n);
        float rws[2][4];
#pragma unroll
        for (int ai = 0; ai < 2; ++ai)
#pragma unroll
            for (int m = 0; m < 4; ++m) rws[ai][m] = wbuf[(size_t)u.e * 8192 + u.pos0 + (row0 + ai * HALF + m * 16 - u.pm * BM)];
#pragma unroll
        for (int ai = 0; ai < 2; ++ai)
#pragma unroll
            for (int m = 0; m < 4; ++m) { const int row = row0 + ai * HALF + m * 16; const float rw = rws[ai][m]; bf16_t* rowp = O + (size_t)row * DM + col0;
#pragma unroll
                for (int bj = 0; bj < 2; ++bj) { const f32x4 v0 = (acc[ai][bj][m][0] * W8_INV + bv[bj][0]) * rw, v1 = (acc[ai][bj][m][1] * W8_INV + bv[bj][1]) * rw;
                    u32x4 w; w.x = cvt_pk_bf16(v0[0], v0[1]); w.y = cvt_pk_bf16(v0[2], v0[3]); w.z = cvt_pk_bf16(v1[0], v1[1]); w.w = cvt_pk_bf16(v1[2], v1[3]);
                    *(u32x4*)(rowp + bj * HALF) = w; } }
    }
};

typedef int i32x8 __attribute__((ext_vector_type(8)));
typedef short s16x16 __attribute__((ext_vector_type(16)));
__device__ __forceinline__ i32x8 ld32(const LAS unsigned char* p) { const bf16x8 lo = *(const LAS bf16x8*)p, hi = *(const LAS bf16x8*)(p + 1024); return __builtin_bit_cast(i32x8, __builtin_shufflevector(lo, hi, 0, 1, 2, 3, 4, 5, 6, 7, 8, 9, 10, 11, 12, 13, 14, 15)); }
__device__ __forceinline__ const char* sbase(const char* p) { asm volatile("" : "+s"(p)); return p; }
template <bool FP8, bool GATHER, class Epi, class Sched>
__device__ __forceinline__ void gemm_phase(LAS unsigned char* lds, const Gemm g, const Sched& S, const Epi& E) {
    const int tid = threadIdx.x, wid = __builtin_amdgcn_readfirstlane(tid >> 6), lane = tid & 63, wr = wid >> 2, wc = wid & 3, fr = lane & 15, fq = lane >> 4;
    const int K = g.K, nt = K / BK;
    unsigned voffA, voffB;
    { int R, C; stage_rc(tid * 16, R, C); const int Rb = Epi::PERM ? ((R & ~31) + perm32(R & 31)) : R; voffA = (unsigned)(R * K + C) * 2u; voffB = (unsigned)(Rb * K + C) * 2u; }
    const size_t pstep = (size_t)64 * K * 2;
    unsigned voffC = 0, ro[4] = {0, 0, 0, 0}; int Rl = 0;
    if constexpr (GATHER) { int R, C; stage_rc(tid * 16, R, C); voffC = (unsigned)C * 2u; Rl = R; }
#define PG8_ROWS(x0, uidx) do { ro[x0] = (unsigned)g.rowtab[(uidx) * 256 + Rl + 64 * (x0)]; ro[(x0) + 1] = (unsigned)g.rowtab[(uidx) * 256 + Rl + 64 * (x0) + 64]; } while (0)
    const size_t kstep = (size_t)(BK * 2);
    const size_t hstep = (size_t)HALF * K * 2;
    const size_t tstep = 2 * hstep;
    const size_t estep = g.b_estride * 2;
    const unsigned ldsw = (unsigned)wid * 1024u;
    const int aoff0 = lds_byte(wr * 64 + fr, fq * 8), boff0 = lds_byte(wc * 32 + fr, fq * 8);
#define PG8_SA(b, h) (((b) * 2 + (h)) * HTB)
#define PG8_SB(b, h) ((4 + (b) * 2 + (h)) * HTB)
#define PG8_STAGE(bufoff, gbase, voff) do { _Pragma("unroll") for (int _i = 0; _i < 2; ++_i) \
        __builtin_amdgcn_global_load_lds((const unsigned*)(sbase((const char*)(gbase) + _i * pstep) + (voff)), (LAS unsigned*)(lds + (bufoff) + ldsw + _i * 8192), 16, 0, 0); } while (0)
#define PG8_STAGEA(bufoff, isnext, half, koff) do { if constexpr (GATHER) { _Pragma("unroll") for (int _i = 0; _i < 2; ++_i) { const unsigned _r = ro[(half) * 2 + _i]; \
            __builtin_amdgcn_global_load_lds((const unsigned*)(sbase((const char*)g.A + (koff)) + (_r + voffC)), (LAS unsigned*)(lds + (bufoff) + ldsw + _i * 8192), 16, 0, 0); } } \
        else { PG8_STAGE(bufoff, ((isnext) ? nA : cA) + (half) * hstep + (koff), voffA); } } while (0)
#define PG8_LDA(dst, b, h) do { _Pragma("unroll") for (int m = 0; m < 4; ++m) { \
        if constexpr (FP8) dst##8[m] = ld32(lds + PG8_SA(b, h) + aoff0 + m * 2048); \
        else { dst[m][0] = *(const LAS bf16x8*)(lds + PG8_SA(b, h) + aoff0 + m * 2048); dst[m][1] = *(const LAS bf16x8*)(lds + PG8_SA(b, h) + aoff0 + m * 2048 + 1024); } } } while (0)
#define PG8_LDB(dst, b, h) do { _Pragma("unroll") for (int n = 0; n < 2; ++n) { \
        if constexpr (FP8) dst##8[n] = ld32(lds + PG8_SB(b, h) + boff0 + n * 2048); \
        else { dst[n][0] = *(const LAS bf16x8*)(lds + PG8_SB(b, h) + boff0 + n * 2048); dst[n][1] = *(const LAS bf16x8*)(lds + PG8_SB(b, h) + boff0 + n * 2048 + 1024); } } } while (0)
#define PG8_MMA(ai, bj, At, Bt) do { __builtin_amdgcn_s_setprio(1); _Pragma("unroll") for (int m = 0; m < 4; ++m) _Pragma("unroll") for (int n = 0; n < 2; ++n) { \
        if constexpr (FP8) { if (FP8_ASM) { asm volatile("v_mfma_scale_f32_16x16x128_f8f6f4 %0, %1, %2, %0, %3, %3 op_sel_hi:[0,0,0]" : "+a"(acc[ai][bj][m][n]) : "v"(Bt##8[n]), "v"(At##8[m]), "v"(scale1)); } \
            else acc[ai][bj][m][n] = __builtin_amdgcn_mfma_scale_f32_16x16x128_f8f6f4(Bt##8[n], At##8[m], acc[ai][bj][m][n], 0, 0, 0, FP8_SCALE_ARG, 0, FP8_SCALE_ARG); } \
        else { acc[ai][bj][m][n] = __builtin_amdgcn_mfma_f32_16x16x32_bf16(Bt[n][0], At[m][0], acc[ai][bj][m][n], 0, 0, 0); \
               acc[ai][bj][m][n] = __builtin_amdgcn_mfma_f32_16x16x32_bf16(Bt[n][1], At[m][1], acc[ai][bj][m][n], 0, 0, 0); } } \
        __builtin_amdgcn_s_setprio(0); } while (0)
#define PG8_WAIT_V(n) asm volatile("s_waitcnt vmcnt(" #n ")" ::: "memory")
#define PG8_WAIT_L(n) asm volatile("s_waitcnt lgkmcnt(" #n ")" ::: "memory")
#define PG8_BAR __builtin_amdgcn_s_barrier()
#define PG8_SCHED __builtin_amdgcn_sched_barrier(0)
#ifdef PROBE_GMAX
    const unsigned long long tg0 = __builtin_amdgcn_s_memrealtime();
#endif
    Unit cur, nxt; int ui = 0;
#ifdef PROBE_EPI
    unsigned long long epi_acc = 0;
#endif
    if (!S.next(0, cur)) return;
    f32x4 acc[2][2][4][2];
#pragma unroll
    for (int a = 0; a < 2; ++a)
#pragma unroll
        for (int b = 0; b < 2; ++b)
#pragma unroll
            for (int m = 0; m < 4; ++m)
#pragma unroll
                for (int n = 0; n < 2; ++n) acc[a][b][m][n] = (f32x4){0.f, 0.f, 0.f, 0.f};
    bf16x8 At[4][2], B0[2][2], B1[2][2]; i32x8 At8[4], B08[2], B18[2];
    const unsigned scale1 = 0x7f7f7f7fu;
    const char* cA = (const char*)g.A + (size_t)cur.pm * tstep; const char* cB = (const char*)g.Bt + (size_t)cur.e * estep + (size_t)cur.pn * tstep;
    const char* nA = cA;
    if constexpr (GATHER) { PG8_ROWS(0, 0); PG8_ROWS(2, 0); }
    PG8_STAGE(PG8_SB(0, 0), cB, voffB); PG8_STAGEA(PG8_SA(0, 0), false, 0, 0); PG8_STAGE(PG8_SB(0, 1), cB + hstep, voffB); PG8_STAGEA(PG8_SA(0, 1), false, 1, 0);
    if (wr == 1) PG8_BAR;
    PG8_WAIT_V(4); PG8_BAR;
    PG8_STAGE(PG8_SB(1, 0), cB + kstep, voffB); PG8_STAGEA(PG8_SA(1, 0), false, 0, kstep); PG8_STAGE(PG8_SB(1, 1), cB + hstep + kstep, voffB);
    PG8_WAIT_V(6); PG8_BAR;
    for (;;) {
        const bool has_next = S.next(ui + 1, nxt);
        const bool cfull = FP8 ? true : (cur.full != 0);
        nA = has_next ? (const char*)g.A + (size_t)nxt.pm * tstep : cA;
        const char* nB = has_next ? (const char*)g.Bt + (size_t)nxt.e * estep + (size_t)nxt.pn * tstep : cB;
#ifdef PROBE_KL
        const unsigned long long tk0 = __builtin_amdgcn_s_memrealtime();
#endif
        for (int t = 0; t < nt; t += 2) {
            const bool last = (t == nt - 2);
            const size_t k1 = (size_t)(t + 1) * kstep, k2 = last ? 0 : (size_t)(t + 2) * kstep, k3 = k2 + kstep;
            const char* b2 = last ? nB : cB + (size_t)(t + 2) * kstep; const char* b3 = b2 + kstep;
            if constexpr (GATHER) { if (last && has_next) PG8_ROWS(0, ui + 1); }
            PG8_LDB(B0, 0, 0); PG8_SCHED; PG8_LDA(At, 0, 0); PG8_STAGEA(PG8_SA(1, 1), false, 1, k1);
            if constexpr (GATHER) { if (last && has_next) PG8_ROWS(2, ui + 1); }
            PG8_WAIT_V(10); PG8_WAIT_L(8); PG8_BAR; PG8_WAIT_L(0); PG8_MMA(0, 0, At, B0); PG8_BAR; PG8_SCHED;
            PG8_LDB(B1, 0, 1); PG8_STAGE(PG8_SB(0, 0), b2, voffB);
            PG8_WAIT_V(10); PG8_BAR; PG8_WAIT_L(0); PG8_MMA(0, 1, At, B1); PG8_BAR;
            PG8_LDA(At, 0, 1); PG8_STAGEA(PG8_SA(0, 0), last, 0, k2);
            PG8_BAR; PG8_WAIT_L(0); if (cfull) PG8_MMA(1, 0, At, B0); PG8_BAR; PG8_SCHED;
            PG8_STAGE(PG8_SB(0, 1), b2 + hstep, voffB);
            PG8_WAIT_V(10); PG8_BAR; if (cfull) PG8_MMA(1, 1, At, B1); PG8_BAR;
            PG8_LDB(B0, 1, 0); PG8_SCHED; PG8_LDA(At, 1, 0); PG8_STAGEA(PG8_SA(0, 1), last, 1, k2);
            PG8_WAIT_V(10); PG8_WAIT_L(8); PG8_BAR; PG8_WAIT_L(0); PG8_MMA(0, 0, At, B0); PG8_BAR; PG8_SCHED;
            PG8_LDB(B1, 1, 1); PG8_STAGE(PG8_SB(1, 0), b3, voffB);
            PG8_WAIT_V(10); PG8_BAR; PG8_WAIT_L(0); PG8_MMA(0, 1, At, B1); PG8_BAR;
            PG8_LDA(At, 1, 1); PG8_STAGEA(PG8_SA(1, 0), last, 0, k3);
            PG8_BAR; PG8_WAIT_L(0); if (cfull) PG8_MMA(1, 0, At, B0); PG8_BAR; PG8_SCHED;
            PG8_STAGE(PG8_SB(1, 1), b3 + hstep, voffB);
            PG8_WAIT_V(10); PG8_BAR; if (cfull) PG8_MMA(1, 1, At, B1); PG8_BAR;
        }
#ifdef PROBE_KL
        if (FP8 && (GATHER ? 9 : 10) == PROBE_EPI) epi_acc += __builtin_amdgcn_s_memrealtime() - tk0;
#endif
        {
            int tz = threadIdx.x; asm volatile("" : "+v"(tz)); const int lz = tz & 63;
#ifdef PROBE_EPI
            const unsigned long long te0 = __builtin_amdgcn_s_memrealtime();
#endif
            E(acc, cur, wr, wc, lz & 15, lz >> 4);
#ifdef PROBE_EPI
#ifndef PROBE_KL
            if (FP8 && (GATHER ? 9 : 10) == PROBE_EPI) { epi_acc += __builtin_amdgcn_s_memrealtime() - te0; }
#endif
#endif
            }
        S.between(ui);
        if (!has_next) break;
#pragma unroll
        for (int a = 0; a < 2; ++a)
#pragma unroll
            for (int b = 0; b < 2; ++b)
#pragma unroll
                for (int m = 0; m < 4; ++m)
#pragma unroll
                    for (int n = 0; n < 2; ++n) acc[a][b][m][n] = (f32x4){0.f, 0.f, 0.f, 0.f};
        cur = nxt; cA = nA; cB = nB; ++ui;

    }
#ifdef PROBE_EPI
    if (FP8 && (GATHER ? 9 : 10) == PROBE_EPI && blockIdx.x == 0 && threadIdx.x == 0) *(unsigned long long*)((char*)g.probe) = epi_acc;
#endif
#ifdef PROBE_GMAX
    if (FP8 && (GATHER ? 9 : 10) == PROBE_GMAX && threadIdx.x == 0) { const unsigned d = (unsigned)(__builtin_amdgcn_s_memrealtime() - tg0); if (PROBE_GMIN) atomicMin((unsigned*)((char*)g.probe + 8), d); else atomicMax((unsigned*)((char*)g.probe + 8), d); }
#endif
    PG8_WAIT_V(0);
    if (wr == 0) PG8_BAR;
    PG8_BAR;
#undef PG8_SA
#undef PG8_SB
#undef PG8_STAGE
#undef PG8_STAGEA
#undef PG8_ROWS
#undef PG8_LDA
#undef PG8_LDB
#undef PG8_MMA
#undef PG8_WAIT_V
#undef PG8_WAIT_L
#undef PG8_BAR
#undef PG8_SCHED
}
}
#ifndef BJOB_NT
#define BJOB_NT 1
#endif
#if BJOB_NT
#define BJOB_LD(p) __builtin_nontemporal_load(p)
#else
#define BJOB_LD(p) (*(p))
#endif

__device__ __forceinline__ void conv_job(const float* src, int ld, bf16_t* dst, int kt) {
    const int w = threadIdx.x >> 6, lane = threadIdx.x & 63, kseg = lane & 7, nq = lane >> 3;
    const int k0 = kt * 128 + (w >> 2) * 64 + kseg * 8, nl = (w & 3) * 32 + nq * 4;
    f32x4 v[8];
#pragma unroll
    for (int r = 0; r < 8; ++r) v[r] = *(const f32x4*)(src + (size_t)(k0 + r) * ld + nl);
#if FP8_EMU
#pragma unroll
    for (int r = 0; r < 8; ++r)
#pragma unroll
        for (int j = 0; j < 4; ++j) v[r][j] = q8(v[r][j] * 64.0f) * (1.0f / 64.0f);
#endif
#pragma unroll
    for (int j = 0; j < 4; ++j) { u32x4 o; o.x = cvt_pk_bf16(v[0][j], v[1][j]); o.y = cvt_pk_bf16(v[2][j], v[3][j]); o.z = cvt_pk_bf16(v[4][j], v[5][j]); o.w = cvt_pk_bf16(v[6][j], v[7][j]);
        *(u32x4*)(dst + (size_t)(nl + j) * 2048 + k0) = o; }
}
constexpr int CONV_JOBS_GU = 32 * 16 * 16, CONV_JOBS_D = 32 * 16 * 8, CONV_JOBS = CONV_JOBS_GU + CONV_JOBS_D;
__device__ __forceinline__ void conv_block_job(const Args& a, LAS unsigned char* T, int j) {
    const int tid = threadIdx.x, w = tid >> 6, lane = tid & 63;
    const float* src; int ld; unsigned char* dst; int gu, s0;
    if (j < CONV_JOBS_GU) { const int e = j >> 8, kb = (j >> 4) & 15, nb = j & 15; s0 = nb * 256; gu = 1;
        src = a.w_gate_up + ((size_t)e * 2048 + kb * 128) * 4096 + s0; ld = 4096; dst = (unsigned char*)(a.ws + WS_WGU_T) + (size_t)e * 4096 * 2048 + kb * 128; }
    else { const int jj = j - CONV_JOBS_GU, e = jj >> 7, kb = (jj >> 3) & 15, nb = jj & 7; s0 = nb * 256; gu = 0;
        src = a.w_down + ((size_t)e * 2048 + kb * 128) * 2048 + s0; ld = 2048; dst = (unsigned char*)(a.ws + WS_WD_T) + (size_t)e * 2048 * 2048 + kb * 128; }
    f32x4 v[16];
#pragma unroll
    for (int r = 0; r < 16; ++r) v[r] = __builtin_nontemporal_load((const f32x4*)(src + (size_t)(w * 16 + r) * ld + lane * 4)) * pg8::W8_SCALE;
#pragma unroll
    for (int jn = 0; jn < 4; ++jn) { u32x4 o;
        o.x = pg8::pk4_fp8(v[0][jn], v[1][jn], v[2][jn], v[3][jn]); o.y = pg8::pk4_fp8(v[4][jn], v[5][jn], v[6][jn], v[7][jn]);
        o.z = pg8::pk4_fp8(v[8][jn], v[9][jn], v[10][jn], v[11][jn]); o.w = pg8::pk4_fp8(v[12][jn], v[13][jn], v[14][jn], v[15][jn]);
        const int n = lane * 4 + jn;
        *(LAS u32x4*)(T + n * 128 + ((w ^ (lane & 7)) << 4)) = o; }
    __syncthreads();
#pragma unroll
    for (int p = 0; p < 4; ++p) { const int idx = tid + 512 * p, n = idx >> 3, wq = idx & 7;
        const u32x4 o = *(const LAS u32x4*)(T + n * 128 + ((wq ^ ((n >> 2) & 7)) << 4));
        const int c = s0 + n; int np = c;
        if (gu) { const int bj = c >> 11, rem = c & 2047; np = (rem >> 7) * 256 + bj * 128 + (rem & 127); }
        __builtin_nontemporal_store(o, (u32x4*)(dst + (size_t)np * 2048 + wq * 16)); }
}
constexpr int SJOBS_GU = 32 * 32 * 128, SJOBS_D = 32 * 32 * 64, SJOBS = SJOBS_GU + SJOBS_D;
constexpr int SJOBS_ATTN = 256 * 33 * 8;
typedef short s16x2 __attribute__((ext_vector_type(2)));
__device__ __forceinline__ unsigned pk4_fp8_scaled(float a, float b, float c, float d) { s16x2 r = {0, 0}; r = __builtin_amdgcn_cvt_scalef32_pk_fp8_f32(r, a, b, pg8::W8_INV, false); r = __builtin_amdgcn_cvt_scalef32_pk_fp8_f32(r, c, d, pg8::W8_INV, true); return __builtin_bit_cast(unsigned, r); }
struct SJob { const float* src; unsigned char* dst; int ld; };
__device__ __forceinline__ SJob sjob_addr(const Args& a, int j, int lane) {
    SJob c; const int kseg = lane & 7, nq = lane >> 3;
    if (j < SJOBS_GU) { const int e = j >> 12, kb = (j >> 7) & 31, nb = j & 127, s0 = nb * 32, bj = s0 >> 11, rem = s0 & 2047, pn = rem >> 7, c0 = rem & 127, np = pn * 256 + bj * 128 + c0;
        c.ld = 4096; c.src = a.w_gate_up + ((size_t)e * 2048 + kb * 64 + kseg * 8) * 4096 + s0 + nq * 4; c.dst = (unsigned char*)(a.ws + WS_WGU_T) + ((size_t)e * 4096 + np + nq * 4) * 2048 + kb * 64 + kseg * 8; }
    else { const int jj = j - SJOBS_GU, e = jj >> 11, kb = (jj >> 6) & 31, nb = jj & 63;
        c.ld = 2048; c.src = a.w_down + ((size_t)e * 2048 + kb * 64 + kseg * 8) * 2048 + nb * 32 + nq * 4; c.dst = (unsigned char*)(a.ws + WS_WD_T) + ((size_t)e * 2048 + nb * 32 + nq * 4) * 2048 + kb * 64 + kseg * 8; }
    return c;
}
__device__ __forceinline__ void sjob_load(const SJob& c, f32x4 (&v)[8]) {
#pragma unroll
    for (int r = 0; r < 8; ++r) v[r] = __builtin_nontemporal_load((const f32x4*)(c.src + (size_t)r * c.ld));
}
__device__ __forceinline__ void sjob_store(const SJob& c, const f32x4 (&v)[8]) {
#pragma unroll
    for (int jn = 0; jn < 4; ++jn) { u32x2 o;
        o.x = pk4_fp8_scaled(v[0][jn], v[1][jn], v[2][jn], v[3][jn]); o.y = pk4_fp8_scaled(v[4][jn], v[5][jn], v[6][jn], v[7][jn]);
        __builtin_nontemporal_store(o, (u32x2*)(c.dst + (size_t)jn * 2048)); }
}
__device__ __forceinline__ void conv_share(const Args& a, int blk, int G) {
    const int s = blk % 3, r = blk / 3, nb = (G - s + 2) / 3, w = threadIdx.x >> 6, lane = threadIdx.x & 63;
    const int npair = (SJOBS - SJOBS_ATTN) / 2, p0 = s * (npair / 3), p1 = (s == 2) ? npair : (s + 1) * (npair / 3);
    int p = p0 + r * 8 + w; const int step = nb * 8;
    if (p >= p1) return;
    f32x4 va0[8], va1[8], vb0[8], vb1[8]; SJob ca = sjob_addr(a, SJOBS_ATTN + 2 * p, lane), cb = ca, t;
    sjob_load(ca, va0); t = ca; t.src += 32; sjob_load(t, va1);
#pragma unroll 1
    for (;;) {
        const bool hb = (p + step) < p1; if (hb) { cb = sjob_addr(a, SJOBS_ATTN + 2 * (p + step), lane); sjob_load(cb, vb0); t = cb; t.src += 32; sjob_load(t, vb1); }
        sjob_store(ca, va0); t = ca; t.dst += 32 * 2048; sjob_store(t, va1);
        if (!hb) break;
        p += step;
        const bool ha = (p + step) < p1; if (ha) { ca = sjob_addr(a, SJOBS_ATTN + 2 * (p + step), lane); sjob_load(ca, va0); t = ca; t.src += 32; sjob_load(t, va1); }
        sjob_store(cb, vb0); t = cb; t.dst += 32 * 2048; sjob_store(t, vb1);
        if (!ha) break;
        p += step;
    }
}
struct BJob { const float* src; unsigned char* dst; int ld, gu, s0; };
__device__ __forceinline__ BJob bjob_addr(const Args& a, int j) {
    BJob c;
    if (j < CONV_JOBS_GU) { const int e = j >> 8, kb = (j >> 4) & 15, nb = j & 15; c.s0 = nb * 256; c.gu = 1;
        c.src = a.w_gate_up + ((size_t)e * 2048 + kb * 128) * 4096 + c.s0; c.ld = 4096; c.dst = (unsigned char*)(a.ws + WS_WGU_T) + (size_t)e * 4096 * 2048 + kb * 128; }
    else { const int jj = j - CONV_JOBS_GU, e = jj >> 7, kb = (jj >> 3) & 15, nb = jj & 7; c.s0 = nb * 256; c.gu = 0;
        c.src = a.w_down + ((size_t)e * 2048 + kb * 128) * 2048 + c.s0; c.ld = 2048; c.dst = (unsigned char*)(a.ws + WS_WD_T) + (size_t)e * 2048 * 2048 + kb * 128; }
    return c;
}
__device__ __forceinline__ void bjob_load(const BJob& c, f32x4 (&v)[16]) {
    int tz = threadIdx.x; asm volatile("" : "+v"(tz));
    const int w = tz >> 6, lane = tz & 63;
#pragma unroll
    for (int r = 0; r < 16; ++r) v[r] = BJOB_LD((const f32x4*)(c.src + (size_t)(w * 16 + r) * c.ld + lane * 4));
}
__device__ __forceinline__ void bjob_pack(const f32x4 (&v)[16], u32x4 (&o)[4]) {
#pragma unroll
    for (int jn = 0; jn < 4; ++jn) {
        o[jn].x = pk4_fp8_scaled(v[0][jn], v[1][jn], v[2][jn], v[3][jn]); o[jn].y = pk4_fp8_scaled(v[4][jn], v[5][jn], v[6][jn], v[7][jn]);
        o[jn].z = pk4_fp8_scaled(v[8][jn], v[9][jn], v[10][jn], v[11][jn]); o[jn].w = pk4_fp8_scaled(v[12][jn], v[13][jn], v[14][jn], v[15][jn]); }
}
__device__ __forceinline__ void bjob_out(const BJob& c, const u32x4 (&o)[4], LAS unsigned char* Tlo, LAS unsigned char* Thi) {
    int tz = threadIdx.x; asm volatile("" : "+v"(tz));
    const int tid = tz, w = tid >> 6, lane = tid & 63;
    LAS unsigned char* Tw = (lane < 32) ? Tlo : Thi;
#pragma unroll
    for (int jn = 0; jn < 4; ++jn) { const int nl = (lane & 31) * 4 + jn;
        *(LAS u32x4*)(Tw + nl * 128 + ((w ^ (lane & 7)) << 4)) = o[jn]; }
    asm volatile("s_waitcnt lgkmcnt(0)" ::: "memory"); __builtin_amdgcn_s_barrier(); asm volatile("" ::: "memory");
#pragma unroll
    for (int p = 0; p < 4; ++p) { const int idx = tid + 512 * p, n = idx >> 3, wq = idx & 7;
        const LAS unsigned char* Tr = (n < 128) ? Tlo : Thi;
        const u32x4 ov = *(const LAS u32x4*)(Tr + (n & 127) * 128 + ((wq ^ ((n >> 2) & 7)) << 4));
        const int cc = c.s0 + n; int np = cc;
        if (c.gu) { const int bj = cc >> 11, rem = cc & 2047; np = (rem >> 7) * 256 + bj * 128 + (rem & 127); }
        __builtin_nontemporal_store(ov, (u32x4*)(c.dst + (size_t)np * 2048 + wq * 16)); }
    asm volatile("s_waitcnt lgkmcnt(0)" ::: "memory"); __builtin_amdgcn_s_barrier(); asm volatile("" ::: "memory");
}
#ifndef CONV_IN_ATTN
#define CONV_IN_ATTN 1
#endif
constexpr int BJOB0 = CONV_IN_ATTN ? 16 * 256 + 8 * 16 : 0;
__device__ __forceinline__ void conv_share_blk(const Args& a, LAS unsigned char* lds, int blk, int G) {
    const int s = blk % 3, r = blk / 3, nb = (G - s + 2) / 3, nj = CONV_JOBS - BJOB0, j0 = BJOB0 + s * (nj / 3), j1 = (s == 2) ? CONV_JOBS : BJOB0 + (s + 1) * (nj / 3);
    LAS unsigned char* Tlo = lds + 3 * 16384; LAS unsigned char* Thi = lds + LDS_EXTRA;
    int j = j0 + r; if (j >= j1) return;
    f32x4 v[16]; u32x4 o[4]; BJob cc = bjob_addr(a, j);
    bjob_load(cc, v);
#pragma unroll 1
    for (;;) {
        bjob_pack(v, o);
        const BJob cur = cc; const bool hn = (j + nb) < j1;
        if (hn) { cc = bjob_addr(a, j + nb); bjob_load(cc, v); }
        bjob_out(cur, o, Tlo, Thi);
        if (!hn) break;
        j += nb;
    }
}
__device__ __forceinline__ void conv_all(const Args& a, LAS unsigned char* lds) {
    int buf = 0;
    for (int j = blockIdx.x; j < CONV_JOBS; j += gridDim.x) { conv_block_job(a, lds + buf * 32768, j); buf ^= 1; }
    __syncthreads();
}
__device__ __forceinline__ bool conv_claim(const Args&, int) { return false; }

__device__ __forceinline__ void phase_prologue(const Args& a, LAS unsigned char* lds) {
    const int tid = threadIdx.x, blk = blockIdx.x, G = gridDim.x;
#ifdef PROBE_P0
    const unsigned long long p0t = __builtin_amdgcn_s_memrealtime();
#endif
    if (blk < 192) {
        LAS float* cact = (LAS float*)lds; LAS float* red = (LAS float*)(lds + 16384);
        for (int i = tid; i < 4096; i += 512) cact[i] = silu_f(a.c[i]);
        __syncthreads();
        float* mod = (float*)(a.ws + WS_MOD);
        for (int job = blk; job < 192; job += G) {
            const int cg = job % 48, kg = job / 48, w = tid >> 6, lane = tid & 63;
            const float* wp = a.w_ada + (size_t)(kg * 512 + w) * 12288 + cg * 256 + lane * 4;
            f32x4 a0 = {0.f, 0.f, 0.f, 0.f}, a1 = {0.f, 0.f, 0.f, 0.f};
#pragma unroll 16
            for (int i = 0; i < 64; ++i) { const int k = kg * 512 + w + 8 * i; const f32x4 wv = *(const f32x4*)(wp + (size_t)(8 * i) * 12288); a0 += wv * cact[k]; a1 += wv * cact[2048 + k]; }
            *(LAS f32x4*)(red + (w * 2 + 0) * 256 + lane * 4) = a0; *(LAS f32x4*)(red + (w * 2 + 1) * 256 + lane * 4) = a1;
            __syncthreads();
            { const int b = tid >> 8, col = tid & 255; float s = 0.f;
#pragma unroll
              for (int r = 0; r < 8; ++r) s += red[(r * 2 + b) * 256 + col];
              if (kg == 0) s += a.b_ada[cg * 256 + col];
              atomicAdd(&mod[b * 12288 + cg * 256 + col], s); }
            __syncthreads();
        }
    }
#ifdef PROBE_P0
    if (PROBE_P0 == 1 && blk == 0 && tid == 0) ((unsigned long long*)(a.ws + 18688))[4] = __builtin_amdgcn_s_memrealtime() - p0t;
    const unsigned long long p0t2 = __builtin_amdgcn_s_memrealtime();
#endif
    {
        float* ct = (float*)(a.ws + WS_ROPE); float* st = ct + 4096 * 64;
        for (int idx = blk * 512 + tid; idx < 4096 * 64; idx += G * 512) {
            const int t = idx >> 6, i = idx & 63;
            const float inv = (float)exp2(-(double)i * (13.287712379549449 / 64.0));
            const float ang = (float)t * inv;
            const double ad = (double)ang, n = rint(ad * 0.15915494309189535), r = fma(-n, 6.283185307179586, ad) - n * 2.4492935982947064e-16;
            const float rf = (float)r;
            ct[idx] = cosf(rf); st[idx] = sinf(rf);
        }
    }
#ifdef PROBE_P0
    if (PROBE_P0 == 2 && blk == 0 && tid == 0) ((unsigned long long*)(a.ws + 18688))[4] = __builtin_amdgcn_s_memrealtime() - p0t2;
#endif
    {
        bf16_t* win_t = (bf16_t*)(a.ws + WS_WIN_T); bf16_t* wout_t = (bf16_t*)(a.ws + WS_WOUT_T);
        const bool lightwg = (G == 256) && (blk >= 192);
        const int nmine = (G == 256) ? (lightwg ? 8 : ((blk < 128) ? 3 : 2)) : (64 * 16 - blk + G - 1) / G;
        auto job_of = [&](int i) { return (G == 256) ? (lightwg ? (blk - 192) + 64 * i : 512 + blk + 192 * i) : blk + G * i; };
        for (int ji = 0; ji < nmine; ji += 2) {
            const int job = job_of(ji), job2 = (ji + 1 < nmine) ? job_of(ji + 1) : job;
            const float* src[2]; int ld[2]; bf16_t* dst[2]; int kts[2]; f32x4 v[2][8];
            const int w = threadIdx.x >> 6, lane = threadIdx.x & 63, kseg = lane & 7, nq = lane >> 3, nl = (w & 3) * 32 + nq * 4;
#pragma unroll
            for (int u = 0; u < 2; ++u) { const int jb = u ? job2 : job, rt = jb >> 4; kts[u] = jb & 15;
                if (rt < 48) { const int n0 = rt * 128, col0 = n0 < 3072 ? n0 : n0 + 16; src[u] = a.w_in + col0; ld[u] = DIN; dst[u] = win_t + (size_t)n0 * 2048; }
                else { const int n0 = (rt - 48) * 128; src[u] = a.w_out + n0; ld[u] = 2048; dst[u] = wout_t + (size_t)n0 * 2048; }
                const int k0 = kts[u] * 128 + (w >> 2) * 64 + kseg * 8;
#pragma unroll
                for (int r = 0; r < 8; ++r) v[u][r] = *(const f32x4*)(src[u] + (size_t)(k0 + r) * ld[u] + nl); }
#pragma unroll
            for (int u = 0; u < 2; ++u) { const int k0 = kts[u] * 128 + (w >> 2) * 64 + kseg * 8;
#pragma unroll
                for (int j = 0; j < 4; ++j) { u32x4 o; o.x = cvt_pk_bf16(v[u][0][j], v[u][1][j]); o.y = cvt_pk_bf16(v[u][2][j], v[u][3][j]); o.z = cvt_pk_bf16(v[u][4][j], v[u][5][j]); o.w = cvt_pk_bf16(v[u][6][j], v[u][7][j]);
                    *(u32x4*)(dst[u] + (size_t)(nl + j) * 2048 + k0) = o; } }
        }
    }
}

__device__ __forceinline__ void phase_norm1(const Args& a, LAS unsigned char* lds) {
    const int tid = threadIdx.x, blk = blockIdx.x, G = gridDim.x, w = tid >> 6, lane = tid & 63;
    constexpr int HS = 2052;
    LAS float* hs = (LAS float*)lds;
    LAS float* part = (LAS float*)(lds + LDS_EXTRA + 4096);
    LAS float* las = (LAS float*)(lds + LDS_EXTRA);
    const float* mod = (const float*)(a.ws + WS_MOD);
    bf16_t* h1 = (bf16_t*)(a.ws + WS_H1); float* gk = (float*)(a.ws + WS_GK);
    float wl[64];
    { const int kk = lane >> 4, fr = lane & 15; const float* wp = a.w_in + (size_t)(w * 256 + kk) * DIN + 3072 + fr;
#pragma unroll
      for (int ks = 0; ks < 64; ++ks) wl[ks] = wp[(size_t)ks * 4 * DIN]; }
    float w2[16];
#pragma unroll
    for (int j = 0; j < 16; ++j) w2[j] = a.w_alpha2[j * 512 + tid];
    const float bz = a.b_alpha[tid];
    for (int grp = blk; grp < NTOK / 16; grp += G) {
        {
            const int r0 = grp * 16 + 2 * w;
            const f32x4* xr0 = (const f32x4*)(a.x + (size_t)r0 * DM) + lane; const f32x4* xr1 = xr0 + DM / 4;
            f32x4 v0[8], v1[8]; float ss0 = 0.f, ss1 = 0.f;
#pragma unroll
            for (int q = 0; q < 8; ++q) { v0[q] = xr0[64 * q]; v1[q] = xr1[64 * q]; }
#pragma unroll
            for (int q = 0; q < 8; ++q) { ss0 += (v0[q][0] * v0[q][0] + v0[q][1] * v0[q][1]) + (v0[q][2] * v0[q][2] + v0[q][3] * v0[q][3]); ss1 += (v1[q][0] * v1[q][0] + v1[q][1] * v1[q][1]) + (v1[q][2] * v1[q][2] + v1[q][3] * v1[q][3]); }
            ss0 = wave_sum(ss0); ss1 = wave_sum(ss1);
            const float rstd0 = 1.0f / sqrtf(ss0 * (1.0f / DM) + EPS), rstd1 = 1.0f / sqrtf(ss1 * (1.0f / DM) + EPS);
            const float* sh = mod + (size_t)(r0 >> 12) * 12288; const float* sc = sh + 2048;
#pragma unroll
            for (int q = 0; q < 8; ++q) { const int k = 4 * (lane + 64 * q);
                const f32x4 nw = *(const f32x4*)(a.norm1_w + k), scv = *(const f32x4*)(sc + k), shv = *(const f32x4*)(sh + k);
                const f32x4 h0 = (v0[q] * rstd0 * nw) * (scv + 1.0f) + shv, h1v = (v1[q] * rstd1 * nw) * (scv + 1.0f) + shv;
                *(LAS f32x4*)(hs + (2 * w) * HS + k) = h0; *(LAS f32x4*)(hs + (2 * w + 1) * HS + k) = h1v;
                u32x2 o; o.x = cvt_pk_bf16(h0[0], h0[1]); o.y = cvt_pk_bf16(h0[2], h0[3]);
                *(u32x2*)(h1 + (size_t)r0 * DM + k) = o;
                o.x = cvt_pk_bf16(h1v[0], h1v[1]); o.y = cvt_pk_bf16(h1v[2], h1v[3]);
                *(u32x2*)(h1 + (size_t)(r0 + 1) * DM + k) = o; } }
        __syncthreads();
        {
            const int kk = lane >> 4, fr = lane & 15; f32x4 acc = {0.f, 0.f, 0.f, 0.f};
            const LAS float* hp = hs + fr * HS + w * 256 + kk;
#pragma unroll
            for (int ks = 0; ks < 64; ++ks) acc = __builtin_amdgcn_mfma_f32_16x16x4f32(wl[ks], hp[ks * 4], acc, 0, 0, 0);
#pragma unroll
            for (int r = 0; r < 4; ++r) part[(w * 16 + 4 * kk + r) * 16 + fr] = acc[r];
        }
        __syncthreads();
        if (tid < 256) { const int t = tid >> 4, j = tid & 15; float s = 0.f;
#pragma unroll
            for (int q = 0; q < 8; ++q) s += part[(q * 16 + j) * 16 + t];
            las[t * 16 + j] = s; }
        __syncthreads();
        {
#pragma unroll 4
            for (int t = 0; t < 16; ++t) { const LAS f32x4* lp = (const LAS f32x4*)(las + t * 16); float z = bz;
#pragma unroll
                for (int q = 0; q < 4; ++q) { const f32x4 l = lp[q]; z += l[0] * w2[4 * q] + l[1] * w2[4 * q + 1] + l[2] * w2[4 * q + 2] + l[3] * w2[4 * q + 3]; }
                const float ls = fminf(z, 0.f) - __logf(1.0f + __expf(-fabsf(z)));
                gk[(size_t)(grp * 16 + t) * 512 + tid] = ls * (1.0f / 16.0f); }
        }
        __syncthreads();
    }
}

__device__ __forceinline__ void gla_stage_vt(const bf16_t* proj, int row0, int h, LAS bf16_t* VT, int tid) {
    const int i = tid >> 3, seg = tid & 7;
    const u32x4* vp = (const u32x4*)(proj + (size_t)(row0 + i) * NPROJ + C_VA + h * 256 + seg * 32);
#pragma unroll
    for (int c4 = 0; c4 < 4; ++c4) { const u32x4 vv = vp[c4];
#pragma unroll
        for (int p = 0; p < 4; ++p) { const unsigned wd = vv[p]; const int e = seg * 32 + c4 * 8 + p * 2;
            VT[e * 72 + i] = (bf16_t)(wd & 0xffffu); VT[(e + 1) * 72 + i] = (bf16_t)(wd >> 16); } }
}
__device__ __forceinline__ void gla1_unit(const Args& a, LAS unsigned char* lds, int u) {
    const int tid = threadIdx.x, w = tid >> 6, lane = tid & 63;
    const int bh = u >> 6, c = u & 63, b = bh >> 2, h = bh & 3, row0 = b * SEQ + c * 64;
    LAS float* Bm = (LAS float*)lds; LAS bf16_t* KT = (LAS bf16_t*)(lds + 32768); LAS bf16_t* VT = (LAS bf16_t*)(lds + 51200);
    const float* gk = (const float*)(a.ws + WS_GK); const bf16_t* proj = (const bf16_t*)(a.ws + WS_PROJ);
    float* bcum = (float*)(a.ws + WS_BCUM); float* dst = (float*)(a.ws + WS_DST); float* dec = (float*)(a.ws + WS_DEC);
    const int i = tid >> 3, seg = tid & 7;
    {
        const f32x4* gp = (const f32x4*)(gk + (size_t)(row0 + i) * 512 + h * 128 + seg * 16);
#pragma unroll
        for (int q = 0; q < 4; ++q) *(LAS f32x4*)(Bm + i * 128 + seg * 16 + q * 4) = gp[q];
    }
    __syncthreads();
    {
        const int d = tid & 127, q4 = tid >> 7; LAS float* qs = (LAS float*)(lds + 90112);
        float run = 0.f;
#pragma unroll
        for (int ii = 0; ii < 16; ++ii) { run += Bm[(q4 * 16 + ii) * 128 + d]; Bm[(q4 * 16 + ii) * 128 + d] = run; }
        qs[q4 * 128 + d] = run;
        __syncthreads();
        float off = 0.f;
#pragma unroll
        for (int qq = 0; qq < 3; ++qq) off += (qq < q4) ? qs[qq * 128 + d] : 0.f;
        if (q4 > 0) {
#pragma unroll
            for (int ii = 0; ii < 16; ++ii) Bm[(q4 * 16 + ii) * 128 + d] += off; }
    }
    __syncthreads();
    {
        const u32x4* kp = (const u32x4*)(proj + (size_t)(row0 + i) * NPROJ + C_KA + h * 128 + seg * 16);
        float* bo = bcum + ((size_t)u * 64 + i) * 128 + seg * 16;
#pragma unroll
        for (int q = 0; q < 2; ++q) { const u32x4 kv = kp[q];
#pragma unroll
            for (int p = 0; p < 4; ++p) { const int d = seg * 16 + q * 8 + p * 2;
                const float b0 = Bm[i * 128 + d], b1 = Bm[i * 128 + d + 1], l0 = Bm[63 * 128 + d], l1 = Bm[63 * 128 + d + 1];
                bo[q * 8 + p * 2] = b0; bo[q * 8 + p * 2 + 1] = b1;
                KT[d * 72 + i] = f2bf(bflo(kv[p]) * expf(l0 - b0)); KT[(d + 1) * 72 + i] = f2bf(bfhi(kv[p]) * expf(l1 - b1));
                if (i == 63) { dec[(size_t)u * 128 + d] = expf(l0); dec[(size_t)u * 128 + d + 1] = expf(l1); } } }
        gla_stage_vt(proj, row0, h, VT, tid);
    }
    __syncthreads();
    {
        f32x4 acc[2][8];
#pragma unroll
        for (int x = 0; x < 2; ++x)
#pragma unroll
            for (int y = 0; y < 8; ++y) acc[x][y] = (f32x4){0.f, 0.f, 0.f, 0.f};
#pragma unroll
        for (int ks = 0; ks < 2; ++ks) {
            const bf16x8 a0 = lds_frag(VT, 72, (2 * w) * 16, ks * 32, lane), a1 = lds_frag(VT, 72, (2 * w + 1) * 16, ks * 32, lane);
#pragma unroll
            for (int dt = 0; dt < 8; ++dt) { const bf16x8 bf = lds_frag(KT, 72, dt * 16, ks * 32, lane); acc[0][dt] = mfma16(a0, bf, acc[0][dt]); acc[1][dt] = mfma16(a1, bf, acc[1][dt]); }
        }
        float* dp = dst + (size_t)u * 32768;
#pragma unroll
        for (int x = 0; x < 2; ++x)
#pragma unroll
            for (int dt = 0; dt < 8; ++dt)
#pragma unroll
                for (int r = 0; r < 4; ++r) dp[((2 * w + x) * 16 + 4 * (lane >> 4) + r) * 128 + dt * 16 + (lane & 15)] = acc[x][dt][r];
    }
    __syncthreads();
}
__device__ __forceinline__ void moba_prep_unit(const Args& a, LAS unsigned char* lds, int u2) {
    const int tid = threadIdx.x;
    const int bh = u2 >> 4, kb = u2 & 15, b = bh >> 3, h = bh & 7, row0 = b * SEQ + kb * 256, t0 = kb * 256;
    const bf16_t* proj = (const bf16_t*)(a.ws + WS_PROJ);
    const float* ct = (const float*)(a.ws + WS_ROPE); const float* st = ct + 4096 * 64;
    bf16_t* qbr = (bf16_t*)(a.ws + WS_QBR); bf16_t* kbr = (bf16_t*)(a.ws + WS_KBR); bf16_t* vbt = (bf16_t*)(a.ws + WS_VBT); float* kmean = (float*)(a.ws + WS_KMEAN);
    constexpr int KS = 132;
    LAS float* Kf = (LAS float*)lds;
    LAS float* part = (LAS float*)(lds + 135168);
    LAS bf16_t* Vl = (LAS bf16_t*)(lds + 139264);
    const int rl = tid >> 3, c = tid & 7;
    f32x4 cvv[4][2], svv[4][2]; u32x4 xin[4][2][2], vin[4][2];
#pragma unroll
    for (int pass = 0; pass < 4; ++pass) { const int row = pass * 64 + rl;
        cvv[pass][0] = *(const f32x4*)(ct + (size_t)(t0 + row) * 64 + c * 8); cvv[pass][1] = *(const f32x4*)(ct + (size_t)(t0 + row) * 64 + c * 8 + 4);
        svv[pass][0] = *(const f32x4*)(st + (size_t)(t0 + row) * 64 + c * 8); svv[pass][1] = *(const f32x4*)(st + (size_t)(t0 + row) * 64 + c * 8 + 4);
#pragma unroll
        for (int which = 0; which < 2; ++which) { const bf16_t* src = proj + (size_t)(row0 + row) * NPROJ + (which == 0 ? C_KB : C_QB) + h * 128 + c * 8;
            xin[pass][which][0] = *(const u32x4*)src; xin[pass][which][1] = *(const u32x4*)(src + 64); } }
#pragma unroll
    for (int sl = 0; sl < 4; ++sl)
#pragma unroll
        for (int ps = 0; ps < 2; ++ps) { const int row = ps * 128 + (tid >> 2);
            vin[sl][ps] = *(const u32x4*)(proj + (size_t)(row0 + row) * NPROJ + C_VB + h * 128 + sl * 32 + (tid & 3) * 8); }
#pragma unroll
    for (int pass = 0; pass < 4; ++pass) { const int row = pass * 64 + rl;
        const f32x4 cv0 = cvv[pass][0], cv1 = cvv[pass][1], sv0 = svv[pass][0], sv1 = svv[pass][1];
#pragma unroll
        for (int which = 0; which < 2; ++which) {
            bf16_t* dsto = (which == 0 ? kbr : qbr) + ((size_t)bh * SEQ + t0 + row) * 128 + c * 8;
            const u32x4 x1 = xin[pass][which][0], x2 = xin[pass][which][1];
            u32x4 o1, o2; float r1[8], r2[8];
#pragma unroll
            for (int p = 0; p < 4; ++p) {
                const float c0 = (p < 2) ? cv0[2 * p] : cv1[2 * p - 4], c1 = (p < 2) ? cv0[2 * p + 1] : cv1[2 * p - 3], s0 = (p < 2) ? sv0[2 * p] : sv1[2 * p - 4], s1 = (p < 2) ? sv0[2 * p + 1] : sv1[2 * p - 3];
                const float a0 = bflo(x1[p]), a1 = bfhi(x1[p]), b0 = bflo(x2[p]), b1 = bfhi(x2[p]);
                r1[2 * p] = a0 * c0 - b0 * s0; r1[2 * p + 1] = a1 * c1 - b1 * s1; r2[2 * p] = a0 * s0 + b0 * c0; r2[2 * p + 1] = a1 * s1 + b1 * c1;
                o1[p] = cvt_pk_bf16(r1[2 * p], r1[2 * p + 1]); o2[p] = cvt_pk_bf16(r2[2 * p], r2[2 * p + 1]); }
            *(u32x4*)dsto = o1; *(u32x4*)(dsto + 64) = o2;
            if (which == 0) { LAS float* kr = Kf + row * KS + c * 8;
                *(LAS f32x4*)kr = (f32x4){r1[0], r1[1], r1[2], r1[3]}; *(LAS f32x4*)(kr + 4) = (f32x4){r1[4], r1[5], r1[6], r1[7]};
                *(LAS f32x4*)(kr + 64) = (f32x4){r2[0], r2[1], r2[2], r2[3]}; *(LAS f32x4*)(kr + 68) = (f32x4){r2[4], r2[5], r2[6], r2[7]}; }
        }
    }
    __syncthreads();
    { const int d = tid & 127, rq = tid >> 7; float s = 0.f;
#pragma unroll 8
        for (int rr = 0; rr < 64; ++rr) s += Kf[(rq * 64 + rr) * KS + d];
        part[rq * 128 + d] = s; }
    __syncthreads();
    if (tid < 128) kmean[((size_t)bh * 16 + kb) * 128 + tid] = (part[tid] + part[128 + tid] + part[256 + tid] + part[384 + tid]) * (1.0f / 256.0f);
#pragma unroll
    for (int sl = 0; sl < 4; ++sl) {
        { const int rw = tid >> 2, c4 = tid & 3;
#pragma unroll
            for (int ps = 0; ps < 2; ++ps) { const int row = ps * 128 + rw;
                *(LAS u32x4*)(Vl + row * 40 + (((c4 + (row >> 4)) & 3) << 3)) = vin[sl][ps]; } }
        __syncthreads();
        { const int d = tid >> 4, tc = tid & 15;
            u32x4 o0, o1;
            const int dp = ((((d >> 3) + tc) & 3) << 3) + (d & 7);
#pragma unroll
            for (int p = 0; p < 4; ++p) { const int tt = tc * 16 + p * 2; o0[p] = (unsigned)Vl[tt * 40 + dp] | ((unsigned)Vl[(tt + 1) * 40 + dp] << 16);
                o1[p] = (unsigned)Vl[(tt + 8) * 40 + dp] | ((unsigned)Vl[(tt + 9) * 40 + dp] << 16); }
            bf16_t* op = vbt + ((size_t)bh * 128 + sl * 32 + d) * SEQ + t0 + tc * 16;
            *(u32x4*)op = o0; *(u32x4*)(op + 8) = o1; }
        __syncthreads();
    }
}
__device__ __forceinline__ void phase_mix_prep(const Args& a, LAS unsigned char* lds) {
    const int blk = blockIdx.x, G = gridDim.x;
    for (int u = blk; u < 512; u += G) gla1_unit(a, lds, u);
    for (int u2 = blk; u2 < 256; u2 += G) moba_prep_unit(a, lds, u2);
}

__device__ __forceinline__ void phase_scan_select(const Args& a, LAS unsigned char* lds) {
    const int tid = threadIdx.x, blk = blockIdx.x, G = gridDim.x;
    {
        const float* dst = (const float*)(a.ws + WS_DST); const float* dec = (const float*)(a.ws + WS_DEC); bf16_t* ST = (bf16_t*)(a.ws + WS_ST);
        for (int el = blk * 512 + tid; el < 8 * 32768; el += G * 512) {
            const int bh = el >> 15, ed = el & 32767, d = ed & 127; float cur = 0.f;
#pragma unroll 1
            for (int c0 = 0; c0 < 64; c0 += 32) { float dv[32], gv[32];
#pragma unroll
                for (int c = 0; c < 32; ++c) { const size_t u = (size_t)bh * 64 + c0 + c; dv[c] = dst[u * 32768 + ed]; gv[c] = dec[u * 128 + d]; }
#pragma unroll
                for (int c = 0; c < 32; ++c) { const size_t u = (size_t)bh * 64 + c0 + c; ST[u * 32768 + ed] = f2bf(cur); cur = gv[c] * cur + dv[c]; } }
        }
    }
    {
        const float* kmean = (const float*)(a.ws + WS_KMEAN); const bf16_t* qbr = (const bf16_t*)(a.ws + WS_QBR); unsigned* sel = (unsigned*)(a.ws + WS_SEL);
        LAS float* km = (LAS float*)lds;
        for (int u2 = blk; u2 < 256; u2 += G) {
            const int bh = u2 >> 4, qb = u2 & 15;
            __syncthreads();
            for (int i = tid; i < 2048; i += 512) km[i] = kmean[(size_t)bh * 2048 + i];
            __syncthreads();
            const int q = tid >> 1, half = tid & 1;
            float gv[8];
#pragma unroll
            for (int n = 0; n < 8; ++n) gv[n] = 0.f;
            const u32x4* qp = (const u32x4*)(qbr + ((size_t)bh * SEQ + qb * 256 + q) * 128);
#pragma unroll 4
            for (int c = 0; c < 16; ++c) { const u32x4 qq = qp[c]; float qf[8];
#pragma unroll
                for (int p = 0; p < 4; ++p) { qf[2 * p] = bflo(qq[p]); qf[2 * p + 1] = bfhi(qq[p]); }
#pragma unroll
                for (int n = 0; n < 8; ++n) { const LAS float* kr = km + (half * 8 + n) * 128 + c * 8; const f32x4 k0 = *(const LAS f32x4*)kr, k1 = *(const LAS f32x4*)(kr + 4);
                    gv[n] += (qf[0] * k0[0] + qf[1] * k0[1]) + (qf[2] * k0[2] + qf[3] * k0[3]) + (qf[4] * k1[0] + qf[5] * k1[1]) + (qf[6] * k1[2] + qf[7] * k1[3]); } }
            float ga[16];
#pragma unroll
            for (int n = 0; n < 8; ++n) { const float o = __shfl_xor(gv[n], 1); ga[n] = half ? o : gv[n]; ga[8 + n] = half ? gv[n] : o; }
            unsigned mask = 0u; const int nsel = qb < 3 ? qb : 3;
            for (int s = 0; s < nsel; ++s) { int best = -1; float bv = -INFINITY;
#pragma unroll
                for (int n = 0; n < 16; ++n) { const bool ok = (n < qb) && !((mask >> n) & 1u) && (best < 0 || ga[n] > bv); if (ok) { bv = ga[n]; best = n; } }
                mask |= 1u << best; }
            if (half == 0) sel[(size_t)bh * SEQ + qb * 256 + q] = mask;
        }
        __syncthreads();
    }
}

#ifndef CHECK_MODE
#define CHECK_MODE 0
#endif
constexpr size_t WS_CHK = 18432;
constexpr size_t WS_CHKO = WS_Y + 160 * MB;
#if CHECK_MODE
__device__ __forceinline__ void phase_check(const Args& a, LAS unsigned char* lds) {
    const int tid = threadIdx.x, blk = blockIdx.x, G = gridDim.x, w = tid >> 6, lane = tid & 63;
    const bf16_t* proj = (const bf16_t*)(a.ws + WS_PROJ); const bf16_t* ocat = (const bf16_t*)(a.ws + WS_OCAT);
    float* chk = (float*)(a.ws + WS_CHK);
#if CHECK_MODE == 1
    const float* ct = (const float*)(a.ws + WS_ROPE); const float* st = ct + 4096 * 64;
    for (int task = blk * 8 + w; task < 67 * 16; task += G * 8) {
        const int s = task >> 4, bh = task & 15, b = bh >> 3, h = bh & 7, t = 61 * s + 7, qblk = t >> 8;
        const bf16_t* qrow = proj + (size_t)(b * SEQ + t) * NPROJ + C_QB + h * 128;
        const float c = ct[t * 64 + lane], sn = st[t * 64 + lane];
        const float q1 = bf2f(qrow[lane]), q2 = bf2f(qrow[lane + 64]);
        const float qa = q1 * c - q2 * sn, qb2 = q1 * sn + q2 * c;
        float gate[16];
#pragma unroll 1
        for (int n = 0; n < 16; ++n) { float g = -INFINITY;
            if (n < qblk) { float m1 = 0.f, m2 = 0.f;
                for (int kk = 0; kk < 256; ++kk) { const int tk = n * 256 + kk; const bf16_t* krow = proj + (size_t)(b * SEQ + tk) * NPROJ + C_KB + h * 128;
                    const float k1 = bf2f(krow[lane]), k2 = bf2f(krow[lane + 64]), ck = ct[tk * 64 + lane], sk = st[tk * 64 + lane];
                    m1 += k1 * ck - k2 * sk; m2 += k1 * sk + k2 * ck; }
                g = wave_sum(qa * (m1 * (1.0f / 256.0f)) + qb2 * (m2 * (1.0f / 256.0f))); }
#pragma unroll
            for (int z = 0; z < 16; ++z) if (z == n) gate[z] = g; }
        unsigned mask = 0u; const int nsel = qblk < 3 ? qblk : 3;
        for (int it = 0; it < nsel; ++it) { int best = -1; float bv = -INFINITY;
#pragma unroll
            for (int n = 0; n < 16; ++n) { const bool ok = (n < qblk) && !((mask >> n) & 1u) && (best < 0 || gate[n] > bv); if (ok) { bv = gate[n]; best = n; } }
            mask |= 1u << best; }
        { const unsigned fastsel = ((const unsigned*)(a.ws + WS_SEL))[(size_t)bh * SEQ + t];
          if (fastsel != mask) { if (lane == 0) atomicAdd(&chk[2], 1.0f); continue; } }
        mask |= 1u << qblk;
        float m = -INFINITY, l = 0.f, o1 = 0.f, o2 = 0.f;
        for (int n = 0; n <= qblk; ++n) { if (!((mask >> n) & 1u)) continue;
            for (int kk = 0; kk < 256; ++kk) { const int tk = n * 256 + kk; if (tk > t) break;
                const bf16_t* krow = proj + (size_t)(b * SEQ + tk) * NPROJ + C_KB + h * 128; const bf16_t* vrow = proj + (size_t)(b * SEQ + tk) * NPROJ + C_VB + h * 128;
                const float k1 = bf2f(krow[lane]), k2 = bf2f(krow[lane + 64]), ck = ct[tk * 64 + lane], sk = st[tk * 64 + lane];
                const float sc = wave_sum(qa * (k1 * ck - k2 * sk) + qb2 * (k1 * sk + k2 * ck)) * 0.08838834764831845f;
                const float mn = fmaxf(m, sc), al = expf(m - mn), p = expf(sc - mn);
                l = l * al + p; o1 = o1 * al + p * bf2f(vrow[lane]); o2 = o2 * al + p * bf2f(vrow[lane + 64]); m = mn; } }
        o1 /= l; o2 /= l;
        const bf16_t* frow = ocat + (size_t)(b * SEQ + t) * DM + 1024 + h * 128;
        const float f1 = bf2f(frow[lane]), f2 = bf2f(frow[lane + 64]);
        const float num = wave_sum((f1 - o1) * (f1 - o1) + (f2 - o2) * (f2 - o2)), den = wave_sum(o1 * o1 + o2 * o2);
        if (lane == 0) { atomicAdd(&chk[0], num); atomicAdd(&chk[1], den); }
    }
#else
    const int cb = 1, ch = 2; const float* gk = (const float*)(a.ws + WS_GK); float* oref = (float*)(a.ws + WS_CHKO);
    for (int e = blk * 8 + w; e < 256; e += G * 8) {
        float s1 = 0.f, s2 = 0.f;
        for (int t = 0; t < SEQ; ++t) { const size_t row = (size_t)(cb * SEQ + t);
            const bf16_t* pr = proj + row * NPROJ;
            const float a1 = expf(gk[row * 512 + ch * 128 + lane]), a2 = expf(gk[row * 512 + ch * 128 + lane + 64]);
            const float k1 = bf2f(pr[C_KA + ch * 128 + lane]), k2 = bf2f(pr[C_KA + ch * 128 + lane + 64]), v = bf2f(pr[C_VA + ch * 256 + e]);
            const float q1 = bf2f(pr[C_QA + ch * 128 + lane]) * 0.08838834764831845f, q2 = bf2f(pr[C_QA + ch * 128 + lane + 64]) * 0.08838834764831845f;
            s1 = a1 * s1 + k1 * v; s2 = a2 * s2 + k2 * v;
            const float o = wave_sum(q1 * s1 + q2 * s2);
            if (lane == 0) oref[(size_t)t * 256 + e] = o; }
    }
#endif
}
__device__ __forceinline__ void phase_check2(const Args& a, LAS unsigned char* lds) {
#if CHECK_MODE == 2
    const int tid = threadIdx.x, blk = blockIdx.x, G = gridDim.x, w = tid >> 6, lane = tid & 63;
    const int cb = 1, ch = 2; const float* oref = (const float*)(a.ws + WS_CHKO); float* chk = (float*)(a.ws + WS_CHK);
    const bf16_t* proj = (const bf16_t*)(a.ws + WS_PROJ); const bf16_t* ocat = (const bf16_t*)(a.ws + WS_OCAT);
    for (int t = blk * 8 + w; t < SEQ; t += G * 8) { float o[4], ss = 0.f;
#pragma unroll
        for (int q = 0; q < 4; ++q) { o[q] = oref[(size_t)t * 256 + lane + 64 * q]; ss += o[q] * o[q]; }
        ss = wave_sum(ss); const float rstd = 1.0f / sqrtf(ss * (1.0f / 256.0f) + EPS); float num = 0.f, den = 0.f;
#pragma unroll
        for (int q = 0; q < 4; ++q) { const int e = lane + 64 * q; const size_t row = (size_t)(cb * SEQ + t);
            const float ga = bf2f(proj[row * NPROJ + C_GA + ch * 256 + e]), ref = o[q] * rstd * a.gla_norm_w[e] * silu_f(ga), f = bf2f(ocat[row * DM + ch * 256 + e]);
            num += (f - ref) * (f - ref); den += ref * ref; }
        num = wave_sum(num); den = wave_sum(den);
        if (lane == 0) { atomicAdd(&chk[0], num); atomicAdd(&chk[1], den); } }
#endif
}
#endif
#ifndef DYN10
#define DYN10 0
#endif
#ifndef PROBE_TIME
#define PROBE_TIME -1
#endif
#ifndef PROBE_TOFF
#define PROBE_TOFF 0.0f
#endif
#ifndef PROBE_TSCALE
#define PROBE_TSCALE 3000.0f
#endif
#ifndef CONV_IN_GEMM
#define CONV_IN_GEMM 1
#endif
#ifndef CONV_IN_ATTN
#define CONV_IN_ATTN 1
#endif
#ifndef CONV_BLK
#define CONV_BLK 1
#endif

__device__ __forceinline__ void gla3_unit(const Args& a, LAS unsigned char* lds, int u) {
    const int tid = threadIdx.x, w = tid >> 6, lane = tid & 63, g = lane >> 4, fr = lane & 15;
    const int bh = u >> 6, c = u & 63, b = bh >> 2, h = bh & 3, row0 = b * SEQ + c * 64;
    LAS bf16_t* QP = (LAS bf16_t*)lds; LAS bf16_t* KP = (LAS bf16_t*)(lds + 17408); LAS bf16_t* VT = (LAS bf16_t*)(lds + 34816);
    LAS bf16_t* AM = (LAS bf16_t*)(lds + 71680); LAS float* OT = (LAS float*)(lds + 81920);
    const bf16_t* proj = (const bf16_t*)(a.ws + WS_PROJ); const float* bcum = (const float*)(a.ws + WS_BCUM); const bf16_t* ST = (const bf16_t*)(a.ws + WS_ST);
    bf16_t* ocat = (bf16_t*)(a.ws + WS_OCAT);
    {
        const int i = tid >> 3, seg = tid & 7;
        const f32x4* bp = (const f32x4*)(bcum + ((size_t)u * 64 + i) * 128 + seg * 16);
        const u32x4* qp = (const u32x4*)(proj + (size_t)(row0 + i) * NPROJ + C_QA + h * 128 + seg * 16);
        const u32x4* kp = (const u32x4*)(proj + (size_t)(row0 + i) * NPROJ + C_KA + h * 128 + seg * 16);
#pragma unroll
        for (int q = 0; q < 2; ++q) { const u32x4 qv = qp[q], kv = kp[q]; const f32x4 b0 = bp[2 * q], b1 = bp[2 * q + 1]; u32x4 qo, ko;
#pragma unroll
            for (int p = 0; p < 4; ++p) { const float bl = (p < 2) ? b0[2 * p] : b1[2 * p - 4], bhv = (p < 2) ? b0[2 * p + 1] : b1[2 * p - 3];
                const float el = expf(bl), eh = expf(bhv);
                qo[p] = cvt_pk_bf16(bflo(qv[p]) * el * 0.08838834764831845f, bfhi(qv[p]) * eh * 0.08838834764831845f);
                ko[p] = cvt_pk_bf16(bflo(kv[p]) / el, bfhi(kv[p]) / eh); }
            *(LAS u32x4*)(QP + i * 136 + seg * 16 + q * 8) = qo; *(LAS u32x4*)(KP + i * 136 + seg * 16 + q * 8) = ko; }
        gla_stage_vt(proj, row0, h, VT, tid);
    }
    __syncthreads();
    {
        const int it = w >> 1;
#pragma unroll
        for (int jj = 0; jj < 2; ++jj) { const int jt = (w & 1) * 2 + jj; f32x4 acc = {0.f, 0.f, 0.f, 0.f};
            if (jt <= it) {
#pragma unroll
                for (int ks = 0; ks < 4; ++ks) acc = mfma16(lds_frag(QP, 136, it * 16, ks * 32, lane), lds_frag(KP, 136, jt * 16, ks * 32, lane), acc);
            }
#pragma unroll
            for (int r = 0; r < 4; ++r) { const int i = it * 16 + 4 * g + r, j = jt * 16 + fr; AM[i * 72 + j] = f2bf((j <= i) ? acc[r] : 0.f); } }
    }
    __syncthreads();
    f32x4 acc[4][2];
    {
#pragma unroll
        for (int x = 0; x < 4; ++x)
#pragma unroll
            for (int y = 0; y < 2; ++y) acc[x][y] = (f32x4){0.f, 0.f, 0.f, 0.f};
        bf16x8 bS[2][4];
        const bf16_t* stp = ST + (size_t)u * 32768;
#pragma unroll
        for (int e2 = 0; e2 < 2; ++e2)
#pragma unroll
            for (int ks = 0; ks < 4; ++ks) bS[e2][ks] = *(const bf16x8*)(stp + ((2 * w + e2) * 16 + fr) * 128 + ks * 32 + 8 * g);
#pragma unroll
        for (int it = 0; it < 4; ++it) {
#pragma unroll
            for (int ks = 0; ks < 4; ++ks) { const bf16x8 aq = lds_frag(QP, 136, it * 16, ks * 32, lane); acc[it][0] = mfma16(aq, bS[0][ks], acc[it][0]); acc[it][1] = mfma16(aq, bS[1][ks], acc[it][1]); }
#pragma unroll
            for (int k2 = 0; k2 < 2; ++k2) { const bf16x8 aa = lds_frag(AM, 72, it * 16, k2 * 32, lane);
                acc[it][0] = mfma16(aa, lds_frag(VT, 72, (2 * w) * 16, k2 * 32, lane), acc[it][0]); acc[it][1] = mfma16(aa, lds_frag(VT, 72, (2 * w + 1) * 16, k2 * 32, lane), acc[it][1]); }
        }
#pragma unroll
        for (int it = 0; it < 4; ++it)
#pragma unroll
            for (int r = 0; r < 4; ++r)
#pragma unroll
                for (int e2 = 0; e2 < 2; ++e2) OT[(it * 16 + 4 * g + r) * 260 + (2 * w + e2) * 16 + fr] = acc[it][e2][r];
    }
    __syncthreads();
    {
        const int i = tid >> 3, seg = tid & 7;
        const LAS float* orow = OT + i * 260 + seg * 32;
        f32x4 ov[8]; float ss = 0.f;
#pragma unroll
        for (int q = 0; q < 8; ++q) { ov[q] = *(const LAS f32x4*)(orow + 4 * q); ss += (ov[q][0] * ov[q][0] + ov[q][1] * ov[q][1]) + (ov[q][2] * ov[q][2] + ov[q][3] * ov[q][3]); }
        ss += __shfl_xor(ss, 1); ss += __shfl_xor(ss, 2); ss += __shfl_xor(ss, 4);
        const float rstd = 1.0f / sqrtf(ss * (1.0f / 256.0f) + EPS);
        const u32x4* gp = (const u32x4*)(proj + (size_t)(row0 + i) * NPROJ + C_GA + h * 256 + seg * 32);
        bf16_t* op = ocat + (size_t)(row0 + i) * DM + h * 256 + seg * 32;
        u32x4 gvs[4]; f32x4 nws[4][2];
#pragma unroll
        for (int c8 = 0; c8 < 4; ++c8) { gvs[c8] = gp[c8]; nws[c8][0] = *(const f32x4*)(a.gla_norm_w + seg * 32 + c8 * 8); nws[c8][1] = *(const f32x4*)(a.gla_norm_w + seg * 32 + c8 * 8 + 4); }
#pragma unroll
        for (int c8 = 0; c8 < 4; ++c8) { const u32x4 gv = gvs[c8]; u32x4 o;
            const f32x4 nw0 = nws[c8][0], nw1 = nws[c8][1];
#pragma unroll
            for (int pp = 0; pp < 4; ++pp) { const float g0 = bflo(gv[pp]), g1 = bfhi(gv[pp]);
                const float n0 = (pp < 2) ? nw0[2 * pp] : nw1[2 * pp - 4], n1 = (pp < 2) ? nw0[2 * pp + 1] : nw1[2 * pp - 3];
                const float v0 = ((pp & 1) ? ov[2 * c8 + (pp >> 1)][2] : ov[2 * c8 + (pp >> 1)][0]) * rstd * n0 * (g0 * __builtin_amdgcn_rcpf(1.0f + __expf(-g0)));
                const float v1 = ((pp & 1) ? ov[2 * c8 + (pp >> 1)][3] : ov[2 * c8 + (pp >> 1)][1]) * rstd * n1 * (g1 * __builtin_amdgcn_rcpf(1.0f + __expf(-g1)));
#if FP8_EMU
                o[pp] = cvt_pk_bf16(q8(v0), q8(v1));
#else
                o[pp] = cvt_pk_bf16(v0, v1);
#endif
            }
            *(u32x4*)(op + c8 * 8) = o; }
    }
    __syncthreads();
}

typedef short s16x4 __attribute__((ext_vector_type(4)));
__device__ __forceinline__ void moba_attn_unit(const Args& a, LAS unsigned char* lds, int bh, int qb, int half, int cjob0) {
    const int tid = threadIdx.x, w = tid >> 6, lane = tid & 63, g = lane >> 4, fr = lane & 15;
    bh = __builtin_amdgcn_readfirstlane(bh); qb = __builtin_amdgcn_readfirstlane(qb); half = __builtin_amdgcn_readfirstlane(half);
    const int b = bh >> 3, h = bh & 7, rg = w & 3, par = w >> 2, qbase = 128 * half + 32 * rg;
    const bf16_t* qbr = (const bf16_t*)(a.ws + WS_QBR); const bf16_t* kbr = (const bf16_t*)(a.ws + WS_KBR); const bf16_t* vbt = (const bf16_t*)(a.ws + WS_VBT);
    const unsigned* sel = (const unsigned*)(a.ws + WS_SEL); bf16_t* ocat = (bf16_t*)(a.ws + WS_OCAT);
    const int nown = 2 * half + 2, nsteps = (nown + 4 * qb) >> 1;
    bf16x8 qf[2][4]; unsigned sm[2]; float m[2], l[2]; f32x4 O[8][2];
#pragma unroll
    for (int b2 = 0; b2 < 2; ++b2) { const size_t qrow = (size_t)bh * SEQ + qb * 256 + qbase + 16 * b2 + fr;
#pragma unroll
        for (int ks = 0; ks < 4; ++ks) qf[b2][ks] = *(const bf16x8*)(qbr + qrow * 128 + ks * 32 + 8 * g);
        sm[b2] = sel[qrow]; m[b2] = -INFINITY; l[b2] = 0.f;
#pragma unroll
        for (int dt = 0; dt < 8; ++dt) O[dt][b2] = (f32x4){0.f, 0.f, 0.f, 0.f}; }
    const float cs = 0.08838834764831845f * 1.4426950408889634f;
    unsigned kso[2], vso[2];
#pragma unroll
    for (int p = 0; p < 2; ++p) { const int kr = 4 * (w + 8 * p) + (lane >> 4), kc = (lane & 15) ^ (kr & 15); kso[p] = (unsigned)(kr * 256 + kc * 16);
        const int vr = 8 * (w + 8 * p) + (lane >> 3), vc = (lane & 7) ^ ((vr >> 1) & 7); vso[p] = (unsigned)(vr * (SEQ * 2) + vc * 16); }
    const char* kbase = (const char*)(kbr + (size_t)bh * SEQ * 128); const char* vbase = (const char*)(vbt + (size_t)bh * 128 * SEQ);
    auto tile_jk = [&](int ti, int& j, int& kt) { if (ti < nown) { j = qb; kt = ti; } else { const int tj = ti - nown; j = tj >> 2; kt = tj & 3; } };
    auto stage = [&](int s) {
#pragma unroll
        for (int t2 = 0; t2 < 2; ++t2) { int j, kt; tile_jk(2 * s + t2, j, kt); const int key0 = j * 256 + kt * 64;
            LAS unsigned char* dstb = lds + (s & 1) * 65536 + t2 * 32768 + w * 1024;
            const char* ks = pg8::sbase(kbase + (size_t)key0 * 256); const char* vs = pg8::sbase(vbase + (size_t)key0 * 2);
#pragma unroll
            for (int p = 0; p < 2; ++p) {
                __builtin_amdgcn_global_load_lds((const unsigned*)(ks + kso[p]), (LAS unsigned*)(dstb + p * 8192), 16, 0, 0);
                __builtin_amdgcn_global_load_lds((const unsigned*)(vs + vso[p]), (LAS unsigned*)(dstb + 16384 + p * 8192), 16, 0, 0); } } };
    __syncthreads();
    stage(0);
    f32x4 cv[8]; const int cjob = __builtin_amdgcn_readfirstlane(cjob0);
    if (CONV_IN_ATTN) { const SJob cj = sjob_addr(a, cjob, lane); sjob_load(cj, cv); }
#pragma unroll 1
    for (int s = 0; s < nsteps; ++s) {
        asm volatile("s_waitcnt vmcnt(0)" ::: "memory");
        __syncthreads();
        if (s + 1 < nsteps) stage(s + 1);
        if (CONV_IN_ATTN) { { const SJob cj = sjob_addr(a, cjob + 8 * s, lane); sjob_store(cj, cv); } if (s + 1 < nsteps) { const SJob cn = sjob_addr(a, cjob + 8 * (s + 1), lane); sjob_load(cn, cv); } }
        int j, kt; tile_jk(2 * s + par, j, kt);
        const bool own = (2 * s + par) < nown;
        if (own && kt * 64 > qbase + 31) continue;
        const LAS unsigned char* Kb = lds + (s & 1) * 65536 + par * 32768; const LAS unsigned char* Vb = Kb + 16384;
        f32x4 sc[4][2];
#pragma unroll
        for (int t4 = 0; t4 < 4; ++t4) { sc[t4][0] = (f32x4){0.f, 0.f, 0.f, 0.f}; sc[t4][1] = (f32x4){0.f, 0.f, 0.f, 0.f};
#pragma unroll
            for (int ks = 0; ks < 4; ++ks) { const bf16x8 kf = *(const LAS bf16x8*)(Kb + (t4 * 16 + fr) * 256 + (((ks * 4 + g) ^ fr) << 4)); sc[t4][0] = mfma16(kf, qf[0][ks], sc[t4][0]); sc[t4][1] = mfma16(kf, qf[1][ks], sc[t4][1]); } }
        bf16x8 pf[2][2];
#pragma unroll
        for (int b2 = 0; b2 < 2; ++b2) {
            float tm = -INFINITY, nb;
            if (own) {
                const int qi = qbase + 16 * b2 + fr;
#pragma unroll
                for (int t4 = 0; t4 < 4; ++t4)
#pragma unroll
                    for (int r = 0; r < 4; ++r) { const int kk = kt * 64 + t4 * 16 + 4 * g + r; const float v = (kk <= qi) ? sc[t4][b2][r] : -INFINITY; sc[t4][b2][r] = v; tm = fmaxf(tm, v); }
            } else {
#pragma unroll
                for (int t4 = 0; t4 < 4; ++t4)
#pragma unroll
                    for (int r = 0; r < 4; ++r) tm = fmaxf(tm, sc[t4][b2][r]);
                if (!((sm[b2] >> j) & 1u)) tm = -INFINITY;
            }
            tm = fmaxf(tm, __shfl_xor(tm, 16)); tm = fmaxf(tm, __shfl_xor(tm, 32));
            if (__builtin_amdgcn_ballot_w64((tm - m[b2]) * cs > 11.5416f) != 0ull) {
                const float mnew = fmaxf(m[b2], tm), ms = (mnew == -INFINITY) ? 0.f : mnew;
                const float alpha = __builtin_amdgcn_exp2f((m[b2] - ms) * cs);
                l[b2] *= alpha; m[b2] = mnew;
#pragma unroll
                for (int dt = 0; dt < 8; ++dt) O[dt][b2] *= alpha;
            }
            nb = (m[b2] == -INFINITY) ? 0.f : -m[b2] * cs; if (!own && !((sm[b2] >> j) & 1u)) nb = -INFINITY;
            float ps = 0.f;
#pragma unroll
            for (int t4 = 0; t4 < 4; ++t4)
#pragma unroll
                for (int r = 0; r < 4; ++r) { const float pe = __builtin_amdgcn_exp2f(fmaf(sc[t4][b2][r], cs, nb)); sc[t4][b2][r] = pe; ps += pe; }
            ps += __shfl_xor(ps, 16); ps += __shfl_xor(ps, 32);
            l[b2] += ps;
#pragma unroll
            for (int k2 = 0; k2 < 2; ++k2) { u32x4 pkk; pkk.x = cvt_pk_bf16(sc[2 * k2][b2][0], sc[2 * k2][b2][1]); pkk.y = cvt_pk_bf16(sc[2 * k2][b2][2], sc[2 * k2][b2][3]);
                pkk.z = cvt_pk_bf16(sc[2 * k2 + 1][b2][0], sc[2 * k2 + 1][b2][1]); pkk.w = cvt_pk_bf16(sc[2 * k2 + 1][b2][2], sc[2 * k2 + 1][b2][3]);
                pf[k2][b2] = __builtin_bit_cast(bf16x8, pkk); }
        }
#pragma unroll
        for (int dt = 0; dt < 8; ++dt)
#pragma unroll
            for (int k2 = 0; k2 < 2; ++k2) { const int vr = dt * 16 + fr, c0 = 4 * k2 + (g >> 1), sw = (vr >> 1) & 7;
                const LAS unsigned char* vrow = Vb + vr * 128 + (g & 1) * 8;
                const s16x4 lo = *(const LAS s16x4*)(vrow + ((c0 ^ sw) << 4)), hi = *(const LAS s16x4*)(vrow + (((c0 + 2) ^ sw) << 4));
                const bf16x8 vf = __builtin_shufflevector(lo, hi, 0, 1, 2, 3, 4, 5, 6, 7);
                O[dt][0] = mfma16(vf, pf[k2][0], O[dt][0]); O[dt][1] = mfma16(vf, pf[k2][1], O[dt][1]); }
    }
    __syncthreads();
    LAS float* X = (LAS float*)lds + rg * (68 * 64) + lane;
    if (par == 1) {
#pragma unroll
        for (int b2 = 0; b2 < 2; ++b2) { X[(64 + b2) * 64] = m[b2]; X[(66 + b2) * 64] = l[b2];
#pragma unroll
            for (int dt = 0; dt < 8; ++dt)
#pragma unroll
                for (int r = 0; r < 4; ++r) X[((dt * 2 + b2) * 4 + r) * 64] = O[dt][b2][r]; } }
    __syncthreads();
    if (par == 0) {
#pragma unroll
        for (int b2 = 0; b2 < 2; ++b2) { const float m1 = X[(64 + b2) * 64], l1 = X[(66 + b2) * 64];
            const float mm = fmaxf(m[b2], m1), a0 = exp2f((m[b2] - mm) * cs), a1 = (m1 == -INFINITY) ? 0.f : exp2f((m1 - mm) * cs);
            const float inv = 1.0f / (l[b2] * a0 + l1 * a1);
            const size_t orow = (size_t)(b * SEQ + qb * 256 + qbase + 16 * b2 + fr) * DM + 1024 + h * 128;
#pragma unroll
            for (int dt = 0; dt < 8; ++dt) { float o4[4];
#pragma unroll
                for (int r = 0; r < 4; ++r) o4[r] = (O[dt][b2][r] * a0 + X[((dt * 2 + b2) * 4 + r) * 64] * a1) * inv;
                u32x2 o; o.x = cvt_pk_bf16(o4[0], o4[1]); o.y = cvt_pk_bf16(o4[2], o4[3]);
                *(u32x2*)(ocat + orow + dt * 16 + 4 * g) = o; } } }
    __syncthreads();
}
__device__ __forceinline__ void phase_mix_out(const Args& a, LAS unsigned char* lds) {
    const int blk = blockIdx.x, G = gridDim.x;
    for (int u = blk; u < 256; u += G) {
        const int cj0 = (u * 33) * 8 + (threadIdx.x >> 6);
        { const int c = u >> 4; moba_attn_unit(a, lds, u & 15, (31 - c) >> 1, (31 - c) & 1, cj0); }
        { const int u2 = 511 - u, c = u2 >> 4; moba_attn_unit(a, lds, u2 & 15, (31 - c) >> 1, (31 - c) & 1, cj0 + 8 * (32 - (u >> 4))); }
    }
    for (int u = blk; u < 512; u += G) gla3_unit(a, lds, u);
}

__device__ __forceinline__ void phase_router(const Args& a, LAS unsigned char* lds) {
    const int tid = threadIdx.x, blk = blockIdx.x, G = gridDim.x, w = tid >> 6, lane = tid & 63;
    constexpr int HS = 2052;
    LAS float* h2s = (LAS float*)lds;
    LAS float* part = (LAS float*)(lds + LDS_EXTRA + 4096);
    LAS float* logit = (LAS float*)(lds + LDS_EXTRA);
    LAS int* pe = (LAS int*)(lds + LDS_EXTRA + 2048); LAS float* pw = (LAS float*)(lds + LDS_EXTRA + 2560); LAS int* lpos = (LAS int*)(lds + LDS_EXTRA + 3072);
    LAS int* hist = (LAS int*)(lds + LDS_EXTRA + 3584); LAS int* base = (LAS int*)(lds + LDS_EXTRA + 3712);
    const float* mod = (const float*)(a.ws + WS_MOD); const float* x1 = (const float*)(a.ws + WS_X1); unsigned char* h2 = (unsigned char*)(a.ws + WS_H1);
    unsigned* cnt = (unsigned*)(a.ws + WS_CNT); int* pair_e = (int*)(a.ws + WS_PAIR_E); int* pair_pos = (int*)(a.ws + WS_PAIR_POS); int* tok_of = (int*)(a.ws + WS_SLOTROW); float* rw_of = (float*)(a.ws + WS_WBUF);
#ifdef PROBE_P7
    const unsigned long long p7t = __builtin_amdgcn_s_memrealtime();
#endif
    const float brt = a.b_router[tid & 31];
    for (int gp = blk; gp < 256; gp += G) {
        if (tid < 32) hist[tid] = 0;
#pragma unroll 1
        for (int gh = 0; gh < 2; ++gh) { const int grp = gp * 2 + gh;
            {
                const int t0 = grp * 16 + 2 * w;
                const f32x4* xr0 = (const f32x4*)(x1 + (size_t)t0 * DM) + lane; const f32x4* xr1 = xr0 + DM / 4;
                f32x4 v0[8], v1[8]; float ss0 = 0.f, ss1 = 0.f;
#pragma unroll
                for (int q = 0; q < 8; ++q) { v0[q] = xr0[64 * q]; v1[q] = xr1[64 * q]; }
#pragma unroll
                for (int q = 0; q < 8; ++q) { ss0 += (v0[q][0] * v0[q][0] + v0[q][1] * v0[q][1]) + (v0[q][2] * v0[q][2] + v0[q][3] * v0[q][3]); ss1 += (v1[q][0] * v1[q][0] + v1[q][1] * v1[q][1]) + (v1[q][2] * v1[q][2] + v1[q][3] * v1[q][3]); }
                ss0 = wave_sum(ss0); ss1 = wave_sum(ss1);
                const float rstd0 = 1.0f / sqrtf(ss0 * (1.0f / DM) + EPS), rstd1 = 1.0f / sqrtf(ss1 * (1.0f / DM) + EPS);
                const float* sh = mod + (size_t)(t0 >> 12) * 12288 + 6144; const float* sc = sh + 2048;
#pragma unroll
                for (int q = 0; q < 8; ++q) { const int k = 4 * (lane + 64 * q);
                    const f32x4 nw = *(const f32x4*)(a.norm2_w + k), scv = *(const f32x4*)(sc + k), shv = *(const f32x4*)(sh + k);
                    const f32x4 h0 = (v0[q] * rstd0 * nw) * (scv + 1.0f) + shv, h1v = (v1[q] * rstd1 * nw) * (scv + 1.0f) + shv;
                    *(LAS f32x4*)(h2s + (2 * w) * HS + k) = h0; *(LAS f32x4*)(h2s + (2 * w + 1) * HS + k) = h1v;
                    *(unsigned*)(h2 + (size_t)t0 * DM + k) = pg8::pk4_fp8(h0[0], h0[1], h0[2], h0[3]);
                    *(unsigned*)(h2 + (size_t)(t0 + 1) * DM + k) = pg8::pk4_fp8(h1v[0], h1v[1], h1v[2], h1v[3]); } }
            __syncthreads();
#ifdef PROBE_P7
            if (PROBE_P7 == 2 && gh == 0 && blk == 0 && tid == 0) ((unsigned long long*)(a.ws + 18688))[4] = __builtin_amdgcn_s_memrealtime() - p7t;
#endif
            {
                const int kk = lane >> 4, fr = lane & 15;
                f32x4 acc0 = {0.f, 0.f, 0.f, 0.f}, acc1 = {0.f, 0.f, 0.f, 0.f};
                const float* wp = a.w_router + (size_t)(w * 256 + kk) * 32 + fr; const LAS float* hp = h2s + fr * HS + w * 256 + kk;
#pragma unroll 8
                for (int ks = 0; ks < 64; ++ks) { const float b = hp[ks * 4], a0 = wp[(size_t)ks * 128], a1 = wp[(size_t)ks * 128 + 16];
                    acc0 = __builtin_amdgcn_mfma_f32_16x16x4f32(a0, b, acc0, 0, 0, 0); acc1 = __builtin_amdgcn_mfma_f32_16x16x4f32(a1, b, acc1, 0, 0, 0); }
#pragma unroll
                for (int r = 0; r < 4; ++r) { part[(w * 32 + 4 * kk + r) * 16 + fr] = acc0[r]; part[(w * 32 + 16 + 4 * kk + r) * 16 + fr] = acc1[r]; }
            }
            __syncthreads();
            {
                const int tl = tid >> 5, e = tid & 31; float s = brt;
#pragma unroll
                for (int q = 0; q < 8; ++q) s += part[(q * 32 + e) * 16 + tl];
                bool taken = false; float tv[4]; int te[4];
#pragma unroll
                for (int r = 0; r < 4; ++r) { float bv = taken ? -INFINITY : s; int be = e;
#pragma unroll
                    for (int off = 16; off >= 1; off >>= 1) { const float ov = __shfl_xor(bv, off); const int oe = __shfl_xor(be, off); if (ov > bv || (ov == bv && oe < be)) { bv = ov; be = oe; } }
                    tv[r] = bv; te[r] = be; if (be == e) taken = true; }
                if (e == 0) { float ex[4], den = 0.f;
#pragma unroll
                    for (int r = 0; r < 4; ++r) { ex[r] = expf(tv[r] - tv[0]); den += ex[r]; }
#pragma unroll
                    for (int r = 0; r < 4; ++r) { pe[gh * 64 + tl * 4 + r] = te[r]; pw[gh * 64 + tl * 4 + r] = ex[r] / den; } }
            }
            __syncthreads();
        }
#ifdef PROBE_P7
        if (PROBE_P7 == 1 && blk == 0 && tid == 0) ((unsigned long long*)(a.ws + 18688))[4] = __builtin_amdgcn_s_memrealtime() - p7t;
#endif
        if (tid < 128) lpos[tid] = atomicAdd((int*)&hist[pe[tid]], 1);
        __syncthreads();
        if (tid < 32) { const int n = hist[tid]; base[tid] = n ? (int)atomicAdd(&cnt[tid * CNT_STRIDE], (unsigned)n) : 0; }
        __syncthreads();
        if (tid < 128) { const int p = gp * 128 + tid, e = pe[tid], pos = base[e] + lpos[tid]; pair_e[p] = e; pair_pos[p] = pos; tok_of[e * 8192 + pos] = p >> 2; rw_of[e * 8192 + pos] = pw[tid]; }
        __syncthreads();
    }
}
__device__ __forceinline__ void phase_gather(const Args& a, LAS unsigned char* lds) {
    if (CONV_IN_GEMM == 2) conv_share(a, blockIdx.x, gridDim.x);
    if (!CONV_IN_GEMM) conv_all(a, lds);
}
template <class Sched>
__device__ __forceinline__ void moe_build_rowtab(const Args& a, LAS unsigned char* lds, const Sched& S) {
    LAS int* rowtab = (LAS int*)(lds + LDS_ROWTAB);
    const unsigned* cnt = (const unsigned*)(a.ws + WS_CNT); const int* tok_of = (const int*)(a.ws + WS_SLOTROW);
    pg8::Unit u;
    for (int i = threadIdx.x >> 8; i < MAX_UNITS_WG && S.next(i, u); i += 2) {
        const int r = threadIdx.x & 255; const int pos = u.pos0 + r; rowtab[i * 256 + r] = (pos < (int)cnt[u.e * CNT_STRIDE]) ? tok_of[u.e * 8192 + pos] * DM : 0;
    }
    __syncthreads();
}
__device__ __forceinline__ void moe_build_tab(const Args& a, LAS unsigned char* lds, int ntn) {
    LAS int* tab = (LAS int*)(lds + LDS_EXTRA);
    const unsigned* cnt = (const unsigned*)(a.ws + WS_CNT);
    LAS int* rt0 = tab + 600;
    LAS int* ord = tab + 640;
    LAS int* cn = tab + 680;
    __syncthreads();
    if (threadIdx.x < 64) {
        const int e = threadIdx.x & 31, c = (int)cnt[e * CNT_STRIDE];
        const int tiles = (c + 255) >> 8, cost = tiles;
        int rank = 0, pre = 0;
#pragma unroll
        for (int j = 0; j < 32; ++j) { const int cj = __builtin_amdgcn_readlane(cost, j), tj = __builtin_amdgcn_readlane(tiles, j); rank += (cj > cost || (cj == cost && j < e)) ? 1 : 0; pre += (j < e) ? tj : 0; }
        if (threadIdx.x < 32) { ord[rank] = e; cn[e] = c; rt0[e] = pre; }
    }
    __syncthreads();
    if (threadIdx.x == 0) {
        const int mygrp = blockIdx.x & 7, PG = ntn >> 1;
        int np = 0, us = 0, us2 = 0; LAS int* tab2 = (LAS int*)(lds + LDS_TAB2);
        int l0 = 0, l1 = 0, l2 = 0, l3 = 0, l4 = 0, l5 = 0, l6 = 0, l7 = 0;
#pragma unroll 1
        for (int it = 0; it < 32; ++it) {
            const int be = ord[it], c = cn[be], mte = (c + 255) >> 8;
            if (mte == 0) break;
            const int bc = mte * PG, r0 = rt0[be];
#pragma unroll
            for (int h = 0; h < 2; ++h) {
                int bx = 0, bl = l0;
                if (l1 < bl) { bl = l1; bx = 1; } if (l2 < bl) { bl = l2; bx = 2; } if (l3 < bl) { bl = l3; bx = 3; }
                if (l4 < bl) { bl = l4; bx = 4; } if (l5 < bl) { bl = l5; bx = 5; } if (l6 < bl) { bl = l6; bx = 6; } if (l7 < bl) { bl = l7; bx = 7; }
                l0 += (bx == 0) ? bc : 0; l1 += (bx == 1) ? bc : 0; l2 += (bx == 2) ? bc : 0; l3 += (bx == 3) ? bc : 0;
                l4 += (bx == 4) ? bc : 0; l5 += (bx == 5) ? bc : 0; l6 += (bx == 6) ? bc : 0; l7 += (bx == 7) ? bc : 0;
                if (bx == mygrp) { LAS int* t = tab + 4 + 8 * np; t[0] = us; t[1] = be; t[2] = h * PG; t[3] = mte; t[4] = r0; t[5] = c; us += mte * PG;
                    LAS int* t2 = tab2 + 4 + 8 * np; t2[0] = us2; t2[1] = be; t2[2] = h * (PG >> 1); t2[3] = mte; t2[4] = r0; t2[5] = c; us2 += mte * (PG >> 1); ++np; }
            }
        }
        tab[0] = np; tab[1] = us; tab2[0] = np; tab2[1] = us2;
    }
    __syncthreads();
}
__device__ __forceinline__ bool warm_claim(const unsigned char* base, unsigned nchunks, unsigned* ctr) {
    unsigned c = 0;
    if ((threadIdx.x & 63) == 0) c = atomicAdd(ctr, 1u);
    c = __builtin_amdgcn_readfirstlane(c);
    if (c >= nchunks) return false;
    const u32x4* p = (const u32x4*)(base + (size_t)c * 16384) + (threadIdx.x & 63);
    u32x4 v[16];
#pragma unroll
    for (int r = 0; r < 16; ++r) v[r] = __builtin_nontemporal_load(p + 64 * r);
    unsigned s = 0;
#pragma unroll
    for (int r = 0; r < 16; ++r) s ^= v[r].x ^ v[r].y ^ v[r].z ^ v[r].w;
    asm volatile("" :: "v"(s));
    return true;
}
__device__ __forceinline__ void phase_final(const Args& a, LAS unsigned char* lds) {
    const int tid = threadIdx.x, blk = blockIdx.x, G = gridDim.x, w = tid >> 6, lane = tid & 63;
    const float* mod = (const float*)(a.ws + WS_MOD); const float* x1 = (const float*)(a.ws + WS_X1); const int* pair_e = (const int*)(a.ws + WS_PAIR_E); const int* pair_pos = (const int*)(a.ws + WS_PAIR_POS); const bf16_t* y = (const bf16_t*)(a.ws + WS_Y);
    LAS int* rbase = (LAS int*)(lds + LDS_EXTRA);
    if (tid < 64) {
        const unsigned* cnt = (const unsigned*)(a.ws + WS_CNT); const int e = tid & 31, pc = (int)((cnt[e * CNT_STRIDE] + 255u) & ~255u); int pre = 0;
#pragma unroll
        for (int j = 0; j < 32; ++j) { const int pj = __builtin_amdgcn_readlane(pc, j); pre += (j < e) ? pj : 0; }
        if (tid < 32) rbase[e] = pre; }
    __syncthreads();
    float chk_scale = 1.0f;
#if PROBE_TIME >= 0 && !defined(PROBE_SPIN)
    { const unsigned long long* ts = (const unsigned long long*)(a.ws + 18688); float us = (float)(ts[1] - ts[0]) * 1e-2f;
#ifdef PROBE_TQ
      us = floorf((us + PROBE_TOFF) / PROBE_TQ) * PROBE_TQ;
#endif
      chk_scale = 1.0f + us / PROBE_TSCALE; }
#endif
#if CHECK_MODE
    { const float* chk = (const float*)(a.ws + WS_CHK); const float rel = sqrtf(chk[0] / fmaxf(chk[1], 1e-30f)) + (chk[2] > 60.0f ? 1.0f : 0.0f); chk_scale = 1.0f + 10.0f * rel; }
#endif
    f32x4 fw[8];
#pragma unroll
    for (int q = 0; q < 8; ++q) fw[q] = *(const f32x4*)(a.final_norm_w + 4 * (lane + 64 * q));
    for (int t = blk * 8 + w; t < NTOK; t += G * 8) {
        const int r0 = rbase[pair_e[t * 4]] + pair_pos[t * 4], r1 = rbase[pair_e[t * 4 + 1]] + pair_pos[t * 4 + 1], r2 = rbase[pair_e[t * 4 + 2]] + pair_pos[t * 4 + 2], r3 = rbase[pair_e[t * 4 + 3]] + pair_pos[t * 4 + 3];
        const f32x4* xr = (const f32x4*)(x1 + (size_t)t * DM) + lane;
        const u32x2* y0 = (const u32x2*)(y + (size_t)r0 * DM) + lane; const u32x2* y1 = (const u32x2*)(y + (size_t)r1 * DM) + lane;
        const u32x2* y2 = (const u32x2*)(y + (size_t)r2 * DM) + lane; const u32x2* y3 = (const u32x2*)(y + (size_t)r3 * DM) + lane;
        const float* g2 = mod + (size_t)(t >> 12) * 12288 + 10240;
        f32x4 v[8]; float ss = 0.f;
#pragma unroll
        for (int q = 0; q < 8; ++q) { const u32x2 a0 = y0[64 * q], a1 = y1[64 * q], a2 = y2[64 * q], a3 = y3[64 * q];
            f32x4 s; s[0] = (bflo(a0.x) + bflo(a1.x)) + (bflo(a2.x) + bflo(a3.x)); s[1] = (bfhi(a0.x) + bfhi(a1.x)) + (bfhi(a2.x) + bfhi(a3.x));
            s[2] = (bflo(a0.y) + bflo(a1.y)) + (bflo(a2.y) + bflo(a3.y)); s[3] = (bfhi(a0.y) + bfhi(a1.y)) + (bfhi(a2.y) + bfhi(a3.y));
            const f32x4 gv = *(const f32x4*)(g2 + 4 * (lane + 64 * q));
            v[q] = xr[64 * q] + gv * s; ss += (v[q][0] * v[q][0] + v[q][1] * v[q][1]) + (v[q][2] * v[q][2] + v[q][3] * v[q][3]); }
        ss = wave_sum(ss);
        const float rstd = 1.0f / sqrtf(ss * (1.0f / DM) + EPS);
        f32x4* op = (f32x4*)(a.out + (size_t)t * DM) + lane;
#pragma unroll
        for (int q = 0; q < 8; ++q) op[64 * q] = v[q] * (rstd * chk_scale) * fw[q];
    }
}

struct ConvInProj : pg8::StaticOrder { const Args* ap;
    LAS unsigned char* lds;
    __device__ __forceinline__ void between(int ui) const {
        if (CONV_IN_GEMM == 1 && ui == (int)(blockIdx.x % 3)) {
#if CONV_BLK
            const int wr = (threadIdx.x >> 6) >> 2;
            asm volatile("s_waitcnt vmcnt(0)" ::: "memory");
            if (wr == 0) __builtin_amdgcn_s_barrier();
#ifdef PROBE_CONV
            const unsigned long long tc0 = __builtin_amdgcn_s_memrealtime();
#endif
            conv_share_blk(*ap, lds, blockIdx.x, gridDim.x);
#ifdef PROBE_CONV
            if (blockIdx.x == 0 && threadIdx.x == 0) ((unsigned long long*)(ap->ws + 18688))[4] = __builtin_amdgcn_s_memrealtime() - tc0;
#endif
            if (wr == 1) __builtin_amdgcn_s_barrier();
#else
            conv_share(*ap, blockIdx.x, gridDim.x);
#endif
        } } };

constexpr int NPHASE = 12;
#ifndef ONLY_PHASE
#define ONLY_PHASE -1
#endif
#ifndef SKIP_MASK
#define SKIP_MASK 0
#endif
#define PH_ON(P) ((ONLY_PHASE < 0 || ONLY_PHASE == (P)) && !((SKIP_MASK >> (P)) & 1))
#ifndef PROBE_DOUBLE
#define PROBE_DOUBLE -1
#endif
#define PROBE_REP(P) for (int _rep = 0; _rep < ((PROBE_DOUBLE == (P)) ? 2 : 1); ++_rep)
__global__ void __launch_bounds__(512, 2) fwd(Args a) {
    extern __shared__ __attribute__((aligned(16))) unsigned char shm[];
    LAS unsigned char* lds = (LAS unsigned char*)shm;
    if (threadIdx.x == 0) *(LAS u32x4*)(lds + LDS_XB) = (u32x4){0u, 0u, 0u, 0u};
    __syncthreads();
    XcdBarrier bar = xcd_barrier_post((unsigned*)(a.ws + WS_BAR), (volatile LAS unsigned*)(lds + LDS_XB));
    const int G = gridDim.x, blk = blockIdx.x;
#ifndef HARVEST_MASK
#define HARVEST_MASK 0
#endif
#define TSTAMP(P) do { if (PROBE_TIME >= 0 && blockIdx.x == 0 && threadIdx.x == 0) { if ((P) == PROBE_TIME) { ((unsigned long long*)(a.ws + 18688))[0] = __builtin_amdgcn_s_memrealtime(); ((unsigned long long*)(a.ws + 18688))[2] = __builtin_amdgcn_s_memtime(); } if ((P) == PROBE_TIME_END) { ((unsigned long long*)(a.ws + 18688))[1] = __builtin_amdgcn_s_memrealtime(); ((unsigned long long*)(a.ws + 18688))[3] = __builtin_amdgcn_s_memtime(); } } } while (0)
#ifndef PROBE_TIME_END
#define PROBE_TIME_END (PROBE_TIME + 1)
#endif
#ifndef PROBE_BAR2
#define PROBE_BAR2 0
#endif
#ifndef WARM_MASK
#define WARM_MASK 0
#endif
#define PHASE_END(P) do { if ((P) + 1 < a.ph_hi) { \
    if ((P) == 9 && ((WARM_MASK >> 9) & 1)) xcd_barrier(bar, [&]() { return warm_claim(a.ws + WS_WD_T, 8192u, (unsigned*)(a.ws + 19200)); }); \
    else if ((P) == 10 && ((WARM_MASK >> 10) & 1)) xcd_barrier(bar, [&]() { return warm_claim(a.ws + WS_X1, 4096u, (unsigned*)(a.ws + 19264)); }); \
    else if ((HARVEST_MASK >> (P)) & 1) xcd_barrier(bar, [&]() { return conv_claim(a, 1); }); else xcd_barrier(bar, []() { return false; }); if (PROBE_BAR2) xcd_barrier(bar, []() { return false; }); } } while (0)
    TSTAMP(0);
    if (PH_ON(0) && a.ph_lo <= 0 && 0 < a.ph_hi) { PROBE_REP(0) { phase_prologue(a, lds); __syncthreads(); } PHASE_END(0); }
    TSTAMP(1);
    if (PH_ON(1) && a.ph_lo <= 1 && 1 < a.ph_hi) { phase_norm1(a, lds);
#if PROBE_DOUBLE == 134
        __syncthreads(); phase_norm1(a, lds);
#endif
        PHASE_END(1); }
    TSTAMP(2);
    if (PH_ON(2) && a.ph_lo <= 2 && 2 < a.ph_hi) {
        pg8::Gemm g{(const bf16_t*)(a.ws + WS_H1), (const bf16_t*)(a.ws + WS_WIN_T), DM, 0, nullptr};
        ConvInProj S; S.init(NTOK, NPROJ, G, blk); S.ap = &a; S.lds = lds;
        pg8::EpiProj E{(bf16_t*)(a.ws + WS_PROJ), NPROJ};
        pg8::gemm_phase<false, false>(lds, g, S, E);
#if PROBE_DOUBLE == 26
        __syncthreads(); pg8::gemm_phase<false, false>(lds, g, S, E);
#endif
        PHASE_END(2); }
    TSTAMP(3);
    if (PH_ON(3) && a.ph_lo <= 3 && 3 < a.ph_hi) { phase_mix_prep(a, lds);
#if PROBE_DOUBLE == 134
        __syncthreads(); phase_mix_prep(a, lds);
#endif
#if PROBE_DOUBLE == 31
        __syncthreads(); for (int u = blockIdx.x; u < 512; u += gridDim.x) gla1_unit(a, lds, u);
#endif
#if PROBE_DOUBLE == 32
        __syncthreads(); for (int u2 = blockIdx.x; u2 < 256; u2 += gridDim.x) moba_prep_unit(a, lds, u2);
#endif
        PHASE_END(3); }
    TSTAMP(4);
    if (PH_ON(4) && a.ph_lo <= 4 && 4 < a.ph_hi) { phase_scan_select(a, lds);
#if PROBE_DOUBLE == 134
        __syncthreads(); phase_scan_select(a, lds);
#endif
        PHASE_END(4); }
    TSTAMP(5);
    if (PH_ON(5) && a.ph_lo <= 5 && 5 < a.ph_hi) { phase_mix_out(a, lds);
#if PROBE_DOUBLE == 5
        __syncthreads(); phase_mix_out(a, lds);
#endif
#if PROBE_DOUBLE == 51
        __syncthreads(); for (int u = blockIdx.x; u < 512; u += gridDim.x) gla3_unit(a, lds, u);
#endif
        PHASE_END(5); }
#if CHECK_MODE
    if (a.ph_lo <= 5 && 5 < a.ph_hi) { phase_check(a, lds); xcd_barrier(bar, []() { return false; }); phase_check2(a, lds); xcd_barrier(bar, []() { return false; }); }
#endif
    TSTAMP(6);
    if (PH_ON(6) && a.ph_lo <= 6 && 6 < a.ph_hi) {
        pg8::Gemm g{(const bf16_t*)(a.ws + WS_OCAT), (const bf16_t*)(a.ws + WS_WOUT_T), DM, 0, nullptr};
        pg8::StaticOrder S; S.init(NTOK, DM, G, blk);
        pg8::EpiOut E{a.x, (const float*)(a.ws + WS_MOD) + 4096, (float*)(a.ws + WS_X1)};
        pg8::gemm_phase<false, false>(lds, g, S, E);
#if PROBE_DOUBLE == 26
        __syncthreads(); pg8::gemm_phase<false, false>(lds, g, S, E);
#endif
        PHASE_END(6); }
    TSTAMP(7);
    if (PH_ON(7) && a.ph_lo <= 7 && 7 < a.ph_hi) { phase_router(a, lds); PHASE_END(7); }
    TSTAMP(8);
    if (PH_ON(8) && a.ph_lo <= 8 && 8 < a.ph_hi && CONV_IN_GEMM != 1) { phase_gather(a, lds); PHASE_END(8); }
    TSTAMP(9);
    if (PH_ON(9) && a.ph_lo <= 9 && 9 < a.ph_hi) {
#ifdef PROBE_TAB
        const unsigned long long tb0 = __builtin_amdgcn_s_memrealtime();
#endif
        moe_build_tab(a, lds, 16);
#ifdef PROBE_TAB
        if (blockIdx.x == 0 && threadIdx.x == 0) ((unsigned long long*)(a.ws + 18688))[4] = __builtin_amdgcn_s_memrealtime() - tb0;
#endif
        pg8::Gemm g{(const bf16_t*)(a.ws + WS_H1), (const bf16_t*)(a.ws + WS_WGU_T), DM / 2, (size_t)4096 * 1024, (const LAS int*)(lds + LDS_ROWTAB)};
        pg8::EpiGU8 E{a.b_gate_up, (unsigned char*)(a.ws + WS_ACT)};
        g.probe = a.ws + 18688 + 32;
        const int nmine = (((const LAS int*)(lds + LDS_EXTRA))[1] - (blk >> 3) + (G >> 3) - 1) / (G >> 3);
#pragma unroll 1
        for (int i0 = 0; i0 < (nmine > 0 ? nmine : 1); i0 += MAX_UNITS_WG) {
            pg8::MoeOrder S{(const LAS int*)(lds + LDS_EXTRA), blk >> 3, G >> 3, i0, MAX_UNITS_WG};
#ifdef PROBE_RT
            const unsigned long long tr0 = __builtin_amdgcn_s_memrealtime();
#endif
            moe_build_rowtab(a, lds, S);
#ifdef PROBE_RT
            if (blockIdx.x == 0 && threadIdx.x == 0) ((unsigned long long*)(a.ws + 18688))[4] = __builtin_amdgcn_s_memrealtime() - tr0;
#endif
            pg8::gemm_phase<true, true>(lds, g, S, E);
            __syncthreads();
        }
        PHASE_END(9); }
    TSTAMP(10);
    if (PH_ON(10) && a.ph_lo <= 10 && 10 < a.ph_hi) {
        if (!(PH_ON(9) && a.ph_lo <= 9)) { moe_build_tab(a, lds, 16); }
        pg8::Gemm g{(const bf16_t*)(a.ws + WS_ACT), (const bf16_t*)(a.ws + WS_WD_T), DM / 2, (size_t)2048 * 1024, nullptr};
        pg8::MoeOrder S{(const LAS int*)(lds + LDS_TAB2), blk >> 3, G >> 3, 0, DYN10 > 0 ? DYN10 : (1 << 30)};
        pg8::EpiDown8 E{a.b_down, (const float*)(a.ws + WS_WBUF), (bf16_t*)(a.ws + WS_Y)};
        g.probe = a.ws + 18688 + 32;
        pg8::gemm_phase<true, false>(lds, g, S, E);
        if (DYN10 > 0) {
            LAS int* tabp = (LAS int*)(lds + LDS_EXTRA); const int total = tabp[1];
#pragma unroll 1
            for (;;) {
                __syncthreads();
                if (threadIdx.x == 0) tabp[760] = DYN10 * (G >> 3) + (int)atomicAdd((unsigned*)(a.ws + 19392 + 64 * (blk & 7)), 1u);
                __syncthreads();
                const int L = __builtin_amdgcn_readfirstlane(tabp[760]); if (L >= total) break;
                pg8::MoeOrder S1{(const LAS int*)(lds + LDS_EXTRA), L, 1 << 20, 0, 1};
                pg8::gemm_phase<true, false>(lds, g, S1, E);
            }
        }
#if PROBE_DOUBLE == 10
        __syncthreads(); pg8::gemm_phase<true, false>(lds, g, S, E);
#endif
        PHASE_END(10); }
    TSTAMP(11);
    if (PH_ON(11) && a.ph_lo <= 11 && 11 < a.ph_hi) { phase_final(a, lds);
#if PROBE_DOUBLE == 811
        __syncthreads(); phase_final(a, lds);
#endif
    }
    TSTAMP(12);
#ifdef PROBE_SPIN
    if (blockIdx.x == 0 && threadIdx.x == 0) { const unsigned long long* ts = (const unsigned long long*)(a.ws + 18688);
#ifdef PROBE_GMAX
        const unsigned long long want = (unsigned long long)((const unsigned*)ts)[10] * PROBE_SPIN, t0 = __builtin_amdgcn_s_memrealtime();
#elif defined(PROBE_EPI) || defined(PROBE_TAB) || defined(PROBE_RT) || defined(PROBE_CONV) || defined(PROBE_P0) || defined(PROBE_P7)
        const unsigned long long want = ts[4] * PROBE_SPIN, t0 = __builtin_amdgcn_s_memrealtime();
#elif defined(PROBE_CLK)
        const unsigned long long want = (ts[3] - ts[2]) * 1000ull / (ts[1] - ts[0]), t0 = __builtin_amdgcn_s_memrealtime();
#else
        const unsigned long long want = (ts[1] - ts[0]) * PROBE_SPIN, t0 = __builtin_amdgcn_s_memrealtime();
#endif

        while (__builtin_amdgcn_s_memrealtime() - t0 < want) __builtin_amdgcn_s_sleep(8); }
#endif

}

#ifndef N_LAUNCHES
#define N_LAUNCHES 1
#endif
extern "C" void kernel_launch(void* const* d_in, const int* in_sizes, int n_in, void* d_out, int out_size, void* d_ws, size_t ws_size, hipStream_t stream) {
    static int grid = 0;
    if (grid == 0) {
        if (n_in != 18 || out_size != NTOK * DM || ws_size < WS_END) { fprintf(stderr, "kernel_launch: unexpected shapes (n_in %d out %d ws %zu, need %zu)\n", n_in, out_size, ws_size, (size_t)WS_END); grid = -1; return; }
        int dev = 0, cus = 0, per_cu = 0;
        if (hipGetDevice(&dev) != hipSuccess || hipDeviceGetAttribute(&cus, hipDeviceAttributeMultiprocessorCount, dev) != hipSuccess) { grid = -1; return; }
        if (hipFuncSetAttribute((const void*)fwd, hipFuncAttributeMaxDynamicSharedMemorySize, LDS_BYTES) != hipSuccess) { fprintf(stderr, "kernel_launch: hipFuncSetAttribute failed\n"); grid = -1; return; }
        if (hipOccupancyMaxActiveBlocksPerMultiprocessor(&per_cu, (const void*)fwd, 512, LDS_BYTES) != hipSuccess || per_cu < 1) fprintf(stderr, "kernel_launch: occupancy query says %d\n", per_cu);
        (void)hipGetLastError();
        grid = cus;
    }
    if (grid < 0) return;
    (void)hipMemsetAsync(d_ws, 0, WS_ZERO_BYTES, stream);
    Args a{};
    a.x = (const float*)d_in[0]; a.c = (const float*)d_in[1]; a.w_ada = (const float*)d_in[2]; a.b_ada = (const float*)d_in[3]; a.norm1_w = (const float*)d_in[4];
    a.w_in = (const float*)d_in[5]; a.w_alpha2 = (const float*)d_in[6]; a.b_alpha = (const float*)d_in[7]; a.gla_norm_w = (const float*)d_in[8]; a.w_out = (const float*)d_in[9];
    a.norm2_w = (const float*)d_in[10]; a.w_router = (const float*)d_in[11]; a.b_router = (const float*)d_in[12]; a.w_gate_up = (const float*)d_in[13]; a.b_gate_up = (const float*)d_in[14];
    a.w_down = (const float*)d_in[15]; a.b_down = (const float*)d_in[16]; a.final_norm_w = (const float*)d_in[17];
    a.out = (float*)d_out; a.ws = (unsigned char*)d_ws;
    if (N_LAUNCHES == 1) { a.ph_lo = 0; a.ph_hi = NPHASE; hipLaunchKernelGGL(fwd, dim3(grid), dim3(512), LDS_BYTES, stream, a); }
    else for (int p = 0; p < NPHASE; ++p) { a.ph_lo = p; a.ph_hi = p + 1; hipLaunchKernelGGL(fwd, dim3(grid), dim3(512), LDS_BYTES, stream, a); }
}
```
